# Optimizing an MI355X kernel written in HIP

```python
import math
import jax
import jax.numpy as jnp
from jax import lax
import numpy as np

D_MODEL = 2048
BATCH = 2
SEQ = 4096
DEPTH = 4

GRID_W = 64
CTX_LEN = 256
EPS = 1e-6
ROPE_THETA = 10000.0

HEAD_DIM = 128
MIX_W = D_MODEL // 2

GDN_HEADS = MIX_W // HEAD_DIM
GDN_DK = HEAD_DIM
GDN_DV = HEAD_DIM
GDN_CHUNK = 64
SHORT_CONV = 3

SSM_HEAD_DIM = 64
SSM_HEADS = MIX_W // SSM_HEAD_DIM
SSM_GROUPS = 2
SSM_STATE = 128
SSM_CHUNK = 64
SSM_INNER = SSM_HEADS * SSM_HEAD_DIM
SSM_BC = SSM_GROUPS * SSM_STATE
SSM_XBC = SSM_INNER + 2 * SSM_BC

ATT_Q_HEADS = MIX_W // HEAD_DIM
ATT_KV_HEADS = 2
ATT_BLOCK = 128
WINDOW = 128

N_BRANCH = 3
D_FF = 5632
FFN_CONV = 3

IN_SPLITS = (
    3 * GDN_HEADS * HEAD_DIM,
    GDN_HEADS * GDN_DV,
    2 * GDN_HEADS,
    2 * GDN_HEADS,
    SSM_INNER,
    SSM_XBC,
    2 * SSM_HEADS,
    ATT_Q_HEADS * HEAD_DIM,
    2 * ATT_KV_HEADS * HEAD_DIM,
    N_BRANCH * D_MODEL,
)
P_IN = sum(IN_SPLITS)

kernel_name = 'hybrid_gdn_ssd_swa_block'

F32 = jnp.float32


def rmsnorm(x, w):
    xf = x.astype(F32)
    y = xf * lax.rsqrt(jnp.mean(xf * xf, axis=-1, keepdims=True) + EPS)
    return (y * w.astype(F32)).astype(x.dtype)


def l2norm(x):
    return x * lax.rsqrt(jnp.sum(x * x, axis=-1, keepdims=True) + EPS)


def modulate(x, shift, scale):
    return x * (1 + scale) + shift


def dwconv_centered(x, w):
    k = w.shape[0]
    pad = k // 2
    n = x.shape[1]
    xp = jnp.pad(x, ((0, 0), (pad, pad), (0, 0)))
    y = xp[:, 0:n] * w[0]
    for j in range(1, k):
        y = y + xp[:, j:j + n] * w[j]
    return y


def split_in(p):
    offs = [int(o) for o in np.cumsum(IN_SPLITS)[:-1]]
    return jnp.split(p, offs, axis=-1)


def gdn_inputs(qkv_raw, a_raw, b_raw, conv_w, a_log, dt_bias):
    bsz, n = qkv_raw.shape[:2]
    qkv = jax.nn.silu(dwconv_centered(qkv_raw, conv_w)).astype(F32)
    q, k, v = jnp.split(qkv, 3, axis=-1)
    q = l2norm(q.reshape(bsz, n, GDN_HEADS, GDN_DK)) * (GDN_DK ** -0.5)
    k = l2norm(k.reshape(bsz, n, GDN_HEADS, GDN_DK))
    v = v.reshape(bsz, n, GDN_HEADS, GDN_DV)
    a = a_raw.astype(F32).reshape(bsz, n, 2, GDN_HEADS)
    g = -jnp.exp(a_log.astype(F32)) * jax.nn.softplus(a + dt_bias.astype(F32))
    beta = jax.nn.sigmoid(b_raw.astype(F32).reshape(bsz, n, 2, GDN_HEADS))
    return q, k, v, g, beta


def gdn_chunked(q, k, v, g, beta, s0):
    bsz, n, h, _ = q.shape
    dv = v.shape[-1]
    cl = GDN_CHUNK
    nc = n // cl

    def chunks(t):
        return jnp.moveaxis(t.reshape((bsz, nc, cl) + t.shape[2:]), 3, 1)

    q, k, v, g, beta = (chunks(t) for t in (q, k, v, g, beta))
    g = jnp.cumsum(g, axis=-1)
    incl = jnp.tril(jnp.ones((cl, cl), bool))
    strict = jnp.tril(jnp.ones((cl, cl), bool), -1)
    decay = jnp.exp(jnp.where(incl, g[..., :, None] - g[..., None, :], -jnp.inf))
    kb = k * beta[..., None]
    lower = jnp.einsum('bhnid,bhnjd->bhnij', kb, k) * jnp.where(strict, decay, 0.0)
    rhs = jnp.concatenate([v * beta[..., None], kb * jnp.exp(g)[..., None]], axis=-1)
    sol = lax.linalg.triangular_solve(lower + jnp.eye(cl, dtype=lower.dtype), rhs,
                                      left_side=True, lower=True)
    u, w = sol[..., :dv], sol[..., dv:]
    attn = jnp.einsum('bhnid,bhnjd->bhnij', q, k) * decay
    q_dec = q * jnp.exp(g)[..., None]
    k_dec = k * jnp.exp(g[..., -1:] - g)[..., None]
    last = jnp.exp(g[..., -1])

    def step(s, xs):
        q_c, a_c, u_c, w_c, k_c, l_c = xs
        v_new = u_c - jnp.einsum('bhcd,bhdv->bhcv', w_c, s)
        o = jnp.einsum('bhcd,bhdv->bhcv', q_c, s) + jnp.einsum('bhij,bhjv->bhiv', a_c, v_new)
        s = s * l_c[..., None, None] + jnp.einsum('bhcd,bhcv->bhdv', k_c, v_new)
        return s, o

    xs = tuple(jnp.moveaxis(t, 2, 0) for t in (q_dec, attn, u, w, k_dec, last))
    s_final, o = lax.scan(step, s0, xs)
    o = jnp.transpose(o, (1, 0, 3, 2, 4)).reshape(bsz, n, h, dv)
    return o, s_final


def gdn_output(o, gate, norm_w):
    bsz, n = gate.shape[:2]
    y = rmsnorm(o, norm_w) * jax.nn.silu(gate.astype(F32).reshape(bsz, n, GDN_HEADS, GDN_DV))
    return y.reshape(bsz, n, GDN_HEADS * GDN_DV).astype(gate.dtype)


def ssd_inputs(xbc_raw, dt_raw, conv_w, conv_b, a_log, dt_bias):
    bsz, n = xbc_raw.shape[:2]
    xbc = jax.nn.silu(dwconv_centered(xbc_raw, conv_w) + conv_b).astype(F32)
    xs, bm, cm = jnp.split(xbc, [SSM_INNER, SSM_INNER + SSM_BC], axis=-1)
    xs = xs.reshape(bsz, n, SSM_HEADS, SSM_HEAD_DIM)
    bm = bm.reshape(bsz, n, SSM_GROUPS, SSM_STATE)
    cm = cm.reshape(bsz, n, SSM_GROUPS, SSM_STATE)
    dt = jax.nn.softplus(dt_raw.astype(F32).reshape(bsz, n, 2, SSM_HEADS) + dt_bias.astype(F32))
    log_decay = -jnp.exp(a_log.astype(F32)) * dt
    return xs, dt, log_decay, bm, cm


def ssd_chunked(x, dt, a, bm, cm, h0):
    bsz, n, h, p = x.shape
    grp = bm.shape[2]
    rep = h // grp
    cl = SSM_CHUNK
    nc = n // cl
    xdt = (x * dt[..., None]).reshape(bsz, nc, cl, grp, rep, p)
    a_cum = jnp.cumsum(a.reshape(bsz, nc, cl, grp, rep), axis=2)
    bc = bm.reshape(bsz, nc, cl, grp, -1)
    cc = cm.reshape(bsz, nc, cl, grp, -1)
    incl = jnp.tril(jnp.ones((cl, cl), bool))[:, :, None, None]
    seg = jnp.exp(jnp.where(incl, a_cum[:, :, :, None] - a_cum[:, :, None, :], -jnp.inf))
    cb = jnp.einsum('bnigs,bnjgs->bnijg', cc, bc)
    y_diag = jnp.einsum('bnijg,bnijgr,bnjgrp->bnigrp', cb, seg, xdt)
    to_end = jnp.exp(a_cum[:, :, -1:] - a_cum)
    states = jnp.einsum('bnjgs,bnjgr,bnjgrp->bngrsp', bc, to_end, xdt)
    chunk_decay = jnp.exp(a_cum[:, :, -1])

    def step(hs, xs):
        st, dec = xs
        return hs * dec[..., None, None] + st, hs

    h_final, h_prev = lax.scan(step, h0, (jnp.moveaxis(states, 1, 0), jnp.moveaxis(chunk_decay, 1, 0)))
    h_prev = jnp.moveaxis(h_prev, 0, 1)
    y_off = jnp.einsum('bnigs,bnigr,bngrsp->bnigrp', cc, jnp.exp(a_cum), h_prev)
    return (y_diag + y_off).reshape(bsz, n, h, p), h_final


def ssd_output(y, xs, d_skip, z, norm_w):
    bsz, n = z.shape[:2]
    y = y + d_skip.astype(F32)[:, None] * xs
    y = y.reshape(bsz, n, SSM_INNER) * jax.nn.silu(z.astype(F32))
    y = rmsnorm(y.reshape(bsz, n, SSM_GROUPS, SSM_INNER // SSM_GROUPS),
                norm_w.reshape(SSM_GROUPS, SSM_INNER // SSM_GROUPS))
    return y.reshape(bsz, n, SSM_INNER).astype(z.dtype)


def bidirectional_scan(scan_fn, lat_fwd, lat_bwd, ctx_fwd, ctx_bwd, state0):
    flip = lambda ts: tuple(jnp.flip(t, axis=1) for t in ts)
    oc_f, sc_f = scan_fn(*ctx_fwd, state0)
    ol_f, _ = scan_fn(*lat_fwd, sc_f)
    oc_b, sc_b = scan_fn(*flip(ctx_bwd), state0)
    ol_b, _ = scan_fn(*flip(lat_bwd), sc_b)
    return ol_f + jnp.flip(ol_b, axis=1), oc_f + jnp.flip(oc_b, axis=1)


def attn_heads(q_raw, kv_raw):
    bsz, n = q_raw.shape[:2]
    k, v = jnp.split(kv_raw, 2, axis=-1)
    return (q_raw.reshape(bsz, n, ATT_Q_HEADS, HEAD_DIM),
            k.reshape(bsz, n, ATT_KV_HEADS, HEAD_DIM),
            v.reshape(bsz, n, ATT_KV_HEADS, HEAD_DIM))


def axial_rope_tables(n_tokens):
    rows = n_tokens // GRID_W
    row = jnp.repeat(jnp.arange(rows, dtype=F32), GRID_W)
    col = jnp.tile(jnp.arange(GRID_W, dtype=F32), rows)
    n_freq = HEAD_DIM // 4
    inv_freq = ROPE_THETA ** (-jnp.arange(n_freq, dtype=F32) / n_freq)
    ang = jnp.stack([row[:, None] * inv_freq, col[:, None] * inv_freq], axis=1)
    return jnp.cos(ang), jnp.sin(ang)


def apply_axial_rope(x, cos, sin):
    bsz, n, h, d = x.shape
    xr = x.astype(F32).reshape(bsz, n, h, 2, 2, d // 4)
    x1, x2 = xr[..., 0, :], xr[..., 1, :]
    c = cos[None, :, None]
    s = sin[None, :, None]
    out = jnp.stack([x1 * c - x2 * s, x2 * c + x1 * s], axis=-2)
    return out.reshape(bsz, n, h, d).astype(x.dtype)


def softmax_with_sink(logits, sink):
    shape = (ATT_KV_HEADS, ATT_Q_HEADS // ATT_KV_HEADS) + (1,) * (logits.ndim - 3)
    sink_col = jnp.broadcast_to(sink.astype(F32).reshape(shape), logits.shape[:-1] + (1,))
    p = jax.nn.softmax(jnp.concatenate([logits, sink_col], axis=-1), axis=-1)
    return p[..., :-1]


def band_attention(q, k, v, kc, vc, sink):
    bsz, n, hq, dh = q.shape
    grp = hq // ATT_KV_HEADS
    nb = n // ATT_BLOCK
    n_ctx = kc.shape[1]
    scale = dh ** -0.5
    qb = q.reshape(bsz, nb, ATT_BLOCK, ATT_KV_HEADS, grp, dh)

    def band(t):
        tp = jnp.pad(t, ((0, 0), (ATT_BLOCK, ATT_BLOCK), (0, 0), (0, 0)))
        views = [tp[:, i * ATT_BLOCK:i * ATT_BLOCK + n].reshape(bsz, nb, ATT_BLOCK, ATT_KV_HEADS, dh)
                 for i in range(3)]
        return jnp.concatenate(views, axis=2)

    kb, vb = band(k), band(v)
    s_loc = jnp.einsum('bnqhgd,bnkhd->bhgnqk', qb, kb, preferred_element_type=F32) * scale
    s_ctx = jnp.einsum('bnqhgd,blhd->bhgnql', qb, kc, preferred_element_type=F32) * scale
    qi = jnp.arange(ATT_BLOCK)[:, None]
    kj = jnp.arange(3 * ATT_BLOCK)[None, :]
    rel = kj - ATT_BLOCK - qi
    pos = (jnp.arange(nb)[:, None, None] - 1) * ATT_BLOCK + kj[None]
    valid = (jnp.abs(rel) <= WINDOW)[None] & (pos >= 0) & (pos < n)
    s_loc = jnp.where(valid, s_loc, -jnp.inf)
    p = softmax_with_sink(jnp.concatenate([s_loc, s_ctx], axis=-1), sink)
    p_loc, p_ctx = p[..., :3 * ATT_BLOCK], p[..., 3 * ATT_BLOCK:3 * ATT_BLOCK + n_ctx]
    o = (jnp.einsum('bhgnqk,bnkhd->bnqhgd', p_loc, vb.astype(F32))
         + jnp.einsum('bhgnql,blhd->bnqhgd', p_ctx, vc.astype(F32)))
    return o.reshape(bsz, n, hq * dh).astype(q.dtype)


def context_attention(qc, kc, vc, sink):
    bsz, n_ctx, hq, dh = qc.shape
    grp = hq // ATT_KV_HEADS
    qg = qc.reshape(bsz, n_ctx, ATT_KV_HEADS, grp, dh)
    s = jnp.einsum('blhgd,bmhd->bhglm', qg, kc, preferred_element_type=F32) * (dh ** -0.5)
    p = softmax_with_sink(s, sink)
    o = jnp.einsum('bhglm,bmhd->blhgd', p, vc.astype(F32))
    return o.reshape(bsz, n_ctx, hq * dh).astype(qc.dtype)


def merge_branches(ya, yb, yc, gate_raw, w_a, w_b, w_c, w_o):
    ga, gb, gc = jnp.split(jax.nn.sigmoid(gate_raw), N_BRANCH, axis=-1)
    m = ga * (ya @ w_a) + gb * (yb @ w_b) + gc * (yc @ w_c)
    return m @ w_o


def conv_ffn(h, w_up, conv_w, conv_b, w_down):
    u, g = jnp.split(h @ w_up, 2, axis=-1)
    g = dwconv_centered(g, conv_w) + conv_b
    return (jax.nn.silu(g) * u) @ w_down


def _dt_bias(key, shape):
    u = jax.random.uniform(key, shape, F32)
    dt = jnp.exp(u * (math.log(0.1) - math.log(0.001)) + math.log(0.001))
    return dt + jnp.log(-jnp.expm1(-dt))


def setup_inputs(seed: int = 0) -> dict:
    key = jax.random.key(seed)
    ks = iter(jax.random.split(key, 40))
    L, D = DEPTH, D_MODEL

    def nrm(shape, scale):
        return jax.random.normal(next(ks), shape, F32) * scale

    def gain(shape):
        return 1.0 + nrm(shape, 0.02)

    def a_log(shape):
        return jnp.log(jax.random.uniform(next(ks), shape, F32, minval=1.0, maxval=16.0))

    return {
        'x': nrm((BATCH, SEQ, D), 1.0),
        'c': nrm((BATCH, D), 1.0),
        'ctx': nrm((BATCH, CTX_LEN, D), 1.0),
        'c_ctx': nrm((D,), 1.0),
        'w_ada': nrm((L, D, 6 * D), 0.5 * D ** -0.5),
        'b_ada': nrm((L, 6 * D), 0.02),
        'g_pre1': gain((L, D)),
        'w_in': nrm((L, D, P_IN), D ** -0.5),
        'gdn_conv_w': nrm((L, SHORT_CONV, 3 * GDN_HEADS * HEAD_DIM), SHORT_CONV ** -0.5),
        'gdn_a_log': a_log((L, 2, GDN_HEADS)),
        'gdn_dt_bias': _dt_bias(next(ks), (L, 2, GDN_HEADS)),
        'gdn_norm': gain((L, GDN_DV)),
        'ssm_conv_w': nrm((L, SHORT_CONV, SSM_XBC), SHORT_CONV ** -0.5),
        'ssm_conv_b': nrm((L, SSM_XBC), 0.02),
        'ssm_a_log': a_log((L, 2, SSM_HEADS)),
        'ssm_dt_bias': _dt_bias(next(ks), (L, 2, SSM_HEADS)),
        'ssm_d': 1.0 + nrm((L, SSM_HEADS), 0.1),
        'ssm_norm': gain((L, SSM_INNER)),
        'attn_sink': nrm((L, ATT_Q_HEADS), 0.5),
        'w_branch_a': nrm((L, GDN_HEADS * GDN_DV, D), (GDN_HEADS * GDN_DV) ** -0.5),
        'w_branch_b': nrm((L, SSM_INNER, D), SSM_INNER ** -0.5),
        'w_branch_c': nrm((L, ATT_Q_HEADS * HEAD_DIM, D), (ATT_Q_HEADS * HEAD_DIM) ** -0.5),
        'w_out': nrm((L, D, D), D ** -0.5),
        'g_post1': gain((L, D)),
        'g_pre2': gain((L, D)),
        'w_up': nrm((L, D, 2 * D_FF), D ** -0.5),
        'ffn_conv_w': nrm((L, FFN_CONV, D_FF), FFN_CONV ** -0.5),
        'ffn_conv_b': nrm((L, D_FF), 0.02),
        'w_down': nrm((L, D_FF, D), D_FF ** -0.5),
        'g_post2': gain((L, D)),
    }


def reference(x, c, ctx, c_ctx, w_ada, b_ada, g_pre1, w_in, gdn_conv_w, gdn_a_log, gdn_dt_bias,
              gdn_norm, ssm_conv_w, ssm_conv_b, ssm_a_log, ssm_dt_bias, ssm_d, ssm_norm, attn_sink,
              w_branch_a, w_branch_b, w_branch_c, w_out, g_post1, g_pre2, w_up, ffn_conv_w,
              ffn_conv_b, w_down, g_post2):
    bsz, n_lat = x.shape[:2]
    cos, sin = axial_rope_tables(n_lat)
    gdn_s0 = jnp.zeros((bsz, GDN_HEADS, GDN_DK, GDN_DV), F32)
    ssd_s0 = jnp.zeros((bsz, SSM_GROUPS, SSM_HEADS // SSM_GROUPS, SSM_STATE, SSM_HEAD_DIM), F32)
    xc = ctx
    for l in range(DEPTH):
        last = l == DEPTH - 1
        mod = jax.nn.silu(c) @ w_ada[l] + b_ada[l]
        mod_c = jax.nn.silu(c_ctx) @ w_ada[l] + b_ada[l]
        sh1, sc1, gt1, sh2, sc2, gt2 = jnp.split(mod[:, None, :], 6, axis=-1)
        sh1c, sc1c, gt1c, sh2c, sc2c, gt2c = jnp.split(mod_c, 6, axis=-1)

        h = modulate(rmsnorm(x, g_pre1[l]), sh1, sc1)
        hc = modulate(rmsnorm(xc, g_pre1[l]), sh1c, sc1c)
        (qkv, gate_a, a_in, b_in, z, xbc, dt_in, q_in, kv_in, mg_in) = split_in(h @ w_in[l])
        (qkv_c, gate_a_c, a_in_c, b_in_c, z_c, xbc_c, dt_in_c, q_in_c, kv_in_c, mg_in_c) = split_in(hc @ w_in[l])

        gq, gk, gv, gg, gb = gdn_inputs(qkv, a_in, b_in, gdn_conv_w[l], gdn_a_log[l], gdn_dt_bias[l])
        cq, ck, cv, cg, cb = gdn_inputs(qkv_c, a_in_c, b_in_c, gdn_conv_w[l], gdn_a_log[l], gdn_dt_bias[l])
        oa, oa_c = bidirectional_scan(
            gdn_chunked,
            (gq, gk, gv, gg[:, :, 0], gb[:, :, 0]), (gq, gk, gv, gg[:, :, 1], gb[:, :, 1]),
            (cq, ck, cv, cg[:, :, 0], cb[:, :, 0]), (cq, ck, cv, cg[:, :, 1], cb[:, :, 1]),
            gdn_s0)
        ya = gdn_output(oa, gate_a, gdn_norm[l])

        sx, sdt, sa, sbm, scm = ssd_inputs(xbc, dt_in, ssm_conv_w[l], ssm_conv_b[l], ssm_a_log[l], ssm_dt_bias[l])
        tx, tdt, ta, tbm, tcm = ssd_inputs(xbc_c, dt_in_c, ssm_conv_w[l], ssm_conv_b[l], ssm_a_log[l], ssm_dt_bias[l])
        ob, ob_c = bidirectional_scan(
            ssd_chunked,
            (sx, sdt[:, :, 0], sa[:, :, 0], sbm, scm), (sx, sdt[:, :, 1], sa[:, :, 1], sbm, scm),
            (tx, tdt[:, :, 0], ta[:, :, 0], tbm, tcm), (tx, tdt[:, :, 1], ta[:, :, 1], tbm, tcm),
            ssd_s0)
        yb = ssd_output(ob, sx, ssm_d[l], z, ssm_norm[l])

        aq, ak, av = attn_heads(q_in, kv_in)
        aq_c, ak_c, av_c = attn_heads(q_in_c, kv_in_c)
        yc = band_attention(apply_axial_rope(aq, cos, sin), apply_axial_rope(ak, cos, sin), av,
                            ak_c, av_c, attn_sink[l])

        mix = merge_branches(ya, yb, yc, mg_in, w_branch_a[l], w_branch_b[l], w_branch_c[l], w_out[l])
        x = x + gt1 * rmsnorm(mix, g_post1[l])
        ff = conv_ffn(modulate(rmsnorm(x, g_pre2[l]), sh2, sc2), w_up[l], ffn_conv_w[l], ffn_conv_b[l], w_down[l])
        x = x + gt2 * rmsnorm(ff, g_post2[l])

        if not last:
            ya_c = gdn_output(oa_c, gate_a_c, gdn_norm[l])
            yb_c = ssd_output(ob_c, tx, ssm_d[l], z_c, ssm_norm[l])
            yc_c = context_attention(aq_c, ak_c, av_c, attn_sink[l])
            mix_c = merge_branches(ya_c, yb_c, yc_c, mg_in_c, w_branch_a[l], w_branch_b[l], w_branch_c[l], w_out[l])
            xc = xc + gt1c * rmsnorm(mix_c, g_post1[l])
            ff_c = conv_ffn(modulate(rmsnorm(xc, g_pre2[l]), sh2c, sc2c), w_up[l], ffn_conv_w[l], ffn_conv_b[l], w_down[l])
            xc = xc + gt2c * rmsnorm(ff_c, g_post2[l])
    return x
```

```cpp
#include <hip/hip_runtime.h>
#include <cstdio>
#include <cstdint>
#include <type_traits>
#define MK_LAUNCH_MODE 1
#define FILL_NA 10
#define FILL_NB 14
#define FILL_NC 4
#define FILL_NM 256
#include <cstdint>
#include <cstddef>
#include <cmath>
#ifdef HOST_TEST
#define HD inline
#define CFENCE() do {} while (0)
#else
#define HD __host__ __device__ __forceinline__
#if defined(__HIP_DEVICE_COMPILE__)
#define CFENCE() asm volatile("" ::: "memory")
#else
#define CFENCE() do {} while (0)
#endif
#endif

#ifndef CFG_SMALL
constexpr int D_MODEL = 2048, BATCH = 2, SEQ = 4096, DEPTH = 4, CTX_LEN = 256, D_FF = 5632;
#else
constexpr int D_MODEL = 1024, BATCH = 2, SEQ = 512, DEPTH = 2, CTX_LEN = 128, D_FF = 512;
#endif
constexpr int GRID_W = 64, WINDOW = 128;
constexpr float EPS = 1e-6f;
constexpr int MIX_W = D_MODEL / 2, GDN_H = MIX_W / 128, SSM_H = MIX_W / 64, SSM_G = 2, SSM_N = 128, SSM_P = 64, SSM_HPG = SSM_H / SSM_G;
constexpr int ATT_HQ = MIX_W / 128, ATT_HKV = 2, ATT_GRP = ATT_HQ / ATT_HKV;
constexpr int SSM_BC = SSM_G * SSM_N, SSM_XBC = MIX_W + 2 * SSM_BC;
constexpr int NLAT = BATCH * SEQ, NCTX = BATCH * CTX_LEN, MROWS = NLAT + NCTX;
constexpr int CHAIN_LEN = CTX_LEN + SEQ;
constexpr int R_QKV = 0, R_GATE = 3 * MIX_W, R_A = 4 * MIX_W, R_B = R_A + 2 * GDN_H, R_Z = R_B + 2 * GDN_H, R_XBC = R_Z + MIX_W, R_DT = R_XBC + SSM_XBC,
              R_AQ = R_DT + 2 * SSM_H, R_AKV = R_AQ + MIX_W, R_MG = R_AKV + 2 * ATT_HKV * 128, P_IN = R_MG + 3 * D_MODEL;
constexpr int C_QKV = 0, C_GATE = 3 * MIX_W, C_Z = 4 * MIX_W, C_XBC = 5 * MIX_W, C_AQ = C_XBC + SSM_XBC, C_AKV = C_AQ + MIX_W, C_MG = C_AKV + 512, NP_MAIN = C_MG + 3 * D_MODEL;
constexpr int PF_A = 0, PF_B = 2 * GDN_H, PF_DT = 4 * GDN_H, PF_N = 4 * GDN_H + 2 * SSM_H;
constexpr int NP_PAD = NP_MAIN + 256;
static_assert(NP_MAIN % 256 == 0 && PF_N <= 256 && MROWS % 256 == 0 && (2 * D_FF) % 256 == 0 && D_FF % 256 == 0, "tile shapes");
static_assert(P_IN == NP_MAIN + PF_N, "column bookkeeping");
constexpr int D6 = 6 * D_MODEL;

typedef unsigned short bf16;
HD float bf2f(bf16 b) { union { unsigned u; float f; } c; c.u = ((unsigned)b) << 16; return c.f; }
HD bf16 f2bf(float f) { union { unsigned u; float f; } c; c.f = f; unsigned u = c.u; u += 0x7FFFu + ((u >> 16) & 1u); return (bf16)(u >> 16); }
HD float silu_f(float x) { return x / (1.0f + expf(-x)); }
HD float sigmoid_f(float x) { return 1.0f / (1.0f + expf(-x)); }
#if defined(__HIP_DEVICE_COMPILE__)
HD float softplus_f(float x) { return x > 20.0f ? x : __logf(1.0f + __expf(x)); }
#else
HD float softplus_f(float x) { return x > 20.0f ? x : log1pf(expf(x)); }
#endif

struct Ptrs {
    const float *x, *c, *ctx, *c_ctx, *w_ada, *b_ada, *g_pre1, *w_in, *gdn_conv_w, *gdn_a_log, *gdn_dt_bias, *gdn_norm, *ssm_conv_w, *ssm_conv_b, *ssm_a_log,
        *ssm_dt_bias, *ssm_d, *ssm_norm, *attn_sink, *w_br_a, *w_br_b, *w_br_c, *w_out, *g_post1, *g_pre2, *w_up, *ffn_conv_w, *ffn_conv_b, *w_down, *g_post2;
    float* out;
    bf16 *Wt_in, *Wt_br, *Wt_out, *Wt_up, *Wt_down;
    float* ROPE;
    float* MOD;
    float* X;
    bf16* H;
    bf16* P;
    float* PF;
    float *GQKV, *GG, *GB;
    float *SXBC, *SDT, *SA;
    float *AQ, *AK;
    bf16 *GW, *GQd, *GKdT, *GA, *GUT; float* GGL;
    bf16 *SBCb, *SSC, *SEAb, *SCF; float *SEA, *SDC;
    bf16 *MIXb, *OGb, *OSb, *OSb2, *GQKVb, *SXb;
    bf16 *AQb, *AKb;
    float *OG, *OS;
    float* SC;
    bf16 *YA, *YB, *YC;
    float* M32;
    bf16* MB;
    float* MIX;
    bf16* UG;
    bf16* ACT;
    bf16* TB;
    float* SLAB;
    float* BP; bf16 *BU, *BG;
};
constexpr int SC_LD = 2 * WINDOW + 1 + CTX_LEN + 3;

HD void row_info(int r, int& b, int& t, int& len, bool& is_ctx) {
    if (r < NLAT) { b = r / SEQ; t = r % SEQ; len = SEQ; is_ctx = false; } else { const int q = r - NLAT; b = q / CTX_LEN; t = q % CTX_LEN; len = CTX_LEN; is_ctx = true; }
}
HD int mod_row(int r) { return r < NLAT ? r / SEQ : BATCH; }

HD int inproj_src_col(int np) {
    if (np < C_Z) return np;
    if (np < NP_MAIN) return np + 4 * GDN_H + (np >= C_AQ ? 2 * SSM_H : 0);
    const int j = np - NP_MAIN;
    if (j < PF_DT) return R_A + j;
    if (j < PF_N) return R_DT + (j - PF_DT);
    return -1;
}
HD void wcvt_item(const float* W, int K, int N, bf16* Wt, int np, int k8, bool inproj) {
    const int n = inproj ? inproj_src_col(np) : np;
    for (int j = 0; j < 8; ++j) { const int k = k8 * 8 + j; Wt[(size_t)np * K + k] = (n < 0) ? (bf16)0 : f2bf(W[(size_t)k * N + n]); }
}

HD void mod_item(const Ptrs& p, int l, int n) {
    float acc[BATCH + 1];
    for (int m = 0; m <= BATCH; ++m) acc[m] = 0.f;
    for (int k = 0; k < D_MODEL; ++k) {
        const float w = p.w_ada[((size_t)l * D_MODEL + k) * D6 + n];
        for (int m = 0; m < BATCH; ++m) acc[m] += silu_f(p.c[m * D_MODEL + k]) * w;
        acc[BATCH] += silu_f(p.c_ctx[k]) * w;
    }
    for (int m = 0; m <= BATCH; ++m) p.MOD[((size_t)l * (BATCH + 1) + m) * D6 + n] = acc[m] + p.b_ada[(size_t)l * D6 + n];
}
HD void xinit_item(const Ptrs& p, size_t i) { p.X[i] = i < (size_t)NLAT * D_MODEL ? p.x[i] : p.ctx[i - (size_t)NLAT * D_MODEL]; }

HD float row_rstd(const float* v, int n) { float s = 0.f; for (int j = 0; j < n; ++j) s += v[j] * v[j]; return 1.0f / sqrtf(s / (float)n + EPS); }
HD void norm_to_h_row(const Ptrs& p, int l, int r, int which) {
    const float* xr = p.X + (size_t)r * D_MODEL; const float* g = (which ? p.g_pre2 : p.g_pre1) + (size_t)l * D_MODEL;
    const float* mod = p.MOD + ((size_t)l * (BATCH + 1) + mod_row(r)) * D6 + (which ? 3 * D_MODEL : 0);
    const float rs = row_rstd(xr, D_MODEL);
    for (int j = 0; j < D_MODEL; ++j) p.H[(size_t)r * D_MODEL + j] = f2bf(xr[j] * rs * g[j] * (1.0f + mod[D_MODEL + j]) + mod[j]);
}
HD void resid_row(const Ptrs& p, int l, int r, int which, bool to_out) {
    const float* yr = p.MIX + (size_t)r * D_MODEL; const float* g = (which ? p.g_post2 : p.g_post1) + (size_t)l * D_MODEL;
    const float* gate = p.MOD + ((size_t)l * (BATCH + 1) + mod_row(r)) * D6 + (which ? 5 * D_MODEL : 2 * D_MODEL);
    const float rs = row_rstd(yr, D_MODEL);
    float* xr = p.X + (size_t)r * D_MODEL;
    for (int j = 0; j < D_MODEL; ++j) { const float v = xr[j] + gate[j] * (yr[j] * rs * g[j]); xr[j] = v; if (to_out && r < NLAT) p.out[(size_t)r * D_MODEL + j] = v; }
}

HD float conv3_p(const Ptrs& p, int r, int col, const float* w, int wld, int j) {
    int b, t, len; bool ic; row_info(r, b, t, len, ic);
    float y = w[wld + j] * bf2f(p.P[(size_t)r * NP_MAIN + col]);
    if (t > 0) y += w[j] * bf2f(p.P[(size_t)(r - 1) * NP_MAIN + col]);
    if (t < len - 1) y += w[2 * wld + j] * bf2f(p.P[(size_t)(r + 1) * NP_MAIN + col]);
    return y;
}
HD void prep_gdn_item(const Ptrs& p, int l, int r, int grp) {
    const float* w = p.gdn_conv_w + (size_t)l * 3 * (3 * MIX_W);
    float sc = 1.0f;
    if (grp < 2 * GDN_H) {
        float ss = 0.f;
        for (int d = 0; d < 128; ++d) { const int j = grp * 128 + d; const float v = silu_f(conv3_p(p, r, C_QKV + j, w, 3 * MIX_W, j)); ss += v * v; }
        sc = 1.0f / sqrtf(ss + EPS); if (grp < GDN_H) sc *= 0.08838834764831845f;
    }
    for (int d = 0; d < 128; ++d) { const int j = grp * 128 + d; p.GQKV[(size_t)r * (3 * MIX_W) + j] = silu_f(conv3_p(p, r, C_QKV + j, w, 3 * MIX_W, j)) * sc; }
}
HD void prep_gdn_gb_item(const Ptrs& p, int l, int r, int j) {
    const float a = p.PF[(size_t)r * PF_N + PF_A + j], bb = p.PF[(size_t)r * PF_N + PF_B + j];
    p.GG[(size_t)r * 2 * GDN_H + j] = -expf(p.gdn_a_log[(size_t)l * 2 * GDN_H + j]) * softplus_f(a + p.gdn_dt_bias[(size_t)l * 2 * GDN_H + j]);
    p.GB[(size_t)r * 2 * GDN_H + j] = sigmoid_f(bb);
}
HD void prep_ssd_item(const Ptrs& p, int l, int r, int j) {
    const float* w = p.ssm_conv_w + (size_t)l * 3 * SSM_XBC;
    p.SXBC[(size_t)r * SSM_XBC + j] = silu_f(conv3_p(p, r, C_XBC + j, w, SSM_XBC, j) + p.ssm_conv_b[(size_t)l * SSM_XBC + j]);
}
HD void prep_ssd_dt_item(const Ptrs& p, int l, int r, int j) {
    const float dt = softplus_f(p.PF[(size_t)r * PF_N + PF_DT + j] + p.ssm_dt_bias[(size_t)l * 2 * SSM_H + j]);
    p.SDT[(size_t)r * 2 * SSM_H + j] = dt; p.SA[(size_t)r * 2 * SSM_H + j] = -expf(p.ssm_a_log[(size_t)l * 2 * SSM_H + j]) * dt;
}
HD float rope_inv_freq(int i) { return exp2f(-(float)i * 0.4152410118609203f); }
HD void prep_attn_item(const Ptrs& p, int r, int hh) {
    int b, t, len; bool ic; row_info(r, b, t, len, ic);
    const bool isq = hh < ATT_HQ; const int h = isq ? hh : hh - ATT_HQ;
    const bf16* src = p.P + (size_t)r * NP_MAIN + (isq ? C_AQ + h * 128 : C_AKV + h * 128);
    float* dst = isq ? p.AQ + (size_t)r * MIX_W + h * 128 : p.AK + (size_t)r * (ATT_HKV * 128) + h * 128;
    if (ic) { for (int d = 0; d < 128; ++d) dst[d] = bf2f(src[d]); return; }
    const float pos[2] = {(float)(t / GRID_W), (float)(t % GRID_W)};
    for (int ax = 0; ax < 2; ++ax)
        for (int i = 0; i < 32; ++i) {
            const float ang = pos[ax] * rope_inv_freq(i), cs = cosf(ang), sn = sinf(ang);
            const float x1 = bf2f(src[ax * 64 + i]), x2 = bf2f(src[ax * 64 + 32 + i]);
            dst[ax * 64 + i] = x1 * cs - x2 * sn; dst[ax * 64 + 32 + i] = x2 * cs + x1 * sn;
        }
}

HD int chain_row(int b, int dir, int s) {
    if (s < CTX_LEN) return NLAT + b * CTX_LEN + (dir ? CTX_LEN - 1 - s : s);
    const int u = s - CTX_LEN; return b * SEQ + (dir ? SEQ - 1 - u : u);
}
HD void gdn_chain_item(const Ptrs& p, int b, int h, int dir, int vc) {
    float S[128];
#pragma unroll
    for (int k = 0; k < 128; ++k) S[k] = 0.f;
    float pf = 0.f;
    for (int s = 0; s < CHAIN_LEN; ++s) {
        const int r = chain_row(b, dir, s);
        const float* q = p.GQKV + (size_t)r * (3 * MIX_W) + h * 128; const float* kk = q + MIX_W; const float vv = q[2 * MIX_W + vc];
        const float a = expf(p.GG[(size_t)r * 2 * GDN_H + dir * GDN_H + h]), be = p.GB[(size_t)r * 2 * GDN_H + dir * GDN_H + h];
        if (s + 1 < CHAIN_LEN) { const float* qn = p.GQKV + (size_t)chain_row(b, dir, s + 1) * (3 * MIX_W) + h * 128;
#pragma unroll
            for (int j = 0; j < 4; ++j) pf += qn[32 * j] + qn[MIX_W + 32 * j]; }
        float ks = 0.f;
#pragma unroll
        for (int c = 0; c < 2; ++c) { float kc[64];
#pragma unroll
            for (int j = 0; j < 64; ++j) kc[j] = kk[64 * c + j];
#pragma unroll
            for (int j = 0; j < 64; ++j) { S[64 * c + j] *= a; ks += kc[j] * S[64 * c + j]; }
            CFENCE(); }
        const float dl = be * (vv - ks); float o = 0.f;
#pragma unroll
        for (int c = 0; c < 4; ++c) { float kc[32], qc[32];
#pragma unroll
            for (int j = 0; j < 32; ++j) { kc[j] = kk[32 * c + j]; qc[j] = q[32 * c + j]; }
#pragma unroll
            for (int j = 0; j < 32; ++j) { S[32 * c + j] += kc[j] * dl; o += qc[j] * S[32 * c + j]; }
            CFENCE(); }
        p.OG[((size_t)dir * MROWS + r) * MIX_W + h * 128 + vc] = o;
    }
    if (pf == 123456.789f) p.OG[0] = pf;
}
HD void ssd_chain_item(const Ptrs& p, int b, int hd, int dir, int pc) {
    float hs[SSM_N];
#pragma unroll
    for (int s = 0; s < SSM_N; ++s) hs[s] = 0.f;
    const int g = hd / SSM_HPG;
    float pf = 0.f;
    for (int s = 0; s < CHAIN_LEN; ++s) {
        const int r = chain_row(b, dir, s);
        const float* xb = p.SXBC + (size_t)r * SSM_XBC; const float* Bm = xb + MIX_W + g * SSM_N; const float* Cm = xb + MIX_W + SSM_BC + g * SSM_N;
        const float dt = p.SDT[(size_t)r * 2 * SSM_H + dir * SSM_H + hd], ea = expf(p.SA[(size_t)r * 2 * SSM_H + dir * SSM_H + hd]);
        const float xd = xb[hd * SSM_P + pc] * dt; float y = 0.f;
        if (s + 1 < CHAIN_LEN) { const float* xn = p.SXBC + (size_t)chain_row(b, dir, s + 1) * SSM_XBC + MIX_W + g * SSM_N;
#pragma unroll
            for (int j = 0; j < 4; ++j) pf += xn[32 * j] + xn[SSM_BC + 32 * j]; }
#pragma unroll
        for (int c = 0; c < 4; ++c) { float bc[32], cc[32];
#pragma unroll
            for (int j = 0; j < 32; ++j) { bc[j] = Bm[32 * c + j]; cc[j] = Cm[32 * c + j]; }
#pragma unroll
            for (int j = 0; j < 32; ++j) { hs[32 * c + j] = ea * hs[32 * c + j] + xd * bc[j]; y += cc[j] * hs[32 * c + j]; }
            CFENCE(); }
        p.OS[((size_t)dir * MROWS + r) * MIX_W + hd * SSM_P + pc] = y;
    }
    if (pf == 123456.789f) p.OS[0] = pf;
}
HD void attn_item(const Ptrs& p, int l, int r, int hq) {
    int b, t, len; bool ic; row_info(r, b, t, len, ic);
    const int hkv = hq / ATT_GRP;
    const float* qp = p.AQ + (size_t)r * MIX_W + hq * 128;
    float* sc = p.SC + ((size_t)r * ATT_HQ + hq) * SC_LD;
    const float sink = p.attn_sink[(size_t)l * ATT_HQ + hq];
    const int lo = ic ? 0 : (t - WINDOW < 0 ? 0 : t - WINDOW), hi = ic ? -1 : (t + WINDOW > SEQ - 1 ? SEQ - 1 : t + WINDOW);
    const int nloc = ic ? 0 : hi - lo + 1, nk = nloc + CTX_LEN;
    float m = sink;
    {
        float q[128];
#pragma unroll
        for (int d = 0; d < 128; ++d) q[d] = qp[d];
        for (int j = 0; j < nk; ++j) {
            const int kr = j < nloc ? b * SEQ + lo + j : NLAT + b * CTX_LEN + (j - nloc);
            const float* kk = p.AK + (size_t)kr * (ATT_HKV * 128) + hkv * 128;
            float s = 0.f;
#pragma unroll
            for (int c = 0; c < 4; ++c) { float kc[32];
#pragma unroll
                for (int d = 0; d < 32; ++d) kc[d] = kk[32 * c + d];
#pragma unroll
                for (int d = 0; d < 32; ++d) s += q[32 * c + d] * kc[d];
                CFENCE(); }
            s *= 0.08838834764831845f; sc[j] = s; m = s > m ? s : m;
        }
    }
    float o[128];
#pragma unroll
    for (int d = 0; d < 128; ++d) o[d] = 0.f;
    float den = expf(sink - m);
    for (int j = 0; j < nk; ++j) {
        const int kr = j < nloc ? b * SEQ + lo + j : NLAT + b * CTX_LEN + (j - nloc);
        const bf16* vv = p.P + (size_t)kr * NP_MAIN + C_AKV + ATT_HKV * 128 + hkv * 128;
        const float e = expf(sc[j] - m); den += e;
#pragma unroll
        for (int c = 0; c < 4; ++c) { float vc[32];
#pragma unroll
            for (int d = 0; d < 32; ++d) vc[d] = bf2f(vv[32 * c + d]);
#pragma unroll
            for (int d = 0; d < 32; ++d) o[32 * c + d] += e * vc[d];
            CFENCE(); }
    }
    const float inv = 1.0f / den;
#pragma unroll
    for (int d = 0; d < 128; ++d) p.YC[(size_t)r * MIX_W + hq * 128 + d] = f2bf(o[d] * inv);
}
HD void gdn_out_item(const Ptrs& p, int l, int r, int h) {
    float ss = 0.f;
    for (int d = 0; d < 128; ++d) { const size_t i = (size_t)r * MIX_W + h * 128 + d; const float v = p.OG[i] + p.OG[(size_t)MROWS * MIX_W + i]; ss += v * v; }
    const float rs = 1.0f / sqrtf(ss / 128.0f + EPS);
    for (int d = 0; d < 128; ++d) { const size_t i = (size_t)r * MIX_W + h * 128 + d; const float v = p.OG[i] + p.OG[(size_t)MROWS * MIX_W + i];
        p.YA[i] = f2bf(v * rs * p.gdn_norm[(size_t)l * 128 + d] * silu_f(bf2f(p.P[(size_t)r * NP_MAIN + C_GATE + h * 128 + d]))); }
}
HD void ssd_out_item(const Ptrs& p, int l, int r, int g) {
    constexpr int GW = MIX_W / SSM_G;
    float ss = 0.f;
    for (int pass = 0; pass < 2; ++pass) {
        const float rs = pass ? 1.0f / sqrtf(ss / (float)GW + EPS) : 0.f;
        for (int jj = 0; jj < GW; ++jj) { const int j = g * GW + jj; const size_t i = (size_t)r * MIX_W + j;
            float y = p.OS[i] + p.OS[(size_t)MROWS * MIX_W + i] + p.ssm_d[(size_t)l * SSM_H + j / SSM_P] * p.SXBC[(size_t)r * SSM_XBC + j];
            y *= silu_f(bf2f(p.P[(size_t)r * NP_MAIN + C_Z + j]));
            if (!pass) ss += y * y; else p.YB[i] = f2bf(y * rs * p.ssm_norm[(size_t)l * MIX_W + j]); }
    }
}
HD void act_item(const Ptrs& p, int l, int r, int j) {
    int b, t, len; bool ic; row_info(r, b, t, len, ic);
    const float* w = p.ffn_conv_w + (size_t)l * 3 * D_FF;
    const bf16* ug = p.UG + (size_t)r * (2 * D_FF);
    float g = w[D_FF + j] * bf2f(ug[D_FF + j]);
    if (t > 0) g += w[j] * bf2f(ug[D_FF + j - 2 * D_FF]);
    if (t < len - 1) g += w[2 * D_FF + j] * bf2f(ug[D_FF + j + 2 * D_FF]);
    g += p.ffn_conv_b[(size_t)l * D_FF + j];
    p.ACT[(size_t)r * D_FF + j] = f2bf(silu_f(g) * bf2f(ug[j]));
}

namespace pg8 {
#define PG8_LAS __attribute__((address_space(3)))
typedef unsigned short bf16_t;
typedef short bf16x8 __attribute__((ext_vector_type(8)));
typedef float f32x4 __attribute__((ext_vector_type(4)));
typedef unsigned u32x4 __attribute__((ext_vector_type(4)));
constexpr int BM = 256, BK = 64, HALF = 128, HTB = HALF * BK * 2  , STAGE_BYTES = 8 * HTB, NXCD = 8, WGM = 8;

__host__ __device__ __forceinline__ int lds_byte(int r, int c) { const int st = (r >> 4) * 2 + (c >> 5), rr = r & 15, cc = c & 31, ob = rr * 64 + cc * 2; return st * 1024 + (ob ^ (((ob >> 9) & 1) << 5)); }
__host__ __device__ __forceinline__ void stage_rc(int b, int& R, int& C) { const int st = b / 1024, sb = b % 1024, swz = sb ^ (((sb >> 9) & 1) << 5); R = (st >> 1) * 16 + swz / 64; C = (st & 1) * 32 + (swz % 64) / 2; }
__host__ __device__ __forceinline__ int perm32(int rho) { const int n = rho >> 4, i = rho & 15; return 8 * (i >> 2) + 4 * n + (i & 3); }

struct Unit { int pm, pn, pk; };
struct Gemm { const bf16_t* A; const bf16_t* Bt; int M, N, K, ld; };

struct StaticOrder {
    int nM, nN, nwg, G, c;
    __host__ __device__ void init(int M, int N, int G_, int c_) { nM = M / BM; nN = N / BM; nwg = nM * nN; G = G_; c = c_; }
    __host__ __device__ bool next(int i, Unit& u) const {
        const long L = (long)i * G + c; if (L >= nwg) return false;
        int wgid = (int)L; { const int q = nwg / NXCD, r = nwg % NXCD, xcd = wgid % NXCD, off = wgid / NXCD; wgid = (xcd < r ? xcd * (q + 1) : r * (q + 1) + (xcd - r) * q) + off; }
        const int nig = WGM * nN, gid = wgid / nig, fm = gid * WGM, gsz = (nM - fm) < WGM ? (nM - fm) : WGM;
        u.pm = fm + ((wgid % nig) % gsz); u.pn = (wgid % nig) / gsz; u.pk = 0; return true;
    }
    __device__ __forceinline__ void a_ready(const Unit&) const {}
    __device__ __forceinline__ void done(const Unit&) const {}
};

__device__ __forceinline__ unsigned cvt_pk_bf16(float lo, float hi) { unsigned r; asm volatile("v_cvt_pk_bf16_f32 %0, %1, %2" : "=v"(r) : "v"(lo), "v"(hi)); return r; }

template <class Epi, class Sched, bool ALIGN_EPI = false, bool SP2 = false>
__device__ __forceinline__ void gemm_phase(PG8_LAS unsigned char* lds, const Gemm g, const Sched& S, const Epi& E, int tid_in) {
    int tid_l = tid_in; asm volatile("" : "+v"(tid_l));
    const int tid = tid_l, wid = __builtin_amdgcn_readfirstlane(tid >> 6), lane = tid & 63, wr = wid >> 2, wc = wid & 3, fr = lane & 15, fq = lane >> 4;
    const int K = g.K, nt = K / BK, LD = g.ld;
    unsigned voffA[2], voffB[2];
#pragma unroll
    for (int i = 0; i < 2; ++i) { int R, C; stage_rc(tid * 16 + i * 8192, R, C); const int Rb = Epi::PERM ? ((R & ~31) + perm32(R & 31)) : R;
        voffA[i] = (unsigned)(R * LD + C) * 2u; voffB[i] = (unsigned)(Rb * LD + C) * 2u; }
    const size_t kstep = (size_t)(BK * 2);
    const size_t hstep = (size_t)HALF * LD * 2;
    const size_t tstep = 2 * hstep;
    const unsigned ldsw = (unsigned)wid * 1024u;
    const int aoff = lds_byte(wr * 64 + fr, fq * 8), boff = lds_byte(wc * 32 + fr, fq * 8);
#define PG8_SA(b, h) (((b) * 2 + (h)) * HTB)
#define PG8_SB(b, h) ((4 + (b) * 2 + (h)) * HTB)
#define PG8_STAGE(bufoff, gbase, voff) do { _Pragma("unroll") for (int _i = 0; _i < 2; ++_i) \
        __builtin_amdgcn_global_load_lds((const unsigned*)((const char*)(gbase) + (voff)[_i]), (PG8_LAS unsigned*)(lds + (bufoff) + ldsw + _i * 8192), 16, 0, 0); } while (0)
#define PG8_LDA(dst, b, h) do { _Pragma("unroll") for (int m = 0; m < 4; ++m) _Pragma("unroll") for (int k = 0; k < 2; ++k) dst[m][k] = *(const PG8_LAS bf16x8*)(lds + PG8_SA(b, h) + aoff + m * 2048 + k * 1024); } while (0)
#define PG8_LDB(dst, b, h) do { _Pragma("unroll") for (int n = 0; n < 2; ++n) _Pragma("unroll") for (int k = 0; k < 2; ++k) dst[n][k] = *(const PG8_LAS bf16x8*)(lds + PG8_SB(b, h) + boff + n * 2048 + k * 1024); } while (0)
#define PG8_MMA(ai, bj, At, Bt) do { __builtin_amdgcn_s_setprio(1); _Pragma("unroll") for (int m = 0; m < 4; ++m) _Pragma("unroll") for (int n = 0; n < 2; ++n) _Pragma("unroll") for (int k = 0; k < 2; ++k) \
        acc[ai][bj][m][n] = __builtin_amdgcn_mfma_f32_16x16x32_bf16(Bt[n][k], At[m][k], acc[ai][bj][m][n], 0, 0, 0); __builtin_amdgcn_s_setprio(0); } while (0)
#define PG8_WAIT_V(n) asm volatile("s_waitcnt vmcnt(" #n ")" ::: "memory")
#define PG8_WAIT_L(n) asm volatile("s_waitcnt lgkmcnt(" #n ")" ::: "memory")
#define PG8_BAR __builtin_amdgcn_s_barrier()
#define PG8_SCHED __builtin_amdgcn_sched_barrier(0)
    Unit cur, nxt; int ui = 0;
    if (!S.next(0, cur)) return;
    f32x4 acc[2][2][4][2];
#pragma unroll
    for (int a = 0; a < 2; ++a)
#pragma unroll
        for (int b = 0; b < 2; ++b)
#pragma unroll
            for (int m = 0; m < 4; ++m)
#pragma unroll
                for (int n = 0; n < 2; ++n) acc[a][b][m][n] = (f32x4){0.f, 0.f, 0.f, 0.f};
    bf16x8 At[4][2], B0[2][2], B1[2][2];
    const char* cA = (const char*)g.A + (size_t)cur.pm * tstep + (size_t)cur.pk * 2; const char* cB = (const char*)g.Bt + (size_t)cur.pn * tstep + (size_t)cur.pk * 2;
    S.a_ready(cur);
    if constexpr (SP2) {
        PG8_STAGE(PG8_SB(0, 0), cB, voffB); PG8_STAGE(PG8_SB(0, 1), cB + hstep, voffB); PG8_STAGE(PG8_SA(0, 0), cA, voffA); PG8_STAGE(PG8_SA(0, 1), cA + hstep, voffA);
        if (wr == 1) PG8_BAR;
        PG8_WAIT_V(2); PG8_BAR;
        PG8_STAGE(PG8_SB(1, 0), cB + kstep, voffB); PG8_STAGE(PG8_SA(1, 0), cA + kstep, voffA); PG8_STAGE(PG8_SB(1, 1), cB + hstep + kstep, voffB);
        PG8_WAIT_V(6); PG8_BAR;
    } else {
        PG8_STAGE(PG8_SB(0, 0), cB, voffB); PG8_STAGE(PG8_SA(0, 0), cA, voffA); PG8_STAGE(PG8_SB(0, 1), cB + hstep, voffB); PG8_STAGE(PG8_SA(0, 1), cA + hstep, voffA);
        if (wr == 1) PG8_BAR;
        PG8_WAIT_V(4); PG8_BAR;
        PG8_STAGE(PG8_SB(1, 0), cB + kstep, voffB); PG8_STAGE(PG8_SA(1, 0), cA + kstep, voffA); PG8_STAGE(PG8_SB(1, 1), cB + hstep + kstep, voffB);
        PG8_WAIT_V(6); PG8_BAR;
    }
    for (;;) {
        const bool has_next = S.next(ui + 1, nxt);
        const char* nA = has_next ? (const char*)g.A + (size_t)nxt.pm * tstep + (size_t)nxt.pk * 2 : cA; const char* nB = has_next ? (const char*)g.Bt + (size_t)nxt.pn * tstep + (size_t)nxt.pk * 2 : cB;
        for (int t = 0; t < nt; t += 2) {
            const bool last = (t == nt - 2);
            const char* a1 = cA + (size_t)(t + 1) * kstep;
            const char* a2 = last ? nA : cA + (size_t)(t + 2) * kstep; const char* b2 = last ? nB : cB + (size_t)(t + 2) * kstep;
            const char* a3 = a2 + kstep; const char* b3 = b2 + kstep;
            if (last && has_next) S.a_ready(nxt);
            if constexpr (Epi::KHOOK) E.khook(acc, cur, t, wr, wc, fr, fq);
            if constexpr (SP2) {
            PG8_LDB(B0, 0, 0); PG8_LDB(B1, 0, 1); PG8_SCHED; PG8_LDA(At, 0, 0); PG8_STAGE(PG8_SA(1, 1), a1 + hstep, voffA);
            PG8_WAIT_V(8); PG8_WAIT_L(0); PG8_BAR; PG8_MMA(0, 0, At, B0); PG8_MMA(0, 1, At, B1); PG8_BAR; PG8_SCHED;
            PG8_LDA(At, 0, 1); PG8_STAGE(PG8_SB(0, 0), b2, voffB); PG8_STAGE(PG8_SB(0, 1), b2 + hstep, voffB); PG8_STAGE(PG8_SA(0, 0), a2, voffA);
            PG8_WAIT_V(8); PG8_WAIT_L(0); PG8_BAR; PG8_MMA(1, 0, At, B0); PG8_MMA(1, 1, At, B1); PG8_BAR; PG8_SCHED;
            PG8_LDB(B0, 1, 0); PG8_LDB(B1, 1, 1); PG8_SCHED; PG8_LDA(At, 1, 0); PG8_STAGE(PG8_SA(0, 1), a2 + hstep, voffA);
            PG8_WAIT_V(8); PG8_WAIT_L(0); PG8_BAR; PG8_MMA(0, 0, At, B0); PG8_MMA(0, 1, At, B1); PG8_BAR; PG8_SCHED;
            PG8_LDA(At, 1, 1); PG8_STAGE(PG8_SB(1, 0), b3, voffB); PG8_STAGE(PG8_SB(1, 1), b3 + hstep, voffB); PG8_STAGE(PG8_SA(1, 0), a3, voffA);
            PG8_WAIT_V(8); PG8_WAIT_L(0); PG8_BAR; PG8_MMA(1, 0, At, B0); PG8_MMA(1, 1, At, B1); PG8_BAR; PG8_SCHED;
            } else {
            PG8_LDB(B0, 0, 0); PG8_SCHED; PG8_LDA(At, 0, 0); PG8_STAGE(PG8_SA(1, 1), a1 + hstep, voffA);
            PG8_WAIT_L(8); PG8_BAR; PG8_WAIT_L(0); PG8_MMA(0, 0, At, B0); PG8_BAR; PG8_SCHED;
            PG8_LDB(B1, 0, 1); PG8_STAGE(PG8_SB(0, 0), b2, voffB);
            PG8_BAR; PG8_WAIT_L(0); PG8_MMA(0, 1, At, B1); PG8_BAR;
            PG8_LDA(At, 0, 1); PG8_STAGE(PG8_SA(0, 0), a2, voffA);
            PG8_BAR; PG8_WAIT_L(0); PG8_MMA(1, 0, At, B0); PG8_BAR; PG8_SCHED;
            PG8_STAGE(PG8_SB(0, 1), b2 + hstep, voffB);
            PG8_WAIT_V(6); PG8_BAR; PG8_MMA(1, 1, At, B1); PG8_BAR;
            PG8_LDB(B0, 1, 0); PG8_SCHED; PG8_LDA(At, 1, 0); PG8_STAGE(PG8_SA(0, 1), a2 + hstep, voffA);
            PG8_WAIT_L(8); PG8_BAR; PG8_WAIT_L(0); PG8_MMA(0, 0, At, B0); PG8_BAR; PG8_SCHED;
            PG8_LDB(B1, 1, 1); PG8_STAGE(PG8_SB(1, 0), b3, voffB);
            PG8_BAR; PG8_WAIT_L(0); PG8_MMA(0, 1, At, B1); PG8_BAR;
            PG8_LDA(At, 1, 1); PG8_STAGE(PG8_SA(1, 0), a3, voffA);
            PG8_BAR; PG8_WAIT_L(0); PG8_MMA(1, 0, At, B0); PG8_BAR; PG8_SCHED;
            PG8_STAGE(PG8_SB(1, 1), b3 + hstep, voffB);
            PG8_WAIT_V(6); PG8_BAR; PG8_MMA(1, 1, At, B1); PG8_BAR;
            }
        }
        if constexpr (ALIGN_EPI) { if (wr == 0) PG8_BAR; }
        if constexpr (!Epi::AFTER_DRAIN) { E(acc, cur, wr, wc, fr, fq); S.done(cur); }
        if (!has_next) break;
#pragma unroll
        for (int a = 0; a < 2; ++a)
#pragma unroll
            for (int b = 0; b < 2; ++b)
#pragma unroll
                for (int m = 0; m < 4; ++m)
#pragma unroll
                    for (int n = 0; n < 2; ++n) acc[a][b][m][n] = (f32x4){0.f, 0.f, 0.f, 0.f};
        cur = nxt; cA = nA; cB = nB; ++ui;
        if constexpr (ALIGN_EPI) { if (wr == 1) PG8_BAR; }
    }
    PG8_WAIT_V(0);
    if constexpr (!ALIGN_EPI) { if (wr == 0) PG8_BAR; }
    PG8_BAR;
    if constexpr (Epi::AFTER_DRAIN) { E.fused(acc, cur, wr, wc, fr, fq, lds, wid, lane); S.done(cur); }
#undef PG8_SA
#undef PG8_SB
#undef PG8_STAGE
#undef PG8_LDA
#undef PG8_LDB
#undef PG8_MMA
#undef PG8_WAIT_V
#undef PG8_WAIT_L
#undef PG8_BAR
#undef PG8_SCHED
}
}
#define GAS __attribute__((address_space(1)))
#define LAS __attribute__((address_space(3)))
typedef GAS unsigned gu32;
typedef GAS unsigned long long gu64;
#define RLX_AGENT __ATOMIC_RELAXED, __HIP_MEMORY_SCOPE_AGENT
#define XB_TMO      128
#define XB_XCNT(j)  (256  + 64 * (j))
#define XB_XSUB(j)  (1280 + 64 * (j))
#define XB_XGEN(j)  (2304 + 64 * (j))
#define XB_TOP      3328
#define XB_TOPGEN   3392
#define XCD_BAR_WORDS 3456
#define XB_SPIN_CAP (1u << 18)

__device__ __forceinline__ unsigned xb_ld(unsigned* p)              { return __hip_atomic_load(p, __ATOMIC_RELAXED, __HIP_MEMORY_SCOPE_AGENT); }
__device__ __forceinline__ unsigned xb_add(unsigned* p, unsigned v) { return __hip_atomic_fetch_add(p, v, __ATOMIC_RELAXED, __HIP_MEMORY_SCOPE_AGENT); }
__device__ __forceinline__ unsigned xb_xcc_id() { return (unsigned)__builtin_amdgcn_s_getreg((3 << 11) | 20) & 0xFu; }
#define XB_SPIN(cond, bar) do { unsigned _sp = 0; while (cond) { __builtin_amdgcn_s_sleep(1); \
    if ((++_sp & 255u) == 0u) { if (xb_ld(&(bar)[XB_TMO])) break; if (_sp > XB_SPIN_CAP) { atomicAdd(&(bar)[XB_TMO], 1u); break; } } } } while (0)

struct XcdBarrier {
    unsigned* bar; unsigned x;
    volatile LAS unsigned* st;
};

__device__ __forceinline__ XcdBarrier xcd_barrier_post(unsigned* bar, volatile LAS unsigned* st) {
    XcdBarrier b; b.bar = bar; b.x = xb_xcc_id(); b.st = st;
    if (threadIdx.x == 0) (void)xb_add(&bar[XB_XCNT(b.x)], 1u);
    return b;
}
__device__ __forceinline__ void xcd_barrier_complete(unsigned* bar, unsigned x, unsigned& nloc, unsigned& nx) {
    const unsigned G = gridDim.x * gridDim.y * gridDim.z;
    unsigned sum, cnt, mine, sp = 0u;
    for (;;) {
        sum = 0u; cnt = 0u; mine = 0u;
#pragma unroll
        for (unsigned j = 0; j < 16; ++j) { const unsigned c = xb_ld(&bar[XB_XCNT(j)]); sum += c; cnt += (c > 0u) ? 1u : 0u; mine = (j == x) ? c : mine; }
        if (sum == G) break;
        __builtin_amdgcn_s_sleep(1);
        if ((++sp & 255u) == 0u) { if (xb_ld(&bar[XB_TMO])) break; if (sp > XB_SPIN_CAP) { atomicAdd(&bar[XB_TMO], 1u); break; } }
    }
    nloc = mine > 0u ? mine : 1u; nx = cnt > 0u ? cnt : 1u;
}

__device__ __forceinline__ void xcd_barrier(const XcdBarrier& b) {
    asm volatile("s_waitcnt vmcnt(0)" ::: "memory");
    __syncthreads();
    if (threadIdx.x == 0) {
        unsigned* bar = b.bar;
        __builtin_amdgcn_s_waitcnt(0);
        unsigned nloc = b.st[0], nx = b.st[1];
        if (nloc == 0u) { xcd_barrier_complete(bar, b.x, nloc, nx); b.st[0] = nloc; b.st[1] = nx; }
        const unsigned old = xb_add(&bar[XB_XSUB(b.x)], 1u);
        const unsigned gen = old / nloc;
        if (old + 1u == (gen + 1u) * nloc) {
            __builtin_amdgcn_fence(__ATOMIC_RELEASE, "agent");
            asm volatile("s_waitcnt vmcnt(0)" ::: "memory");
            const unsigned og = xb_add(&bar[XB_TOP], 1u);
            const unsigned tg = og / nx;
            if (og + 1u == (tg + 1u) * nx) xb_add(&bar[XB_TOPGEN], 1u);
            else XB_SPIN(xb_ld(&bar[XB_TOPGEN]) == tg, bar);
            __builtin_amdgcn_fence(__ATOMIC_ACQUIRE, "agent");
            xb_add(&bar[XB_XGEN(b.x)], 1u);
            asm volatile("s_waitcnt vmcnt(0)" ::: "memory");
        } else {
            XB_SPIN(xb_ld(&bar[XB_XGEN(b.x)]) == gen, bar);
            __builtin_amdgcn_fence(__ATOMIC_ACQUIRE, "agent");
            asm volatile("s_waitcnt vmcnt(0)" ::: "memory");
        }
    }
    __syncthreads();
}

#define LDS_BARRIER() do { asm volatile("s_waitcnt lgkmcnt(0)" ::: "memory"); __builtin_amdgcn_s_barrier(); asm volatile("" ::: "memory"); } while (0)
typedef float vf4 __attribute__((ext_vector_type(4)));
typedef unsigned vu2 __attribute__((ext_vector_type(2)));
typedef unsigned vu4 __attribute__((ext_vector_type(4)));
__device__ __forceinline__ float wave_sum(float v) {
#pragma unroll
    for (int o = 1; o < 64; o <<= 1) v += __shfl_xor(v, o);
    return v;
}
template <int CTRL> __device__ __forceinline__ float dpp_f(float x) { return __builtin_bit_cast(float, __builtin_amdgcn_mov_dpp(__builtin_bit_cast(int, x), CTRL, 0xf, 0xf, true)); }
__device__ __forceinline__ float sum16(float x) { x += dpp_f<0xB1>(x); x += dpp_f<0x4E>(x); x += dpp_f<0x124>(x); x += dpp_f<0x128>(x); return x; }
__device__ __forceinline__ float sum8(float x) { x += dpp_f<0xB1>(x); x += dpp_f<0x4E>(x); x += dpp_f<0x141>(x); return x; }
__device__ __forceinline__ unsigned pk2(float lo, float hi) { return (unsigned)f2bf(lo) | ((unsigned)f2bf(hi) << 16); }

constexpr int NV4 = D_MODEL / 256;
__device__ __forceinline__ void row_load(const float* row, int lane, vf4 (&x)[NV4]) {
#pragma unroll
    for (int j = 0; j < NV4; ++j) x[j] = *(const vf4*)(row + (size_t)(j * 64 + lane) * 4);
}
__device__ __forceinline__ void row_store(float* row, int lane, const vf4 (&x)[NV4]) {
#pragma unroll
    for (int j = 0; j < NV4; ++j) *(vf4*)(row + (size_t)(j * 64 + lane) * 4) = x[j];
}
__device__ __forceinline__ float row_rs(const vf4 (&x)[NV4]) {
    float ss = 0.f;
#pragma unroll
    for (int j = 0; j < NV4; ++j) ss += (x[j].x * x[j].x + x[j].y * x[j].y) + (x[j].z * x[j].z + x[j].w * x[j].w);
    return 1.0f / sqrtf(wave_sum(ss) * (1.0f / D_MODEL) + EPS);
}
__device__ __forceinline__ void norm_h_wave(const Ptrs& p, int l, int r, int which, int lane, const vf4 (&x)[NV4]) {
    const float rs = row_rs(x);
    const float* g = (which ? p.g_pre2 : p.g_pre1) + (size_t)l * D_MODEL;
    const float* mod = p.MOD + ((size_t)l * (BATCH + 1) + mod_row(r)) * D6 + (which ? 3 * D_MODEL : 0);
#pragma unroll
    for (int j = 0; j < NV4; ++j) { const int c = (j * 64 + lane) * 4;
        const vf4 gv = *(const vf4*)(g + c), sh = *(const vf4*)(mod + c), sc = *(const vf4*)(mod + D_MODEL + c);
        const vf4 o = x[j] * rs * gv * (1.0f + sc) + sh;
        vu2 w; w.x = pk2(o.x, o.y); w.y = pk2(o.z, o.w);
        *(vu2*)(p.H + (size_t)r * D_MODEL + c) = w; }
}
__device__ __forceinline__ void resid_wave(const Ptrs& p, int l, int r, int which, int lane, vf4 (&x)[NV4], int ns) {
    vf4 y[NV4];
    if (r >= NLAT) {
#pragma unroll
        for (int j = 0; j < NV4; ++j) y[j] = (vf4){0.f, 0.f, 0.f, 0.f};
        for (int s = 0; s < ns; ++s) {
#pragma unroll
            for (int j = 0; j < NV4; ++j) y[j] += *(const vf4*)(p.SLAB + ((size_t)s * NCTX + (r - NLAT)) * D_MODEL + (size_t)(j * 64 + lane) * 4); }
    } else
#pragma unroll
    for (int j = 0; j < NV4; ++j) { const vu2 w = *(const vu2*)(p.MIXb + (size_t)r * D_MODEL + (size_t)(j * 64 + lane) * 4); y[j] = (vf4){__uint_as_float(w.x << 16), __uint_as_float(w.x & 0xffff0000u), __uint_as_float(w.y << 16), __uint_as_float(w.y & 0xffff0000u)}; }
    const float rs = row_rs(y);
    const float* g = (which ? p.g_post2 : p.g_post1) + (size_t)l * D_MODEL;
    const float* gate = p.MOD + ((size_t)l * (BATCH + 1) + mod_row(r)) * D6 + (which ? 5 * D_MODEL : 2 * D_MODEL);
#pragma unroll
    for (int j = 0; j < NV4; ++j) { const int c = (j * 64 + lane) * 4; x[j] += *(const vf4*)(gate + c) * (y[j] * rs * *(const vf4*)(g + c)); }
}

struct WtDesc { const float* W; bf16* WT; int K, N, k0, n0, drow0; };
__device__ __forceinline__ void transpose_load(const WtDesc& d, int lane, float (&wv)[32]) {
#pragma unroll
    for (int i = 0; i < 32; ++i) wv[i] = d.W[(size_t)(d.k0 + 2 * i + (lane >> 5)) * d.N + d.n0 + (lane & 31)];
}
__device__ __forceinline__ void transpose_finish(const WtDesc& d, const float (&wv)[32], LAS float* scr, int lane) {
#pragma unroll
    for (int i = 0; i < 32; ++i) scr[(2 * i + (lane >> 5)) * 33 + (lane & 31)] = wv[i];
    asm volatile("s_waitcnt lgkmcnt(0)" ::: "memory");
    const int c = lane & 7;
#pragma unroll
    for (int j = 0; j < 4; ++j) { const int n = (lane >> 3) + 8 * j; const LAS float* s = scr + (8 * c) * 33 + n;
        vu4 o; o.x = pk2(s[0 * 33], s[1 * 33]); o.y = pk2(s[2 * 33], s[3 * 33]); o.z = pk2(s[4 * 33], s[5 * 33]); o.w = pk2(s[6 * 33], s[7 * 33]);
        *(vu4*)(d.WT + (size_t)(d.drow0 + n) * d.K + d.k0 + 8 * c) = o; }
    asm volatile("s_waitcnt lgkmcnt(0)" ::: "memory");
}
__device__ __forceinline__ void transpose_item(const float* W, int K, int N, bf16* WT, int k0, int n0, int drow0, LAS float* scr, int lane) {
    const WtDesc d{W, WT, K, N, k0, n0, drow0}; float wv[32];
    transpose_load(d, lane, wv); transpose_finish(d, wv, scr, lane);
}
__device__ __forceinline__ int inproj_dst_row0(int n0) {
    if (n0 < R_A) return n0;
    if (n0 == R_A) return NP_MAIN;
    if (n0 < R_DT) return n0 - 4 * GDN_H;
    if (n0 == R_DT) return NP_MAIN + PF_DT;
    return n0 - 4 * GDN_H - 2 * SSM_H;
}
__device__ __forceinline__ int up_dst_row0(int n0) {
    const int isg = n0 >= D_FF, j = isg ? n0 - D_FF : n0; return 256 * (j >> 7) + 128 * isg + (j & 127);
}
static_assert(D_FF % 128 == 0, "up-projection tile order");
static_assert(4 * GDN_H == 32 && 2 * SSM_H == 32 && R_A % 32 == 0 && R_DT % 32 == 0, "the 32-column transpose items assume the real shapes");

constexpr int TB = 32;
constexpr int GDN_BUF = TB * 256 + TB * 32 + TB * 2;
__device__ __forceinline__ void gdn_token_wg(const Ptrs& p, LAS float* L, int chain, int slice, int tid) {
    const int b = chain / (GDN_H * 2), h = (chain >> 1) % GDN_H, dir = chain & 1;
    const int lane = tid & 63, wave = tid >> 6, ks = lane & 15, cl = wave * 4 + (lane >> 4);
    LAS float* obuf = L + 2 * GDN_BUF;
    float S[8];
#pragma unroll
    for (int e = 0; e < 8; ++e) S[e] = 0.f;
    vf4 rq[4], rv; float ra = 0.f, rb = 0.f;
    constexpr int NB = CHAIN_LEN / TB;
    auto gload = [&](int n) {
#pragma unroll
        for (int j = 0; j < 4; ++j) { const int idx = j * 512 + tid, i = idx >> 6, c4 = idx & 63; const int r = chain_row(b, dir, n * TB + i);
            rq[j] = *(const vf4*)(p.GQKV + (size_t)r * (3 * MIX_W) + h * 128 + (c4 < 32 ? c4 * 4 : MIX_W + (c4 - 32) * 4)); }
        if (tid < 256) { const int i = tid >> 3, c4 = tid & 7; const int r = chain_row(b, dir, n * TB + i);
            rv = *(const vf4*)(p.GQKV + (size_t)r * (3 * MIX_W) + 2 * MIX_W + h * 128 + slice * 32 + c4 * 4); }
        if (tid < TB) { const int r = chain_row(b, dir, n * TB + tid); ra = __expf(p.GG[(size_t)r * 2 * GDN_H + dir * GDN_H + h]); rb = p.GB[(size_t)r * 2 * GDN_H + dir * GDN_H + h]; }
    };
    auto lstore = [&](LAS float* B) {
#pragma unroll
        for (int j = 0; j < 4; ++j) { const int idx = j * 512 + tid; *(LAS vf4*)(B + (idx >> 6) * 256 + (idx & 63) * 4) = rq[j]; }
        if (tid < 256) *(LAS vf4*)(B + TB * 256 + tid * 4) = rv;
        if (tid < TB) { B[TB * 256 + TB * 32 + tid * 2] = ra; B[TB * 256 + TB * 32 + tid * 2 + 1] = rb; }
    };
    gload(0); lstore(L); LDS_BARRIER();
    for (int n = 0; n < NB; ++n) {
        LAS float* B = L + (n & 1) * GDN_BUF; LAS float* ob = obuf + (n & 1) * (TB * 32);
        if (n + 1 < NB) gload(n + 1);
#pragma unroll 4
        for (int i = 0; i < TB; ++i) {
            const LAS float* kq = B + i * 256;
            const vf4 q0 = *(const LAS vf4*)(kq + ks * 8), q1 = *(const LAS vf4*)(kq + ks * 8 + 4), k0 = *(const LAS vf4*)(kq + 128 + ks * 8), k1 = *(const LAS vf4*)(kq + 128 + ks * 8 + 4);
            const float v = B[TB * 256 + i * 32 + cl], a = B[TB * 256 + TB * 32 + i * 2], be = B[TB * 256 + TB * 32 + i * 2 + 1];
            const float kk[8] = {k0.x, k0.y, k0.z, k0.w, k1.x, k1.y, k1.z, k1.w}, qq[8] = {q0.x, q0.y, q0.z, q0.w, q1.x, q1.y, q1.z, q1.w};
            float rr = 0.f;
#pragma unroll
            for (int e = 0; e < 8; ++e) { S[e] *= a; rr += kk[e] * S[e]; }
            rr = sum16(rr);
            const float dl = be * (v - rr); float o = 0.f;
#pragma unroll
            for (int e = 0; e < 8; ++e) { S[e] += kk[e] * dl; o += qq[e] * S[e]; }
            o = sum16(o);
            if (ks == 0) ob[i * 32 + cl] = o;
        }
        if (n + 1 < NB) lstore(L + ((n + 1) & 1) * GDN_BUF);
        LDS_BARRIER();
        if (tid < 256) { const int i = tid >> 3, c4 = tid & 7; const int r = chain_row(b, dir, n * TB + i);
            *(vf4*)(p.OG + ((size_t)dir * MROWS + r) * MIX_W + h * 128 + slice * 32 + c4 * 4) = *(const LAS vf4*)(ob + i * 32 + c4 * 4); }
    }
}
constexpr int SSD_BUF = TB * 256 + TB * 64 + TB * 2;
__device__ __forceinline__ void ssd_token_wg(const Ptrs& p, LAS float* L, int chain, int tid) {
    const int b = chain / (SSM_H * 2), hd = (chain >> 1) % SSM_H, dir = chain & 1, g = hd / SSM_HPG;
    const int lane = tid & 63, wave = tid >> 6, ss = lane & 7, pc = wave * 8 + (lane >> 3);
    LAS float* obuf = L + 2 * SSD_BUF;
    float hs[16];
#pragma unroll
    for (int e = 0; e < 16; ++e) hs[e] = 0.f;
    vf4 rbc[4], rx; float rdt = 0.f, rea = 0.f;
    constexpr int NB = CHAIN_LEN / TB;
    auto gload = [&](int n) {
#pragma unroll
        for (int j = 0; j < 4; ++j) { const int idx = j * 512 + tid, i = idx >> 6, c4 = idx & 63; const int r = chain_row(b, dir, n * TB + i);
            rbc[j] = *(const vf4*)(p.SXBC + (size_t)r * SSM_XBC + MIX_W + (c4 < 32 ? g * SSM_N + c4 * 4 : SSM_BC + g * SSM_N + (c4 - 32) * 4)); }
        { const int i = tid >> 4, c4 = tid & 15; const int r = chain_row(b, dir, n * TB + i); rx = *(const vf4*)(p.SXBC + (size_t)r * SSM_XBC + hd * SSM_P + c4 * 4); }
        if (tid < TB) { const int r = chain_row(b, dir, n * TB + tid); rdt = p.SDT[(size_t)r * 2 * SSM_H + dir * SSM_H + hd]; rea = __expf(p.SA[(size_t)r * 2 * SSM_H + dir * SSM_H + hd]); }
    };
    auto lstore = [&](LAS float* B) {
#pragma unroll
        for (int j = 0; j < 4; ++j) { const int idx = j * 512 + tid; *(LAS vf4*)(B + (idx >> 6) * 256 + (idx & 63) * 4) = rbc[j]; }
        *(LAS vf4*)(B + TB * 256 + tid * 4) = rx;
        if (tid < TB) { B[TB * 256 + TB * 64 + tid * 2] = rdt; B[TB * 256 + TB * 64 + tid * 2 + 1] = rea; }
    };
    gload(0); lstore(L); LDS_BARRIER();
    for (int n = 0; n < NB; ++n) {
        LAS float* B = L + (n & 1) * SSD_BUF; LAS float* ob = obuf + (n & 1) * (TB * 64);
        if (n + 1 < NB) gload(n + 1);
#pragma unroll 2
        for (int i = 0; i < TB; ++i) {
            const LAS float* bc = B + i * 256;
            const float xd = B[TB * 256 + i * 64 + pc] * B[TB * 256 + TB * 64 + i * 2], ea = B[TB * 256 + TB * 64 + i * 2 + 1];
            float y = 0.f;
#pragma unroll
            for (int q = 0; q < 4; ++q) { const vf4 bv = *(const LAS vf4*)(bc + ss * 16 + q * 4), cv = *(const LAS vf4*)(bc + 128 + ss * 16 + q * 4);
                hs[4 * q + 0] = ea * hs[4 * q + 0] + xd * bv.x; y += cv.x * hs[4 * q + 0];
                hs[4 * q + 1] = ea * hs[4 * q + 1] + xd * bv.y; y += cv.y * hs[4 * q + 1];
                hs[4 * q + 2] = ea * hs[4 * q + 2] + xd * bv.z; y += cv.z * hs[4 * q + 2];
                hs[4 * q + 3] = ea * hs[4 * q + 3] + xd * bv.w; y += cv.w * hs[4 * q + 3]; }
            y = sum8(y);
            if (ss == 0) ob[i * 64 + pc] = y;
        }
        if (n + 1 < NB) lstore(L + ((n + 1) & 1) * SSD_BUF);
        LDS_BARRIER();
        { const int i = tid >> 4, c4 = tid & 15; const int r = chain_row(b, dir, n * TB + i);
            *(vf4*)(p.OS + ((size_t)dir * MROWS + r) * MIX_W + hd * SSM_P + c4 * 4) = *(const LAS vf4*)(ob + i * 64 + c4 * 4); }
    }
}

constexpr int YLD = 3 * MIX_W;
typedef float f32x2_t __attribute__((ext_vector_type(2)));
typedef __bf16 bf16x2_t __attribute__((ext_vector_type(2)));
typedef short bf16x8_t __attribute__((ext_vector_type(8)));
typedef float f32x16_t __attribute__((ext_vector_type(16)));
__device__ __forceinline__ unsigned cvtpk(float lo, float hi) { f32x2_t v = {lo, hi}; bf16x2_t b = __builtin_convertvector(v, bf16x2_t); return __builtin_bit_cast(unsigned, b); }
__device__ __forceinline__ float bflo(unsigned w) { return __uint_as_float(w << 16); }
__device__ __forceinline__ float bfhi(unsigned w) { return __uint_as_float(w & 0xffff0000u); }
__device__ __forceinline__ void unpack8(const vu4 w, float (&f)[8]) { f[0] = bflo(w.x); f[1] = bfhi(w.x); f[2] = bflo(w.y); f[3] = bfhi(w.y); f[4] = bflo(w.z); f[5] = bfhi(w.z); f[6] = bflo(w.w); f[7] = bfhi(w.w); }
__device__ __forceinline__ float silu_fast(float x) { return x * __builtin_amdgcn_rcpf(1.0f + __expf(-x)); }

__device__ __forceinline__ void conv8(const bf16* Prow, bool hp, bool hn, int col, const float* w, int wld, int jc, float (&y)[8]) {
    float xc[8], xp[8], xn[8];
    unpack8(*(const vu4*)(Prow + col), xc);
    if (hp) unpack8(*(const vu4*)(Prow - NP_MAIN + col), xp);
    if (hn) unpack8(*(const vu4*)(Prow + NP_MAIN + col), xn);
    const vf4 w0a = *(const vf4*)(w + jc), w0b = *(const vf4*)(w + jc + 4), w1a = *(const vf4*)(w + wld + jc), w1b = *(const vf4*)(w + wld + jc + 4), w2a = *(const vf4*)(w + 2 * wld + jc), w2b = *(const vf4*)(w + 2 * wld + jc + 4);
    const float w0[8] = {w0a.x, w0a.y, w0a.z, w0a.w, w0b.x, w0b.y, w0b.z, w0b.w}, w1[8] = {w1a.x, w1a.y, w1a.z, w1a.w, w1b.x, w1b.y, w1b.z, w1b.w}, w2[8] = {w2a.x, w2a.y, w2a.z, w2a.w, w2b.x, w2b.y, w2b.z, w2b.w};
#pragma unroll
    for (int e = 0; e < 8; ++e) { float v = w1[e] * xc[e]; if (hp) v += w0[e] * xp[e]; if (hn) v += w2[e] * xn[e]; y[e] = v; }
}
constexpr float ATT_QSCALE = 0.08838834764831845f * 1.4426950408889634f;
__device__ __forceinline__ void prep_row_wave(const Ptrs& p, int l, int r, int lane) {
    int b, t, len; bool ic; row_info(r, b, t, len, ic);
    const bool hp = t > 0, hn = t < len - 1;
    const bf16* Pr = p.P + (size_t)r * NP_MAIN;
    { const float* w = p.gdn_conv_w + (size_t)l * 3 * (3 * MIX_W);
#pragma unroll 3
        for (int ps = 0; ps < (3 * MIX_W) / 512; ++ps) { const int col = ps * 512 + lane * 8, grp = col >> 7; float y[8]; conv8(Pr, hp, hn, C_QKV + col, w, 3 * MIX_W, col, y);
            float ss = 0.f;
#pragma unroll
            for (int e = 0; e < 8; ++e) { y[e] = silu_fast(y[e]); ss += y[e] * y[e]; }
            ss = sum16(ss);
            float sc = 1.0f; if (grp < 2 * GDN_H) { sc = 1.0f / sqrtf(ss + EPS); if (grp < GDN_H) sc *= 0.08838834764831845f; }
            *(vu4*)(p.GQKVb + (size_t)r * (3 * MIX_W) + col) = (vu4){cvtpk(y[0] * sc, y[1] * sc), cvtpk(y[2] * sc, y[3] * sc), cvtpk(y[4] * sc, y[5] * sc), cvtpk(y[6] * sc, y[7] * sc)}; } }
    { const float* w = p.ssm_conv_w + (size_t)l * 3 * SSM_XBC; const float* cb = p.ssm_conv_b + (size_t)l * SSM_XBC;
#pragma unroll 3
        for (int ps = 0; ps < SSM_XBC / 512; ++ps) { const int col = ps * 512 + lane * 8; float y[8]; conv8(Pr, hp, hn, C_XBC + col, w, SSM_XBC, col, y);
            const vf4 ba = *(const vf4*)(cb + col), bb = *(const vf4*)(cb + col + 4); const float bs[8] = {ba.x, ba.y, ba.z, ba.w, bb.x, bb.y, bb.z, bb.w};
#pragma unroll
            for (int e = 0; e < 8; ++e) y[e] = silu_fast(y[e] + bs[e]);
            const vu4 w8 = {cvtpk(y[0], y[1]), cvtpk(y[2], y[3]), cvtpk(y[4], y[5]), cvtpk(y[6], y[7])};
            if (col >= MIX_W) *(vu4*)(p.SBCb + (size_t)r * (2 * SSM_BC) + col - MIX_W) = w8; else *(vu4*)(p.SXb + (size_t)r * MIX_W + col) = w8; } }
    if (lane < 2 * GDN_H) prep_gdn_gb_item(p, l, r, lane);
    if (lane < 2 * SSM_H) prep_ssd_dt_item(p, l, r, lane);
    { const int l16 = lane & 15, ax = l16 >> 3, i0 = (l16 & 7) * 4; const int pos = ic ? 0 : (ax ? t % GRID_W : t / GRID_W);
        const vf4 t0 = *(const vf4*)(p.ROPE + (size_t)(pos * 32 + i0) * 2), t1 = *(const vf4*)(p.ROPE + (size_t)(pos * 32 + i0) * 2 + 4);
        const float cs[4] = {t0.x, t0.z, t1.x, t1.z}, sn[4] = {t0.y, t0.w, t1.y, t1.w};
#pragma unroll 3
        for (int ps = 0; ps < 3; ++ps) { const int hh = ps * 4 + (lane >> 4);
            if (hh < ATT_HQ + ATT_HKV) { const bool isq = hh < ATT_HQ; const int h = isq ? hh : hh - ATT_HQ;
                const bf16* src = Pr + (isq ? C_AQ : C_AKV) + h * 128 + ax * 64 + i0;
                const vu2 a = *(const vu2*)src, c = *(const vu2*)(src + 32);
                const float x1[4] = {bflo(a.x), bfhi(a.x), bflo(a.y), bfhi(a.y)}, x2[4] = {bflo(c.x), bfhi(c.x), bflo(c.y), bfhi(c.y)};
                float o1[4], o2[4]; const float sc = isq ? ATT_QSCALE : 1.0f;
#pragma unroll
                for (int e = 0; e < 4; ++e) { o1[e] = (x1[e] * cs[e] - x2[e] * sn[e]) * sc; o2[e] = (x2[e] * cs[e] + x1[e] * sn[e]) * sc; }
                bf16* dst = (isq ? p.AQb + (size_t)r * MIX_W : p.AKb + (size_t)r * (ATT_HKV * 128)) + h * 128 + ax * 64 + i0;
                vu2 w1; w1.x = cvtpk(o1[0], o1[1]); w1.y = cvtpk(o1[2], o1[3]); vu2 w2; w2.x = cvtpk(o2[0], o2[1]); w2.y = cvtpk(o2[2], o2[3]);
                *(vu2*)dst = w1; *(vu2*)(dst + 32) = w2; } } }
}
constexpr int PREP_RB = 17, PREP_QP = (3 * MIX_W) / 512, PREP_NPASS = PREP_QP + SSM_XBC / 512;
static_assert(MROWS % PREP_RB == 0 && (3 * MIX_W) % 512 == 0 && SSM_XBC % 512 == 0 && MIX_W % 512 == 0, "prep tiling");
__device__ __forceinline__ void prep_conv_block_wave(const Ptrs& p, int l, int blk, int ps, int lane) {
    const int r0 = blk * PREP_RB; const bool isx = ps >= PREP_QP;
    const int col = (isx ? ps - PREP_QP : ps) * 512 + lane * 8, wld = isx ? SSM_XBC : 3 * MIX_W, grp = col >> 7;
    const float* w = (isx ? p.ssm_conv_w + (size_t)l * 3 * SSM_XBC : p.gdn_conv_w + (size_t)l * 3 * (3 * MIX_W)) + col;
    const vf4 w0a = *(const vf4*)w, w0b = *(const vf4*)(w + 4), w1a = *(const vf4*)(w + wld), w1b = *(const vf4*)(w + wld + 4), w2a = *(const vf4*)(w + 2 * wld), w2b = *(const vf4*)(w + 2 * wld + 4);
    const float w0[8] = {w0a.x, w0a.y, w0a.z, w0a.w, w0b.x, w0b.y, w0b.z, w0b.w}, w1[8] = {w1a.x, w1a.y, w1a.z, w1a.w, w1b.x, w1b.y, w1b.z, w1b.w}, w2[8] = {w2a.x, w2a.y, w2a.z, w2a.w, w2b.x, w2b.y, w2b.z, w2b.w};
    float bs[8] = {0.f, 0.f, 0.f, 0.f, 0.f, 0.f, 0.f, 0.f};
    if (isx) { const float* cb = p.ssm_conv_b + (size_t)l * SSM_XBC + col; const vf4 ba = *(const vf4*)cb, bb = *(const vf4*)(cb + 4); bs[0] = ba.x; bs[1] = ba.y; bs[2] = ba.z; bs[3] = ba.w; bs[4] = bb.x; bs[5] = bb.y; bs[6] = bb.z; bs[7] = bb.w; }
    const bf16* src = p.P + (size_t)r0 * NP_MAIN + (isx ? C_XBC : C_QKV) + col;
    vu4 rows[PREP_RB + 2];
#pragma unroll
    for (int j = 0; j < PREP_RB + 2; ++j) { const int r = r0 - 1 + j; rows[j] = (r >= 0 && r < MROWS) ? *(const vu4*)(src + ((ptrdiff_t)j - 1) * NP_MAIN) : (vu4){0u, 0u, 0u, 0u}; }
    float xp[8], xc[8], xn[8];
    unpack8(rows[0], xp); unpack8(rows[1], xc);
#pragma unroll
    for (int i = 0; i < PREP_RB; ++i) { const int r = r0 + i; int b, t, len; bool ic; row_info(r, b, t, len, ic); const bool hp = t > 0, hn = t < len - 1;
        unpack8(rows[i + 2], xn);
        float y[8];
#pragma unroll
        for (int e = 0; e < 8; ++e) { float v = w1[e] * xc[e] + bs[e]; if (hp) v += w0[e] * xp[e]; if (hn) v += w2[e] * xn[e]; y[e] = silu_fast(v); }
        if (isx) { const vu4 w8 = {cvtpk(y[0], y[1]), cvtpk(y[2], y[3]), cvtpk(y[4], y[5]), cvtpk(y[6], y[7])};
            if (col >= MIX_W) *(vu4*)(p.SBCb + (size_t)r * (2 * SSM_BC) + col - MIX_W) = w8; else *(vu4*)(p.SXb + (size_t)r * MIX_W + col) = w8; }
        else { float ss = 0.f;
#pragma unroll
            for (int e = 0; e < 8; ++e) ss += y[e] * y[e];
            ss = sum16(ss);
            float sc = 1.0f; if (grp < 2 * GDN_H) { sc = 1.0f / sqrtf(ss + EPS); if (grp < GDN_H) sc *= 0.08838834764831845f; }
            *(vu4*)(p.GQKVb + (size_t)r * (3 * MIX_W) + col) = (vu4){cvtpk(y[0] * sc, y[1] * sc), cvtpk(y[2] * sc, y[3] * sc), cvtpk(y[4] * sc, y[5] * sc), cvtpk(y[6] * sc, y[7] * sc)}; }
#pragma unroll
        for (int e = 0; e < 8; ++e) { xp[e] = xc[e]; xc[e] = xn[e]; } }
}
__device__ __forceinline__ void prep_row_scalars_wave(const Ptrs& p, int l, int r, int lane) {
    int b, t, len; bool ic; row_info(r, b, t, len, ic);
    const bf16* Pr = p.P + (size_t)r * NP_MAIN;
    if (lane < 2 * GDN_H) prep_gdn_gb_item(p, l, r, lane);
    if (lane < 2 * SSM_H) prep_ssd_dt_item(p, l, r, lane);
    { const int l16 = lane & 15, ax = l16 >> 3, i0 = (l16 & 7) * 4; const int pos = ic ? 0 : (ax ? t % GRID_W : t / GRID_W);
        const vf4 t0 = *(const vf4*)(p.ROPE + (size_t)(pos * 32 + i0) * 2), t1 = *(const vf4*)(p.ROPE + (size_t)(pos * 32 + i0) * 2 + 4);
        const float cs[4] = {t0.x, t0.z, t1.x, t1.z}, sn[4] = {t0.y, t0.w, t1.y, t1.w};
#pragma unroll 3
        for (int ps = 0; ps < 3; ++ps) { const int hh = ps * 4 + (lane >> 4);
            if (hh < ATT_HQ + ATT_HKV) { const bool isq = hh < ATT_HQ; const int h = isq ? hh : hh - ATT_HQ;
                const bf16* src = Pr + (isq ? C_AQ : C_AKV) + h * 128 + ax * 64 + i0;
                const vu2 a = *(const vu2*)src, c = *(const vu2*)(src + 32);
                const float x1[4] = {bflo(a.x), bfhi(a.x), bflo(a.y), bfhi(a.y)}, x2[4] = {bflo(c.x), bfhi(c.x), bflo(c.y), bfhi(c.y)};
                float o1[4], o2[4]; const float sc = isq ? ATT_QSCALE : 1.0f;
#pragma unroll
                for (int e = 0; e < 4; ++e) { o1[e] = (x1[e] * cs[e] - x2[e] * sn[e]) * sc; o2[e] = (x2[e] * cs[e] + x1[e] * sn[e]) * sc; }
                bf16* dst = (isq ? p.AQb + (size_t)r * MIX_W : p.AKb + (size_t)r * (ATT_HKV * 128)) + h * 128 + ax * 64 + i0;
                vu2 w1; w1.x = cvtpk(o1[0], o1[1]); w1.y = cvtpk(o1[2], o1[3]); vu2 w2; w2.x = cvtpk(o2[0], o2[1]); w2.y = cvtpk(o2[2], o2[3]);
                *(vu2*)dst = w1; *(vu2*)(dst + 32) = w2; } } }
}
__device__ __forceinline__ void mixout_row_wave(const Ptrs& p, int l, int r, int lane) {
    const int c0 = lane * 16;
    {
        float o[16]; float ss = 0.f;
#pragma unroll
        for (int q = 0; q < 2; ++q) { float a8[8], b8[8]; unpack8(*(const vu4*)(p.OGb + (size_t)r * MIX_W + c0 + 8 * q), a8); unpack8(*(const vu4*)(p.OGb + ((size_t)MROWS + r) * MIX_W + c0 + 8 * q), b8);
#pragma unroll
            for (int e = 0; e < 8; ++e) o[8 * q + e] = a8[e] + b8[e]; }
#pragma unroll
        for (int e = 0; e < 16; ++e) ss += o[e] * o[e];
        ss = sum8(ss);
        const float rs = 1.0f / sqrtf(ss * (1.0f / 128.0f) + EPS);
        float gt[16]; { float t8[8]; unpack8(*(const vu4*)(p.P + (size_t)r * NP_MAIN + C_GATE + c0), t8);
#pragma unroll
            for (int e = 0; e < 8; ++e) gt[e] = t8[e];
            unpack8(*(const vu4*)(p.P + (size_t)r * NP_MAIN + C_GATE + c0 + 8), t8);
#pragma unroll
            for (int e = 0; e < 8; ++e) gt[8 + e] = t8[e]; }
        const float* nw = p.gdn_norm + (size_t)l * 128 + (c0 & 127);
        unsigned w[8];
#pragma unroll
        for (int e = 0; e < 8; ++e) w[e] = cvtpk(o[2 * e] * rs * nw[2 * e] * silu_fast(gt[2 * e]), o[2 * e + 1] * rs * nw[2 * e + 1] * silu_fast(gt[2 * e + 1]));
        *(vu4*)(p.YA + (size_t)r * YLD + c0) = (vu4){w[0], w[1], w[2], w[3]}; *(vu4*)(p.YA + (size_t)r * YLD + c0 + 8) = (vu4){w[4], w[5], w[6], w[7]};
    }
    {
        float y[16]; float ss = 0.f; const float dsk = p.ssm_d[(size_t)l * SSM_H + c0 / SSM_P];
        float zt[16]; { float t8[8]; unpack8(*(const vu4*)(p.P + (size_t)r * NP_MAIN + C_Z + c0), t8);
#pragma unroll
            for (int e = 0; e < 8; ++e) zt[e] = t8[e];
            unpack8(*(const vu4*)(p.P + (size_t)r * NP_MAIN + C_Z + c0 + 8), t8);
#pragma unroll
            for (int e = 0; e < 8; ++e) zt[8 + e] = t8[e]; }
#pragma unroll
        for (int q = 0; q < 2; ++q) { float a8[8], c8[8], d8[8], x8[8]; unpack8(*(const vu4*)(p.OSb + (size_t)r * MIX_W + c0 + 8 * q), a8);
            unpack8(*(const vu4*)(p.OSb2 + (size_t)r * MIX_W + c0 + 8 * q), c8); unpack8(*(const vu4*)(p.OSb2 + ((size_t)MROWS + r) * MIX_W + c0 + 8 * q), d8); unpack8(*(const vu4*)(p.SXb + (size_t)r * MIX_W + c0 + 8 * q), x8);
#pragma unroll
            for (int e = 0; e < 8; ++e) y[8 * q + e] = a8[e] + (c8[e] + d8[e]) + dsk * x8[e]; }
#pragma unroll
        for (int e = 0; e < 16; ++e) { y[e] *= silu_fast(zt[e]); ss += y[e] * y[e]; }
        ss = sum16(ss); ss += __shfl_xor(ss, 16);
        const float rs = 1.0f / sqrtf(ss * (1.0f / (float)(MIX_W / SSM_G)) + EPS);
        const float* nw = p.ssm_norm + (size_t)l * MIX_W + c0;
        unsigned w[8];
#pragma unroll
        for (int e = 0; e < 8; ++e) w[e] = cvtpk(y[2 * e] * rs * nw[2 * e], y[2 * e + 1] * rs * nw[2 * e + 1]);
        *(vu4*)(p.YB + (size_t)r * YLD + c0) = (vu4){w[0], w[1], w[2], w[3]}; *(vu4*)(p.YB + (size_t)r * YLD + c0 + 8) = (vu4){w[4], w[5], w[6], w[7]};
    }
}
static_assert(MIX_W == 1024 && SSM_P == 64 && MIX_W / SSM_G == 512, "mixout_row_wave lane mapping assumes the real shapes");
__device__ __forceinline__ void act_vec_item(const Ptrs& p, int l, int r, int j) {
    int b, t, len; bool ic; row_info(r, b, t, len, ic);
    const bf16* ug = p.UG + (size_t)r * (2 * D_FF);
    float u[8], g[8], gp[8], gn[8];
    unpack8(*(const vu4*)(ug + j), u); unpack8(*(const vu4*)(ug + D_FF + j), g);
    const bool hp = t > 0, hn = t < len - 1;
    if (hp) unpack8(*(const vu4*)(ug - 2 * D_FF + D_FF + j), gp);
    if (hn) unpack8(*(const vu4*)(ug + 2 * D_FF + D_FF + j), gn);
    const float* w = p.ffn_conv_w + (size_t)l * 3 * D_FF + j; const float* cb = p.ffn_conv_b + (size_t)l * D_FF + j;
    unsigned o[4];
    float a[8];
#pragma unroll
    for (int e = 0; e < 8; ++e) { float v = w[D_FF + e] * g[e] + cb[e]; if (hp) v += w[e] * gp[e]; if (hn) v += w[2 * D_FF + e] * gn[e]; a[e] = silu_fast(v) * u[e]; }
#pragma unroll
    for (int e = 0; e < 4; ++e) o[e] = cvtpk(a[2 * e], a[2 * e + 1]);
    *(vu4*)(p.ACT + (size_t)r * D_FF + j) = (vu4){o[0], o[1], o[2], o[3]};
}

__device__ __forceinline__ void act_task(const Ptrs& p, int l, int task) {
    constexpr int NJ = D_FF / 8;
    const int rc = task / NJ, j = (task % NJ) * 8, r0 = rc * 16;
    int b, t, len; bool ic; row_info(r0, b, t, len, ic);
    const float* w = p.ffn_conv_w + (size_t)l * 3 * D_FF + j; const float* cb = p.ffn_conv_b + (size_t)l * D_FF + j;
    float w0[8], w1[8], w2[8], bs[8];
    { const vf4 a0 = *(const vf4*)w, a1 = *(const vf4*)(w + 4), b0 = *(const vf4*)(w + D_FF), b1 = *(const vf4*)(w + D_FF + 4), c0 = *(const vf4*)(w + 2 * D_FF), c1 = *(const vf4*)(w + 2 * D_FF + 4), d0 = *(const vf4*)cb, d1 = *(const vf4*)(cb + 4);
        const float t0[8] = {a0.x, a0.y, a0.z, a0.w, a1.x, a1.y, a1.z, a1.w}, t1[8] = {b0.x, b0.y, b0.z, b0.w, b1.x, b1.y, b1.z, b1.w}, t2[8] = {c0.x, c0.y, c0.z, c0.w, c1.x, c1.y, c1.z, c1.w}, t3[8] = {d0.x, d0.y, d0.z, d0.w, d1.x, d1.y, d1.z, d1.w};
#pragma unroll
        for (int e = 0; e < 8; ++e) { w0[e] = t0[e]; w1[e] = t1[e]; w2[e] = t2[e]; bs[e] = t3[e]; } }
    const bf16* base = p.UG + (size_t)r0 * (2 * D_FF) + j;
    vu4 gq[18], uq[16];
    const vu4 z4 = {0u, 0u, 0u, 0u};
    gq[0] = (t > 0) ? *(const vu4*)(base - 2 * D_FF + D_FF) : z4;
#pragma unroll
    for (int i = 0; i < 16; ++i) { gq[i + 1] = *(const vu4*)(base + (size_t)i * (2 * D_FF) + D_FF); uq[i] = *(const vu4*)(base + (size_t)i * (2 * D_FF)); }
    gq[17] = (t + 16 < len) ? *(const vu4*)(base + (size_t)16 * (2 * D_FF) + D_FF) : z4;
#pragma unroll
    for (int i = 0; i < 16; ++i) { float gp[8], gc[8], gn[8], u[8]; unpack8(gq[i], gp); unpack8(gq[i + 1], gc); unpack8(gq[i + 2], gn); unpack8(uq[i], u);
        float a[8];
#pragma unroll
        for (int e = 0; e < 8; ++e) a[e] = silu_fast(w0[e] * gp[e] + w1[e] * gc[e] + w2[e] * gn[e] + bs[e]) * u[e];
        *(vu4*)(p.ACT + (size_t)(r0 + i) * D_FF + j) = (vu4){cvtpk(a[0], a[1]), cvtpk(a[2], a[3]), cvtpk(a[4], a[5]), cvtpk(a[6], a[7])}; }
}
static_assert(SEQ % 16 == 0 && CTX_LEN % 16 == 0, "act_task row chunks must not straddle sequences");

__device__ __forceinline__ void act_fix_item(const Ptrs& p, int l, int bidx, int j) {
    const int row = (bidx >> 1) * 64 + ((bidx & 1) ? 63 : 0);
    int b, t, len; bool ic; row_info(row, b, t, len, ic);
    const size_t bi = (size_t)bidx * D_FF + j;
    vf4 pre = *(const vf4*)(p.BP + bi);
    const vu2 uw = *(const vu2*)(p.BU + bi);
    const bool hasn = (bidx & 1) ? (t < len - 1) : (t > 0);
    if (hasn) { const vu2 gw = *(const vu2*)(p.BG + (size_t)((bidx & 1) ? bidx + 1 : bidx - 1) * D_FF + j);
        const vf4 w = *(const vf4*)(p.ffn_conv_w + (size_t)l * 3 * D_FF + ((bidx & 1) ? 2 * D_FF : 0) + j);
        pre += w * (vf4){bflo(gw.x), bfhi(gw.x), bflo(gw.y), bfhi(gw.y)}; }
    const float u4[4] = {bflo(uw.x), bfhi(uw.x), bflo(uw.y), bfhi(uw.y)};
    *(vu2*)(p.ACT + (size_t)row * D_FF + j) = (vu2){cvtpk(silu_fast(pre.x) * u4[0], silu_fast(pre.y) * u4[1]), cvtpk(silu_fast(pre.z) * u4[2], silu_fast(pre.w) * u4[3])};
}

constexpr int AT_KSTR = 136, AT_VSTR = 68;
constexpr int AT_BUF = 64 * AT_KSTR + 128 * AT_VSTR;
constexpr int ATT_UNITS_LAT = BATCH * ATT_HKV * (SEQ / 64), ATT_UNITS_CTX = BATCH * ATT_HKV * (CTX_LEN / 64);
__device__ __forceinline__ void attn_unit(const Ptrs& p, int l, LAS bf16* L, int unit, int tid) {
    const int lane = tid & 63, wave = tid >> 6, r32 = lane & 31, h = lane >> 5;
    const bool cu = unit >= ATT_UNITS_LAT; const int uu = cu ? unit - ATT_UNITS_LAT : unit;
    const int nqb = cu ? CTX_LEN / 64 : SEQ / 64;
    const int b = uu / (ATT_HKV * nqb), kvh = (uu / nqb) % ATT_HKV, qb = uu % nqb, q0 = qb * 64;
    const int rowbase = (cu ? NLAT + b * CTX_LEN : b * SEQ) + q0;
    const int g = wave >> 1, qh = wave & 1, hq = kvh * ATT_GRP + g;
    const int qpos = q0 + 32 * qh + r32, qrow = rowbase + 32 * qh + r32;
    bf16x8_t qf[8];
#pragma unroll
    for (int s = 0; s < 8; ++s) qf[s] = *(const bf16x8_t*)(p.AQb + (size_t)qrow * MIX_W + hq * 128 + 16 * s + 8 * h);
    float m = p.attn_sink[(size_t)l * ATT_HQ + hq] * 1.4426950408889634f, lsum = h ? 0.f : 1.0f;
    f32x16_t o[4];
#pragma unroll
    for (int d = 0; d < 4; ++d)
#pragma unroll
        for (int e = 0; e < 16; ++e) o[d][e] = 0.f;
    const int jl0 = cu ? 5 : (q0 - 128 < 0 ? (128 - q0) / 64 : 0), jl1 = cu ? 5 : ((q0 + 192 > SEQ) ? 5 - (q0 + 192 - SEQ) / 64 : 5);
    const int nt = (jl1 - jl0) + CTX_LEN / 64;
    vu4 rk[2], rv[2];
    auto tile_row0 = [&](int ti, int& kpos0) -> int { const int j = jl0 + ti; if (j < jl1) { kpos0 = q0 - 128 + 64 * j; return b * SEQ + kpos0; } kpos0 = -1000000; return NLAT + b * CTX_LEN + 64 * (j - jl1); };
    auto gload = [&](int ti) { int kp; const int kr0 = tile_row0(ti, kp);
#pragma unroll
        for (int it = 0; it < 2; ++it) { const int c = tid + 512 * it;
            rk[it] = *(const vu4*)(p.AKb + (size_t)(kr0 + (c >> 4)) * (ATT_HKV * 128) + kvh * 128 + (c & 15) * 8);
            const int vk = (c & 15) | (((c >> 6) & 3) << 4), vd = ((c >> 4) & 3) | ((c >> 8) << 2);
            rv[it] = *(const vu4*)(p.P + (size_t)(kr0 + vk) * NP_MAIN + C_AKV + ATT_HKV * 128 + kvh * 128 + vd * 8); } };
    auto lstore = [&](LAS bf16* B) {
#pragma unroll
        for (int it = 0; it < 2; ++it) { const int c = tid + 512 * it;
            *(LAS vu4*)(B + (c >> 4) * AT_KSTR + (c & 15) * 8) = rk[it];
            const int vk = (c & 15) | (((c >> 6) & 3) << 4), vd = ((c >> 4) & 3) | ((c >> 8) << 2);
            LAS bf16* vt = B + 64 * AT_KSTR + (vd * 8) * AT_VSTR + vk;
            const unsigned w4[4] = {rv[it].x, rv[it].y, rv[it].z, rv[it].w};
#pragma unroll
            for (int e = 0; e < 4; ++e) { vt[(2 * e) * AT_VSTR] = (bf16)(w4[e] & 0xffffu); vt[(2 * e + 1) * AT_VSTR] = (bf16)(w4[e] >> 16); } } };
    gload(0); lstore(L); LDS_BARRIER();
    for (int ti = 0; ti < nt; ++ti) {
        LAS bf16* B = L + (ti & 1) * AT_BUF;
        int kpos0; (void)tile_row0(ti, kpos0);
        if (ti + 1 < nt) gload(ti + 1);
        f32x16_t st[2];
#pragma unroll
        for (int sub = 0; sub < 2; ++sub) {
#pragma unroll
            for (int e = 0; e < 16; ++e) st[sub][e] = 0.f;
            bf16x8_t kf[8];
#pragma unroll
            for (int s = 0; s < 8; ++s) kf[s] = *(const LAS bf16x8_t*)(B + (32 * sub + r32) * AT_KSTR + 16 * s + 8 * h);
            __builtin_amdgcn_s_setprio(1);
#pragma unroll
            for (int s = 0; s < 8; ++s) st[sub] = __builtin_amdgcn_mfma_f32_32x32x16_bf16(kf[s], qf[s], st[sub], 0, 0, 0);
            __builtin_amdgcn_s_setprio(0); }
        float mx = -1e30f;
#pragma unroll
        for (int sub = 0; sub < 2; ++sub)
#pragma unroll
            for (int e = 0; e < 16; ++e) { const int key = 32 * sub + (e & 3) + 8 * (e >> 2) + 4 * h; const int dlt = kpos0 + key - qpos;
                if (kpos0 > -500000 && (dlt > WINDOW || dlt < -WINDOW)) st[sub][e] = -1e30f;
                mx = fmaxf(mx, st[sub][e]); }
        mx = fmaxf(mx, __shfl_xor(mx, 32));
        const float mn = fmaxf(m, mx), alpha = __builtin_amdgcn_exp2f(m - mn); m = mn;
        float ps = 0.f;
#pragma unroll
        for (int sub = 0; sub < 2; ++sub)
#pragma unroll
            for (int e = 0; e < 16; ++e) { const float pe = __builtin_amdgcn_exp2f(st[sub][e] - mn); st[sub][e] = pe; ps += pe; }
        lsum = lsum * alpha + ps;
        if (!__all(alpha == 1.0f)) {
#pragma unroll
            for (int d = 0; d < 4; ++d)
#pragma unroll
                for (int e = 0; e < 16; ++e) o[d][e] *= alpha; }
#pragma unroll
        for (int kk = 0; kk < 4; ++kk) { const int sub = kk >> 1, s8 = (kk & 1) * 8;
            vu4 pw; pw.x = cvtpk(st[sub][s8], st[sub][s8 + 1]); pw.y = cvtpk(st[sub][s8 + 2], st[sub][s8 + 3]); pw.z = cvtpk(st[sub][s8 + 4], st[sub][s8 + 5]); pw.w = cvtpk(st[sub][s8 + 6], st[sub][s8 + 7]);
            const bf16x8_t pf = __builtin_bit_cast(bf16x8_t, pw);
            bf16x8_t vf[4];
#pragma unroll
            for (int d = 0; d < 4; ++d) { const LAS bf16* vp = B + 64 * AT_KSTR + (32 * d + r32) * AT_VSTR + 16 * kk + 4 * h;
                const vu2 lo = *(const LAS vu2*)vp, hi = *(const LAS vu2*)(vp + 8);
                vf[d] = __builtin_bit_cast(bf16x8_t, (vu4){lo.x, lo.y, hi.x, hi.y}); }
            __builtin_amdgcn_s_setprio(1);
#pragma unroll
            for (int d = 0; d < 4; ++d) o[d] = __builtin_amdgcn_mfma_f32_32x32x16_bf16(vf[d], pf, o[d], 0, 0, 0);
            __builtin_amdgcn_s_setprio(0); }
        if (ti + 1 < nt) lstore(L + ((ti + 1) & 1) * AT_BUF);
        LDS_BARRIER();
    }
    lsum += __shfl_xor(lsum, 32);
    const float inv = 1.0f / lsum;
    LAS bf16* os = L + wave * (32 * AT_KSTR);
#pragma unroll
    for (int d = 0; d < 4; ++d)
#pragma unroll
        for (int a4 = 0; a4 < 4; ++a4) { vu2 w; w.x = cvtpk(o[d][4 * a4] * inv, o[d][4 * a4 + 1] * inv); w.y = cvtpk(o[d][4 * a4 + 2] * inv, o[d][4 * a4 + 3] * inv);
            *(LAS vu2*)(os + r32 * AT_KSTR + 32 * d + 8 * a4 + 4 * h) = w; }
    LDS_BARRIER();
#pragma unroll
    for (int i = 0; i < 8; ++i) { const int c = lane + 64 * i, row = c >> 4, ch = c & 15;
        *(vu4*)(p.YC + (size_t)(rowbase + 32 * qh + row) * YLD + hq * 128 + ch * 8) = *(const LAS vu4*)(os + row * AT_KSTR + ch * 8); }
    LDS_BARRIER();
}
static_assert(2 * AT_BUF * 2 <= 131072 && 8 * 32 * AT_KSTR <= 2 * AT_BUF, "attention LDS map");

constexpr int NCH = CHAIN_LEN / 64, NCH_CTX = CTX_LEN / 64;
constexpr int GDN_NU = BATCH * NCH * GDN_H * 2;
constexpr int GC_KS = 136, GC_FS = 65, GC_LS = 68, GC_TS = 72;
__device__ __forceinline__ int gdn_unit_index(int b, int c, int h, int dir) { return ((b * NCH + c) * GDN_H + h) * 2 + dir; }
__device__ __forceinline__ int chunk_row0(int b, int c) { return c < NCH_CTX ? NLAT + b * CTX_LEN + 64 * c : b * SEQ + 64 * (c - NCH_CTX); }
template <int NK> __device__ __forceinline__ f32x16_t mma_lds(f32x16_t acc, const LAS bf16* A, int lda, const LAS bf16* Bt, int ldb, int r32, int hh) {
    bf16x8_t a[NK], bb[NK];
#pragma unroll
    for (int s = 0; s < NK; ++s) { a[s] = *(const LAS bf16x8_t*)(A + r32 * lda + 16 * s + 8 * hh); bb[s] = *(const LAS bf16x8_t*)(Bt + r32 * ldb + 16 * s + 8 * hh); }
    f32x16_t acc2;
#pragma unroll
    for (int e = 0; e < 16; ++e) acc2[e] = 0.f;
#pragma unroll
    for (int s = 0; s < NK; s += 2) { acc = __builtin_amdgcn_mfma_f32_32x32x16_bf16(a[s], bb[s], acc, 0, 0, 0); acc2 = __builtin_amdgcn_mfma_f32_32x32x16_bf16(a[s + 1], bb[s + 1], acc2, 0, 0, 0); }
#pragma unroll
    for (int e = 0; e < 16; ++e) acc[e] += acc2[e];
    return acc;
}
__device__ __forceinline__ f32x16_t zero16() { f32x16_t z;
#pragma unroll
    for (int e = 0; e < 16; ++e) z[e] = 0.f;
    return z; }
__device__ __forceinline__ void tri_solve_wave(const LAS float* Lm, LAS bf16* Tm, LAS bf16* scr, int lane) {
    const int blk = lane >> 5, c = lane & 31, r32 = c, hh = blk;
    LAS bf16* B00 = scr; LAS bf16* XT = scr + 32 * 40;
    float t[32];
    vf4 lb[3][8];
#define TRI_LDROW(i_) do { _Pragma("unroll") for (int j4 = 0; j4 < ((i_) + 3) / 4; ++j4) lb[(i_) % 3][j4] = *(const LAS vf4*)(Lm + (32 * blk + (i_)) * GC_LS + 32 * blk + 4 * j4); } while (0)
    TRI_LDROW(1);
#pragma unroll
    for (int i = 0; i < 32; ++i) {
        if (i + 2 < 32) TRI_LDROW(i + 2);
        float s = (i == c) ? 1.0f : 0.0f;
#pragma unroll
        for (int j4 = 0; j4 < (i + 3) / 4; ++j4) { const vf4 lv = lb[i % 3][j4];
            if (4 * j4 + 0 < i) s -= lv.x * t[4 * j4 + 0];
            if (4 * j4 + 1 < i) s -= lv.y * t[4 * j4 + 1];
            if (4 * j4 + 2 < i) s -= lv.z * t[4 * j4 + 2];
            if (4 * j4 + 3 < i) s -= lv.w * t[4 * j4 + 3]; }
        t[i] = s;
        asm volatile("" : "+v"(t[i]));
    }
#undef TRI_LDROW
#pragma unroll
    for (int i = 0; i < 32; ++i) { Tm[(32 * blk + i) * GC_TS + 32 * blk + c] = f2bf(t[i]); if (blk == 0) Tm[i * GC_TS + 32 + c] = (bf16)0; }
    if (blk == 0) {
#pragma unroll
        for (int q = 0; q < 4; ++q) *(LAS vu4*)(B00 + c * 40 + 8 * q) = (vu4){cvtpk(t[8 * q], t[8 * q + 1]), cvtpk(t[8 * q + 2], t[8 * q + 3]), cvtpk(t[8 * q + 4], t[8 * q + 5]), cvtpk(t[8 * q + 6], t[8 * q + 7])}; }
    f32x16_t x = zero16();
#pragma unroll
    for (int s = 0; s < 2; ++s) { const LAS float* lp = Lm + (32 + r32) * GC_LS + 16 * s + 8 * hh; const vf4 l0 = *(const LAS vf4*)lp, l1 = *(const LAS vf4*)(lp + 4);
        const bf16x8_t a = __builtin_bit_cast(bf16x8_t, (vu4){cvtpk(l0.x, l0.y), cvtpk(l0.z, l0.w), cvtpk(l1.x, l1.y), cvtpk(l1.z, l1.w)});
        const bf16x8_t bb = *(const LAS bf16x8_t*)(B00 + r32 * 40 + 16 * s + 8 * hh);
        x = __builtin_amdgcn_mfma_f32_32x32x16_bf16(a, bb, x, 0, 0, 0); }
#pragma unroll
    for (int a4 = 0; a4 < 4; ++a4) *(LAS vu2*)(XT + r32 * 40 + 8 * a4 + 4 * hh) = (vu2){cvtpk(x[4 * a4], x[4 * a4 + 1]), cvtpk(x[4 * a4 + 2], x[4 * a4 + 3])};
    f32x16_t y = zero16();
#pragma unroll
    for (int s = 0; s < 2; ++s) { const bf16x8_t a = *(const LAS bf16x8_t*)(Tm + (32 + r32) * GC_TS + 32 + 16 * s + 8 * hh), bb = *(const LAS bf16x8_t*)(XT + r32 * 40 + 16 * s + 8 * hh);
        y = __builtin_amdgcn_mfma_f32_32x32x16_bf16(a, bb, y, 0, 0, 0); }
#pragma unroll
    for (int e = 0; e < 16; ++e) Tm[(32 + (e & 3) + 8 * (e >> 2) + 4 * hh) * GC_TS + r32] = f2bf(-y[e]);
}
constexpr int G1_KK = 0, G1_QK = G1_KK + 64 * GC_FS * 4, G1_L = G1_QK + 64 * GC_FS * 4, G1_T = G1_L + 2 * 64 * GC_LS * 4,
              G1_KB = G1_T + 2 * 64 * GC_TS * 2, G1_VB = G1_KB + 128 * GC_TS * 2, G1_SM = G1_VB + 128 * GC_TS * 2, G1_END = G1_SM + 10 * 64 * 4;
__device__ __forceinline__ void st_vu2(LAS bf16* q, vu2 v) { *(LAS vu2*)q = v; }
__device__ __forceinline__ void st_vu2(bf16* q, vu2 v) { *(vu2*)q = v; }
__device__ __forceinline__ void gdn_g1_unit(const Ptrs& p, LAS unsigned char* lds, int unit, int tid) {
    const int lane = tid & 63, wave = tid >> 6, r32 = lane & 31, hh = lane >> 5;
    const int b = unit / (NCH * GDN_H), c = (unit / GDN_H) % NCH, h = unit % GDN_H;
    const int r0 = chunk_row0(b, c);
    LAS float* KKs = (LAS float*)(lds + G1_KK); LAS float* QKs = (LAS float*)(lds + G1_QK);
    LAS float* Lm = (LAS float*)(lds + G1_L); LAS bf16* Tm = (LAS bf16*)(lds + G1_T); LAS bf16* KbT = (LAS bf16*)(lds + G1_KB); LAS bf16* VbT = (LAS bf16*)(lds + G1_VB);
    LAS float* gc = (LAS float*)(lds + G1_SM); LAS float* be = gc + 128; LAS float* eg = gc + 256; LAS float* beg = gc + 384; LAS float* egl = gc + 512;
    const bf16* Qg = p.GQKVb + (size_t)r0 * (3 * MIX_W) + h * 128;
    const int prod = wave >> 2, mt = (wave >> 1) & 1, nt = wave & 1;
    bf16x8_t fa[8], fb[8], ft[4];
    { const bf16* Ap = Qg + (size_t)(32 * mt + r32) * (3 * MIX_W) + (prod ? 0 : MIX_W) + 8 * hh;
      const bf16* Bp = Qg + (size_t)(32 * nt + r32) * (3 * MIX_W) + MIX_W + 8 * hh;
      const bf16* Tp = Qg + (size_t)(32 * mt + r32) * (3 * MIX_W) + (prod ? 2 * MIX_W : MIX_W) + 64 * nt + 8 * hh;
#pragma unroll
      for (int s = 0; s < 8; ++s) { fa[s] = *(const bf16x8_t*)(Ap + 16 * s); fb[s] = *(const bf16x8_t*)(Bp + 16 * s); }
#pragma unroll
      for (int s = 0; s < 4; ++s) ft[s] = *(const bf16x8_t*)(Tp + 16 * s); }
    if (wave < 2) { const int dir = wave, n = dir ? 63 - lane : lane; const size_t gi = (size_t)(r0 + n) * 2 * GDN_H + dir * GDN_H + h;
        float x = p.GG[gi]; const float bt = p.GB[gi];
#pragma unroll
        for (int o = 1; o < 64; o <<= 1) { const float y = __shfl_up(x, o); if (lane >= o) x += y; }
        const float x63 = __shfl(x, 63), ex = __expf(x);
        gc[dir * 64 + lane] = x; be[dir * 64 + lane] = bt; eg[dir * 64 + lane] = ex; beg[dir * 64 + lane] = bt * ex; egl[dir * 64 + lane] = __expf(x63 - x); }
    f32x16_t tt[2];
    { f32x16_t acc = zero16(), acc2 = zero16();
#pragma unroll
      for (int s = 0; s < 8; s += 2) { acc = __builtin_amdgcn_mfma_f32_32x32x16_bf16(fa[s], fb[s], acc, 0, 0, 0); acc2 = __builtin_amdgcn_mfma_f32_32x32x16_bf16(fa[s + 1], fb[s + 1], acc2, 0, 0, 0); }
      LAS float* dst = prod ? QKs : KKs;
#pragma unroll
      for (int e = 0; e < 16; ++e) dst[(32 * mt + (e & 3) + 8 * (e >> 2) + 4 * hh) * GC_FS + 32 * nt + r32] = acc[e] + acc2[e];
      bf16x8_t id[2];
#pragma unroll
      for (int s = 0; s < 2; ++s) { unsigned w[4];
#pragma unroll
          for (int e2 = 0; e2 < 4; ++e2) { const int k0 = 16 * s + 8 * hh + 2 * e2; w[e2] = (k0 == r32 ? 0x3F80u : 0u) | (k0 + 1 == r32 ? 0x3F800000u : 0u); }
          id[s] = __builtin_bit_cast(bf16x8_t, (vu4){w[0], w[1], w[2], w[3]}); }
#pragma unroll
      for (int j = 0; j < 2; ++j) { tt[j] = zero16();
          tt[j] = __builtin_amdgcn_mfma_f32_32x32x16_bf16(ft[2 * j], id[0], tt[j], 0, 0, 0); tt[j] = __builtin_amdgcn_mfma_f32_32x32x16_bf16(ft[2 * j + 1], id[1], tt[j], 0, 0, 0); } }
    LDS_BARRIER();
    auto put_T = [&](int dir, const LAS float* tab, auto dstf) {
#pragma unroll
        for (int j = 0; j < 2; ++j) {
#pragma unroll
            for (int a4 = 0; a4 < 4; ++a4) { const int n0 = 32 * mt + 8 * a4 + 4 * hh;
                if (dir == 0) { const vf4 sc = *(const LAS vf4*)(tab + n0);
                    st_vu2(dstf(j, n0), (vu2){cvtpk(tt[j][4 * a4] * sc.x, tt[j][4 * a4 + 1] * sc.y), cvtpk(tt[j][4 * a4 + 2] * sc.z, tt[j][4 * a4 + 3] * sc.w)}); }
                else { const int i0 = 60 - n0; const vf4 sc = *(const LAS vf4*)(tab + 64 + i0);
                    st_vu2(dstf(j, i0), (vu2){cvtpk(tt[j][4 * a4 + 3] * sc.x, tt[j][4 * a4 + 2] * sc.y), cvtpk(tt[j][4 * a4 + 1] * sc.z, tt[j][4 * a4] * sc.w)}); } } } };
    auto lds_T = [&](LAS bf16* img) { return [=](int j, int i0) { return img + (64 * nt + 32 * j + r32) * GC_TS + i0; }; };
    auto kdt_T = [&](int dir) { bf16* base = p.GKdT + (size_t)gdn_unit_index(b, c, h, dir) * 128 * 64; return [=](int j, int i0) { return base + (((2 * nt + j) * 4 + (i0 >> 4)) * 64 + ((i0 >> 3) & 1) * 32 + r32) * 8 + (i0 & 7); }; };
    if (prod == 0) { put_T(0, egl, kdt_T(0)); put_T(1, egl, kdt_T(1)); put_T(0, beg, lds_T(KbT)); }
    else {
        const int dir = nt, n = 32 * mt + r32, i = dir ? 63 - n : n; const float sc = eg[dir * 64 + i];
        bf16* base = p.GQd + (size_t)gdn_unit_index(b, c, h, dir) * 64 * 128 + ((size_t)((i >> 5) * 8) * 64 + hh * 32 + (i & 31)) * 8;
#pragma unroll
        for (int q = 0; q < 8; ++q) { float q8[8]; unpack8(__builtin_bit_cast(vu4, fa[q]), q8);
            *(vu4*)(base + q * 512) = (vu4){cvtpk(q8[0] * sc, q8[1] * sc), cvtpk(q8[2] * sc, q8[3] * sc), cvtpk(q8[4] * sc, q8[5] * sc), cvtpk(q8[6] * sc, q8[7] * sc)}; }
        put_T(0, be, lds_T(VbT)); }
#pragma unroll
    for (int it = 0; it < 2; ++it) { const int item = it * 512 + tid, dir = item >> 9, j0 = ((item >> 6) & 7) * 8, i = item & 63, ni = dir ? 63 - i : i;
        float o[8] = {0.f, 0.f, 0.f, 0.f, 0.f, 0.f, 0.f, 0.f};
        if (j0 < i) { const float gi = gc[dir * 64 + i], bi = be[dir * 64 + i]; const vf4 ga = *(const LAS vf4*)(gc + dir * 64 + j0), gb = *(const LAS vf4*)(gc + dir * 64 + j0 + 4);
            const float gj[8] = {ga.x, ga.y, ga.z, ga.w, gb.x, gb.y, gb.z, gb.w};
#pragma unroll
            for (int q = 0; q < 8; ++q) { const int j = j0 + q, nj = dir ? 63 - j : j; o[q] = (i > j) ? bi * KKs[ni * GC_FS + nj] * __expf(gi - gj[q]) : 0.0f; } }
        LAS float* dst = Lm + dir * 64 * GC_LS + i * GC_LS + j0;
        *(LAS vf4*)dst = (vf4){o[0], o[1], o[2], o[3]}; *(LAS vf4*)(dst + 4) = (vf4){o[4], o[5], o[6], o[7]}; }
    LDS_BARRIER();
    if (wave < 2) { __builtin_amdgcn_s_setprio(3); tri_solve_wave(Lm + wave * 64 * GC_LS, Tm + wave * 64 * GC_TS, (LAS bf16*)KKs + wave * 2 * 32 * 40, lane); __builtin_amdgcn_s_setprio(0); }
    else if ((wave & 3) >= 2) { const int t6 = ((wave & 1) | ((wave >> 2) << 1)) * 64 + lane;
        for (int it = t6; it < 2 * 64 * 8; it += 256) { const int dir = it >> 9, j8 = (it >> 6) & 7, i = it & 63, ni = dir ? 63 - i : i; unsigned w[4];
#pragma unroll
            for (int e2 = 0; e2 < 4; ++e2) { float a[2];
#pragma unroll
                for (int q = 0; q < 2; ++q) { const int j = j8 * 8 + 2 * e2 + q; a[q] = (i >= j) ? QKs[ni * GC_FS + (dir ? 63 - j : j)] * __expf(gc[dir * 64 + i] - gc[dir * 64 + j]) : 0.0f; }
                w[e2] = cvtpk(a[0], a[1]); }
            *(vu4*)(p.GA + (size_t)gdn_unit_index(b, c, h, dir) * 64 * 64 + (((i >> 5) * 4 + (j8 >> 1)) * 64 + (j8 & 1) * 32 + (i & 31)) * 8) = (vu4){w[0], w[1], w[2], w[3]}; }
        if (t6 < 2) p.GGL[gdn_unit_index(b, c, h, t6)] = eg[t6 * 64 + 63]; }
    LDS_BARRIER();
    LAS bf16* KbT1 = (LAS bf16*)(lds + G1_KK); LAS bf16* VbT1 = KbT1 + 128 * GC_TS;
    if (prod == 0) put_T(1, beg, lds_T(KbT1)); else put_T(1, be, lds_T(VbT1));
    LDS_BARRIER();
#pragma unroll
    for (int dir = 0; dir < 2; ++dir) {
        const int u = gdn_unit_index(b, c, h, dir); const LAS bf16* Td = Tm + dir * 64 * GC_TS; const LAS bf16* Kd = dir ? KbT1 : KbT; const LAS bf16* Vd = dir ? VbT1 : VbT;
        { const int dt = wave >> 1, it2 = wave & 1; f32x16_t acc = zero16(); acc = mma_lds<4>(acc, Kd + 32 * dt * GC_TS, GC_TS, Td + 32 * it2 * GC_TS, GC_TS, r32, hh);
            bf16* dst = p.GW + (size_t)u * 64 * 128 + ((it2 * 8 + 2 * dt) * 64 + r32) * 8 + 4 * hh;
#pragma unroll
            for (int a4 = 0; a4 < 4; ++a4) *(vu2*)(dst + (a4 >> 1) * 512 + (a4 & 1) * 256) = (vu2){cvtpk(acc[4 * a4], acc[4 * a4 + 1]), cvtpk(acc[4 * a4 + 2], acc[4 * a4 + 3])}; }
        { const int it2 = wave >> 2, dt = wave & 3; f32x16_t acc = zero16(); acc = mma_lds<4>(acc, Td + 32 * it2 * GC_TS, GC_TS, Vd + 32 * dt * GC_TS, GC_TS, r32, hh);
            bf16* dst = p.GUT + (size_t)u * 128 * 64 + ((size_t)((dt * 2 + it2) * 4) * 64 + lane) * 4;
#pragma unroll
            for (int a4 = 0; a4 < 4; ++a4) *(vu2*)(dst + a4 * 256) = (vu2){cvtpk(acc[4 * a4], acc[4 * a4 + 1]), cvtpk(acc[4 * a4 + 2], acc[4 * a4 + 3])}; }
    }
    LDS_BARRIER();
}

template <class F> __device__ __forceinline__ void store_tile_rows(const f32x16_t& a, LAS bf16* T, int lane, F rowptr) {
    const int r32 = lane & 31, hh = lane >> 5;
#pragma unroll
    for (int e = 0; e < 16; ++e) T[((e & 3) + 8 * (e >> 2) + 4 * hh) * 40 + r32] = f2bf(a[e]);
    const int il = lane >> 1, half = lane & 1;
    const vu4 w0 = *(const LAS vu4*)(T + il * 40 + half * 16), w1 = *(const LAS vu4*)(T + il * 40 + half * 16 + 8);
    bf16* dst = rowptr(il) + half * 16;
    *(vu4*)dst = w0; *(vu4*)(dst + 8) = w1;
}
__device__ __forceinline__ void gdn_scan_wg(const Ptrs& p, LAS unsigned char* lds, int chain, int slice, int tid) {
    const int b = chain / (GDN_H * 2), h = (chain >> 1) % GDN_H, dir = chain & 1;
    const int lane = tid & 63, wave = tid >> 6, r32 = lane & 31, hh = lane >> 5;
    LAS bf16* SbT = (LAS bf16*)lds;
    LAS bf16* vnT = SbT + 4 * 32 * GC_KS;
    LAS bf16* otile = vnT + 3 * 32 * GC_TS + (wave & 1) * 32 * 40;
    for (int i = tid; i < 32 * GC_KS / 2; i += 512) ((LAS unsigned*)SbT)[i] = 0u;
    LDS_BARRIER();
    auto chunk_of = [&](int s) { return s < NCH_CTX ? (dir ? NCH_CTX - 1 - s : s) : NCH_CTX + (dir ? NCH - NCH_CTX - 1 - (s - NCH_CTX) : s - NCH_CTX); };
    auto unit_of = [&](int s) { return (size_t)gdn_unit_index(b, chunk_of(s), h, dir); };
    using I0 = std::integral_constant<int, 0>; using I1 = std::integral_constant<int, 1>; using I2 = std::integral_constant<int, 2>; using I3 = std::integral_constant<int, 3>;
    if (wave < 2) {
        __builtin_amdgcn_s_setprio(3);
        int tr = tid; asm volatile("" : "+v"(tr)); const int ln = tr & 63, t = (tr >> 6) & 1;
        bf16x8_t fa[4][8]; vu2 ut[4][4];
        auto prefetch = [&](int s, auto KC2) { constexpr int k = decltype(KC2)::value; const size_t u = unit_of(s);
            const bf16* wp = p.GW + u * 64 * 128 + (size_t)(t * 512 + ln) * 8; const bf16* up = p.GUT + u * 128 * 64 + (size_t)((slice * 2 + t) * 256 + ln) * 4;
#pragma unroll
            for (int q = 0; q < 8; ++q) fa[k][q] = *(const bf16x8_t*)(wp + q * 512);
#pragma unroll
            for (int a4 = 0; a4 < 4; ++a4) ut[k][a4] = *(const vu2*)(up + a4 * 256); };
        auto step = [&](int s, auto KC) { constexpr int k = decltype(KC)::value;
            if (s + 3 < NCH) prefetch(s + 3, std::integral_constant<int, (k + 3) % 4>{});
            const LAS bf16* Sc = SbT + (s & 3) * 32 * GC_KS; LAS bf16* vn = vnT + (s % 3) * 32 * GC_TS;
            f32x16_t acc = zero16(), acc2 = zero16();
#pragma unroll
            for (int qh = 0; qh < 2; ++qh) { bf16x8_t bq[4];
#pragma unroll
                for (int q = 0; q < 4; ++q) bq[q] = *(const LAS bf16x8_t*)(Sc + r32 * GC_KS + 16 * (4 * qh + q) + 8 * hh);
#pragma unroll
                for (int q = 0; q < 4; q += 2) { acc = __builtin_amdgcn_mfma_f32_32x32x16_bf16(fa[k][4 * qh + q], bq[q], acc, 0, 0, 0); acc2 = __builtin_amdgcn_mfma_f32_32x32x16_bf16(fa[k][4 * qh + q + 1], bq[q + 1], acc2, 0, 0, 0); } }
#pragma unroll
            for (int a4 = 0; a4 < 4; ++a4) { const vu2 uw = ut[k][a4];
                *(LAS vu2*)(vn + r32 * GC_TS + 32 * t + 8 * a4 + 4 * hh) = (vu2){cvtpk(bflo(uw.x) - (acc[4 * a4] + acc2[4 * a4]), bfhi(uw.x) - (acc[4 * a4 + 1] + acc2[4 * a4 + 1])), cvtpk(bflo(uw.y) - (acc[4 * a4 + 2] + acc2[4 * a4 + 2]), bfhi(uw.y) - (acc[4 * a4 + 3] + acc2[4 * a4 + 3]))}; }
            LDS_BARRIER(); LDS_BARRIER(); };
        prefetch(0, I0{}); prefetch(1, I1{}); prefetch(2, I2{});
        for (int s = 0; s < NCH; s += 4) { step(s, I0{}); step(s + 1, I1{}); step(s + 2, I2{}); step(s + 3, I3{}); }
        __builtin_amdgcn_s_setprio(0);
    } else if (wave >= 4) {
        __builtin_amdgcn_s_setprio(3);
        int tr = tid; asm volatile("" : "+v"(tr)); const int ln = tr & 63, rr = (tr >> 6) & 3;
        int zl = 0; asm volatile("v_mov_b32 %0, 0" : "=v"(zl));
        bf16x8_t fb[8][4]; float gl[8] = {0.f, 0.f, 0.f, 0.f, 0.f, 0.f, 0.f, 0.f}; f32x16_t S = zero16();
        auto prefetch = [&](int s, auto KC2) { constexpr int k = decltype(KC2)::value; const size_t u = unit_of(s);
            const bf16* kp = p.GKdT + u * 128 * 64 + (size_t)(rr * 256 + ln) * 8;
#pragma unroll
            for (int q = 0; q < 4; ++q) fb[k][q] = *(const bf16x8_t*)(kp + q * 512);
            gl[k] = p.GGL[u + zl]; };
        auto step = [&](int s, auto KC) { constexpr int k = decltype(KC)::value;
            if (s + 7 < NCH) prefetch(s + 7, std::integral_constant<int, (k + 7) % 8>{});
            const LAS bf16* vn = vnT + (s % 3) * 32 * GC_TS; LAS bf16* Sn = SbT + ((s + 1) & 3) * 32 * GC_KS;
            const float g1 = gl[k];
#pragma unroll
            for (int e = 0; e < 16; ++e) S[e] *= g1;
            LDS_BARRIER();
            bf16x8_t bq[4];
#pragma unroll
            for (int q = 0; q < 4; ++q) bq[q] = *(const LAS bf16x8_t*)(vn + r32 * GC_TS + 16 * q + 8 * hh);
#pragma unroll
            for (int q = 0; q < 4; ++q) S = __builtin_amdgcn_mfma_f32_32x32x16_bf16(fb[k][q], bq[q], S, 0, 0, 0);
#pragma unroll
            for (int a4 = 0; a4 < 4; ++a4) *(LAS vu2*)(Sn + r32 * GC_KS + 32 * rr + 8 * a4 + 4 * hh) = (vu2){cvtpk(S[4 * a4], S[4 * a4 + 1]), cvtpk(S[4 * a4 + 2], S[4 * a4 + 3])};
            LDS_BARRIER(); };
        using I4 = std::integral_constant<int, 4>; using I5 = std::integral_constant<int, 5>; using I6 = std::integral_constant<int, 6>; using I7 = std::integral_constant<int, 7>;
        prefetch(0, I0{}); prefetch(1, I1{}); prefetch(2, I2{}); prefetch(3, I3{}); prefetch(4, I4{}); prefetch(5, I5{}); prefetch(6, I6{});
        for (int s = 0; s + 7 < NCH; s += 8) { step(s, I0{}); step(s + 1, I1{}); step(s + 2, I2{}); step(s + 3, I3{}); step(s + 4, I4{}); step(s + 5, I5{}); step(s + 6, I6{}); step(s + 7, I7{}); }
        step(NCH - 4, I0{}); step(NCH - 3, I1{}); step(NCH - 2, I2{}); step(NCH - 1, I3{});
        __builtin_amdgcn_s_setprio(0);
    } else {
        int tr = tid; asm volatile("" : "+v"(tr)); const int ln = tr & 63, t = (tr >> 6) & 1;
        bf16x8_t fa[3][8], fb[3][4];
        auto prefetch = [&](int s, auto KC2) { constexpr int k = decltype(KC2)::value; const size_t u = unit_of(s);
            const bf16* qp = p.GQd + u * 64 * 128 + (size_t)(t * 512 + ln) * 8; const bf16* ap = p.GA + u * 64 * 64 + (size_t)(t * 256 + ln) * 8;
#pragma unroll
            for (int q = 0; q < 8; ++q) fa[k][q] = *(const bf16x8_t*)(qp + q * 512);
#pragma unroll
            for (int q = 0; q < 4; ++q) fb[k][q] = *(const bf16x8_t*)(ap + q * 512); };
        auto out_of = [&](int so, auto KC) { constexpr int k = decltype(KC)::value;
            const LAS bf16* Sc = SbT + (so & 3) * 32 * GC_KS; const LAS bf16* vn = vnT + (so % 3) * 32 * GC_TS;
            f32x16_t acc = zero16(), acc2 = zero16();
#pragma unroll
            for (int qh = 0; qh < 2; ++qh) { bf16x8_t bq[4];
#pragma unroll
                for (int q = 0; q < 4; ++q) bq[q] = *(const LAS bf16x8_t*)(Sc + r32 * GC_KS + 16 * (4 * qh + q) + 8 * hh);
#pragma unroll
                for (int q = 0; q < 4; q += 2) { acc = __builtin_amdgcn_mfma_f32_32x32x16_bf16(fa[k][4 * qh + q], bq[q], acc, 0, 0, 0); acc2 = __builtin_amdgcn_mfma_f32_32x32x16_bf16(fa[k][4 * qh + q + 1], bq[q + 1], acc2, 0, 0, 0); } }
            { bf16x8_t bv[4];
#pragma unroll
              for (int q = 0; q < 4; ++q) bv[q] = *(const LAS bf16x8_t*)(vn + r32 * GC_TS + 16 * q + 8 * hh);
#pragma unroll
              for (int q = 0; q < 4; q += 2) { acc = __builtin_amdgcn_mfma_f32_32x32x16_bf16(fb[k][q], bv[q], acc, 0, 0, 0); acc2 = __builtin_amdgcn_mfma_f32_32x32x16_bf16(fb[k][q + 1], bv[q + 1], acc2, 0, 0, 0); } }
            const int r0 = chunk_row0(b, chunk_of(so));
#pragma unroll
            for (int e = 0; e < 16; ++e) acc[e] += acc2[e];
            store_tile_rows(acc, otile, lane, [&](int il) { const int i = 32 * t + il; return p.OGb + ((size_t)dir * MROWS + r0 + (dir ? 63 - i : i)) * MIX_W + h * 128 + slice * 32; }); };
        auto step = [&](int s, auto KC) { constexpr int k = decltype(KC)::value;
            if (s > 1) out_of(s - 2, std::integral_constant<int, (k + 1) % 3>{});
            if (s + 1 < NCH) prefetch(s + 1, std::integral_constant<int, (k + 1) % 3>{});
            LDS_BARRIER(); LDS_BARRIER(); };
        prefetch(0, I0{});
        for (int s = 0; s + 2 < NCH; s += 3) { step(s, I0{}); step(s + 1, I1{}); step(s + 2, I2{}); }
        step(NCH - 2, std::integral_constant<int, (NCH - 2) % 3>{}); step(NCH - 1, std::integral_constant<int, (NCH - 1) % 3>{});
        out_of(NCH - 2, std::integral_constant<int, (NCH - 2) % 3>{}); out_of(NCH - 1, std::integral_constant<int, (NCH - 1) % 3>{});
    }
}
static_assert(G1_END <= 146432 && NCH % 8 == 4 && NCH % 3 == 2, "G1 LDS map / scan unroll");

constexpr int SSD_NU = BATCH * NCH * SSM_H * 2;
__device__ __forceinline__ int ssd_unit_index(int b, int c, int hd, int dir) { return ((b * NCH + c) * SSM_H + hd) * 2 + dir; }
constexpr int SL_BN = 0, SL_CN = SL_BN + 64 * GC_KS * 2, SL_CB = SL_CN + 64 * GC_KS * 2, SL_BT = SL_CB + 64 * GC_FS * 4, SL_XT = SL_BT + 128 * GC_TS * 2, SL_M = SL_XT + 256 * GC_TS * 2,
              SL_XW = SL_M + 64 * GC_TS * 2, SL_SM = SL_XW + 2 * 64 * GC_TS * 2, SL_END = SL_SM + 8 * 3 * 64 * 4;
static_assert(SL_END <= 146432, "ssd local LDS map");
constexpr int SSD_LOCAL_UNITS = BATCH * NCH * SSM_G * 2;
__device__ __forceinline__ void ssd_local_unit(const Ptrs& p, LAS unsigned char* lds, int unit, int tid) {
    const int lane = tid & 63, wave = tid >> 6, r32 = lane & 31, hh = lane >> 5;
    const int b = unit / (NCH * SSM_G * 2), c = (unit / (SSM_G * 2)) % NCH, g = (unit >> 1) % SSM_G, hq = unit & 1;
    const int r0 = chunk_row0(b, c), hd0 = g * SSM_HPG + hq * 4;
    LAS bf16* Bn = (LAS bf16*)(lds + SL_BN); LAS bf16* Cn = (LAS bf16*)(lds + SL_CN); LAS float* CBs = (LAS float*)(lds + SL_CB); LAS bf16* BT = (LAS bf16*)(lds + SL_BT);
    LAS bf16* XT = (LAS bf16*)(lds + SL_XT); LAS bf16* Mm = (LAS bf16*)(lds + SL_M); LAS bf16* XwT = (LAS bf16*)(lds + SL_XW); LAS float* sm = (LAS float*)(lds + SL_SM);
#pragma unroll
    for (int it = 0; it < 4; ++it) { const int idx = it * 512 + tid, row = idx >> 5, which = (idx >> 4) & 1, c8 = idx & 15;
        *(LAS vu4*)((which ? Cn : Bn) + row * GC_KS + c8 * 8) = *(const vu4*)(p.SBCb + (size_t)(r0 + row) * (2 * SSM_BC) + which * SSM_BC + g * SSM_N + c8 * 8); }
    { vu4 xv[4];
#pragma unroll
        for (int it = 0; it < 4; ++it) { const int idx = it * 512 + tid, j = idx >> 5, p8 = idx & 31; xv[it] = *(const vu4*)(p.SXb + (size_t)(r0 + j) * MIX_W + hd0 * SSM_P + p8 * 8); }
#pragma unroll
        for (int it = 0; it < 4; ++it) { const int idx = it * 512 + tid, j = idx >> 5, p8 = idx & 31; const unsigned w4[4] = {xv[it].x, xv[it].y, xv[it].z, xv[it].w};
#pragma unroll
            for (int e = 0; e < 4; ++e) { XT[(8 * p8 + 2 * e) * GC_TS + j] = (bf16)(w4[e] & 0xffffu); XT[(8 * p8 + 2 * e + 1) * GC_TS + j] = (bf16)(w4[e] >> 16); } } }
    { const int hd = hd0 + (wave >> 1), dir = wave & 1, n = dir ? 63 - lane : lane; const size_t gi = (size_t)(r0 + n) * 2 * SSM_H + dir * SSM_H + hd; const int u = ssd_unit_index(b, c, hd, dir);
        float x = p.SA[gi]; const float dt = p.SDT[gi];
#pragma unroll
        for (int o = 1; o < 64; o <<= 1) { const float y = __shfl_up(x, o); if (lane >= o) x += y; }
        const float x63 = __shfl(x, 63);
        sm[(wave * 3 + 0) * 64 + lane] = x; sm[(wave * 3 + 1) * 64 + lane] = dt; sm[(wave * 3 + 2) * 64 + lane] = __expf(x63 - x) * dt;
        p.SEAb[(size_t)u * 64 + lane] = f2bf(__expf(x)); if (lane == 63) p.SDC[u] = __expf(x); }
    LDS_BARRIER();
    *(vu4*)(p.SCF + ((((size_t)(b * NCH + c) * SSM_G + g) * 2 + hq) * 8 + wave) * 512 + lane * 8) = *(const LAS vu4*)(Cn + (32 * hq + r32) * GC_KS + 16 * wave + 8 * hh);
    if (wave < 4) { const int mt = wave >> 1, nt = wave & 1; f32x16_t acc = zero16(); acc = mma_lds<8>(acc, Cn + 32 * mt * GC_KS, GC_KS, Bn + 32 * nt * GC_KS, GC_KS, r32, hh);
#pragma unroll
        for (int e = 0; e < 16; ++e) CBs[(32 * mt + (e & 3) + 8 * (e >> 2) + 4 * hh) * GC_FS + 32 * nt + r32] = acc[e]; }
    else { for (int it = tid - 256; it < 128 * 8; it += 256) { const int s = it >> 3, j8 = it & 7; unsigned w[4];
#pragma unroll
            for (int e2 = 0; e2 < 4; ++e2) w[e2] = (unsigned)Bn[(j8 * 8 + 2 * e2) * GC_KS + s] | ((unsigned)Bn[(j8 * 8 + 2 * e2 + 1) * GC_KS + s] << 16);
            *(LAS vu4*)(BT + s * GC_TS + j8 * 8) = (vu4){w[0], w[1], w[2], w[3]}; } }
    LDS_BARRIER();
#pragma unroll 1
    for (int hl = 0; hl < 4; ++hl) {
        const int hd = hd0 + hl;
        const LAS float* ac0 = sm + (hl * 2 * 3) * 64; const LAS float* ac1 = ac0 + 3 * 64;
        { const int n = tid >> 3, n8 = tid & 7; unsigned w[4];
            const float a0n = ac0[n], a1n = ac1[63 - n];
#pragma unroll
            for (int e2 = 0; e2 < 4; ++e2) { float a[2];
#pragma unroll
                for (int q = 0; q < 2; ++q) { const int nj = n8 * 8 + 2 * e2 + q; const bool lo = nj <= n;
                    const float ex = __expf(lo ? a0n - ac0[nj] : a1n - ac1[63 - nj]);
                    const float dd = (nj < n) ? ac0[64 + nj] : (nj > n) ? ac1[64 + 63 - nj] : ac0[64 + nj] + ac1[64 + 63 - nj];
                    a[q] = CBs[n * GC_FS + nj] * ex * dd; }
                w[e2] = cvtpk(a[0], a[1]); }
            *(LAS vu4*)(Mm + n * GC_TS + n8 * 8) = (vu4){w[0], w[1], w[2], w[3]};
            const int pp = tid >> 3; float xs[8]; unpack8(*(const LAS vu4*)(XT + (hl * 64 + pp) * GC_TS + n8 * 8), xs);
#pragma unroll
            for (int e2 = 0; e2 < 4; ++e2) { const int nj = n8 * 8 + 2 * e2; w[e2] = cvtpk(xs[2 * e2] * ac0[128 + nj], xs[2 * e2 + 1] * ac0[128 + nj + 1]); }
            *(LAS vu4*)(XwT + pp * GC_TS + n8 * 8) = (vu4){w[0], w[1], w[2], w[3]};
#pragma unroll
            for (int e2 = 0; e2 < 4; ++e2) { const int nj = n8 * 8 + 2 * e2; w[e2] = cvtpk(xs[2 * e2] * ac1[128 + 63 - nj], xs[2 * e2 + 1] * ac1[128 + 62 - nj]); }
            *(LAS vu4*)(XwT + (64 + pp) * GC_TS + n8 * 8) = (vu4){w[0], w[1], w[2], w[3]}; }
        LDS_BARRIER();
#pragma unroll
        for (int dir = 0; dir < 2; ++dir) { const int sb = wave >> 1, pb = wave & 1, u = ssd_unit_index(b, c, hd, dir); f32x16_t acc = zero16();
            acc = mma_lds<4>(acc, BT + 32 * sb * GC_TS, GC_TS, XwT + (64 * dir + 32 * pb) * GC_TS, GC_TS, r32, hh);
            bf16* dst = p.SSC + (((size_t)u * 8 + wave) * 64 + lane) * 16;
            *(vu4*)dst = (vu4){cvtpk(acc[0], acc[1]), cvtpk(acc[2], acc[3]), cvtpk(acc[4], acc[5]), cvtpk(acc[6], acc[7])};
            *(vu4*)(dst + 8) = (vu4){cvtpk(acc[8], acc[9]), cvtpk(acc[10], acc[11]), cvtpk(acc[12], acc[13]), cvtpk(acc[14], acc[15])}; }
        if (wave < 4) { const int mt = wave >> 1, pb = wave & 1; f32x16_t acc = zero16(); acc = mma_lds<4>(acc, Mm + 32 * mt * GC_TS, GC_TS, XT + (hl * 64 + 32 * pb) * GC_TS, GC_TS, r32, hh);
#pragma unroll
            for (int e = 0; e < 16; ++e) { const int n = 32 * mt + (e & 3) + 8 * (e >> 2) + 4 * hh;
                p.OSb[((size_t)r0 + n) * MIX_W + hd * SSM_P + 32 * pb + r32] = f2bf(acc[e]); } }
        LDS_BARRIER();
    }
}
__device__ __forceinline__ void ssd_scan_wg(const Ptrs& p, LAS unsigned char* lds, int chain, int tid) {
    const int b = chain / (SSM_H * 2), hd = (chain >> 1) % SSM_H, dir = chain & 1, g = hd / SSM_HPG;
    const int lane = tid & 63, wave = tid >> 6, r32 = lane & 31, hh = lane >> 5;
    int zl = 0; asm volatile("v_mov_b32 %0, 0" : "=v"(zl));
    LAS bf16* hT = (LAS bf16*)lds;
    for (int i = tid; i < 64 * GC_KS / 2; i += 512) ((LAS unsigned*)hT)[i] = 0u;
    LDS_BARRIER();
    auto chunk_of = [&](int s) { return s < NCH_CTX ? (dir ? NCH_CTX - 1 - s : s) : NCH_CTX + (dir ? NCH - NCH_CTX - 1 - (s - NCH_CTX) : s - NCH_CTX); };
    using I0 = std::integral_constant<int, 0>; using I1 = std::integral_constant<int, 1>; using I2 = std::integral_constant<int, 2>; using I3 = std::integral_constant<int, 3>;
    if (wave >= 4) {
        __builtin_amdgcn_s_setprio(3);
        const int hw = wave - 4;
        f32x16_t h0 = zero16(), h1 = zero16();
        vu4 sc[4][4]; float dec[4] = {0.f, 0.f, 0.f, 0.f};
        auto pre_h = [&](int s, auto KC2) { constexpr int k = decltype(KC2)::value; const size_t u = (size_t)ssd_unit_index(b, chunk_of(s), hd, dir);
            const bf16* sp = p.SSC + ((u * 8 + 2 * hw) * 64 + lane) * 16; sc[k][0] = *(const vu4*)sp; sc[k][1] = *(const vu4*)(sp + 8); sc[k][2] = *(const vu4*)(sp + 1024); sc[k][3] = *(const vu4*)(sp + 1024 + 8); dec[k] = p.SDC[u + zl]; };
        auto step = [&](int s, auto KC) { constexpr int k = decltype(KC)::value;
            const unsigned w0[8] = {sc[k][0].x, sc[k][0].y, sc[k][0].z, sc[k][0].w, sc[k][1].x, sc[k][1].y, sc[k][1].z, sc[k][1].w}, w1[8] = {sc[k][2].x, sc[k][2].y, sc[k][2].z, sc[k][2].w, sc[k][3].x, sc[k][3].y, sc[k][3].z, sc[k][3].w};
            const float d1 = dec[k];
#pragma unroll
            for (int e2 = 0; e2 < 8; ++e2) { h0[2 * e2] = h0[2 * e2] * d1 + bflo(w0[e2]); h0[2 * e2 + 1] = h0[2 * e2 + 1] * d1 + bfhi(w0[e2]); h1[2 * e2] = h1[2 * e2] * d1 + bflo(w1[e2]); h1[2 * e2 + 1] = h1[2 * e2 + 1] * d1 + bfhi(w1[e2]); }
            if (s + 3 < NCH) pre_h(s + 3, std::integral_constant<int, (k + 3) % 4>{});
            LAS bf16* Hn = hT + ((s + 1) & 3) * 64 * GC_KS;
#pragma unroll
            for (int a4 = 0; a4 < 4; ++a4) { *(LAS vu2*)(Hn + r32 * GC_KS + 32 * hw + 8 * a4 + 4 * hh) = (vu2){cvtpk(h0[4 * a4], h0[4 * a4 + 1]), cvtpk(h0[4 * a4 + 2], h0[4 * a4 + 3])};
                *(LAS vu2*)(Hn + (32 + r32) * GC_KS + 32 * hw + 8 * a4 + 4 * hh) = (vu2){cvtpk(h1[4 * a4], h1[4 * a4 + 1]), cvtpk(h1[4 * a4 + 2], h1[4 * a4 + 3])}; }
            LDS_BARRIER(); };
        pre_h(0, I0{}); pre_h(1, I1{}); pre_h(2, I2{});
        for (int s = 0; s < NCH; s += 4) { step(s, I0{}); step(s + 1, I1{}); step(s + 2, I2{}); step(s + 3, I3{}); }
        __builtin_amdgcn_s_setprio(0);
    } else {
        const int mt = wave >> 1, pb = wave & 1;
        LAS bf16* otile = hT + 4 * 64 * GC_KS + wave * 32 * 40;
        bf16x8_t cf[3][8]; vu2 ea[3][4];
        auto pre_y = [&](int s, auto KC2) { constexpr int k = decltype(KC2)::value; const int c = chunk_of(s); const size_t u = (size_t)ssd_unit_index(b, c, hd, dir); const int r0 = chunk_row0(b, c);
            const bf16* cp = p.SCF + ((((size_t)(b * NCH + c) * SSM_G + g) * 2 + (dir ? 1 - mt : mt)) * 8) * 512 + (hh * 32 + (dir ? 31 - r32 : r32)) * 8;
#pragma unroll
            for (int q = 0; q < 8; ++q) cf[k][q] = *(const bf16x8_t*)(cp + q * 512);
#pragma unroll
            for (int a4 = 0; a4 < 4; ++a4) ea[k][a4] = *(const vu2*)(p.SEAb + u * 64 + 32 * mt + 8 * a4 + 4 * hh); };
        auto out_y = [&](int so, auto KC) { constexpr int k = decltype(KC)::value;
            const LAS bf16* Hc = hT + (so & 3) * 64 * GC_KS;
            f32x16_t acc = zero16(), acc2 = zero16();
#pragma unroll
            for (int qh = 0; qh < 2; ++qh) { bf16x8_t bq[4];
#pragma unroll
                for (int q = 0; q < 4; ++q) bq[q] = *(const LAS bf16x8_t*)(Hc + (32 * pb + r32) * GC_KS + 16 * (4 * qh + q) + 8 * hh);
#pragma unroll
                for (int q = 0; q < 4; q += 2) { acc = __builtin_amdgcn_mfma_f32_32x32x16_bf16(cf[k][4 * qh + q], bq[q], acc, 0, 0, 0); acc2 = __builtin_amdgcn_mfma_f32_32x32x16_bf16(cf[k][4 * qh + q + 1], bq[q + 1], acc2, 0, 0, 0); } }
            const int r0 = chunk_row0(b, chunk_of(so));
#pragma unroll
            for (int e = 0; e < 16; ++e) { const unsigned ew = (e & 2) ? ea[k][e >> 2].y : ea[k][e >> 2].x; const float ev = (e & 1) ? bfhi(ew) : bflo(ew); acc[e] = ev * (acc[e] + acc2[e]); }
            store_tile_rows(acc, otile, lane, [&](int il) { const int i = 32 * mt + il; return p.OSb2 + ((size_t)dir * MROWS + r0 + (dir ? 63 - i : i)) * MIX_W + hd * SSM_P + 32 * pb; }); };
        auto step = [&](int s, auto KC) { constexpr int k = decltype(KC)::value;
            if (s > 1) out_y(s - 2, std::integral_constant<int, (k + 1) % 3>{});
            if (s + 1 < NCH) pre_y(s + 1, std::integral_constant<int, (k + 1) % 3>{});
            LDS_BARRIER(); };
        pre_y(0, I0{});
        for (int s = 0; s + 2 < NCH; s += 3) { step(s, I0{}); step(s + 1, I1{}); step(s + 2, I2{}); }
        step(NCH - 2, std::integral_constant<int, (NCH - 2) % 3>{}); step(NCH - 1, std::integral_constant<int, (NCH - 1) % 3>{});
        out_y(NCH - 2, std::integral_constant<int, (NCH - 2) % 3>{}); out_y(NCH - 1, std::integral_constant<int, (NCH - 1) % 3>{});
    }
}


namespace pg8 {
struct EpiInProj {
    static constexpr bool PERM = true, AFTER_DRAIN = false, KHOOK = false;
    bf16_t* P; float* PF;
    __device__ __forceinline__ void operator()(const f32x4 (&acc)[2][2][4][2], const Unit& u, int wr, int wc, int fr, int fq) const {
        const int row0 = u.pm * BM + wr * 64 + fr;
        if (u.pn * BM < NP_MAIN) {
            const int col0 = u.pn * BM + wc * 32 + 8 * fq;
#pragma unroll
            for (int ai = 0; ai < 2; ++ai)
#pragma unroll
                for (int m = 0; m < 4; ++m) { bf16_t* rowp = P + (size_t)(row0 + ai * HALF + m * 16) * NP_MAIN + col0;
#pragma unroll
                    for (int bj = 0; bj < 2; ++bj) { const f32x4 v0 = acc[ai][bj][m][0], v1 = acc[ai][bj][m][1];
                        u32x4 w; w.x = cvt_pk_bf16(v0[0], v0[1]); w.y = cvt_pk_bf16(v0[2], v0[3]); w.z = cvt_pk_bf16(v1[0], v1[1]); w.w = cvt_pk_bf16(v1[2], v1[3]);
                        *(u32x4*)(rowp + bj * HALF) = w; } }
        } else {
#pragma unroll
            for (int ai = 0; ai < 2; ++ai)
#pragma unroll
                for (int m = 0; m < 4; ++m) { float* rowp = PF + (size_t)(row0 + ai * HALF + m * 16) * PF_N;
#pragma unroll
                    for (int bj = 0; bj < 2; ++bj) { const int c = bj * HALF + wc * 32 + 8 * fq;
                        if (c < PF_N) { *(f32x4*)(rowp + c) = acc[ai][bj][m][0]; *(f32x4*)(rowp + c + 4) = acc[ai][bj][m][1]; } } }
        }
    }
};
struct EpiMerge {
    static constexpr bool PERM = true, AFTER_DRAIN = false, KHOOK = false;
    const bf16_t* G0; bf16_t* TB;
    __device__ __forceinline__ void operator()(const f32x4 (&acc)[2][2][4][2], const Unit& u, int wr, int wc, int fr, int fq) const {
        const int row0 = u.pm * BM + wr * 64 + fr, col0 = u.pn * BM + wc * 32 + 8 * fq, br = u.pk / MIX_W; const bf16_t* G = G0 + br * D_MODEL;
#pragma unroll
        for (int ai = 0; ai < 2; ++ai)
#pragma unroll
            for (int m = 0; m < 4; ++m) { const size_t row = (size_t)(row0 + ai * HALF + m * 16);
#pragma unroll
                for (int bj = 0; bj < 2; ++bj) { const int col = col0 + bj * HALF;
                    const u32x4 gw = *(const u32x4*)(G + row * NP_MAIN + col);
                    float gt[8];
#pragma unroll
                    for (int j = 0; j < 4; ++j) { gt[2 * j] = __uint_as_float(gw[j] << 16); gt[2 * j + 1] = __uint_as_float(gw[j] & 0xffff0000u); }
                    f32x4 t0, t1;
#pragma unroll
                    for (int j = 0; j < 4; ++j) { t0[j] = acc[ai][bj][m][0][j] * __builtin_amdgcn_rcpf(1.0f + __expf(-gt[j])); t1[j] = acc[ai][bj][m][1][j] * __builtin_amdgcn_rcpf(1.0f + __expf(-gt[4 + j])); }
                    u32x4 w; w.x = cvt_pk_bf16(t0[0], t0[1]); w.y = cvt_pk_bf16(t0[2], t0[3]); w.z = cvt_pk_bf16(t1[0], t1[1]); w.w = cvt_pk_bf16(t1[2], t1[3]);
                    *(u32x4*)(TB + ((size_t)br * NCTX + (row - NLAT)) * D_MODEL + col) = w; } }
    }
};
struct EpiF32Plain {
    static constexpr bool PERM = false, AFTER_DRAIN = false, KHOOK = false;
    float* C; int ldc;
    __device__ __forceinline__ void operator()(const f32x4 (&acc)[2][2][4][2], const Unit& u, int wr, int wc, int fr, int fq) const {
        const int row0 = u.pm * BM + wr * 64 + fr, col0 = u.pn * BM + wc * 32 + 4 * fq;
#pragma unroll
        for (int ai = 0; ai < 2; ++ai)
#pragma unroll
            for (int m = 0; m < 4; ++m) { float* rowp = C + (size_t)(row0 + ai * HALF + m * 16) * ldc + col0;
#pragma unroll
                for (int bj = 0; bj < 2; ++bj)
#pragma unroll
                    for (int n = 0; n < 2; ++n) *(f32x4*)(rowp + bj * HALF + n * 16) = acc[ai][bj][m][n]; }
    }
};
struct EpiBf16Plain {
    static constexpr bool PERM = true, AFTER_DRAIN = false, KHOOK = false;
    bf16_t* O; int ldc;
    __device__ __forceinline__ void operator()(const f32x4 (&acc)[2][2][4][2], const Unit& u, int wr, int wc, int fr, int fq) const {
        const int row0 = u.pm * BM + wr * 64 + fr, col0 = u.pn * BM + wc * 32 + 8 * fq;
#pragma unroll
        for (int ai = 0; ai < 2; ++ai)
#pragma unroll
            for (int m = 0; m < 4; ++m) { bf16_t* rowp = O + (size_t)(row0 + ai * HALF + m * 16) * ldc + col0;
#pragma unroll
                for (int bj = 0; bj < 2; ++bj) { const f32x4 v0 = acc[ai][bj][m][0], v1 = acc[ai][bj][m][1];
                    u32x4 w; w.x = cvt_pk_bf16(v0[0], v0[1]); w.y = cvt_pk_bf16(v0[2], v0[3]); w.z = cvt_pk_bf16(v1[0], v1[1]); w.w = cvt_pk_bf16(v1[2], v1[3]);
                    *(u32x4*)(rowp + bj * HALF) = w; } }
    }
};

struct EpiAct {
    static constexpr bool PERM = true, AFTER_DRAIN = false, KHOOK = false;
    bf16_t* ACT; float* BP; bf16_t* BU; bf16_t* BG; const float* cw; const float* cb;
    __device__ __forceinline__ void operator()(const f32x4 (&acc)[2][2][4][2], const Unit& u, int wr, int wc, int fr, int fq) const {
        const int lp = (fq * 16 + ((fr + 15) & 15)) * 4, ln = (fq * 16 + ((fr + 1) & 15)) * 4;
#pragma unroll
        for (int n = 0; n < 2; ++n) {
            const int j0 = u.pn * 128 + wc * 32 + 8 * fq + 4 * n;
            const f32x4 w0 = *(const f32x4*)(cw + j0), w1 = *(const f32x4*)(cw + D_FF + j0), w2 = *(const f32x4*)(cw + 2 * D_FF + j0), bs = *(const f32x4*)(cb + j0);
#pragma unroll
            for (int ai = 0; ai < 2; ++ai) {
#pragma unroll
                for (int m = 0; m < 4; ++m) {
                    const int row = u.pm * BM + ai * HALF + wr * 64 + m * 16 + fr;
                    const bool hp = !(m == 0 && fr == 0), hn = !(m == 3 && fr == 15);
                    f32x4 gp, gn;
#pragma unroll
                    for (int e = 0; e < 4; ++e) { const float gc = acc[ai][1][m][n][e], gm = acc[ai][1][m > 0 ? m - 1 : 0][n][e], gq = acc[ai][1][m < 3 ? m + 1 : 3][n][e];
                        gp[e] = __int_as_float(__builtin_amdgcn_ds_bpermute(lp, __float_as_int(fr == 15 ? gm : gc)));
                        gn[e] = __int_as_float(__builtin_amdgcn_ds_bpermute(ln, __float_as_int(fr == 0 ? gq : gc))); }
                    const f32x4 g = acc[ai][1][m][n], uu = acc[ai][0][m][n];
                    f32x4 pre = w1 * g + bs;
                    if (hp) pre += w0 * gp;
                    if (hn) pre += w2 * gn;
                    if (hp && hn) {
                        f32x4 a;
#pragma unroll
                        for (int e = 0; e < 4; ++e) a[e] = pre[e] * __builtin_amdgcn_rcpf(1.0f + __expf(-pre[e])) * uu[e];
                        typedef unsigned u32x2 __attribute__((ext_vector_type(2)));
                        u32x2 w; w.x = cvt_pk_bf16(a[0], a[1]); w.y = cvt_pk_bf16(a[2], a[3]);
                        *(u32x2*)(ACT + (size_t)row * D_FF + j0) = w;
                    } else {
                        const size_t bi = (size_t)((row >> 6) * 2 + ((row & 63) == 63 ? 1 : 0)) * D_FF + j0;
                        typedef unsigned u32x2 __attribute__((ext_vector_type(2)));
                        *(f32x4*)(BP + bi) = pre;
                        u32x2 wu; wu.x = cvt_pk_bf16(uu[0], uu[1]); wu.y = cvt_pk_bf16(uu[2], uu[3]); *(u32x2*)(BU + bi) = wu;
                        u32x2 wg; wg.x = cvt_pk_bf16(g[0], g[1]); wg.y = cvt_pk_bf16(g[2], g[3]); *(u32x2*)(BG + bi) = wg;
                    }
                }
            }
        }
    }
};

constexpr int SPLIT_KS = 512, OUT_NS = D_MODEL / SPLIT_KS, DOWN_NS = D_FF / SPLIT_KS;
static_assert(D_MODEL % SPLIT_KS == 0 && D_FF % SPLIT_KS == 0 && NCTX % 256 == 0, "split-K context units");
struct SplitOrder {
    int ns, G, c;
    __device__ __forceinline__ bool next(int i, Unit& u) const { const int L = i * G + c; if (L >= (NCTX / 256) * (D_MODEL / 256) * ns) return false;
        const int ks = L % ns, tile = L / ns; u.pm = NLAT / 256 + tile / (D_MODEL / 256); u.pn = tile % (D_MODEL / 256); u.pk = ks * SPLIT_KS; return true; }
    __device__ __forceinline__ void a_ready(const Unit&) const {}
    __device__ __forceinline__ void done(const Unit&) const {}
};
struct SplitOrder3 {
    int G, c;
    __device__ __forceinline__ bool next(int i, Unit& u) const { const int L = i * G + c; constexpr int NT = (NCTX / 256) * (D_MODEL / 256); if (L >= NT * 3 * OUT_NS) return false;
        const int ks = L % OUT_NS, br = (L / OUT_NS) % 3, tile = L / (3 * OUT_NS); u.pm = br * (NCTX / 256) + tile / (D_MODEL / 256); u.pn = tile % (D_MODEL / 256); u.pk = ks * SPLIT_KS; return true; }
    __device__ __forceinline__ void a_ready(const Unit&) const {}
    __device__ __forceinline__ void done(const Unit&) const {}
};
struct EpiSlab3 {
    static constexpr bool PERM = false, AFTER_DRAIN = false, KHOOK = false;
    float* S;
    __device__ __forceinline__ void operator()(const f32x4 (&acc)[2][2][4][2], const Unit& u, int wr, int wc, int fr, int fq) const {
        const int br = u.pm / (NCTX / 256), ct = u.pm % (NCTX / 256);
        const int row0 = ct * BM + wr * 64 + fr, col0 = u.pn * BM + wc * 32 + 4 * fq; float* base = S + (size_t)(br * OUT_NS + u.pk / SPLIT_KS) * NCTX * D_MODEL;
#pragma unroll
        for (int ai = 0; ai < 2; ++ai)
#pragma unroll
            for (int m = 0; m < 4; ++m) { float* rowp = base + (size_t)(row0 + ai * HALF + m * 16) * D_MODEL + col0;
#pragma unroll
                for (int bj = 0; bj < 2; ++bj)
#pragma unroll
                    for (int n = 0; n < 2; ++n) *(f32x4*)(rowp + bj * HALF + n * 16) = acc[ai][bj][m][n]; }
    }
};

struct EpiMerge3 {
    static constexpr bool PERM = true, AFTER_DRAIN = false, KHOOK = true;
    const bf16_t* G0; bf16_t* MB;
    __device__ __forceinline__ void khook(f32x4 (&acc)[2][2][4][2], const Unit& u, int t, int wr, int wc, int fr, int fq) const {
        if (t != MIX_W / BK && t != 2 * MIX_W / BK) return;
        const int bp = t / (MIX_W / BK) - 1;
        const int row0 = u.pm * BM + wr * 64 + fr, col0 = u.pn * BM + wc * 32 + 8 * fq; const bf16_t* Gp = G0 + bp * D_MODEL;
#pragma unroll
        for (int ai = 0; ai < 2; ++ai) {
            asm volatile("" ::: "memory");
#pragma unroll
            for (int m = 0; m < 4; ++m) { const unsigned rowo = (unsigned)(row0 + ai * HALF + m * 16) * (unsigned)NP_MAIN;
#pragma unroll
                for (int bj = 0; bj < 2; ++bj) { const unsigned off = rowo + (unsigned)(col0 + bj * HALF);
                    const u32x4 gp = *(const u32x4*)(Gp + off), gn = *(const u32x4*)(Gp + D_MODEL + off);
#pragma unroll
                    for (int j = 0; j < 4; ++j) { const float p0 = __uint_as_float(gp[j] << 16), p1 = __uint_as_float(gp[j] & 0xffff0000u), n0 = __uint_as_float(gn[j] << 16), n1 = __uint_as_float(gn[j] & 0xffff0000u);
                        const float r0 = (1.0f + __expf(-n0)) * __builtin_amdgcn_rcpf(1.0f + __expf(-p0)), r1 = (1.0f + __expf(-n1)) * __builtin_amdgcn_rcpf(1.0f + __expf(-p1));
                        if (j < 2) { acc[ai][bj][m][0][2 * j] *= r0; acc[ai][bj][m][0][2 * j + 1] *= r1; } else { acc[ai][bj][m][1][2 * (j - 2)] *= r0; acc[ai][bj][m][1][2 * (j - 2) + 1] *= r1; } } } } }
    }
    __device__ __forceinline__ void operator()(const f32x4 (&acc)[2][2][4][2], const Unit& u, int wr, int wc, int fr, int fq) const {
        const int row0 = u.pm * BM + wr * 64 + fr, col0 = u.pn * BM + wc * 32 + 8 * fq; const bf16_t* G = G0 + 2 * D_MODEL;
#pragma unroll
        for (int ai = 0; ai < 2; ++ai)
#pragma unroll
            for (int m = 0; m < 4; ++m) { const size_t row = (size_t)(row0 + ai * HALF + m * 16);
#pragma unroll
                for (int bj = 0; bj < 2; ++bj) { const int col = col0 + bj * HALF;
                    const u32x4 gw = *(const u32x4*)(G + row * NP_MAIN + col);
                    float gt[8];
#pragma unroll
                    for (int j = 0; j < 4; ++j) { gt[2 * j] = __uint_as_float(gw[j] << 16); gt[2 * j + 1] = __uint_as_float(gw[j] & 0xffff0000u); }
                    f32x4 t0, t1;
#pragma unroll
                    for (int j = 0; j < 4; ++j) { t0[j] = acc[ai][bj][m][0][j] * __builtin_amdgcn_rcpf(1.0f + __expf(-gt[j])); t1[j] = acc[ai][bj][m][1][j] * __builtin_amdgcn_rcpf(1.0f + __expf(-gt[4 + j])); }
                    u32x4 w; w.x = cvt_pk_bf16(t0[0], t0[1]); w.y = cvt_pk_bf16(t0[2], t0[3]); w.z = cvt_pk_bf16(t1[0], t1[1]); w.w = cvt_pk_bf16(t1[2], t1[3]);
                    *(u32x4*)(MB + row * D_MODEL + col) = w; } }
    }
};
struct CtxMergeOrder {
    int c;
    __device__ __forceinline__ bool next(int i, Unit& u) const { if (i > 0 || c >= 3 * (NCTX / 256) * (D_MODEL / 256)) return false;
        const int tile = c / 3; u.pm = NLAT / 256 + tile / (D_MODEL / 256); u.pn = tile % (D_MODEL / 256); u.pk = (c % 3) * MIX_W; return true; }
    __device__ __forceinline__ void a_ready(const Unit&) const {}
    __device__ __forceinline__ void done(const Unit&) const {}
};
struct EpiSlab {
    static constexpr bool PERM = false, AFTER_DRAIN = false, KHOOK = false;
    float* S;
    __device__ __forceinline__ void operator()(const f32x4 (&acc)[2][2][4][2], const Unit& u, int wr, int wc, int fr, int fq) const {
        const int row0 = (u.pm * BM - NLAT) + wr * 64 + fr, col0 = u.pn * BM + wc * 32 + 4 * fq; float* base = S + (size_t)(u.pk / SPLIT_KS) * NCTX * D_MODEL;
#pragma unroll
        for (int ai = 0; ai < 2; ++ai)
#pragma unroll
            for (int m = 0; m < 4; ++m) { float* rowp = base + (size_t)(row0 + ai * HALF + m * 16) * D_MODEL + col0;
#pragma unroll
                for (int bj = 0; bj < 2; ++bj)
#pragma unroll
                    for (int n = 0; n < 2; ++n) *(f32x4*)(rowp + bj * HALF + n * 16) = acc[ai][bj][m][n]; }
    }
};
}

constexpr size_t al256(size_t x) { return (x + 255) & ~(size_t)255; }
constexpr size_t WS_CTL = 0, CTL_BYTES = 1u << 20;
constexpr size_t WS_WIN = WS_CTL + CTL_BYTES;
constexpr size_t WS_WBR = WS_WIN + al256((size_t)DEPTH * NP_PAD * D_MODEL * 2);
constexpr size_t WS_WOUT = WS_WBR + al256((size_t)DEPTH * 3 * D_MODEL * MIX_W * 2);
constexpr size_t WS_WUP = WS_WOUT + al256((size_t)DEPTH * D_MODEL * D_MODEL * 2);
constexpr size_t WS_WDOWN = WS_WUP + al256((size_t)DEPTH * 2 * D_FF * D_MODEL * 2);
constexpr size_t WS_MOD = WS_WDOWN + al256((size_t)DEPTH * D_MODEL * D_FF * 2);
constexpr size_t WS_X = WS_MOD + al256((size_t)DEPTH * (BATCH + 1) * D6 * 4 + GRID_W * 32 * 2 * 4);
constexpr size_t WS_H = WS_X + al256((size_t)MROWS * D_MODEL * 4);
constexpr size_t WS_MIX = WS_H + al256((size_t)MROWS * D_MODEL * 2);
constexpr size_t WS_SLAB = WS_MIX + al256((size_t)MROWS * D_MODEL * 4);
constexpr size_t WS_TB = WS_SLAB + al256((size_t)(D_FF / 512 > 12 ? D_FF / 512 : 12) * NCTX * D_MODEL * 4);
constexpr size_t WS_R = WS_TB + al256((size_t)3 * NCTX * D_MODEL * 2);
constexpr size_t WS_P = WS_R;
constexpr size_t WS_PF = WS_P + al256((size_t)MROWS * NP_MAIN * 2);
constexpr size_t WS_GQKV = WS_PF + al256((size_t)MROWS * PF_N * 4);
#if defined(TOKEN_GDN) || defined(NAIVE_PREP)
constexpr size_t WS_GG = WS_GQKV + al256((size_t)MROWS * 3 * MIX_W * 4);
#else
constexpr size_t WS_GG = WS_GQKV + 256;
#endif
constexpr size_t WS_GB = WS_GG + al256((size_t)MROWS * 2 * GDN_H * 4);
constexpr size_t WS_SXBC = WS_GB + al256((size_t)MROWS * 2 * GDN_H * 4);
#if defined(TOKEN_SSD) || defined(NAIVE_PREP)
constexpr size_t WS_SDT = WS_SXBC + al256((size_t)MROWS * SSM_XBC * 4);
#else
constexpr size_t WS_SDT = WS_SXBC + 256;
#endif
constexpr size_t WS_SA = WS_SDT + al256((size_t)MROWS * 2 * SSM_H * 4);
constexpr size_t WS_AQ = WS_SA + al256((size_t)MROWS * 2 * SSM_H * 4);
#ifdef NAIVE_ATTN
constexpr size_t WS_AK = WS_AQ + al256((size_t)MROWS * MIX_W * 4);
constexpr size_t WS_OG = WS_AK + al256((size_t)MROWS * ATT_HKV * 128 * 4);
#else
constexpr size_t WS_AK = WS_AQ + 256;
constexpr size_t WS_OG = WS_AK + 256;
#endif
#if defined(TOKEN_GDN) || defined(TOKEN_SSD) || defined(NAIVE_MIXOUT)
constexpr size_t WS_OS = WS_OG + al256((size_t)2 * MROWS * MIX_W * 4);
constexpr size_t WS_SC = WS_OS + al256((size_t)2 * MROWS * MIX_W * 4);
#else
constexpr size_t WS_OS = WS_OG + 256;
constexpr size_t WS_SC = WS_OS + 256;
#endif
#ifdef NAIVE_ATTN
constexpr size_t WS_YA = WS_SC + al256((size_t)MROWS * ATT_HQ * SC_LD * 4);
#else
constexpr size_t WS_YA = WS_SC + 256;
#endif
constexpr size_t WS_YB = WS_YA + al256((size_t)MROWS * MIX_W * 2);
constexpr size_t WS_YC = WS_YB + al256((size_t)MROWS * MIX_W * 2);
constexpr size_t WS_M32 = WS_YC + al256((size_t)MROWS * MIX_W * 2);
constexpr size_t WS_MB = WS_M32 + al256((size_t)MROWS * D_MODEL * 4);
constexpr size_t WS_AQB = WS_MB + al256((size_t)MROWS * D_MODEL * 2);
constexpr size_t WS_AKB = WS_AQB + al256((size_t)MROWS * MIX_W * 2);
constexpr size_t GDN_NU_H = (size_t)BATCH * (CHAIN_LEN / 64) * GDN_H * 2;
constexpr size_t WS_GW = WS_AKB + al256((size_t)MROWS * ATT_HKV * 128 * 2);
constexpr size_t WS_GQD = WS_GW + al256(GDN_NU_H * 64 * 128 * 2);
constexpr size_t WS_GKDT = WS_GQD + al256(GDN_NU_H * 64 * 128 * 2);
constexpr size_t WS_GA = WS_GKDT + al256(GDN_NU_H * 128 * 64 * 2);
constexpr size_t WS_GUT = WS_GA + al256(GDN_NU_H * 64 * 64 * 2);
constexpr size_t WS_GGL = WS_GUT + al256(GDN_NU_H * 128 * 64 * 2);
constexpr size_t SSD_NU_H = (size_t)BATCH * (CHAIN_LEN / 64) * SSM_H * 2;
constexpr size_t WS_SBCB = WS_GGL + al256(GDN_NU_H * 4);
constexpr size_t WS_SSC = WS_SBCB + al256((size_t)MROWS * 2 * SSM_BC * 2);
constexpr size_t WS_SEA = WS_SSC + al256(SSD_NU_H * 8 * 64 * 16 * 2);
constexpr size_t WS_SDC = WS_SEA + al256(SSD_NU_H * 64 * 4);
constexpr size_t WS_OGB = WS_SDC + al256(SSD_NU_H * 4);
constexpr size_t WS_OSB = WS_OGB + al256((size_t)2 * MROWS * MIX_W * 2);
constexpr size_t WS_OSB2 = WS_OSB + al256((size_t)2 * MROWS * MIX_W * 2);
constexpr size_t WS_GQKVB = WS_OSB2 + al256((size_t)2 * MROWS * MIX_W * 2);
constexpr size_t WS_SXB = WS_GQKVB + al256((size_t)MROWS * 3 * MIX_W * 2);
constexpr size_t WS_SCF = WS_SXB + al256((size_t)MROWS * MIX_W * 2);
constexpr size_t WS_END_MIX = WS_SCF + al256((size_t)BATCH * (CHAIN_LEN / 64) * SSM_G * 2 * 8 * 512 * 2);
constexpr size_t NBND = (size_t)MROWS / 64 * 2;
constexpr size_t WS_BP = WS_R;
constexpr size_t WS_BU = WS_BP + al256(NBND * D_FF * 4);
constexpr size_t WS_BG = WS_BU + al256(NBND * D_FF * 2);
constexpr size_t WS_ACT = WS_BG + al256(NBND * D_FF * 2);
constexpr size_t WS_END_FFN = WS_ACT + al256((size_t)MROWS * D_FF * 2);
constexpr size_t WS_NEED = WS_END_MIX > WS_END_FFN ? WS_END_MIX : WS_END_FFN;

constexpr int NWAVES = 8, NTHREADS = NWAVES * 64;
#ifndef ATT_EARLY_N
#define ATT_EARLY_N 0
#endif
constexpr int ATT_EARLY = ATT_EARLY_N;
static_assert(ATT_EARLY <= ATT_UNITS_LAT, "early attention units are latent units");
constexpr int RING_BYTES = 131072, LDS_BYTES = 147456, MISC_OFF = LDS_BYTES - 1024;

enum { ST_INPROJ = 0, ST_PREP, ST_G1, ST_MIX, ST_MIXOUT, ST_MERGE, ST_OUT, ST_NORM2, ST_UP, ST_ACT, ST_DOWN, ST_NORM3, NSTEP };
constexpr int STEP0 = 2;
constexpr int TOTAL_STEPS = STEP0 + DEPTH * NSTEP;
#ifndef MK_LAUNCH_MODE
#define MK_LAUNCH_MODE 1
#endif

struct Args { Ptrs p; unsigned* ctl; int step_lo, step_hi; };
typedef const __attribute__((address_space(4))) Args* KArgs;
__device__ __forceinline__ KArgs fresh_args() { KArgs k = (KArgs)__builtin_amdgcn_kernarg_segment_ptr(); asm volatile("" : "+s"(k)); return k; }
#if defined(__HIP_DEVICE_COMPILE__)
#define PTRS() const Ptrs p = fresh_args()->p; int lane; asm volatile("v_mbcnt_lo_u32_b32 %0, -1, 0\n\tv_mbcnt_hi_u32_b32 %0, -1, %0" : "=v"(lane)); const int wave = wave_s; const int tid = wave * 64 + lane; \
    const size_t gtid = (size_t)blockIdx.x * NTHREADS + tid, NT = (size_t)G * NTHREADS; const int gwave = (int)blockIdx.x * NWAVES + wave, NGW = G * NWAVES; (void)lane; (void)wave; (void)gtid; (void)NT; (void)gwave; (void)NGW
#else
#define PTRS() const Ptrs p = a.p; const int tid = 0, lane = 0, wave = 0, gwave = 0, NGW = 1; const size_t gtid = 0, NT = 1; (void)tid; (void)lane; (void)wave; (void)gtid; (void)NT; (void)gwave; (void)NGW
#endif

constexpr int WT_I_IN = (D_MODEL / 64) * (P_IN / 32), WT_I_BR = (MIX_W / 64) * (D_MODEL / 32), WT_I_OUT = (D_MODEL / 64) * (D_MODEL / 32), WT_I_UP = (D_MODEL / 64) * (2 * D_FF / 32), WT_I_DN = (D_FF / 64) * (D_MODEL / 32);
constexpr int WT_I_ALL = WT_I_IN + 3 * WT_I_BR + WT_I_OUT + WT_I_UP + WT_I_DN;
template <class PT> __device__ __forceinline__ void weight_item(const PT& p, int l, int it, LAS float* scr, int lane) {
    int r = it;
    if (r < WT_I_IN) { const int nblk = P_IN / 32, k0 = 64 * (r / nblk), n0 = 32 * (r % nblk);
        transpose_item(p.w_in + (size_t)l * D_MODEL * P_IN, D_MODEL, P_IN, p.Wt_in + (size_t)l * NP_PAD * D_MODEL, k0, n0, inproj_dst_row0(n0), scr, lane); return; } r -= WT_I_IN;
    if (r < 3 * WT_I_BR) { const int br = r / WT_I_BR; r -= br * WT_I_BR; const int nblk = D_MODEL / 32, k0 = 64 * (r / nblk), n0 = 32 * (r % nblk);
        const float* w = (br == 0 ? p.w_br_a : br == 1 ? p.w_br_b : p.w_br_c) + (size_t)l * MIX_W * D_MODEL;
        transpose_item(w, 3 * MIX_W, D_MODEL, p.Wt_br + (size_t)l * 3 * D_MODEL * MIX_W + br * MIX_W, k0, n0, n0, scr, lane); return; } r -= 3 * WT_I_BR;
    if (r < WT_I_OUT) { const int nblk = D_MODEL / 32, k0 = 64 * (r / nblk), n0 = 32 * (r % nblk);
        transpose_item(p.w_out + (size_t)l * D_MODEL * D_MODEL, D_MODEL, D_MODEL, p.Wt_out + (size_t)l * D_MODEL * D_MODEL, k0, n0, n0, scr, lane); return; } r -= WT_I_OUT;
    if (r < WT_I_UP) { const int nblk = 2 * D_FF / 32, k0 = 64 * (r / nblk), n0 = 32 * (r % nblk);
        transpose_item(p.w_up + (size_t)l * D_MODEL * 2 * D_FF, D_MODEL, 2 * D_FF, p.Wt_up + (size_t)l * 2 * D_FF * D_MODEL, k0, n0, up_dst_row0(n0), scr, lane); return; } r -= WT_I_UP;
    { const int nblk = D_MODEL / 32, k0 = 64 * (r / nblk), n0 = 32 * (r % nblk);
        transpose_item(p.w_down + (size_t)l * D_FF * D_MODEL, D_FF, D_MODEL, p.Wt_down + (size_t)l * D_MODEL * D_FF, k0, n0, n0, scr, lane); }
}
template <class PT> __device__ __forceinline__ WtDesc weight_desc(const PT& p, int l, int it) {
    int r = it;
    if (r < WT_I_IN) { const int nblk = P_IN / 32, k0 = 64 * (r / nblk), n0 = 32 * (r % nblk); return WtDesc{p.w_in + (size_t)l * D_MODEL * P_IN, p.Wt_in + (size_t)l * NP_PAD * D_MODEL, D_MODEL, P_IN, k0, n0, inproj_dst_row0(n0)}; } r -= WT_I_IN;
    if (r < 3 * WT_I_BR) { const int br = r / WT_I_BR; r -= br * WT_I_BR; const int nblk = D_MODEL / 32, k0 = 64 * (r / nblk), n0 = 32 * (r % nblk);
        const float* w = (br == 0 ? p.w_br_a : br == 1 ? p.w_br_b : p.w_br_c) + (size_t)l * MIX_W * D_MODEL;
        return WtDesc{w, p.Wt_br + (size_t)l * 3 * D_MODEL * MIX_W + br * MIX_W, 3 * MIX_W, D_MODEL, k0, n0, n0}; } r -= 3 * WT_I_BR;
    if (r < WT_I_OUT) { const int nblk = D_MODEL / 32, k0 = 64 * (r / nblk), n0 = 32 * (r % nblk); return WtDesc{p.w_out + (size_t)l * D_MODEL * D_MODEL, p.Wt_out + (size_t)l * D_MODEL * D_MODEL, D_MODEL, D_MODEL, k0, n0, n0}; } r -= WT_I_OUT;
    if (r < WT_I_UP) { const int nblk = 2 * D_FF / 32, k0 = 64 * (r / nblk), n0 = 32 * (r % nblk); return WtDesc{p.w_up + (size_t)l * D_MODEL * 2 * D_FF, p.Wt_up + (size_t)l * 2 * D_FF * D_MODEL, D_MODEL, 2 * D_FF, k0, n0, up_dst_row0(n0)}; } r -= WT_I_UP;
    { const int nblk = D_MODEL / 32, k0 = 64 * (r / nblk), n0 = 32 * (r % nblk); return WtDesc{p.w_down + (size_t)l * D_FF * D_MODEL, p.Wt_down + (size_t)l * D_MODEL * D_FF, D_FF, D_MODEL, k0, n0, n0}; }
}
constexpr int FILL_A0 = ((MROWS / 256) * (NP_PAD / 256)) % 256, FILL_B0 = 3 * (NCTX / 256) * (D_MODEL / 256), FILL_C0 = ((MROWS / 256) * (2 * D_FF / 256)) % 256;
#ifndef FILL_NA
#define FILL_NA 14
#endif
#ifndef FILL_NB
#define FILL_NB 11
#endif
#ifndef FILL_NC
#define FILL_NC 19
#endif
constexpr int fill_min(int a, int b) { return a < b ? a : b; }
constexpr int WT_OWN = WT_I_ALL - WT_I_IN;
#ifndef FILL_NM
#define FILL_NM 512
#endif
constexpr int FILL_MCH = 16;
constexpr int FILL_EA = fill_min((256 - FILL_A0) * 8 * FILL_NA, WT_I_ALL), FILL_EM = fill_min(FILL_EA + FILL_NM * FILL_MCH, WT_I_ALL), FILL_EB = fill_min(FILL_EM + (256 - FILL_B0) * 8 * FILL_NB, WT_I_ALL), FILL_EC = fill_min(FILL_EB + (256 - FILL_C0) * 8 * FILL_NC, WT_I_ALL);
static_assert(FILL_A0 > 0 && FILL_C0 > 0, "fill slots");
static_assert(FILL_EM >= 3 * WT_I_BR && FILL_EB >= 3 * WT_I_BR + WT_I_OUT + WT_I_UP && FILL_EC >= WT_OWN, "a matrix must be complete before the phase that multiplies by it (branch: merge; up: up-projection; down: within the layer)");
static_assert(64 * 33 <= 2176 && 8 * 4352 * 4 <= 146432 - 1024, "fill scratch: two transpose tiles per wave inside the dynamic LDS below the control words");
__device__ __forceinline__ void weight_fill_ws(int l, int seg_b, int seg_e_in, int ws, int nws, LAS unsigned char* lds, int wv) {
#if defined(__HIP_DEVICE_COMPILE__)
    asm volatile("s_waitcnt vmcnt(0)" ::: "memory"); LDS_BARRIER();
    int l_; asm volatile("v_mbcnt_lo_u32_b32 %0, -1, 0\n\tv_mbcnt_hi_u32_b32 %0, -1, %0" : "=v"(l_));
    const int seg_e = (l == DEPTH - 1 && seg_e_in > WT_OWN) ? WT_OWN : seg_e_in;
#define WT_AT(f_) weight_desc(fresh_args()->p, (f_) < WT_OWN ? l : l + 1, (f_) < WT_OWN ? WT_I_IN + (f_) : (f_) - WT_OWN)
    LAS float* scr = (LAS float*)lds + wv * 4352;
    int it = seg_b + ws;
    if (it < seg_e) { float wa[32], wb[32]; WtDesc da = WT_AT(it), db = da; transpose_load(da, l_, wa);
        for (;;) { const int it2 = it + nws; const bool h2 = it2 < seg_e;
            if (h2) { db = WT_AT(it2); transpose_load(db, l_, wb); }
            transpose_finish(da, wa, scr, l_);
            if (!h2) break;
            const int it3 = it2 + nws; const bool h3 = it3 < seg_e;
            if (h3) { da = WT_AT(it3); transpose_load(da, l_, wa); }
            transpose_finish(db, wb, scr + 2176, l_);
            if (!h3) break;
            it = it3; } }
#undef WT_AT
    LDS_BARRIER();
#endif
}
__device__ __forceinline__ void weight_fill(int l, int seg_b, int seg_e, int wg0, LAS unsigned char* lds, int wv) { weight_fill_ws(l, seg_b, seg_e, ((int)blockIdx.x - wg0) * 8 + wv, (256 - wg0) * 8, lds, wv); }
__global__ void __launch_bounds__(NTHREADS, 2) fwd(Args a) {
    extern __shared__ __attribute__((aligned(16))) unsigned char lds_raw[];
    LAS unsigned char* lds = (LAS unsigned char*)lds_raw;
    volatile LAS unsigned* MISC = (volatile LAS unsigned*)(lds + MISC_OFF);
    const int G = gridDim.x;
    const int wave_s = __builtin_amdgcn_readfirstlane((int)threadIdx.x >> 6);
    for (int u = threadIdx.x; u < (LDS_BYTES - MISC_OFF) / 4; u += NTHREADS) ((LAS unsigned*)(lds + MISC_OFF))[u] = 0u;
    __syncthreads();
    const bool multi = (a.step_hi - a.step_lo) > 1;
    if (multi) (void)xcd_barrier_post(a.ctl + 4096, MISC + 8);
#define IN(k) (fresh_args()->step_lo <= (k) && (k) < fresh_args()->step_hi)
#ifdef ONLY_STEP
#define EN(k) ((k) == ONLY_STEP)
#elif defined(SKIP_MASK)
#define EN(k) (!((SKIP_MASK >> (k)) & 1))
#else
#define EN(k) true
#endif
#define SEAM(k) do { if (IN((k) + 1)) { XcdBarrier bl; bl.bar = fresh_args()->ctl + 4096; bl.x = xb_xcc_id(); bl.st = (volatile LAS unsigned*)(lds + MISC_OFF) + 8; xcd_barrier(bl); } } while (0)
#define FOR_ITEMS(i, n) for (size_t i = gtid; i < (size_t)(n); i += NT)
#define FRESH_TID(name) int name; { int l_; asm volatile("v_mbcnt_lo_u32_b32 %0, -1, 0\n\tv_mbcnt_hi_u32_b32 %0, -1, %0" : "=v"(l_)); name = wave_s * 64 + l_; }

    if (EN(0) && IN(0)) {
        PTRS();
        LAS float* scr = (LAS float*)lds + wave * 4096;
        FOR_ITEMS(i, (size_t)GRID_W * 32) { const float ang = (float)(i >> 5) * rope_inv_freq((int)(i & 31)); p.ROPE[2 * i] = cosf(ang); p.ROPE[2 * i + 1] = sinf(ang); }
#ifdef FILL_OFF
        for (int l = 0; l < DEPTH; ++l) for (int it = gwave; it < WT_I_ALL; it += NGW) weight_item(fresh_args()->p, l, it, scr, lane);
#else
        for (int it = gwave; it < WT_I_IN; it += NGW) weight_item(fresh_args()->p, 0, it, scr, lane);
        for (int l = 1; l < DEPTH; ++l) for (int it = FILL_EC - WT_OWN + gwave; it < WT_I_IN; it += NGW) weight_item(fresh_args()->p, l, it, scr, lane);
#endif
        for (int l = 0; l < DEPTH; ++l) {
            { bf16* z = p.Wt_in + ((size_t)l * NP_PAD + NP_MAIN + PF_N) * D_MODEL; const size_t n16 = (size_t)(NP_PAD - NP_MAIN - PF_N) * D_MODEL / 8;
                FOR_ITEMS(i, n16) *(vu4*)(z + i * 8) = (vu4){0u, 0u, 0u, 0u}; }
        }
        __syncthreads();
        LAS float* sl = (LAS float*)lds;
        LAS float* red = sl + 3 * D_MODEL;
        for (int i = tid; i < (BATCH + 1) * D_MODEL; i += NTHREADS) sl[i] = silu_f(i < BATCH * D_MODEL ? p.c[i] : p.c_ctx[i - BATCH * D_MODEL]);
        __syncthreads();
        for (int it = (int)blockIdx.x; it < DEPTH * (D6 / 64); it += G) {
            const int l = it / (D6 / 64), n0 = (it % (D6 / 64)) * 64;
            float acc0 = 0.f, acc1 = 0.f, acc2 = 0.f;
            const float* w = p.w_ada + ((size_t)l * D_MODEL + wave * (D_MODEL / 8)) * D6 + n0 + lane;
            for (int k0 = 0; k0 < D_MODEL / 8; k0 += 32) { float wv[32];
#pragma unroll
                for (int j = 0; j < 32; ++j) wv[j] = w[(size_t)(k0 + j) * D6];
#pragma unroll
                for (int j = 0; j < 32; ++j) { const int kk = wave * (D_MODEL / 8) + k0 + j; acc0 += sl[kk] * wv[j]; acc1 += sl[D_MODEL + kk] * wv[j]; acc2 += sl[2 * D_MODEL + kk] * wv[j]; } }
            red[(wave * 3 + 0) * 64 + lane] = acc0; red[(wave * 3 + 1) * 64 + lane] = acc1; red[(wave * 3 + 2) * 64 + lane] = acc2;
            __syncthreads();
            if (tid < 192) { const int m = tid >> 6, ln = tid & 63; float s = 0.f;
#pragma unroll
                for (int w8 = 0; w8 < 8; ++w8) s += red[(w8 * 3 + m) * 64 + ln];
                p.MOD[((size_t)l * (BATCH + 1) + m) * D6 + n0 + ln] = s + p.b_ada[(size_t)l * D6 + n0 + ln]; }
            __syncthreads();
        }
        SEAM(0);
    }
    if (EN(1) && IN(1)) {
        PTRS();
        for (int r = gwave; r < MROWS; r += NGW) { vf4 x[NV4]; row_load(r < NLAT ? p.x + (size_t)r * D_MODEL : p.ctx + (size_t)(r - NLAT) * D_MODEL, lane, x);
            norm_h_wave(p, 0, r, 0, lane, x); }
        SEAM(1);
    }

    for (int l = 0; l < DEPTH; ++l) {
        const int sb = STEP0 + l * NSTEP;
        if (sb + NSTEP <= fresh_args()->step_lo || sb >= fresh_args()->step_hi) continue;
        const bool last = (l == DEPTH - 1);
        const int MR = last ? NLAT : MROWS;

        if (EN(2 + ST_INPROJ) && IN(sb + ST_INPROJ)) {
            PTRS();
            pg8::Gemm g{p.H, p.Wt_in + (size_t)l * NP_PAD * D_MODEL, MROWS, NP_PAD, D_MODEL, D_MODEL}; pg8::StaticOrder S; S.init(MROWS, NP_PAD, G, (int)blockIdx.x);
            pg8::EpiInProj E{p.P, p.PF};
            pg8::gemm_phase<pg8::EpiInProj, pg8::StaticOrder, true, true>(lds, g, S, E, tid);
#ifndef FILL_OFF
            if ((int)blockIdx.x >= FILL_A0) weight_fill(l, 0, FILL_EA, FILL_A0, lds, wave_s);
#endif
            SEAM(sb + ST_INPROJ);
        }

        if (EN(2 + ST_PREP) && IN(sb + ST_PREP)) {
            PTRS();
#ifdef NAIVE_PREP
            FOR_ITEMS(i, (size_t)MROWS * 3 * GDN_H) prep_gdn_item(p, l, (int)(i / (3 * GDN_H)), (int)(i % (3 * GDN_H)));
            FOR_ITEMS(i, (size_t)MROWS * 2 * GDN_H) prep_gdn_gb_item(p, l, (int)(i / (2 * GDN_H)), (int)(i % (2 * GDN_H)));
            FOR_ITEMS(i, (size_t)MROWS * SSM_XBC) prep_ssd_item(p, l, (int)(i / SSM_XBC), (int)(i % SSM_XBC));
            FOR_ITEMS(i, (size_t)MROWS * 2 * SSM_H) prep_ssd_dt_item(p, l, (int)(i / (2 * SSM_H)), (int)(i % (2 * SSM_H)));
#else
            for (int it = gwave; it < (MROWS / PREP_RB) * PREP_NPASS; it += NGW) prep_conv_block_wave(p, l, it / PREP_NPASS, it % PREP_NPASS, lane);
            for (int r = gwave; r < MROWS; r += NGW) prep_row_scalars_wave(p, l, r, lane);
#endif
#ifdef NAIVE_ATTN
            FOR_ITEMS(i, (size_t)MROWS * (ATT_HQ + ATT_HKV)) prep_attn_item(p, (int)(i / (ATT_HQ + ATT_HKV)), (int)(i % (ATT_HQ + ATT_HKV)));
#endif
            SEAM(sb + ST_PREP);
        }

        if (EN(2 + ST_G1) && IN(sb + ST_G1)) {
            PTRS();
            {
                constexpr int NG = BATCH * NCH * GDN_H, NS = SSD_LOCAL_UNITS; unsigned* ctr = fresh_args()->ctl + 8192 + 64 * (DEPTH + l);
                for (;;) { if (tid == 0) MISC[16] = __hip_atomic_fetch_add(ctr, 1u, __ATOMIC_RELAXED, __HIP_MEMORY_SCOPE_AGENT);
                    LDS_BARRIER(); const int u = (int)MISC[16]; LDS_BARRIER();
                    if (u >= NG + NS + ATT_EARLY) break;
                    int tl = tid; asm volatile("" : "+v"(tl));
                    if (u < ATT_EARLY) attn_unit(p, l, (LAS bf16*)lds, u, tl);
                    else if (u < ATT_EARLY + NS) ssd_local_unit(p, lds, u - ATT_EARLY, tl); else gdn_g1_unit(p, lds, u - ATT_EARLY - NS, tl); } }
            SEAM(sb + ST_G1);
        }

        if (EN(2 + ST_MIX) && IN(sb + ST_MIX)) {
            PTRS();
            constexpr int N_GDN_WG = BATCH * GDN_H * 2 * 4, N_SSD_WG = BATCH * SSM_H * 2;
            const int wg = (int)blockIdx.x;
#ifdef TOKEN_GDN
            if (wg < N_GDN_WG) gdn_token_wg(p, (LAS float*)lds, wg >> 2, wg & 3, tid);
#else
            if (wg < N_GDN_WG) gdn_scan_wg(p, lds, (wg & 7) + 8 * (wg >> 5), (wg >> 3) & 3, tid);
#endif
#ifdef TOKEN_SSD
            else if (wg < N_GDN_WG + N_SSD_WG) ssd_token_wg(p, (LAS float*)lds, wg - N_GDN_WG, tid);
#else
            else if (wg < N_GDN_WG + N_SSD_WG) ssd_scan_wg(p, lds, wg - N_GDN_WG, tid);
#endif
            {
                const int nu = ATT_UNITS_LAT + (last ? 0 : ATT_UNITS_CTX); unsigned* ctr = fresh_args()->ctl + 8192 + 64 * l;
                for (;;) { if (tid == 0) MISC[16] = ATT_EARLY + __hip_atomic_fetch_add(ctr, 1u, __ATOMIC_RELAXED, __HIP_MEMORY_SCOPE_AGENT);
                    LDS_BARRIER(); const int u = (int)MISC[16]; LDS_BARRIER();
                    if (u >= nu) break;
                    attn_unit(p, l, (LAS bf16*)lds, u, tid); } }
#ifndef FILL_OFF
            {
                constexpr int NCH_M = (FILL_EM - FILL_EA + FILL_MCH - 1) / FILL_MCH; unsigned* ctr = fresh_args()->ctl + 8192 + 64 * (2 * DEPTH + l);
                const int em = (last && FILL_EM > WT_OWN) ? WT_OWN : FILL_EM;
                for (;;) { if (tid == 0) MISC[16] = __hip_atomic_fetch_add(ctr, 1u, __ATOMIC_RELAXED, __HIP_MEMORY_SCOPE_AGENT);
                    LDS_BARRIER(); const int ch = (int)MISC[16]; LDS_BARRIER();
                    const int fb = FILL_EA + ch * FILL_MCH; if (ch >= NCH_M || fb >= em) break;
                    weight_fill_ws(l, fb, fb + FILL_MCH < em ? fb + FILL_MCH : em, wave_s, 8, lds, wave_s); } }
#endif
            SEAM(sb + ST_MIX);
        }

        if (EN(2 + ST_MIXOUT) && IN(sb + ST_MIXOUT)) {
            PTRS();
#ifdef NAIVE_MIXOUT
            FOR_ITEMS(i, (size_t)MROWS * GDN_H) gdn_out_item(p, l, (int)(i / GDN_H), (int)(i % GDN_H));
            FOR_ITEMS(i, (size_t)MROWS * SSM_G) ssd_out_item(p, l, (int)(i / SSM_G), (int)(i % SSM_G));
#else
            for (int r = gwave; r < (last ? NLAT : MROWS); r += NGW) mixout_row_wave(p, l, r, lane);
#endif
            SEAM(sb + ST_MIXOUT);
        }

        if (EN(2 + ST_MERGE) && IN(sb + ST_MERGE)) {
            PTRS();
            { pg8::Gemm g{p.YA, p.Wt_br + (size_t)l * 3 * D_MODEL * MIX_W, NLAT, D_MODEL, 3 * MIX_W, 3 * MIX_W}; pg8::StaticOrder S; S.init(NLAT, D_MODEL, G, (int)blockIdx.x);
              pg8::EpiMerge3 E{p.P + C_MG, p.MB};
              pg8::gemm_phase<pg8::EpiMerge3, pg8::StaticOrder, true, true>(lds, g, S, E, tid); }
            if (!last) { pg8::Gemm g{p.YA, p.Wt_br + (size_t)l * 3 * D_MODEL * MIX_W, MROWS, D_MODEL, MIX_W, 3 * MIX_W}; pg8::CtxMergeOrder S{(int)blockIdx.x};
              pg8::EpiMerge E{p.P + C_MG, p.TB};
              FRESH_TID(tid2); pg8::gemm_phase<pg8::EpiMerge, pg8::CtxMergeOrder, true, true>(lds, g, S, E, tid2); }
#ifndef FILL_OFF
            if ((int)blockIdx.x >= FILL_B0) weight_fill(l, FILL_EM, FILL_EB, FILL_B0, lds, wave_s);
#endif
            SEAM(sb + ST_MERGE);
        }

        if (EN(2 + ST_OUT) && IN(sb + ST_OUT)) {
            PTRS();
            { pg8::Gemm g{p.MB, p.Wt_out + (size_t)l * D_MODEL * D_MODEL, NLAT, D_MODEL, D_MODEL, D_MODEL}; pg8::StaticOrder S; S.init(NLAT, D_MODEL, G, (int)blockIdx.x);
              pg8::EpiBf16Plain E{p.MIXb, D_MODEL};
              pg8::gemm_phase<pg8::EpiBf16Plain, pg8::StaticOrder, true, true>(lds, g, S, E, tid); }
            if (!last) {
                pg8::Gemm g{p.TB, p.Wt_out + (size_t)l * D_MODEL * D_MODEL, 3 * NCTX, D_MODEL, pg8::SPLIT_KS, D_MODEL}; pg8::SplitOrder3 S{G, (int)blockIdx.x};
                pg8::EpiSlab3 E{p.SLAB};
                FRESH_TID(tid2); pg8::gemm_phase<pg8::EpiSlab3, pg8::SplitOrder3, true, true>(lds, g, S, E, tid2); }
            SEAM(sb + ST_OUT);
        }

        if (EN(2 + ST_NORM2) && IN(sb + ST_NORM2)) {
            PTRS();
            for (int r = gwave; r < MR; r += NGW) { int ll = lane; asm volatile("" : "+v"(ll)); vf4 x[NV4]; row_load(l > 0 ? p.X + (size_t)r * D_MODEL : (r < NLAT ? p.x + (size_t)r * D_MODEL : p.ctx + (size_t)(r - NLAT) * D_MODEL), ll, x); resid_wave(p, l, r, 0, ll, x, 3 * pg8::OUT_NS);
                row_store(p.X + (size_t)r * D_MODEL, ll, x); norm_h_wave(p, l, r, 1, ll, x); }
            SEAM(sb + ST_NORM2);
        }

        if (EN(2 + ST_UP) && IN(sb + ST_UP)) {
            PTRS();
            pg8::Gemm g{p.H, p.Wt_up + (size_t)l * 2 * D_FF * D_MODEL, MR, 2 * D_FF, D_MODEL, D_MODEL}; pg8::StaticOrder S; S.init(MR, 2 * D_FF, G, (int)blockIdx.x);
            pg8::EpiAct E{p.ACT, p.BP, p.BU, p.BG, p.ffn_conv_w + (size_t)l * 3 * D_FF, p.ffn_conv_b + (size_t)l * D_FF};
            pg8::gemm_phase<pg8::EpiAct, pg8::StaticOrder, true, true>(lds, g, S, E, tid);
#ifndef FILL_OFF
            if ((int)blockIdx.x >= FILL_C0) weight_fill(l, FILL_EB, FILL_EC, FILL_C0, lds, wave_s);
#endif
            SEAM(sb + ST_UP);
        }

        if (EN(2 + ST_ACT) && IN(sb + ST_ACT)) { PTRS();
            for (int it = (int)gtid; it < (MR / 64 * 2) * (D_FF / 4); it += (int)NT) act_fix_item(p, l, it / (D_FF / 4), (it % (D_FF / 4)) * 4);
            SEAM(sb + ST_ACT); }

        if (EN(2 + ST_DOWN) && IN(sb + ST_DOWN)) {
            PTRS();
            { pg8::Gemm g{p.ACT, p.Wt_down + (size_t)l * D_MODEL * D_FF, NLAT, D_MODEL, D_FF, D_FF}; pg8::StaticOrder S; S.init(NLAT, D_MODEL, G, (int)blockIdx.x);
              pg8::EpiBf16Plain E{p.MIXb, D_MODEL};
              pg8::gemm_phase<pg8::EpiBf16Plain, pg8::StaticOrder, true, true>(lds, g, S, E, tid); }
            if (!last) {
                pg8::Gemm g{p.ACT, p.Wt_down + (size_t)l * D_MODEL * D_FF, MROWS, D_MODEL, pg8::SPLIT_KS, D_FF}; pg8::SplitOrder S{pg8::DOWN_NS, G, (int)blockIdx.x};
                pg8::EpiSlab E{p.SLAB};
                FRESH_TID(tid2); pg8::gemm_phase<pg8::EpiSlab, pg8::SplitOrder, true, true>(lds, g, S, E, tid2); }
            SEAM(sb + ST_DOWN);
        }

        if (EN(2 + ST_NORM3) && IN(sb + ST_NORM3)) {
            PTRS();
            for (int r = gwave; r < (last ? NLAT : MROWS); r += NGW) { int ll = lane; asm volatile("" : "+v"(ll)); vf4 x[NV4]; row_load(p.X + (size_t)r * D_MODEL, ll, x); resid_wave(p, l, r, 1, ll, x, pg8::DOWN_NS);
                if (last) row_store(p.out + (size_t)r * D_MODEL, ll, x);
                else { row_store(p.X + (size_t)r * D_MODEL, ll, x); norm_h_wave(p, l + 1, r, 0, ll, x); } }
            SEAM(sb + ST_NORM3);
        }
    }
#undef IN
#undef SEAM
#undef FOR_ITEMS
}

extern "C" void kernel_launch(void* const* d_in, const int* in_sizes, int n_in, void* d_out, int out_size, void* d_ws, size_t ws_size, hipStream_t stream) {
    static int grid = 0;
    if (grid == 0) {
        if (n_in != 30 || in_sizes[0] != NLAT * D_MODEL || out_size != NLAT * D_MODEL || ws_size < WS_NEED) {
            fprintf(stderr, "kernel_launch: unexpected problem: n_in %d in0 %d out %d ws %zu (need %zu); nothing launched\n", n_in, n_in > 0 ? in_sizes[0] : -1, out_size, ws_size, (size_t)WS_NEED); grid = -1; return; }
        int dev = 0, cus = 0;
        if (hipGetDevice(&dev) != hipSuccess || hipDeviceGetAttribute(&cus, hipDeviceAttributeMultiprocessorCount, dev) != hipSuccess) { grid = -1; return; }
        if (hipFuncSetAttribute((const void*)fwd, hipFuncAttributeMaxDynamicSharedMemorySize, LDS_BYTES) != hipSuccess) { fprintf(stderr, "kernel_launch: hipFuncSetAttribute failed\n"); grid = -1; return; }
        int per_cu = 0;
        if (hipOccupancyMaxActiveBlocksPerMultiprocessor(&per_cu, (const void*)fwd, NTHREADS, LDS_BYTES) != hipSuccess || per_cu < 1) fprintf(stderr, "kernel_launch: occupancy query reports %d\n", per_cu);
        (void)hipGetLastError();
        grid = cus;
        if (grid != 256) { fprintf(stderr, "kernel_launch: built for a 256-CU device (workgroup roles in the mixer phase); got %d; nothing launched\n", cus); grid = -1; return; }
    }
    if (grid < 0) return;
    unsigned char* ws = (unsigned char*)d_ws;
    if (hipMemsetAsync(ws + WS_CTL, 0, CTL_BYTES, stream) != hipSuccess) return;
    Args a{};
    const float** pi = (const float**)&a.p;
    for (int i = 0; i < 30; ++i) pi[i] = (const float*)d_in[i];
    Ptrs& p = a.p;
    p.out = (float*)d_out;
    p.Wt_in = (bf16*)(ws + WS_WIN); p.Wt_br = (bf16*)(ws + WS_WBR); p.Wt_out = (bf16*)(ws + WS_WOUT); p.Wt_up = (bf16*)(ws + WS_WUP); p.Wt_down = (bf16*)(ws + WS_WDOWN);
    p.MOD = (float*)(ws + WS_MOD); p.ROPE = p.MOD + (size_t)DEPTH * (BATCH + 1) * D6; p.X = (float*)(ws + WS_X); p.H = (bf16*)(ws + WS_H); p.MIX = (float*)(ws + WS_MIX); p.MIXb = (bf16*)(ws + WS_MIX);
    p.SLAB = (float*)(ws + WS_SLAB); p.TB = (bf16*)(ws + WS_TB);
    p.OGb = (bf16*)(ws + WS_OGB); p.OSb = (bf16*)(ws + WS_OSB); p.OSb2 = (bf16*)(ws + WS_OSB2); p.GQKVb = (bf16*)(ws + WS_GQKVB); p.SXb = (bf16*)(ws + WS_SXB);
    p.P = (bf16*)(ws + WS_P); p.PF = (float*)(ws + WS_PF); p.GQKV = (float*)(ws + WS_GQKV); p.GG = (float*)(ws + WS_GG); p.GB = (float*)(ws + WS_GB);
    p.SXBC = (float*)(ws + WS_SXBC); p.SDT = (float*)(ws + WS_SDT); p.SA = (float*)(ws + WS_SA); p.AQ = (float*)(ws + WS_AQ); p.AK = (float*)(ws + WS_AK);
    p.OG = (float*)(ws + WS_OG); p.OS = (float*)(ws + WS_OS); p.SC = (float*)(ws + WS_SC); p.YA = (bf16*)(ws + WS_YA); p.YB = p.YA + MIX_W; p.YC = p.YA + 2 * MIX_W;
    p.SBCb = (bf16*)(ws + WS_SBCB); p.SSC = (bf16*)(ws + WS_SSC); p.SEA = (float*)(ws + WS_SEA); p.SEAb = (bf16*)(ws + WS_SEA); p.SDC = (float*)(ws + WS_SDC); p.SCF = (bf16*)(ws + WS_SCF);
    p.GW = (bf16*)(ws + WS_GW); p.GQd = (bf16*)(ws + WS_GQD); p.GKdT = (bf16*)(ws + WS_GKDT); p.GA = (bf16*)(ws + WS_GA); p.GUT = (bf16*)(ws + WS_GUT); p.GGL = (float*)(ws + WS_GGL);
    p.AQb = (bf16*)(ws + WS_AQB); p.AKb = (bf16*)(ws + WS_AKB);
    p.M32 = (float*)(ws + WS_M32); p.MB = (bf16*)(ws + WS_MB); p.UG = nullptr; p.ACT = (bf16*)(ws + WS_ACT); p.BP = (float*)(ws + WS_BP); p.BU = (bf16*)(ws + WS_BU); p.BG = (bf16*)(ws + WS_BG);
    a.ctl = (unsigned*)(ws + WS_CTL);
#if MK_LAUNCH_MODE == 1
    a.step_lo = 0; a.step_hi = TOTAL_STEPS;
    hipLaunchKernelGGL(fwd, dim3(grid), dim3(NTHREADS), LDS_BYTES, stream, a);
#else
    for (int s = 0; s < TOTAL_STEPS; ++s) { a.step_lo = s; a.step_hi = s + 1; hipLaunchKernelGGL(fwd, dim3(grid), dim3(NTHREADS), LDS_BYTES, stream, a); }
#endif
    const hipError_t le = hipPeekAtLastError();
    if (le != hipSuccess) fprintf(stderr, "kernel_launch: launch failed: %s\n", hipGetErrorName(le));
}
```

```cpp
#include <hip/hip_runtime.h>
#include <cstdio>
#include <cstdint>
#include <type_traits>
#define MK_LAUNCH_MODE 1
#define FILL_NA 10
#define FILL_NB 14
#define FILL_NC 4
#define FILL_NM 256
#include <cstdint>
#include <cstddef>
#include <cmath>
#ifdef HOST_TEST
#define HD inline
#define CFENCE() do {} while (0)
#else
#define HD __host__ __device__ __forceinline__
#if defined(__HIP_DEVICE_COMPILE__)
#define CFENCE() asm volatile("" ::: "memory")
#else
#define CFENCE() do {} while (0)
#endif
#endif

#ifndef CFG_SMALL
constexpr int D_MODEL = 2048, BATCH = 2, SEQ = 4096, DEPTH = 4, CTX_LEN = 256, D_FF = 5632;
#else
constexpr int D_MODEL = 1024, BATCH = 2, SEQ = 512, DEPTH = 2, CTX_LEN = 128, D_FF = 512;
#endif
constexpr int GRID_W = 64, WINDOW = 128;
constexpr float EPS = 1e-6f;
constexpr int MIX_W = D_MODEL / 2, GDN_H = MIX_W / 128, SSM_H = MIX_W / 64, SSM_G = 2, SSM_N = 128, SSM_P = 64, SSM_HPG = SSM_H / SSM_G;
constexpr int ATT_HQ = MIX_W / 128, ATT_HKV = 2, ATT_GRP = ATT_HQ / ATT_HKV;
constexpr int SSM_BC = SSM_G * SSM_N, SSM_XBC = MIX_W + 2 * SSM_BC;
constexpr int NLAT = BATCH * SEQ, NCTX = BATCH * CTX_LEN, MROWS = NLAT + NCTX;
constexpr int CHAIN_LEN = CTX_LEN + SEQ;
constexpr int R_QKV = 0, R_GATE = 3 * MIX_W, R_A = 4 * MIX_W, R_B = R_A + 2 * GDN_H, R_Z = R_B + 2 * GDN_H, R_XBC = R_Z + MIX_W, R_DT = R_XBC + SSM_XBC,
              R_AQ = R_DT + 2 * SSM_H, R_AKV = R_AQ + MIX_W, R_MG = R_AKV + 2 * ATT_HKV * 128, P_IN = R_MG + 3 * D_MODEL;
constexpr int C_QKV = 0, C_GATE = 3 * MIX_W, C_Z = 4 * MIX_W, C_XBC = 5 * MIX_W, C_AQ = C_XBC + SSM_XBC, C_AKV = C_AQ + MIX_W, C_MG = C_AKV + 512, NP_MAIN = C_MG + 3 * D_MODEL;
constexpr int PF_A = 0, PF_B = 2 * GDN_H, PF_DT = 4 * GDN_H, PF_N = 4 * GDN_H + 2 * SSM_H;
constexpr int NP_PAD = NP_MAIN + 256;
static_assert(NP_MAIN % 256 == 0 && PF_N <= 256 && MROWS % 256 == 0 && (2 * D_FF) % 256 == 0 && D_FF % 256 == 0, "tile shapes");
static_assert(P_IN == NP_MAIN + PF_N, "column bookkeeping");
constexpr int D6 = 6 * D_MODEL;

typedef unsigned short bf16;
HD float bf2f(bf16 b) { union { unsigned u; float f; } c; c.u = ((unsigned)b) << 16; return c.f; }
HD bf16 f2bf(float f) { union { unsigned u; float f; } c; c.f = f; unsigned u = c.u; u += 0x7FFFu + ((u >> 16) & 1u); return (bf16)(u >> 16); }
HD float silu_f(float x) { return x / (1.0f + expf(-x)); }
HD float sigmoid_f(float x) { return 1.0f / (1.0f + expf(-x)); }
#if defined(__HIP_DEVICE_COMPILE__)
HD float softplus_f(float x) { return x > 20.0f ? x : __logf(1.0f + __expf(x)); }
#else
HD float softplus_f(float x) { return x > 20.0f ? x : log1pf(expf(x)); }
#endif

struct Ptrs {
    const float *x, *c, *ctx, *c_ctx, *w_ada, *b_ada, *g_pre1, *w_in, *gdn_conv_w, *gdn_a_log, *gdn_dt_bias, *gdn_norm, *ssm_conv_w, *ssm_conv_b, *ssm_a_log,
        *ssm_dt_bias, *ssm_d, *ssm_norm, *attn_sink, *w_br_a, *w_br_b, *w_br_c, *w_out, *g_post1, *g_pre2, *w_up, *ffn_conv_w, *ffn_conv_b, *w_down, *g_post2;
    float* out;
    bf16 *Wt_in, *Wt_br, *Wt_out, *Wt_up, *Wt_down;
    float* ROPE;
    float* MOD;
    float* X;
    bf16* H;
    bf16* P;
    float* PF;
    float *GQKV, *GG, *GB;
    float *SXBC, *SDT, *SA;
    float *AQ, *AK;
    bf16 *GW, *GQd, *GKdT, *GA, *GUT; float* GGL;
    bf16 *SBCb, *SSC, *SEAb, *SCF; float *SEA, *SDC;
    bf16 *MIXb, *OGb, *OSb, *OSb2, *GQKVb, *SXb;
    bf16 *AQb, *AKb;
    float *OG, *OS;
    float* SC;
    bf16 *YA, *YB, *YC;
    float* M32;
    bf16* MB;
    float* MIX;
    bf16* UG;
    bf16* ACT;
    bf16* TB;
    float* SLAB;
    float* BP; bf16 *BU, *BG;
};
constexpr int SC_LD = 2 * WINDOW + 1 + CTX_LEN + 3;

HD void row_info(int r, int& b, int& t, int& len, bool& is_ctx) {
    if (r < NLAT) { b = r / SEQ; t = r % SEQ; len = SEQ; is_ctx = false; } else { const int q = r - NLAT; b = q / CTX_LEN; t = q % CTX_LEN; len = CTX_LEN; is_ctx = true; }
}
HD int mod_row(int r) { return r < NLAT ? r / SEQ : BATCH; }

HD int inproj_src_col(int np) {
    if (np < C_Z) return np;
    if (np < NP_MAIN) return np + 4 * GDN_H + (np >= C_AQ ? 2 * SSM_H : 0);
    const int j = np - NP_MAIN;
    if (j < PF_DT) return R_A + j;
    if (j < PF_N) return R_DT + (j - PF_DT);
    return -1;
}
HD void wcvt_item(const float* W, int K, int N, bf16* Wt, int np, int k8, bool inproj) {
    const int n = inproj ? inproj_src_col(np) : np;
    for (int j = 0; j < 8; ++j) { const int k = k8 * 8 + j; Wt[(size_t)np * K + k] = (n < 0) ? (bf16)0 : f2bf(W[(size_t)k * N + n]); }
}

HD void mod_item(const Ptrs& p, int l, int n) {
    float acc[BATCH + 1];
    for (int m = 0; m <= BATCH; ++m) acc[m] = 0.f;
    for (int k = 0; k < D_MODEL; ++k) {
        const float w = p.w_ada[((size_t)l * D_MODEL + k) * D6 + n];
        for (int m = 0; m < BATCH; ++m) acc[m] += silu_f(p.c[m * D_MODEL + k]) * w;
        acc[BATCH] += silu_f(p.c_ctx[k]) * w;
    }
    for (int m = 0; m <= BATCH; ++m) p.MOD[((size_t)l * (BATCH + 1) + m) * D6 + n] = acc[m] + p.b_ada[(size_t)l * D6 + n];
}
HD void xinit_item(const Ptrs& p, size_t i) { p.X[i] = i < (size_t)NLAT * D_MODEL ? p.x[i] : p.ctx[i - (size_t)NLAT * D_MODEL]; }

HD float row_rstd(const float* v, int n) { float s = 0.f; for (int j = 0; j < n; ++j) s += v[j] * v[j]; return 1.0f / sqrtf(s / (float)n + EPS); }
HD void norm_to_h_row(const Ptrs& p, int l, int r, int which) {
    const float* xr = p.X + (size_t)r * D_MODEL; const float* g = (which ? p.g_pre2 : p.g_pre1) + (size_t)l * D_MODEL;
    const float* mod = p.MOD + ((size_t)l * (BATCH + 1) + mod_row(r)) * D6 + (which ? 3 * D_MODEL : 0);
    const float rs = row_rstd(xr, D_MODEL);
    for (int j = 0; j < D_MODEL; ++j) p.H[(size_t)r * D_MODEL + j] = f2bf(xr[j] * rs * g[j] * (1.0f + mod[D_MODEL + j]) + mod[j]);
}
HD void resid_row(const Ptrs& p, int l, int r, int which, bool to_out) {
    const float* yr = p.MIX + (size_t)r * D_MODEL; const float* g = (which ? p.g_post2 : p.g_post1) + (size_t)l * D_MODEL;
    const float* gate = p.MOD + ((size_t)l * (BATCH + 1) + mod_row(r)) * D6 + (which ? 5 * D_MODEL : 2 * D_MODEL);
    const float rs = row_rstd(yr, D_MODEL);
    float* xr = p.X + (size_t)r * D_MODEL;
    for (int j = 0; j < D_MODEL; ++j) { const float v = xr[j] + gate[j] * (yr[j] * rs * g[j]); xr[j] = v; if (to_out && r < NLAT) p.out[(size_t)r * D_MODEL + j] = v; }
}

HD float conv3_p(const Ptrs& p, int r, int col, const float* w, int wld, int j) {
    int b, t, len; bool ic; row_info(r, b, t, len, ic);
    float y = w[wld + j] * bf2f(p.P[(size_t)r * NP_MAIN + col]);
    if (t > 0) y += w[j] * bf2f(p.P[(size_t)(r - 1) * NP_MAIN + col]);
    if (t < len - 1) y += w[2 * wld + j] * bf2f(p.P[(size_t)(r + 1) * NP_MAIN + col]);
    return y;
}
HD void prep_gdn_item(const Ptrs& p, int l, int r, int grp) {
    const float* w = p.gdn_conv_w + (size_t)l * 3 * (3 * MIX_W);
    float sc = 1.0f;
    if (grp < 2 * GDN_H) {
        float ss = 0.f;
        for (int d = 0; d < 128; ++d) { const int j = grp * 128 + d; const float v = silu_f(conv3_p(p, r, C_QKV + j, w, 3 * MIX_W, j)); ss += v * v; }
        sc = 1.0f / sqrtf(ss + EPS); if (grp < GDN_H) sc *= 0.08838834764831845f;
    }
    for (int d = 0; d < 128; ++d) { const int j = grp * 128 + d; p.GQKV[(size_t)r * (3 * MIX_W) + j] = silu_f(conv3_p(p, r, C_QKV + j, w, 3 * MIX_W, j)) * sc; }
}
HD void prep_gdn_gb_item(const Ptrs& p, int l, int r, int j) {
    const float a = p.PF[(size_t)r * PF_N + PF_A + j], bb = p.PF[(size_t)r * PF_N + PF_B + j];
    p.GG[(size_t)r * 2 * GDN_H + j] = -expf(p.gdn_a_log[(size_t)l * 2 * GDN_H + j]) * softplus_f(a + p.gdn_dt_bias[(size_t)l * 2 * GDN_H + j]);
    p.GB[(size_t)r * 2 * GDN_H + j] = sigmoid_f(bb);
}
HD void prep_ssd_item(const Ptrs& p, int l, int r, int j) {
    const float* w = p.ssm_conv_w + (size_t)l * 3 * SSM_XBC;
    p.SXBC[(size_t)r * SSM_XBC + j] = silu_f(conv3_p(p, r, C_XBC + j, w, SSM_XBC, j) + p.ssm_conv_b[(size_t)l * SSM_XBC + j]);
}
HD void prep_ssd_dt_item(const Ptrs& p, int l, int r, int j) {
    const float dt = softplus_f(p.PF[(size_t)r * PF_N + PF_DT + j] + p.ssm_dt_bias[(size_t)l * 2 * SSM_H + j]);
    p.SDT[(size_t)r * 2 * SSM_H + j] = dt; p.SA[(size_t)r * 2 * SSM_H + j] = -expf(p.ssm_a_log[(size_t)l * 2 * SSM_H + j]) * dt;
}
HD float rope_inv_freq(int i) { return exp2f(-(float)i * 0.4152410118609203f); }
HD void prep_attn_item(const Ptrs& p, int r, int hh) {
    int b, t, len; bool ic; row_info(r, b, t, len, ic);
    const bool isq = hh < ATT_HQ; const int h = isq ? hh : hh - ATT_HQ;
    const bf16* src = p.P + (size_t)r * NP_MAIN + (isq ? C_AQ + h * 128 : C_AKV + h * 128);
    float* dst = isq ? p.AQ + (size_t)r * MIX_W + h * 128 : p.AK + (size_t)r * (ATT_HKV * 128) + h * 128;
    if (ic) { for (int d = 0; d < 128; ++d) dst[d] = bf2f(src[d]); return; }
    const float pos[2] = {(float)(t / GRID_W), (float)(t % GRID_W)};
    for (int ax = 0; ax < 2; ++ax)
        for (int i = 0; i < 32; ++i) {
            const float ang = pos[ax] * rope_inv_freq(i), cs = cosf(ang), sn = sinf(ang);
            const float x1 = bf2f(src[ax * 64 + i]), x2 = bf2f(src[ax * 64 + 32 + i]);
            dst[ax * 64 + i] = x1 * cs - x2 * sn; dst[ax * 64 + 32 + i] = x2 * cs + x1 * sn;
        }
}

HD int chain_row(int b, int dir, int s) {
    if (s < CTX_LEN) return NLAT + b * CTX_LEN + (dir ? CTX_LEN - 1 - s : s);
    const int u = s - CTX_LEN; return b * SEQ + (dir ? SEQ - 1 - u : u);
}
HD void gdn_chain_item(const Ptrs& p, int b, int h, int dir, int vc) {
    float S[128];
#pragma unroll
    for (int k = 0; k < 128; ++k) S[k] = 0.f;
    float pf = 0.f;
    for (int s = 0; s < CHAIN_LEN; ++s) {
        const int r = chain_row(b, dir, s);
        const float* q = p.GQKV + (size_t)r * (3 * MIX_W) + h * 128; const float* kk = q + MIX_W; const float vv = q[2 * MIX_W + vc];
        const float a = expf(p.GG[(size_t)r * 2 * GDN_H + dir * GDN_H + h]), be = p.GB[(size_t)r * 2 * GDN_H + dir * GDN_H + h];
        if (s + 1 < CHAIN_LEN) { const float* qn = p.GQKV + (size_t)chain_row(b, dir, s + 1) * (3 * MIX_W) + h * 128;
#pragma unroll
            for (int j = 0; j < 4; ++j) pf += qn[32 * j] + qn[MIX_W + 32 * j]; }
        float ks = 0.f;
#pragma unroll
        for (int c = 0; c < 2; ++c) { float kc[64];
#pragma unroll
            for (int j = 0; j < 64; ++j) kc[j] = kk[64 * c + j];
#pragma unroll
            for (int j = 0; j < 64; ++j) { S[64 * c + j] *= a; ks += kc[j] * S[64 * c + j]; }
            CFENCE(); }
        const float dl = be * (vv - ks); float o = 0.f;
#pragma unroll
        for (int c = 0; c < 4; ++c) { float kc[32], qc[32];
#pragma unroll
            for (int j = 0; j < 32; ++j) { kc[j] = kk[32 * c + j]; qc[j] = q[32 * c + j]; }
#pragma unroll
            for (int j = 0; j < 32; ++j) { S[32 * c + j] += kc[j] * dl; o += qc[j] * S[32 * c + j]; }
            CFENCE(); }
        p.OG[((size_t)dir * MROWS + r) * MIX_W + h * 128 + vc] = o;
    }
    if (pf == 123456.789f) p.OG[0] = pf;
}
HD void ssd_chain_item(const Ptrs& p, int b, int hd, int dir, int pc) {
    float hs[SSM_N];
#pragma unroll
    for (int s = 0; s < SSM_N; ++s) hs[s] = 0.f;
    const int g = hd / SSM_HPG;
    float pf = 0.f;
    for (int s = 0; s < CHAIN_LEN; ++s) {
        const int r = chain_row(b, dir, s);
        const float* xb = p.SXBC + (size_t)r * SSM_XBC; const float* Bm = xb + MIX_W + g * SSM_N; const float* Cm = xb + MIX_W + SSM_BC + g * SSM_N;
        const float dt = p.SDT[(size_t)r * 2 * SSM_H + dir * SSM_H + hd], ea = expf(p.SA[(size_t)r * 2 * SSM_H + dir * SSM_H + hd]);
        const float xd = xb[hd * SSM_P + pc] * dt; float y = 0.f;
        if (s + 1 < CHAIN_LEN) { const float* xn = p.SXBC + (size_t)chain_row(b, dir, s + 1) * SSM_XBC + MIX_W + g * SSM_N;
#pragma unroll
            for (int j = 0; j < 4; ++j) pf += xn[32 * j] + xn[SSM_BC + 32 * j]; }
#pragma unroll
        for (int c = 0; c < 4; ++c) { float bc[32], cc[32];
#pragma unroll
            for (int j = 0; j < 32; ++j) { bc[j] = Bm[32 * c + j]; cc[j] = Cm[32 * c + j]; }
#pragma unroll
            for (int j = 0; j < 32; ++j) { hs[32 * c + j] = ea * hs[32 * c + j] + xd * bc[j]; y += cc[j] * hs[32 * c + j]; }
            CFENCE(); }
        p.OS[((size_t)dir * MROWS + r) * MIX_W + hd * SSM_P + pc] = y;
    }
    if (pf == 123456.789f) p.OS[0] = pf;
}
HD void attn_item(const Ptrs& p, int l, int r, int hq) {
    int b, t, len; bool ic; row_info(r, b, t, len, ic);
    const int hkv = hq / ATT_GRP;
    const float* qp = p.AQ + (size_t)r * MIX_W + hq * 128;
    float* sc = p.SC + ((size_t)r * ATT_HQ + hq) * SC_LD;
    const float sink = p.attn_sink[(size_t)l * ATT_HQ + hq];
    const int lo = ic ? 0 : (t - WINDOW < 0 ? 0 : t - WINDOW), hi = ic ? -1 : (t + WINDOW > SEQ - 1 ? SEQ - 1 : t + WINDOW);
    const int nloc = ic ? 0 : hi - lo + 1, nk = nloc + CTX_LEN;
    float m = sink;
    {
        float q[128];
#pragma unroll
        for (int d = 0; d < 128; ++d) q[d] = qp[d];
        for (int j = 0; j < nk; ++j) {
            const int kr = j < nloc ? b * SEQ + lo + j : NLAT + b * CTX_LEN + (j - nloc);
            const float* kk = p.AK + (size_t)kr * (ATT_HKV * 128) + hkv * 128;
            float s = 0.f;
#pragma unroll
            for (int c = 0; c < 4; ++c) { float kc[32];
#pragma unroll
                for (int d = 0; d < 32; ++d) kc[d] = kk[32 * c + d];
#pragma unroll
                for (int d = 0; d < 32; ++d) s += q[32 * c + d] * kc[d];
                CFENCE(); }
            s *= 0.08838834764831845f; sc[j] = s; m = s > m ? s : m;
        }
    }
    float o[128];
#pragma unroll
    for (int d = 0; d < 128; ++d) o[d] = 0.f;
    float den = expf(sink - m);
    for (int j = 0; j < nk; ++j) {
        const int kr = j < nloc ? b * SEQ + lo + j : NLAT + b * CTX_LEN + (j - nloc);
        const bf16* vv = p.P + (size_t)kr * NP_MAIN + C_AKV + ATT_HKV * 128 + hkv * 128;
        const float e = expf(sc[j] - m); den += e;
#pragma unroll
        for (int c = 0; c < 4; ++c) { float vc[32];
#pragma unroll
            for (int d = 0; d < 32; ++d) vc[d] = bf2f(vv[32 * c + d]);
#pragma unroll
            for (int d = 0; d < 32; ++d) o[32 * c + d] += e * vc[d];
            CFENCE(); }
    }
    const float inv = 1.0f / den;
#pragma unroll
    for (int d = 0; d < 128; ++d) p.YC[(size_t)r * MIX_W + hq * 128 + d] = f2bf(o[d] * inv);
}
HD void gdn_out_item(const Ptrs& p, int l, int r, int h) {
    float ss = 0.f;
    for (int d = 0; d < 128; ++d) { const size_t i = (size_t)r * MIX_W + h * 128 + d; const float v = p.OG[i] + p.OG[(size_t)MROWS * MIX_W + i]; ss += v * v; }
    const float rs = 1.0f / sqrtf(ss / 128.0f + EPS);
    for (int d = 0; d < 128; ++d) { const size_t i = (size_t)r * MIX_W + h * 128 + d; const float v = p.OG[i] + p.OG[(size_t)MROWS * MIX_W + i];
        p.YA[i] = f2bf(v * rs * p.gdn_norm[(size_t)l * 128 + d] * silu_f(bf2f(p.P[(size_t)r * NP_MAIN + C_GATE + h * 128 + d]))); }
}
HD void ssd_out_item(const Ptrs& p, int l, int r, int g) {
    constexpr int GW = MIX_W / SSM_G;
    float ss = 0.f;
    for (int pass = 0; pass < 2; ++pass) {
        const float rs = pass ? 1.0f / sqrtf(ss / (float)GW + EPS) : 0.f;
        for (int jj = 0; jj < GW; ++jj) { const int j = g * GW + jj; const size_t i = (size_t)r * MIX_W + j;
            float y = p.OS[i] + p.OS[(size_t)MROWS * MIX_W + i] + p.ssm_d[(size_t)l * SSM_H + j / SSM_P] * p.SXBC[(size_t)r * SSM_XBC + j];
            y *= silu_f(bf2f(p.P[(size_t)r * NP_MAIN + C_Z + j]));
            if (!pass) ss += y * y; else p.YB[i] = f2bf(y * rs * p.ssm_norm[(size_t)l * MIX_W + j]); }
    }
}
HD void act_item(const Ptrs& p, int l, int r, int j) {
    int b, t, len; bool ic; row_info(r, b, t, len, ic);
    const float* w = p.ffn_conv_w + (size_t)l * 3 * D_FF;
    const bf16* ug = p.UG + (size_t)r * (2 * D_FF);
    float g = w[D_FF + j] * bf2f(ug[D_FF + j]);
    if (t > 0) g += w[j] * bf2f(ug[D_FF + j - 2 * D_FF]);
    if (t < len - 1) g += w[2 * D_FF + j] * bf2f(ug[D_FF + j + 2 * D_FF]);
    g += p.ffn_conv_b[(size_t)l * D_FF + j];
    p.ACT[(size_t)r * D_FF + j] = f2bf(silu_f(g) * bf2f(ug[j]));
}

namespace pg8 {
#define PG8_LAS __attribute__((address_space(3)))
typedef unsigned short bf16_t;
typedef short bf16x8 __attribute__((ext_vector_type(8)));
typedef float f32x4 __attribute__((ext_vector_type(4)));
typedef unsigned u32x4 __attribute__((ext_vector_type(4)));
constexpr int BM = 256, BK = 64, HALF = 128, HTB = HALF * BK * 2  , STAGE_BYTES = 8 * HTB, NXCD = 8, WGM = 8;

__host__ __device__ __forceinline__ int lds_byte(int r, int c) { const int st = (r >> 4) * 2 + (c >> 5), rr = r & 15, cc = c & 31, ob = rr * 64 + cc * 2; return st * 1024 + (ob ^ (((ob >> 9) & 1) << 5)); }
__host__ __device__ __forceinline__ void stage_rc(int b, int& R, int& C) { const int st = b / 1024, sb = b % 1024, swz = sb ^ (((sb >> 9) & 1) << 5); R = (st >> 1) * 16 + swz / 64; C = (st & 1) * 32 + (swz % 64) / 2; }
__host__ __device__ __forceinline__ int perm32(int rho) { const int n = rho >> 4, i = rho & 15; return 8 * (i >> 2) + 4 * n + (i & 3); }

struct Unit { int pm, pn, pk; };
struct Gemm { const bf16_t* A; const bf16_t* Bt; int M, N, K, ld; };

struct StaticOrder {
    int nM, nN, nwg, G, c;
    __host__ __device__ void init(int M, int N, int G_, int c_) { nM = M / BM; nN = N / BM; nwg = nM * nN; G = G_; c = c_; }
    __host__ __device__ bool next(int i, Unit& u) const {
        const long L = (long)i * G + c; if (L >= nwg) return false;
        int wgid = (int)L; { const int q = nwg / NXCD, r = nwg % NXCD, xcd = wgid % NXCD, off = wgid / NXCD; wgid = (xcd < r ? xcd * (q + 1) : r * (q + 1) + (xcd - r) * q) + off; }
        const int nig = WGM * nN, gid = wgid / nig, fm = gid * WGM, gsz = (nM - fm) < WGM ? (nM - fm) : WGM;
        u.pm = fm + ((wgid % nig) % gsz); u.pn = (wgid % nig) / gsz; u.pk = 0; return true;
    }
    __device__ __forceinline__ void a_ready(const Unit&) const {}
    __device__ __forceinline__ void done(const Unit&) const {}
};

__device__ __forceinline__ unsigned cvt_pk_bf16(float lo, float hi) { unsigned r; asm volatile("v_cvt_pk_bf16_f32 %0, %1, %2" : "=v"(r) : "v"(lo), "v"(hi)); return r; }

template <class Epi, class Sched, bool ALIGN_EPI = false, bool SP2 = false>
__device__ __forceinline__ void gemm_phase(PG8_LAS unsigned char* lds, const Gemm g, const Sched& S, const Epi& E, int tid_in) {
    int tid_l = tid_in; asm volatile("" : "+v"(tid_l));
    const int tid = tid_l, wid = __builtin_amdgcn_readfirstlane(tid >> 6), lane = tid & 63, wr = wid >> 2, wc = wid & 3, fr = lane & 15, fq = lane >> 4;
    const int K = g.K, nt = K / BK, LD = g.ld;
    unsigned voffA[2], voffB[2];
#pragma unroll
    for (int i = 0; i < 2; ++i) { int R, C; stage_rc(tid * 16 + i * 8192, R, C); const int Rb = Epi::PERM ? ((R & ~31) + perm32(R & 31)) : R;
        voffA[i] = (unsigned)(R * LD + C) * 2u; voffB[i] = (unsigned)(Rb * LD + C) * 2u; }
    const size_t kstep = (size_t)(BK * 2);
    const size_t hstep = (size_t)HALF * LD * 2;
    const size_t tstep = 2 * hstep;
    const unsigned ldsw = (unsigned)wid * 1024u;
    const int aoff = lds_byte(wr * 64 + fr, fq * 8), boff = lds_byte(wc * 32 + fr, fq * 8);
#define PG8_SA(b, h) (((b) * 2 + (h)) * HTB)
#define PG8_SB(b, h) ((4 + (b) * 2 + (h)) * HTB)
#define PG8_STAGE(bufoff, gbase, voff) do { _Pragma("unroll") for (int _i = 0; _i < 2; ++_i) \
        __builtin_amdgcn_global_load_lds((const unsigned*)((const char*)(gbase) + (voff)[_i]), (PG8_LAS unsigned*)(lds + (bufoff) + ldsw + _i * 8192), 16, 0, 0); } while (0)
#define PG8_LDA(dst, b, h) do { _Pragma("unroll") for (int m = 0; m < 4; ++m) _Pragma("unroll") for (int k = 0; k < 2; ++k) dst[m][k] = *(const PG8_LAS bf16x8*)(lds + PG8_SA(b, h) + aoff + m * 2048 + k * 1024); } while (0)
#define PG8_LDB(dst, b, h) do { _Pragma("unroll") for (int n = 0; n < 2; ++n) _Pragma("unroll") for (int k = 0; k < 2; ++k) dst[n][k] = *(const PG8_LAS bf16x8*)(lds + PG8_SB(b, h) + boff + n * 2048 + k * 1024); } while (0)
#define PG8_MMA(ai, bj, At, Bt) do { __builtin_amdgcn_s_setprio(1); _Pragma("unroll") for (int m = 0; m < 4; ++m) _Pragma("unroll") for (int n = 0; n < 2; ++n) _Pragma("unroll") for (int k = 0; k < 2; ++k) \
        acc[ai][bj][m][n] = __builtin_amdgcn_mfma_f32_16x16x32_bf16(Bt[n][k], At[m][k], acc[ai][bj][m][n], 0, 0, 0); __builtin_amdgcn_s_setprio(0); } while (0)
#define PG8_WAIT_V(n) asm volatile("s_waitcnt vmcnt(" #n ")" ::: "memory")
#define PG8_WAIT_L(n) asm volatile("s_waitcnt lgkmcnt(" #n ")" ::: "memory")
#define PG8_BAR __builtin_amdgcn_s_barrier()
#define PG8_SCHED __builtin_amdgcn_sched_barrier(0)
    Unit cur, nxt; int ui = 0;
    if (!S.next(0, cur)) return;
    f32x4 acc[2][2][4][2];
#pragma unroll
    for (int a = 0; a < 2; ++a)
#pragma unroll
        for (int b = 0; b < 2; ++b)
#pragma unroll
            for (int m = 0; m < 4; ++m)
#pragma unroll
                for (int n = 0; n < 2; ++n) acc[a][b][m][n] = (f32x4){0.f, 0.f, 0.f, 0.f};
    bf16x8 At[4][2], B0[2][2], B1[2][2];
    const char* cA = (const char*)g.A + (size_t)cur.pm * tstep + (size_t)cur.pk * 2; const char* cB = (const char*)g.Bt + (size_t)cur.pn * tstep + (size_t)cur.pk * 2;
    S.a_ready(cur);
    if constexpr (SP2) {
        PG8_STAGE(PG8_SB(0, 0), cB, voffB); PG8_STAGE(PG8_SB(0, 1), cB + hstep, voffB); PG8_STAGE(PG8_SA(0, 0), cA, voffA); PG8_STAGE(PG8_SA(0, 1), cA + hstep, voffA);
        if (wr == 1) PG8_BAR;
        PG8_WAIT_V(2); PG8_BAR;
        PG8_STAGE(PG8_SB(1, 0), cB + kstep, voffB); PG8_STAGE(PG8_SA(1, 0), cA + kstep, voffA); PG8_STAGE(PG8_SB(1, 1), cB + hstep + kstep, voffB);
        PG8_WAIT_V(6); PG8_BAR;
    } else {
        PG8_STAGE(PG8_SB(0, 0), cB, voffB); PG8_STAGE(PG8_SA(0, 0), cA, voffA); PG8_STAGE(PG8_SB(0, 1), cB + hstep, voffB); PG8_STAGE(PG8_SA(0, 1), cA + hstep, voffA);
        if (wr == 1) PG8_BAR;
        PG8_WAIT_V(4); PG8_BAR;
        PG8_STAGE(PG8_SB(1, 0), cB + kstep, voffB); PG8_STAGE(PG8_SA(1, 0), cA + kstep, voffA); PG8_STAGE(PG8_SB(1, 1), cB + hstep + kstep, voffB);
        PG8_WAIT_V(6); PG8_BAR;
    }
    for (;;) {
        const bool has_next = S.next(ui + 1, nxt);
        const char* nA = has_next ? (const char*)g.A + (size_t)nxt.pm * tstep + (size_t)nxt.pk * 2 : cA; const char* nB = has_next ? (const char*)g.Bt + (size_t)nxt.pn * tstep + (size_t)nxt.pk * 2 : cB;
        for (int t = 0; t < nt; t += 2) {
            const bool last = (t == nt - 2);
            const char* a1 = cA + (size_t)(t + 1) * kstep;
            const char* a2 = last ? nA : cA + (size_t)(t + 2) * kstep; const char* b2 = last ? nB : cB + (size_t)(t + 2) * kstep;
            const char* a3 = a2 + kstep; const char* b3 = b2 + kstep;
            if (last && has_next) S.a_ready(nxt);
            if constexpr (Epi::KHOOK) E.khook(acc, cur, t, wr, wc, fr, fq);
            if constexpr (SP2) {
            PG8_LDB(B0, 0, 0); PG8_LDB(B1, 0, 1); PG8_SCHED; PG8_LDA(At, 0, 0); PG8_STAGE(PG8_SA(1, 1), a1 + hstep, voffA);
            PG8_WAIT_V(8); PG8_WAIT_L(0); PG8_BAR; PG8_MMA(0, 0, At, B0); PG8_MMA(0, 1, At, B1); PG8_BAR; PG8_SCHED;
            PG8_LDA(At, 0, 1); PG8_STAGE(PG8_SB(0, 0), b2, voffB); PG8_STAGE(PG8_SB(0, 1), b2 + hstep, voffB); PG8_STAGE(PG8_SA(0, 0), a2, voffA);
            PG8_WAIT_V(8); PG8_WAIT_L(0); PG8_BAR; PG8_MMA(1, 0, At, B0); PG8_MMA(1, 1, At, B1); PG8_BAR; PG8_SCHED;
            PG8_LDB(B0, 1, 0); PG8_LDB(B1, 1, 1); PG8_SCHED; PG8_LDA(At, 1, 0); PG8_STAGE(PG8_SA(0, 1), a2 + hstep, voffA);
            PG8_WAIT_V(8); PG8_WAIT_L(0); PG8_BAR; PG8_MMA(0, 0, At, B0); PG8_MMA(0, 1, At, B1); PG8_BAR; PG8_SCHED;
            PG8_LDA(At, 1, 1); PG8_STAGE(PG8_SB(1, 0), b3, voffB); PG8_STAGE(PG8_SB(1, 1), b3 + hstep, voffB); PG8_STAGE(PG8_SA(1, 0), a3, voffA);
            PG8_WAIT_V(8); PG8_WAIT_L(0); PG8_BAR; PG8_MMA(1, 0, At, B0); PG8_MMA(1, 1, At, B1); PG8_BAR; PG8_SCHED;
            } else {
            PG8_LDB(B0, 0, 0); PG8_SCHED; PG8_LDA(At, 0, 0); PG8_STAGE(PG8_SA(1, 1), a1 + hstep, voffA);
            PG8_WAIT_L(8); PG8_BAR; PG8_WAIT_L(0); PG8_MMA(0, 0, At, B0); PG8_BAR; PG8_SCHED;
            PG8_LDB(B1, 0, 1); PG8_STAGE(PG8_SB(0, 0), b2, voffB);
            PG8_BAR; PG8_WAIT_L(0); PG8_MMA(0, 1, At, B1); PG8_BAR;
            PG8_LDA(At, 0, 1); PG8_STAGE(PG8_SA(0, 0), a2, voffA);
            PG8_BAR; PG8_WAIT_L(0); PG8_MMA(1, 0, At, B0); PG8_BAR; PG8_SCHED;
            PG8_STAGE(PG8_SB(0, 1), b2 + hstep, voffB);
            PG8_WAIT_V(6); PG8_BAR; PG8_MMA(1, 1, At, B1); PG8_BAR;
            PG8_LDB(B0, 1, 0); PG8_SCHED; PG8_LDA(At, 1, 0); PG8_STAGE(PG8_SA(0, 1), a2 + hstep, voffA);
            PG8_WAIT_L(8); PG8_BAR; PG8_WAIT_L(0); PG8_MMA(0, 0, At, B0); PG8_BAR; PG8_SCHED;
            PG8_LDB(B1, 1, 1); PG8_STAGE(PG8_SB(1, 0), b3, voffB);
            PG8_BAR; PG8_WAIT_L(0); PG8_MMA(0, 1, At, B1); PG8_BAR;
            PG8_LDA(At, 1, 1); PG8_STAGE(PG8_SA(1, 0), a3, voffA);
            PG8_BAR; PG8_WAIT_L(0); PG8_MMA(1, 0, At, B0); PG8_BAR; PG8_SCHED;
            PG8_STAGE(PG8_SB(1, 1), b3 + hstep, voffB);
            PG8_WAIT_V(6); PG8_BAR; PG8_MMA(1, 1, At, B1); PG8_BAR;
            }
        }
        if constexpr (ALIGN_EPI) { if (wr == 0) PG8_BAR; }
        if constexpr (!Epi::AFTER_DRAIN) { E(acc, cur, wr, wc, fr, fq); S.done(cur); }
        if (!has_next) break;
#pragma unroll
        for (int a = 0; a < 2; ++a)
#pragma unroll
            for (int b = 0; b < 2; ++b)
#pragma unroll
                for (int m = 0; m < 4; ++m)
#pragma unroll
                    for (int n = 0; n < 2; ++n) acc[a][b][m][n] = (f32x4){0.f, 0.f, 0.f, 0.f};
        cur = nxt; cA = nA; cB = nB; ++ui;
        if constexpr (ALIGN_EPI) { if (wr == 1) PG8_BAR; }
    }
    PG8_WAIT_V(0);
    if constexpr (!ALIGN_EPI) { if (wr == 0) PG8_BAR; }
    PG8_BAR;
    if constexpr (Epi::AFTER_DRAIN) { E.fused(acc, cur, wr, wc, fr, fq, lds, wid, lane); S.done(cur); }
#undef PG8_SA
#undef PG8_SB
#undef PG8_STAGE
#undef PG8_LDA
#undef PG8_LDB
#undef PG8_MMA
#undef PG8_WAIT_V
#undef PG8_WAIT_L
#undef PG8_BAR
#undef PG8_SCHED
}
}
#define GAS __attribute__((address_space(1)))
#define LAS __attribute__((address_space(3)))
typedef GAS unsigned gu32;
typedef GAS unsigned long long gu64;
#define RLX_AGENT __ATOMIC_RELAXED, __HIP_MEMORY_SCOPE_AGENT
#define XB_TMO      128
#define XB_XCNT(j)  (256  + 64 * (j))
#define XB_XSUB(j)  (1280 + 64 * (j))
#define XB_XGEN(j)  (2304 + 64 * (j))
#define XB_TOP      3328
#define XB_TOPGEN   3392
#define XCD_BAR_WORDS 3456
#define XB_SPIN_CAP (1u << 18)

__device__ __forceinline__ unsigned xb_ld(unsigned* p)              { return __hip_atomic_load(p, __ATOMIC_RELAXED, __HIP_MEMORY_SCOPE_AGENT); }
__device__ __forceinline__ unsigned xb_add(unsigned* p, unsigned v) { return __hip_atomic_fetch_add(p, v, __ATOMIC_RELAXED, __HIP_MEMORY_SCOPE_AGENT); }
__device__ __forceinline__ unsigned xb_xcc_id() { return (unsigned)__builtin_amdgcn_s_getreg((3 << 11) | 20) & 0xFu; }
#define XB_SPIN(cond, bar) do { unsigned _sp = 0; while (cond) { __builtin_amdgcn_s_sleep(1); \
    if ((++_sp & 255u) == 0u) { if (xb_ld(&(bar)[XB_TMO])) break; if (_sp > XB_SPIN_CAP) { atomicAdd(&(bar)[XB_TMO], 1u); break; } } } } while (0)

struct XcdBarrier {
    unsigned* bar; unsigned x;
    volatile LAS unsigned* st;
};

__device__ __forceinline__ XcdBarrier xcd_barrier_post(unsigned* bar, volatile LAS unsigned* st) {
    XcdBarrier b; b.bar = bar; b.x = xb_xcc_id(); b.st = st;
    if (threadIdx.x == 0) (void)xb_add(&bar[XB_XCNT(b.x)], 1u);
    return b;
}
__device__ __forceinline__ void xcd_barrier_complete(unsigned* bar, unsigned x, unsigned& nloc, unsigned& nx) {
    const unsigned G = gridDim.x * gridDim.y * gridDim.z;
    unsigned sum, cnt, mine, sp = 0u;
    for (;;) {
        sum = 0u; cnt = 0u; mine = 0u;
#pragma unroll
        for (unsigned j = 0; j < 16; ++j) { const unsigned c = xb_ld(&bar[XB_XCNT(j)]); sum += c; cnt += (c > 0u) ? 1u : 0u; mine = (j == x) ? c : mine; }
        if (sum == G) break;
        __builtin_amdgcn_s_sleep(1);
        if ((++sp & 255u) == 0u) { if (xb_ld(&bar[XB_TMO])) break; if (sp > XB_SPIN_CAP) { atomicAdd(&bar[XB_TMO], 1u); break; } }
    }
    nloc = mine > 0u ? mine : 1u; nx = cnt > 0u ? cnt : 1u;
}

__device__ __forceinline__ void xcd_barrier(const XcdBarrier& b) {
    asm volatile("s_waitcnt vmcnt(0)" ::: "memory");
    __syncthreads();
    if (threadIdx.x == 0) {
        unsigned* bar = b.bar;
        __builtin_amdgcn_s_waitcnt(0);
        unsigned nloc = b.st[0], nx = b.st[1];
        if (nloc == 0u) { xcd_barrier_complete(bar, b.x, nloc, nx); b.st[0] = nloc; b.st[1] = nx; }
        const unsigned old = xb_add(&bar[XB_XSUB(b.x)], 1u);
        const unsigned gen = old / nloc;
        if (old + 1u == (gen + 1u) * nloc) {
            __builtin_amdgcn_fence(__ATOMIC_RELEASE, "agent");
            asm volatile("s_waitcnt vmcnt(0)" ::: "memory");
            const unsigned og = xb_add(&bar[XB_TOP], 1u);
            const unsigned tg = og / nx;
            if (og + 1u == (tg + 1u) * nx) xb_add(&bar[XB_TOPGEN], 1u);
            else XB_SPIN(xb_ld(&bar[XB_TOPGEN]) == tg, bar);
            __builtin_amdgcn_fence(__ATOMIC_ACQUIRE, "agent");
            xb_add(&bar[XB_XGEN(b.x)], 1u);
            asm volatile("s_waitcnt vmcnt(0)" ::: "memory");
        } else {
            XB_SPIN(xb_ld(&bar[XB_XGEN(b.x)]) == gen, bar);
            __builtin_amdgcn_fence(__ATOMIC_ACQUIRE, "agent");
            asm volatile("s_waitcnt vmcnt(0)" ::: "memory");
        }
    }
    __syncthreads();
}

#define LDS_BARRIER() do { asm volatile("s_waitcnt lgkmcnt(0)" ::: "memory"); __builtin_amdgcn_s_barrier(); asm volatile("" ::: "memory"); } while (0)
typedef float vf4 __attribute__((ext_vector_type(4)));
typedef unsigned vu2 __attribute__((ext_vector_type(2)));
typedef unsigned vu4 __attribute__((ext_vector_type(4)));
__device__ __forceinline__ float wave_sum(float v) {
#pragma unroll
    for (int o = 1; o < 64; o <<= 1) v += __shfl_xor(v, o);
    return v;
}
template <int CTRL> __device__ __forceinline__ float dpp_f(float x) { return __builtin_bit_cast(float, __builtin_amdgcn_mov_dpp(__builtin_bit_cast(int, x), CTRL, 0xf, 0xf, true)); }
__device__ __forceinline__ float sum16(float x) { x += dpp_f<0xB1>(x); x += dpp_f<0x4E>(x); x += dpp_f<0x124>(x); x += dpp_f<0x128>(x); return x; }
__device__ __forceinline__ float sum8(float x) { x += dpp_f<0xB1>(x); x += dpp_f<0x4E>(x); x += dpp_f<0x141>(x); return x; }
__device__ __forceinline__ unsigned pk2(float lo, float hi) { return (unsigned)f2bf(lo) | ((unsigned)f2bf(hi) << 16); }

constexpr int NV4 = D_MODEL / 256;
__device__ __forceinline__ void row_load(const float* row, int lane, vf4 (&x)[NV4]) {
#pragma unroll
    for (int j = 0; j < NV4; ++j) x[j] = *(const vf4*)(row + (size_t)(j * 64 + lane) * 4);
}
__device__ __forceinline__ void row_store(float* row, int lane, const vf4 (&x)[NV4]) {
#pragma unroll
    for (int j = 0; j < NV4; ++j) *(vf4*)(row + (size_t)(j * 64 + lane) * 4) = x[j];
}
__device__ __forceinline__ float row_rs(const vf4 (&x)[NV4]) {
    float ss = 0.f;
#pragma unroll
    for (int j = 0; j < NV4; ++j) ss += (x[j].x * x[j].x + x[j].y * x[j].y) + (x[j].z * x[j].z + x[j].w * x[j].w);
    return 1.0f / sqrtf(wave_sum(ss) * (1.0f / D_MODEL) + EPS);
}
__device__ __forceinline__ void norm_h_wave(const Ptrs& p, int l, int r, int which, int lane, const vf4 (&x)[NV4]) {
    const float rs = row_rs(x);
    const float* g = (which ? p.g_pre2 : p.g_pre1) + (size_t)l * D_MODEL;
    const float* mod = p.MOD + ((size_t)l * (BATCH + 1) + mod_row(r)) * D6 + (which ? 3 * D_MODEL : 0);
#pragma unroll
    for (int j = 0; j < NV4; ++j) { const int c = (j * 64 + lane) * 4;
        const vf4 gv = *(const vf4*)(g + c), sh = *(const vf4*)(mod + c), sc = *(const vf4*)(mod + D_MODEL + c);
        const vf4 o = x[j] * rs * gv * (1.0f + sc) + sh;
        vu2 w; w.x = pk2(o.x, o.y); w.y = pk2(o.z, o.w);
        *(vu2*)(p.H + (size_t)r * D_MODEL + c) = w; }
}
__device__ __forceinline__ void resid_wave(const Ptrs& p, int l, int r, int which, int lane, vf4 (&x)[NV4], int ns) {
    vf4 y[NV4];
    if (r >= NLAT) {
#pragma unroll
        for (int j = 0; j < NV4; ++j) y[j] = (vf4){0.f, 0.f, 0.f, 0.f};
        for (int s = 0; s < ns; ++s) {
#pragma unroll
            for (int j = 0; j < NV4; ++j) y[j] += *(const vf4*)(p.SLAB + ((size_t)s * NCTX + (r - NLAT)) * D_MODEL + (size_t)(j * 64 + lane) * 4); }
    } else
#pragma unroll
    for (int j = 0; j < NV4; ++j) { const vu2 w = *(const vu2*)(p.MIXb + (size_t)r * D_MODEL + (size_t)(j * 64 + lane) * 4); y[j] = (vf4){__uint_as_float(w.x << 16), __uint_as_float(w.x & 0xffff0000u), __uint_as_float(w.y << 16), __uint_as_float(w.y & 0xffff0000u)}; }
    const float rs = row_rs(y);
    const float* g = (which ? p.g_post2 : p.g_post1) + (size_t)l * D_MODEL;
    const float* gate = p.MOD + ((size_t)l * (BATCH + 1) + mod_row(r)) * D6 + (which ? 5 * D_MODEL : 2 * D_MODEL);
#pragma unroll
    for (int j = 0; j < NV4; ++j) { const int c = (j * 64 + lane) * 4; x[j] += *(const vf4*)(gate + c) * (y[j] * rs * *(const vf4*)(g + c)); }
}

struct WtDesc { const float* W; bf16* WT; int K, N, k0, n0, drow0; };
__device__ __forceinline__ void transpose_load(const WtDesc& d, int lane, float (&wv)[32]) {
#pragma unroll
    for (int i = 0; i < 32; ++i) wv[i] = d.W[(size_t)(d.k0 + 2 * i + (lane >> 5)) * d.N + d.n0 + (lane & 31)];
}
__device__ __forceinline__ void transpose_finish(const WtDesc& d, const float (&wv)[32], LAS float* scr, int lane) {
#pragma unroll
    for (int i = 0; i < 32; ++i) scr[(2 * i + (lane >> 5)) * 33 + (lane & 31)] = wv[i];
    asm volatile("s_waitcnt lgkmcnt(0)" ::: "memory");
    const int c = lane & 7;
#pragma unroll
    for (int j = 0; j < 4; ++j) { const int n = (lane >> 3) + 8 * j; const LAS float* s = scr + (8 * c) * 33 + n;
        vu4 o; o.x = pk2(s[0 * 33], s[1 * 33]); o.y = pk2(s[2 * 33], s[3 * 33]); o.z = pk2(s[4 * 33], s[5 * 33]); o.w = pk2(s[6 * 33], s[7 * 33]);
        *(vu4*)(d.WT + (size_t)(d.drow0 + n) * d.K + d.k0 + 8 * c) = o; }
    asm volatile("s_waitcnt lgkmcnt(0)" ::: "memory");
}
__device__ __forceinline__ void transpose_item(const float* W, int K, int N, bf16* WT, int k0, int n0, int drow0, LAS float* scr, int lane) {
    const WtDesc d{W, WT, K, N, k0, n0, drow0}; float wv[32];
    transpose_load(d, lane, wv); transpose_finish(d, wv, scr, lane);
}
__device__ __forceinline__ int inproj_dst_row0(int n0) {
    if (n0 < R_A) return n0;
    if (n0 == R_A) return NP_MAIN;
    if (n0 < R_DT) return n0 - 4 * GDN_H;
    if (n0 == R_DT) return NP_MAIN + PF_DT;
    return n0 - 4 * GDN_H - 2 * SSM_H;
}
__device__ __forceinline__ int up_dst_row0(int n0) {
    const int isg = n0 >= D_FF, j = isg ? n0 - D_FF : n0; return 256 * (j >> 7) + 128 * isg + (j & 127);
}
static_assert(D_FF % 128 == 0, "up-projection tile order");
static_assert(4 * GDN_H == 32 && 2 * SSM_H == 32 && R_A % 32 == 0 && R_DT % 32 == 0, "the 32-column transpose items assume the real shapes");

constexpr int TB = 32;
constexpr int GDN_BUF = TB * 256 + TB * 32 + TB * 2;
__device__ __forceinline__ void gdn_token_wg(const Ptrs& p, LAS float* L, int chain, int slice, int tid) {
    const int b = chain / (GDN_H * 2), h = (chain >> 1) % GDN_H, dir = chain & 1;
    const int lane = tid & 63, wave = tid >> 6, ks = lane & 15, cl = wave * 4 + (lane >> 4);
    LAS float* obuf = L + 2 * GDN_BUF;
    float S[8];
#pragma unroll
    for (int e = 0; e < 8; ++e) S[e] = 0.f;
    vf4 rq[4], rv; float ra = 0.f, rb = 0.f;
    constexpr int NB = CHAIN_LEN / TB;
    auto gload = [&](int n) {
#pragma unroll
        for (int j = 0; j < 4; ++j) { const int idx = j * 512 + tid, i = idx >> 6, c4 = idx & 63; const int r = chain_row(b, dir, n * TB + i);
            rq[j] = *(const vf4*)(p.GQKV + (size_t)r * (3 * MIX_W) + h * 128 + (c4 < 32 ? c4 * 4 : MIX_W + (c4 - 32) * 4)); }
        if (tid < 256) { const int i = tid >> 3, c4 = tid & 7; const int r = chain_row(b, dir, n * TB + i);
            rv = *(const vf4*)(p.GQKV + (size_t)r * (3 * MIX_W) + 2 * MIX_W + h * 128 + slice * 32 + c4 * 4); }
        if (tid < TB) { const int r = chain_row(b, dir, n * TB + tid); ra = __expf(p.GG[(size_t)r * 2 * GDN_H + dir * GDN_H + h]); rb = p.GB[(size_t)r * 2 * GDN_H + dir * GDN_H + h]; }
    };
    auto lstore = [&](LAS float* B) {
#pragma unroll
        for (int j = 0; j < 4; ++j) { const int idx = j * 512 + tid; *(LAS vf4*)(B + (idx >> 6) * 256 + (idx & 63) * 4) = rq[j]; }
        if (tid < 256) *(LAS vf4*)(B + TB * 256 + tid * 4) = rv;
        if (tid < TB) { B[TB * 256 + TB * 32 + tid * 2] = ra; B[TB * 256 + TB * 32 + tid * 2 + 1] = rb; }
    };
    gload(0); lstore(L); LDS_BARRIER();
    for (int n = 0; n < NB; ++n) {
        LAS float* B = L + (n & 1) * GDN_BUF; LAS float* ob = obuf + (n & 1) * (TB * 32);
        if (n + 1 < NB) gload(n + 1);
#pragma unroll 4
        for (int i = 0; i < TB; ++i) {
            const LAS float* kq = B + i * 256;
            const vf4 q0 = *(const LAS vf4*)(kq + ks * 8), q1 = *(const LAS vf4*)(kq + ks * 8 + 4), k0 = *(const LAS vf4*)(kq + 128 + ks * 8), k1 = *(const LAS vf4*)(kq + 128 + ks * 8 + 4);
            const float v = B[TB * 256 + i * 32 + cl], a = B[TB * 256 + TB * 32 + i * 2], be = B[TB * 256 + TB * 32 + i * 2 + 1];
            const float kk[8] = {k0.x, k0.y, k0.z, k0.w, k1.x, k1.y, k1.z, k1.w}, qq[8] = {q0.x, q0.y, q0.z, q0.w, q1.x, q1.y, q1.z, q1.w};
            float rr = 0.f;
#pragma unroll
            for (int e = 0; e < 8; ++e) { S[e] *= a; rr += kk[e] * S[e]; }
            rr = sum16(rr);
            const float dl = be * (v - rr); float o = 0.f;
#pragma unroll
            for (int e = 0; e < 8; ++e) { S[e] += kk[e] * dl; o += qq[e] * S[e]; }
            o = sum16(o);
            if (ks == 0) ob[i * 32 + cl] = o;
        }
        if (n + 1 < NB) lstore(L + ((n + 1) & 1) * GDN_BUF);
        LDS_BARRIER();
        if (tid < 256) { const int i = tid >> 3, c4 = tid & 7; const int r = chain_row(b, dir, n * TB + i);
            *(vf4*)(p.OG + ((size_t)dir * MROWS + r) * MIX_W + h * 128 + slice * 32 + c4 * 4) = *(const LAS vf4*)(ob + i * 32 + c4 * 4); }
    }
}
constexpr int SSD_BUF = TB * 256 + TB * 64 + TB * 2;
__device__ __forceinline__ void ssd_token_wg(const Ptrs& p, LAS float* L, int chain, int tid) {
    const int b = chain / (SSM_H * 2), hd = (chain >> 1) % SSM_H, dir = chain & 1, g = hd / SSM_HPG;
    const int lane = tid & 63, wave = tid >> 6, ss = lane & 7, pc = wave * 8 + (lane >> 3);
    LAS float* obuf = L + 2 * SSD_BUF;
    float hs[16];
#pragma unroll
    for (int e = 0; e < 16; ++e) hs[e] = 0.f;
    vf4 rbc[4], rx; float rdt = 0.f, rea = 0.f;
    constexpr int NB = CHAIN_LEN / TB;
    auto gload = [&](int n) {
#pragma unroll
        for (int j = 0; j < 4; ++j) { const int idx = j * 512 + tid, i = idx >> 6, c4 = idx & 63; const int r = chain_row(b, dir, n * TB + i);
            rbc[j] = *(const vf4*)(p.SXBC + (size_t)r * SSM_XBC + MIX_W + (c4 < 32 ? g * SSM_N + c4 * 4 : SSM_BC + g * SSM_N + (c4 - 32) * 4)); }
        { const int i = tid >> 4, c4 = tid & 15; const int r = chain_row(b, dir, n * TB + i); rx = *(const vf4*)(p.SXBC + (size_t)r * SSM_XBC + hd * SSM_P + c4 * 4); }
        if (tid < TB) { const int r = chain_row(b, dir, n * TB + tid); rdt = p.SDT[(size_t)r * 2 * SSM_H + dir * SSM_H + hd]; rea = __expf(p.SA[(size_t)r * 2 * SSM_H + dir * SSM_H + hd]); }
    };
    auto lstore = [&](LAS float* B) {
#pragma unroll
        for (int j = 0; j < 4; ++j) { const int idx = j * 512 + tid; *(LAS vf4*)(B + (idx >> 6) * 256 + (idx & 63) * 4) = rbc[j]; }
        *(LAS vf4*)(B + TB * 256 + tid * 4) = rx;
        if (tid < TB) { B[TB * 256 + TB * 64 + tid * 2] = rdt; B[TB * 256 + TB * 64 + tid * 2 + 1] = rea; }
    };
    gload(0); lstore(L); LDS_BARRIER();
    for (int n = 0; n < NB; ++n) {
        LAS float* B = L + (n & 1) * SSD_BUF; LAS float* ob = obuf + (n & 1) * (TB * 64);
        if (n + 1 < NB) gload(n + 1);
#pragma unroll 2
        for (int i = 0; i < TB; ++i) {
            const LAS float* bc = B + i * 256;
            const float xd = B[TB * 256 + i * 64 + pc] * B[TB * 256 + TB * 64 + i * 2], ea = B[TB * 256 + TB * 64 + i * 2 + 1];
            float y = 0.f;
#pragma unroll
            for (int q = 0; q < 4; ++q) { const vf4 bv = *(const LAS vf4*)(bc + ss * 16 + q * 4), cv = *(const LAS vf4*)(bc + 128 + ss * 16 + q * 4);
                hs[4 * q + 0] = ea * hs[4 * q + 0] + xd * bv.x; y += cv.x * hs[4 * q + 0];
                hs[4 * q + 1] = ea * hs[4 * q + 1] + xd * bv.y; y += cv.y * hs[4 * q + 1];
                hs[4 * q + 2] = ea * hs[4 * q + 2] + xd * bv.z; y += cv.z * hs[4 * q + 2];
                hs[4 * q + 3] = ea * hs[4 * q + 3] + xd * bv.w; y += cv.w * hs[4 * q + 3]; }
            y = sum8(y);
            if (ss == 0) ob[i * 64 + pc] = y;
        }
        if (n + 1 < NB) lstore(L + ((n + 1) & 1) * SSD_BUF);
        LDS_BARRIER();
        { const int i = tid >> 4, c4 = tid & 15; const int r = chain_row(b, dir, n * TB + i);
            *(vf4*)(p.OS + ((size_t)dir * MROWS + r) * MIX_W + hd * SSM_P + c4 * 4) = *(const LAS vf4*)(ob + i * 64 + c4 * 4); }
    }
}

constexpr int YLD = 3 * MIX_W;
typedef float f32x2_t __attribute__((ext_vector_type(2)));
typedef __bf16 bf16x2_t __attribute__((ext_vector_type(2)));
typedef short bf16x8_t __attribute__((ext_vector_type(8)));
typedef float f32x16_t __attribute__((ext_vector_type(16)));
__device__ __forceinline__ unsigned cvtpk(float lo, float hi) { f32x2_t v = {lo, hi}; bf16x2_t b = __builtin_convertvector(v, bf16x2_t); return __builtin_bit_cast(unsigned, b); }
__device__ __forceinline__ float bflo(unsigned w) { return __uint_as_float(w << 16); }
__device__ __forceinline__ float bfhi(unsigned w) { return __uint_as_float(w & 0xffff0000u); }
__device__ __forceinline__ void unpack8(const vu4 w, float (&f)[8]) { f[0] = bflo(w.x); f[1] = bfhi(w.x); f[2] = bflo(w.y); f[3] = bfhi(w.y); f[4] = bflo(w.z); f[5] = bfhi(w.z); f[6] = bflo(w.w); f[7] = bfhi(w.w); }
__device__ __forceinline__ float silu_fast(float x) { return x * __builtin_amdgcn_rcpf(1.0f + __expf(-x)); }

__device__ __forceinline__ void conv8(const bf16* Prow, bool hp, bool hn, int col, const float* w, int wld, int jc, float (&y)[8]) {
    float xc[8], xp[8], xn[8];
    unpack8(*(const vu4*)(Prow + col), xc);
    if (hp) unpack8(*(const vu4*)(Prow - NP_MAIN + col), xp);
    if (hn) unpack8(*(const vu4*)(Prow + NP_MAIN + col), xn);
    const vf4 w0a = *(const vf4*)(w + jc), w0b = *(const vf4*)(w + jc + 4), w1a = *(const vf4*)(w + wld + jc), w1b = *(const vf4*)(w + wld + jc + 4), w2a = *(const vf4*)(w + 2 * wld + jc), w2b = *(const vf4*)(w + 2 * wld + jc + 4);
    const float w0[8] = {w0a.x, w0a.y, w0a.z, w0a.w, w0b.x, w0b.y, w0b.z, w0b.w}, w1[8] = {w1a.x, w1a.y, w1a.z, w1a.w, w1b.x, w1b.y, w1b.z, w1b.w}, w2[8] = {w2a.x, w2a.y, w2a.z, w2a.w, w2b.x, w2b.y, w2b.z, w2b.w};
#pragma unroll
    for (int e = 0; e < 8; ++e) { float v = w1[e] * xc[e]; if (hp) v += w0[e] * xp[e]; if (hn) v += w2[e] * xn[e]; y[e] = v; }
}
constexpr float ATT_QSCALE = 0.08838834764831845f * 1.4426950408889634f;
__device__ __forceinline__ void prep_row_wave(const Ptrs& p, int l, int r, int lane) {
    int b, t, len; bool ic; row_info(r, b, t, len, ic);
    const bool hp = t > 0, hn = t < len - 1;
    const bf16* Pr = p.P + (size_t)r * NP_MAIN;
    { const float* w = p.gdn_conv_w + (size_t)l * 3 * (3 * MIX_W);
#pragma unroll 3
        for (int ps = 0; ps < (3 * MIX_W) / 512; ++ps) { const int col = ps * 512 + lane * 8, grp = col >> 7; float y[8]; conv8(Pr, hp, hn, C_QKV + col, w, 3 * MIX_W, col, y);
            float ss = 0.f;
#pragma unroll
            for (int e = 0; e < 8; ++e) { y[e] = silu_fast(y[e]); ss += y[e] * y[e]; }
            ss = sum16(ss);
            float sc = 1.0f; if (grp < 2 * GDN_H) { sc = 1.0f / sqrtf(ss + EPS); if (grp < GDN_H) sc *= 0.08838834764831845f; }
            *(vu4*)(p.GQKVb + (size_t)r * (3 * MIX_W) + col) = (vu4){cvtpk(y[0] * sc, y[1] * sc), cvtpk(y[2] * sc, y[3] * sc), cvtpk(y[4] * sc, y[5] * sc), cvtpk(y[6] * sc, y[7] * sc)}; } }
    { const float* w = p.ssm_conv_w + (size_t)l * 3 * SSM_XBC; const float* cb = p.ssm_conv_b + (size_t)l * SSM_XBC;
#pragma unroll 3
        for (int ps = 0; ps < SSM_XBC / 512; ++ps) { const int col = ps * 512 + lane * 8; float y[8]; conv8(Pr, hp, hn, C_XBC + col, w, SSM_XBC, col, y);
            const vf4 ba = *(const vf4*)(cb + col), bb = *(const vf4*)(cb + col + 4); const float bs[8] = {ba.x, ba.y, ba.z, ba.w, bb.x, bb.y, bb.z, bb.w};
#pragma unroll
            for (int e = 0; e < 8; ++e) y[e] = silu_fast(y[e] + bs[e]);
            const vu4 w8 = {cvtpk(y[0], y[1]), cvtpk(y[2], y[3]), cvtpk(y[4], y[5]), cvtpk(y[6], y[7])};
            if (col >= MIX_W) *(vu4*)(p.SBCb + (size_t)r * (2 * SSM_BC) + col - MIX_W) = w8; else *(vu4*)(p.SXb + (size_t)r * MIX_W + col) = w8; } }
    if (lane < 2 * GDN_H) prep_gdn_gb_item(p, l, r, lane);
    if (lane < 2 * SSM_H) prep_ssd_dt_item(p, l, r, lane);
    { const int l16 = lane & 15, ax = l16 >> 3, i0 = (l16 & 7) * 4; const int pos = ic ? 0 : (ax ? t % GRID_W : t / GRID_W);
        const vf4 t0 = *(const vf4*)(p.ROPE + (size_t)(pos * 32 + i0) * 2), t1 = *(const vf4*)(p.ROPE + (size_t)(pos * 32 + i0) * 2 + 4);
        const float cs[4] = {t0.x, t0.z, t1.x, t1.z}, sn[4] = {t0.y, t0.w, t1.y, t1.w};
#pragma unroll 3
        for (int ps = 0; ps < 3; ++ps) { const int hh = ps * 4 + (lane >> 4);
            if (hh < ATT_HQ + ATT_HKV) { const bool isq = hh < ATT_HQ; const int h = isq ? hh : hh - ATT_HQ;
                const bf16* src = Pr + (isq ? C_AQ : C_AKV) + h * 128 + ax * 64 + i0;
                const vu2 a = *(const vu2*)src, c = *(const vu2*)(src + 32);
                const float x1[4] = {bflo(a.x), bfhi(a.x), bflo(a.y), bfhi(a.y)}, x2[4] = {bflo(c.x), bfhi(c.x), bflo(c.y), bfhi(c.y)};
                float o1[4], o2[4]; const float sc = isq ? ATT_QSCALE : 1.0f;
#pragma unroll
                for (int e = 0; e < 4; ++e) { o1[e] = (x1[e] * cs[e] - x2[e] * sn[e]) * sc; o2[e] = (x2[e] * cs[e] + x1[e] * sn[e]) * sc; }
                bf16* dst = (isq ? p.AQb + (size_t)r * MIX_W : p.AKb + (size_t)r * (ATT_HKV * 128)) + h * 128 + ax * 64 + i0;
                vu2 w1; w1.x = cvtpk(o1[0], o1[1]); w1.y = cvtpk(o1[2], o1[3]); vu2 w2; w2.x = cvtpk(o2[0], o2[1]); w2.y = cvtpk(o2[2], o2[3]);
                *(vu2*)dst = w1; *(vu2*)(dst + 32) = w2; } } }
}
constexpr int PREP_RB = 17, PREP_QP = (3 * MIX_W) / 512, PREP_NPASS = PREP_QP + SSM_XBC / 512;
static_assert(MROWS % PREP_RB == 0 && (3 * MIX_W) % 512 == 0 && SSM_XBC % 512 == 0 && MIX_W % 512 == 0 && PREP_NPASS <= PREP_RB && 2 * PREP_NPASS >= PREP_RB, "prep tiling");
__device__ __forceinline__ void prep_row_scalars_wave(const Ptrs& p, int l, int r, int lane);
__device__ __forceinline__ void prep_conv_block_wave(const Ptrs& p, int l, int blk, int ps, int lane) {
    const int r0 = blk * PREP_RB; const bool isx = ps >= PREP_QP;
    const int col = (isx ? ps - PREP_QP : ps) * 512 + lane * 8, wld = isx ? SSM_XBC : 3 * MIX_W, grp = col >> 7;
    const float* w = (isx ? p.ssm_conv_w + (size_t)l * 3 * SSM_XBC : p.gdn_conv_w + (size_t)l * 3 * (3 * MIX_W)) + col;
    const vf4 w0a = *(const vf4*)w, w0b = *(const vf4*)(w + 4), w1a = *(const vf4*)(w + wld), w1b = *(const vf4*)(w + wld + 4), w2a = *(const vf4*)(w + 2 * wld), w2b = *(const vf4*)(w + 2 * wld + 4);
    const float w0[8] = {w0a.x, w0a.y, w0a.z, w0a.w, w0b.x, w0b.y, w0b.z, w0b.w}, w1[8] = {w1a.x, w1a.y, w1a.z, w1a.w, w1b.x, w1b.y, w1b.z, w1b.w}, w2[8] = {w2a.x, w2a.y, w2a.z, w2a.w, w2b.x, w2b.y, w2b.z, w2b.w};
    float bs[8] = {0.f, 0.f, 0.f, 0.f, 0.f, 0.f, 0.f, 0.f};
    if (isx) { const float* cb = p.ssm_conv_b + (size_t)l * SSM_XBC + col; const vf4 ba = *(const vf4*)cb, bb = *(const vf4*)(cb + 4); bs[0] = ba.x; bs[1] = ba.y; bs[2] = ba.z; bs[3] = ba.w; bs[4] = bb.x; bs[5] = bb.y; bs[6] = bb.z; bs[7] = bb.w; }
    const bf16* src = p.P + (size_t)r0 * NP_MAIN + (isx ? C_XBC : C_QKV) + col;
    vu4 rows[PREP_RB + 2];
#pragma unroll
    for (int j = 0; j < PREP_RB + 2; ++j) { const int r = r0 - 1 + j; rows[j] = (r >= 0 && r < MROWS) ? *(const vu4*)(src + ((ptrdiff_t)j - 1) * NP_MAIN) : (vu4){0u, 0u, 0u, 0u}; }
    prep_row_scalars_wave(p, l, r0 + ps, lane);
    if (ps + PREP_NPASS < PREP_RB) prep_row_scalars_wave(p, l, r0 + ps + PREP_NPASS, lane);
    float xp[8], xc[8], xn[8];
    unpack8(rows[0], xp); unpack8(rows[1], xc);
#pragma unroll
    for (int i = 0; i < PREP_RB; ++i) { const int r = r0 + i; int b, t, len; bool ic; row_info(r, b, t, len, ic); const bool hp = t > 0, hn = t < len - 1;
        unpack8(rows[i + 2], xn);
        float y[8];
#pragma unroll
        for (int e = 0; e < 8; ++e) { float v = w1[e] * xc[e] + bs[e]; if (hp) v += w0[e] * xp[e]; if (hn) v += w2[e] * xn[e]; y[e] = silu_fast(v); }
        if (isx) { const vu4 w8 = {cvtpk(y[0], y[1]), cvtpk(y[2], y[3]), cvtpk(y[4], y[5]), cvtpk(y[6], y[7])};
            if (col >= MIX_W) *(vu4*)(p.SBCb + (size_t)r * (2 * SSM_BC) + col - MIX_W) = w8; else *(vu4*)(p.SXb + (size_t)r * MIX_W + col) = w8; }
        else { float ss = 0.f;
#pragma unroll
            for (int e = 0; e < 8; ++e) ss += y[e] * y[e];
            ss = sum16(ss);
            float sc = 1.0f; if (grp < 2 * GDN_H) { sc = 1.0f / sqrtf(ss + EPS); if (grp < GDN_H) sc *= 0.08838834764831845f; }
            *(vu4*)(p.GQKVb + (size_t)r * (3 * MIX_W) + col) = (vu4){cvtpk(y[0] * sc, y[1] * sc), cvtpk(y[2] * sc, y[3] * sc), cvtpk(y[4] * sc, y[5] * sc), cvtpk(y[6] * sc, y[7] * sc)}; }
#pragma unroll
        for (int e = 0; e < 8; ++e) { xp[e] = xc[e]; xc[e] = xn[e]; } }
}
__device__ __forceinline__ void prep_row_scalars_wave(const Ptrs& p, int l, int r, int lane) {
    int b, t, len; bool ic; row_info(r, b, t, len, ic);
    const bf16* Pr = p.P + (size_t)r * NP_MAIN;
    if (lane < 2 * GDN_H) prep_gdn_gb_item(p, l, r, lane);
    if (lane < 2 * SSM_H) prep_ssd_dt_item(p, l, r, lane);
    { const int l16 = lane & 15, ax = l16 >> 3, i0 = (l16 & 7) * 4; const int pos = ic ? 0 : (ax ? t % GRID_W : t / GRID_W);
        const vf4 t0 = *(const vf4*)(p.ROPE + (size_t)(pos * 32 + i0) * 2), t1 = *(const vf4*)(p.ROPE + (size_t)(pos * 32 + i0) * 2 + 4);
        const float cs[4] = {t0.x, t0.z, t1.x, t1.z}, sn[4] = {t0.y, t0.w, t1.y, t1.w};
#pragma unroll 3
        for (int ps = 0; ps < 3; ++ps) { const int hh = ps * 4 + (lane >> 4);
            if (hh < ATT_HQ + ATT_HKV) { const bool isq = hh < ATT_HQ; const int h = isq ? hh : hh - ATT_HQ;
                const bf16* src = Pr + (isq ? C_AQ : C_AKV) + h * 128 + ax * 64 + i0;
                const vu2 a = *(const vu2*)src, c = *(const vu2*)(src + 32);
                const float x1[4] = {bflo(a.x), bfhi(a.x), bflo(a.y), bfhi(a.y)}, x2[4] = {bflo(c.x), bfhi(c.x), bflo(c.y), bfhi(c.y)};
                float o1[4], o2[4]; const float sc = isq ? ATT_QSCALE : 1.0f;
#pragma unroll
                for (int e = 0; e < 4; ++e) { o1[e] = (x1[e] * cs[e] - x2[e] * sn[e]) * sc; o2[e] = (x2[e] * cs[e] + x1[e] * sn[e]) * sc; }
                bf16* dst = (isq ? p.AQb + (size_t)r * MIX_W : p.AKb + (size_t)r * (ATT_HKV * 128)) + h * 128 + ax * 64 + i0;
                vu2 w1; w1.x = cvtpk(o1[0], o1[1]); w1.y = cvtpk(o1[2], o1[3]); vu2 w2; w2.x = cvtpk(o2[0], o2[1]); w2.y = cvtpk(o2[2], o2[3]);
                *(vu2*)dst = w1; *(vu2*)(dst + 32) = w2; } } }
}
__device__ __forceinline__ void mixout_row_wave(const Ptrs& p, int l, int r, int lane) {
    const int c0 = lane * 16;
    {
        float o[16]; float ss = 0.f;
#pragma unroll
        for (int q = 0; q < 2; ++q) { float a8[8], b8[8]; unpack8(*(const vu4*)(p.OGb + (size_t)r * MIX_W + c0 + 8 * q), a8); unpack8(*(const vu4*)(p.OGb + ((size_t)MROWS + r) * MIX_W + c0 + 8 * q), b8);
#pragma unroll
            for (int e = 0; e < 8; ++e) o[8 * q + e] = a8[e] + b8[e]; }
#pragma unroll
        for (int e = 0; e < 16; ++e) ss += o[e] * o[e];
        ss = sum8(ss);
        const float rs = 1.0f / sqrtf(ss * (1.0f / 128.0f) + EPS);
        float gt[16]; { float t8[8]; unpack8(*(const vu4*)(p.P + (size_t)r * NP_MAIN + C_GATE + c0), t8);
#pragma unroll
            for (int e = 0; e < 8; ++e) gt[e] = t8[e];
            unpack8(*(const vu4*)(p.P + (size_t)r * NP_MAIN + C_GATE + c0 + 8), t8);
#pragma unroll
            for (int e = 0; e < 8; ++e) gt[8 + e] = t8[e]; }
        const float* nw = p.gdn_norm + (size_t)l * 128 + (c0 & 127);
        unsigned w[8];
#pragma unroll
        for (int e = 0; e < 8; ++e) w[e] = cvtpk(o[2 * e] * rs * nw[2 * e] * silu_fast(gt[2 * e]), o[2 * e + 1] * rs * nw[2 * e + 1] * silu_fast(gt[2 * e + 1]));
        *(vu4*)(p.YA + (size_t)r * YLD + c0) = (vu4){w[0], w[1], w[2], w[3]}; *(vu4*)(p.YA + (size_t)r * YLD + c0 + 8) = (vu4){w[4], w[5], w[6], w[7]};
    }
    {
        float y[16]; float ss = 0.f; const float dsk = p.ssm_d[(size_t)l * SSM_H + c0 / SSM_P];
        float zt[16]; { float t8[8]; unpack8(*(const vu4*)(p.P + (size_t)r * NP_MAIN + C_Z + c0), t8);
#pragma unroll
            for (int e = 0; e < 8; ++e) zt[e] = t8[e];
            unpack8(*(const vu4*)(p.P + (size_t)r * NP_MAIN + C_Z + c0 + 8), t8);
#pragma unroll
            for (int e = 0; e < 8; ++e) zt[8 + e] = t8[e]; }
#pragma unroll
        for (int q = 0; q < 2; ++q) { float a8[8], c8[8], d8[8], x8[8]; unpack8(*(const vu4*)(p.OSb + (size_t)r * MIX_W + c0 + 8 * q), a8);
            unpack8(*(const vu4*)(p.OSb2 + (size_t)r * MIX_W + c0 + 8 * q), c8); unpack8(*(const vu4*)(p.OSb2 + ((size_t)MROWS + r) * MIX_W + c0 + 8 * q), d8); unpack8(*(const vu4*)(p.SXb + (size_t)r * MIX_W + c0 + 8 * q), x8);
#pragma unroll
            for (int e = 0; e < 8; ++e) y[8 * q + e] = a8[e] + (c8[e] + d8[e]) + dsk * x8[e]; }
#pragma unroll
        for (int e = 0; e < 16; ++e) { y[e] *= silu_fast(zt[e]); ss += y[e] * y[e]; }
        ss = sum16(ss); ss += __shfl_xor(ss, 16);
        const float rs = 1.0f / sqrtf(ss * (1.0f / (float)(MIX_W / SSM_G)) + EPS);
        const float* nw = p.ssm_norm + (size_t)l * MIX_W + c0;
        unsigned w[8];
#pragma unroll
        for (int e = 0; e < 8; ++e) w[e] = cvtpk(y[2 * e] * rs * nw[2 * e], y[2 * e + 1] * rs * nw[2 * e + 1]);
        *(vu4*)(p.YB + (size_t)r * YLD + c0) = (vu4){w[0], w[1], w[2], w[3]}; *(vu4*)(p.YB + (size_t)r * YLD + c0 + 8) = (vu4){w[4], w[5], w[6], w[7]};
    }
}
static_assert(MIX_W == 1024 && SSM_P == 64 && MIX_W / SSM_G == 512, "mixout_row_wave lane mapping assumes the real shapes");
__device__ __forceinline__ void act_vec_item(const Ptrs& p, int l, int r, int j) {
    int b, t, len; bool ic; row_info(r, b, t, len, ic);
    const bf16* ug = p.UG + (size_t)r * (2 * D_FF);
    float u[8], g[8], gp[8], gn[8];
    unpack8(*(const vu4*)(ug + j), u); unpack8(*(const vu4*)(ug + D_FF + j), g);
    const bool hp = t > 0, hn = t < len - 1;
    if (hp) unpack8(*(const vu4*)(ug - 2 * D_FF + D_FF + j), gp);
    if (hn) unpack8(*(const vu4*)(ug + 2 * D_FF + D_FF + j), gn);
    const float* w = p.ffn_conv_w + (size_t)l * 3 * D_FF + j; const float* cb = p.ffn_conv_b + (size_t)l * D_FF + j;
    unsigned o[4];
    float a[8];
#pragma unroll
    for (int e = 0; e < 8; ++e) { float v = w[D_FF + e] * g[e] + cb[e]; if (hp) v += w[e] * gp[e]; if (hn) v += w[2 * D_FF + e] * gn[e]; a[e] = silu_fast(v) * u[e]; }
#pragma unroll
    for (int e = 0; e < 4; ++e) o[e] = cvtpk(a[2 * e], a[2 * e + 1]);
    *(vu4*)(p.ACT + (size_t)r * D_FF + j) = (vu4){o[0], o[1], o[2], o[3]};
}

__device__ __forceinline__ void act_task(const Ptrs& p, int l, int task) {
    constexpr int NJ = D_FF / 8;
    const int rc = task / NJ, j = (task % NJ) * 8, r0 = rc * 16;
    int b, t, len; bool ic; row_info(r0, b, t, len, ic);
    const float* w = p.ffn_conv_w + (size_t)l * 3 * D_FF + j; const float* cb = p.ffn_conv_b + (size_t)l * D_FF + j;
    float w0[8], w1[8], w2[8], bs[8];
    { const vf4 a0 = *(const vf4*)w, a1 = *(const vf4*)(w + 4), b0 = *(const vf4*)(w + D_FF), b1 = *(const vf4*)(w + D_FF + 4), c0 = *(const vf4*)(w + 2 * D_FF), c1 = *(const vf4*)(w + 2 * D_FF + 4), d0 = *(const vf4*)cb, d1 = *(const vf4*)(cb + 4);
        const float t0[8] = {a0.x, a0.y, a0.z, a0.w, a1.x, a1.y, a1.z, a1.w}, t1[8] = {b0.x, b0.y, b0.z, b0.w, b1.x, b1.y, b1.z, b1.w}, t2[8] = {c0.x, c0.y, c0.z, c0.w, c1.x, c1.y, c1.z, c1.w}, t3[8] = {d0.x, d0.y, d0.z, d0.w, d1.x, d1.y, d1.z, d1.w};
#pragma unroll
        for (int e = 0; e < 8; ++e) { w0[e] = t0[e]; w1[e] = t1[e]; w2[e] = t2[e]; bs[e] = t3[e]; } }
    const bf16* base = p.UG + (size_t)r0 * (2 * D_FF) + j;
    vu4 gq[18], uq[16];
    const vu4 z4 = {0u, 0u, 0u, 0u};
    gq[0] = (t > 0) ? *(const vu4*)(base - 2 * D_FF + D_FF) : z4;
#pragma unroll
    for (int i = 0; i < 16; ++i) { gq[i + 1] = *(const vu4*)(base + (size_t)i * (2 * D_FF) + D_FF); uq[i] = *(const vu4*)(base + (size_t)i * (2 * D_FF)); }
    gq[17] = (t + 16 < len) ? *(const vu4*)(base + (size_t)16 * (2 * D_FF) + D_FF) : z4;
#pragma unroll
    for (int i = 0; i < 16; ++i) { float gp[8], gc[8], gn[8], u[8]; unpack8(gq[i], gp); unpack8(gq[i + 1], gc); unpack8(gq[i + 2], gn); unpack8(uq[i], u);
        float a[8];
#pragma unroll
        for (int e = 0; e < 8; ++e) a[e] = silu_fast(w0[e] * gp[e] + w1[e] * gc[e] + w2[e] * gn[e] + bs[e]) * u[e];
        *(vu4*)(p.ACT + (size_t)(r0 + i) * D_FF + j) = (vu4){cvtpk(a[0], a[1]), cvtpk(a[2], a[3]), cvtpk(a[4], a[5]), cvtpk(a[6], a[7])}; }
}
static_assert(SEQ % 16 == 0 && CTX_LEN % 16 == 0, "act_task row chunks must not straddle sequences");

__device__ __forceinline__ void act_fix_item(const Ptrs& p, int l, int bidx, int j) {
    const int row = (bidx >> 1) * 64 + ((bidx & 1) ? 63 : 0);
    int b, t, len; bool ic; row_info(row, b, t, len, ic);
    const size_t bi = (size_t)bidx * D_FF + j;
    vf4 pre = *(const vf4*)(p.BP + bi);
    const vu2 uw = *(const vu2*)(p.BU + bi);
    const bool hasn = (bidx & 1) ? (t < len - 1) : (t > 0);
    if (hasn) { const vu2 gw = *(const vu2*)(p.BG + (size_t)((bidx & 1) ? bidx + 1 : bidx - 1) * D_FF + j);
        const vf4 w = *(const vf4*)(p.ffn_conv_w + (size_t)l * 3 * D_FF + ((bidx & 1) ? 2 * D_FF : 0) + j);
        pre += w * (vf4){bflo(gw.x), bfhi(gw.x), bflo(gw.y), bfhi(gw.y)}; }
    const float u4[4] = {bflo(uw.x), bfhi(uw.x), bflo(uw.y), bfhi(uw.y)};
    *(vu2*)(p.ACT + (size_t)row * D_FF + j) = (vu2){cvtpk(silu_fast(pre.x) * u4[0], silu_fast(pre.y) * u4[1]), cvtpk(silu_fast(pre.z) * u4[2], silu_fast(pre.w) * u4[3])};
}

constexpr int AT_KSTR = 136, AT_VSTR = 68;
constexpr int AT_BUF = 64 * AT_KSTR + 128 * AT_VSTR;
constexpr int ATT_UNITS_LAT = BATCH * ATT_HKV * (SEQ / 64), ATT_UNITS_CTX = BATCH * ATT_HKV * (CTX_LEN / 64);
__device__ __forceinline__ void attn_unit(const Ptrs& p, int l, LAS bf16* L, int unit, int tid) {
    const int lane = tid & 63, wave = tid >> 6, r32 = lane & 31, h = lane >> 5;
    const bool cu = unit >= ATT_UNITS_LAT; const int uu = cu ? unit - ATT_UNITS_LAT : unit;
    const int nqb = cu ? CTX_LEN / 64 : SEQ / 64;
    const int b = uu / (ATT_HKV * nqb), kvh = (uu / nqb) % ATT_HKV, qb = uu % nqb, q0 = qb * 64;
    const int rowbase = (cu ? NLAT + b * CTX_LEN : b * SEQ) + q0;
    const int g = wave >> 1, qh = wave & 1, hq = kvh * ATT_GRP + g;
    const int qpos = q0 + 32 * qh + r32, qrow = rowbase + 32 * qh + r32;
    bf16x8_t qf[8];
#pragma unroll
    for (int s = 0; s < 8; ++s) qf[s] = *(const bf16x8_t*)(p.AQb + (size_t)qrow * MIX_W + hq * 128 + 16 * s + 8 * h);
    float m = p.attn_sink[(size_t)l * ATT_HQ + hq] * 1.4426950408889634f, lsum = h ? 0.f : 1.0f;
    f32x16_t o[4];
#pragma unroll
    for (int d = 0; d < 4; ++d)
#pragma unroll
        for (int e = 0; e < 16; ++e) o[d][e] = 0.f;
    const int jl0 = cu ? 5 : (q0 - 128 < 0 ? (128 - q0) / 64 : 0), jl1 = cu ? 5 : ((q0 + 192 > SEQ) ? 5 - (q0 + 192 - SEQ) / 64 : 5);
    const int nt = (jl1 - jl0) + CTX_LEN / 64;
    vu4 rk[2], rv[2];
    auto tile_row0 = [&](int ti, int& kpos0) -> int { const int j = jl0 + ti; if (j < jl1) { kpos0 = q0 - 128 + 64 * j; return b * SEQ + kpos0; } kpos0 = -1000000; return NLAT + b * CTX_LEN + 64 * (j - jl1); };
    auto gload = [&](int ti) { int kp; const int kr0 = tile_row0(ti, kp);
#pragma unroll
        for (int it = 0; it < 2; ++it) { const int c = tid + 512 * it;
            rk[it] = *(const vu4*)(p.AKb + (size_t)(kr0 + (c >> 4)) * (ATT_HKV * 128) + kvh * 128 + (c & 15) * 8);
            const int vk = (c & 15) | (((c >> 6) & 3) << 4), vd = ((c >> 4) & 3) | ((c >> 8) << 2);
            rv[it] = *(const vu4*)(p.P + (size_t)(kr0 + vk) * NP_MAIN + C_AKV + ATT_HKV * 128 + kvh * 128 + vd * 8); } };
    auto lstore = [&](LAS bf16* B) {
#pragma unroll
        for (int it = 0; it < 2; ++it) { const int c = tid + 512 * it;
            *(LAS vu4*)(B + (c >> 4) * AT_KSTR + (c & 15) * 8) = rk[it];
            const int vk = (c & 15) | (((c >> 6) & 3) << 4), vd = ((c >> 4) & 3) | ((c >> 8) << 2);
            LAS bf16* vt = B + 64 * AT_KSTR + (vd * 8) * AT_VSTR + vk;
            const unsigned w4[4] = {rv[it].x, rv[it].y, rv[it].z, rv[it].w};
#pragma unroll
            for (int e = 0; e < 4; ++e) { vt[(2 * e) * AT_VSTR] = (bf16)(w4[e] & 0xffffu); vt[(2 * e + 1) * AT_VSTR] = (bf16)(w4[e] >> 16); } } };
    gload(0); lstore(L); LDS_BARRIER();
    for (int ti = 0; ti < nt; ++ti) {
        LAS bf16* B = L + (ti & 1) * AT_BUF;
        int kpos0; (void)tile_row0(ti, kpos0);
        if (ti + 1 < nt) gload(ti + 1);
        f32x16_t st[2];
#pragma unroll
        for (int sub = 0; sub < 2; ++sub) {
#pragma unroll
            for (int e = 0; e < 16; ++e) st[sub][e] = 0.f;
            bf16x8_t kf[8];
#pragma unroll
            for (int s = 0; s < 8; ++s) kf[s] = *(const LAS bf16x8_t*)(B + (32 * sub + r32) * AT_KSTR + 16 * s + 8 * h);
            __builtin_amdgcn_s_setprio(1);
#pragma unroll
            for (int s = 0; s < 8; ++s) st[sub] = __builtin_amdgcn_mfma_f32_32x32x16_bf16(kf[s], qf[s], st[sub], 0, 0, 0);
            __builtin_amdgcn_s_setprio(0); }
        float mx = -1e30f;
#pragma unroll
        for (int sub = 0; sub < 2; ++sub)
#pragma unroll
            for (int e = 0; e < 16; ++e) { const int key = 32 * sub + (e & 3) + 8 * (e >> 2) + 4 * h; const int dlt = kpos0 + key - qpos;
                if (kpos0 > -500000 && (dlt > WINDOW || dlt < -WINDOW)) st[sub][e] = -1e30f;
                mx = fmaxf(mx, st[sub][e]); }
        mx = fmaxf(mx, __shfl_xor(mx, 32));
        const float mn = fmaxf(m, mx), alpha = __builtin_amdgcn_exp2f(m - mn); m = mn;
        float ps = 0.f;
#pragma unroll
        for (int sub = 0; sub < 2; ++sub)
#pragma unroll
            for (int e = 0; e < 16; ++e) { const float pe = __builtin_amdgcn_exp2f(st[sub][e] - mn); st[sub][e] = pe; ps += pe; }
        lsum = lsum * alpha + ps;
        if (!__all(alpha == 1.0f)) {
#pragma unroll
            for (int d = 0; d < 4; ++d)
#pragma unroll
                for (int e = 0; e < 16; ++e) o[d][e] *= alpha; }
#pragma unroll
        for (int kk = 0; kk < 4; ++kk) { const int sub = kk >> 1, s8 = (kk & 1) * 8;
            vu4 pw; pw.x = cvtpk(st[sub][s8], st[sub][s8 + 1]); pw.y = cvtpk(st[sub][s8 + 2], st[sub][s8 + 3]); pw.z = cvtpk(st[sub][s8 + 4], st[sub][s8 + 5]); pw.w = cvtpk(st[sub][s8 + 6], st[sub][s8 + 7]);
            const bf16x8_t pf = __builtin_bit_cast(bf16x8_t, pw);
            bf16x8_t vf[4];
#pragma unroll
            for (int d = 0; d < 4; ++d) { const LAS bf16* vp = B + 64 * AT_KSTR + (32 * d + r32) * AT_VSTR + 16 * kk + 4 * h;
                const vu2 lo = *(const LAS vu2*)vp, hi = *(const LAS vu2*)(vp + 8);
                vf[d] = __builtin_bit_cast(bf16x8_t, (vu4){lo.x, lo.y, hi.x, hi.y}); }
            __builtin_amdgcn_s_setprio(1);
#pragma unroll
            for (int d = 0; d < 4; ++d) o[d] = __builtin_amdgcn_mfma_f32_32x32x16_bf16(vf[d], pf, o[d], 0, 0, 0);
            __builtin_amdgcn_s_setprio(0); }
        if (ti + 1 < nt) lstore(L + ((ti + 1) & 1) * AT_BUF);
        LDS_BARRIER();
    }
    lsum += __shfl_xor(lsum, 32);
    const float inv = 1.0f / lsum;
    LAS bf16* os = L + wave * (32 * AT_KSTR);
#pragma unroll
    for (int d = 0; d < 4; ++d)
#pragma unroll
        for (int a4 = 0; a4 < 4; ++a4) { vu2 w; w.x = cvtpk(o[d][4 * a4] * inv, o[d][4 * a4 + 1] * inv); w.y = cvtpk(o[d][4 * a4 + 2] * inv, o[d][4 * a4 + 3] * inv);
            *(LAS vu2*)(os + r32 * AT_KSTR + 32 * d + 8 * a4 + 4 * h) = w; }
    LDS_BARRIER();
#pragma unroll
    for (int i = 0; i < 8; ++i) { const int c = lane + 64 * i, row = c >> 4, ch = c & 15;
        *(vu4*)(p.YC + (size_t)(rowbase + 32 * qh + row) * YLD + hq * 128 + ch * 8) = *(const LAS vu4*)(os + row * AT_KSTR + ch * 8); }
    LDS_BARRIER();
}
static_assert(2 * AT_BUF * 2 <= 131072 && 8 * 32 * AT_KSTR <= 2 * AT_BUF, "attention LDS map");

constexpr int NCH = CHAIN_LEN / 64, NCH_CTX = CTX_LEN / 64;
constexpr int GDN_NU = BATCH * NCH * GDN_H * 2;
constexpr int GC_KS = 136, GC_FS = 65, GC_LS = 68, GC_TS = 72;
__device__ __forceinline__ int gdn_unit_index(int b, int c, int h, int dir) { return ((b * NCH + c) * GDN_H + h) * 2 + dir; }
__device__ __forceinline__ int chunk_row0(int b, int c) { return c < NCH_CTX ? NLAT + b * CTX_LEN + 64 * c : b * SEQ + 64 * (c - NCH_CTX); }
template <int NK> __device__ __forceinline__ f32x16_t mma_lds(f32x16_t acc, const LAS bf16* A, int lda, const LAS bf16* Bt, int ldb, int r32, int hh) {
    bf16x8_t a[NK], bb[NK];
#pragma unroll
    for (int s = 0; s < NK; ++s) { a[s] = *(const LAS bf16x8_t*)(A + r32 * lda + 16 * s + 8 * hh); bb[s] = *(const LAS bf16x8_t*)(Bt + r32 * ldb + 16 * s + 8 * hh); }
    f32x16_t acc2;
#pragma unroll
    for (int e = 0; e < 16; ++e) acc2[e] = 0.f;
#pragma unroll
    for (int s = 0; s < NK; s += 2) { acc = __builtin_amdgcn_mfma_f32_32x32x16_bf16(a[s], bb[s], acc, 0, 0, 0); acc2 = __builtin_amdgcn_mfma_f32_32x32x16_bf16(a[s + 1], bb[s + 1], acc2, 0, 0, 0); }
#pragma unroll
    for (int e = 0; e < 16; ++e) acc[e] += acc2[e];
    return acc;
}
__device__ __forceinline__ f32x16_t zero16() { f32x16_t z;
#pragma unroll
    for (int e = 0; e < 16; ++e) z[e] = 0.f;
    return z; }
__device__ __forceinline__ void tri_solve_wave(const LAS float* Lm, LAS bf16* Tm, LAS bf16* scr, int lane) {
    const int blk = lane >> 5, c = lane & 31, r32 = c, hh = blk;
    LAS bf16* B00 = scr; LAS bf16* XT = scr + 32 * 40;
    float t[32];
    vf4 lb[3][8];
#define TRI_LDROW(i_) do { _Pragma("unroll") for (int j4 = 0; j4 < ((i_) + 3) / 4; ++j4) lb[(i_) % 3][j4] = *(const LAS vf4*)(Lm + (32 * blk + (i_)) * GC_LS + 32 * blk + 4 * j4); } while (0)
    TRI_LDROW(1);
#pragma unroll
    for (int i = 0; i < 32; ++i) {
        if (i + 2 < 32) TRI_LDROW(i + 2);
        float s = (i == c) ? 1.0f : 0.0f;
#pragma unroll
        for (int j4 = 0; j4 < (i + 3) / 4; ++j4) { const vf4 lv = lb[i % 3][j4];
            if (4 * j4 + 0 < i) s -= lv.x * t[4 * j4 + 0];
            if (4 * j4 + 1 < i) s -= lv.y * t[4 * j4 + 1];
            if (4 * j4 + 2 < i) s -= lv.z * t[4 * j4 + 2];
            if (4 * j4 + 3 < i) s -= lv.w * t[4 * j4 + 3]; }
        t[i] = s;
        asm volatile("" : "+v"(t[i]));
    }
#undef TRI_LDROW
#pragma unroll
    for (int i = 0; i < 32; ++i) { Tm[(32 * blk + i) * GC_TS + 32 * blk + c] = f2bf(t[i]); if (blk == 0) Tm[i * GC_TS + 32 + c] = (bf16)0; }
    if (blk == 0) {
#pragma unroll
        for (int q = 0; q < 4; ++q) *(LAS vu4*)(B00 + c * 40 + 8 * q) = (vu4){cvtpk(t[8 * q], t[8 * q + 1]), cvtpk(t[8 * q + 2], t[8 * q + 3]), cvtpk(t[8 * q + 4], t[8 * q + 5]), cvtpk(t[8 * q + 6], t[8 * q + 7])}; }
    f32x16_t x = zero16();
#pragma unroll
    for (int s = 0; s < 2; ++s) { const LAS float* lp = Lm + (32 + r32) * GC_LS + 16 * s + 8 * hh; const vf4 l0 = *(const LAS vf4*)lp, l1 = *(const LAS vf4*)(lp + 4);
        const bf16x8_t a = __builtin_bit_cast(bf16x8_t, (vu4){cvtpk(l0.x, l0.y), cvtpk(l0.z, l0.w), cvtpk(l1.x, l1.y), cvtpk(l1.z, l1.w)});
        const bf16x8_t bb = *(const LAS bf16x8_t*)(B00 + r32 * 40 + 16 * s + 8 * hh);
        x = __builtin_amdgcn_mfma_f32_32x32x16_bf16(a, bb, x, 0, 0, 0); }
#pragma unroll
    for (int a4 = 0; a4 < 4; ++a4) *(LAS vu2*)(XT + r32 * 40 + 8 * a4 + 4 * hh) = (vu2){cvtpk(x[4 * a4], x[4 * a4 + 1]), cvtpk(x[4 * a4 + 2], x[4 * a4 + 3])};
    f32x16_t y = zero16();
#pragma unroll
    for (int s = 0; s < 2; ++s) { const bf16x8_t a = *(const LAS bf16x8_t*)(Tm + (32 + r32) * GC_TS + 32 + 16 * s + 8 * hh), bb = *(const LAS bf16x8_t*)(XT + r32 * 40 + 16 * s + 8 * hh);
        y = __builtin_amdgcn_mfma_f32_32x32x16_bf16(a, bb, y, 0, 0, 0); }
#pragma unroll
    for (int e = 0; e < 16; ++e) Tm[(32 + (e & 3) + 8 * (e >> 2) + 4 * hh) * GC_TS + r32] = f2bf(-y[e]);
}
constexpr int G1_KK = 0, G1_QK = G1_KK + 64 * GC_FS * 4, G1_L = G1_QK + 64 * GC_FS * 4, G1_T = G1_L + 2 * 64 * GC_LS * 4,
              G1_KB = G1_T + 2 * 64 * GC_TS * 2, G1_VB = G1_KB + 128 * GC_TS * 2, G1_SM = G1_VB + 128 * GC_TS * 2, G1_END = G1_SM + 10 * 64 * 4;
__device__ __forceinline__ void st_vu2(LAS bf16* q, vu2 v) { *(LAS vu2*)q = v; }
__device__ __forceinline__ void st_vu2(bf16* q, vu2 v) { *(vu2*)q = v; }
__device__ __forceinline__ void gdn_g1_unit(const Ptrs& p, LAS unsigned char* lds, int unit, int tid) {
    const int lane = tid & 63, wave = tid >> 6, r32 = lane & 31, hh = lane >> 5;
    const int b = unit / (NCH * GDN_H), c = (unit / GDN_H) % NCH, h = unit % GDN_H;
    const int r0 = chunk_row0(b, c);
    LAS float* KKs = (LAS float*)(lds + G1_KK); LAS float* QKs = (LAS float*)(lds + G1_QK);
    LAS float* Lm = (LAS float*)(lds + G1_L); LAS bf16* Tm = (LAS bf16*)(lds + G1_T); LAS bf16* KbT = (LAS bf16*)(lds + G1_KB); LAS bf16* VbT = (LAS bf16*)(lds + G1_VB);
    LAS float* gc = (LAS float*)(lds + G1_SM); LAS float* be = gc + 128; LAS float* eg = gc + 256; LAS float* beg = gc + 384; LAS float* egl = gc + 512;
    const bf16* Qg = p.GQKVb + (size_t)r0 * (3 * MIX_W) + h * 128;
    const int prod = wave >> 2, mt = (wave >> 1) & 1, nt = wave & 1;
    bf16x8_t fa[8], fb[8], ft[4];
    { const bf16* Ap = Qg + (size_t)(32 * mt + r32) * (3 * MIX_W) + (prod ? 0 : MIX_W) + 8 * hh;
      const bf16* Bp = Qg + (size_t)(32 * nt + r32) * (3 * MIX_W) + MIX_W + 8 * hh;
      const bf16* Tp = Qg + (size_t)(32 * mt + r32) * (3 * MIX_W) + (prod ? 2 * MIX_W : MIX_W) + 64 * nt + 8 * hh;
#pragma unroll
      for (int s = 0; s < 8; ++s) { fa[s] = *(const bf16x8_t*)(Ap + 16 * s); fb[s] = *(const bf16x8_t*)(Bp + 16 * s); }
#pragma unroll
      for (int s = 0; s < 4; ++s) ft[s] = *(const bf16x8_t*)(Tp + 16 * s); }
    if (wave < 2) { const int dir = wave, n = dir ? 63 - lane : lane; const size_t gi = (size_t)(r0 + n) * 2 * GDN_H + dir * GDN_H + h;
        float x = p.GG[gi]; const float bt = p.GB[gi];
#pragma unroll
        for (int o = 1; o < 64; o <<= 1) { const float y = __shfl_up(x, o); if (lane >= o) x += y; }
        const float x63 = __shfl(x, 63), ex = __expf(x);
        gc[dir * 64 + lane] = x; be[dir * 64 + lane] = bt; eg[dir * 64 + lane] = ex; beg[dir * 64 + lane] = bt * ex; egl[dir * 64 + lane] = __expf(x63 - x); }
    f32x16_t tt[2];
    { f32x16_t acc = zero16(), acc2 = zero16();
#pragma unroll
      for (int s = 0; s < 8; s += 2) { acc = __builtin_amdgcn_mfma_f32_32x32x16_bf16(fa[s], fb[s], acc, 0, 0, 0); acc2 = __builtin_amdgcn_mfma_f32_32x32x16_bf16(fa[s + 1], fb[s + 1], acc2, 0, 0, 0); }
      LAS float* dst = prod ? QKs : KKs;
#pragma unroll
      for (int e = 0; e < 16; ++e) dst[(32 * mt + (e & 3) + 8 * (e >> 2) + 4 * hh) * GC_FS + 32 * nt + r32] = acc[e] + acc2[e];
      bf16x8_t id[2];
#pragma unroll
      for (int s = 0; s < 2; ++s) { unsigned w[4];
#pragma unroll
          for (int e2 = 0; e2 < 4; ++e2) { const int k0 = 16 * s + 8 * hh + 2 * e2; w[e2] = (k0 == r32 ? 0x3F80u : 0u) | (k0 + 1 == r32 ? 0x3F800000u : 0u); }
          id[s] = __builtin_bit_cast(bf16x8_t, (vu4){w[0], w[1], w[2], w[3]}); }
#pragma unroll
      for (int j = 0; j < 2; ++j) { tt[j] = zero16();
          tt[j] = __builtin_amdgcn_mfma_f32_32x32x16_bf16(ft[2 * j], id[0], tt[j], 0, 0, 0); tt[j] = __builtin_amdgcn_mfma_f32_32x32x16_bf16(ft[2 * j + 1], id[1], tt[j], 0, 0, 0); } }
    LDS_BARRIER();
    auto put_T = [&](int dir, const LAS float* tab, auto dstf) {
#pragma unroll
        for (int j = 0; j < 2; ++j) {
#pragma unroll
            for (int a4 = 0; a4 < 4; ++a4) { const int n0 = 32 * mt + 8 * a4 + 4 * hh;
                if (dir == 0) { const vf4 sc = *(const LAS vf4*)(tab + n0);
                    st_vu2(dstf(j, n0), (vu2){cvtpk(tt[j][4 * a4] * sc.x, tt[j][4 * a4 + 1] * sc.y), cvtpk(tt[j][4 * a4 + 2] * sc.z, tt[j][4 * a4 + 3] * sc.w)}); }
                else { const int i0 = 60 - n0; const vf4 sc = *(const LAS vf4*)(tab + 64 + i0);
                    st_vu2(dstf(j, i0), (vu2){cvtpk(tt[j][4 * a4 + 3] * sc.x, tt[j][4 * a4 + 2] * sc.y), cvtpk(tt[j][4 * a4 + 1] * sc.z, tt[j][4 * a4] * sc.w)}); } } } };
    auto lds_T = [&](LAS bf16* img) { return [=](int j, int i0) { return img + (64 * nt + 32 * j + r32) * GC_TS + i0; }; };
    auto kdt_T = [&](int dir) { bf16* base = p.GKdT + (size_t)gdn_unit_index(b, c, h, dir) * 128 * 64; return [=](int j, int i0) { return base + (((2 * nt + j) * 4 + (i0 >> 4)) * 64 + ((i0 >> 3) & 1) * 32 + r32) * 8 + (i0 & 7); }; };
    if (prod == 0) { put_T(0, egl, kdt_T(0)); put_T(1, egl, kdt_T(1)); put_T(0, beg, lds_T(KbT)); }
    else {
        const int dir = nt, n = 32 * mt + r32, i = dir ? 63 - n : n; const float sc = eg[dir * 64 + i];
        bf16* base = p.GQd + (size_t)gdn_unit_index(b, c, h, dir) * 64 * 128 + ((size_t)((i >> 5) * 8) * 64 + hh * 32 + (i & 31)) * 8;
#pragma unroll
        for (int q = 0; q < 8; ++q) { float q8[8]; unpack8(__builtin_bit_cast(vu4, fa[q]), q8);
            *(vu4*)(base + q * 512) = (vu4){cvtpk(q8[0] * sc, q8[1] * sc), cvtpk(q8[2] * sc, q8[3] * sc), cvtpk(q8[4] * sc, q8[5] * sc), cvtpk(q8[6] * sc, q8[7] * sc)}; }
        put_T(0, be, lds_T(VbT)); }
#pragma unroll
    for (int it = 0; it < 2; ++it) { const int item = it * 512 + tid, dir = item >> 9, j0 = ((item >> 6) & 7) * 8, i = item & 63, ni = dir ? 63 - i : i;
        float o[8] = {0.f, 0.f, 0.f, 0.f, 0.f, 0.f, 0.f, 0.f};
        if (j0 < i) { const float gi = gc[dir * 64 + i], bi = be[dir * 64 + i]; const vf4 ga = *(const LAS vf4*)(gc + dir * 64 + j0), gb = *(const LAS vf4*)(gc + dir * 64 + j0 + 4);
            const float gj[8] = {ga.x, ga.y, ga.z, ga.w, gb.x, gb.y, gb.z, gb.w};
#pragma unroll
            for (int q = 0; q < 8; ++q) { const int j = j0 + q, nj = dir ? 63 - j : j; o[q] = (i > j) ? bi * KKs[ni * GC_FS + nj] * __expf(gi - gj[q]) : 0.0f; } }
        LAS float* dst = Lm + dir * 64 * GC_LS + i * GC_LS + j0;
        *(LAS vf4*)dst = (vf4){o[0], o[1], o[2], o[3]}; *(LAS vf4*)(dst + 4) = (vf4){o[4], o[5], o[6], o[7]}; }
    LDS_BARRIER();
    if (wave < 2) { __builtin_amdgcn_s_setprio(3); tri_solve_wave(Lm + wave * 64 * GC_LS, Tm + wave * 64 * GC_TS, (LAS bf16*)KKs + wave * 2 * 32 * 40, lane); __builtin_amdgcn_s_setprio(0); }
    else if ((wave & 3) >= 2) { const int t6 = ((wave & 1) | ((wave >> 2) << 1)) * 64 + lane;
        for (int it = t6; it < 2 * 64 * 8; it += 256) { const int dir = it >> 9, j8 = (it >> 6) & 7, i = it & 63, ni = dir ? 63 - i : i; unsigned w[4];
#pragma unroll
            for (int e2 = 0; e2 < 4; ++e2) { float a[2];
#pragma unroll
                for (int q = 0; q < 2; ++q) { const int j = j8 * 8 + 2 * e2 + q; a[q] = (i >= j) ? QKs[ni * GC_FS + (dir ? 63 - j : j)] * __expf(gc[dir * 64 + i] - gc[dir * 64 + j]) : 0.0f; }
                w[e2] = cvtpk(a[0], a[1]); }
            *(vu4*)(p.GA + (size_t)gdn_unit_index(b, c, h, dir) * 64 * 64 + (((i >> 5) * 4 + (j8 >> 1)) * 64 + (j8 & 1) * 32 + (i & 31)) * 8) = (vu4){w[0], w[1], w[2], w[3]}; }
        if (t6 < 2) p.GGL[gdn_unit_index(b, c, h, t6)] = eg[t6 * 64 + 63]; }
    LDS_BARRIER();
    LAS bf16* KbT1 = (LAS bf16*)(lds + G1_KK); LAS bf16* VbT1 = KbT1 + 128 * GC_TS;
    if (prod == 0) put_T(1, beg, lds_T(KbT1)); else put_T(1, be, lds_T(VbT1));
    LDS_BARRIER();
#pragma unroll
    for (int dir = 0; dir < 2; ++dir) {
        const int u = gdn_unit_index(b, c, h, dir); const LAS bf16* Td = Tm + dir * 64 * GC_TS; const LAS bf16* Kd = dir ? KbT1 : KbT; const LAS bf16* Vd = dir ? VbT1 : VbT;
        { const int dt = wave >> 1, it2 = wave & 1; f32x16_t acc = zero16(); acc = mma_lds<4>(acc, Kd + 32 * dt * GC_TS, GC_TS, Td + 32 * it2 * GC_TS, GC_TS, r32, hh);
            bf16* dst = p.GW + (size_t)u * 64 * 128 + ((it2 * 8 + 2 * dt) * 64 + r32) * 8 + 4 * hh;
#pragma unroll
            for (int a4 = 0; a4 < 4; ++a4) *(vu2*)(dst + (a4 >> 1) * 512 + (a4 & 1) * 256) = (vu2){cvtpk(acc[4 * a4], acc[4 * a4 + 1]), cvtpk(acc[4 * a4 + 2], acc[4 * a4 + 3])}; }
        { const int it2 = wave >> 2, dt = wave & 3; f32x16_t acc = zero16(); acc = mma_lds<4>(acc, Td + 32 * it2 * GC_TS, GC_TS, Vd + 32 * dt * GC_TS, GC_TS, r32, hh);
            bf16* dst = p.GUT + (size_t)u * 128 * 64 + ((size_t)((dt * 2 + it2) * 4) * 64 + lane) * 4;
#pragma unroll
            for (int a4 = 0; a4 < 4; ++a4) *(vu2*)(dst + a4 * 256) = (vu2){cvtpk(acc[4 * a4], acc[4 * a4 + 1]), cvtpk(acc[4 * a4 + 2], acc[4 * a4 + 3])}; }
    }
    LDS_BARRIER();
}

template <class F> __device__ __forceinline__ void store_tile_rows(const f32x16_t& a, LAS bf16* T, int lane, F rowptr) {
    const int r32 = lane & 31, hh = lane >> 5;
#pragma unroll
    for (int e = 0; e < 16; ++e) T[((e & 3) + 8 * (e >> 2) + 4 * hh) * 40 + r32] = f2bf(a[e]);
    const int il = lane >> 1, half = lane & 1;
    const vu4 w0 = *(const LAS vu4*)(T + il * 40 + half * 16), w1 = *(const LAS vu4*)(T + il * 40 + half * 16 + 8);
    bf16* dst = rowptr(il) + half * 16;
    *(vu4*)dst = w0; *(vu4*)(dst + 8) = w1;
}
__device__ __forceinline__ void gdn_scan_wg(const Ptrs& p, LAS unsigned char* lds, int chain, int slice, int tid) {
    const int b = chain / (GDN_H * 2), h = (chain >> 1) % GDN_H, dir = chain & 1;
    const int lane = tid & 63, wave = tid >> 6, r32 = lane & 31, hh = lane >> 5;
    LAS bf16* SbT = (LAS bf16*)lds;
    LAS bf16* vnT = SbT + 4 * 32 * GC_KS;
    LAS bf16* otile = vnT + 3 * 32 * GC_TS + (wave & 1) * 32 * 40;
    for (int i = tid; i < 32 * GC_KS / 2; i += 512) ((LAS unsigned*)SbT)[i] = 0u;
    LDS_BARRIER();
    auto chunk_of = [&](int s) { return s < NCH_CTX ? (dir ? NCH_CTX - 1 - s : s) : NCH_CTX + (dir ? NCH - NCH_CTX - 1 - (s - NCH_CTX) : s - NCH_CTX); };
    auto unit_of = [&](int s) { return (size_t)gdn_unit_index(b, chunk_of(s), h, dir); };
    using I0 = std::integral_constant<int, 0>; using I1 = std::integral_constant<int, 1>; using I2 = std::integral_constant<int, 2>; using I3 = std::integral_constant<int, 3>;
    if (wave < 2) {
        __builtin_amdgcn_s_setprio(3);
        int tr = tid; asm volatile("" : "+v"(tr)); const int ln = tr & 63, t = (tr >> 6) & 1;
        bf16x8_t fa[4][8]; vu2 ut[4][4];
        auto prefetch = [&](int s, auto KC2) { constexpr int k = decltype(KC2)::value; const size_t u = unit_of(s);
            const bf16* wp = p.GW + u * 64 * 128 + (size_t)(t * 512 + ln) * 8; const bf16* up = p.GUT + u * 128 * 64 + (size_t)((slice * 2 + t) * 256 + ln) * 4;
#pragma unroll
            for (int q = 0; q < 8; ++q) fa[k][q] = *(const bf16x8_t*)(wp + q * 512);
#pragma unroll
            for (int a4 = 0; a4 < 4; ++a4) ut[k][a4] = *(const vu2*)(up + a4 * 256); };
        auto step = [&](int s, auto KC) { constexpr int k = decltype(KC)::value;
            if (s + 3 < NCH) prefetch(s + 3, std::integral_constant<int, (k + 3) % 4>{});
            const LAS bf16* Sc = SbT + (s & 3) * 32 * GC_KS; LAS bf16* vn = vnT + (s % 3) * 32 * GC_TS;
            f32x16_t acc = zero16(), acc2 = zero16();
#pragma unroll
            for (int qh = 0; qh < 2; ++qh) { bf16x8_t bq[4];
#pragma unroll
                for (int q = 0; q < 4; ++q) bq[q] = *(const LAS bf16x8_t*)(Sc + r32 * GC_KS + 16 * (4 * qh + q) + 8 * hh);
#pragma unroll
                for (int q = 0; q < 4; q += 2) { acc = __builtin_amdgcn_mfma_f32_32x32x16_bf16(fa[k][4 * qh + q], bq[q], acc, 0, 0, 0); acc2 = __builtin_amdgcn_mfma_f32_32x32x16_bf16(fa[k][4 * qh + q + 1], bq[q + 1], acc2, 0, 0, 0); } }
#pragma unroll
            for (int a4 = 0; a4 < 4; ++a4) { const vu2 uw = ut[k][a4];
                *(LAS vu2*)(vn + r32 * GC_TS + 32 * t + 8 * a4 + 4 * hh) = (vu2){cvtpk(bflo(uw.x) - (acc[4 * a4] + acc2[4 * a4]), bfhi(uw.x) - (acc[4 * a4 + 1] + acc2[4 * a4 + 1])), cvtpk(bflo(uw.y) - (acc[4 * a4 + 2] + acc2[4 * a4 + 2]), bfhi(uw.y) - (acc[4 * a4 + 3] + acc2[4 * a4 + 3]))}; }
            LDS_BARRIER(); LDS_BARRIER(); };
        prefetch(0, I0{}); prefetch(1, I1{}); prefetch(2, I2{});
        for (int s = 0; s < NCH; s += 4) { step(s, I0{}); step(s + 1, I1{}); step(s + 2, I2{}); step(s + 3, I3{}); }
        __builtin_amdgcn_s_setprio(0);
    } else if (wave >= 4) {
        __builtin_amdgcn_s_setprio(3);
        int tr = tid; asm volatile("" : "+v"(tr)); const int ln = tr & 63, rr = (tr >> 6) & 3;
        int zl = 0; asm volatile("v_mov_b32 %0, 0" : "=v"(zl));
        bf16x8_t fb[8][4]; float gl[8] = {0.f, 0.f, 0.f, 0.f, 0.f, 0.f, 0.f, 0.f}; f32x16_t S = zero16();
        auto prefetch = [&](int s, auto KC2) { constexpr int k = decltype(KC2)::value; const size_t u = unit_of(s);
            const bf16* kp = p.GKdT + u * 128 * 64 + (size_t)(rr * 256 + ln) * 8;
#pragma unroll
            for (int q = 0; q < 4; ++q) fb[k][q] = *(const bf16x8_t*)(kp + q * 512);
            gl[k] = p.GGL[u + zl]; };
        auto step = [&](int s, auto KC) { constexpr int k = decltype(KC)::value;
            if (s + 7 < NCH) prefetch(s + 7, std::integral_constant<int, (k + 7) % 8>{});
            const LAS bf16* vn = vnT + (s % 3) * 32 * GC_TS; LAS bf16* Sn = SbT + ((s + 1) & 3) * 32 * GC_KS;
            const float g1 = gl[k];
#pragma unroll
            for (int e = 0; e < 16; ++e) S[e] *= g1;
            LDS_BARRIER();
            bf16x8_t bq[4];
#pragma unroll
            for (int q = 0; q < 4; ++q) bq[q] = *(const LAS bf16x8_t*)(vn + r32 * GC_TS + 16 * q + 8 * hh);
#pragma unroll
            for (int q = 0; q < 4; ++q) S = __builtin_amdgcn_mfma_f32_32x32x16_bf16(fb[k][q], bq[q], S, 0, 0, 0);
#pragma unroll
            for (int a4 = 0; a4 < 4; ++a4) *(LAS vu2*)(Sn + r32 * GC_KS + 32 * rr + 8 * a4 + 4 * hh) = (vu2){cvtpk(S[4 * a4], S[4 * a4 + 1]), cvtpk(S[4 * a4 + 2], S[4 * a4 + 3])};
            LDS_BARRIER(); };
        using I4 = std::integral_constant<int, 4>; using I5 = std::integral_constant<int, 5>; using I6 = std::integral_constant<int, 6>; using I7 = std::integral_constant<int, 7>;
        prefetch(0, I0{}); prefetch(1, I1{}); prefetch(2, I2{}); prefetch(3, I3{}); prefetch(4, I4{}); prefetch(5, I5{}); prefetch(6, I6{});
        for (int s = 0; s + 7 < NCH; s += 8) { step(s, I0{}); step(s + 1, I1{}); step(s + 2, I2{}); step(s + 3, I3{}); step(s + 4, I4{}); step(s + 5, I5{}); step(s + 6, I6{}); step(s + 7, I7{}); }
        step(NCH - 4, I0{}); step(NCH - 3, I1{}); step(NCH - 2, I2{}); step(NCH - 1, I3{});
        __builtin_amdgcn_s_setprio(0);
    } else {
        int tr = tid; asm volatile("" : "+v"(tr)); const int ln = tr & 63, t = (tr >> 6) & 1;
        bf16x8_t fa[3][8], fb[3][4];
        auto prefetch = [&](int s, auto KC2) { constexpr int k = decltype(KC2)::value; const size_t u = unit_of(s);
            const bf16* qp = p.GQd + u * 64 * 128 + (size_t)(t * 512 + ln) * 8; const bf16* ap = p.GA + u * 64 * 64 + (size_t)(t * 256 + ln) * 8;
#pragma unroll
            for (int q = 0; q < 8; ++q) fa[k][q] = *(const bf16x8_t*)(qp + q * 512);
#pragma unroll
            for (int q = 0; q < 4; ++q) fb[k][q] = *(const bf16x8_t*)(ap + q * 512); };
        auto out_of = [&](int so, auto KC) { constexpr int k = decltype(KC)::value;
            const LAS bf16* Sc = SbT + (so & 3) * 32 * GC_KS; const LAS bf16* vn = vnT + (so % 3) * 32 * GC_TS;
            f32x16_t acc = zero16(), acc2 = zero16();
#pragma unroll
            for (int qh = 0; qh < 2; ++qh) { bf16x8_t bq[4];
#pragma unroll
                for (int q = 0; q < 4; ++q) bq[q] = *(const LAS bf16x8_t*)(Sc + r32 * GC_KS + 16 * (4 * qh + q) + 8 * hh);
#pragma unroll
                for (int q = 0; q < 4; q += 2) { acc = __builtin_amdgcn_mfma_f32_32x32x16_bf16(fa[k][4 * qh + q], bq[q], acc, 0, 0, 0); acc2 = __builtin_amdgcn_mfma_f32_32x32x16_bf16(fa[k][4 * qh + q + 1], bq[q + 1], acc2, 0, 0, 0); } }
            { bf16x8_t bv[4];
#pragma unroll
              for (int q = 0; q < 4; ++q) bv[q] = *(const LAS bf16x8_t*)(vn + r32 * GC_TS + 16 * q + 8 * hh);
#pragma unroll
              for (int q = 0; q < 4; q += 2) { acc = __builtin_amdgcn_mfma_f32_32x32x16_bf16(fb[k][q], bv[q], acc, 0, 0, 0); acc2 = __builtin_amdgcn_mfma_f32_32x32x16_bf16(fb[k][q + 1], bv[q + 1], acc2, 0, 0, 0); } }
            const int r0 = chunk_row0(b, chunk_of(so));
#pragma unroll
            for (int e = 0; e < 16; ++e) acc[e] += acc2[e];
            store_tile_rows(acc, otile, lane, [&](int il) { const int i = 32 * t + il; return p.OGb + ((size_t)dir * MROWS + r0 + (dir ? 63 - i : i)) * MIX_W + h * 128 + slice * 32; }); };
        auto step = [&](int s, auto KC) { constexpr int k = decltype(KC)::value;
            if (s > 1) out_of(s - 2, std::integral_constant<int, (k + 1) % 3>{});
            if (s + 1 < NCH) prefetch(s + 1, std::integral_constant<int, (k + 1) % 3>{});
            LDS_BARRIER(); LDS_BARRIER(); };
        prefetch(0, I0{});
        for (int s = 0; s + 2 < NCH; s += 3) { step(s, I0{}); step(s + 1, I1{}); step(s + 2, I2{}); }
        step(NCH - 2, std::integral_constant<int, (NCH - 2) % 3>{}); step(NCH - 1, std::integral_constant<int, (NCH - 1) % 3>{});
        out_of(NCH - 2, std::integral_constant<int, (NCH - 2) % 3>{}); out_of(NCH - 1, std::integral_constant<int, (NCH - 1) % 3>{});
    }
}
static_assert(G1_END <= 146432 && NCH % 8 == 4 && NCH % 3 == 2, "G1 LDS map / scan unroll");

constexpr int SSD_NU = BATCH * NCH * SSM_H * 2;
__device__ __forceinline__ int ssd_unit_index(int b, int c, int hd, int dir) { return ((b * NCH + c) * SSM_H + hd) * 2 + dir; }
constexpr int SL_BN = 0, SL_CN = SL_BN + 64 * GC_KS * 2, SL_CB = SL_CN + 64 * GC_KS * 2, SL_BT = SL_CB + 64 * GC_FS * 4, SL_XT = SL_BT + 128 * GC_TS * 2, SL_M = SL_XT + 256 * GC_TS * 2,
              SL_XW = SL_M + 64 * GC_TS * 2, SL_SM = SL_XW + 2 * 64 * GC_TS * 2, SL_END = SL_SM + 8 * 3 * 64 * 4;
static_assert(SL_END <= 146432, "ssd local LDS map");
constexpr int SSD_LOCAL_UNITS = BATCH * NCH * SSM_G * 2;
__device__ __forceinline__ void ssd_local_unit(const Ptrs& p, LAS unsigned char* lds, int unit, int tid) {
    const int lane = tid & 63, wave = tid >> 6, r32 = lane & 31, hh = lane >> 5;
    const int b = unit / (NCH * SSM_G * 2), c = (unit / (SSM_G * 2)) % NCH, g = (unit >> 1) % SSM_G, hq = unit & 1;
    const int r0 = chunk_row0(b, c), hd0 = g * SSM_HPG + hq * 4;
    LAS bf16* Bn = (LAS bf16*)(lds + SL_BN); LAS bf16* Cn = (LAS bf16*)(lds + SL_CN); LAS float* CBs = (LAS float*)(lds + SL_CB); LAS bf16* BT = (LAS bf16*)(lds + SL_BT);
    LAS bf16* XT = (LAS bf16*)(lds + SL_XT); LAS bf16* Mm = (LAS bf16*)(lds + SL_M); LAS bf16* XwT = (LAS bf16*)(lds + SL_XW); LAS float* sm = (LAS float*)(lds + SL_SM);
#pragma unroll
    for (int it = 0; it < 4; ++it) { const int idx = it * 512 + tid, row = idx >> 5, which = (idx >> 4) & 1, c8 = idx & 15;
        *(LAS vu4*)((which ? Cn : Bn) + row * GC_KS + c8 * 8) = *(const vu4*)(p.SBCb + (size_t)(r0 + row) * (2 * SSM_BC) + which * SSM_BC + g * SSM_N + c8 * 8); }
    { vu4 xv[4];
#pragma unroll
        for (int it = 0; it < 4; ++it) { const int idx = it * 512 + tid, j = idx >> 5, p8 = idx & 31; xv[it] = *(const vu4*)(p.SXb + (size_t)(r0 + j) * MIX_W + hd0 * SSM_P + p8 * 8); }
#pragma unroll
        for (int it = 0; it < 4; ++it) { const int idx = it * 512 + tid, j = idx >> 5, p8 = idx & 31; const unsigned w4[4] = {xv[it].x, xv[it].y, xv[it].z, xv[it].w};
#pragma unroll
            for (int e = 0; e < 4; ++e) { XT[(8 * p8 + 2 * e) * GC_TS + j] = (bf16)(w4[e] & 0xffffu); XT[(8 * p8 + 2 * e + 1) * GC_TS + j] = (bf16)(w4[e] >> 16); } } }
    { const int hd = hd0 + (wave >> 1), dir = wave & 1, n = dir ? 63 - lane : lane; const size_t gi = (size_t)(r0 + n) * 2 * SSM_H + dir * SSM_H + hd; const int u = ssd_unit_index(b, c, hd, dir);
        float x = p.SA[gi]; const float dt = p.SDT[gi];
#pragma unroll
        for (int o = 1; o < 64; o <<= 1) { const float y = __shfl_up(x, o); if (lane >= o) x += y; }
        const float x63 = __shfl(x, 63);
        sm[(wave * 3 + 0) * 64 + lane] = x; sm[(wave * 3 + 1) * 64 + lane] = dt; sm[(wave * 3 + 2) * 64 + lane] = __expf(x63 - x) * dt;
        p.SEAb[(size_t)u * 64 + lane] = f2bf(__expf(x)); if (lane == 63) p.SDC[u] = __expf(x); }
    LDS_BARRIER();
    *(vu4*)(p.SCF + ((((size_t)(b * NCH + c) * SSM_G + g) * 2 + hq) * 8 + wave) * 512 + lane * 8) = *(const LAS vu4*)(Cn + (32 * hq + r32) * GC_KS + 16 * wave + 8 * hh);
    if (wave < 4) { const int mt = wave >> 1, nt = wave & 1; f32x16_t acc = zero16(); acc = mma_lds<8>(acc, Cn + 32 * mt * GC_KS, GC_KS, Bn + 32 * nt * GC_KS, GC_KS, r32, hh);
#pragma unroll
        for (int e = 0; e < 16; ++e) CBs[(32 * mt + (e & 3) + 8 * (e >> 2) + 4 * hh) * GC_FS + 32 * nt + r32] = acc[e]; }
    else { for (int it = tid - 256; it < 128 * 8; it += 256) { const int s = it >> 3, j8 = it & 7; unsigned w[4];
#pragma unroll
            for (int e2 = 0; e2 < 4; ++e2) w[e2] = (unsigned)Bn[(j8 * 8 + 2 * e2) * GC_KS + s] | ((unsigned)Bn[(j8 * 8 + 2 * e2 + 1) * GC_KS + s] << 16);
            *(LAS vu4*)(BT + s * GC_TS + j8 * 8) = (vu4){w[0], w[1], w[2], w[3]}; } }
    LDS_BARRIER();
#pragma unroll 1
    for (int hl = 0; hl < 4; ++hl) {
        const int hd = hd0 + hl;
        const LAS float* ac0 = sm + (hl * 2 * 3) * 64; const LAS float* ac1 = ac0 + 3 * 64;
        { const int n = tid >> 3, n8 = tid & 7; unsigned w[4];
            const float a0n = ac0[n], a1n = ac1[63 - n];
#pragma unroll
            for (int e2 = 0; e2 < 4; ++e2) { float a[2];
#pragma unroll
                for (int q = 0; q < 2; ++q) { const int nj = n8 * 8 + 2 * e2 + q; const bool lo = nj <= n;
                    const float ex = __expf(lo ? a0n - ac0[nj] : a1n - ac1[63 - nj]);
                    const float dd = (nj < n) ? ac0[64 + nj] : (nj > n) ? ac1[64 + 63 - nj] : ac0[64 + nj] + ac1[64 + 63 - nj];
                    a[q] = CBs[n * GC_FS + nj] * ex * dd; }
                w[e2] = cvtpk(a[0], a[1]); }
            *(LAS vu4*)(Mm + n * GC_TS + n8 * 8) = (vu4){w[0], w[1], w[2], w[3]};
            const int pp = tid >> 3; float xs[8]; unpack8(*(const LAS vu4*)(XT + (hl * 64 + pp) * GC_TS + n8 * 8), xs);
#pragma unroll
            for (int e2 = 0; e2 < 4; ++e2) { const int nj = n8 * 8 + 2 * e2; w[e2] = cvtpk(xs[2 * e2] * ac0[128 + nj], xs[2 * e2 + 1] * ac0[128 + nj + 1]); }
            *(LAS vu4*)(XwT + pp * GC_TS + n8 * 8) = (vu4){w[0], w[1], w[2], w[3]};
#pragma unroll
            for (int e2 = 0; e2 < 4; ++e2) { const int nj = n8 * 8 + 2 * e2; w[e2] = cvtpk(xs[2 * e2] * ac1[128 + 63 - nj], xs[2 * e2 + 1] * ac1[128 + 62 - nj]); }
            *(LAS vu4*)(XwT + (64 + pp) * GC_TS + n8 * 8) = (vu4){w[0], w[1], w[2], w[3]}; }
        LDS_BARRIER();
#pragma unroll
        for (int dir = 0; dir < 2; ++dir) { const int sb = wave >> 1, pb = wave & 1, u = ssd_unit_index(b, c, hd, dir); f32x16_t acc = zero16();
            acc = mma_lds<4>(acc, BT + 32 * sb * GC_TS, GC_TS, XwT + (64 * dir + 32 * pb) * GC_TS, GC_TS, r32, hh);
            bf16* dst = p.SSC + (((size_t)u * 8 + wave) * 64 + lane) * 16;
            *(vu4*)dst = (vu4){cvtpk(acc[0], acc[1]), cvtpk(acc[2], acc[3]), cvtpk(acc[4], acc[5]), cvtpk(acc[6], acc[7])};
            *(vu4*)(dst + 8) = (vu4){cvtpk(acc[8], acc[9]), cvtpk(acc[10], acc[11]), cvtpk(acc[12], acc[13]), cvtpk(acc[14], acc[15])}; }
        if (wave < 4) { const int mt = wave >> 1, pb = wave & 1; f32x16_t acc = zero16(); acc = mma_lds<4>(acc, Mm + 32 * mt * GC_TS, GC_TS, XT + (hl * 64 + 32 * pb) * GC_TS, GC_TS, r32, hh);
#pragma unroll
            for (int e = 0; e < 16; ++e) { const int n = 32 * mt + (e & 3) + 8 * (e >> 2) + 4 * hh;
                p.OSb[((size_t)r0 + n) * MIX_W + hd * SSM_P + 32 * pb + r32] = f2bf(acc[e]); } }
        LDS_BARRIER();
    }
}
__device__ __forceinline__ void ssd_scan_wg(const Ptrs& p, LAS unsigned char* lds, int chain, int tid) {
    const int b = chain / (SSM_H * 2), hd = (chain >> 1) % SSM_H, dir = chain & 1, g = hd / SSM_HPG;
    const int lane = tid & 63, wave = tid >> 6, r32 = lane & 31, hh = lane >> 5;
    int zl = 0; asm volatile("v_mov_b32 %0, 0" : "=v"(zl));
    LAS bf16* hT = (LAS bf16*)lds;
    for (int i = tid; i < 64 * GC_KS / 2; i += 512) ((LAS unsigned*)hT)[i] = 0u;
    LDS_BARRIER();
    auto chunk_of = [&](int s) { return s < NCH_CTX ? (dir ? NCH_CTX - 1 - s : s) : NCH_CTX + (dir ? NCH - NCH_CTX - 1 - (s - NCH_CTX) : s - NCH_CTX); };
    using I0 = std::integral_constant<int, 0>; using I1 = std::integral_constant<int, 1>; using I2 = std::integral_constant<int, 2>; using I3 = std::integral_constant<int, 3>;
    if (wave >= 4) {
        __builtin_amdgcn_s_setprio(3);
        const int hw = wave - 4;
        f32x16_t h0 = zero16(), h1 = zero16();
        vu4 sc[4][4]; float dec[4] = {0.f, 0.f, 0.f, 0.f};
        auto pre_h = [&](int s, auto KC2) { constexpr int k = decltype(KC2)::value; const size_t u = (size_t)ssd_unit_index(b, chunk_of(s), hd, dir);
            const bf16* sp = p.SSC + ((u * 8 + 2 * hw) * 64 + lane) * 16; sc[k][0] = *(const vu4*)sp; sc[k][1] = *(const vu4*)(sp + 8); sc[k][2] = *(const vu4*)(sp + 1024); sc[k][3] = *(const vu4*)(sp + 1024 + 8); dec[k] = p.SDC[u + zl]; };
        auto step = [&](int s, auto KC) { constexpr int k = decltype(KC)::value;
            const unsigned w0[8] = {sc[k][0].x, sc[k][0].y, sc[k][0].z, sc[k][0].w, sc[k][1].x, sc[k][1].y, sc[k][1].z, sc[k][1].w}, w1[8] = {sc[k][2].x, sc[k][2].y, sc[k][2].z, sc[k][2].w, sc[k][3].x, sc[k][3].y, sc[k][3].z, sc[k][3].w};
            const float d1 = dec[k];
#pragma unroll
            for (int e2 = 0; e2 < 8; ++e2) { h0[2 * e2] = h0[2 * e2] * d1 + bflo(w0[e2]); h0[2 * e2 + 1] = h0[2 * e2 + 1] * d1 + bfhi(w0[e2]); h1[2 * e2] = h1[2 * e2] * d1 + bflo(w1[e2]); h1[2 * e2 + 1] = h1[2 * e2 + 1] * d1 + bfhi(w1[e2]); }
            if (s + 3 < NCH) pre_h(s + 3, std::integral_constant<int, (k + 3) % 4>{});
            LAS bf16* Hn = hT + ((s + 1) & 3) * 64 * GC_KS;
#pragma unroll
            for (int a4 = 0; a4 < 4; ++a4) { *(LAS vu2*)(Hn + r32 * GC_KS + 32 * hw + 8 * a4 + 4 * hh) = (vu2){cvtpk(h0[4 * a4], h0[4 * a4 + 1]), cvtpk(h0[4 * a4 + 2], h0[4 * a4 + 3])};
                *(LAS vu2*)(Hn + (32 + r32) * GC_KS + 32 * hw + 8 * a4 + 4 * hh) = (vu2){cvtpk(h1[4 * a4], h1[4 * a4 + 1]), cvtpk(h1[4 * a4 + 2], h1[4 * a4 + 3])}; }
            LDS_BARRIER(); };
        pre_h(0, I0{}); pre_h(1, I1{}); pre_h(2, I2{});
        for (int s = 0; s < NCH; s += 4) { step(s, I0{}); step(s + 1, I1{}); step(s + 2, I2{}); step(s + 3, I3{}); }
        __builtin_amdgcn_s_setprio(0);
    } else {
        const int mt = wave >> 1, pb = wave & 1;
        LAS bf16* otile = hT + 4 * 64 * GC_KS + wave * 32 * 40;
        bf16x8_t cf[3][8]; vu2 ea[3][4];
        auto pre_y = [&](int s, auto KC2) { constexpr int k = decltype(KC2)::value; const int c = chunk_of(s); const size_t u = (size_t)ssd_unit_index(b, c, hd, dir); const int r0 = chunk_row0(b, c);
            const bf16* cp = p.SCF + ((((size_t)(b * NCH + c) * SSM_G + g) * 2 + (dir ? 1 - mt : mt)) * 8) * 512 + (hh * 32 + (dir ? 31 - r32 : r32)) * 8;
#pragma unroll
            for (int q = 0; q < 8; ++q) cf[k][q] = *(const bf16x8_t*)(cp + q * 512);
#pragma unroll
            for (int a4 = 0; a4 < 4; ++a4) ea[k][a4] = *(const vu2*)(p.SEAb + u * 64 + 32 * mt + 8 * a4 + 4 * hh); };
        auto out_y = [&](int so, auto KC) { constexpr int k = decltype(KC)::value;
            const LAS bf16* Hc = hT + (so & 3) * 64 * GC_KS;
            f32x16_t acc = zero16(), acc2 = zero16();
#pragma unroll
            for (int qh = 0; qh < 2; ++qh) { bf16x8_t bq[4];
#pragma unroll
                for (int q = 0; q < 4; ++q) bq[q] = *(const LAS bf16x8_t*)(Hc + (32 * pb + r32) * GC_KS + 16 * (4 * qh + q) + 8 * hh);
#pragma unroll
                for (int q = 0; q < 4; q += 2) { acc = __builtin_amdgcn_mfma_f32_32x32x16_bf16(cf[k][4 * qh + q], bq[q], acc, 0, 0, 0); acc2 = __builtin_amdgcn_mfma_f32_32x32x16_bf16(cf[k][4 * qh + q + 1], bq[q + 1], acc2, 0, 0, 0); } }
            const int r0 = chunk_row0(b, chunk_of(so));
#pragma unroll
            for (int e = 0; e < 16; ++e) { const unsigned ew = (e & 2) ? ea[k][e >> 2].y : ea[k][e >> 2].x; const float ev = (e & 1) ? bfhi(ew) : bflo(ew); acc[e] = ev * (acc[e] + acc2[e]); }
            store_tile_rows(acc, otile, lane, [&](int il) { const int i = 32 * mt + il; return p.OSb2 + ((size_t)dir * MROWS + r0 + (dir ? 63 - i : i)) * MIX_W + hd * SSM_P + 32 * pb; }); };
        auto step = [&](int s, auto KC) { constexpr int k = decltype(KC)::value;
            if (s > 1) out_y(s - 2, std::integral_constant<int, (k + 1) % 3>{});
            if (s + 1 < NCH) pre_y(s + 1, std::integral_constant<int, (k + 1) % 3>{});
            LDS_BARRIER(); };
        pre_y(0, I0{});
        for (int s = 0; s + 2 < NCH; s += 3) { step(s, I0{}); step(s + 1, I1{}); step(s + 2, I2{}); }
        step(NCH - 2, std::integral_constant<int, (NCH - 2) % 3>{}); step(NCH - 1, std::integral_constant<int, (NCH - 1) % 3>{});
        out_y(NCH - 2, std::integral_constant<int, (NCH - 2) % 3>{}); out_y(NCH - 1, std::integral_constant<int, (NCH - 1) % 3>{});
    }
}


namespace pg8 {
struct EpiInProj {
    static constexpr bool PERM = true, AFTER_DRAIN = false, KHOOK = false;
    bf16_t* P; float* PF;
    __device__ __forceinline__ void operator()(const f32x4 (&acc)[2][2][4][2], const Unit& u, int wr, int wc, int fr, int fq) const {
        const int row0 = u.pm * BM + wr * 64 + fr;
        if (u.pn * BM < NP_MAIN) {
            const int col0 = u.pn * BM + wc * 32 + 8 * fq;
#pragma unroll
            for (int ai = 0; ai < 2; ++ai)
#pragma unroll
                for (int m = 0; m < 4; ++m) { bf16_t* rowp = P + (size_t)(row0 + ai * HALF + m * 16) * NP_MAIN + col0;
#pragma unroll
                    for (int bj = 0; bj < 2; ++bj) { const f32x4 v0 = acc[ai][bj][m][0], v1 = acc[ai][bj][m][1];
                        u32x4 w; w.x = cvt_pk_bf16(v0[0], v0[1]); w.y = cvt_pk_bf16(v0[2], v0[3]); w.z = cvt_pk_bf16(v1[0], v1[1]); w.w = cvt_pk_bf16(v1[2], v1[3]);
                        *(u32x4*)(rowp + bj * HALF) = w; } }
        } else {
#pragma unroll
            for (int ai = 0; ai < 2; ++ai)
#pragma unroll
                for (int m = 0; m < 4; ++m) { float* rowp = PF + (size_t)(row0 + ai * HALF + m * 16) * PF_N;
#pragma unroll
                    for (int bj = 0; bj < 2; ++bj) { const int c = bj * HALF + wc * 32 + 8 * fq;
                        if (c < PF_N) { *(f32x4*)(rowp + c) = acc[ai][bj][m][0]; *(f32x4*)(rowp + c + 4) = acc[ai][bj][m][1]; } } }
        }
    }
};
struct EpiMerge {
    static constexpr bool PERM = true, AFTER_DRAIN = false, KHOOK = false;
    const bf16_t* G0; bf16_t* TB;
    __device__ __forceinline__ void operator()(const f32x4 (&acc)[2][2][4][2], const Unit& u, int wr, int wc, int fr, int fq) const {
        const int row0 = u.pm * BM + wr * 64 + fr, col0 = u.pn * BM + wc * 32 + 8 * fq, br = u.pk / MIX_W; const bf16_t* G = G0 + br * D_MODEL;
#pragma unroll
        for (int ai = 0; ai < 2; ++ai)
#pragma unroll
            for (int m = 0; m < 4; ++m) { const size_t row = (size_t)(row0 + ai * HALF + m * 16);
#pragma unroll
                for (int bj = 0; bj < 2; ++bj) { const int col = col0 + bj * HALF;
                    const u32x4 gw = *(const u32x4*)(G + row * NP_MAIN + col);
                    float gt[8];
#pragma unroll
                    for (int j = 0; j < 4; ++j) { gt[2 * j] = __uint_as_float(gw[j] << 16); gt[2 * j + 1] = __uint_as_float(gw[j] & 0xffff0000u); }
                    f32x4 t0, t1;
#pragma unroll
                    for (int j = 0; j < 4; ++j) { t0[j] = acc[ai][bj][m][0][j] * __builtin_amdgcn_rcpf(1.0f + __expf(-gt[j])); t1[j] = acc[ai][bj][m][1][j] * __builtin_amdgcn_rcpf(1.0f + __expf(-gt[4 + j])); }
                    u32x4 w; w.x = cvt_pk_bf16(t0[0], t0[1]); w.y = cvt_pk_bf16(t0[2], t0[3]); w.z = cvt_pk_bf16(t1[0], t1[1]); w.w = cvt_pk_bf16(t1[2], t1[3]);
                    *(u32x4*)(TB + ((size_t)br * NCTX + (row - NLAT)) * D_MODEL + col) = w; } }
    }
};
struct EpiF32Plain {
    static constexpr bool PERM = false, AFTER_DRAIN = false, KHOOK = false;
    float* C; int ldc;
    __device__ __forceinline__ void operator()(const f32x4 (&acc)[2][2][4][2], const Unit& u, int wr, int wc, int fr, int fq) const {
        const int row0 = u.pm * BM + wr * 64 + fr, col0 = u.pn * BM + wc * 32 + 4 * fq;
#pragma unroll
        for (int ai = 0; ai < 2; ++ai)
#pragma unroll
            for (int m = 0; m < 4; ++m) { float* rowp = C + (size_t)(row0 + ai * HALF + m * 16) * ldc + col0;
#pragma unroll
                for (int bj = 0; bj < 2; ++bj)
#pragma unroll
                    for (int n = 0; n < 2; ++n) *(f32x4*)(rowp + bj * HALF + n * 16) = acc[ai][bj][m][n]; }
    }
};
struct EpiBf16Plain {
    static constexpr bool PERM = true, AFTER_DRAIN = false, KHOOK = false;
    bf16_t* O; int ldc;
    __device__ __forceinline__ void operator()(const f32x4 (&acc)[2][2][4][2], const Unit& u, int wr, int wc, int fr, int fq) const {
        const int row0 = u.pm * BM + wr * 64 + fr, col0 = u.pn * BM + wc * 32 + 8 * fq;
#pragma unroll
        for (int ai = 0; ai < 2; ++ai)
#pragma unroll
            for (int m = 0; m < 4; ++m) { bf16_t* rowp = O + (size_t)(row0 + ai * HALF + m * 16) * ldc + col0;
#pragma unroll
                for (int bj = 0; bj < 2; ++bj) { const f32x4 v0 = acc[ai][bj][m][0], v1 = acc[ai][bj][m][1];
                    u32x4 w; w.x = cvt_pk_bf16(v0[0], v0[1]); w.y = cvt_pk_bf16(v0[2], v0[3]); w.z = cvt_pk_bf16(v1[0], v1[1]); w.w = cvt_pk_bf16(v1[2], v1[3]);
                    *(u32x4*)(rowp + bj * HALF) = w; } }
    }
};

struct EpiAct {
    static constexpr bool PERM = true, AFTER_DRAIN = false, KHOOK = false;
    bf16_t* ACT; float* BP; bf16_t* BU; bf16_t* BG; const float* cw; const float* cb;
    __device__ __forceinline__ void operator()(const f32x4 (&acc)[2][2][4][2], const Unit& u, int wr, int wc, int fr, int fq) const {
        const int lp = (fq * 16 + ((fr + 15) & 15)) * 4, ln = (fq * 16 + ((fr + 1) & 15)) * 4;
#pragma unroll
        for (int n = 0; n < 2; ++n) {
            const int j0 = u.pn * 128 + wc * 32 + 8 * fq + 4 * n;
            const f32x4 w0 = *(const f32x4*)(cw + j0), w1 = *(const f32x4*)(cw + D_FF + j0), w2 = *(const f32x4*)(cw + 2 * D_FF + j0), bs = *(const f32x4*)(cb + j0);
#pragma unroll
            for (int ai = 0; ai < 2; ++ai) {
#pragma unroll
                for (int m = 0; m < 4; ++m) {
                    const int row = u.pm * BM + ai * HALF + wr * 64 + m * 16 + fr;
                    const bool hp = !(m == 0 && fr == 0), hn = !(m == 3 && fr == 15);
                    f32x4 gp, gn;
#pragma unroll
                    for (int e = 0; e < 4; ++e) { const float gc = acc[ai][1][m][n][e], gm = acc[ai][1][m > 0 ? m - 1 : 0][n][e], gq = acc[ai][1][m < 3 ? m + 1 : 3][n][e];
                        gp[e] = __int_as_float(__builtin_amdgcn_ds_bpermute(lp, __float_as_int(fr == 15 ? gm : gc)));
                        gn[e] = __int_as_float(__builtin_amdgcn_ds_bpermute(ln, __float_as_int(fr == 0 ? gq : gc))); }
                    const f32x4 g = acc[ai][1][m][n], uu = acc[ai][0][m][n];
                    f32x4 pre = w1 * g + bs;
                    if (hp) pre += w0 * gp;
                    if (hn) pre += w2 * gn;
                    if (hp && hn) {
                        f32x4 a;
#pragma unroll
                        for (int e = 0; e < 4; ++e) a[e] = pre[e] * __builtin_amdgcn_rcpf(1.0f + __expf(-pre[e])) * uu[e];
                        typedef unsigned u32x2 __attribute__((ext_vector_type(2)));
                        u32x2 w; w.x = cvt_pk_bf16(a[0], a[1]); w.y = cvt_pk_bf16(a[2], a[3]);
                        *(u32x2*)(ACT + (size_t)row * D_FF + j0) = w;
                    } else {
                        const size_t bi = (size_t)((row >> 6) * 2 + ((row & 63) == 63 ? 1 : 0)) * D_FF + j0;
                        typedef unsigned u32x2 __attribute__((ext_vector_type(2)));
                        *(f32x4*)(BP + bi) = pre;
                        u32x2 wu; wu.x = cvt_pk_bf16(uu[0], uu[1]); wu.y = cvt_pk_bf16(uu[2], uu[3]); *(u32x2*)(BU + bi) = wu;
                        u32x2 wg; wg.x = cvt_pk_bf16(g[0], g[1]); wg.y = cvt_pk_bf16(g[2], g[3]); *(u32x2*)(BG + bi) = wg;
                    }
                }
            }
        }
    }
};

constexpr int SPLIT_KS = 512, OUT_NS = D_MODEL / SPLIT_KS, DOWN_NS = D_FF / SPLIT_KS;
static_assert(D_MODEL % SPLIT_KS == 0 && D_FF % SPLIT_KS == 0 && NCTX % 256 == 0, "split-K context units");
struct SplitOrder {
    int ns, G, c;
    __device__ __forceinline__ bool next(int i, Unit& u) const { const int L = i * G + c; if (L >= (NCTX / 256) * (D_MODEL / 256) * ns) return false;
        const int ks = L % ns, tile = L / ns; u.pm = NLAT / 256 + tile / (D_MODEL / 256); u.pn = tile % (D_MODEL / 256); u.pk = ks * SPLIT_KS; return true; }
    __device__ __forceinline__ void a_ready(const Unit&) const {}
    __device__ __forceinline__ void done(const Unit&) const {}
};
struct SplitOrder3 {
    int G, c;
    __device__ __forceinline__ bool next(int i, Unit& u) const { const int L = i * G + c; constexpr int NT = (NCTX / 256) * (D_MODEL / 256); if (L >= NT * 3 * OUT_NS) return false;
        const int ks = L % OUT_NS, br = (L / OUT_NS) % 3, tile = L / (3 * OUT_NS); u.pm = br * (NCTX / 256) + tile / (D_MODEL / 256); u.pn = tile % (D_MODEL / 256); u.pk = ks * SPLIT_KS; return true; }
    __device__ __forceinline__ void a_ready(const Unit&) const {}
    __device__ __forceinline__ void done(const Unit&) const {}
};
struct EpiSlab3 {
    static constexpr bool PERM = false, AFTER_DRAIN = false, KHOOK = false;
    float* S;
    __device__ __forceinline__ void operator()(const f32x4 (&acc)[2][2][4][2], const Unit& u, int wr, int wc, int fr, int fq) const {
        const int br = u.pm / (NCTX / 256), ct = u.pm % (NCTX / 256);
        const int row0 = ct * BM + wr * 64 + fr, col0 = u.pn * BM + wc * 32 + 4 * fq; float* base = S + (size_t)(br * OUT_NS + u.pk / SPLIT_KS) * NCTX * D_MODEL;
#pragma unroll
        for (int ai = 0; ai < 2; ++ai)
#pragma unroll
            for (int m = 0; m < 4; ++m) { float* rowp = base + (size_t)(row0 + ai * HALF + m * 16) * D_MODEL + col0;
#pragma unroll
                for (int bj = 0; bj < 2; ++bj)
#pragma unroll
                    for (int n = 0; n < 2; ++n) *(f32x4*)(rowp + bj * HALF + n * 16) = acc[ai][bj][m][n]; }
    }
};

struct EpiMerge3 {
    static constexpr bool PERM = true, AFTER_DRAIN = false, KHOOK = true;
    const bf16_t* G0; bf16_t* MB;
    __device__ __forceinline__ void khook(f32x4 (&acc)[2][2][4][2], const Unit& u, int t, int wr, int wc, int fr, int fq) const {
        if (t != MIX_W / BK && t != 2 * MIX_W / BK) return;
        const int bp = t / (MIX_W / BK) - 1;
        const int row0 = u.pm * BM + wr * 64 + fr, col0 = u.pn * BM + wc * 32 + 8 * fq; const bf16_t* Gp = G0 + bp * D_MODEL;
#pragma unroll
        for (int ai = 0; ai < 2; ++ai) {
            asm volatile("" ::: "memory");
#pragma unroll
            for (int m = 0; m < 4; ++m) { const unsigned rowo = (unsigned)(row0 + ai * HALF + m * 16) * (unsigned)NP_MAIN;
#pragma unroll
                for (int bj = 0; bj < 2; ++bj) { const unsigned off = rowo + (unsigned)(col0 + bj * HALF);
                    const u32x4 gp = *(const u32x4*)(Gp + off), gn = *(const u32x4*)(Gp + D_MODEL + off);
#pragma unroll
                    for (int j = 0; j < 4; ++j) { const float p0 = __uint_as_float(gp[j] << 16), p1 = __uint_as_float(gp[j] & 0xffff0000u), n0 = __uint_as_float(gn[j] << 16), n1 = __uint_as_float(gn[j] & 0xffff0000u);
                        const float r0 = (1.0f + __expf(-n0)) * __builtin_amdgcn_rcpf(1.0f + __expf(-p0)), r1 = (1.0f + __expf(-n1)) * __builtin_amdgcn_rcpf(1.0f + __expf(-p1));
                        if (j < 2) { acc[ai][bj][m][0][2 * j] *= r0; acc[ai][bj][m][0][2 * j + 1] *= r1; } else { acc[ai][bj][m][1][2 * (j - 2)] *= r0; acc[ai][bj][m][1][2 * (j - 2) + 1] *= r1; } } } } }
    }
    __device__ __forceinline__ void operator()(const f32x4 (&acc)[2][2][4][2], const Unit& u, int wr, int wc, int fr, int fq) const {
        const int row0 = u.pm * BM + wr * 64 + fr, col0 = u.pn * BM + wc * 32 + 8 * fq; const bf16_t* G = G0 + 2 * D_MODEL;
#pragma unroll
        for (int ai = 0; ai < 2; ++ai)
#pragma unroll
            for (int m = 0; m < 4; ++m) { const size_t row = (size_t)(row0 + ai * HALF + m * 16);
#pragma unroll
                for (int bj = 0; bj < 2; ++bj) { const int col = col0 + bj * HALF;
                    const u32x4 gw = *(const u32x4*)(G + row * NP_MAIN + col);
                    float gt[8];
#pragma unroll
                    for (int j = 0; j < 4; ++j) { gt[2 * j] = __uint_as_float(gw[j] << 16); gt[2 * j + 1] = __uint_as_float(gw[j] & 0xffff0000u); }
                    f32x4 t0, t1;
#pragma unroll
                    for (int j = 0; j < 4; ++j) { t0[j] = acc[ai][bj][m][0][j] * __builtin_amdgcn_rcpf(1.0f + __expf(-gt[j])); t1[j] = acc[ai][bj][m][1][j] * __builtin_amdgcn_rcpf(1.0f + __expf(-gt[4 + j])); }
                    u32x4 w; w.x = cvt_pk_bf16(t0[0], t0[1]); w.y = cvt_pk_bf16(t0[2], t0[3]); w.z = cvt_pk_bf16(t1[0], t1[1]); w.w = cvt_pk_bf16(t1[2], t1[3]);
                    *(u32x4*)(MB + row * D_MODEL + col) = w; } }
    }
};
struct CtxMergeOrder {
    int c;
    __device__ __forceinline__ bool next(int i, Unit& u) const { if (i > 0 || c >= 3 * (NCTX / 256) * (D_MODEL / 256)) return false;
        const int tile = c / 3; u.pm = NLAT / 256 + tile / (D_MODEL / 256); u.pn = tile % (D_MODEL / 256); u.pk = (c % 3) * MIX_W; return true; }
    __device__ __forceinline__ void a_ready(const Unit&) const {}
    __device__ __forceinline__ void done(const Unit&) const {}
};
struct EpiSlab {
    static constexpr bool PERM = false, AFTER_DRAIN = false, KHOOK = false;
    float* S;
    __device__ __forceinline__ void operator()(const f32x4 (&acc)[2][2][4][2], const Unit& u, int wr, int wc, int fr, int fq) const {
        const int row0 = (u.pm * BM - NLAT) + wr * 64 + fr, col0 = u.pn * BM + wc * 32 + 4 * fq; float* base = S + (size_t)(u.pk / SPLIT_KS) * NCTX * D_MODEL;
#pragma unroll
        for (int ai = 0; ai < 2; ++ai)
#pragma unroll
            for (int m = 0; m < 4; ++m) { float* rowp = base + (size_t)(row0 + ai * HALF + m * 16) * D_MODEL + col0;
#pragma unroll
                for (int bj = 0; bj < 2; ++bj)
#pragma unroll
                    for (int n = 0; n < 2; ++n) *(f32x4*)(rowp + bj * HALF + n * 16) = acc[ai][bj][m][n]; }
    }
};
}

constexpr size_t al256(size_t x) { return (x + 255) & ~(size_t)255; }
constexpr size_t WS_CTL = 0, CTL_BYTES = 1u << 20;
constexpr size_t WS_WIN = WS_CTL + CTL_BYTES;
constexpr size_t WS_WBR = WS_WIN + al256((size_t)DEPTH * NP_PAD * D_MODEL * 2);
constexpr size_t WS_WOUT = WS_WBR + al256((size_t)DEPTH * 3 * D_MODEL * MIX_W * 2);
constexpr size_t WS_WUP = WS_WOUT + al256((size_t)DEPTH * D_MODEL * D_MODEL * 2);
constexpr size_t WS_WDOWN = WS_WUP + al256((size_t)DEPTH * 2 * D_FF * D_MODEL * 2);
constexpr size_t WS_MOD = WS_WDOWN + al256((size_t)DEPTH * D_MODEL * D_FF * 2);
constexpr size_t WS_X = WS_MOD + al256((size_t)DEPTH * (BATCH + 1) * D6 * 4 + GRID_W * 32 * 2 * 4);
constexpr size_t WS_H = WS_X + al256((size_t)MROWS * D_MODEL * 4);
constexpr size_t WS_MIX = WS_H + al256((size_t)MROWS * D_MODEL * 2);
constexpr size_t WS_SLAB = WS_MIX + al256((size_t)MROWS * D_MODEL * 4);
constexpr size_t WS_TB = WS_SLAB + al256((size_t)(D_FF / 512 > 12 ? D_FF / 512 : 12) * NCTX * D_MODEL * 4);
constexpr size_t WS_R = WS_TB + al256((size_t)3 * NCTX * D_MODEL * 2);
constexpr size_t WS_P = WS_R;
constexpr size_t WS_PF = WS_P + al256((size_t)MROWS * NP_MAIN * 2);
constexpr size_t WS_GQKV = WS_PF + al256((size_t)MROWS * PF_N * 4);
#if defined(TOKEN_GDN) || defined(NAIVE_PREP)
constexpr size_t WS_GG = WS_GQKV + al256((size_t)MROWS * 3 * MIX_W * 4);
#else
constexpr size_t WS_GG = WS_GQKV + 256;
#endif
constexpr size_t WS_GB = WS_GG + al256((size_t)MROWS * 2 * GDN_H * 4);
constexpr size_t WS_SXBC = WS_GB + al256((size_t)MROWS * 2 * GDN_H * 4);
#if defined(TOKEN_SSD) || defined(NAIVE_PREP)
constexpr size_t WS_SDT = WS_SXBC + al256((size_t)MROWS * SSM_XBC * 4);
#else
constexpr size_t WS_SDT = WS_SXBC + 256;
#endif
constexpr size_t WS_SA = WS_SDT + al256((size_t)MROWS * 2 * SSM_H * 4);
constexpr size_t WS_AQ = WS_SA + al256((size_t)MROWS * 2 * SSM_H * 4);
#ifdef NAIVE_ATTN
constexpr size_t WS_AK = WS_AQ + al256((size_t)MROWS * MIX_W * 4);
constexpr size_t WS_OG = WS_AK + al256((size_t)MROWS * ATT_HKV * 128 * 4);
#else
constexpr size_t WS_AK = WS_AQ + 256;
constexpr size_t WS_OG = WS_AK + 256;
#endif
#if defined(TOKEN_GDN) || defined(TOKEN_SSD) || defined(NAIVE_MIXOUT)
constexpr size_t WS_OS = WS_OG + al256((size_t)2 * MROWS * MIX_W * 4);
constexpr size_t WS_SC = WS_OS + al256((size_t)2 * MROWS * MIX_W * 4);
#else
constexpr size_t WS_OS = WS_OG + 256;
constexpr size_t WS_SC = WS_OS + 256;
#endif
#ifdef NAIVE_ATTN
constexpr size_t WS_YA = WS_SC + al256((size_t)MROWS * ATT_HQ * SC_LD * 4);
#else
constexpr size_t WS_YA = WS_SC + 256;
#endif
constexpr size_t WS_YB = WS_YA + al256((size_t)MROWS * MIX_W * 2);
constexpr size_t WS_YC = WS_YB + al256((size_t)MROWS * MIX_W * 2);
constexpr size_t WS_M32 = WS_YC + al256((size_t)MROWS * MIX_W * 2);
constexpr size_t WS_MB = WS_M32 + al256((size_t)MROWS * D_MODEL * 4);
constexpr size_t WS_AQB = WS_MB + al256((size_t)MROWS * D_MODEL * 2);
constexpr size_t WS_AKB = WS_AQB + al256((size_t)MROWS * MIX_W * 2);
constexpr size_t GDN_NU_H = (size_t)BATCH * (CHAIN_LEN / 64) * GDN_H * 2;
constexpr size_t WS_GW = WS_AKB + al256((size_t)MROWS * ATT_HKV * 128 * 2);
constexpr size_t WS_GQD = WS_GW + al256(GDN_NU_H * 64 * 128 * 2);
constexpr size_t WS_GKDT = WS_GQD + al256(GDN_NU_H * 64 * 128 * 2);
constexpr size_t WS_GA = WS_GKDT + al256(GDN_NU_H * 128 * 64 * 2);
constexpr size_t WS_GUT = WS_GA + al256(GDN_NU_H * 64 * 64 * 2);
constexpr size_t WS_GGL = WS_GUT + al256(GDN_NU_H * 128 * 64 * 2);
constexpr size_t SSD_NU_H = (size_t)BATCH * (CHAIN_LEN / 64) * SSM_H * 2;
constexpr size_t WS_SBCB = WS_GGL + al256(GDN_NU_H * 4);
constexpr size_t WS_SSC = WS_SBCB + al256((size_t)MROWS * 2 * SSM_BC * 2);
constexpr size_t WS_SEA = WS_SSC + al256(SSD_NU_H * 8 * 64 * 16 * 2);
constexpr size_t WS_SDC = WS_SEA + al256(SSD_NU_H * 64 * 4);
constexpr size_t WS_OGB = WS_SDC + al256(SSD_NU_H * 4);
constexpr size_t WS_OSB = WS_OGB + al256((size_t)2 * MROWS * MIX_W * 2);
constexpr size_t WS_OSB2 = WS_OSB + al256((size_t)2 * MROWS * MIX_W * 2);
constexpr size_t WS_GQKVB = WS_OSB2 + al256((size_t)2 * MROWS * MIX_W * 2);
constexpr size_t WS_SXB = WS_GQKVB + al256((size_t)MROWS * 3 * MIX_W * 2);
constexpr size_t WS_SCF = WS_SXB + al256((size_t)MROWS * MIX_W * 2);
constexpr size_t WS_END_MIX = WS_SCF + al256((size_t)BATCH * (CHAIN_LEN / 64) * SSM_G * 2 * 8 * 512 * 2);
constexpr size_t NBND = (size_t)MROWS / 64 * 2;
constexpr size_t WS_BP = WS_R;
constexpr size_t WS_BU = WS_BP + al256(NBND * D_FF * 4);
constexpr size_t WS_BG = WS_BU + al256(NBND * D_FF * 2);
constexpr size_t WS_ACT = WS_BG + al256(NBND * D_FF * 2);
constexpr size_t WS_END_FFN = WS_ACT + al256((size_t)MROWS * D_FF * 2);
constexpr size_t WS_NEED = WS_END_MIX > WS_END_FFN ? WS_END_MIX : WS_END_FFN;

constexpr int NWAVES = 8, NTHREADS = NWAVES * 64;
#ifndef ATT_EARLY_N
#define ATT_EARLY_N 0
#endif
constexpr int ATT_EARLY = ATT_EARLY_N;
static_assert(ATT_EARLY <= ATT_UNITS_LAT, "early attention units are latent units");
constexpr int RING_BYTES = 131072, LDS_BYTES = 147456, MISC_OFF = LDS_BYTES - 1024;

enum { ST_INPROJ = 0, ST_PREP, ST_G1, ST_MIX, ST_MIXOUT, ST_MERGE, ST_OUT, ST_NORM2, ST_UP, ST_ACT, ST_DOWN, ST_NORM3, NSTEP };
constexpr int STEP0 = 2;
constexpr int TOTAL_STEPS = STEP0 + DEPTH * NSTEP;
#ifndef MK_LAUNCH_MODE
#define MK_LAUNCH_MODE 1
#endif

struct Args { Ptrs p; unsigned* ctl; int step_lo, step_hi; };
typedef const __attribute__((address_space(4))) Args* KArgs;
__device__ __forceinline__ KArgs fresh_args() { KArgs k = (KArgs)__builtin_amdgcn_kernarg_segment_ptr(); asm volatile("" : "+s"(k)); return k; }
#if defined(__HIP_DEVICE_COMPILE__)
#define PTRS() const Ptrs p = fresh_args()->p; int lane; asm volatile("v_mbcnt_lo_u32_b32 %0, -1, 0\n\tv_mbcnt_hi_u32_b32 %0, -1, %0" : "=v"(lane)); const int wave = wave_s; const int tid = wave * 64 + lane; \
    const size_t gtid = (size_t)blockIdx.x * NTHREADS + tid, NT = (size_t)G * NTHREADS; const int gwave = (int)blockIdx.x * NWAVES + wave, NGW = G * NWAVES; (void)lane; (void)wave; (void)gtid; (void)NT; (void)gwave; (void)NGW
#else
#define PTRS() const Ptrs p = a.p; const int tid = 0, lane = 0, wave = 0, gwave = 0, NGW = 1; const size_t gtid = 0, NT = 1; (void)tid; (void)lane; (void)wave; (void)gtid; (void)NT; (void)gwave; (void)NGW
#endif

constexpr int WT_I_IN = (D_MODEL / 64) * (P_IN / 32), WT_I_BR = (MIX_W / 64) * (D_MODEL / 32), WT_I_OUT = (D_MODEL / 64) * (D_MODEL / 32), WT_I_UP = (D_MODEL / 64) * (2 * D_FF / 32), WT_I_DN = (D_FF / 64) * (D_MODEL / 32);
constexpr int WT_I_ALL = WT_I_IN + 3 * WT_I_BR + WT_I_OUT + WT_I_UP + WT_I_DN;
template <class PT> __device__ __forceinline__ void weight_item(const PT& p, int l, int it, LAS float* scr, int lane) {
    int r = it;
    if (r < WT_I_IN) { const int nblk = P_IN / 32, k0 = 64 * (r / nblk), n0 = 32 * (r % nblk);
        transpose_item(p.w_in + (size_t)l * D_MODEL * P_IN, D_MODEL, P_IN, p.Wt_in + (size_t)l * NP_PAD * D_MODEL, k0, n0, inproj_dst_row0(n0), scr, lane); return; } r -= WT_I_IN;
    if (r < 3 * WT_I_BR) { const int br = r / WT_I_BR; r -= br * WT_I_BR; const int nblk = D_MODEL / 32, k0 = 64 * (r / nblk), n0 = 32 * (r % nblk);
        const float* w = (br == 0 ? p.w_br_a : br == 1 ? p.w_br_b : p.w_br_c) + (size_t)l * MIX_W * D_MODEL;
        transpose_item(w, 3 * MIX_W, D_MODEL, p.Wt_br + (size_t)l * 3 * D_MODEL * MIX_W + br * MIX_W, k0, n0, n0, scr, lane); return; } r -= 3 * WT_I_BR;
    if (r < WT_I_OUT) { const int nblk = D_MODEL / 32, k0 = 64 * (r / nblk), n0 = 32 * (r % nblk);
        transpose_item(p.w_out + (size_t)l * D_MODEL * D_MODEL, D_MODEL, D_MODEL, p.Wt_out + (size_t)l * D_MODEL * D_MODEL, k0, n0, n0, scr, lane); return; } r -= WT_I_OUT;
    if (r < WT_I_UP) { const int nblk = 2 * D_FF / 32, k0 = 64 * (r / nblk), n0 = 32 * (r % nblk);
        transpose_item(p.w_up + (size_t)l * D_MODEL * 2 * D_FF, D_MODEL, 2 * D_FF, p.Wt_up + (size_t)l * 2 * D_FF * D_MODEL, k0, n0, up_dst_row0(n0), scr, lane); return; } r -= WT_I_UP;
    { const int nblk = D_MODEL / 32, k0 = 64 * (r / nblk), n0 = 32 * (r % nblk);
        transpose_item(p.w_down + (size_t)l * D_FF * D_MODEL, D_FF, D_MODEL, p.Wt_down + (size_t)l * D_MODEL * D_FF, k0, n0, n0, scr, lane); }
}
template <class PT> __device__ __forceinline__ WtDesc weight_desc(const PT& p, int l, int it) {
    int r = it;
    if (r < WT_I_IN) { const int nblk = P_IN / 32, k0 = 64 * (r / nblk), n0 = 32 * (r % nblk); return WtDesc{p.w_in + (size_t)l * D_MODEL * P_IN, p.Wt_in + (size_t)l * NP_PAD * D_MODEL, D_MODEL, P_IN, k0, n0, inproj_dst_row0(n0)}; } r -= WT_I_IN;
    if (r < 3 * WT_I_BR) { const int br = r / WT_I_BR; r -= br * WT_I_BR; const int nblk = D_MODEL / 32, k0 = 64 * (r / nblk), n0 = 32 * (r % nblk);
        const float* w = (br == 0 ? p.w_br_a : br == 1 ? p.w_br_b : p.w_br_c) + (size_t)l * MIX_W * D_MODEL;
        return WtDesc{w, p.Wt_br + (size_t)l * 3 * D_MODEL * MIX_W + br * MIX_W, 3 * MIX_W, D_MODEL, k0, n0, n0}; } r -= 3 * WT_I_BR;
    if (r < WT_I_OUT) { const int nblk = D_MODEL / 32, k0 = 64 * (r / nblk), n0 = 32 * (r % nblk); return WtDesc{p.w_out + (size_t)l * D_MODEL * D_MODEL, p.Wt_out + (size_t)l * D_MODEL * D_MODEL, D_MODEL, D_MODEL, k0, n0, n0}; } r -= WT_I_OUT;
    if (r < WT_I_UP) { const int nblk = 2 * D_FF / 32, k0 = 64 * (r / nblk), n0 = 32 * (r % nblk); return WtDesc{p.w_up + (size_t)l * D_MODEL * 2 * D_FF, p.Wt_up + (size_t)l * 2 * D_FF * D_MODEL, D_MODEL, 2 * D_FF, k0, n0, up_dst_row0(n0)}; } r -= WT_I_UP;
    { const int nblk = D_MODEL / 32, k0 = 64 * (r / nblk), n0 = 32 * (r % nblk); return WtDesc{p.w_down + (size_t)l * D_FF * D_MODEL, p.Wt_down + (size_t)l * D_MODEL * D_FF, D_FF, D_MODEL, k0, n0, n0}; }
}
constexpr int FILL_A0 = ((MROWS / 256) * (NP_PAD / 256)) % 256, FILL_B0 = 3 * (NCTX / 256) * (D_MODEL / 256), FILL_C0 = ((MROWS / 256) * (2 * D_FF / 256)) % 256;
#ifndef FILL_NA
#define FILL_NA 14
#endif
#ifndef FILL_NB
#define FILL_NB 11
#endif
#ifndef FILL_NC
#define FILL_NC 19
#endif
constexpr int fill_min(int a, int b) { return a < b ? a : b; }
constexpr int WT_OWN = WT_I_ALL - WT_I_IN;
#ifndef FILL_NM
#define FILL_NM 512
#endif
constexpr int FILL_MCH = 16;
constexpr int FILL_EA = fill_min((256 - FILL_A0) * 8 * FILL_NA, WT_I_ALL), FILL_EM = fill_min(FILL_EA + FILL_NM * FILL_MCH, WT_I_ALL), FILL_EB = fill_min(FILL_EM + (256 - FILL_B0) * 8 * FILL_NB, WT_I_ALL), FILL_EC = fill_min(FILL_EB + (256 - FILL_C0) * 8 * FILL_NC, WT_I_ALL);
static_assert(FILL_A0 > 0 && FILL_C0 > 0, "fill slots");
static_assert(FILL_EM >= 3 * WT_I_BR && FILL_EB >= 3 * WT_I_BR + WT_I_OUT + WT_I_UP && FILL_EC >= WT_OWN, "a matrix must be complete before the phase that multiplies by it (branch: merge; up: up-projection; down: within the layer)");
static_assert(64 * 33 <= 2176 && 8 * 4352 * 4 <= 146432 - 1024, "fill scratch: two transpose tiles per wave inside the dynamic LDS below the control words");
__device__ __forceinline__ void weight_fill_ws(int l, int seg_b, int seg_e_in, int ws, int nws, LAS unsigned char* lds, int wv) {
#if defined(__HIP_DEVICE_COMPILE__)
    asm volatile("s_waitcnt vmcnt(0)" ::: "memory"); LDS_BARRIER();
    int l_; asm volatile("v_mbcnt_lo_u32_b32 %0, -1, 0\n\tv_mbcnt_hi_u32_b32 %0, -1, %0" : "=v"(l_));
    const int seg_e = (l == DEPTH - 1 && seg_e_in > WT_OWN) ? WT_OWN : seg_e_in;
#define WT_AT(f_) weight_desc(fresh_args()->p, (f_) < WT_OWN ? l : l + 1, (f_) < WT_OWN ? WT_I_IN + (f_) : (f_) - WT_OWN)
    LAS float* scr = (LAS float*)lds + wv * 4352;
    int it = seg_b + ws;
    if (it < seg_e) { float wa[32], wb[32]; WtDesc da = WT_AT(it), db = da; transpose_load(da, l_, wa);
        for (;;) { const int it2 = it + nws; const bool h2 = it2 < seg_e;
            if (h2) { db = WT_AT(it2); transpose_load(db, l_, wb); }
            transpose_finish(da, wa, scr, l_);
            if (!h2) break;
            const int it3 = it2 + nws; const bool h3 = it3 < seg_e;
            if (h3) { da = WT_AT(it3); transpose_load(da, l_, wa); }
            transpose_finish(db, wb, scr + 2176, l_);
            if (!h3) break;
            it = it3; } }
#undef WT_AT
    LDS_BARRIER();
#endif
}
__device__ __forceinline__ void weight_fill(int l, int seg_b, int seg_e, int wg0, LAS unsigned char* lds, int wv) { weight_fill_ws(l, seg_b, seg_e, ((int)blockIdx.x - wg0) * 8 + wv, (256 - wg0) * 8, lds, wv); }
__global__ void __launch_bounds__(NTHREADS, 2) fwd(Args a) {
    extern __shared__ __attribute__((aligned(16))) unsigned char lds_raw[];
    LAS unsigned char* lds = (LAS unsigned char*)lds_raw;
    volatile LAS unsigned* MISC = (volatile LAS unsigned*)(lds + MISC_OFF);
    const int G = gridDim.x;
    const int wave_s = __builtin_amdgcn_readfirstlane((int)threadIdx.x >> 6);
    for (int u = threadIdx.x; u < (LDS_BYTES - MISC_OFF) / 4; u += NTHREADS) ((LAS unsigned*)(lds + MISC_OFF))[u] = 0u;
    __syncthreads();
    const bool multi = (a.step_hi - a.step_lo) > 1;
    if (multi) (void)xcd_barrier_post(a.ctl + 4096, MISC + 8);
#define IN(k) (fresh_args()->step_lo <= (k) && (k) < fresh_args()->step_hi)
#ifdef ONLY_STEP
#define EN(k) ((k) == ONLY_STEP)
#elif defined(SKIP_MASK)
#define EN(k) (!((SKIP_MASK >> (k)) & 1))
#else
#define EN(k) true
#endif
#define SEAM(k) do { if (IN((k) + 1)) { XcdBarrier bl; bl.bar = fresh_args()->ctl + 4096; bl.x = xb_xcc_id(); bl.st = (volatile LAS unsigned*)(lds + MISC_OFF) + 8; xcd_barrier(bl); } } while (0)
#define FOR_ITEMS(i, n) for (size_t i = gtid; i < (size_t)(n); i += NT)
#define FRESH_TID(name) int name; { int l_; asm volatile("v_mbcnt_lo_u32_b32 %0, -1, 0\n\tv_mbcnt_hi_u32_b32 %0, -1, %0" : "=v"(l_)); name = wave_s * 64 + l_; }

    if (EN(0) && IN(0)) {
        PTRS();
        LAS float* scr = (LAS float*)lds + wave * 4096;
        FOR_ITEMS(i, (size_t)GRID_W * 32) { const float ang = (float)(i >> 5) * rope_inv_freq((int)(i & 31)); p.ROPE[2 * i] = cosf(ang); p.ROPE[2 * i + 1] = sinf(ang); }
#ifdef FILL_OFF
        for (int l = 0; l < DEPTH; ++l) for (int it = gwave; it < WT_I_ALL; it += NGW) weight_item(fresh_args()->p, l, it, scr, lane);
#else
        for (int it = gwave; it < WT_I_IN; it += NGW) weight_item(fresh_args()->p, 0, it, scr, lane);
        for (int l = 1; l < DEPTH; ++l) for (int it = FILL_EC - WT_OWN + gwave; it < WT_I_IN; it += NGW) weight_item(fresh_args()->p, l, it, scr, lane);
#endif
        for (int l = 0; l < DEPTH; ++l) {
            { bf16* z = p.Wt_in + ((size_t)l * NP_PAD + NP_MAIN + PF_N) * D_MODEL; const size_t n16 = (size_t)(NP_PAD - NP_MAIN - PF_N) * D_MODEL / 8;
                FOR_ITEMS(i, n16) *(vu4*)(z + i * 8) = (vu4){0u, 0u, 0u, 0u}; }
        }
        __syncthreads();
        LAS float* sl = (LAS float*)lds;
        LAS float* red = sl + 3 * D_MODEL;
        for (int i = tid; i < (BATCH + 1) * D_MODEL; i += NTHREADS) sl[i] = silu_f(i < BATCH * D_MODEL ? p.c[i] : p.c_ctx[i - BATCH * D_MODEL]);
        __syncthreads();
        for (int it = (int)blockIdx.x; it < DEPTH * (D6 / 64); it += G) {
            const int l = it / (D6 / 64), n0 = (it % (D6 / 64)) * 64;
            float acc0 = 0.f, acc1 = 0.f, acc2 = 0.f;
            const float* w = p.w_ada + ((size_t)l * D_MODEL + wave * (D_MODEL / 8)) * D6 + n0 + lane;
            for (int k0 = 0; k0 < D_MODEL / 8; k0 += 32) { float wv[32];
#pragma unroll
                for (int j = 0; j < 32; ++j) wv[j] = w[(size_t)(k0 + j) * D6];
#pragma unroll
                for (int j = 0; j < 32; ++j) { const int kk = wave * (D_MODEL / 8) + k0 + j; acc0 += sl[kk] * wv[j]; acc1 += sl[D_MODEL + kk] * wv[j]; acc2 += sl[2 * D_MODEL + kk] * wv[j]; } }
            red[(wave * 3 + 0) * 64 + lane] = acc0; red[(wave * 3 + 1) * 64 + lane] = acc1; red[(wave * 3 + 2) * 64 + lane] = acc2;
            __syncthreads();
            if (tid < 192) { const int m = tid >> 6, ln = tid & 63; float s = 0.f;
#pragma unroll
                for (int w8 = 0; w8 < 8; ++w8) s += red[(w8 * 3 + m) * 64 + ln];
                p.MOD[((size_t)l * (BATCH + 1) + m) * D6 + n0 + ln] = s + p.b_ada[(size_t)l * D6 + n0 + ln]; }
            __syncthreads();
        }
        SEAM(0);
    }
    if (EN(1) && IN(1)) {
        PTRS();
        for (int r = gwave; r < MROWS; r += NGW) { vf4 x[NV4]; row_load(r < NLAT ? p.x + (size_t)r * D_MODEL : p.ctx + (size_t)(r - NLAT) * D_MODEL, lane, x);
            norm_h_wave(p, 0, r, 0, lane, x); }
        SEAM(1);
    }

    for (int l = 0; l < DEPTH; ++l) {
        const int sb = STEP0 + l * NSTEP;
        if (sb + NSTEP <= fresh_args()->step_lo || sb >= fresh_args()->step_hi) continue;
        const bool last = (l == DEPTH - 1);
        const int MR = last ? NLAT : MROWS;

        if (EN(2 + ST_INPROJ) && IN(sb + ST_INPROJ)) {
            PTRS();
            pg8::Gemm g{p.H, p.Wt_in + (size_t)l * NP_PAD * D_MODEL, MROWS, NP_PAD, D_MODEL, D_MODEL}; pg8::StaticOrder S; S.init(MROWS, NP_PAD, G, (int)blockIdx.x);
            pg8::EpiInProj E{p.P, p.PF};
            pg8::gemm_phase<pg8::EpiInProj, pg8::StaticOrder, true, true>(lds, g, S, E, tid);
#ifndef FILL_OFF
            if ((int)blockIdx.x >= FILL_A0) weight_fill(l, 0, FILL_EA, FILL_A0, lds, wave_s);
#endif
            SEAM(sb + ST_INPROJ);
        }

        if (EN(2 + ST_PREP) && IN(sb + ST_PREP)) {
            PTRS();
#ifdef NAIVE_PREP
            FOR_ITEMS(i, (size_t)MROWS * 3 * GDN_H) prep_gdn_item(p, l, (int)(i / (3 * GDN_H)), (int)(i % (3 * GDN_H)));
            FOR_ITEMS(i, (size_t)MROWS * 2 * GDN_H) prep_gdn_gb_item(p, l, (int)(i / (2 * GDN_H)), (int)(i % (2 * GDN_H)));
            FOR_ITEMS(i, (size_t)MROWS * SSM_XBC) prep_ssd_item(p, l, (int)(i / SSM_XBC), (int)(i % SSM_XBC));
            FOR_ITEMS(i, (size_t)MROWS * 2 * SSM_H) prep_ssd_dt_item(p, l, (int)(i / (2 * SSM_H)), (int)(i % (2 * SSM_H)));
#else
            for (int it = gwave; it < (MROWS / PREP_RB) * PREP_NPASS; it += NGW) prep_conv_block_wave(p, l, it / PREP_NPASS, it % PREP_NPASS, lane);
#endif
#ifdef NAIVE_ATTN
            FOR_ITEMS(i, (size_t)MROWS * (ATT_HQ + ATT_HKV)) prep_attn_item(p, (int)(i / (ATT_HQ + ATT_HKV)), (int)(i % (ATT_HQ + ATT_HKV)));
#endif
            SEAM(sb + ST_PREP);
        }

        if (EN(2 + ST_G1) && IN(sb + ST_G1)) {
            PTRS();
            {
                constexpr int NG = BATCH * NCH * GDN_H, NS = SSD_LOCAL_UNITS; unsigned* ctr = fresh_args()->ctl + 8192 + 64 * (DEPTH + l);
                for (;;) { if (tid == 0) MISC[16] = __hip_atomic_fetch_add(ctr, 1u, __ATOMIC_RELAXED, __HIP_MEMORY_SCOPE_AGENT);
                    LDS_BARRIER(); const int u = (int)MISC[16]; LDS_BARRIER();
                    if (u >= NG + NS + ATT_EARLY) break;
                    int tl = tid; asm volatile("" : "+v"(tl));
                    if (u < ATT_EARLY) attn_unit(p, l, (LAS bf16*)lds, u, tl);
                    else if (u < ATT_EARLY + NS) ssd_local_unit(p, lds, u - ATT_EARLY, tl); else gdn_g1_unit(p, lds, u - ATT_EARLY - NS, tl); } }
            SEAM(sb + ST_G1);
        }

        if (EN(2 + ST_MIX) && IN(sb + ST_MIX)) {
            PTRS();
            constexpr int N_GDN_WG = BATCH * GDN_H * 2 * 4, N_SSD_WG = BATCH * SSM_H * 2;
            const int wg = (int)blockIdx.x;
#ifdef TOKEN_GDN
            if (wg < N_GDN_WG) gdn_token_wg(p, (LAS float*)lds, wg >> 2, wg & 3, tid);
#else
            if (wg < N_GDN_WG) gdn_scan_wg(p, lds, (wg & 7) + 8 * (wg >> 5), (wg >> 3) & 3, tid);
#endif
#ifdef TOKEN_SSD
            else if (wg < N_GDN_WG + N_SSD_WG) ssd_token_wg(p, (LAS float*)lds, wg - N_GDN_WG, tid);
#else
            else if (wg < N_GDN_WG + N_SSD_WG) ssd_scan_wg(p, lds, wg - N_GDN_WG, tid);
#endif
            {
                const int nu = ATT_UNITS_LAT + (last ? 0 : ATT_UNITS_CTX); unsigned* ctr = fresh_args()->ctl + 8192 + 64 * l;
                for (;;) { if (tid == 0) MISC[16] = ATT_EARLY + __hip_atomic_fetch_add(ctr, 1u, __ATOMIC_RELAXED, __HIP_MEMORY_SCOPE_AGENT);
                    LDS_BARRIER(); const int u = (int)MISC[16]; LDS_BARRIER();
                    if (u >= nu) break;
                    attn_unit(p, l, (LAS bf16*)lds, u, tid); } }
#ifndef FILL_OFF
            {
                constexpr int NCH_M = (FILL_EM - FILL_EA + FILL_MCH - 1) / FILL_MCH; unsigned* ctr = fresh_args()->ctl + 8192 + 64 * (2 * DEPTH + l);
                const int em = (last && FILL_EM > WT_OWN) ? WT_OWN : FILL_EM;
                for (;;) { if (tid == 0) MISC[16] = __hip_atomic_fetch_add(ctr, 1u, __ATOMIC_RELAXED, __HIP_MEMORY_SCOPE_AGENT);
                    LDS_BARRIER(); const int ch = (int)MISC[16]; LDS_BARRIER();
                    const int fb = FILL_EA + ch * FILL_MCH; if (ch >= NCH_M || fb >= em) break;
                    weight_fill_ws(l, fb, fb + FILL_MCH < em ? fb + FILL_MCH : em, wave_s, 8, lds, wave_s); } }
#endif
            SEAM(sb + ST_MIX);
        }

        if (EN(2 + ST_MIXOUT) && IN(sb + ST_MIXOUT)) {
            PTRS();
#ifdef NAIVE_MIXOUT
            FOR_ITEMS(i, (size_t)MROWS * GDN_H) gdn_out_item(p, l, (int)(i / GDN_H), (int)(i % GDN_H));
            FOR_ITEMS(i, (size_t)MROWS * SSM_G) ssd_out_item(p, l, (int)(i / SSM_G), (int)(i % SSM_G));
#else
            for (int r = gwave; r < (last ? NLAT : MROWS); r += NGW) mixout_row_wave(p, l, r, lane);
#endif
            SEAM(sb + ST_MIXOUT);
        }

        if (EN(2 + ST_MERGE) && IN(sb + ST_MERGE)) {
            PTRS();
            { pg8::Gemm g{p.YA, p.Wt_br + (size_t)l * 3 * D_MODEL * MIX_W, NLAT, D_MODEL, 3 * MIX_W, 3 * MIX_W}; pg8::StaticOrder S; S.init(NLAT, D_MODEL, G, (int)blockIdx.x);
              pg8::EpiMerge3 E{p.P + C_MG, p.MB};
              pg8::gemm_phase<pg8::EpiMerge3, pg8::StaticOrder, true, true>(lds, g, S, E, tid); }
            if (!last) { pg8::Gemm g{p.YA, p.Wt_br + (size_t)l * 3 * D_MODEL * MIX_W, MROWS, D_MODEL, MIX_W, 3 * MIX_W}; pg8::CtxMergeOrder S{(int)blockIdx.x};
              pg8::EpiMerge E{p.P + C_MG, p.TB};
              FRESH_TID(tid2); pg8::gemm_phase<pg8::EpiMerge, pg8::CtxMergeOrder, true, true>(lds, g, S, E, tid2); }
#ifndef FILL_OFF
            if ((int)blockIdx.x >= FILL_B0) weight_fill(l, FILL_EM, FILL_EB, FILL_B0, lds, wave_s);
#endif
            SEAM(sb + ST_MERGE);
        }

        if (EN(2 + ST_OUT) && IN(sb + ST_OUT)) {
            PTRS();
            { pg8::Gemm g{p.MB, p.Wt_out + (size_t)l * D_MODEL * D_MODEL, NLAT, D_MODEL, D_MODEL, D_MODEL}; pg8::StaticOrder S; S.init(NLAT, D_MODEL, G, (int)blockIdx.x);
              pg8::EpiBf16Plain E{p.MIXb, D_MODEL};
              pg8::gemm_phase<pg8::EpiBf16Plain, pg8::StaticOrder, true, true>(lds, g, S, E, tid); }
            if (!last) {
                pg8::Gemm g{p.TB, p.Wt_out + (size_t)l * D_MODEL * D_MODEL, 3 * NCTX, D_MODEL, pg8::SPLIT_KS, D_MODEL}; pg8::SplitOrder3 S{G, (int)blockIdx.x};
                pg8::EpiSlab3 E{p.SLAB};
                FRESH_TID(tid2); pg8::gemm_phase<pg8::EpiSlab3, pg8::SplitOrder3, true, true>(lds, g, S, E, tid2); }
            SEAM(sb + ST_OUT);
        }

        if (EN(2 + ST_NORM2) && IN(sb + ST_NORM2)) {
            PTRS();
            for (int r = gwave; r < MR; r += NGW) { int ll = lane; asm volatile("" : "+v"(ll)); vf4 x[NV4]; row_load(l > 0 ? p.X + (size_t)r * D_MODEL : (r < NLAT ? p.x + (size_t)r * D_MODEL : p.ctx + (size_t)(r - NLAT) * D_MODEL), ll, x); resid_wave(p, l, r, 0, ll, x, 3 * pg8::OUT_NS);
                row_store(p.X + (size_t)r * D_MODEL, ll, x); norm_h_wave(p, l, r, 1, ll, x); }
            SEAM(sb + ST_NORM2);
        }

        if (EN(2 + ST_UP) && IN(sb + ST_UP)) {
            PTRS();
            pg8::Gemm g{p.H, p.Wt_up + (size_t)l * 2 * D_FF * D_MODEL, MR, 2 * D_FF, D_MODEL, D_MODEL}; pg8::StaticOrder S; S.init(MR, 2 * D_FF, G, (int)blockIdx.x);
            pg8::EpiAct E{p.ACT, p.BP, p.BU, p.BG, p.ffn_conv_w + (size_t)l * 3 * D_FF, p.ffn_conv_b + (size_t)l * D_FF};
            pg8::gemm_phase<pg8::EpiAct, pg8::StaticOrder, true, true>(lds, g, S, E, tid);
#ifndef FILL_OFF
            if ((int)blockIdx.x >= FILL_C0) weight_fill(l, FILL_EB, FILL_EC, FILL_C0, lds, wave_s);
#endif
            SEAM(sb + ST_UP);
        }

        if (EN(2 + ST_ACT) && IN(sb + ST_ACT)) { PTRS();
            for (int it = (int)gtid; it < (MR / 64 * 2) * (D_FF / 4); it += (int)NT) act_fix_item(p, l, it / (D_FF / 4), (it % (D_FF / 4)) * 4);
            SEAM(sb + ST_ACT); }

        if (EN(2 + ST_DOWN) && IN(sb + ST_DOWN)) {
            PTRS();
            { pg8::Gemm g{p.ACT, p.Wt_down + (size_t)l * D_MODEL * D_FF, NLAT, D_MODEL, D_FF, D_FF}; pg8::StaticOrder S; S.init(NLAT, D_MODEL, G, (int)blockIdx.x);
              pg8::EpiBf16Plain E{p.MIXb, D_MODEL};
              pg8::gemm_phase<pg8::EpiBf16Plain, pg8::StaticOrder, true, true>(lds, g, S, E, tid); }
            if (!last) {
                pg8::Gemm g{p.ACT, p.Wt_down + (size_t)l * D_MODEL * D_FF, MROWS, D_MODEL, pg8::SPLIT_KS, D_FF}; pg8::SplitOrder S{pg8::DOWN_NS, G, (int)blockIdx.x};
                pg8::EpiSlab E{p.SLAB};
                FRESH_TID(tid2); pg8::gemm_phase<pg8::EpiSlab, pg8::SplitOrder, true, true>(lds, g, S, E, tid2); }
            SEAM(sb + ST_DOWN);
        }

        if (EN(2 + ST_NORM3) && IN(sb + ST_NORM3)) {
            PTRS();
            for (int r = gwave; r < (last ? NLAT : MROWS); r += NGW) { int ll = lane; asm volatile("" : "+v"(ll)); vf4 x[NV4]; row_load(p.X + (size_t)r * D_MODEL, ll, x); resid_wave(p, l, r, 1, ll, x, pg8::DOWN_NS);
                if (last) row_store(p.out + (size_t)r * D_MODEL, ll, x);
                else { row_store(p.X + (size_t)r * D_MODEL, ll, x); norm_h_wave(p, l + 1, r, 0, ll, x); } }
            SEAM(sb + ST_NORM3);
        }
    }
#undef IN
#undef SEAM
#undef FOR_ITEMS
}

extern "C" void kernel_launch(void* const* d_in, const int* in_sizes, int n_in, void* d_out, int out_size, void* d_ws, size_t ws_size, hipStream_t stream) {
    static int grid = 0;
    if (grid == 0) {
        if (n_in != 30 || in_sizes[0] != NLAT * D_MODEL || out_size != NLAT * D_MODEL || ws_size < WS_NEED) {
            fprintf(stderr, "kernel_launch: unexpected problem: n_in %d in0 %d out %d ws %zu (need %zu); nothing launched\n", n_in, n_in > 0 ? in_sizes[0] : -1, out_size, ws_size, (size_t)WS_NEED); grid = -1; return; }
        int dev = 0, cus = 0;
        if (hipGetDevice(&dev) != hipSuccess || hipDeviceGetAttribute(&cus, hipDeviceAttributeMultiprocessorCount, dev) != hipSuccess) { grid = -1; return; }
        if (hipFuncSetAttribute((const void*)fwd, hipFuncAttributeMaxDynamicSharedMemorySize, LDS_BYTES) != hipSuccess) { fprintf(stderr, "kernel_launch: hipFuncSetAttribute failed\n"); grid = -1; return; }
        int per_cu = 0;
        if (hipOccupancyMaxActiveBlocksPerMultiprocessor(&per_cu, (const void*)fwd, NTHREADS, LDS_BYTES) != hipSuccess || per_cu < 1) fprintf(stderr, "kernel_launch: occupancy query reports %d\n", per_cu);
        (void)hipGetLastError();
        grid = cus;
        if (grid != 256) { fprintf(stderr, "kernel_launch: built for a 256-CU device (workgroup roles in the mixer phase); got %d; nothing launched\n", cus); grid = -1; return; }
    }
    if (grid < 0) return;
    unsigned char* ws = (unsigned char*)d_ws;
    if (hipMemsetAsync(ws + WS_CTL, 0, CTL_BYTES, stream) != hipSuccess) return;
    Args a{};
    const float** pi = (const float**)&a.p;
    for (int i = 0; i < 30; ++i) pi[i] = (const float*)d_in[i];
    Ptrs& p = a.p;
    p.out = (float*)d_out;
    p.Wt_in = (bf16*)(ws + WS_WIN); p.Wt_br = (bf16*)(ws + WS_WBR); p.Wt_out = (bf16*)(ws + WS_WOUT); p.Wt_up = (bf16*)(ws + WS_WUP); p.Wt_down = (bf16*)(ws + WS_WDOWN);
    p.MOD = (float*)(ws + WS_MOD); p.ROPE = p.MOD + (size_t)DEPTH * (BATCH + 1) * D6; p.X = (float*)(ws + WS_X); p.H = (bf16*)(ws + WS_H); p.MIX = (float*)(ws + WS_MIX); p.MIXb = (bf16*)(ws + WS_MIX);
    p.SLAB = (float*)(ws + WS_SLAB); p.TB = (bf16*)(ws + WS_TB);
    p.OGb = (bf16*)(ws + WS_OGB); p.OSb = (bf16*)(ws + WS_OSB); p.OSb2 = (bf16*)(ws + WS_OSB2); p.GQKVb = (bf16*)(ws + WS_GQKVB); p.SXb = (bf16*)(ws + WS_SXB);
    p.P = (bf16*)(ws + WS_P); p.PF = (float*)(ws + WS_PF); p.GQKV = (float*)(ws + WS_GQKV); p.GG = (float*)(ws + WS_GG); p.GB = (float*)(ws + WS_GB);
    p.SXBC = (float*)(ws + WS_SXBC); p.SDT = (float*)(ws + WS_SDT); p.SA = (float*)(ws + WS_SA); p.AQ = (float*)(ws + WS_AQ); p.AK = (float*)(ws + WS_AK);
    p.OG = (float*)(ws + WS_OG); p.OS = (float*)(ws + WS_OS); p.SC = (float*)(ws + WS_SC); p.YA = (bf16*)(ws + WS_YA); p.YB = p.YA + MIX_W; p.YC = p.YA + 2 * MIX_W;
    p.SBCb = (bf16*)(ws + WS_SBCB); p.SSC = (bf16*)(ws + WS_SSC); p.SEA = (float*)(ws + WS_SEA); p.SEAb = (bf16*)(ws + WS_SEA); p.SDC = (float*)(ws + WS_SDC); p.SCF = (bf16*)(ws + WS_SCF);
    p.GW = (bf16*)(ws + WS_GW); p.GQd = (bf16*)(ws + WS_GQD); p.GKdT = (bf16*)(ws + WS_GKDT); p.GA = (bf16*)(ws + WS_GA); p.GUT = (bf16*)(ws + WS_GUT); p.GGL = (float*)(ws + WS_GGL);
    p.AQb = (bf16*)(ws + WS_AQB); p.AKb = (bf16*)(ws + WS_AKB);
    p.M32 = (float*)(ws + WS_M32); p.MB = (bf16*)(ws + WS_MB); p.UG = nullptr; p.ACT = (bf16*)(ws + WS_ACT); p.BP = (float*)(ws + WS_BP); p.BU = (bf16*)(ws + WS_BU); p.BG = (bf16*)(ws + WS_BG);
    a.ctl = (unsigned*)(ws + WS_CTL);
#if MK_LAUNCH_MODE == 1
    a.step_lo = 0; a.step_hi = TOTAL_STEPS;
    hipLaunchKernelGGL(fwd, dim3(grid), dim3(NTHREADS), LDS_BYTES, stream, a);
#else
    for (int s = 0; s < TOTAL_STEPS; ++s) { a.step_lo = s; a.step_hi = s + 1; hipLaunchKernelGGL(fwd, dim3(grid), dim3(NTHREADS), LDS_BYTES, stream, a); }
#endif
    const hipError_t le = hipPeekAtLastError();
    if (le != hipSuccess) fprintf(stderr, "kernel_launch: launch failed: %s\n", hipGetErrorName(le));
}
```

```cpp
#include <hip/hip_runtime.h>
#include <cstdio>
#include <cstdint>
#include <type_traits>
#define MK_LAUNCH_MODE 1
#define FILL_NA 10
#define FILL_NB 14
#define FILL_NC 4
#define FILL_NM 256
#include <cstdint>
#include <cstddef>
#include <cmath>
#ifdef HOST_TEST
#define HD inline
#define CFENCE() do {} while (0)
#else
#define HD __host__ __device__ __forceinline__
#if defined(__HIP_DEVICE_COMPILE__)
#define CFENCE() asm volatile("" ::: "memory")
#else
#define CFENCE() do {} while (0)
#endif
#endif

#ifndef CFG_SMALL
constexpr int D_MODEL = 2048, BATCH = 2, SEQ = 4096, DEPTH = 4, CTX_LEN = 256, D_FF = 5632;
#else
constexpr int D_MODEL = 1024, BATCH = 2, SEQ = 512, DEPTH = 2, CTX_LEN = 128, D_FF = 512;
#endif
constexpr int GRID_W = 64, WINDOW = 128;
constexpr float EPS = 1e-6f;
constexpr int MIX_W = D_MODEL / 2, GDN_H = MIX_W / 128, SSM_H = MIX_W / 64, SSM_G = 2, SSM_N = 128, SSM_P = 64, SSM_HPG = SSM_H / SSM_G;
constexpr int ATT_HQ = MIX_W / 128, ATT_HKV = 2, ATT_GRP = ATT_HQ / ATT_HKV;
constexpr int SSM_BC = SSM_G * SSM_N, SSM_XBC = MIX_W + 2 * SSM_BC;
constexpr int NLAT = BATCH * SEQ, NCTX = BATCH * CTX_LEN, MROWS = NLAT + NCTX;
constexpr int CHAIN_LEN = CTX_LEN + SEQ;
constexpr int R_QKV = 0, R_GATE = 3 * MIX_W, R_A = 4 * MIX_W, R_B = R_A + 2 * GDN_H, R_Z = R_B + 2 * GDN_H, R_XBC = R_Z + MIX_W, R_DT = R_XBC + SSM_XBC,
              R_AQ = R_DT + 2 * SSM_H, R_AKV = R_AQ + MIX_W, R_MG = R_AKV + 2 * ATT_HKV * 128, P_IN = R_MG + 3 * D_MODEL;
constexpr int C_QKV = 0, C_GATE = 3 * MIX_W, C_Z = 4 * MIX_W, C_XBC = 5 * MIX_W, C_AQ = C_XBC + SSM_XBC, C_AKV = C_AQ + MIX_W, C_MG = C_AKV + 512, NP_MAIN = C_MG + 3 * D_MODEL;
constexpr int PF_A = 0, PF_B = 2 * GDN_H, PF_DT = 4 * GDN_H, PF_N = 4 * GDN_H + 2 * SSM_H;
constexpr int NP_PAD = NP_MAIN + 256;
static_assert(NP_MAIN % 256 == 0 && PF_N <= 256 && MROWS % 256 == 0 && (2 * D_FF) % 256 == 0 && D_FF % 256 == 0, "tile shapes");
static_assert(P_IN == NP_MAIN + PF_N, "column bookkeeping");
constexpr int D6 = 6 * D_MODEL;

typedef unsigned short bf16;
HD float bf2f(bf16 b) { union { unsigned u; float f; } c; c.u = ((unsigned)b) << 16; return c.f; }
HD bf16 f2bf(float f) { union { unsigned u; float f; } c; c.f = f; unsigned u = c.u; u += 0x7FFFu + ((u >> 16) & 1u); return (bf16)(u >> 16); }
HD float silu_f(float x) { return x / (1.0f + expf(-x)); }
HD float sigmoid_f(float x) { return 1.0f / (1.0f + expf(-x)); }
#if defined(__HIP_DEVICE_COMPILE__)
HD float softplus_f(float x) { return x > 20.0f ? x : __logf(1.0f + __expf(x)); }
#else
HD float softplus_f(float x) { return x > 20.0f ? x : log1pf(expf(x)); }
#endif

struct Ptrs {
    const float *x, *c, *ctx, *c_ctx, *w_ada, *b_ada, *g_pre1, *w_in, *gdn_conv_w, *gdn_a_log, *gdn_dt_bias, *gdn_norm, *ssm_conv_w, *ssm_conv_b, *ssm_a_log,
        *ssm_dt_bias, *ssm_d, *ssm_norm, *attn_sink, *w_br_a, *w_br_b, *w_br_c, *w_out, *g_post1, *g_pre2, *w_up, *ffn_conv_w, *ffn_conv_b, *w_down, *g_post2;
    float* out;
    bf16 *Wt_in, *Wt_br, *Wt_out, *Wt_up, *Wt_down;
    float* ROPE;
    float* MOD;
    float* X;
    bf16* H;
    bf16* P;
    float* PF;
    float *GQKV, *GG, *GB;
    float *SXBC, *SDT, *SA;
    float *AQ, *AK;
    bf16 *GW, *GQd, *GKdT, *GA, *GUT; float* GGL;
    bf16 *SBCb, *SSC, *SEAb, *SCF; float *SEA, *SDC;
    bf16 *MIXb, *OGb, *OSb, *OSb2, *GQKVb, *SXb;
    bf16 *AQb, *AKb;
    float *OG, *OS;
    float* SC;
    bf16 *YA, *YB, *YC;
    float* M32;
    bf16* MB;
    float* MIX;
    bf16* UG;
    bf16* ACT;
    bf16* TB;
    float* SLAB;
    float* BP; bf16 *BU, *BG;
};
constexpr int SC_LD = 2 * WINDOW + 1 + CTX_LEN + 3;

HD void row_info(int r, int& b, int& t, int& len, bool& is_ctx) {
    if (r < NLAT) { b = r / SEQ; t = r % SEQ; len = SEQ; is_ctx = false; } else { const int q = r - NLAT; b = q / CTX_LEN; t = q % CTX_LEN; len = CTX_LEN; is_ctx = true; }
}
HD int mod_row(int r) { return r < NLAT ? r / SEQ : BATCH; }

HD int inproj_src_col(int np) {
    if (np < C_Z) return np;
    if (np < NP_MAIN) return np + 4 * GDN_H + (np >= C_AQ ? 2 * SSM_H : 0);
    const int j = np - NP_MAIN;
    if (j < PF_DT) return R_A + j;
    if (j < PF_N) return R_DT + (j - PF_DT);
    return -1;
}
HD void wcvt_item(const float* W, int K, int N, bf16* Wt, int np, int k8, bool inproj) {
    const int n = inproj ? inproj_src_col(np) : np;
    for (int j = 0; j < 8; ++j) { const int k = k8 * 8 + j; Wt[(size_t)np * K + k] = (n < 0) ? (bf16)0 : f2bf(W[(size_t)k * N + n]); }
}

HD void mod_item(const Ptrs& p, int l, int n) {
    float acc[BATCH + 1];
    for (int m = 0; m <= BATCH; ++m) acc[m] = 0.f;
    for (int k = 0; k < D_MODEL; ++k) {
        const float w = p.w_ada[((size_t)l * D_MODEL + k) * D6 + n];
        for (int m = 0; m < BATCH; ++m) acc[m] += silu_f(p.c[m * D_MODEL + k]) * w;
        acc[BATCH] += silu_f(p.c_ctx[k]) * w;
    }
    for (int m = 0; m <= BATCH; ++m) p.MOD[((size_t)l * (BATCH + 1) + m) * D6 + n] = acc[m] + p.b_ada[(size_t)l * D6 + n];
}
HD void xinit_item(const Ptrs& p, size_t i) { p.X[i] = i < (size_t)NLAT * D_MODEL ? p.x[i] : p.ctx[i - (size_t)NLAT * D_MODEL]; }

HD float row_rstd(const float* v, int n) { float s = 0.f; for (int j = 0; j < n; ++j) s += v[j] * v[j]; return 1.0f / sqrtf(s / (float)n + EPS); }
HD void norm_to_h_row(const Ptrs& p, int l, int r, int which) {
    const float* xr = p.X + (size_t)r * D_MODEL; const float* g = (which ? p.g_pre2 : p.g_pre1) + (size_t)l * D_MODEL;
    const float* mod = p.MOD + ((size_t)l * (BATCH + 1) + mod_row(r)) * D6 + (which ? 3 * D_MODEL : 0);
    const float rs = row_rstd(xr, D_MODEL);
    for (int j = 0; j < D_MODEL; ++j) p.H[(size_t)r * D_MODEL + j] = f2bf(xr[j] * rs * g[j] * (1.0f + mod[D_MODEL + j]) + mod[j]);
}
HD void resid_row(const Ptrs& p, int l, int r, int which, bool to_out) {
    const float* yr = p.MIX + (size_t)r * D_MODEL; const float* g = (which ? p.g_post2 : p.g_post1) + (size_t)l * D_MODEL;
    const float* gate = p.MOD + ((size_t)l * (BATCH + 1) + mod_row(r)) * D6 + (which ? 5 * D_MODEL : 2 * D_MODEL);
    const float rs = row_rstd(yr, D_MODEL);
    float* xr = p.X + (size_t)r * D_MODEL;
    for (int j = 0; j < D_MODEL; ++j) { const float v = xr[j] + gate[j] * (yr[j] * rs * g[j]); xr[j] = v; if (to_out && r < NLAT) p.out[(size_t)r * D_MODEL + j] = v; }
}

HD float conv3_p(const Ptrs& p, int r, int col, const float* w, int wld, int j) {
    int b, t, len; bool ic; row_info(r, b, t, len, ic);
    float y = w[wld + j] * bf2f(p.P[(size_t)r * NP_MAIN + col]);
    if (t > 0) y += w[j] * bf2f(p.P[(size_t)(r - 1) * NP_MAIN + col]);
    if (t < len - 1) y += w[2 * wld + j] * bf2f(p.P[(size_t)(r + 1) * NP_MAIN + col]);
    return y;
}
HD void prep_gdn_item(const Ptrs& p, int l, int r, int grp) {
    const float* w = p.gdn_conv_w + (size_t)l * 3 * (3 * MIX_W);
    float sc = 1.0f;
    if (grp < 2 * GDN_H) {
        float ss = 0.f;
        for (int d = 0; d < 128; ++d) { const int j = grp * 128 + d; const float v = silu_f(conv3_p(p, r, C_QKV + j, w, 3 * MIX_W, j)); ss += v * v; }
        sc = 1.0f / sqrtf(ss + EPS); if (grp < GDN_H) sc *= 0.08838834764831845f;
    }
    for (int d = 0; d < 128; ++d) { const int j = grp * 128 + d; p.GQKV[(size_t)r * (3 * MIX_W) + j] = silu_f(conv3_p(p, r, C_QKV + j, w, 3 * MIX_W, j)) * sc; }
}
HD void prep_gdn_gb_item(const Ptrs& p, int l, int r, int j) {
    const float a = p.PF[(size_t)r * PF_N + PF_A + j], bb = p.PF[(size_t)r * PF_N + PF_B + j];
    p.GG[(size_t)r * 2 * GDN_H + j] = -expf(p.gdn_a_log[(size_t)l * 2 * GDN_H + j]) * softplus_f(a + p.gdn_dt_bias[(size_t)l * 2 * GDN_H + j]);
    p.GB[(size_t)r * 2 * GDN_H + j] = sigmoid_f(bb);
}
HD void prep_ssd_item(const Ptrs& p, int l, int r, int j) {
    const float* w = p.ssm_conv_w + (size_t)l * 3 * SSM_XBC;
    p.SXBC[(size_t)r * SSM_XBC + j] = silu_f(conv3_p(p, r, C_XBC + j, w, SSM_XBC, j) + p.ssm_conv_b[(size_t)l * SSM_XBC + j]);
}
HD void prep_ssd_dt_item(const Ptrs& p, int l, int r, int j) {
    const float dt = softplus_f(p.PF[(size_t)r * PF_N + PF_DT + j] + p.ssm_dt_bias[(size_t)l * 2 * SSM_H + j]);
    p.SDT[(size_t)r * 2 * SSM_H + j] = dt; p.SA[(size_t)r * 2 * SSM_H + j] = -expf(p.ssm_a_log[(size_t)l * 2 * SSM_H + j]) * dt;
}
HD float rope_inv_freq(int i) { return exp2f(-(float)i * 0.4152410118609203f); }
HD void prep_attn_item(const Ptrs& p, int r, int hh) {
    int b, t, len; bool ic; row_info(r, b, t, len, ic);
    const bool isq = hh < ATT_HQ; const int h = isq ? hh : hh - ATT_HQ;
    const bf16* src = p.P + (size_t)r * NP_MAIN + (isq ? C_AQ + h * 128 : C_AKV + h * 128);
    float* dst = isq ? p.AQ + (size_t)r * MIX_W + h * 128 : p.AK + (size_t)r * (ATT_HKV * 128) + h * 128;
    if (ic) { for (int d = 0; d < 128; ++d) dst[d] = bf2f(src[d]); return; }
    const float pos[2] = {(float)(t / GRID_W), (float)(t % GRID_W)};
    for (int ax = 0; ax < 2; ++ax)
        for (int i = 0; i < 32; ++i) {
            const float ang = pos[ax] * rope_inv_freq(i), cs = cosf(ang), sn = sinf(ang);
            const float x1 = bf2f(src[ax * 64 + i]), x2 = bf2f(src[ax * 64 + 32 + i]);
            dst[ax * 64 + i] = x1 * cs - x2 * sn; dst[ax * 64 + 32 + i] = x2 * cs + x1 * sn;
        }
}

HD int chain_row(int b, int dir, int s) {
    if (s < CTX_LEN) return NLAT + b * CTX_LEN + (dir ? CTX_LEN - 1 - s : s);
    const int u = s - CTX_LEN; return b * SEQ + (dir ? SEQ - 1 - u : u);
}
HD void gdn_chain_item(const Ptrs& p, int b, int h, int dir, int vc) {
    float S[128];
#pragma unroll
    for (int k = 0; k < 128; ++k) S[k] = 0.f;
    float pf = 0.f;
    for (int s = 0; s < CHAIN_LEN; ++s) {
        const int r = chain_row(b, dir, s);
        const float* q = p.GQKV + (size_t)r * (3 * MIX_W) + h * 128; const float* kk = q + MIX_W; const float vv = q[2 * MIX_W + vc];
        const float a = expf(p.GG[(size_t)r * 2 * GDN_H + dir * GDN_H + h]), be = p.GB[(size_t)r * 2 * GDN_H + dir * GDN_H + h];
        if (s + 1 < CHAIN_LEN) { const float* qn = p.GQKV + (size_t)chain_row(b, dir, s + 1) * (3 * MIX_W) + h * 128;
#pragma unroll
            for (int j = 0; j < 4; ++j) pf += qn[32 * j] + qn[MIX_W + 32 * j]; }
        float ks = 0.f;
#pragma unroll
        for (int c = 0; c < 2; ++c) { float kc[64];
#pragma unroll
            for (int j = 0; j < 64; ++j) kc[j] = kk[64 * c + j];
#pragma unroll
            for (int j = 0; j < 64; ++j) { S[64 * c + j] *= a; ks += kc[j] * S[64 * c + j]; }
            CFENCE(); }
        const float dl = be * (vv - ks); float o = 0.f;
#pragma unroll
        for (int c = 0; c < 4; ++c) { float kc[32], qc[32];
#pragma unroll
            for (int j = 0; j < 32; ++j) { kc[j] = kk[32 * c + j]; qc[j] = q[32 * c + j]; }
#pragma unroll
            for (int j = 0; j < 32; ++j) { S[32 * c + j] += kc[j] * dl; o += qc[j] * S[32 * c + j]; }
            CFENCE(); }
        p.OG[((size_t)dir * MROWS + r) * MIX_W + h * 128 + vc] = o;
    }
    if (pf == 123456.789f) p.OG[0] = pf;
}
HD void ssd_chain_item(const Ptrs& p, int b, int hd, int dir, int pc) {
    float hs[SSM_N];
#pragma unroll
    for (int s = 0; s < SSM_N; ++s) hs[s] = 0.f;
    const int g = hd / SSM_HPG;
    float pf = 0.f;
    for (int s = 0; s < CHAIN_LEN; ++s) {
        const int r = chain_row(b, dir, s);
        const float* xb = p.SXBC + (size_t)r * SSM_XBC; const float* Bm = xb + MIX_W + g * SSM_N; const float* Cm = xb + MIX_W + SSM_BC + g * SSM_N;
        const float dt = p.SDT[(size_t)r * 2 * SSM_H + dir * SSM_H + hd], ea = expf(p.SA[(size_t)r * 2 * SSM_H + dir * SSM_H + hd]);
        const float xd = xb[hd * SSM_P + pc] * dt; float y = 0.f;
        if (s + 1 < CHAIN_LEN) { const float* xn = p.SXBC + (size_t)chain_row(b, dir, s + 1) * SSM_XBC + MIX_W + g * SSM_N;
#pragma unroll
            for (int j = 0; j < 4; ++j) pf += xn[32 * j] + xn[SSM_BC + 32 * j]; }
#pragma unroll
        for (int c = 0; c < 4; ++c) { float bc[32], cc[32];
#pragma unroll
            for (int j = 0; j < 32; ++j) { bc[j] = Bm[32 * c + j]; cc[j] = Cm[32 * c + j]; }
#pragma unroll
            for (int j = 0; j < 32; ++j) { hs[32 * c + j] = ea * hs[32 * c + j] + xd * bc[j]; y += cc[j] * hs[32 * c + j]; }
            CFENCE(); }
        p.OS[((size_t)dir * MROWS + r) * MIX_W + hd * SSM_P + pc] = y;
    }
    if (pf == 123456.789f) p.OS[0] = pf;
}
HD void attn_item(const Ptrs& p, int l, int r, int hq) {
    int b, t, len; bool ic; row_info(r, b, t, len, ic);
    const int hkv = hq / ATT_GRP;
    const float* qp = p.AQ + (size_t)r * MIX_W + hq * 128;
    float* sc = p.SC + ((size_t)r * ATT_HQ + hq) * SC_LD;
    const float sink = p.attn_sink[(size_t)l * ATT_HQ + hq];
    const int lo = ic ? 0 : (t - WINDOW < 0 ? 0 : t - WINDOW), hi = ic ? -1 : (t + WINDOW > SEQ - 1 ? SEQ - 1 : t + WINDOW);
    const int nloc = ic ? 0 : hi - lo + 1, nk = nloc + CTX_LEN;
    float m = sink;
    {
        float q[128];
#pragma unroll
        for (int d = 0; d < 128; ++d) q[d] = qp[d];
        for (int j = 0; j < nk; ++j) {
            const int kr = j < nloc ? b * SEQ + lo + j : NLAT + b * CTX_LEN + (j - nloc);
            const float* kk = p.AK + (size_t)kr * (ATT_HKV * 128) + hkv * 128;
            float s = 0.f;
#pragma unroll
            for (int c = 0; c < 4; ++c) { float kc[32];
#pragma unroll
                for (int d = 0; d < 32; ++d) kc[d] = kk[32 * c + d];
#pragma unroll
                for (int d = 0; d < 32; ++d) s += q[32 * c + d] * kc[d];
                CFENCE(); }
            s *= 0.08838834764831845f; sc[j] = s; m = s > m ? s : m;
        }
    }
    float o[128];
#pragma unroll
    for (int d = 0; d < 128; ++d) o[d] = 0.f;
    float den = expf(sink - m);
    for (int j = 0; j < nk; ++j) {
        const int kr = j < nloc ? b * SEQ + lo + j : NLAT + b * CTX_LEN + (j - nloc);
        const bf16* vv = p.P + (size_t)kr * NP_MAIN + C_AKV + ATT_HKV * 128 + hkv * 128;
        const float e = expf(sc[j] - m); den += e;
#pragma unroll
        for (int c = 0; c < 4; ++c) { float vc[32];
#pragma unroll
            for (int d = 0; d < 32; ++d) vc[d] = bf2f(vv[32 * c + d]);
#pragma unroll
            for (int d = 0; d < 32; ++d) o[32 * c + d] += e * vc[d];
            CFENCE(); }
    }
    const float inv = 1.0f / den;
#pragma unroll
    for (int d = 0; d < 128; ++d) p.YC[(size_t)r * MIX_W + hq * 128 + d] = f2bf(o[d] * inv);
}
HD void gdn_out_item(const Ptrs& p, int l, int r, int h) {
    float ss = 0.f;
    for (int d = 0; d < 128; ++d) { const size_t i = (size_t)r * MIX_W + h * 128 + d; const float v = p.OG[i] + p.OG[(size_t)MROWS * MIX_W + i]; ss += v * v; }
    const float rs = 1.0f / sqrtf(ss / 128.0f + EPS);
    for (int d = 0; d < 128; ++d) { const size_t i = (size_t)r * MIX_W + h * 128 + d; const float v = p.OG[i] + p.OG[(size_t)MROWS * MIX_W + i];
        p.YA[i] = f2bf(v * rs * p.gdn_norm[(size_t)l * 128 + d] * silu_f(bf2f(p.P[(size_t)r * NP_MAIN + C_GATE + h * 128 + d]))); }
}
HD void ssd_out_item(const Ptrs& p, int l, int r, int g) {
    constexpr int GW = MIX_W / SSM_G;
    float ss = 0.f;
    for (int pass = 0; pass < 2; ++pass) {
        const float rs = pass ? 1.0f / sqrtf(ss / (float)GW + EPS) : 0.f;
        for (int jj = 0; jj < GW; ++jj) { const int j = g * GW + jj; const size_t i = (size_t)r * MIX_W + j;
            float y = p.OS[i] + p.OS[(size_t)MROWS * MIX_W + i] + p.ssm_d[(size_t)l * SSM_H + j / SSM_P] * p.SXBC[(size_t)r * SSM_XBC + j];
            y *= silu_f(bf2f(p.P[(size_t)r * NP_MAIN + C_Z + j]));
            if (!pass) ss += y * y; else p.YB[i] = f2bf(y * rs * p.ssm_norm[(size_t)l * MIX_W + j]); }
    }
}
HD void act_item(const Ptrs& p, int l, int r, int j) {
    int b, t, len; bool ic; row_info(r, b, t, len, ic);
    const float* w = p.ffn_conv_w + (size_t)l * 3 * D_FF;
    const bf16* ug = p.UG + (size_t)r * (2 * D_FF);
    float g = w[D_FF + j] * bf2f(ug[D_FF + j]);
    if (t > 0) g += w[j] * bf2f(ug[D_FF + j - 2 * D_FF]);
    if (t < len - 1) g += w[2 * D_FF + j] * bf2f(ug[D_FF + j + 2 * D_FF]);
    g += p.ffn_conv_b[(size_t)l * D_FF + j];
    p.ACT[(size_t)r * D_FF + j] = f2bf(silu_f(g) * bf2f(ug[j]));
}

namespace pg8 {
#define PG8_LAS __attribute__((address_space(3)))
typedef unsigned short bf16_t;
typedef short bf16x8 __attribute__((ext_vector_type(8)));
typedef float f32x4 __attribute__((ext_vector_type(4)));
typedef unsigned u32x4 __attribute__((ext_vector_type(4)));
constexpr int BM = 256, BK = 64, HALF = 128, HTB = HALF * BK * 2  , STAGE_BYTES = 8 * HTB, NXCD = 8, WGM = 8;

__host__ __device__ __forceinline__ int lds_byte(int r, int c) { const int st = (r >> 4) * 2 + (c >> 5), rr = r & 15, cc = c & 31, ob = rr * 64 + cc * 2; return st * 1024 + (ob ^ (((ob >> 9) & 1) << 5)); }
__host__ __device__ __forceinline__ void stage_rc(int b, int& R, int& C) { const int st = b / 1024, sb = b % 1024, swz = sb ^ (((sb >> 9) & 1) << 5); R = (st >> 1) * 16 + swz / 64; C = (st & 1) * 32 + (swz % 64) / 2; }
__host__ __device__ __forceinline__ int perm32(int rho) { const int n = rho >> 4, i = rho & 15; return 8 * (i >> 2) + 4 * n + (i & 3); }

struct Unit { int pm, pn, pk; };
struct Gemm { const bf16_t* A; const bf16_t* Bt; int M, N, K, ld; };

struct StaticOrder {
    int nM, nN, nwg, G, c;
    __host__ __device__ void init(int M, int N, int G_, int c_) { nM = M / BM; nN = N / BM; nwg = nM * nN; G = G_; c = c_; }
    __host__ __device__ bool next(int i, Unit& u) const {
        const long L = (long)i * G + c; if (L >= nwg) return false;
        int wgid = (int)L; { const int q = nwg / NXCD, r = nwg % NXCD, xcd = wgid % NXCD, off = wgid / NXCD; wgid = (xcd < r ? xcd * (q + 1) : r * (q + 1) + (xcd - r) * q) + off; }
        const int nig = WGM * nN, gid = wgid / nig, fm = gid * WGM, gsz = (nM - fm) < WGM ? (nM - fm) : WGM;
        u.pm = fm + ((wgid % nig) % gsz); u.pn = (wgid % nig) / gsz; u.pk = 0; return true;
    }
    __device__ __forceinline__ void a_ready(const Unit&) const {}
    __device__ __forceinline__ void done(const Unit&) const {}
};

__device__ __forceinline__ unsigned cvt_pk_bf16(float lo, float hi) { unsigned r; asm volatile("v_cvt_pk_bf16_f32 %0, %1, %2" : "=v"(r) : "v"(lo), "v"(hi)); return r; }

template <class Epi, class Sched, bool ALIGN_EPI = false, bool SP2 = false>
__device__ __forceinline__ void gemm_phase(PG8_LAS unsigned char* lds, const Gemm g, const Sched& S, const Epi& E, int tid_in) {
    int tid_l = tid_in; asm volatile("" : "+v"(tid_l));
    const int tid = tid_l, wid = __builtin_amdgcn_readfirstlane(tid >> 6), lane = tid & 63, wr = wid >> 2, wc = wid & 3, fr = lane & 15, fq = lane >> 4;
    const int K = g.K, nt = K / BK, LD = g.ld;
    unsigned voffA[2], voffB[2];
#pragma unroll
    for (int i = 0; i < 2; ++i) { int R, C; stage_rc(tid * 16 + i * 8192, R, C); const int Rb = Epi::PERM ? ((R & ~31) + perm32(R & 31)) : R;
        voffA[i] = (unsigned)(R * LD + C) * 2u; voffB[i] = (unsigned)(Rb * LD + C) * 2u; }
    const size_t kstep = (size_t)(BK * 2);
    const size_t hstep = (size_t)HALF * LD * 2;
    const size_t tstep = 2 * hstep;
    const unsigned ldsw = (unsigned)wid * 1024u;
    const int aoff = lds_byte(wr * 64 + fr, fq * 8), boff = lds_byte(wc * 32 + fr, fq * 8);
#define PG8_SA(b, h) (((b) * 2 + (h)) * HTB)
#define PG8_SB(b, h) ((4 + (b) * 2 + (h)) * HTB)
#define PG8_STAGE(bufoff, gbase, voff) do { _Pragma("unroll") for (int _i = 0; _i < 2; ++_i) \
        __builtin_amdgcn_global_load_lds((const unsigned*)((const char*)(gbase) + (voff)[_i]), (PG8_LAS unsigned*)(lds + (bufoff) + ldsw + _i * 8192), 16, 0, 0); } while (0)
#define PG8_LDA(dst, b, h) do { _Pragma("unroll") for (int m = 0; m < 4; ++m) _Pragma("unroll") for (int k = 0; k < 2; ++k) dst[m][k] = *(const PG8_LAS bf16x8*)(lds + PG8_SA(b, h) + aoff + m * 2048 + k * 1024); } while (0)
#define PG8_LDB(dst, b, h) do { _Pragma("unroll") for (int n = 0; n < 2; ++n) _Pragma("unroll") for (int k = 0; k < 2; ++k) dst[n][k] = *(const PG8_LAS bf16x8*)(lds + PG8_SB(b, h) + boff + n * 2048 + k * 1024); } while (0)
#define PG8_MMA(ai, bj, At, Bt) do { __builtin_amdgcn_s_setprio(1); _Pragma("unroll") for (int m = 0; m < 4; ++m) _Pragma("unroll") for (int n = 0; n < 2; ++n) _Pragma("unroll") for (int k = 0; k < 2; ++k) \
        acc[ai][bj][m][n] = __builtin_amdgcn_mfma_f32_16x16x32_bf16(Bt[n][k], At[m][k], acc[ai][bj][m][n], 0, 0, 0); __builtin_amdgcn_s_setprio(0); } while (0)
#define PG8_WAIT_V(n) asm volatile("s_waitcnt vmcnt(" #n ")" ::: "memory")
#define PG8_WAIT_L(n) asm volatile("s_waitcnt lgkmcnt(" #n ")" ::: "memory")
#define PG8_BAR __builtin_amdgcn_s_barrier()
#define PG8_SCHED __builtin_amdgcn_sched_barrier(0)
    Unit cur, nxt; int ui = 0;
    if (!S.next(0, cur)) return;
    f32x4 acc[2][2][4][2];
#pragma unroll
    for (int a = 0; a < 2; ++a)
#pragma unroll
        for (int b = 0; b < 2; ++b)
#pragma unroll
            for (int m = 0; m < 4; ++m)
#pragma unroll
                for (int n = 0; n < 2; ++n) acc[a][b][m][n] = (f32x4){0.f, 0.f, 0.f, 0.f};
    bf16x8 At[4][2], B0[2][2], B1[2][2];
    const char* cA = (const char*)g.A + (size_t)cur.pm * tstep + (size_t)cur.pk * 2; const char* cB = (const char*)g.Bt + (size_t)cur.pn * tstep + (size_t)cur.pk * 2;
    S.a_ready(cur);
    if constexpr (SP2) {
        PG8_STAGE(PG8_SB(0, 0), cB, voffB); PG8_STAGE(PG8_SB(0, 1), cB + hstep, voffB); PG8_STAGE(PG8_SA(0, 0), cA, voffA); PG8_STAGE(PG8_SA(0, 1), cA + hstep, voffA);
        if (wr == 1) PG8_BAR;
        PG8_WAIT_V(2); PG8_BAR;
        PG8_STAGE(PG8_SB(1, 0), cB + kstep, voffB); PG8_STAGE(PG8_SA(1, 0), cA + kstep, voffA); PG8_STAGE(PG8_SB(1, 1), cB + hstep + kstep, voffB);
        PG8_WAIT_V(6); PG8_BAR;
    } else {
        PG8_STAGE(PG8_SB(0, 0), cB, voffB); PG8_STAGE(PG8_SA(0, 0), cA, voffA); PG8_STAGE(PG8_SB(0, 1), cB + hstep, voffB); PG8_STAGE(PG8_SA(0, 1), cA + hstep, voffA);
        if (wr == 1) PG8_BAR;
        PG8_WAIT_V(4); PG8_BAR;
        PG8_STAGE(PG8_SB(1, 0), cB + kstep, voffB); PG8_STAGE(PG8_SA(1, 0), cA + kstep, voffA); PG8_STAGE(PG8_SB(1, 1), cB + hstep + kstep, voffB);
        PG8_WAIT_V(6); PG8_BAR;
    }
    for (;;) {
        const bool has_next = S.next(ui + 1, nxt);
        const char* nA = has_next ? (const char*)g.A + (size_t)nxt.pm * tstep + (size_t)nxt.pk * 2 : cA; const char* nB = has_next ? (const char*)g.Bt + (size_t)nxt.pn * tstep + (size_t)nxt.pk * 2 : cB;
        for (int t = 0; t < nt; t += 2) {
            const bool last = (t == nt - 2);
            const char* a1 = cA + (size_t)(t + 1) * kstep;
            const char* a2 = last ? nA : cA + (size_t)(t + 2) * kstep; const char* b2 = last ? nB : cB + (size_t)(t + 2) * kstep;
            const char* a3 = a2 + kstep; const char* b3 = b2 + kstep;
            if (last && has_next) S.a_ready(nxt);
            if constexpr (Epi::KHOOK) E.khook(acc, cur, t, wr, wc, fr, fq);
            if constexpr (SP2) {
            PG8_LDB(B0, 0, 0); PG8_LDB(B1, 0, 1); PG8_SCHED; PG8_LDA(At, 0, 0); PG8_STAGE(PG8_SA(1, 1), a1 + hstep, voffA);
            PG8_WAIT_V(8); PG8_WAIT_L(0); PG8_BAR; PG8_MMA(0, 0, At, B0); PG8_MMA(0, 1, At, B1); PG8_BAR; PG8_SCHED;
            PG8_LDA(At, 0, 1); PG8_STAGE(PG8_SB(0, 0), b2, voffB); PG8_STAGE(PG8_SB(0, 1), b2 + hstep, voffB); PG8_STAGE(PG8_SA(0, 0), a2, voffA);
            PG8_WAIT_V(8); PG8_WAIT_L(0); PG8_BAR; PG8_MMA(1, 0, At, B0); PG8_MMA(1, 1, At, B1); PG8_BAR; PG8_SCHED;
            PG8_LDB(B0, 1, 0); PG8_LDB(B1, 1, 1); PG8_SCHED; PG8_LDA(At, 1, 0); PG8_STAGE(PG8_SA(0, 1), a2 + hstep, voffA);
            PG8_WAIT_V(8); PG8_WAIT_L(0); PG8_BAR; PG8_MMA(0, 0, At, B0); PG8_MMA(0, 1, At, B1); PG8_BAR; PG8_SCHED;
            PG8_LDA(At, 1, 1); PG8_STAGE(PG8_SB(1, 0), b3, voffB); PG8_STAGE(PG8_SB(1, 1), b3 + hstep, voffB); PG8_STAGE(PG8_SA(1, 0), a3, voffA);
            PG8_WAIT_V(8); PG8_WAIT_L(0); PG8_BAR; PG8_MMA(1, 0, At, B0); PG8_MMA(1, 1, At, B1); PG8_BAR; PG8_SCHED;
            } else {
            PG8_LDB(B0, 0, 0); PG8_SCHED; PG8_LDA(At, 0, 0); PG8_STAGE(PG8_SA(1, 1), a1 + hstep, voffA);
            PG8_WAIT_L(8); PG8_BAR; PG8_WAIT_L(0); PG8_MMA(0, 0, At, B0); PG8_BAR; PG8_SCHED;
            PG8_LDB(B1, 0, 1); PG8_STAGE(PG8_SB(0, 0), b2, voffB);
            PG8_BAR; PG8_WAIT_L(0); PG8_MMA(0, 1, At, B1); PG8_BAR;
            PG8_LDA(At, 0, 1); PG8_STAGE(PG8_SA(0, 0), a2, voffA);
            PG8_BAR; PG8_WAIT_L(0); PG8_MMA(1, 0, At, B0); PG8_BAR; PG8_SCHED;
            PG8_STAGE(PG8_SB(0, 1), b2 + hstep, voffB);
            PG8_WAIT_V(6); PG8_BAR; PG8_MMA(1, 1, At, B1); PG8_BAR;
            PG8_LDB(B0, 1, 0); PG8_SCHED; PG8_LDA(At, 1, 0); PG8_STAGE(PG8_SA(0, 1), a2 + hstep, voffA);
            PG8_WAIT_L(8); PG8_BAR; PG8_WAIT_L(0); PG8_MMA(0, 0, At, B0); PG8_BAR; PG8_SCHED;
            PG8_LDB(B1, 1, 1); PG8_STAGE(PG8_SB(1, 0), b3, voffB);
            PG8_BAR; PG8_WAIT_L(0); PG8_MMA(0, 1, At, B1); PG8_BAR;
            PG8_LDA(At, 1, 1); PG8_STAGE(PG8_SA(1, 0), a3, voffA);
            PG8_BAR; PG8_WAIT_L(0); PG8_MMA(1, 0, At, B0); PG8_BAR; PG8_SCHED;
            PG8_STAGE(PG8_SB(1, 1), b3 + hstep, voffB);
            PG8_WAIT_V(6); PG8_BAR; PG8_MMA(1, 1, At, B1); PG8_BAR;
            }
        }
        if constexpr (ALIGN_EPI) { if (wr == 0) PG8_BAR; }
        if constexpr (!Epi::AFTER_DRAIN) { E(acc, cur, wr, wc, fr, fq); S.done(cur); }
        if (!has_next) break;
#pragma unroll
        for (int a = 0; a < 2; ++a)
#pragma unroll
            for (int b = 0; b < 2; ++b)
#pragma unroll
                for (int m = 0; m < 4; ++m)
#pragma unroll
                    for (int n = 0; n < 2; ++n) acc[a][b][m][n] = (f32x4){0.f, 0.f, 0.f, 0.f};
        cur = nxt; cA = nA; cB = nB; ++ui;
        if constexpr (ALIGN_EPI) { if (wr == 1) PG8_BAR; }
    }
    PG8_WAIT_V(0);
    if constexpr (!ALIGN_EPI) { if (wr == 0) PG8_BAR; }
    PG8_BAR;
    if constexpr (Epi::AFTER_DRAIN) { E.fused(acc, cur, wr, wc, fr, fq, lds, wid, lane); S.done(cur); }
#undef PG8_SA
#undef PG8_SB
#undef PG8_STAGE
#undef PG8_LDA
#undef PG8_LDB
#undef PG8_MMA
#undef PG8_WAIT_V
#undef PG8_WAIT_L
#undef PG8_BAR
#undef PG8_SCHED
}
}
#define GAS __attribute__((address_space(1)))
#define LAS __attribute__((address_space(3)))
typedef GAS unsigned gu32;
typedef GAS unsigned long long gu64;
#define RLX_AGENT __ATOMIC_RELAXED, __HIP_MEMORY_SCOPE_AGENT
#define XB_TMO      128
#define XB_XCNT(j)  (256  + 64 * (j))
#define XB_XSUB(j)  (1280 + 64 * (j))
#define XB_XGEN(j)  (2304 + 64 * (j))
#define XB_TOP      3328
#define XB_TOPGEN   3392
#define XCD_BAR_WORDS 3456
#define XB_SPIN_CAP (1u << 18)

__device__ __forceinline__ unsigned xb_ld(unsigned* p)              { return __hip_atomic_load(p, __ATOMIC_RELAXED, __HIP_MEMORY_SCOPE_AGENT); }
__device__ __forceinline__ unsigned xb_add(unsigned* p, unsigned v) { return __hip_atomic_fetch_add(p, v, __ATOMIC_RELAXED, __HIP_MEMORY_SCOPE_AGENT); }
__device__ __forceinline__ unsigned xb_xcc_id() { return (unsigned)__builtin_amdgcn_s_getreg((3 << 11) | 20) & 0xFu; }
#define XB_SPIN(cond, bar) do { unsigned _sp = 0; while (cond) { __builtin_amdgcn_s_sleep(1); \
    if ((++_sp & 255u) == 0u) { if (xb_ld(&(bar)[XB_TMO])) break; if (_sp > XB_SPIN_CAP) { atomicAdd(&(bar)[XB_TMO], 1u); break; } } } } while (0)

struct XcdBarrier {
    unsigned* bar; unsigned x;
    volatile LAS unsigned* st;
};

__device__ __forceinline__ XcdBarrier xcd_barrier_post(unsigned* bar, volatile LAS unsigned* st) {
    XcdBarrier b; b.bar = bar; b.x = xb_xcc_id(); b.st = st;
    if (threadIdx.x == 0) (void)xb_add(&bar[XB_XCNT(b.x)], 1u);
    return b;
}
__device__ __forceinline__ void xcd_barrier_complete(unsigned* bar, unsigned x, unsigned& nloc, unsigned& nx) {
    const unsigned G = gridDim.x * gridDim.y * gridDim.z;
    unsigned sum, cnt, mine, sp = 0u;
    for (;;) {
        sum = 0u; cnt = 0u; mine = 0u;
#pragma unroll
        for (unsigned j = 0; j < 16; ++j) { const unsigned c = xb_ld(&bar[XB_XCNT(j)]); sum += c; cnt += (c > 0u) ? 1u : 0u; mine = (j == x) ? c : mine; }
        if (sum == G) break;
        __builtin_amdgcn_s_sleep(1);
        if ((++sp & 255u) == 0u) { if (xb_ld(&bar[XB_TMO])) break; if (sp > XB_SPIN_CAP) { atomicAdd(&bar[XB_TMO], 1u); break; } }
    }
    nloc = mine > 0u ? mine : 1u; nx = cnt > 0u ? cnt : 1u;
}

__device__ __forceinline__ void xcd_barrier(const XcdBarrier& b) {
    asm volatile("s_waitcnt vmcnt(0)" ::: "memory");
    __syncthreads();
    if (threadIdx.x == 0) {
        unsigned* bar = b.bar;
        __builtin_amdgcn_s_waitcnt(0);
        unsigned nloc = b.st[0], nx = b.st[1];
        if (nloc == 0u) { xcd_barrier_complete(bar, b.x, nloc, nx); b.st[0] = nloc; b.st[1] = nx; }
        const unsigned old = xb_add(&bar[XB_XSUB(b.x)], 1u);
        const unsigned gen = old / nloc;
        if (old + 1u == (gen + 1u) * nloc) {
            __builtin_amdgcn_fence(__ATOMIC_RELEASE, "agent");
            asm volatile("s_waitcnt vmcnt(0)" ::: "memory");
            const unsigned og = xb_add(&bar[XB_TOP], 1u);
            const unsigned tg = og / nx;
            if (og + 1u == (tg + 1u) * nx) xb_add(&bar[XB_TOPGEN], 1u);
            else XB_SPIN(xb_ld(&bar[XB_TOPGEN]) == tg, bar);
            __builtin_amdgcn_fence(__ATOMIC_ACQUIRE, "agent");
            xb_add(&bar[XB_XGEN(b.x)], 1u);
            asm volatile("s_waitcnt vmcnt(0)" ::: "memory");
        } else {
            XB_SPIN(xb_ld(&bar[XB_XGEN(b.x)]) == gen, bar);
            __builtin_amdgcn_fence(__ATOMIC_ACQUIRE, "agent");
            asm volatile("s_waitcnt vmcnt(0)" ::: "memory");
        }
    }
    __syncthreads();
}

#define LDS_BARRIER() do { asm volatile("s_waitcnt lgkmcnt(0)" ::: "memory"); __builtin_amdgcn_s_barrier(); asm volatile("" ::: "memory"); } while (0)
typedef float vf4 __attribute__((ext_vector_type(4)));
typedef unsigned vu2 __attribute__((ext_vector_type(2)));
typedef unsigned vu4 __attribute__((ext_vector_type(4)));
__device__ __forceinline__ float wave_sum(float v) {
#pragma unroll
    for (int o = 1; o < 64; o <<= 1) v += __shfl_xor(v, o);
    return v;
}
template <int CTRL> __device__ __forceinline__ float dpp_f(float x) { return __builtin_bit_cast(float, __builtin_amdgcn_mov_dpp(__builtin_bit_cast(int, x), CTRL, 0xf, 0xf, true)); }
__device__ __forceinline__ float sum16(float x) { x += dpp_f<0xB1>(x); x += dpp_f<0x4E>(x); x += dpp_f<0x124>(x); x += dpp_f<0x128>(x); return x; }
__device__ __forceinline__ float sum8(float x) { x += dpp_f<0xB1>(x); x += dpp_f<0x4E>(x); x += dpp_f<0x141>(x); return x; }
__device__ __forceinline__ unsigned pk2(float lo, float hi) { return (unsigned)f2bf(lo) | ((unsigned)f2bf(hi) << 16); }

constexpr int NV4 = D_MODEL / 256;
__device__ __forceinline__ void row_load(const float* row, int lane, vf4 (&x)[NV4]) {
#pragma unroll
    for (int j = 0; j < NV4; ++j) x[j] = *(const vf4*)(row + (size_t)(j * 64 + lane) * 4);
}
__device__ __forceinline__ void row_store(float* row, int lane, const vf4 (&x)[NV4]) {
#pragma unroll
    for (int j = 0; j < NV4; ++j) *(vf4*)(row + (size_t)(j * 64 + lane) * 4) = x[j];
}
__device__ __forceinline__ float row_rs(const vf4 (&x)[NV4]) {
    float ss = 0.f;
#pragma unroll
    for (int j = 0; j < NV4; ++j) ss += (x[j].x * x[j].x + x[j].y * x[j].y) + (x[j].z * x[j].z + x[j].w * x[j].w);
    return 1.0f / sqrtf(wave_sum(ss) * (1.0f / D_MODEL) + EPS);
}
__device__ __forceinline__ void norm_h_wave(const Ptrs& p, int l, int r, int which, int lane, const vf4 (&x)[NV4]) {
    const float rs = row_rs(x);
    const float* g = (which ? p.g_pre2 : p.g_pre1) + (size_t)l * D_MODEL;
    const float* mod = p.MOD + ((size_t)l * (BATCH + 1) + mod_row(r)) * D6 + (which ? 3 * D_MODEL : 0);
#pragma unroll
    for (int j = 0; j < NV4; ++j) { const int c = (j * 64 + lane) * 4;
        const vf4 gv = *(const vf4*)(g + c), sh = *(const vf4*)(mod + c), sc = *(const vf4*)(mod + D_MODEL + c);
        const vf4 o = x[j] * rs * gv * (1.0f + sc) + sh;
        vu2 w; w.x = pk2(o.x, o.y); w.y = pk2(o.z, o.w);
        *(vu2*)(p.H + (size_t)r * D_MODEL + c) = w; }
}
__device__ __forceinline__ void resid_wave(const Ptrs& p, int l, int r, int which, int lane, vf4 (&x)[NV4], int ns) {
    vf4 y[NV4];
    if (r >= NLAT) {
#pragma unroll
        for (int j = 0; j < NV4; ++j) y[j] = (vf4){0.f, 0.f, 0.f, 0.f};
        for (int s = 0; s < ns; ++s) {
#pragma unroll
            for (int j = 0; j < NV4; ++j) y[j] += *(const vf4*)(p.SLAB + ((size_t)s * NCTX + (r - NLAT)) * D_MODEL + (size_t)(j * 64 + lane) * 4); }
    } else
#pragma unroll
    for (int j = 0; j < NV4; ++j) { const vu2 w = *(const vu2*)(p.MIXb + (size_t)r * D_MODEL + (size_t)(j * 64 + lane) * 4); y[j] = (vf4){__uint_as_float(w.x << 16), __uint_as_float(w.x & 0xffff0000u), __uint_as_float(w.y << 16), __uint_as_float(w.y & 0xffff0000u)}; }
    const float rs = row_rs(y);
    const float* g = (which ? p.g_post2 : p.g_post1) + (size_t)l * D_MODEL;
    const float* gate = p.MOD + ((size_t)l * (BATCH + 1) + mod_row(r)) * D6 + (which ? 5 * D_MODEL : 2 * D_MODEL);
#pragma unroll
    for (int j = 0; j < NV4; ++j) { const int c = (j * 64 + lane) * 4; x[j] += *(const vf4*)(gate + c) * (y[j] * rs * *(const vf4*)(g + c)); }
}

struct WtDesc { const float* W; bf16* WT; int K, N, k0, n0, drow0; };
__device__ __forceinline__ void transpose_load(const WtDesc& d, int lane, float (&wv)[32]) {
#pragma unroll
    for (int i = 0; i < 32; ++i) wv[i] = __builtin_nontemporal_load(d.W + (size_t)(d.k0 + 2 * i + (lane >> 5)) * d.N + d.n0 + (lane & 31));
}
__device__ __forceinline__ void transpose_finish(const WtDesc& d, const float (&wv)[32], LAS float* scr, int lane) {
#pragma unroll
    for (int i = 0; i < 32; ++i) scr[(2 * i + (lane >> 5)) * 33 + (lane & 31)] = wv[i];
    asm volatile("s_waitcnt lgkmcnt(0)" ::: "memory");
    const int c = lane & 7;
#pragma unroll
    for (int j = 0; j < 4; ++j) { const int n = (lane >> 3) + 8 * j; const LAS float* s = scr + (8 * c) * 33 + n;
        vu4 o; o.x = pk2(s[0 * 33], s[1 * 33]); o.y = pk2(s[2 * 33], s[3 * 33]); o.z = pk2(s[4 * 33], s[5 * 33]); o.w = pk2(s[6 * 33], s[7 * 33]);
        *(vu4*)(d.WT + (size_t)(d.drow0 + n) * d.K + d.k0 + 8 * c) = o; }
    asm volatile("s_waitcnt lgkmcnt(0)" ::: "memory");
}
__device__ __forceinline__ void transpose_item(const float* W, int K, int N, bf16* WT, int k0, int n0, int drow0, LAS float* scr, int lane) {
    const WtDesc d{W, WT, K, N, k0, n0, drow0}; float wv[32];
    transpose_load(d, lane, wv); transpose_finish(d, wv, scr, lane);
}
__device__ __forceinline__ int inproj_dst_row0(int n0) {
    if (n0 < R_A) return n0;
    if (n0 == R_A) return NP_MAIN;
    if (n0 < R_DT) return n0 - 4 * GDN_H;
    if (n0 == R_DT) return NP_MAIN + PF_DT;
    return n0 - 4 * GDN_H - 2 * SSM_H;
}
__device__ __forceinline__ int up_dst_row0(int n0) {
    const int isg = n0 >= D_FF, j = isg ? n0 - D_FF : n0; return 256 * (j >> 7) + 128 * isg + (j & 127);
}
static_assert(D_FF % 128 == 0, "up-projection tile order");
static_assert(4 * GDN_H == 32 && 2 * SSM_H == 32 && R_A % 32 == 0 && R_DT % 32 == 0, "the 32-column transpose items assume the real shapes");

constexpr int TB = 32;
constexpr int GDN_BUF = TB * 256 + TB * 32 + TB * 2;
__device__ __forceinline__ void gdn_token_wg(const Ptrs& p, LAS float* L, int chain, int slice, int tid) {
    const int b = chain / (GDN_H * 2), h = (chain >> 1) % GDN_H, dir = chain & 1;
    const int lane = tid & 63, wave = tid >> 6, ks = lane & 15, cl = wave * 4 + (lane >> 4);
    LAS float* obuf = L + 2 * GDN_BUF;
    float S[8];
#pragma unroll
    for (int e = 0; e < 8; ++e) S[e] = 0.f;
    vf4 rq[4], rv; float ra = 0.f, rb = 0.f;
    constexpr int NB = CHAIN_LEN / TB;
    auto gload = [&](int n) {
#pragma unroll
        for (int j = 0; j < 4; ++j) { const int idx = j * 512 + tid, i = idx >> 6, c4 = idx & 63; const int r = chain_row(b, dir, n * TB + i);
            rq[j] = *(const vf4*)(p.GQKV + (size_t)r * (3 * MIX_W) + h * 128 + (c4 < 32 ? c4 * 4 : MIX_W + (c4 - 32) * 4)); }
        if (tid < 256) { const int i = tid >> 3, c4 = tid & 7; const int r = chain_row(b, dir, n * TB + i);
            rv = *(const vf4*)(p.GQKV + (size_t)r * (3 * MIX_W) + 2 * MIX_W + h * 128 + slice * 32 + c4 * 4); }
        if (tid < TB) { const int r = chain_row(b, dir, n * TB + tid); ra = __expf(p.GG[(size_t)r * 2 * GDN_H + dir * GDN_H + h]); rb = p.GB[(size_t)r * 2 * GDN_H + dir * GDN_H + h]; }
    };
    auto lstore = [&](LAS float* B) {
#pragma unroll
        for (int j = 0; j < 4; ++j) { const int idx = j * 512 + tid; *(LAS vf4*)(B + (idx >> 6) * 256 + (idx & 63) * 4) = rq[j]; }
        if (tid < 256) *(LAS vf4*)(B + TB * 256 + tid * 4) = rv;
        if (tid < TB) { B[TB * 256 + TB * 32 + tid * 2] = ra; B[TB * 256 + TB * 32 + tid * 2 + 1] = rb; }
    };
    gload(0); lstore(L); LDS_BARRIER();
    for (int n = 0; n < NB; ++n) {
        LAS float* B = L + (n & 1) * GDN_BUF; LAS float* ob = obuf + (n & 1) * (TB * 32);
        if (n + 1 < NB) gload(n + 1);
#pragma unroll 4
        for (int i = 0; i < TB; ++i) {
            const LAS float* kq = B + i * 256;
            const vf4 q0 = *(const LAS vf4*)(kq + ks * 8), q1 = *(const LAS vf4*)(kq + ks * 8 + 4), k0 = *(const LAS vf4*)(kq + 128 + ks * 8), k1 = *(const LAS vf4*)(kq + 128 + ks * 8 + 4);
            const float v = B[TB * 256 + i * 32 + cl], a = B[TB * 256 + TB * 32 + i * 2], be = B[TB * 256 + TB * 32 + i * 2 + 1];
            const float kk[8] = {k0.x, k0.y, k0.z, k0.w, k1.x, k1.y, k1.z, k1.w}, qq[8] = {q0.x, q0.y, q0.z, q0.w, q1.x, q1.y, q1.z, q1.w};
            float rr = 0.f;
#pragma unroll
            for (int e = 0; e < 8; ++e) { S[e] *= a; rr += kk[e] * S[e]; }
            rr = sum16(rr);
            const float dl = be * (v - rr); float o = 0.f;
#pragma unroll
            for (int e = 0; e < 8; ++e) { S[e] += kk[e] * dl; o += qq[e] * S[e]; }
            o = sum16(o);
            if (ks == 0) ob[i * 32 + cl] = o;
        }
        if (n + 1 < NB) lstore(L + ((n + 1) & 1) * GDN_BUF);
        LDS_BARRIER();
        if (tid < 256) { const int i = tid >> 3, c4 = tid & 7; const int r = chain_row(b, dir, n * TB + i);
            *(vf4*)(p.OG + ((size_t)dir * MROWS + r) * MIX_W + h * 128 + slice * 32 + c4 * 4) = *(const LAS vf4*)(ob + i * 32 + c4 * 4); }
    }
}
constexpr int SSD_BUF = TB * 256 + TB * 64 + TB * 2;
__device__ __forceinline__ void ssd_token_wg(const Ptrs& p, LAS float* L, int chain, int tid) {
    const int b = chain / (SSM_H * 2), hd = (chain >> 1) % SSM_H, dir = chain & 1, g = hd / SSM_HPG;
    const int lane = tid & 63, wave = tid >> 6, ss = lane & 7, pc = wave * 8 + (lane >> 3);
    LAS float* obuf = L + 2 * SSD_BUF;
    float hs[16];
#pragma unroll
    for (int e = 0; e < 16; ++e) hs[e] = 0.f;
    vf4 rbc[4], rx; float rdt = 0.f, rea = 0.f;
    constexpr int NB = CHAIN_LEN / TB;
    auto gload = [&](int n) {
#pragma unroll
        for (int j = 0; j < 4; ++j) { const int idx = j * 512 + tid, i = idx >> 6, c4 = idx & 63; const int r = chain_row(b, dir, n * TB + i);
            rbc[j] = *(const vf4*)(p.SXBC + (size_t)r * SSM_XBC + MIX_W + (c4 < 32 ? g * SSM_N + c4 * 4 : SSM_BC + g * SSM_N + (c4 - 32) * 4)); }
        { const int i = tid >> 4, c4 = tid & 15; const int r = chain_row(b, dir, n * TB + i); rx = *(const vf4*)(p.SXBC + (size_t)r * SSM_XBC + hd * SSM_P + c4 * 4); }
        if (tid < TB) { const int r = chain_row(b, dir, n * TB + tid); rdt = p.SDT[(size_t)r * 2 * SSM_H + dir * SSM_H + hd]; rea = __expf(p.SA[(size_t)r * 2 * SSM_H + dir * SSM_H + hd]); }
    };
    auto lstore = [&](LAS float* B) {
#pragma unroll
        for (int j = 0; j < 4; ++j) { const int idx = j * 512 + tid; *(LAS vf4*)(B + (idx >> 6) * 256 + (idx & 63) * 4) = rbc[j]; }
        *(LAS vf4*)(B + TB * 256 + tid * 4) = rx;
        if (tid < TB) { B[TB * 256 + TB * 64 + tid * 2] = rdt; B[TB * 256 + TB * 64 + tid * 2 + 1] = rea; }
    };
    gload(0); lstore(L); LDS_BARRIER();
    for (int n = 0; n < NB; ++n) {
        LAS float* B = L + (n & 1) * SSD_BUF; LAS float* ob = obuf + (n & 1) * (TB * 64);
        if (n + 1 < NB) gload(n + 1);
#pragma unroll 2
        for (int i = 0; i < TB; ++i) {
            const LAS float* bc = B + i * 256;
            const float xd = B[TB * 256 + i * 64 + pc] * B[TB * 256 + TB * 64 + i * 2], ea = B[TB * 256 + TB * 64 + i * 2 + 1];
            float y = 0.f;
#pragma unroll
            for (int q = 0; q < 4; ++q) { const vf4 bv = *(const LAS vf4*)(bc + ss * 16 + q * 4), cv = *(const LAS vf4*)(bc + 128 + ss * 16 + q * 4);
                hs[4 * q + 0] = ea * hs[4 * q + 0] + xd * bv.x; y += cv.x * hs[4 * q + 0];
                hs[4 * q + 1] = ea * hs[4 * q + 1] + xd * bv.y; y += cv.y * hs[4 * q + 1];
                hs[4 * q + 2] = ea * hs[4 * q + 2] + xd * bv.z; y += cv.z * hs[4 * q + 2];
                hs[4 * q + 3] = ea * hs[4 * q + 3] + xd * bv.w; y += cv.w * hs[4 * q + 3]; }
            y = sum8(y);
            if (ss == 0) ob[i * 64 + pc] = y;
        }
        if (n + 1 < NB) lstore(L + ((n + 1) & 1) * SSD_BUF);
        LDS_BARRIER();
        { const int i = tid >> 4, c4 = tid & 15; const int r = chain_row(b, dir, n * TB + i);
            *(vf4*)(p.OS + ((size_t)dir * MROWS + r) * MIX_W + hd * SSM_P + c4 * 4) = *(const LAS vf4*)(ob + i * 64 + c4 * 4); }
    }
}

constexpr int YLD = 3 * MIX_W;
typedef float f32x2_t __attribute__((ext_vector_type(2)));
typedef __bf16 bf16x2_t __attribute__((ext_vector_type(2)));
typedef short bf16x8_t __attribute__((ext_vector_type(8)));
typedef float f32x16_t __attribute__((ext_vector_type(16)));
__device__ __forceinline__ unsigned cvtpk(float lo, float hi) { f32x2_t v = {lo, hi}; bf16x2_t b = __builtin_convertvector(v, bf16x2_t); return __builtin_bit_cast(unsigned, b); }
__device__ __forceinline__ float bflo(unsigned w) { return __uint_as_float(w << 16); }
__device__ __forceinline__ float bfhi(unsigned w) { return __uint_as_float(w & 0xffff0000u); }
__device__ __forceinline__ void unpack8(const vu4 w, float (&f)[8]) { f[0] = bflo(w.x); f[1] = bfhi(w.x); f[2] = bflo(w.y); f[3] = bfhi(w.y); f[4] = bflo(w.z); f[5] = bfhi(w.z); f[6] = bflo(w.w); f[7] = bfhi(w.w); }
__device__ __forceinline__ float silu_fast(float x) { return x * __builtin_amdgcn_rcpf(1.0f + __expf(-x)); }

__device__ __forceinline__ void conv8(const bf16* Prow, bool hp, bool hn, int col, const float* w, int wld, int jc, float (&y)[8]) {
    float xc[8], xp[8], xn[8];
    unpack8(*(const vu4*)(Prow + col), xc);
    if (hp) unpack8(*(const vu4*)(Prow - NP_MAIN + col), xp);
    if (hn) unpack8(*(const vu4*)(Prow + NP_MAIN + col), xn);
    const vf4 w0a = *(const vf4*)(w + jc), w0b = *(const vf4*)(w + jc + 4), w1a = *(const vf4*)(w + wld + jc), w1b = *(const vf4*)(w + wld + jc + 4), w2a = *(const vf4*)(w + 2 * wld + jc), w2b = *(const vf4*)(w + 2 * wld + jc + 4);
    const float w0[8] = {w0a.x, w0a.y, w0a.z, w0a.w, w0b.x, w0b.y, w0b.z, w0b.w}, w1[8] = {w1a.x, w1a.y, w1a.z, w1a.w, w1b.x, w1b.y, w1b.z, w1b.w}, w2[8] = {w2a.x, w2a.y, w2a.z, w2a.w, w2b.x, w2b.y, w2b.z, w2b.w};
#pragma unroll
    for (int e = 0; e < 8; ++e) { float v = w1[e] * xc[e]; if (hp) v += w0[e] * xp[e]; if (hn) v += w2[e] * xn[e]; y[e] = v; }
}
constexpr float ATT_QSCALE = 0.08838834764831845f * 1.4426950408889634f;
__device__ __forceinline__ void prep_row_wave(const Ptrs& p, int l, int r, int lane) {
    int b, t, len; bool ic; row_info(r, b, t, len, ic);
    const bool hp = t > 0, hn = t < len - 1;
    const bf16* Pr = p.P + (size_t)r * NP_MAIN;
    { const float* w = p.gdn_conv_w + (size_t)l * 3 * (3 * MIX_W);
#pragma unroll 3
        for (int ps = 0; ps < (3 * MIX_W) / 512; ++ps) { const int col = ps * 512 + lane * 8, grp = col >> 7; float y[8]; conv8(Pr, hp, hn, C_QKV + col, w, 3 * MIX_W, col, y);
            float ss = 0.f;
#pragma unroll
            for (int e = 0; e < 8; ++e) { y[e] = silu_fast(y[e]); ss += y[e] * y[e]; }
            ss = sum16(ss);
            float sc = 1.0f; if (grp < 2 * GDN_H) { sc = 1.0f / sqrtf(ss + EPS); if (grp < GDN_H) sc *= 0.08838834764831845f; }
            *(vu4*)(p.GQKVb + (size_t)r * (3 * MIX_W) + col) = (vu4){cvtpk(y[0] * sc, y[1] * sc), cvtpk(y[2] * sc, y[3] * sc), cvtpk(y[4] * sc, y[5] * sc), cvtpk(y[6] * sc, y[7] * sc)}; } }
    { const float* w = p.ssm_conv_w + (size_t)l * 3 * SSM_XBC; const float* cb = p.ssm_conv_b + (size_t)l * SSM_XBC;
#pragma unroll 3
        for (int ps = 0; ps < SSM_XBC / 512; ++ps) { const int col = ps * 512 + lane * 8; float y[8]; conv8(Pr, hp, hn, C_XBC + col, w, SSM_XBC, col, y);
            const vf4 ba = *(const vf4*)(cb + col), bb = *(const vf4*)(cb + col + 4); const float bs[8] = {ba.x, ba.y, ba.z, ba.w, bb.x, bb.y, bb.z, bb.w};
#pragma unroll
            for (int e = 0; e < 8; ++e) y[e] = silu_fast(y[e] + bs[e]);
            const vu4 w8 = {cvtpk(y[0], y[1]), cvtpk(y[2], y[3]), cvtpk(y[4], y[5]), cvtpk(y[6], y[7])};
            if (col >= MIX_W) *(vu4*)(p.SBCb + (size_t)r * (2 * SSM_BC) + col - MIX_W) = w8; else *(vu4*)(p.SXb + (size_t)r * MIX_W + col) = w8; } }
    if (lane < 2 * GDN_H) prep_gdn_gb_item(p, l, r, lane);
    if (lane < 2 * SSM_H) prep_ssd_dt_item(p, l, r, lane);
    { const int l16 = lane & 15, ax = l16 >> 3, i0 = (l16 & 7) * 4; const int pos = ic ? 0 : (ax ? t % GRID_W : t / GRID_W);
        const vf4 t0 = *(const vf4*)(p.ROPE + (size_t)(pos * 32 + i0) * 2), t1 = *(const vf4*)(p.ROPE + (size_t)(pos * 32 + i0) * 2 + 4);
        const float cs[4] = {t0.x, t0.z, t1.x, t1.z}, sn[4] = {t0.y, t0.w, t1.y, t1.w};
#pragma unroll 3
        for (int ps = 0; ps < 3; ++ps) { const int hh = ps * 4 + (lane >> 4);
            if (hh < ATT_HQ + ATT_HKV) { const bool isq = hh < ATT_HQ; const int h = isq ? hh : hh - ATT_HQ;
                const bf16* src = Pr + (isq ? C_AQ : C_AKV) + h * 128 + ax * 64 + i0;
                const vu2 a = *(const vu2*)src, c = *(const vu2*)(src + 32);
                const float x1[4] = {bflo(a.x), bfhi(a.x), bflo(a.y), bfhi(a.y)}, x2[4] = {bflo(c.x), bfhi(c.x), bflo(c.y), bfhi(c.y)};
                float o1[4], o2[4]; const float sc = isq ? ATT_QSCALE : 1.0f;
#pragma unroll
                for (int e = 0; e < 4; ++e) { o1[e] = (x1[e] * cs[e] - x2[e] * sn[e]) * sc; o2[e] = (x2[e] * cs[e] + x1[e] * sn[e]) * sc; }
                bf16* dst = (isq ? p.AQb + (size_t)r * MIX_W : p.AKb + (size_t)r * (ATT_HKV * 128)) + h * 128 + ax * 64 + i0;
                vu2 w1; w1.x = cvtpk(o1[0], o1[1]); w1.y = cvtpk(o1[2], o1[3]); vu2 w2; w2.x = cvtpk(o2[0], o2[1]); w2.y = cvtpk(o2[2], o2[3]);
                *(vu2*)dst = w1; *(vu2*)(dst + 32) = w2; } } }
}
constexpr int PREP_RB = 17, PREP_QP = (3 * MIX_W) / 512, PREP_NPASS = PREP_QP + SSM_XBC / 512;
static_assert(MROWS % PREP_RB == 0 && (3 * MIX_W) % 512 == 0 && SSM_XBC % 512 == 0 && MIX_W % 512 == 0 && PREP_NPASS <= PREP_RB && 2 * PREP_NPASS >= PREP_RB, "prep tiling");
__device__ __forceinline__ void prep_row_scalars_wave(const Ptrs& p, int l, int r, int lane);
__device__ __forceinline__ void prep_conv_block_wave(const Ptrs& p, int l, int blk, int ps, int lane) {
    const int r0 = blk * PREP_RB; const bool isx = ps >= PREP_QP;
    const int col = (isx ? ps - PREP_QP : ps) * 512 + lane * 8, wld = isx ? SSM_XBC : 3 * MIX_W, grp = col >> 7;
    const float* w = (isx ? p.ssm_conv_w + (size_t)l * 3 * SSM_XBC : p.gdn_conv_w + (size_t)l * 3 * (3 * MIX_W)) + col;
    const vf4 w0a = *(const vf4*)w, w0b = *(const vf4*)(w + 4), w1a = *(const vf4*)(w + wld), w1b = *(const vf4*)(w + wld + 4), w2a = *(const vf4*)(w + 2 * wld), w2b = *(const vf4*)(w + 2 * wld + 4);
    const float w0[8] = {w0a.x, w0a.y, w0a.z, w0a.w, w0b.x, w0b.y, w0b.z, w0b.w}, w1[8] = {w1a.x, w1a.y, w1a.z, w1a.w, w1b.x, w1b.y, w1b.z, w1b.w}, w2[8] = {w2a.x, w2a.y, w2a.z, w2a.w, w2b.x, w2b.y, w2b.z, w2b.w};
    float bs[8] = {0.f, 0.f, 0.f, 0.f, 0.f, 0.f, 0.f, 0.f};
    if (isx) { const float* cb = p.ssm_conv_b + (size_t)l * SSM_XBC + col; const vf4 ba = *(const vf4*)cb, bb = *(const vf4*)(cb + 4); bs[0] = ba.x; bs[1] = ba.y; bs[2] = ba.z; bs[3] = ba.w; bs[4] = bb.x; bs[5] = bb.y; bs[6] = bb.z; bs[7] = bb.w; }
    const bf16* src = p.P + (size_t)r0 * NP_MAIN + (isx ? C_XBC : C_QKV) + col;
    vu4 rows[PREP_RB + 2];
#pragma unroll
    for (int j = 0; j < PREP_RB + 2; ++j) { const int r = r0 - 1 + j; rows[j] = (r >= 0 && r < MROWS) ? *(const vu4*)(src + ((ptrdiff_t)j - 1) * NP_MAIN) : (vu4){0u, 0u, 0u, 0u}; }
    prep_row_scalars_wave(p, l, r0 + ps, lane);
    if (ps + PREP_NPASS < PREP_RB) prep_row_scalars_wave(p, l, r0 + ps + PREP_NPASS, lane);
    float xp[8], xc[8], xn[8];
    unpack8(rows[0], xp); unpack8(rows[1], xc);
#pragma unroll
    for (int i = 0; i < PREP_RB; ++i) { const int r = r0 + i; int b, t, len; bool ic; row_info(r, b, t, len, ic); const bool hp = t > 0, hn = t < len - 1;
        unpack8(rows[i + 2], xn);
        float y[8];
#pragma unroll
        for (int e = 0; e < 8; ++e) { float v = w1[e] * xc[e] + bs[e]; if (hp) v += w0[e] * xp[e]; if (hn) v += w2[e] * xn[e]; y[e] = silu_fast(v); }
        if (isx) { const vu4 w8 = {cvtpk(y[0], y[1]), cvtpk(y[2], y[3]), cvtpk(y[4], y[5]), cvtpk(y[6], y[7])};
            if (col >= MIX_W) *(vu4*)(p.SBCb + (size_t)r * (2 * SSM_BC) + col - MIX_W) = w8; else *(vu4*)(p.SXb + (size_t)r * MIX_W + col) = w8; }
        else { float ss = 0.f;
#pragma unroll
            for (int e = 0; e < 8; ++e) ss += y[e] * y[e];
            ss = sum16(ss);
            float sc = 1.0f; if (grp < 2 * GDN_H) { sc = 1.0f / sqrtf(ss + EPS); if (grp < GDN_H) sc *= 0.08838834764831845f; }
            *(vu4*)(p.GQKVb + (size_t)r * (3 * MIX_W) + col) = (vu4){cvtpk(y[0] * sc, y[1] * sc), cvtpk(y[2] * sc, y[3] * sc), cvtpk(y[4] * sc, y[5] * sc), cvtpk(y[6] * sc, y[7] * sc)}; }
#pragma unroll
        for (int e = 0; e < 8; ++e) { xp[e] = xc[e]; xc[e] = xn[e]; } }
}
__device__ __forceinline__ void prep_row_scalars_wave(const Ptrs& p, int l, int r, int lane) {
    int b, t, len; bool ic; row_info(r, b, t, len, ic);
    const bf16* Pr = p.P + (size_t)r * NP_MAIN;
    if (lane < 2 * GDN_H) prep_gdn_gb_item(p, l, r, lane);
    if (lane < 2 * SSM_H) prep_ssd_dt_item(p, l, r, lane);
    { const int l16 = lane & 15, ax = l16 >> 3, i0 = (l16 & 7) * 4; const int pos = ic ? 0 : (ax ? t % GRID_W : t / GRID_W);
        const vf4 t0 = *(const vf4*)(p.ROPE + (size_t)(pos * 32 + i0) * 2), t1 = *(const vf4*)(p.ROPE + (size_t)(pos * 32 + i0) * 2 + 4);
        const float cs[4] = {t0.x, t0.z, t1.x, t1.z}, sn[4] = {t0.y, t0.w, t1.y, t1.w};
#pragma unroll 3
        for (int ps = 0; ps < 3; ++ps) { const int hh = ps * 4 + (lane >> 4);
            if (hh < ATT_HQ + ATT_HKV) { const bool isq = hh < ATT_HQ; const int h = isq ? hh : hh - ATT_HQ;
                const bf16* src = Pr + (isq ? C_AQ : C_AKV) + h * 128 + ax * 64 + i0;
                const vu2 a = *(const vu2*)src, c = *(const vu2*)(src + 32);
                const float x1[4] = {bflo(a.x), bfhi(a.x), bflo(a.y), bfhi(a.y)}, x2[4] = {bflo(c.x), bfhi(c.x), bflo(c.y), bfhi(c.y)};
                float o1[4], o2[4]; const float sc = isq ? ATT_QSCALE : 1.0f;
#pragma unroll
                for (int e = 0; e < 4; ++e) { o1[e] = (x1[e] * cs[e] - x2[e] * sn[e]) * sc; o2[e] = (x2[e] * cs[e] + x1[e] * sn[e]) * sc; }
                bf16* dst = (isq ? p.AQb + (size_t)r * MIX_W : p.AKb + (size_t)r * (ATT_HKV * 128)) + h * 128 + ax * 64 + i0;
                vu2 w1; w1.x = cvtpk(o1[0], o1[1]); w1.y = cvtpk(o1[2], o1[3]); vu2 w2; w2.x = cvtpk(o2[0], o2[1]); w2.y = cvtpk(o2[2], o2[3]);
                *(vu2*)dst = w1; *(vu2*)(dst + 32) = w2; } } }
}
__device__ __forceinline__ void mixout_row_wave(const Ptrs& p, int l, int r, int lane) {
    const int c0 = lane * 16;
    {
        float o[16]; float ss = 0.f;
#pragma unroll
        for (int q = 0; q < 2; ++q) { float a8[8], b8[8]; unpack8(*(const vu4*)(p.OGb + (size_t)r * MIX_W + c0 + 8 * q), a8); unpack8(*(const vu4*)(p.OGb + ((size_t)MROWS + r) * MIX_W + c0 + 8 * q), b8);
#pragma unroll
            for (int e = 0; e < 8; ++e) o[8 * q + e] = a8[e] + b8[e]; }
#pragma unroll
        for (int e = 0; e < 16; ++e) ss += o[e] * o[e];
        ss = sum8(ss);
        const float rs = 1.0f / sqrtf(ss * (1.0f / 128.0f) + EPS);
        float gt[16]; { float t8[8]; unpack8(*(const vu4*)(p.P + (size_t)r * NP_MAIN + C_GATE + c0), t8);
#pragma unroll
            for (int e = 0; e < 8; ++e) gt[e] = t8[e];
            unpack8(*(const vu4*)(p.P + (size_t)r * NP_MAIN + C_GATE + c0 + 8), t8);
#pragma unroll
            for (int e = 0; e < 8; ++e) gt[8 + e] = t8[e]; }
        const float* nw = p.gdn_norm + (size_t)l * 128 + (c0 & 127);
        unsigned w[8];
#pragma unroll
        for (int e = 0; e < 8; ++e) w[e] = cvtpk(o[2 * e] * rs * nw[2 * e] * silu_fast(gt[2 * e]), o[2 * e + 1] * rs * nw[2 * e + 1] * silu_fast(gt[2 * e + 1]));
        *(vu4*)(p.YA + (size_t)r * YLD + c0) = (vu4){w[0], w[1], w[2], w[3]}; *(vu4*)(p.YA + (size_t)r * YLD + c0 + 8) = (vu4){w[4], w[5], w[6], w[7]};
    }
    {
        float y[16]; float ss = 0.f; const float dsk = p.ssm_d[(size_t)l * SSM_H + c0 / SSM_P];
        float zt[16]; { float t8[8]; unpack8(*(const vu4*)(p.P + (size_t)r * NP_MAIN + C_Z + c0), t8);
#pragma unroll
            for (int e = 0; e < 8; ++e) zt[e] = t8[e];
            unpack8(*(const vu4*)(p.P + (size_t)r * NP_MAIN + C_Z + c0 + 8), t8);
#pragma unroll
            for (int e = 0; e < 8; ++e) zt[8 + e] = t8[e]; }
#pragma unroll
        for (int q = 0; q < 2; ++q) { float a8[8], c8[8], d8[8], x8[8]; unpack8(*(const vu4*)(p.OSb + (size_t)r * MIX_W + c0 + 8 * q), a8);
            unpack8(*(const vu4*)(p.OSb2 + (size_t)r * MIX_W + c0 + 8 * q), c8); unpack8(*(const vu4*)(p.OSb2 + ((size_t)MROWS + r) * MIX_W + c0 + 8 * q), d8); unpack8(*(const vu4*)(p.SXb + (size_t)r * MIX_W + c0 + 8 * q), x8);
#pragma unroll
            for (int e = 0; e < 8; ++e) y[8 * q + e] = a8[e] + (c8[e] + d8[e]) + dsk * x8[e]; }
#pragma unroll
        for (int e = 0; e < 16; ++e) { y[e] *= silu_fast(zt[e]); ss += y[e] * y[e]; }
        ss = sum16(ss); ss += __shfl_xor(ss, 16);
        const float rs = 1.0f / sqrtf(ss * (1.0f / (float)(MIX_W / SSM_G)) + EPS);
        const float* nw = p.ssm_norm + (size_t)l * MIX_W + c0;
        unsigned w[8];
#pragma unroll
        for (int e = 0; e < 8; ++e) w[e] = cvtpk(y[2 * e] * rs * nw[2 * e], y[2 * e + 1] * rs * nw[2 * e + 1]);
        *(vu4*)(p.YB + (size_t)r * YLD + c0) = (vu4){w[0], w[1], w[2], w[3]}; *(vu4*)(p.YB + (size_t)r * YLD + c0 + 8) = (vu4){w[4], w[5], w[6], w[7]};
    }
}
static_assert(MIX_W == 1024 && SSM_P == 64 && MIX_W / SSM_G == 512, "mixout_row_wave lane mapping assumes the real shapes");
__device__ __forceinline__ void act_vec_item(const Ptrs& p, int l, int r, int j) {
    int b, t, len; bool ic; row_info(r, b, t, len, ic);
    const bf16* ug = p.UG + (size_t)r * (2 * D_FF);
    float u[8], g[8], gp[8], gn[8];
    unpack8(*(const vu4*)(ug + j), u); unpack8(*(const vu4*)(ug + D_FF + j), g);
    const bool hp = t > 0, hn = t < len - 1;
    if (hp) unpack8(*(const vu4*)(ug - 2 * D_FF + D_FF + j), gp);
    if (hn) unpack8(*(const vu4*)(ug + 2 * D_FF + D_FF + j), gn);
    const float* w = p.ffn_conv_w + (size_t)l * 3 * D_FF + j; const float* cb = p.ffn_conv_b + (size_t)l * D_FF + j;
    unsigned o[4];
    float a[8];
#pragma unroll
    for (int e = 0; e < 8; ++e) { float v = w[D_FF + e] * g[e] + cb[e]; if (hp) v += w[e] * gp[e]; if (hn) v += w[2 * D_FF + e] * gn[e]; a[e] = silu_fast(v) * u[e]; }
#pragma unroll
    for (int e = 0; e < 4; ++e) o[e] = cvtpk(a[2 * e], a[2 * e + 1]);
    *(vu4*)(p.ACT + (size_t)r * D_FF + j) = (vu4){o[0], o[1], o[2], o[3]};
}

__device__ __forceinline__ void act_task(const Ptrs& p, int l, int task) {
    constexpr int NJ = D_FF / 8;
    const int rc = task / NJ, j = (task % NJ) * 8, r0 = rc * 16;
    int b, t, len; bool ic; row_info(r0, b, t, len, ic);
    const float* w = p.ffn_conv_w + (size_t)l * 3 * D_FF + j; const float* cb = p.ffn_conv_b + (size_t)l * D_FF + j;
    float w0[8], w1[8], w2[8], bs[8];
    { const vf4 a0 = *(const vf4*)w, a1 = *(const vf4*)(w + 4), b0 = *(const vf4*)(w + D_FF), b1 = *(const vf4*)(w + D_FF + 4), c0 = *(const vf4*)(w + 2 * D_FF), c1 = *(const vf4*)(w + 2 * D_FF + 4), d0 = *(const vf4*)cb, d1 = *(const vf4*)(cb + 4);
        const float t0[8] = {a0.x, a0.y, a0.z, a0.w, a1.x, a1.y, a1.z, a1.w}, t1[8] = {b0.x, b0.y, b0.z, b0.w, b1.x, b1.y, b1.z, b1.w}, t2[8] = {c0.x, c0.y, c0.z, c0.w, c1.x, c1.y, c1.z, c1.w}, t3[8] = {d0.x, d0.y, d0.z, d0.w, d1.x, d1.y, d1.z, d1.w};
#pragma unroll
        for (int e = 0; e < 8; ++e) { w0[e] = t0[e]; w1[e] = t1[e]; w2[e] = t2[e]; bs[e] = t3[e]; } }
    const bf16* base = p.UG + (size_t)r0 * (2 * D_FF) + j;
    vu4 gq[18], uq[16];
    const vu4 z4 = {0u, 0u, 0u, 0u};
    gq[0] = (t > 0) ? *(const vu4*)(base - 2 * D_FF + D_FF) : z4;
#pragma unroll
    for (int i = 0; i < 16; ++i) { gq[i + 1] = *(const vu4*)(base + (size_t)i * (2 * D_FF) + D_FF); uq[i] = *(const vu4*)(base + (size_t)i * (2 * D_FF)); }
    gq[17] = (t + 16 < len) ? *(const vu4*)(base + (size_t)16 * (2 * D_FF) + D_FF) : z4;
#pragma unroll
    for (int i = 0; i < 16; ++i) { float gp[8], gc[8], gn[8], u[8]; unpack8(gq[i], gp); unpack8(gq[i + 1], gc); unpack8(gq[i + 2], gn); unpack8(uq[i], u);
        float a[8];
#pragma unroll
        for (int e = 0; e < 8; ++e) a[e] = silu_fast(w0[e] * gp[e] + w1[e] * gc[e] + w2[e] * gn[e] + bs[e]) * u[e];
        *(vu4*)(p.ACT + (size_t)(r0 + i) * D_FF + j) = (vu4){cvtpk(a[0], a[1]), cvtpk(a[2], a[3]), cvtpk(a[4], a[5]), cvtpk(a[6], a[7])}; }
}
static_assert(SEQ % 16 == 0 && CTX_LEN % 16 == 0, "act_task row chunks must not straddle sequences");

__device__ __forceinline__ void act_fix_item(const Ptrs& p, int l, int bidx, int j) {
    const int row = (bidx >> 1) * 64 + ((bidx & 1) ? 63 : 0);
    int b, t, len; bool ic; row_info(row, b, t, len, ic);
    const size_t bi = (size_t)bidx * D_FF + j;
    vf4 pre = *(const vf4*)(p.BP + bi);
    const vu2 uw = *(const vu2*)(p.BU + bi);
    const bool hasn = (bidx & 1) ? (t < len - 1) : (t > 0);
    if (hasn) { const vu2 gw = *(const vu2*)(p.BG + (size_t)((bidx & 1) ? bidx + 1 : bidx - 1) * D_FF + j);
        const vf4 w = *(const vf4*)(p.ffn_conv_w + (size_t)l * 3 * D_FF + ((bidx & 1) ? 2 * D_FF : 0) + j);
        pre += w * (vf4){bflo(gw.x), bfhi(gw.x), bflo(gw.y), bfhi(gw.y)}; }
    const float u4[4] = {bflo(uw.x), bfhi(uw.x), bflo(uw.y), bfhi(uw.y)};
    *(vu2*)(p.ACT + (size_t)row * D_FF + j) = (vu2){cvtpk(silu_fast(pre.x) * u4[0], silu_fast(pre.y) * u4[1]), cvtpk(silu_fast(pre.z) * u4[2], silu_fast(pre.w) * u4[3])};
}

constexpr int AT_KSTR = 136, AT_VSTR = 68;
constexpr int AT_BUF = 64 * AT_KSTR + 128 * AT_VSTR;
constexpr int ATT_UNITS_LAT = BATCH * ATT_HKV * (SEQ / 64), ATT_UNITS_CTX = BATCH * ATT_HKV * (CTX_LEN / 64);
__device__ __forceinline__ void attn_unit(const Ptrs& p, int l, LAS bf16* L, int unit, int tid) {
    const int lane = tid & 63, wave = tid >> 6, r32 = lane & 31, h = lane >> 5;
    const bool cu = unit >= ATT_UNITS_LAT; const int uu = cu ? unit - ATT_UNITS_LAT : unit;
    const int nqb = cu ? CTX_LEN / 64 : SEQ / 64;
    const int b = uu / (ATT_HKV * nqb), kvh = (uu / nqb) % ATT_HKV, qb = uu % nqb, q0 = qb * 64;
    const int rowbase = (cu ? NLAT + b * CTX_LEN : b * SEQ) + q0;
    const int g = wave >> 1, qh = wave & 1, hq = kvh * ATT_GRP + g;
    const int qpos = q0 + 32 * qh + r32, qrow = rowbase + 32 * qh + r32;
    bf16x8_t qf[8];
#pragma unroll
    for (int s = 0; s < 8; ++s) qf[s] = *(const bf16x8_t*)(p.AQb + (size_t)qrow * MIX_W + hq * 128 + 16 * s + 8 * h);
    float m = p.attn_sink[(size_t)l * ATT_HQ + hq] * 1.4426950408889634f, lsum = h ? 0.f : 1.0f;
    f32x16_t o[4];
#pragma unroll
    for (int d = 0; d < 4; ++d)
#pragma unroll
        for (int e = 0; e < 16; ++e) o[d][e] = 0.f;
    const int jl0 = cu ? 5 : (q0 - 128 < 0 ? (128 - q0) / 64 : 0), jl1 = cu ? 5 : ((q0 + 192 > SEQ) ? 5 - (q0 + 192 - SEQ) / 64 : 5);
    const int nt = (jl1 - jl0) + CTX_LEN / 64;
    vu4 rk[2], rv[2];
    auto tile_row0 = [&](int ti, int& kpos0) -> int { const int j = jl0 + ti; if (j < jl1) { kpos0 = q0 - 128 + 64 * j; return b * SEQ + kpos0; } kpos0 = -1000000; return NLAT + b * CTX_LEN + 64 * (j - jl1); };
    auto gload = [&](int ti) { int kp; const int kr0 = tile_row0(ti, kp);
#pragma unroll
        for (int it = 0; it < 2; ++it) { const int c = tid + 512 * it;
            rk[it] = *(const vu4*)(p.AKb + (size_t)(kr0 + (c >> 4)) * (ATT_HKV * 128) + kvh * 128 + (c & 15) * 8);
            const int vk = (c & 15) | (((c >> 6) & 3) << 4), vd = ((c >> 4) & 3) | ((c >> 8) << 2);
            rv[it] = *(const vu4*)(p.P + (size_t)(kr0 + vk) * NP_MAIN + C_AKV + ATT_HKV * 128 + kvh * 128 + vd * 8); } };
    auto lstore = [&](LAS bf16* B) {
#pragma unroll
        for (int it = 0; it < 2; ++it) { const int c = tid + 512 * it;
            *(LAS vu4*)(B + (c >> 4) * AT_KSTR + (c & 15) * 8) = rk[it];
            const int vk = (c & 15) | (((c >> 6) & 3) << 4), vd = ((c >> 4) & 3) | ((c >> 8) << 2);
            LAS bf16* vt = B + 64 * AT_KSTR + (vd * 8) * AT_VSTR + vk;
            const unsigned w4[4] = {rv[it].x, rv[it].y, rv[it].z, rv[it].w};
#pragma unroll
            for (int e = 0; e < 4; ++e) { vt[(2 * e) * AT_VSTR] = (bf16)(w4[e] & 0xffffu); vt[(2 * e + 1) * AT_VSTR] = (bf16)(w4[e] >> 16); } } };
    gload(0); lstore(L); LDS_BARRIER();
    for (int ti = 0; ti < nt; ++ti) {
        LAS bf16* B = L + (ti & 1) * AT_BUF;
        int kpos0; (void)tile_row0(ti, kpos0);
        if (ti + 1 < nt) gload(ti + 1);
        f32x16_t st[2];
#pragma unroll
        for (int sub = 0; sub < 2; ++sub) {
#pragma unroll
            for (int e = 0; e < 16; ++e) st[sub][e] = 0.f;
            bf16x8_t kf[8];
#pragma unroll
            for (int s = 0; s < 8; ++s) kf[s] = *(const LAS bf16x8_t*)(B + (32 * sub + r32) * AT_KSTR + 16 * s + 8 * h);
            __builtin_amdgcn_s_setprio(1);
#pragma unroll
            for (int s = 0; s < 8; ++s) st[sub] = __builtin_amdgcn_mfma_f32_32x32x16_bf16(kf[s], qf[s], st[sub], 0, 0, 0);
            __builtin_amdgcn_s_setprio(0); }
        float mx = -1e30f;
#pragma unroll
        for (int sub = 0; sub < 2; ++sub)
#pragma unroll
            for (int e = 0; e < 16; ++e) { const int key = 32 * sub + (e & 3) + 8 * (e >> 2) + 4 * h; const int dlt = kpos0 + key - qpos;
                if (kpos0 > -500000 && (dlt > WINDOW || dlt < -WINDOW)) st[sub][e] = -1e30f;
                mx = fmaxf(mx, st[sub][e]); }
        mx = fmaxf(mx, __shfl_xor(mx, 32));
        const float mn = fmaxf(m, mx), alpha = __builtin_amdgcn_exp2f(m - mn); m = mn;
        float ps = 0.f;
#pragma unroll
        for (int sub = 0; sub < 2; ++sub)
#pragma unroll
            for (int e = 0; e < 16; ++e) { const float pe = __builtin_amdgcn_exp2f(st[sub][e] - mn); st[sub][e] = pe; ps += pe; }
        lsum = lsum * alpha + ps;
        if (!__all(alpha == 1.0f)) {
#pragma unroll
            for (int d = 0; d < 4; ++d)
#pragma unroll
                for (int e = 0; e < 16; ++e) o[d][e] *= alpha; }
#pragma unroll
        for (int kk = 0; kk < 4; ++kk) { const int sub = kk >> 1, s8 = (kk & 1) * 8;
            vu4 pw; pw.x = cvtpk(st[sub][s8], st[sub][s8 + 1]); pw.y = cvtpk(st[sub][s8 + 2], st[sub][s8 + 3]); pw.z = cvtpk(st[sub][s8 + 4], st[sub][s8 + 5]); pw.w = cvtpk(st[sub][s8 + 6], st[sub][s8 + 7]);
            const bf16x8_t pf = __builtin_bit_cast(bf16x8_t, pw);
            bf16x8_t vf[4];
#pragma unroll
            for (int d = 0; d < 4; ++d) { const LAS bf16* vp = B + 64 * AT_KSTR + (32 * d + r32) * AT_VSTR + 16 * kk + 4 * h;
                const vu2 lo = *(const LAS vu2*)vp, hi = *(const LAS vu2*)(vp + 8);
                vf[d] = __builtin_bit_cast(bf16x8_t, (vu4){lo.x, lo.y, hi.x, hi.y}); }
            __builtin_amdgcn_s_setprio(1);
#pragma unroll
            for (int d = 0; d < 4; ++d) o[d] = __builtin_amdgcn_mfma_f32_32x32x16_bf16(vf[d], pf, o[d], 0, 0, 0);
            __builtin_amdgcn_s_setprio(0); }
        if (ti + 1 < nt) lstore(L + ((ti + 1) & 1) * AT_BUF);
        LDS_BARRIER();
    }
    lsum += __shfl_xor(lsum, 32);
    const float inv = 1.0f / lsum;
    LAS bf16* os = L + wave * (32 * AT_KSTR);
#pragma unroll
    for (int d = 0; d < 4; ++d)
#pragma unroll
        for (int a4 = 0; a4 < 4; ++a4) { vu2 w; w.x = cvtpk(o[d][4 * a4] * inv, o[d][4 * a4 + 1] * inv); w.y = cvtpk(o[d][4 * a4 + 2] * inv, o[d][4 * a4 + 3] * inv);
            *(LAS vu2*)(os + r32 * AT_KSTR + 32 * d + 8 * a4 + 4 * h) = w; }
    LDS_BARRIER();
#pragma unroll
    for (int i = 0; i < 8; ++i) { const int c = lane + 64 * i, row = c >> 4, ch = c & 15;
        *(vu4*)(p.YC + (size_t)(rowbase + 32 * qh + row) * YLD + hq * 128 + ch * 8) = *(const LAS vu4*)(os + row * AT_KSTR + ch * 8); }
    LDS_BARRIER();
}
static_assert(2 * AT_BUF * 2 <= 131072 && 8 * 32 * AT_KSTR <= 2 * AT_BUF, "attention LDS map");

constexpr int NCH = CHAIN_LEN / 64, NCH_CTX = CTX_LEN / 64;
constexpr int GDN_NU = BATCH * NCH * GDN_H * 2;
constexpr int GC_KS = 136, GC_FS = 65, GC_LS = 68, GC_TS = 72;
__device__ __forceinline__ int gdn_unit_index(int b, int c, int h, int dir) { return ((b * NCH + c) * GDN_H + h) * 2 + dir; }
__device__ __forceinline__ int chunk_row0(int b, int c) { return c < NCH_CTX ? NLAT + b * CTX_LEN + 64 * c : b * SEQ + 64 * (c - NCH_CTX); }
template <int NK> __device__ __forceinline__ f32x16_t mma_lds(f32x16_t acc, const LAS bf16* A, int lda, const LAS bf16* Bt, int ldb, int r32, int hh) {
    bf16x8_t a[NK], bb[NK];
#pragma unroll
    for (int s = 0; s < NK; ++s) { a[s] = *(const LAS bf16x8_t*)(A + r32 * lda + 16 * s + 8 * hh); bb[s] = *(const LAS bf16x8_t*)(Bt + r32 * ldb + 16 * s + 8 * hh); }
    f32x16_t acc2;
#pragma unroll
    for (int e = 0; e < 16; ++e) acc2[e] = 0.f;
#pragma unroll
    for (int s = 0; s < NK; s += 2) { acc = __builtin_amdgcn_mfma_f32_32x32x16_bf16(a[s], bb[s], acc, 0, 0, 0); acc2 = __builtin_amdgcn_mfma_f32_32x32x16_bf16(a[s + 1], bb[s + 1], acc2, 0, 0, 0); }
#pragma unroll
    for (int e = 0; e < 16; ++e) acc[e] += acc2[e];
    return acc;
}
__device__ __forceinline__ f32x16_t zero16() { f32x16_t z;
#pragma unroll
    for (int e = 0; e < 16; ++e) z[e] = 0.f;
    return z; }
__device__ __forceinline__ void tri_solve_wave(const LAS float* Lm, LAS bf16* Tm, LAS bf16* scr, int lane) {
    const int blk = lane >> 5, c = lane & 31, r32 = c, hh = blk;
    LAS bf16* B00 = scr; LAS bf16* XT = scr + 32 * 40;
    float t[32];
    vf4 lb[3][8];
#define TRI_LDROW(i_) do { _Pragma("unroll") for (int j4 = 0; j4 < ((i_) + 3) / 4; ++j4) lb[(i_) % 3][j4] = *(const LAS vf4*)(Lm + (32 * blk + (i_)) * GC_LS + 32 * blk + 4 * j4); } while (0)
    TRI_LDROW(1);
#pragma unroll
    for (int i = 0; i < 32; ++i) {
        if (i + 2 < 32) TRI_LDROW(i + 2);
        float s = (i == c) ? 1.0f : 0.0f;
#pragma unroll
        for (int j4 = 0; j4 < (i + 3) / 4; ++j4) { const vf4 lv = lb[i % 3][j4];
            if (4 * j4 + 0 < i) s -= lv.x * t[4 * j4 + 0];
            if (4 * j4 + 1 < i) s -= lv.y * t[4 * j4 + 1];
            if (4 * j4 + 2 < i) s -= lv.z * t[4 * j4 + 2];
            if (4 * j4 + 3 < i) s -= lv.w * t[4 * j4 + 3]; }
        t[i] = s;
        asm volatile("" : "+v"(t[i]));
    }
#undef TRI_LDROW
#pragma unroll
    for (int i = 0; i < 32; ++i) { Tm[(32 * blk + i) * GC_TS + 32 * blk + c] = f2bf(t[i]); if (blk == 0) Tm[i * GC_TS + 32 + c] = (bf16)0; }
    if (blk == 0) {
#pragma unroll
        for (int q = 0; q < 4; ++q) *(LAS vu4*)(B00 + c * 40 + 8 * q) = (vu4){cvtpk(t[8 * q], t[8 * q + 1]), cvtpk(t[8 * q + 2], t[8 * q + 3]), cvtpk(t[8 * q + 4], t[8 * q + 5]), cvtpk(t[8 * q + 6], t[8 * q + 7])}; }
    f32x16_t x = zero16();
#pragma unroll
    for (int s = 0; s < 2; ++s) { const LAS float* lp = Lm + (32 + r32) * GC_LS + 16 * s + 8 * hh; const vf4 l0 = *(const LAS vf4*)lp, l1 = *(const LAS vf4*)(lp + 4);
        const bf16x8_t a = __builtin_bit_cast(bf16x8_t, (vu4){cvtpk(l0.x, l0.y), cvtpk(l0.z, l0.w), cvtpk(l1.x, l1.y), cvtpk(l1.z, l1.w)});
        const bf16x8_t bb = *(const LAS bf16x8_t*)(B00 + r32 * 40 + 16 * s + 8 * hh);
        x = __builtin_amdgcn_mfma_f32_32x32x16_bf16(a, bb, x, 0, 0, 0); }
#pragma unroll
    for (int a4 = 0; a4 < 4; ++a4) *(LAS vu2*)(XT + r32 * 40 + 8 * a4 + 4 * hh) = (vu2){cvtpk(x[4 * a4], x[4 * a4 + 1]), cvtpk(x[4 * a4 + 2], x[4 * a4 + 3])};
    f32x16_t y = zero16();
#pragma unroll
    for (int s = 0; s < 2; ++s) { const bf16x8_t a = *(const LAS bf16x8_t*)(Tm + (32 + r32) * GC_TS + 32 + 16 * s + 8 * hh), bb = *(const LAS bf16x8_t*)(XT + r32 * 40 + 16 * s + 8 * hh);
        y = __builtin_amdgcn_mfma_f32_32x32x16_bf16(a, bb, y, 0, 0, 0); }
#pragma unroll
    for (int e = 0; e < 16; ++e) Tm[(32 + (e & 3) + 8 * (e >> 2) + 4 * hh) * GC_TS + r32] = f2bf(-y[e]);
}
constexpr int G1_KK = 0, G1_QK = G1_KK + 64 * GC_FS * 4, G1_L = G1_QK + 64 * GC_FS * 4, G1_T = G1_L + 2 * 64 * GC_LS * 4,
              G1_KB = G1_T + 2 * 64 * GC_TS * 2, G1_VB = G1_KB + 128 * GC_TS * 2, G1_SM = G1_VB + 128 * GC_TS * 2, G1_END = G1_SM + 10 * 64 * 4;
__device__ __forceinline__ void st_vu2(LAS bf16* q, vu2 v) { *(LAS vu2*)q = v; }
__device__ __forceinline__ void st_vu2(bf16* q, vu2 v) { *(vu2*)q = v; }
__device__ __forceinline__ void gdn_g1_unit(const Ptrs& p, LAS unsigned char* lds, int unit, int tid) {
    const int lane = tid & 63, wave = tid >> 6, r32 = lane & 31, hh = lane >> 5;
    const int b = unit / (NCH * GDN_H), c = (unit / GDN_H) % NCH, h = unit % GDN_H;
    const int r0 = chunk_row0(b, c);
    LAS float* KKs = (LAS float*)(lds + G1_KK); LAS float* QKs = (LAS float*)(lds + G1_QK);
    LAS float* Lm = (LAS float*)(lds + G1_L); LAS bf16* Tm = (LAS bf16*)(lds + G1_T); LAS bf16* KbT = (LAS bf16*)(lds + G1_KB); LAS bf16* VbT = (LAS bf16*)(lds + G1_VB);
    LAS float* gc = (LAS float*)(lds + G1_SM); LAS float* be = gc + 128; LAS float* eg = gc + 256; LAS float* beg = gc + 384; LAS float* egl = gc + 512;
    const bf16* Qg = p.GQKVb + (size_t)r0 * (3 * MIX_W) + h * 128;
    const int prod = wave >> 2, mt = (wave >> 1) & 1, nt = wave & 1;
    bf16x8_t fa[8], fb[8], ft[4];
    { const bf16* Ap = Qg + (size_t)(32 * mt + r32) * (3 * MIX_W) + (prod ? 0 : MIX_W) + 8 * hh;
      const bf16* Bp = Qg + (size_t)(32 * nt + r32) * (3 * MIX_W) + MIX_W + 8 * hh;
      const bf16* Tp = Qg + (size_t)(32 * mt + r32) * (3 * MIX_W) + (prod ? 2 * MIX_W : MIX_W) + 64 * nt + 8 * hh;
#pragma unroll
      for (int s = 0; s < 8; ++s) { fa[s] = *(const bf16x8_t*)(Ap + 16 * s); fb[s] = *(const bf16x8_t*)(Bp + 16 * s); }
#pragma unroll
      for (int s = 0; s < 4; ++s) ft[s] = *(const bf16x8_t*)(Tp + 16 * s); }
    if (wave < 2) { const int dir = wave, n = dir ? 63 - lane : lane; const size_t gi = (size_t)(r0 + n) * 2 * GDN_H + dir * GDN_H + h;
        float x = p.GG[gi]; const float bt = p.GB[gi];
#pragma unroll
        for (int o = 1; o < 64; o <<= 1) { const float y = __shfl_up(x, o); if (lane >= o) x += y; }
        const float x63 = __shfl(x, 63), ex = __expf(x);
        gc[dir * 64 + lane] = x; be[dir * 64 + lane] = bt; eg[dir * 64 + lane] = ex; beg[dir * 64 + lane] = bt * ex; egl[dir * 64 + lane] = __expf(x63 - x); }
    f32x16_t tt[2];
    { f32x16_t acc = zero16(), acc2 = zero16();
#pragma unroll
      for (int s = 0; s < 8; s += 2) { acc = __builtin_amdgcn_mfma_f32_32x32x16_bf16(fa[s], fb[s], acc, 0, 0, 0); acc2 = __builtin_amdgcn_mfma_f32_32x32x16_bf16(fa[s + 1], fb[s + 1], acc2, 0, 0, 0); }
      LAS float* dst = prod ? QKs : KKs;
#pragma unroll
      for (int e = 0; e < 16; ++e) dst[(32 * mt + (e & 3) + 8 * (e >> 2) + 4 * hh) * GC_FS + 32 * nt + r32] = acc[e] + acc2[e];
      bf16x8_t id[2];
#pragma unroll
      for (int s = 0; s < 2; ++s) { unsigned w[4];
#pragma unroll
          for (int e2 = 0; e2 < 4; ++e2) { const int k0 = 16 * s + 8 * hh + 2 * e2; w[e2] = (k0 == r32 ? 0x3F80u : 0u) | (k0 + 1 == r32 ? 0x3F800000u : 0u); }
          id[s] = __builtin_bit_cast(bf16x8_t, (vu4){w[0], w[1], w[2], w[3]}); }
#pragma unroll
      for (int j = 0; j < 2; ++j) { tt[j] = zero16();
          tt[j] = __builtin_amdgcn_mfma_f32_32x32x16_bf16(ft[2 * j], id[0], tt[j], 0, 0, 0); tt[j] = __builtin_amdgcn_mfma_f32_32x32x16_bf16(ft[2 * j + 1], id[1], tt[j], 0, 0, 0); } }
    LDS_BARRIER();
    auto put_T = [&](int dir, const LAS float* tab, auto dstf) {
#pragma unroll
        for (int j = 0; j < 2; ++j) {
#pragma unroll
            for (int a4 = 0; a4 < 4; ++a4) { const int n0 = 32 * mt + 8 * a4 + 4 * hh;
                if (dir == 0) { const vf4 sc = *(const LAS vf4*)(tab + n0);
                    st_vu2(dstf(j, n0), (vu2){cvtpk(tt[j][4 * a4] * sc.x, tt[j][4 * a4 + 1] * sc.y), cvtpk(tt[j][4 * a4 + 2] * sc.z, tt[j][4 * a4 + 3] * sc.w)}); }
                else { const int i0 = 60 - n0; const vf4 sc = *(const LAS vf4*)(tab + 64 + i0);
                    st_vu2(dstf(j, i0), (vu2){cvtpk(tt[j][4 * a4 + 3] * sc.x, tt[j][4 * a4 + 2] * sc.y), cvtpk(tt[j][4 * a4 + 1] * sc.z, tt[j][4 * a4] * sc.w)}); } } } };
    auto lds_T = [&](LAS bf16* img) { return [=](int j, int i0) { return img + (64 * nt + 32 * j + r32) * GC_TS + i0; }; };
    auto kdt_T = [&](int dir) { bf16* base = p.GKdT + (size_t)gdn_unit_index(b, c, h, dir) * 128 * 64; return [=](int j, int i0) { return base + (((2 * nt + j) * 4 + (i0 >> 4)) * 64 + ((i0 >> 3) & 1) * 32 + r32) * 8 + (i0 & 7); }; };
    if (prod == 0) { put_T(0, egl, kdt_T(0)); put_T(1, egl, kdt_T(1)); put_T(0, beg, lds_T(KbT)); }
    else {
        const int dir = nt, n = 32 * mt + r32, i = dir ? 63 - n : n; const float sc = eg[dir * 64 + i];
        bf16* base = p.GQd + (size_t)gdn_unit_index(b, c, h, dir) * 64 * 128 + ((size_t)((i >> 5) * 8) * 64 + hh * 32 + (i & 31)) * 8;
#pragma unroll
        for (int q = 0; q < 8; ++q) { float q8[8]; unpack8(__builtin_bit_cast(vu4, fa[q]), q8);
            *(vu4*)(base + q * 512) = (vu4){cvtpk(q8[0] * sc, q8[1] * sc), cvtpk(q8[2] * sc, q8[3] * sc), cvtpk(q8[4] * sc, q8[5] * sc), cvtpk(q8[6] * sc, q8[7] * sc)}; }
        put_T(0, be, lds_T(VbT)); }
#pragma unroll
    for (int it = 0; it < 2; ++it) { const int item = it * 512 + tid, dir = item >> 9, j0 = ((item >> 6) & 7) * 8, i = item & 63, ni = dir ? 63 - i : i;
        float o[8] = {0.f, 0.f, 0.f, 0.f, 0.f, 0.f, 0.f, 0.f};
        if (j0 < i) { const float gi = gc[dir * 64 + i], bi = be[dir * 64 + i]; const vf4 ga = *(const LAS vf4*)(gc + dir * 64 + j0), gb = *(const LAS vf4*)(gc + dir * 64 + j0 + 4);
            const float gj[8] = {ga.x, ga.y, ga.z, ga.w, gb.x, gb.y, gb.z, gb.w};
#pragma unroll
            for (int q = 0; q < 8; ++q) { const int j = j0 + q, nj = dir ? 63 - j : j; o[q] = (i > j) ? bi * KKs[ni * GC_FS + nj] * __expf(gi - gj[q]) : 0.0f; } }
        LAS float* dst = Lm + dir * 64 * GC_LS + i * GC_LS + j0;
        *(LAS vf4*)dst = (vf4){o[0], o[1], o[2], o[3]}; *(LAS vf4*)(dst + 4) = (vf4){o[4], o[5], o[6], o[7]}; }
    LDS_BARRIER();
    if (wave < 2) { __builtin_amdgcn_s_setprio(3); tri_solve_wave(Lm + wave * 64 * GC_LS, Tm + wave * 64 * GC_TS, (LAS bf16*)KKs + wave * 2 * 32 * 40, lane); __builtin_amdgcn_s_setprio(0); }
    else if ((wave & 3) >= 2) { const int t6 = ((wave & 1) | ((wave >> 2) << 1)) * 64 + lane;
        for (int it = t6; it < 2 * 64 * 8; it += 256) { const int dir = it >> 9, j8 = (it >> 6) & 7, i = it & 63, ni = dir ? 63 - i : i; unsigned w[4];
#pragma unroll
            for (int e2 = 0; e2 < 4; ++e2) { float a[2];
#pragma unroll
                for (int q = 0; q < 2; ++q) { const int j = j8 * 8 + 2 * e2 + q; a[q] = (i >= j) ? QKs[ni * GC_FS + (dir ? 63 - j : j)] * __expf(gc[dir * 64 + i] - gc[dir * 64 + j]) : 0.0f; }
                w[e2] = cvtpk(a[0], a[1]); }
            *(vu4*)(p.GA + (size_t)gdn_unit_index(b, c, h, dir) * 64 * 64 + (((i >> 5) * 4 + (j8 >> 1)) * 64 + (j8 & 1) * 32 + (i & 31)) * 8) = (vu4){w[0], w[1], w[2], w[3]}; }
        if (t6 < 2) p.GGL[gdn_unit_index(b, c, h, t6)] = eg[t6 * 64 + 63]; }
    LDS_BARRIER();
    LAS bf16* KbT1 = (LAS bf16*)(lds + G1_KK); LAS bf16* VbT1 = KbT1 + 128 * GC_TS;
    if (prod == 0) put_T(1, beg, lds_T(KbT1)); else put_T(1, be, lds_T(VbT1));
    LDS_BARRIER();
#pragma unroll
    for (int dir = 0; dir < 2; ++dir) {
        const int u = gdn_unit_index(b, c, h, dir); const LAS bf16* Td = Tm + dir * 64 * GC_TS; const LAS bf16* Kd = dir ? KbT1 : KbT; const LAS bf16* Vd = dir ? VbT1 : VbT;
        { const int dt = wave >> 1, it2 = wave & 1; f32x16_t acc = zero16(); acc = mma_lds<4>(acc, Kd + 32 * dt * GC_TS, GC_TS, Td + 32 * it2 * GC_TS, GC_TS, r32, hh);
            bf16* dst = p.GW + (size_t)u * 64 * 128 + ((it2 * 8 + 2 * dt) * 64 + r32) * 8 + 4 * hh;
#pragma unroll
            for (int a4 = 0; a4 < 4; ++a4) *(vu2*)(dst + (a4 >> 1) * 512 + (a4 & 1) * 256) = (vu2){cvtpk(acc[4 * a4], acc[4 * a4 + 1]), cvtpk(acc[4 * a4 + 2], acc[4 * a4 + 3])}; }
        { const int it2 = wave >> 2, dt = wave & 3; f32x16_t acc = zero16(); acc = mma_lds<4>(acc, Td + 32 * it2 * GC_TS, GC_TS, Vd + 32 * dt * GC_TS, GC_TS, r32, hh);
            bf16* dst = p.GUT + (size_t)u * 128 * 64 + ((size_t)((dt * 2 + it2) * 4) * 64 + lane) * 4;
#pragma unroll
            for (int a4 = 0; a4 < 4; ++a4) *(vu2*)(dst + a4 * 256) = (vu2){cvtpk(acc[4 * a4], acc[4 * a4 + 1]), cvtpk(acc[4 * a4 + 2], acc[4 * a4 + 3])}; }
    }
    LDS_BARRIER();
}

template <class F> __device__ __forceinline__ void store_tile_rows(const f32x16_t& a, LAS bf16* T, int lane, F rowptr) {
    const int r32 = lane & 31, hh = lane >> 5;
#pragma unroll
    for (int e = 0; e < 16; ++e) T[((e & 3) + 8 * (e >> 2) + 4 * hh) * 40 + r32] = f2bf(a[e]);
    const int il = lane >> 1, half = lane & 1;
    const vu4 w0 = *(const LAS vu4*)(T + il * 40 + half * 16), w1 = *(const LAS vu4*)(T + il * 40 + half * 16 + 8);
    bf16* dst = rowptr(il) + half * 16;
    *(vu4*)dst = w0; *(vu4*)(dst + 8) = w1;
}
__device__ __forceinline__ void gdn_scan_wg(const Ptrs& p, LAS unsigned char* lds, int chain, int slice, int tid) {
    const int b = chain / (GDN_H * 2), h = (chain >> 1) % GDN_H, dir = chain & 1;
    const int lane = tid & 63, wave = tid >> 6, r32 = lane & 31, hh = lane >> 5;
    LAS bf16* SbT = (LAS bf16*)lds;
    LAS bf16* vnT = SbT + 4 * 32 * GC_KS;
    LAS bf16* otile = vnT + 3 * 32 * GC_TS + (wave & 1) * 32 * 40;
    for (int i = tid; i < 32 * GC_KS / 2; i += 512) ((LAS unsigned*)SbT)[i] = 0u;
    LDS_BARRIER();
    auto chunk_of = [&](int s) { return s < NCH_CTX ? (dir ? NCH_CTX - 1 - s : s) : NCH_CTX + (dir ? NCH - NCH_CTX - 1 - (s - NCH_CTX) : s - NCH_CTX); };
    auto unit_of = [&](int s) { return (size_t)gdn_unit_index(b, chunk_of(s), h, dir); };
    using I0 = std::integral_constant<int, 0>; using I1 = std::integral_constant<int, 1>; using I2 = std::integral_constant<int, 2>; using I3 = std::integral_constant<int, 3>;
    if (wave < 2) {
        __builtin_amdgcn_s_setprio(3);
        int tr = tid; asm volatile("" : "+v"(tr)); const int ln = tr & 63, t = (tr >> 6) & 1;
        bf16x8_t fa[4][8]; vu2 ut[4][4];
        auto prefetch = [&](int s, auto KC2) { constexpr int k = decltype(KC2)::value; const size_t u = unit_of(s);
            const bf16* wp = p.GW + u * 64 * 128 + (size_t)(t * 512 + ln) * 8; const bf16* up = p.GUT + u * 128 * 64 + (size_t)((slice * 2 + t) * 256 + ln) * 4;
#pragma unroll
            for (int q = 0; q < 8; ++q) fa[k][q] = *(const bf16x8_t*)(wp + q * 512);
#pragma unroll
            for (int a4 = 0; a4 < 4; ++a4) ut[k][a4] = *(const vu2*)(up + a4 * 256); };
        auto step = [&](int s, auto KC) { constexpr int k = decltype(KC)::value;
            if (s + 3 < NCH) prefetch(s + 3, std::integral_constant<int, (k + 3) % 4>{});
            const LAS bf16* Sc = SbT + (s & 3) * 32 * GC_KS; LAS bf16* vn = vnT + (s % 3) * 32 * GC_TS;
            f32x16_t acc = zero16(), acc2 = zero16();
#pragma unroll
            for (int qh = 0; qh < 2; ++qh) { bf16x8_t bq[4];
#pragma unroll
                for (int q = 0; q < 4; ++q) bq[q] = *(const LAS bf16x8_t*)(Sc + r32 * GC_KS + 16 * (4 * qh + q) + 8 * hh);
#pragma unroll
                for (int q = 0; q < 4; q += 2) { acc = __builtin_amdgcn_mfma_f32_32x32x16_bf16(fa[k][4 * qh + q], bq[q], acc, 0, 0, 0); acc2 = __builtin_amdgcn_mfma_f32_32x32x16_bf16(fa[k][4 * qh + q + 1], bq[q + 1], acc2, 0, 0, 0); } }
#pragma unroll
            for (int a4 = 0; a4 < 4; ++a4) { const vu2 uw = ut[k][a4];
                *(LAS vu2*)(vn + r32 * GC_TS + 32 * t + 8 * a4 + 4 * hh) = (vu2){cvtpk(bflo(uw.x) - (acc[4 * a4] + acc2[4 * a4]), bfhi(uw.x) - (acc[4 * a4 + 1] + acc2[4 * a4 + 1])), cvtpk(bflo(uw.y) - (acc[4 * a4 + 2] + acc2[4 * a4 + 2]), bfhi(uw.y) - (acc[4 * a4 + 3] + acc2[4 * a4 + 3]))}; }
            LDS_BARRIER(); LDS_BARRIER(); };
        prefetch(0, I0{}); prefetch(1, I1{}); prefetch(2, I2{});
        for (int s = 0; s < NCH; s += 4) { step(s, I0{}); step(s + 1, I1{}); step(s + 2, I2{}); step(s + 3, I3{}); }
        __builtin_amdgcn_s_setprio(0);
    } else if (wave >= 4) {
        __builtin_amdgcn_s_setprio(3);
        int tr = tid; asm volatile("" : "+v"(tr)); const int ln = tr & 63, rr = (tr >> 6) & 3;
        int zl = 0; asm volatile("v_mov_b32 %0, 0" : "=v"(zl));
        bf16x8_t fb[8][4]; float gl[8] = {0.f, 0.f, 0.f, 0.f, 0.f, 0.f, 0.f, 0.f}; f32x16_t S = zero16();
        auto prefetch = [&](int s, auto KC2) { constexpr int k = decltype(KC2)::value; const size_t u = unit_of(s);
            const bf16* kp = p.GKdT + u * 128 * 64 + (size_t)(rr * 256 + ln) * 8;
#pragma unroll
            for (int q = 0; q < 4; ++q) fb[k][q] = *(const bf16x8_t*)(kp + q * 512);
            gl[k] = p.GGL[u + zl]; };
        auto step = [&](int s, auto KC) { constexpr int k = decltype(KC)::value;
            if (s + 7 < NCH) prefetch(s + 7, std::integral_constant<int, (k + 7) % 8>{});
            const LAS bf16* vn = vnT + (s % 3) * 32 * GC_TS; LAS bf16* Sn = SbT + ((s + 1) & 3) * 32 * GC_KS;
            const float g1 = gl[k];
#pragma unroll
            for (int e = 0; e < 16; ++e) S[e] *= g1;
            LDS_BARRIER();
            bf16x8_t bq[4];
#pragma unroll
            for (int q = 0; q < 4; ++q) bq[q] = *(const LAS bf16x8_t*)(vn + r32 * GC_TS + 16 * q + 8 * hh);
#pragma unroll
            for (int q = 0; q < 4; ++q) S = __builtin_amdgcn_mfma_f32_32x32x16_bf16(fb[k][q], bq[q], S, 0, 0, 0);
#pragma unroll
            for (int a4 = 0; a4 < 4; ++a4) *(LAS vu2*)(Sn + r32 * GC_KS + 32 * rr + 8 * a4 + 4 * hh) = (vu2){cvtpk(S[4 * a4], S[4 * a4 + 1]), cvtpk(S[4 * a4 + 2], S[4 * a4 + 3])};
            LDS_BARRIER(); };
        using I4 = std::integral_constant<int, 4>; using I5 = std::integral_constant<int, 5>; using I6 = std::integral_constant<int, 6>; using I7 = std::integral_constant<int, 7>;
        prefetch(0, I0{}); prefetch(1, I1{}); prefetch(2, I2{}); prefetch(3, I3{}); prefetch(4, I4{}); prefetch(5, I5{}); prefetch(6, I6{});
        for (int s = 0; s + 7 < NCH; s += 8) { step(s, I0{}); step(s + 1, I1{}); step(s + 2, I2{}); step(s + 3, I3{}); step(s + 4, I4{}); step(s + 5, I5{}); step(s + 6, I6{}); step(s + 7, I7{}); }
        step(NCH - 4, I0{}); step(NCH - 3, I1{}); step(NCH - 2, I2{}); step(NCH - 1, I3{});
        __builtin_amdgcn_s_setprio(0);
    } else {
        int tr = tid; asm volatile("" : "+v"(tr)); const int ln = tr & 63, t = (tr >> 6) & 1;
        bf16x8_t fa[3][8], fb[3][4];
        auto prefetch = [&](int s, auto KC2) { constexpr int k = decltype(KC2)::value; const size_t u = unit_of(s);
            const bf16* qp = p.GQd + u * 64 * 128 + (size_t)(t * 512 + ln) * 8; const bf16* ap = p.GA + u * 64 * 64 + (size_t)(t * 256 + ln) * 8;
#pragma unroll
            for (int q = 0; q < 8; ++q) fa[k][q] = *(const bf16x8_t*)(qp + q * 512);
#pragma unroll
            for (int q = 0; q < 4; ++q) fb[k][q] = *(const bf16x8_t*)(ap + q * 512); };
        auto out_of = [&](int so, auto KC) { constexpr int k = decltype(KC)::value;
            const LAS bf16* Sc = SbT + (so & 3) * 32 * GC_KS; const LAS bf16* vn = vnT + (so % 3) * 32 * GC_TS;
            f32x16_t acc = zero16(), acc2 = zero16();
#pragma unroll
            for (int qh = 0; qh < 2; ++qh) { bf16x8_t bq[4];
#pragma unroll
                for (int q = 0; q < 4; ++q) bq[q] = *(const LAS bf16x8_t*)(Sc + r32 * GC_KS + 16 * (4 * qh + q) + 8 * hh);
#pragma unroll
                for (int q = 0; q < 4; q += 2) { acc = __builtin_amdgcn_mfma_f32_32x32x16_bf16(fa[k][4 * qh + q], bq[q], acc, 0, 0, 0); acc2 = __builtin_amdgcn_mfma_f32_32x32x16_bf16(fa[k][4 * qh + q + 1], bq[q + 1], acc2, 0, 0, 0); } }
            { bf16x8_t bv[4];
#pragma unroll
              for (int q = 0; q < 4; ++q) bv[q] = *(const LAS bf16x8_t*)(vn + r32 * GC_TS + 16 * q + 8 * hh);
#pragma unroll
              for (int q = 0; q < 4; q += 2) { acc = __builtin_amdgcn_mfma_f32_32x32x16_bf16(fb[k][q], bv[q], acc, 0, 0, 0); acc2 = __builtin_amdgcn_mfma_f32_32x32x16_bf16(fb[k][q + 1], bv[q + 1], acc2, 0, 0, 0); } }
            const int r0 = chunk_row0(b, chunk_of(so));
#pragma unroll
            for (int e = 0; e < 16; ++e) acc[e] += acc2[e];
            store_tile_rows(acc, otile, lane, [&](int il) { const int i = 32 * t + il; return p.OGb + ((size_t)dir * MROWS + r0 + (dir ? 63 - i : i)) * MIX_W + h * 128 + slice * 32; }); };
        auto step = [&](int s, auto KC) { constexpr int k = decltype(KC)::value;
            if (s > 1) out_of(s - 2, std::integral_constant<int, (k + 1) % 3>{});
            if (s + 1 < NCH) prefetch(s + 1, std::integral_constant<int, (k + 1) % 3>{});
            LDS_BARRIER(); LDS_BARRIER(); };
        prefetch(0, I0{});
        for (int s = 0; s + 2 < NCH; s += 3) { step(s, I0{}); step(s + 1, I1{}); step(s + 2, I2{}); }
        step(NCH - 2, std::integral_constant<int, (NCH - 2) % 3>{}); step(NCH - 1, std::integral_constant<int, (NCH - 1) % 3>{});
        out_of(NCH - 2, std::integral_constant<int, (NCH - 2) % 3>{}); out_of(NCH - 1, std::integral_constant<int, (NCH - 1) % 3>{});
    }
}
static_assert(G1_END <= 146432 && NCH % 8 == 4 && NCH % 3 == 2, "G1 LDS map / scan unroll");

constexpr int SSD_NU = BATCH * NCH * SSM_H * 2;
__device__ __forceinline__ int ssd_unit_index(int b, int c, int hd, int dir) { return ((b * NCH + c) * SSM_H + hd) * 2 + dir; }
constexpr int SL_BN = 0, SL_CN = SL_BN + 64 * GC_KS * 2, SL_CB = SL_CN + 64 * GC_KS * 2, SL_BT = SL_CB + 64 * GC_FS * 4, SL_XT = SL_BT + 128 * GC_TS * 2, SL_M = SL_XT + 256 * GC_TS * 2,
              SL_XW = SL_M + 64 * GC_TS * 2, SL_SM = SL_XW + 2 * 64 * GC_TS * 2, SL_END = SL_SM + 8 * 3 * 64 * 4;
static_assert(SL_END <= 146432, "ssd local LDS map");
constexpr int SSD_LOCAL_UNITS = BATCH * NCH * SSM_G * 2;
__device__ __forceinline__ void ssd_local_unit(const Ptrs& p, LAS unsigned char* lds, int unit, int tid) {
    const int lane = tid & 63, wave = tid >> 6, r32 = lane & 31, hh = lane >> 5;
    const int b = unit / (NCH * SSM_G * 2), c = (unit / (SSM_G * 2)) % NCH, g = (unit >> 1) % SSM_G, hq = unit & 1;
    const int r0 = chunk_row0(b, c), hd0 = g * SSM_HPG + hq * 4;
    LAS bf16* Bn = (LAS bf16*)(lds + SL_BN); LAS bf16* Cn = (LAS bf16*)(lds + SL_CN); LAS float* CBs = (LAS float*)(lds + SL_CB); LAS bf16* BT = (LAS bf16*)(lds + SL_BT);
    LAS bf16* XT = (LAS bf16*)(lds + SL_XT); LAS bf16* Mm = (LAS bf16*)(lds + SL_M); LAS bf16* XwT = (LAS bf16*)(lds + SL_XW); LAS float* sm = (LAS float*)(lds + SL_SM);
#pragma unroll
    for (int it = 0; it < 4; ++it) { const int idx = it * 512 + tid, row = idx >> 5, which = (idx >> 4) & 1, c8 = idx & 15;
        *(LAS vu4*)((which ? Cn : Bn) + row * GC_KS + c8 * 8) = *(const vu4*)(p.SBCb + (size_t)(r0 + row) * (2 * SSM_BC) + which * SSM_BC + g * SSM_N + c8 * 8); }
    { vu4 xv[4];
#pragma unroll
        for (int it = 0; it < 4; ++it) { const int idx = it * 512 + tid, j = idx >> 5, p8 = idx & 31; xv[it] = *(const vu4*)(p.SXb + (size_t)(r0 + j) * MIX_W + hd0 * SSM_P + p8 * 8); }
#pragma unroll
        for (int it = 0; it < 4; ++it) { const int idx = it * 512 + tid, j = idx >> 5, p8 = idx & 31; const unsigned w4[4] = {xv[it].x, xv[it].y, xv[it].z, xv[it].w};
#pragma unroll
            for (int e = 0; e < 4; ++e) { XT[(8 * p8 + 2 * e) * GC_TS + j] = (bf16)(w4[e] & 0xffffu); XT[(8 * p8 + 2 * e + 1) * GC_TS + j] = (bf16)(w4[e] >> 16); } } }
    { const int hd = hd0 + (wave >> 1), dir = wave & 1, n = dir ? 63 - lane : lane; const size_t gi = (size_t)(r0 + n) * 2 * SSM_H + dir * SSM_H + hd; const int u = ssd_unit_index(b, c, hd, dir);
        float x = p.SA[gi]; const float dt = p.SDT[gi];
#pragma unroll
        for (int o = 1; o < 64; o <<= 1) { const float y = __shfl_up(x, o); if (lane >= o) x += y; }
        const float x63 = __shfl(x, 63);
        sm[(wave * 3 + 0) * 64 + lane] = x; sm[(wave * 3 + 1) * 64 + lane] = dt; sm[(wave * 3 + 2) * 64 + lane] = __expf(x63 - x) * dt;
        p.SEAb[(size_t)u * 64 + lane] = f2bf(__expf(x)); if (lane == 63) p.SDC[u] = __expf(x); }
    LDS_BARRIER();
    *(vu4*)(p.SCF + ((((size_t)(b * NCH + c) * SSM_G + g) * 2 + hq) * 8 + wave) * 512 + lane * 8) = *(const LAS vu4*)(Cn + (32 * hq + r32) * GC_KS + 16 * wave + 8 * hh);
    if (wave < 4) { const int mt = wave >> 1, nt = wave & 1; f32x16_t acc = zero16(); acc = mma_lds<8>(acc, Cn + 32 * mt * GC_KS, GC_KS, Bn + 32 * nt * GC_KS, GC_KS, r32, hh);
#pragma unroll
        for (int e = 0; e < 16; ++e) CBs[(32 * mt + (e & 3) + 8 * (e >> 2) + 4 * hh) * GC_FS + 32 * nt + r32] = acc[e]; }
    else { for (int it = tid - 256; it < 128 * 8; it += 256) { const int s = it >> 3, j8 = it & 7; unsigned w[4];
#pragma unroll
            for (int e2 = 0; e2 < 4; ++e2) w[e2] = (unsigned)Bn[(j8 * 8 + 2 * e2) * GC_KS + s] | ((unsigned)Bn[(j8 * 8 + 2 * e2 + 1) * GC_KS + s] << 16);
            *(LAS vu4*)(BT + s * GC_TS + j8 * 8) = (vu4){w[0], w[1], w[2], w[3]}; } }
    LDS_BARRIER();
#pragma unroll 1
    for (int hl = 0; hl < 4; ++hl) {
        const int hd = hd0 + hl;
        const LAS float* ac0 = sm + (hl * 2 * 3) * 64; const LAS float* ac1 = ac0 + 3 * 64;
        { const int n = tid >> 3, n8 = tid & 7; unsigned w[4];
            const float a0n = ac0[n], a1n = ac1[63 - n];
#pragma unroll
            for (int e2 = 0; e2 < 4; ++e2) { float a[2];
#pragma unroll
                for (int q = 0; q < 2; ++q) { const int nj = n8 * 8 + 2 * e2 + q; const bool lo = nj <= n;
                    const float ex = __expf(lo ? a0n - ac0[nj] : a1n - ac1[63 - nj]);
                    const float dd = (nj < n) ? ac0[64 + nj] : (nj > n) ? ac1[64 + 63 - nj] : ac0[64 + nj] + ac1[64 + 63 - nj];
                    a[q] = CBs[n * GC_FS + nj] * ex * dd; }
                w[e2] = cvtpk(a[0], a[1]); }
            *(LAS vu4*)(Mm + n * GC_TS + n8 * 8) = (vu4){w[0], w[1], w[2], w[3]};
            const int pp = tid >> 3; float xs[8]; unpack8(*(const LAS vu4*)(XT + (hl * 64 + pp) * GC_TS + n8 * 8), xs);
#pragma unroll
            for (int e2 = 0; e2 < 4; ++e2) { const int nj = n8 * 8 + 2 * e2; w[e2] = cvtpk(xs[2 * e2] * ac0[128 + nj], xs[2 * e2 + 1] * ac0[128 + nj + 1]); }
            *(LAS vu4*)(XwT + pp * GC_TS + n8 * 8) = (vu4){w[0], w[1], w[2], w[3]};
#pragma unroll
            for (int e2 = 0; e2 < 4; ++e2) { const int nj = n8 * 8 + 2 * e2; w[e2] = cvtpk(xs[2 * e2] * ac1[128 + 63 - nj], xs[2 * e2 + 1] * ac1[128 + 62 - nj]); }
            *(LAS vu4*)(XwT + (64 + pp) * GC_TS + n8 * 8) = (vu4){w[0], w[1], w[2], w[3]}; }
        LDS_BARRIER();
#pragma unroll
        for (int dir = 0; dir < 2; ++dir) { const int sb = wave >> 1, pb = wave & 1, u = ssd_unit_index(b, c, hd, dir); f32x16_t acc = zero16();
            acc = mma_lds<4>(acc, BT + 32 * sb * GC_TS, GC_TS, XwT + (64 * dir + 32 * pb) * GC_TS, GC_TS, r32, hh);
            bf16* dst = p.SSC + (((size_t)u * 8 + wave) * 64 + lane) * 16;
            *(vu4*)dst = (vu4){cvtpk(acc[0], acc[1]), cvtpk(acc[2], acc[3]), cvtpk(acc[4], acc[5]), cvtpk(acc[6], acc[7])};
            *(vu4*)(dst + 8) = (vu4){cvtpk(acc[8], acc[9]), cvtpk(acc[10], acc[11]), cvtpk(acc[12], acc[13]), cvtpk(acc[14], acc[15])}; }
        if (wave < 4) { const int mt = wave >> 1, pb = wave & 1; f32x16_t acc = zero16(); acc = mma_lds<4>(acc, Mm + 32 * mt * GC_TS, GC_TS, XT + (hl * 64 + 32 * pb) * GC_TS, GC_TS, r32, hh);
#pragma unroll
            for (int e = 0; e < 16; ++e) { const int n = 32 * mt + (e & 3) + 8 * (e >> 2) + 4 * hh;
                p.OSb[((size_t)r0 + n) * MIX_W + hd * SSM_P + 32 * pb + r32] = f2bf(acc[e]); } }
        LDS_BARRIER();
    }
}
__device__ __forceinline__ void ssd_scan_wg(const Ptrs& p, LAS unsigned char* lds, int chain, int tid) {
    const int b = chain / (SSM_H * 2), hd = (chain >> 1) % SSM_H, dir = chain & 1, g = hd / SSM_HPG;
    const int lane = tid & 63, wave = tid >> 6, r32 = lane & 31, hh = lane >> 5;
    int zl = 0; asm volatile("v_mov_b32 %0, 0" : "=v"(zl));
    LAS bf16* hT = (LAS bf16*)lds;
    for (int i = tid; i < 64 * GC_KS / 2; i += 512) ((LAS unsigned*)hT)[i] = 0u;
    LDS_BARRIER();
    auto chunk_of = [&](int s) { return s < NCH_CTX ? (dir ? NCH_CTX - 1 - s : s) : NCH_CTX + (dir ? NCH - NCH_CTX - 1 - (s - NCH_CTX) : s - NCH_CTX); };
    using I0 = std::integral_constant<int, 0>; using I1 = std::integral_constant<int, 1>; using I2 = std::integral_constant<int, 2>; using I3 = std::integral_constant<int, 3>;
    if (wave >= 4) {
        __builtin_amdgcn_s_setprio(3);
        const int hw = wave - 4;
        f32x16_t h0 = zero16(), h1 = zero16();
        vu4 sc[4][4]; float dec[4] = {0.f, 0.f, 0.f, 0.f};
        auto pre_h = [&](int s, auto KC2) { constexpr int k = decltype(KC2)::value; const size_t u = (size_t)ssd_unit_index(b, chunk_of(s), hd, dir);
            const bf16* sp = p.SSC + ((u * 8 + 2 * hw) * 64 + lane) * 16; sc[k][0] = *(const vu4*)sp; sc[k][1] = *(const vu4*)(sp + 8); sc[k][2] = *(const vu4*)(sp + 1024); sc[k][3] = *(const vu4*)(sp + 1024 + 8); dec[k] = p.SDC[u + zl]; };
        auto step = [&](int s, auto KC) { constexpr int k = decltype(KC)::value;
            const unsigned w0[8] = {sc[k][0].x, sc[k][0].y, sc[k][0].z, sc[k][0].w, sc[k][1].x, sc[k][1].y, sc[k][1].z, sc[k][1].w}, w1[8] = {sc[k][2].x, sc[k][2].y, sc[k][2].z, sc[k][2].w, sc[k][3].x, sc[k][3].y, sc[k][3].z, sc[k][3].w};
            const float d1 = dec[k];
#pragma unroll
            for (int e2 = 0; e2 < 8; ++e2) { h0[2 * e2] = h0[2 * e2] * d1 + bflo(w0[e2]); h0[2 * e2 + 1] = h0[2 * e2 + 1] * d1 + bfhi(w0[e2]); h1[2 * e2] = h1[2 * e2] * d1 + bflo(w1[e2]); h1[2 * e2 + 1] = h1[2 * e2 + 1] * d1 + bfhi(w1[e2]); }
            if (s + 3 < NCH) pre_h(s + 3, std::integral_constant<int, (k + 3) % 4>{});
            LAS bf16* Hn = hT + ((s + 1) & 3) * 64 * GC_KS;
#pragma unroll
            for (int a4 = 0; a4 < 4; ++a4) { *(LAS vu2*)(Hn + r32 * GC_KS + 32 * hw + 8 * a4 + 4 * hh) = (vu2){cvtpk(h0[4 * a4], h0[4 * a4 + 1]), cvtpk(h0[4 * a4 + 2], h0[4 * a4 + 3])};
                *(LAS vu2*)(Hn + (32 + r32) * GC_KS + 32 * hw + 8 * a4 + 4 * hh) = (vu2){cvtpk(h1[4 * a4], h1[4 * a4 + 1]), cvtpk(h1[4 * a4 + 2], h1[4 * a4 + 3])}; }
            LDS_BARRIER(); };
        pre_h(0, I0{}); pre_h(1, I1{}); pre_h(2, I2{});
        for (int s = 0; s < NCH; s += 4) { step(s, I0{}); step(s + 1, I1{}); step(s + 2, I2{}); step(s + 3, I3{}); }
        __builtin_amdgcn_s_setprio(0);
    } else {
        const int mt = wave >> 1, pb = wave & 1;
        LAS bf16* otile = hT + 4 * 64 * GC_KS + wave * 32 * 40;
        bf16x8_t cf[3][8]; vu2 ea[3][4];
        auto pre_y = [&](int s, auto KC2) { constexpr int k = decltype(KC2)::value; const int c = chunk_of(s); const size_t u = (size_t)ssd_unit_index(b, c, hd, dir); const int r0 = chunk_row0(b, c);
            const bf16* cp = p.SCF + ((((size_t)(b * NCH + c) * SSM_G + g) * 2 + (dir ? 1 - mt : mt)) * 8) * 512 + (hh * 32 + (dir ? 31 - r32 : r32)) * 8;
#pragma unroll
            for (int q = 0; q < 8; ++q) cf[k][q] = *(const bf16x8_t*)(cp + q * 512);
#pragma unroll
            for (int a4 = 0; a4 < 4; ++a4) ea[k][a4] = *(const vu2*)(p.SEAb + u * 64 + 32 * mt + 8 * a4 + 4 * hh); };
        auto out_y = [&](int so, auto KC) { constexpr int k = decltype(KC)::value;
            const LAS bf16* Hc = hT + (so & 3) * 64 * GC_KS;
            f32x16_t acc = zero16(), acc2 = zero16();
#pragma unroll
            for (int qh = 0; qh < 2; ++qh) { bf16x8_t bq[4];
#pragma unroll
                for (int q = 0; q < 4; ++q) bq[q] = *(const LAS bf16x8_t*)(Hc + (32 * pb + r32) * GC_KS + 16 * (4 * qh + q) + 8 * hh);
#pragma unroll
                for (int q = 0; q < 4; q += 2) { acc = __builtin_amdgcn_mfma_f32_32x32x16_bf16(cf[k][4 * qh + q], bq[q], acc, 0, 0, 0); acc2 = __builtin_amdgcn_mfma_f32_32x32x16_bf16(cf[k][4 * qh + q + 1], bq[q + 1], acc2, 0, 0, 0); } }
            const int r0 = chunk_row0(b, chunk_of(so));
#pragma unroll
            for (int e = 0; e < 16; ++e) { const unsigned ew = (e & 2) ? ea[k][e >> 2].y : ea[k][e >> 2].x; const float ev = (e & 1) ? bfhi(ew) : bflo(ew); acc[e] = ev * (acc[e] + acc2[e]); }
            store_tile_rows(acc, otile, lane, [&](int il) { const int i = 32 * mt + il; return p.OSb2 + ((size_t)dir * MROWS + r0 + (dir ? 63 - i : i)) * MIX_W + hd * SSM_P + 32 * pb; }); };
        auto step = [&](int s, auto KC) { constexpr int k = decltype(KC)::value;
            if (s > 1) out_y(s - 2, std::integral_constant<int, (k + 1) % 3>{});
            if (s + 1 < NCH) pre_y(s + 1, std::integral_constant<int, (k + 1) % 3>{});
            LDS_BARRIER(); };
        pre_y(0, I0{});
        for (int s = 0; s + 2 < NCH; s += 3) { step(s, I0{}); step(s + 1, I1{}); step(s + 2, I2{}); }
        step(NCH - 2, std::integral_constant<int, (NCH - 2) % 3>{}); step(NCH - 1, std::integral_constant<int, (NCH - 1) % 3>{});
        out_y(NCH - 2, std::integral_constant<int, (NCH - 2) % 3>{}); out_y(NCH - 1, std::integral_constant<int, (NCH - 1) % 3>{});
    }
}


namespace pg8 {
struct EpiInProj {
    static constexpr bool PERM = true, AFTER_DRAIN = false, KHOOK = false;
    bf16_t* P; float* PF;
    __device__ __forceinline__ void operator()(const f32x4 (&acc)[2][2][4][2], const Unit& u, int wr, int wc, int fr, int fq) const {
        const int row0 = u.pm * BM + wr * 64 + fr;
        if (u.pn * BM < NP_MAIN) {
            const int col0 = u.pn * BM + wc * 32 + 8 * fq;
#pragma unroll
            for (int ai = 0; ai < 2; ++ai)
#pragma unroll
                for (int m = 0; m < 4; ++m) { bf16_t* rowp = P + (size_t)(row0 + ai * HALF + m * 16) * NP_MAIN + col0;
#pragma unroll
                    for (int bj = 0; bj < 2; ++bj) { const f32x4 v0 = acc[ai][bj][m][0], v1 = acc[ai][bj][m][1];
                        u32x4 w; w.x = cvt_pk_bf16(v0[0], v0[1]); w.y = cvt_pk_bf16(v0[2], v0[3]); w.z = cvt_pk_bf16(v1[0], v1[1]); w.w = cvt_pk_bf16(v1[2], v1[3]);
                        *(u32x4*)(rowp + bj * HALF) = w; } }
        } else {
#pragma unroll
            for (int ai = 0; ai < 2; ++ai)
#pragma unroll
                for (int m = 0; m < 4; ++m) { float* rowp = PF + (size_t)(row0 + ai * HALF + m * 16) * PF_N;
#pragma unroll
                    for (int bj = 0; bj < 2; ++bj) { const int c = bj * HALF + wc * 32 + 8 * fq;
                        if (c < PF_N) { *(f32x4*)(rowp + c) = acc[ai][bj][m][0]; *(f32x4*)(rowp + c + 4) = acc[ai][bj][m][1]; } } }
        }
    }
};
struct EpiMerge {
    static constexpr bool PERM = true, AFTER_DRAIN = false, KHOOK = false;
    const bf16_t* G0; bf16_t* TB;
    __device__ __forceinline__ void operator()(const f32x4 (&acc)[2][2][4][2], const Unit& u, int wr, int wc, int fr, int fq) const {
        const int row0 = u.pm * BM + wr * 64 + fr, col0 = u.pn * BM + wc * 32 + 8 * fq, br = u.pk / MIX_W; const bf16_t* G = G0 + br * D_MODEL;
#pragma unroll
        for (int ai = 0; ai < 2; ++ai)
#pragma unroll
            for (int m = 0; m < 4; ++m) { const size_t row = (size_t)(row0 + ai * HALF + m * 16);
#pragma unroll
                for (int bj = 0; bj < 2; ++bj) { const int col = col0 + bj * HALF;
                    const u32x4 gw = *(const u32x4*)(G + row * NP_MAIN + col);
                    float gt[8];
#pragma unroll
                    for (int j = 0; j < 4; ++j) { gt[2 * j] = __uint_as_float(gw[j] << 16); gt[2 * j + 1] = __uint_as_float(gw[j] & 0xffff0000u); }
                    f32x4 t0, t1;
#pragma unroll
                    for (int j = 0; j < 4; ++j) { t0[j] = acc[ai][bj][m][0][j] * __builtin_amdgcn_rcpf(1.0f + __expf(-gt[j])); t1[j] = acc[ai][bj][m][1][j] * __builtin_amdgcn_rcpf(1.0f + __expf(-gt[4 + j])); }
                    u32x4 w; w.x = cvt_pk_bf16(t0[0], t0[1]); w.y = cvt_pk_bf16(t0[2], t0[3]); w.z = cvt_pk_bf16(t1[0], t1[1]); w.w = cvt_pk_bf16(t1[2], t1[3]);
                    *(u32x4*)(TB + ((size_t)br * NCTX + (row - NLAT)) * D_MODEL + col) = w; } }
    }
};
struct EpiF32Plain {
    static constexpr bool PERM = false, AFTER_DRAIN = false, KHOOK = false;
    float* C; int ldc;
    __device__ __forceinline__ void operator()(const f32x4 (&acc)[2][2][4][2], const Unit& u, int wr, int wc, int fr, int fq) const {
        const int row0 = u.pm * BM + wr * 64 + fr, col0 = u.pn * BM + wc * 32 + 4 * fq;
#pragma unroll
        for (int ai = 0; ai < 2; ++ai)
#pragma unroll
            for (int m = 0; m < 4; ++m) { float* rowp = C + (size_t)(row0 + ai * HALF + m * 16) * ldc + col0;
#pragma unroll
                for (int bj = 0; bj < 2; ++bj)
#pragma unroll
                    for (int n = 0; n < 2; ++n) *(f32x4*)(rowp + bj * HALF + n * 16) = acc[ai][bj][m][n]; }
    }
};
struct EpiBf16Plain {
    static constexpr bool PERM = true, AFTER_DRAIN = false, KHOOK = false;
    bf16_t* O; int ldc;
    __device__ __forceinline__ void operator()(const f32x4 (&acc)[2][2][4][2], const Unit& u, int wr, int wc, int fr, int fq) const {
        const int row0 = u.pm * BM + wr * 64 + fr, col0 = u.pn * BM + wc * 32 + 8 * fq;
#pragma unroll
        for (int ai = 0; ai < 2; ++ai)
#pragma unroll
            for (int m = 0; m < 4; ++m) { bf16_t* rowp = O + (size_t)(row0 + ai * HALF + m * 16) * ldc + col0;
#pragma unroll
                for (int bj = 0; bj < 2; ++bj) { const f32x4 v0 = acc[ai][bj][m][0], v1 = acc[ai][bj][m][1];
                    u32x4 w; w.x = cvt_pk_bf16(v0[0], v0[1]); w.y = cvt_pk_bf16(v0[2], v0[3]); w.z = cvt_pk_bf16(v1[0], v1[1]); w.w = cvt_pk_bf16(v1[2], v1[3]);
                    *(u32x4*)(rowp + bj * HALF) = w; } }
    }
};

struct EpiAct {
    static constexpr bool PERM = true, AFTER_DRAIN = false, KHOOK = false;
    bf16_t* ACT; float* BP; bf16_t* BU; bf16_t* BG; const float* cw; const float* cb;
    __device__ __forceinline__ void operator()(const f32x4 (&acc)[2][2][4][2], const Unit& u, int wr, int wc, int fr, int fq) const {
        const int lp = (fq * 16 + ((fr + 15) & 15)) * 4, ln = (fq * 16 + ((fr + 1) & 15)) * 4;
#pragma unroll
        for (int n = 0; n < 2; ++n) {
            const int j0 = u.pn * 128 + wc * 32 + 8 * fq + 4 * n;
            const f32x4 w0 = *(const f32x4*)(cw + j0), w1 = *(const f32x4*)(cw + D_FF + j0), w2 = *(const f32x4*)(cw + 2 * D_FF + j0), bs = *(const f32x4*)(cb + j0);
#pragma unroll
            for (int ai = 0; ai < 2; ++ai) {
#pragma unroll
                for (int m = 0; m < 4; ++m) {
                    const int row = u.pm * BM + ai * HALF + wr * 64 + m * 16 + fr;
                    const bool hp = !(m == 0 && fr == 0), hn = !(m == 3 && fr == 15);
                    f32x4 gp, gn;
#pragma unroll
                    for (int e = 0; e < 4; ++e) { const float gc = acc[ai][1][m][n][e], gm = acc[ai][1][m > 0 ? m - 1 : 0][n][e], gq = acc[ai][1][m < 3 ? m + 1 : 3][n][e];
                        gp[e] = __int_as_float(__builtin_amdgcn_ds_bpermute(lp, __float_as_int(fr == 15 ? gm : gc)));
                        gn[e] = __int_as_float(__builtin_amdgcn_ds_bpermute(ln, __float_as_int(fr == 0 ? gq : gc))); }
                    const f32x4 g = acc[ai][1][m][n], uu = acc[ai][0][m][n];
                    f32x4 pre = w1 * g + bs;
                    if (hp) pre += w0 * gp;
                    if (hn) pre += w2 * gn;
                    if (hp && hn) {
                        f32x4 a;
#pragma unroll
                        for (int e = 0; e < 4; ++e) a[e] = pre[e] * __builtin_amdgcn_rcpf(1.0f + __expf(-pre[e])) * uu[e];
                        typedef unsigned u32x2 __attribute__((ext_vector_type(2)));
                        u32x2 w; w.x = cvt_pk_bf16(a[0], a[1]); w.y = cvt_pk_bf16(a[2], a[3]);
                        *(u32x2*)(ACT + (size_t)row * D_FF + j0) = w;
                    } else {
                        const size_t bi = (size_t)((row >> 6) * 2 + ((row & 63) == 63 ? 1 : 0)) * D_FF + j0;
                        typedef unsigned u32x2 __attribute__((ext_vector_type(2)));
                        *(f32x4*)(BP + bi) = pre;
                        u32x2 wu; wu.x = cvt_pk_bf16(uu[0], uu[1]); wu.y = cvt_pk_bf16(uu[2], uu[3]); *(u32x2*)(BU + bi) = wu;
                        u32x2 wg; wg.x = cvt_pk_bf16(g[0], g[1]); wg.y = cvt_pk_bf16(g[2], g[3]); *(u32x2*)(BG + bi) = wg;
                    }
                }
            }
        }
    }
};

constexpr int SPLIT_KS = 512, OUT_NS = D_MODEL / SPLIT_KS, DOWN_NS = D_FF / SPLIT_KS;
static_assert(D_MODEL % SPLIT_KS == 0 && D_FF % SPLIT_KS == 0 && NCTX % 256 == 0, "split-K context units");
struct SplitOrder {
    int ns, G, c;
    __device__ __forceinline__ bool next(int i, Unit& u) const { const int L = i * G + c; if (L >= (NCTX / 256) * (D_MODEL / 256) * ns) return false;
        const int ks = L % ns, tile = L / ns; u.pm = NLAT / 256 + tile / (D_MODEL / 256); u.pn = tile % (D_MODEL / 256); u.pk = ks * SPLIT_KS; return true; }
    __device__ __forceinline__ void a_ready(const Unit&) const {}
    __device__ __forceinline__ void done(const Unit&) const {}
};
struct SplitOrder3 {
    int G, c;
    __device__ __forceinline__ bool next(int i, Unit& u) const { const int L = i * G + c; constexpr int NT = (NCTX / 256) * (D_MODEL / 256); if (L >= NT * 3 * OUT_NS) return false;
        const int ks = L % OUT_NS, br = (L / OUT_NS) % 3, tile = L / (3 * OUT_NS); u.pm = br * (NCTX / 256) + tile / (D_MODEL / 256); u.pn = tile % (D_MODEL / 256); u.pk = ks * SPLIT_KS; return true; }
    __device__ __forceinline__ void a_ready(const Unit&) const {}
    __device__ __forceinline__ void done(const Unit&) const {}
};
struct EpiSlab3 {
    static constexpr bool PERM = false, AFTER_DRAIN = false, KHOOK = false;
    float* S;
    __device__ __forceinline__ void operator()(const f32x4 (&acc)[2][2][4][2], const Unit& u, int wr, int wc, int fr, int fq) const {
        const int br = u.pm / (NCTX / 256), ct = u.pm % (NCTX / 256);
        const int row0 = ct * BM + wr * 64 + fr, col0 = u.pn * BM + wc * 32 + 4 * fq; float* base = S + (size_t)(br * OUT_NS + u.pk / SPLIT_KS) * NCTX * D_MODEL;
#pragma unroll
        for (int ai = 0; ai < 2; ++ai)
#pragma unroll
            for (int m = 0; m < 4; ++m) { float* rowp = base + (size_t)(row0 + ai * HALF + m * 16) * D_MODEL + col0;
#pragma unroll
                for (int bj = 0; bj < 2; ++bj)
#pragma unroll
                    for (int n = 0; n < 2; ++n) *(f32x4*)(rowp + bj * HALF + n * 16) = acc[ai][bj][m][n]; }
    }
};

struct EpiMerge3 {
    static constexpr bool PERM = true, AFTER_DRAIN = false, KHOOK = true;
    const bf16_t* G0; bf16_t* MB;
    __device__ __forceinline__ void khook(f32x4 (&acc)[2][2][4][2], const Unit& u, int t, int wr, int wc, int fr, int fq) const {
        if (t != MIX_W / BK && t != 2 * MIX_W / BK) return;
        const int bp = t / (MIX_W / BK) - 1;
        const int row0 = u.pm * BM + wr * 64 + fr, col0 = u.pn * BM + wc * 32 + 8 * fq; const bf16_t* Gp = G0 + bp * D_MODEL;
#pragma unroll
        for (int ai = 0; ai < 2; ++ai) {
            asm volatile("" ::: "memory");
#pragma unroll
            for (int m = 0; m < 4; ++m) { const unsigned rowo = (unsigned)(row0 + ai * HALF + m * 16) * (unsigned)NP_MAIN;
#pragma unroll
                for (int bj = 0; bj < 2; ++bj) { const unsigned off = rowo + (unsigned)(col0 + bj * HALF);
                    const u32x4 gp = *(const u32x4*)(Gp + off), gn = *(const u32x4*)(Gp + D_MODEL + off);
#pragma unroll
                    for (int j = 0; j < 4; ++j) { const float p0 = __uint_as_float(gp[j] << 16), p1 = __uint_as_float(gp[j] & 0xffff0000u), n0 = __uint_as_float(gn[j] << 16), n1 = __uint_as_float(gn[j] & 0xffff0000u);
                        const float r0 = (1.0f + __expf(-n0)) * __builtin_amdgcn_rcpf(1.0f + __expf(-p0)), r1 = (1.0f + __expf(-n1)) * __builtin_amdgcn_rcpf(1.0f + __expf(-p1));
                        if (j < 2) { acc[ai][bj][m][0][2 * j] *= r0; acc[ai][bj][m][0][2 * j + 1] *= r1; } else { acc[ai][bj][m][1][2 * (j - 2)] *= r0; acc[ai][bj][m][1][2 * (j - 2) + 1] *= r1; } } } } }
    }
    __device__ __forceinline__ void operator()(const f32x4 (&acc)[2][2][4][2], const Unit& u, int wr, int wc, int fr, int fq) const {
        const int row0 = u.pm * BM + wr * 64 + fr, col0 = u.pn * BM + wc * 32 + 8 * fq; const bf16_t* G = G0 + 2 * D_MODEL;
#pragma unroll
        for (int ai = 0; ai < 2; ++ai)
#pragma unroll
            for (int m = 0; m < 4; ++m) { const size_t row = (size_t)(row0 + ai * HALF + m * 16);
#pragma unroll
                for (int bj = 0; bj < 2; ++bj) { const int col = col0 + bj * HALF;
                    const u32x4 gw = *(const u32x4*)(G + row * NP_MAIN + col);
                    float gt[8];
#pragma unroll
                    for (int j = 0; j < 4; ++j) { gt[2 * j] = __uint_as_float(gw[j] << 16); gt[2 * j + 1] = __uint_as_float(gw[j] & 0xffff0000u); }
                    f32x4 t0, t1;
#pragma unroll
                    for (int j = 0; j < 4; ++j) { t0[j] = acc[ai][bj][m][0][j] * __builtin_amdgcn_rcpf(1.0f + __expf(-gt[j])); t1[j] = acc[ai][bj][m][1][j] * __builtin_amdgcn_rcpf(1.0f + __expf(-gt[4 + j])); }
                    u32x4 w; w.x = cvt_pk_bf16(t0[0], t0[1]); w.y = cvt_pk_bf16(t0[2], t0[3]); w.z = cvt_pk_bf16(t1[0], t1[1]); w.w = cvt_pk_bf16(t1[2], t1[3]);
                    *(u32x4*)(MB + row * D_MODEL + col) = w; } }
    }
};
struct CtxMergeOrder {
    int c;
    __device__ __forceinline__ bool next(int i, Unit& u) const { if (i > 0 || c >= 3 * (NCTX / 256) * (D_MODEL / 256)) return false;
        const int tile = c / 3; u.pm = NLAT / 256 + tile / (D_MODEL / 256); u.pn = tile % (D_MODEL / 256); u.pk = (c % 3) * MIX_W; return true; }
    __device__ __forceinline__ void a_ready(const Unit&) const {}
    __device__ __forceinline__ void done(const Unit&) const {}
};
struct EpiSlab {
    static constexpr bool PERM = false, AFTER_DRAIN = false, KHOOK = false;
    float* S;
    __device__ __forceinline__ void operator()(const f32x4 (&acc)[2][2][4][2], const Unit& u, int wr, int wc, int fr, int fq) const {
        const int row0 = (u.pm * BM - NLAT) + wr * 64 + fr, col0 = u.pn * BM + wc * 32 + 4 * fq; float* base = S + (size_t)(u.pk / SPLIT_KS) * NCTX * D_MODEL;
#pragma unroll
        for (int ai = 0; ai < 2; ++ai)
#pragma unroll
            for (int m = 0; m < 4; ++m) { float* rowp = base + (size_t)(row0 + ai * HALF + m * 16) * D_MODEL + col0;
#pragma unroll
                for (int bj = 0; bj < 2; ++bj)
#pragma unroll
                    for (int n = 0; n < 2; ++n) *(f32x4*)(rowp + bj * HALF + n * 16) = acc[ai][bj][m][n]; }
    }
};
}

constexpr size_t al256(size_t x) { return (x + 255) & ~(size_t)255; }
constexpr size_t WS_CTL = 0, CTL_BYTES = 1u << 20;
constexpr size_t WS_WIN = WS_CTL + CTL_BYTES;
constexpr size_t WS_WBR = WS_WIN + al256((size_t)DEPTH * NP_PAD * D_MODEL * 2);
constexpr size_t WS_WOUT = WS_WBR + al256((size_t)DEPTH * 3 * D_MODEL * MIX_W * 2);
constexpr size_t WS_WUP = WS_WOUT + al256((size_t)DEPTH * D_MODEL * D_MODEL * 2);
constexpr size_t WS_WDOWN = WS_WUP + al256((size_t)DEPTH * 2 * D_FF * D_MODEL * 2);
constexpr size_t WS_MOD = WS_WDOWN + al256((size_t)DEPTH * D_MODEL * D_FF * 2);
constexpr size_t WS_X = WS_MOD + al256((size_t)DEPTH * (BATCH + 1) * D6 * 4 + GRID_W * 32 * 2 * 4);
constexpr size_t WS_H = WS_X + al256((size_t)MROWS * D_MODEL * 4);
constexpr size_t WS_MIX = WS_H + al256((size_t)MROWS * D_MODEL * 2);
constexpr size_t WS_SLAB = WS_MIX + al256((size_t)MROWS * D_MODEL * 4);
constexpr size_t WS_TB = WS_SLAB + al256((size_t)(D_FF / 512 > 12 ? D_FF / 512 : 12) * NCTX * D_MODEL * 4);
constexpr size_t WS_R = WS_TB + al256((size_t)3 * NCTX * D_MODEL * 2);
constexpr size_t WS_P = WS_R;
constexpr size_t WS_PF = WS_P + al256((size_t)MROWS * NP_MAIN * 2);
constexpr size_t WS_GQKV = WS_PF + al256((size_t)MROWS * PF_N * 4);
#if defined(TOKEN_GDN) || defined(NAIVE_PREP)
constexpr size_t WS_GG = WS_GQKV + al256((size_t)MROWS * 3 * MIX_W * 4);
#else
constexpr size_t WS_GG = WS_GQKV + 256;
#endif
constexpr size_t WS_GB = WS_GG + al256((size_t)MROWS * 2 * GDN_H * 4);
constexpr size_t WS_SXBC = WS_GB + al256((size_t)MROWS * 2 * GDN_H * 4);
#if defined(TOKEN_SSD) || defined(NAIVE_PREP)
constexpr size_t WS_SDT = WS_SXBC + al256((size_t)MROWS * SSM_XBC * 4);
#else
constexpr size_t WS_SDT = WS_SXBC + 256;
#endif
constexpr size_t WS_SA = WS_SDT + al256((size_t)MROWS * 2 * SSM_H * 4);
constexpr size_t WS_AQ = WS_SA + al256((size_t)MROWS * 2 * SSM_H * 4);
#ifdef NAIVE_ATTN
constexpr size_t WS_AK = WS_AQ + al256((size_t)MROWS * MIX_W * 4);
constexpr size_t WS_OG = WS_AK + al256((size_t)MROWS * ATT_HKV * 128 * 4);
#else
constexpr size_t WS_AK = WS_AQ + 256;
constexpr size_t WS_OG = WS_AK + 256;
#endif
#if defined(TOKEN_GDN) || defined(TOKEN_SSD) || defined(NAIVE_MIXOUT)
constexpr size_t WS_OS = WS_OG + al256((size_t)2 * MROWS * MIX_W * 4);
constexpr size_t WS_SC = WS_OS + al256((size_t)2 * MROWS * MIX_W * 4);
#else
constexpr size_t WS_OS = WS_OG + 256;
constexpr size_t WS_SC = WS_OS + 256;
#endif
#ifdef NAIVE_ATTN
constexpr size_t WS_YA = WS_SC + al256((size_t)MROWS * ATT_HQ * SC_LD * 4);
#else
constexpr size_t WS_YA = WS_SC + 256;
#endif
constexpr size_t WS_YB = WS_YA + al256((size_t)MROWS * MIX_W * 2);
constexpr size_t WS_YC = WS_YB + al256((size_t)MROWS * MIX_W * 2);
constexpr size_t WS_M32 = WS_YC + al256((size_t)MROWS * MIX_W * 2);
constexpr size_t WS_MB = WS_M32 + al256((size_t)MROWS * D_MODEL * 4);
constexpr size_t WS_AQB = WS_MB + al256((size_t)MROWS * D_MODEL * 2);
constexpr size_t WS_AKB = WS_AQB + al256((size_t)MROWS * MIX_W * 2);
constexpr size_t GDN_NU_H = (size_t)BATCH * (CHAIN_LEN / 64) * GDN_H * 2;
constexpr size_t WS_GW = WS_AKB + al256((size_t)MROWS * ATT_HKV * 128 * 2);
constexpr size_t WS_GQD = WS_GW + al256(GDN_NU_H * 64 * 128 * 2);
constexpr size_t WS_GKDT = WS_GQD + al256(GDN_NU_H * 64 * 128 * 2);
constexpr size_t WS_GA = WS_GKDT + al256(GDN_NU_H * 128 * 64 * 2);
constexpr size_t WS_GUT = WS_GA + al256(GDN_NU_H * 64 * 64 * 2);
constexpr size_t WS_GGL = WS_GUT + al256(GDN_NU_H * 128 * 64 * 2);
constexpr size_t SSD_NU_H = (size_t)BATCH * (CHAIN_LEN / 64) * SSM_H * 2;
constexpr size_t WS_SBCB = WS_GGL + al256(GDN_NU_H * 4);
constexpr size_t WS_SSC = WS_SBCB + al256((size_t)MROWS * 2 * SSM_BC * 2);
constexpr size_t WS_SEA = WS_SSC + al256(SSD_NU_H * 8 * 64 * 16 * 2);
constexpr size_t WS_SDC = WS_SEA + al256(SSD_NU_H * 64 * 4);
constexpr size_t WS_OGB = WS_SDC + al256(SSD_NU_H * 4);
constexpr size_t WS_OSB = WS_OGB + al256((size_t)2 * MROWS * MIX_W * 2);
constexpr size_t WS_OSB2 = WS_OSB + al256((size_t)2 * MROWS * MIX_W * 2);
constexpr size_t WS_GQKVB = WS_OSB2 + al256((size_t)2 * MROWS * MIX_W * 2);
constexpr size_t WS_SXB = WS_GQKVB + al256((size_t)MROWS * 3 * MIX_W * 2);
constexpr size_t WS_SCF = WS_SXB + al256((size_t)MROWS * MIX_W * 2);
constexpr size_t WS_END_MIX = WS_SCF + al256((size_t)BATCH * (CHAIN_LEN / 64) * SSM_G * 2 * 8 * 512 * 2);
constexpr size_t NBND = (size_t)MROWS / 64 * 2;
constexpr size_t WS_BP = WS_R;
constexpr size_t WS_BU = WS_BP + al256(NBND * D_FF * 4);
constexpr size_t WS_BG = WS_BU + al256(NBND * D_FF * 2);
constexpr size_t WS_ACT = WS_BG + al256(NBND * D_FF * 2);
constexpr size_t WS_END_FFN = WS_ACT + al256((size_t)MROWS * D_FF * 2);
constexpr size_t WS_NEED = WS_END_MIX > WS_END_FFN ? WS_END_MIX : WS_END_FFN;

constexpr int NWAVES = 8, NTHREADS = NWAVES * 64;
#ifndef ATT_EARLY_N
#define ATT_EARLY_N 0
#endif
constexpr int ATT_EARLY = ATT_EARLY_N;
static_assert(ATT_EARLY <= ATT_UNITS_LAT, "early attention units are latent units");
constexpr int RING_BYTES = 131072, LDS_BYTES = 147456, MISC_OFF = LDS_BYTES - 1024;

enum { ST_INPROJ = 0, ST_PREP, ST_G1, ST_MIX, ST_MIXOUT, ST_MERGE, ST_OUT, ST_NORM2, ST_UP, ST_ACT, ST_DOWN, ST_NORM3, NSTEP };
constexpr int STEP0 = 2;
constexpr int TOTAL_STEPS = STEP0 + DEPTH * NSTEP;
#ifndef MK_LAUNCH_MODE
#define MK_LAUNCH_MODE 1
#endif

struct Args { Ptrs p; unsigned* ctl; int step_lo, step_hi; };
typedef const __attribute__((address_space(4))) Args* KArgs;
__device__ __forceinline__ KArgs fresh_args() { KArgs k = (KArgs)__builtin_amdgcn_kernarg_segment_ptr(); asm volatile("" : "+s"(k)); return k; }
#if defined(__HIP_DEVICE_COMPILE__)
#define PTRS() const Ptrs p = fresh_args()->p; int lane; asm volatile("v_mbcnt_lo_u32_b32 %0, -1, 0\n\tv_mbcnt_hi_u32_b32 %0, -1, %0" : "=v"(lane)); const int wave = wave_s; const int tid = wave * 64 + lane; \
    const size_t gtid = (size_t)blockIdx.x * NTHREADS + tid, NT = (size_t)G * NTHREADS; const int gwave = (int)blockIdx.x * NWAVES + wave, NGW = G * NWAVES; (void)lane; (void)wave; (void)gtid; (void)NT; (void)gwave; (void)NGW
#else
#define PTRS() const Ptrs p = a.p; const int tid = 0, lane = 0, wave = 0, gwave = 0, NGW = 1; const size_t gtid = 0, NT = 1; (void)tid; (void)lane; (void)wave; (void)gtid; (void)NT; (void)gwave; (void)NGW
#endif

constexpr int WT_I_IN = (D_MODEL / 64) * (P_IN / 32), WT_I_BR = (MIX_W / 64) * (D_MODEL / 32), WT_I_OUT = (D_MODEL / 64) * (D_MODEL / 32), WT_I_UP = (D_MODEL / 64) * (2 * D_FF / 32), WT_I_DN = (D_FF / 64) * (D_MODEL / 32);
constexpr int WT_I_ALL = WT_I_IN + 3 * WT_I_BR + WT_I_OUT + WT_I_UP + WT_I_DN;
template <class PT> __device__ __forceinline__ void weight_item(const PT& p, int l, int it, LAS float* scr, int lane) {
    int r = it;
    if (r < WT_I_IN) { const int nblk = P_IN / 32, k0 = 64 * (r / nblk), n0 = 32 * (r % nblk);
        transpose_item(p.w_in + (size_t)l * D_MODEL * P_IN, D_MODEL, P_IN, p.Wt_in + (size_t)l * NP_PAD * D_MODEL, k0, n0, inproj_dst_row0(n0), scr, lane); return; } r -= WT_I_IN;
    if (r < 3 * WT_I_BR) { const int br = r / WT_I_BR; r -= br * WT_I_BR; const int nblk = D_MODEL / 32, k0 = 64 * (r / nblk), n0 = 32 * (r % nblk);
        const float* w = (br == 0 ? p.w_br_a : br == 1 ? p.w_br_b : p.w_br_c) + (size_t)l * MIX_W * D_MODEL;
        transpose_item(w, 3 * MIX_W, D_MODEL, p.Wt_br + (size_t)l * 3 * D_MODEL * MIX_W + br * MIX_W, k0, n0, n0, scr, lane); return; } r -= 3 * WT_I_BR;
    if (r < WT_I_OUT) { const int nblk = D_MODEL / 32, k0 = 64 * (r / nblk), n0 = 32 * (r % nblk);
        transpose_item(p.w_out + (size_t)l * D_MODEL * D_MODEL, D_MODEL, D_MODEL, p.Wt_out + (size_t)l * D_MODEL * D_MODEL, k0, n0, n0, scr, lane); return; } r -= WT_I_OUT;
    if (r < WT_I_UP) { const int nblk = 2 * D_FF / 32, k0 = 64 * (r / nblk), n0 = 32 * (r % nblk);
        transpose_item(p.w_up + (size_t)l * D_MODEL * 2 * D_FF, D_MODEL, 2 * D_FF, p.Wt_up + (size_t)l * 2 * D_FF * D_MODEL, k0, n0, up_dst_row0(n0), scr, lane); return; } r -= WT_I_UP;
    { const int nblk = D_MODEL / 32, k0 = 64 * (r / nblk), n0 = 32 * (r % nblk);
        transpose_item(p.w_down + (size_t)l * D_FF * D_MODEL, D_FF, D_MODEL, p.Wt_down + (size_t)l * D_MODEL * D_FF, k0, n0, n0, scr, lane); }
}
template <class PT> __device__ __forceinline__ WtDesc weight_desc(const PT& p, int l, int it) {
    int r = it;
    if (r < WT_I_IN) { const int nblk = P_IN / 32, k0 = 64 * (r / nblk), n0 = 32 * (r % nblk); return WtDesc{p.w_in + (size_t)l * D_MODEL * P_IN, p.Wt_in + (size_t)l * NP_PAD * D_MODEL, D_MODEL, P_IN, k0, n0, inproj_dst_row0(n0)}; } r -= WT_I_IN;
    if (r < 3 * WT_I_BR) { const int br = r / WT_I_BR; r -= br * WT_I_BR; const int nblk = D_MODEL / 32, k0 = 64 * (r / nblk), n0 = 32 * (r % nblk);
        const float* w = (br == 0 ? p.w_br_a : br == 1 ? p.w_br_b : p.w_br_c) + (size_t)l * MIX_W * D_MODEL;
        return WtDesc{w, p.Wt_br + (size_t)l * 3 * D_MODEL * MIX_W + br * MIX_W, 3 * MIX_W, D_MODEL, k0, n0, n0}; } r -= 3 * WT_I_BR;
    if (r < WT_I_OUT) { const int nblk = D_MODEL / 32, k0 = 64 * (r / nblk), n0 = 32 * (r % nblk); return WtDesc{p.w_out + (size_t)l * D_MODEL * D_MODEL, p.Wt_out + (size_t)l * D_MODEL * D_MODEL, D_MODEL, D_MODEL, k0, n0, n0}; } r -= WT_I_OUT;
    if (r < WT_I_UP) { const int nblk = 2 * D_FF / 32, k0 = 64 * (r / nblk), n0 = 32 * (r % nblk); return WtDesc{p.w_up + (size_t)l * D_MODEL * 2 * D_FF, p.Wt_up + (size_t)l * 2 * D_FF * D_MODEL, D_MODEL, 2 * D_FF, k0, n0, up_dst_row0(n0)}; } r -= WT_I_UP;
    { const int nblk = D_MODEL / 32, k0 = 64 * (r / nblk), n0 = 32 * (r % nblk); return WtDesc{p.w_down + (size_t)l * D_FF * D_MODEL, p.Wt_down + (size_t)l * D_MODEL * D_FF, D_FF, D_MODEL, k0, n0, n0}; }
}
constexpr int FILL_A0 = ((MROWS / 256) * (NP_PAD / 256)) % 256, FILL_B0 = 3 * (NCTX / 256) * (D_MODEL / 256), FILL_C0 = ((MROWS / 256) * (2 * D_FF / 256)) % 256;
#ifndef FILL_NA
#define FILL_NA 14
#endif
#ifndef FILL_NB
#define FILL_NB 11
#endif
#ifndef FILL_NC
#define FILL_NC 19
#endif
constexpr int fill_min(int a, int b) { return a < b ? a : b; }
constexpr int WT_OWN = WT_I_ALL - WT_I_IN;
#ifndef FILL_NM
#define FILL_NM 512
#endif
constexpr int FILL_MCH = 16;
constexpr int FILL_EA = fill_min((256 - FILL_A0) * 8 * FILL_NA, WT_I_ALL), FILL_EM = fill_min(FILL_EA + FILL_NM * FILL_MCH, WT_I_ALL), FILL_EB = fill_min(FILL_EM + (256 - FILL_B0) * 8 * FILL_NB, WT_I_ALL), FILL_EC = fill_min(FILL_EB + (256 - FILL_C0) * 8 * FILL_NC, WT_I_ALL);
static_assert(FILL_A0 > 0 && FILL_C0 > 0, "fill slots");
static_assert(FILL_EM >= 3 * WT_I_BR && FILL_EB >= 3 * WT_I_BR + WT_I_OUT + WT_I_UP && FILL_EC >= WT_OWN, "a matrix must be complete before the phase that multiplies by it (branch: merge; up: up-projection; down: within the layer)");
static_assert(64 * 33 <= 2176 && 8 * 4352 * 4 <= 146432 - 1024, "fill scratch: two transpose tiles per wave inside the dynamic LDS below the control words");
__device__ __forceinline__ void weight_fill_ws(int l, int seg_b, int seg_e_in, int ws, int nws, LAS unsigned char* lds, int wv) {
#if defined(__HIP_DEVICE_COMPILE__)
    asm volatile("s_waitcnt vmcnt(0)" ::: "memory"); LDS_BARRIER();
    int l_; asm volatile("v_mbcnt_lo_u32_b32 %0, -1, 0\n\tv_mbcnt_hi_u32_b32 %0, -1, %0" : "=v"(l_));
    const int seg_e = (l == DEPTH - 1 && seg_e_in > WT_OWN) ? WT_OWN : seg_e_in;
#define WT_AT(f_) weight_desc(fresh_args()->p, (f_) < WT_OWN ? l : l + 1, (f_) < WT_OWN ? WT_I_IN + (f_) : (f_) - WT_OWN)
    LAS float* scr = (LAS float*)lds + wv * 4352;
    int it = seg_b + ws;
    if (it < seg_e) { float wa[32], wb[32]; WtDesc da = WT_AT(it), db = da; transpose_load(da, l_, wa);
        for (;;) { const int it2 = it + nws; const bool h2 = it2 < seg_e;
            if (h2) { db = WT_AT(it2); transpose_load(db, l_, wb); }
            transpose_finish(da, wa, scr, l_);
            if (!h2) break;
            const int it3 = it2 + nws; const bool h3 = it3 < seg_e;
            if (h3) { da = WT_AT(it3); transpose_load(da, l_, wa); }
            transpose_finish(db, wb, scr + 2176, l_);
            if (!h3) break;
            it = it3; } }
#undef WT_AT
    LDS_BARRIER();
#endif
}
__device__ __forceinline__ void weight_fill(int l, int seg_b, int seg_e, int wg0, LAS unsigned char* lds, int wv) { weight_fill_ws(l, seg_b, seg_e, ((int)blockIdx.x - wg0) * 8 + wv, (256 - wg0) * 8, lds, wv); }
__global__ void __launch_bounds__(NTHREADS, 2) fwd(Args a) {
    extern __shared__ __attribute__((aligned(16))) unsigned char lds_raw[];
    LAS unsigned char* lds = (LAS unsigned char*)lds_raw;
    volatile LAS unsigned* MISC = (volatile LAS unsigned*)(lds + MISC_OFF);
    const int G = gridDim.x;
    const int wave_s = __builtin_amdgcn_readfirstlane((int)threadIdx.x >> 6);
    for (int u = threadIdx.x; u < (LDS_BYTES - MISC_OFF) / 4; u += NTHREADS) ((LAS unsigned*)(lds + MISC_OFF))[u] = 0u;
    __syncthreads();
    const bool multi = (a.step_hi - a.step_lo) > 1;
    if (multi) (void)xcd_barrier_post(a.ctl + 4096, MISC + 8);
#define IN(k) (fresh_args()->step_lo <= (k) && (k) < fresh_args()->step_hi)
#ifdef ONLY_STEP
#define EN(k) ((k) == ONLY_STEP)
#elif defined(SKIP_MASK)
#define EN(k) (!((SKIP_MASK >> (k)) & 1))
#else
#define EN(k) true
#endif
#define SEAM(k) do { if (IN((k) + 1)) { XcdBarrier bl; bl.bar = fresh_args()->ctl + 4096; bl.x = xb_xcc_id(); bl.st = (volatile LAS unsigned*)(lds + MISC_OFF) + 8; xcd_barrier(bl); } } while (0)
#define FOR_ITEMS(i, n) for (size_t i = gtid; i < (size_t)(n); i += NT)
#define FRESH_TID(name) int name; { int l_; asm volatile("v_mbcnt_lo_u32_b32 %0, -1, 0\n\tv_mbcnt_hi_u32_b32 %0, -1, %0" : "=v"(l_)); name = wave_s * 64 + l_; }

    if (EN(0) && IN(0)) {
        PTRS();
        LAS float* scr = (LAS float*)lds + wave * 4096;
        FOR_ITEMS(i, (size_t)GRID_W * 32) { const float ang = (float)(i >> 5) * rope_inv_freq((int)(i & 31)); p.ROPE[2 * i] = cosf(ang); p.ROPE[2 * i + 1] = sinf(ang); }
#ifdef FILL_OFF
        for (int l = 0; l < DEPTH; ++l) for (int it = gwave; it < WT_I_ALL; it += NGW) weight_item(fresh_args()->p, l, it, scr, lane);
#else
        for (int it = gwave; it < WT_I_IN; it += NGW) weight_item(fresh_args()->p, 0, it, scr, lane);
        for (int l = 1; l < DEPTH; ++l) for (int it = FILL_EC - WT_OWN + gwave; it < WT_I_IN; it += NGW) weight_item(fresh_args()->p, l, it, scr, lane);
#endif
        for (int l = 0; l < DEPTH; ++l) {
            { bf16* z = p.Wt_in + ((size_t)l * NP_PAD + NP_MAIN + PF_N) * D_MODEL; const size_t n16 = (size_t)(NP_PAD - NP_MAIN - PF_N) * D_MODEL / 8;
                FOR_ITEMS(i, n16) *(vu4*)(z + i * 8) = (vu4){0u, 0u, 0u, 0u}; }
        }
        __syncthreads();
        LAS float* sl = (LAS float*)lds;
        LAS float* red = sl + 3 * D_MODEL;
        for (int i = tid; i < (BATCH + 1) * D_MODEL; i += NTHREADS) sl[i] = silu_f(i < BATCH * D_MODEL ? p.c[i] : p.c_ctx[i - BATCH * D_MODEL]);
        __syncthreads();
        for (int it = (int)blockIdx.x; it < DEPTH * (D6 / 64); it += G) {
            const int l = it / (D6 / 64), n0 = (it % (D6 / 64)) * 64;
            float acc0 = 0.f, acc1 = 0.f, acc2 = 0.f;
            const float* w = p.w_ada + ((size_t)l * D_MODEL + wave * (D_MODEL / 8)) * D6 + n0 + lane;
            for (int k0 = 0; k0 < D_MODEL / 8; k0 += 32) { float wv[32];
#pragma unroll
                for (int j = 0; j < 32; ++j) wv[j] = __builtin_nontemporal_load(w + (size_t)(k0 + j) * D6);
#pragma unroll
                for (int j = 0; j < 32; ++j) { const int kk = wave * (D_MODEL / 8) + k0 + j; acc0 += sl[kk] * wv[j]; acc1 += sl[D_MODEL + kk] * wv[j]; acc2 += sl[2 * D_MODEL + kk] * wv[j]; } }
            red[(wave * 3 + 0) * 64 + lane] = acc0; red[(wave * 3 + 1) * 64 + lane] = acc1; red[(wave * 3 + 2) * 64 + lane] = acc2;
            __syncthreads();
            if (tid < 192) { const int m = tid >> 6, ln = tid & 63; float s = 0.f;
#pragma unroll
                for (int w8 = 0; w8 < 8; ++w8) s += red[(w8 * 3 + m) * 64 + ln];
                p.MOD[((size_t)l * (BATCH + 1) + m) * D6 + n0 + ln] = s + p.b_ada[(size_t)l * D6 + n0 + ln]; }
            __syncthreads();
        }
        SEAM(0);
    }
    if (EN(1) && IN(1)) {
        PTRS();
        for (int r = gwave; r < MROWS; r += NGW) { vf4 x[NV4]; row_load(r < NLAT ? p.x + (size_t)r * D_MODEL : p.ctx + (size_t)(r - NLAT) * D_MODEL, lane, x);
            norm_h_wave(p, 0, r, 0, lane, x); }
        SEAM(1);
    }

    for (int l = 0; l < DEPTH; ++l) {
        const int sb = STEP0 + l * NSTEP;
        if (sb + NSTEP <= fresh_args()->step_lo || sb >= fresh_args()->step_hi) continue;
        const bool last = (l == DEPTH - 1);
        const int MR = last ? NLAT : MROWS;

        if (EN(2 + ST_INPROJ) && IN(sb + ST_INPROJ)) {
            PTRS();
            pg8::Gemm g{p.H, p.Wt_in + (size_t)l * NP_PAD * D_MODEL, MROWS, NP_PAD, D_MODEL, D_MODEL}; pg8::StaticOrder S; S.init(MROWS, NP_PAD, G, (int)blockIdx.x);
            pg8::EpiInProj E{p.P, p.PF};
            pg8::gemm_phase<pg8::EpiInProj, pg8::StaticOrder, true, true>(lds, g, S, E, tid);
#ifndef FILL_OFF
            if ((int)blockIdx.x >= FILL_A0) weight_fill(l, 0, FILL_EA, FILL_A0, lds, wave_s);
#endif
            SEAM(sb + ST_INPROJ);
        }

        if (EN(2 + ST_PREP) && IN(sb + ST_PREP)) {
            PTRS();
#ifdef NAIVE_PREP
            FOR_ITEMS(i, (size_t)MROWS * 3 * GDN_H) prep_gdn_item(p, l, (int)(i / (3 * GDN_H)), (int)(i % (3 * GDN_H)));
            FOR_ITEMS(i, (size_t)MROWS * 2 * GDN_H) prep_gdn_gb_item(p, l, (int)(i / (2 * GDN_H)), (int)(i % (2 * GDN_H)));
            FOR_ITEMS(i, (size_t)MROWS * SSM_XBC) prep_ssd_item(p, l, (int)(i / SSM_XBC), (int)(i % SSM_XBC));
            FOR_ITEMS(i, (size_t)MROWS * 2 * SSM_H) prep_ssd_dt_item(p, l, (int)(i / (2 * SSM_H)), (int)(i % (2 * SSM_H)));
#else
            for (int it = gwave; it < (MROWS / PREP_RB) * PREP_NPASS; it += NGW) prep_conv_block_wave(p, l, it / PREP_NPASS, it % PREP_NPASS, lane);
#endif
#ifdef NAIVE_ATTN
            FOR_ITEMS(i, (size_t)MROWS * (ATT_HQ + ATT_HKV)) prep_attn_item(p, (int)(i / (ATT_HQ + ATT_HKV)), (int)(i % (ATT_HQ + ATT_HKV)));
#endif
            SEAM(sb + ST_PREP);
        }

        if (EN(2 + ST_G1) && IN(sb + ST_G1)) {
            PTRS();
            {
                constexpr int NG = BATCH * NCH * GDN_H, NS = SSD_LOCAL_UNITS; unsigned* ctr = fresh_args()->ctl + 8192 + 64 * (DEPTH + l);
                for (;;) { if (tid == 0) MISC[16] = __hip_atomic_fetch_add(ctr, 1u, __ATOMIC_RELAXED, __HIP_MEMORY_SCOPE_AGENT);
                    LDS_BARRIER(); const int u = (int)MISC[16]; LDS_BARRIER();
                    if (u >= NG + NS + ATT_EARLY) break;
                    int tl = tid; asm volatile("" : "+v"(tl));
                    if (u < ATT_EARLY) attn_unit(p, l, (LAS bf16*)lds, u, tl);
                    else if (u < ATT_EARLY + NS) ssd_local_unit(p, lds, u - ATT_EARLY, tl); else gdn_g1_unit(p, lds, u - ATT_EARLY - NS, tl); } }
            SEAM(sb + ST_G1);
        }

        if (EN(2 + ST_MIX) && IN(sb + ST_MIX)) {
            PTRS();
            constexpr int N_GDN_WG = BATCH * GDN_H * 2 * 4, N_SSD_WG = BATCH * SSM_H * 2;
            const int wg = (int)blockIdx.x;
#ifdef TOKEN_GDN
            if (wg < N_GDN_WG) gdn_token_wg(p, (LAS float*)lds, wg >> 2, wg & 3, tid);
#else
            if (wg < N_GDN_WG) gdn_scan_wg(p, lds, (wg & 7) + 8 * (wg >> 5), (wg >> 3) & 3, tid);
#endif
#ifdef TOKEN_SSD
            else if (wg < N_GDN_WG + N_SSD_WG) ssd_token_wg(p, (LAS float*)lds, wg - N_GDN_WG, tid);
#else
            else if (wg < N_GDN_WG + N_SSD_WG) ssd_scan_wg(p, lds, wg - N_GDN_WG, tid);
#endif
            {
                const int nu = ATT_UNITS_LAT + (last ? 0 : ATT_UNITS_CTX); unsigned* ctr = fresh_args()->ctl + 8192 + 64 * l;
                for (;;) { if (tid == 0) MISC[16] = ATT_EARLY + __hip_atomic_fetch_add(ctr, 1u, __ATOMIC_RELAXED, __HIP_MEMORY_SCOPE_AGENT);
                    LDS_BARRIER(); const int u = (int)MISC[16]; LDS_BARRIER();
                    if (u >= nu) break;
                    attn_unit(p, l, (LAS bf16*)lds, u, tid); } }
#ifndef FILL_OFF
            {
                constexpr int NCH_M = (FILL_EM - FILL_EA + FILL_MCH - 1) / FILL_MCH; unsigned* ctr = fresh_args()->ctl + 8192 + 64 * (2 * DEPTH + l);
                const int em = (last && FILL_EM > WT_OWN) ? WT_OWN : FILL_EM;
                for (;;) { if (tid == 0) MISC[16] = __hip_atomic_fetch_add(ctr, 1u, __ATOMIC_RELAXED, __HIP_MEMORY_SCOPE_AGENT);
                    LDS_BARRIER(); const int ch = (int)MISC[16]; LDS_BARRIER();
                    const int fb = FILL_EA + ch * FILL_MCH; if (ch >= NCH_M || fb >= em) break;
                    weight_fill_ws(l, fb, fb + FILL_MCH < em ? fb + FILL_MCH : em, wave_s, 8, lds, wave_s); } }
#endif
            SEAM(sb + ST_MIX);
        }

        if (EN(2 + ST_MIXOUT) && IN(sb + ST_MIXOUT)) {
            PTRS();
#ifdef NAIVE_MIXOUT
            FOR_ITEMS(i, (size_t)MROWS * GDN_H) gdn_out_item(p, l, (int)(i / GDN_H), (int)(i % GDN_H));
            FOR_ITEMS(i, (size_t)MROWS * SSM_G) ssd_out_item(p, l, (int)(i / SSM_G), (int)(i % SSM_G));
#else
            for (int r = gwave; r < (last ? NLAT : MROWS); r += NGW) mixout_row_wave(p, l, r, lane);
#endif
            SEAM(sb + ST_MIXOUT);
        }

        if (EN(2 + ST_MERGE) && IN(sb + ST_MERGE)) {
            PTRS();
            { pg8::Gemm g{p.YA, p.Wt_br + (size_t)l * 3 * D_MODEL * MIX_W, NLAT, D_MODEL, 3 * MIX_W, 3 * MIX_W}; pg8::StaticOrder S; S.init(NLAT, D_MODEL, G, (int)blockIdx.x);
              pg8::EpiMerge3 E{p.P + C_MG, p.MB};
              pg8::gemm_phase<pg8::EpiMerge3, pg8::StaticOrder, true, true>(lds, g, S, E, tid); }
            if (!last) { pg8::Gemm g{p.YA, p.Wt_br + (size_t)l * 3 * D_MODEL * MIX_W, MROWS, D_MODEL, MIX_W, 3 * MIX_W}; pg8::CtxMergeOrder S{(int)blockIdx.x};
              pg8::EpiMerge E{p.P + C_MG, p.TB};
              FRESH_TID(tid2); pg8::gemm_phase<pg8::EpiMerge, pg8::CtxMergeOrder, true, true>(lds, g, S, E, tid2); }
#ifndef FILL_OFF
            if ((int)blockIdx.x >= FILL_B0) weight_fill(l, FILL_EM, FILL_EB, FILL_B0, lds, wave_s);
#endif
            SEAM(sb + ST_MERGE);
        }

        if (EN(2 + ST_OUT) && IN(sb + ST_OUT)) {
            PTRS();
            { pg8::Gemm g{p.MB, p.Wt_out + (size_t)l * D_MODEL * D_MODEL, NLAT, D_MODEL, D_MODEL, D_MODEL}; pg8::StaticOrder S; S.init(NLAT, D_MODEL, G, (int)blockIdx.x);
              pg8::EpiBf16Plain E{p.MIXb, D_MODEL};
              pg8::gemm_phase<pg8::EpiBf16Plain, pg8::StaticOrder, true, true>(lds, g, S, E, tid); }
            if (!last) {
                pg8::Gemm g{p.TB, p.Wt_out + (size_t)l * D_MODEL * D_MODEL, 3 * NCTX, D_MODEL, pg8::SPLIT_KS, D_MODEL}; pg8::SplitOrder3 S{G, (int)blockIdx.x};
                pg8::EpiSlab3 E{p.SLAB};
                FRESH_TID(tid2); pg8::gemm_phase<pg8::EpiSlab3, pg8::SplitOrder3, true, true>(lds, g, S, E, tid2); }
            SEAM(sb + ST_OUT);
        }

        if (EN(2 + ST_NORM2) && IN(sb + ST_NORM2)) {
            PTRS();
            for (int r = gwave; r < MR; r += NGW) { int ll = lane; asm volatile("" : "+v"(ll)); vf4 x[NV4]; row_load(l > 0 ? p.X + (size_t)r * D_MODEL : (r < NLAT ? p.x + (size_t)r * D_MODEL : p.ctx + (size_t)(r - NLAT) * D_MODEL), ll, x); resid_wave(p, l, r, 0, ll, x, 3 * pg8::OUT_NS);
                row_store(p.X + (size_t)r * D_MODEL, ll, x); norm_h_wave(p, l, r, 1, ll, x); }
            SEAM(sb + ST_NORM2);
        }

        if (EN(2 + ST_UP) && IN(sb + ST_UP)) {
            PTRS();
            pg8::Gemm g{p.H, p.Wt_up + (size_t)l * 2 * D_FF * D_MODEL, MR, 2 * D_FF, D_MODEL, D_MODEL}; pg8::StaticOrder S; S.init(MR, 2 * D_FF, G, (int)blockIdx.x);
            pg8::EpiAct E{p.ACT, p.BP, p.BU, p.BG, p.ffn_conv_w + (size_t)l * 3 * D_FF, p.ffn_conv_b + (size_t)l * D_FF};
            pg8::gemm_phase<pg8::EpiAct, pg8::StaticOrder, true, true>(lds, g, S, E, tid);
#ifndef FILL_OFF
            if ((int)blockIdx.x >= FILL_C0) weight_fill(l, FILL_EB, FILL_EC, FILL_C0, lds, wave_s);
#endif
            SEAM(sb + ST_UP);
        }

        if (EN(2 + ST_ACT) && IN(sb + ST_ACT)) { PTRS();
            for (int it = (int)gtid; it < (MR / 64 * 2) * (D_FF / 4); it += (int)NT) act_fix_item(p, l, it / (D_FF / 4), (it % (D_FF / 4)) * 4);
            SEAM(sb + ST_ACT); }

        if (EN(2 + ST_DOWN) && IN(sb + ST_DOWN)) {
            PTRS();
            { pg8::Gemm g{p.ACT, p.Wt_down + (size_t)l * D_MODEL * D_FF, NLAT, D_MODEL, D_FF, D_FF}; pg8::StaticOrder S; S.init(NLAT, D_MODEL, G, (int)blockIdx.x);
              pg8::EpiBf16Plain E{p.MIXb, D_MODEL};
              pg8::gemm_phase<pg8::EpiBf16Plain, pg8::StaticOrder, true, true>(lds, g, S, E, tid); }
            if (!last) {
                pg8::Gemm g{p.ACT, p.Wt_down + (size_t)l * D_MODEL * D_FF, MROWS, D_MODEL, pg8::SPLIT_KS, D_FF}; pg8::SplitOrder S{pg8::DOWN_NS, G, (int)blockIdx.x};
                pg8::EpiSlab E{p.SLAB};
                FRESH_TID(tid2); pg8::gemm_phase<pg8::EpiSlab, pg8::SplitOrder, true, true>(lds, g, S, E, tid2); }
            SEAM(sb + ST_DOWN);
        }

        if (EN(2 + ST_NORM3) && IN(sb + ST_NORM3)) {
            PTRS();
            for (int r = gwave; r < (last ? NLAT : MROWS); r += NGW) { int ll = lane; asm volatile("" : "+v"(ll)); vf4 x[NV4]; row_load(p.X + (size_t)r * D_MODEL, ll, x); resid_wave(p, l, r, 1, ll, x, pg8::DOWN_NS);
                if (last) row_store(p.out + (size_t)r * D_MODEL, ll, x);
                else { row_store(p.X + (size_t)r * D_MODEL, ll, x); norm_h_wave(p, l + 1, r, 0, ll, x); } }
            SEAM(sb + ST_NORM3);
        }
    }
#undef IN
#undef SEAM
#undef FOR_ITEMS
}

extern "C" void kernel_launch(void* const* d_in, const int* in_sizes, int n_in, void* d_out, int out_size, void* d_ws, size_t ws_size, hipStream_t stream) {
    static int grid = 0;
    if (grid == 0) {
        if (n_in != 30 || in_sizes[0] != NLAT * D_MODEL || out_size != NLAT * D_MODEL || ws_size < WS_NEED) {
            fprintf(stderr, "kernel_launch: unexpected problem: n_in %d in0 %d out %d ws %zu (need %zu); nothing launched\n", n_in, n_in > 0 ? in_sizes[0] : -1, out_size, ws_size, (size_t)WS_NEED); grid = -1; return; }
        int dev = 0, cus = 0;
        if (hipGetDevice(&dev) != hipSuccess || hipDeviceGetAttribute(&cus, hipDeviceAttributeMultiprocessorCount, dev) != hipSuccess) { grid = -1; return; }
        if (hipFuncSetAttribute((const void*)fwd, hipFuncAttributeMaxDynamicSharedMemorySize, LDS_BYTES) != hipSuccess) { fprintf(stderr, "kernel_launch: hipFuncSetAttribute failed\n"); grid = -1; return; }
        int per_cu = 0;
        if (hipOccupancyMaxActiveBlocksPerMultiprocessor(&per_cu, (const void*)fwd, NTHREADS, LDS_BYTES) != hipSuccess || per_cu < 1) fprintf(stderr, "kernel_launch: occupancy query reports %d\n", per_cu);
        (void)hipGetLastError();
        grid = cus;
        if (grid != 256) { fprintf(stderr, "kernel_launch: built for a 256-CU device (workgroup roles in the mixer phase); got %d; nothing launched\n", cus); grid = -1; return; }
    }
    if (grid < 0) return;
    unsigned char* ws = (unsigned char*)d_ws;
    if (hipMemsetAsync(ws + WS_CTL, 0, CTL_BYTES, stream) != hipSuccess) return;
    Args a{};
    const float** pi = (const float**)&a.p;
    for (int i = 0; i < 30; ++i) pi[i] = (const float*)d_in[i];
    Ptrs& p = a.p;
    p.out = (float*)d_out;
    p.Wt_in = (bf16*)(ws + WS_WIN); p.Wt_br = (bf16*)(ws + WS_WBR); p.Wt_out = (bf16*)(ws + WS_WOUT); p.Wt_up = (bf16*)(ws + WS_WUP); p.Wt_down = (bf16*)(ws + WS_WDOWN);
    p.MOD = (float*)(ws + WS_MOD); p.ROPE = p.MOD + (size_t)DEPTH * (BATCH + 1) * D6; p.X = (float*)(ws + WS_X); p.H = (bf16*)(ws + WS_H); p.MIX = (float*)(ws + WS_MIX); p.MIXb = (bf16*)(ws + WS_MIX);
    p.SLAB = (float*)(ws + WS_SLAB); p.TB = (bf16*)(ws + WS_TB);
    p.OGb = (bf16*)(ws + WS_OGB); p.OSb = (bf16*)(ws + WS_OSB); p.OSb2 = (bf16*)(ws + WS_OSB2); p.GQKVb = (bf16*)(ws + WS_GQKVB); p.SXb = (bf16*)(ws + WS_SXB);
    p.P = (bf16*)(ws + WS_P); p.PF = (float*)(ws + WS_PF); p.GQKV = (float*)(ws + WS_GQKV); p.GG = (float*)(ws + WS_GG); p.GB = (float*)(ws + WS_GB);
    p.SXBC = (float*)(ws + WS_SXBC); p.SDT = (float*)(ws + WS_SDT); p.SA = (float*)(ws + WS_SA); p.AQ = (float*)(ws + WS_AQ); p.AK = (float*)(ws + WS_AK);
    p.OG = (float*)(ws + WS_OG); p.OS = (float*)(ws + WS_OS); p.SC = (float*)(ws + WS_SC); p.YA = (bf16*)(ws + WS_YA); p.YB = p.YA + MIX_W; p.YC = p.YA + 2 * MIX_W;
    p.SBCb = (bf16*)(ws + WS_SBCB); p.SSC = (bf16*)(ws + WS_SSC); p.SEA = (float*)(ws + WS_SEA); p.SEAb = (bf16*)(ws + WS_SEA); p.SDC = (float*)(ws + WS_SDC); p.SCF = (bf16*)(ws + WS_SCF);
    p.GW = (bf16*)(ws + WS_GW); p.GQd = (bf16*)(ws + WS_GQD); p.GKdT = (bf16*)(ws + WS_GKDT); p.GA = (bf16*)(ws + WS_GA); p.GUT = (bf16*)(ws + WS_GUT); p.GGL = (float*)(ws + WS_GGL);
    p.AQb = (bf16*)(ws + WS_AQB); p.AKb = (bf16*)(ws + WS_AKB);
    p.M32 = (float*)(ws + WS_M32); p.MB = (bf16*)(ws + WS_MB); p.UG = nullptr; p.ACT = (bf16*)(ws + WS_ACT); p.BP = (float*)(ws + WS_BP); p.BU = (bf16*)(ws + WS_BU); p.BG = (bf16*)(ws + WS_BG);
    a.ctl = (unsigned*)(ws + WS_CTL);
#if MK_LAUNCH_MODE == 1
    a.step_lo = 0; a.step_hi = TOTAL_STEPS;
    hipLaunchKernelGGL(fwd, dim3(grid), dim3(NTHREADS), LDS_BYTES, stream, a);
#else
    for (int s = 0; s < TOTAL_STEPS; ++s) { a.step_lo = s; a.step_hi = s + 1; hipLaunchKernelGGL(fwd, dim3(grid), dim3(NTHREADS), LDS_BYTES, stream, a); }
#endif
    const hipError_t le = hipPeekAtLastError();
    if (le != hipSuccess) fprintf(stderr, "kernel_launch: launch failed: %s\n", hipGetErrorName(le));
}
```

```cpp
#include <hip/hip_runtime.h>
#include <cstdio>
#include <cstdint>
#include <type_traits>
#define MK_LAUNCH_MODE 1
#define FILL_NA 10
#define FILL_NB 14
#define FILL_NC 4
#define FILL_NM 256
#include <cstdint>
#include <cstddef>
#include <cmath>
#ifdef HOST_TEST
#define HD inline
#define CFENCE() do {} while (0)
#else
#define HD __host__ __device__ __forceinline__
#if defined(__HIP_DEVICE_COMPILE__)
#define CFENCE() asm volatile("" ::: "memory")
#else
#define CFENCE() do {} while (0)
#endif
#endif

#ifndef CFG_SMALL
constexpr int D_MODEL = 2048, BATCH = 2, SEQ = 4096, DEPTH = 4, CTX_LEN = 256, D_FF = 5632;
#else
constexpr int D_MODEL = 1024, BATCH = 2, SEQ = 512, DEPTH = 2, CTX_LEN = 128, D_FF = 512;
#endif
constexpr int GRID_W = 64, WINDOW = 128;
constexpr float EPS = 1e-6f;
constexpr int MIX_W = D_MODEL / 2, GDN_H = MIX_W / 128, SSM_H = MIX_W / 64, SSM_G = 2, SSM_N = 128, SSM_P = 64, SSM_HPG = SSM_H / SSM_G;
constexpr int ATT_HQ = MIX_W / 128, ATT_HKV = 2, ATT_GRP = ATT_HQ / ATT_HKV;
constexpr int SSM_BC = SSM_G * SSM_N, SSM_XBC = MIX_W + 2 * SSM_BC;
constexpr int NLAT = BATCH * SEQ, NCTX = BATCH * CTX_LEN, MROWS = NLAT + NCTX;
constexpr int CHAIN_LEN = CTX_LEN + SEQ;
constexpr int R_QKV = 0, R_GATE = 3 * MIX_W, R_A = 4 * MIX_W, R_B = R_A + 2 * GDN_H, R_Z = R_B + 2 * GDN_H, R_XBC = R_Z + MIX_W, R_DT = R_XBC + SSM_XBC,
              R_AQ = R_DT + 2 * SSM_H, R_AKV = R_AQ + MIX_W, R_MG = R_AKV + 2 * ATT_HKV * 128, P_IN = R_MG + 3 * D_MODEL;
constexpr int C_QKV = 0, C_GATE = 3 * MIX_W, C_Z = 4 * MIX_W, C_XBC = 5 * MIX_W, C_AQ = C_XBC + SSM_XBC, C_AKV = C_AQ + MIX_W, C_MG = C_AKV + 512, NP_MAIN = C_MG + 3 * D_MODEL;
constexpr int PF_A = 0, PF_B = 2 * GDN_H, PF_DT = 4 * GDN_H, PF_N = 4 * GDN_H + 2 * SSM_H;
constexpr int NP_PAD = NP_MAIN + 256;
static_assert(NP_MAIN % 256 == 0 && PF_N <= 256 && MROWS % 256 == 0 && (2 * D_FF) % 256 == 0 && D_FF % 256 == 0, "tile shapes");
static_assert(P_IN == NP_MAIN + PF_N, "column bookkeeping");
constexpr int D6 = 6 * D_MODEL;

typedef unsigned short bf16;
HD float bf2f(bf16 b) { union { unsigned u; float f; } c; c.u = ((unsigned)b) << 16; return c.f; }
HD bf16 f2bf(float f) { union { unsigned u; float f; } c; c.f = f; unsigned u = c.u; u += 0x7FFFu + ((u >> 16) & 1u); return (bf16)(u >> 16); }
HD float silu_f(float x) { return x / (1.0f + expf(-x)); }
HD float sigmoid_f(float x) { return 1.0f / (1.0f + expf(-x)); }
#if defined(__HIP_DEVICE_COMPILE__)
HD float softplus_f(float x) { return x > 20.0f ? x : __logf(1.0f + __expf(x)); }
#else
HD float softplus_f(float x) { return x > 20.0f ? x : log1pf(expf(x)); }
#endif

struct Ptrs {
    const float *x, *c, *ctx, *c_ctx, *w_ada, *b_ada, *g_pre1, *w_in, *gdn_conv_w, *gdn_a_log, *gdn_dt_bias, *gdn_norm, *ssm_conv_w, *ssm_conv_b, *ssm_a_log,
        *ssm_dt_bias, *ssm_d, *ssm_norm, *attn_sink, *w_br_a, *w_br_b, *w_br_c, *w_out, *g_post1, *g_pre2, *w_up, *ffn_conv_w, *ffn_conv_b, *w_down, *g_post2;
    float* out;
    bf16 *Wt_in, *Wt_br, *Wt_out, *Wt_up, *Wt_down;
    float* ROPE;
    float* MOD;
    float* X;
    bf16* H;
    bf16* P;
    float* PF;
    float *GQKV, *GG, *GB;
    float *SXBC, *SDT, *SA;
    float *AQ, *AK;
    bf16 *GW, *GQd, *GKdT, *GA, *GUT; float* GGL;
    bf16 *SBCb, *SSC, *SEAb, *SCF; float *SEA, *SDC;
    bf16 *MIXb, *OGb, *OSb, *OSb2, *GQKVb, *SXb;
    bf16 *AQb, *AKb;
    float *OG, *OS;
    float* SC;
    bf16 *YA, *YB, *YC;
    float* M32;
    bf16* MB;
    float* MIX;
    bf16* UG;
    bf16* ACT;
    bf16* TB;
    float* SLAB;
    float* BP; bf16 *BU, *BG;
};
constexpr int SC_LD = 2 * WINDOW + 1 + CTX_LEN + 3;

HD void row_info(int r, int& b, int& t, int& len, bool& is_ctx) {
    if (r < NLAT) { b = r / SEQ; t = r % SEQ; len = SEQ; is_ctx = false; } else { const int q = r - NLAT; b = q / CTX_LEN; t = q % CTX_LEN; len = CTX_LEN; is_ctx = true; }
}
HD int mod_row(int r) { return r < NLAT ? r / SEQ : BATCH; }

HD int inproj_src_col(int np) {
    if (np < C_Z) return np;
    if (np < NP_MAIN) return np + 4 * GDN_H + (np >= C_AQ ? 2 * SSM_H : 0);
    const int j = np - NP_MAIN;
    if (j < PF_DT) return R_A + j;
    if (j < PF_N) return R_DT + (j - PF_DT);
    return -1;
}
HD void wcvt_item(const float* W, int K, int N, bf16* Wt, int np, int k8, bool inproj) {
    const int n = inproj ? inproj_src_col(np) : np;
    for (int j = 0; j < 8; ++j) { const int k = k8 * 8 + j; Wt[(size_t)np * K + k] = (n < 0) ? (bf16)0 : f2bf(W[(size_t)k * N + n]); }
}

HD void mod_item(const Ptrs& p, int l, int n) {
    float acc[BATCH + 1];
    for (int m = 0; m <= BATCH; ++m) acc[m] = 0.f;
    for (int k = 0; k < D_MODEL; ++k) {
        const float w = p.w_ada[((size_t)l * D_MODEL + k) * D6 + n];
        for (int m = 0; m < BATCH; ++m) acc[m] += silu_f(p.c[m * D_MODEL + k]) * w;
        acc[BATCH] += silu_f(p.c_ctx[k]) * w;
    }
    for (int m = 0; m <= BATCH; ++m) p.MOD[((size_t)l * (BATCH + 1) + m) * D6 + n] = acc[m] + p.b_ada[(size_t)l * D6 + n];
}
HD void xinit_item(const Ptrs& p, size_t i) { p.X[i] = i < (size_t)NLAT * D_MODEL ? p.x[i] : p.ctx[i - (size_t)NLAT * D_MODEL]; }

HD float row_rstd(const float* v, int n) { float s = 0.f; for (int j = 0; j < n; ++j) s += v[j] * v[j]; return 1.0f / sqrtf(s / (float)n + EPS); }
HD void norm_to_h_row(const Ptrs& p, int l, int r, int which) {
    const float* xr = p.X + (size_t)r * D_MODEL; const float* g = (which ? p.g_pre2 : p.g_pre1) + (size_t)l * D_MODEL;
    const float* mod = p.MOD + ((size_t)l * (BATCH + 1) + mod_row(r)) * D6 + (which ? 3 * D_MODEL : 0);
    const float rs = row_rstd(xr, D_MODEL);
    for (int j = 0; j < D_MODEL; ++j) p.H[(size_t)r * D_MODEL + j] = f2bf(xr[j] * rs * g[j] * (1.0f + mod[D_MODEL + j]) + mod[j]);
}
HD void resid_row(const Ptrs& p, int l, int r, int which, bool to_out) {
    const float* yr = p.MIX + (size_t)r * D_MODEL; const float* g = (which ? p.g_post2 : p.g_post1) + (size_t)l * D_MODEL;
    const float* gate = p.MOD + ((size_t)l * (BATCH + 1) + mod_row(r)) * D6 + (which ? 5 * D_MODEL : 2 * D_MODEL);
    const float rs = row_rstd(yr, D_MODEL);
    float* xr = p.X + (size_t)r * D_MODEL;
    for (int j = 0; j < D_MODEL; ++j) { const float v = xr[j] + gate[j] * (yr[j] * rs * g[j]); xr[j] = v; if (to_out && r < NLAT) p.out[(size_t)r * D_MODEL + j] = v; }
}

HD float conv3_p(const Ptrs& p, int r, int col, const float* w, int wld, int j) {
    int b, t, len; bool ic; row_info(r, b, t, len, ic);
    float y = w[wld + j] * bf2f(p.P[(size_t)r * NP_MAIN + col]);
    if (t > 0) y += w[j] * bf2f(p.P[(size_t)(r - 1) * NP_MAIN + col]);
    if (t < len - 1) y += w[2 * wld + j] * bf2f(p.P[(size_t)(r + 1) * NP_MAIN + col]);
    return y;
}
HD void prep_gdn_item(const Ptrs& p, int l, int r, int grp) {
    const float* w = p.gdn_conv_w + (size_t)l * 3 * (3 * MIX_W);
    float sc = 1.0f;
    if (grp < 2 * GDN_H) {
        float ss = 0.f;
        for (int d = 0; d < 128; ++d) { const int j = grp * 128 + d; const float v = silu_f(conv3_p(p, r, C_QKV + j, w, 3 * MIX_W, j)); ss += v * v; }
        sc = 1.0f / sqrtf(ss + EPS); if (grp < GDN_H) sc *= 0.08838834764831845f;
    }
    for (int d = 0; d < 128; ++d) { const int j = grp * 128 + d; p.GQKV[(size_t)r * (3 * MIX_W) + j] = silu_f(conv3_p(p, r, C_QKV + j, w, 3 * MIX_W, j)) * sc; }
}
HD void prep_gdn_gb_item(const Ptrs& p, int l, int r, int j) {
    const float a = p.PF[(size_t)r * PF_N + PF_A + j], bb = p.PF[(size_t)r * PF_N + PF_B + j];
    p.GG[(size_t)r * 2 * GDN_H + j] = -expf(p.gdn_a_log[(size_t)l * 2 * GDN_H + j]) * softplus_f(a + p.gdn_dt_bias[(size_t)l * 2 * GDN_H + j]);
    p.GB[(size_t)r * 2 * GDN_H + j] = sigmoid_f(bb);
}
HD void prep_ssd_item(const Ptrs& p, int l, int r, int j) {
    const float* w = p.ssm_conv_w + (size_t)l * 3 * SSM_XBC;
    p.SXBC[(size_t)r * SSM_XBC + j] = silu_f(conv3_p(p, r, C_XBC + j, w, SSM_XBC, j) + p.ssm_conv_b[(size_t)l * SSM_XBC + j]);
}
HD void prep_ssd_dt_item(const Ptrs& p, int l, int r, int j) {
    const float dt = softplus_f(p.PF[(size_t)r * PF_N + PF_DT + j] + p.ssm_dt_bias[(size_t)l * 2 * SSM_H + j]);
    p.SDT[(size_t)r * 2 * SSM_H + j] = dt; p.SA[(size_t)r * 2 * SSM_H + j] = -expf(p.ssm_a_log[(size_t)l * 2 * SSM_H + j]) * dt;
}
HD float rope_inv_freq(int i) { return exp2f(-(float)i * 0.4152410118609203f); }
HD void prep_attn_item(const Ptrs& p, int r, int hh) {
    int b, t, len; bool ic; row_info(r, b, t, len, ic);
    const bool isq = hh < ATT_HQ; const int h = isq ? hh : hh - ATT_HQ;
    const bf16* src = p.P + (size_t)r * NP_MAIN + (isq ? C_AQ + h * 128 : C_AKV + h * 128);
    float* dst = isq ? p.AQ + (size_t)r * MIX_W + h * 128 : p.AK + (size_t)r * (ATT_HKV * 128) + h * 128;
    if (ic) { for (int d = 0; d < 128; ++d) dst[d] = bf2f(src[d]); return; }
    const float pos[2] = {(float)(t / GRID_W), (float)(t % GRID_W)};
    for (int ax = 0; ax < 2; ++ax)
        for (int i = 0; i < 32; ++i) {
            const float ang = pos[ax] * rope_inv_freq(i), cs = cosf(ang), sn = sinf(ang);
            const float x1 = bf2f(src[ax * 64 + i]), x2 = bf2f(src[ax * 64 + 32 + i]);
            dst[ax * 64 + i] = x1 * cs - x2 * sn; dst[ax * 64 + 32 + i] = x2 * cs + x1 * sn;
        }
}

HD int chain_row(int b, int dir, int s) {
    if (s < CTX_LEN) return NLAT + b * CTX_LEN + (dir ? CTX_LEN - 1 - s : s);
    const int u = s - CTX_LEN; return b * SEQ + (dir ? SEQ - 1 - u : u);
}
HD void gdn_chain_item(const Ptrs& p, int b, int h, int dir, int vc) {
    float S[128];
#pragma unroll
    for (int k = 0; k < 128; ++k) S[k] = 0.f;
    float pf = 0.f;
    for (int s = 0; s < CHAIN_LEN; ++s) {
        const int r = chain_row(b, dir, s);
        const float* q = p.GQKV + (size_t)r * (3 * MIX_W) + h * 128; const float* kk = q + MIX_W; const float vv = q[2 * MIX_W + vc];
        const float a = expf(p.GG[(size_t)r * 2 * GDN_H + dir * GDN_H + h]), be = p.GB[(size_t)r * 2 * GDN_H + dir * GDN_H + h];
        if (s + 1 < CHAIN_LEN) { const float* qn = p.GQKV + (size_t)chain_row(b, dir, s + 1) * (3 * MIX_W) + h * 128;
#pragma unroll
            for (int j = 0; j < 4; ++j) pf += qn[32 * j] + qn[MIX_W + 32 * j]; }
        float ks = 0.f;
#pragma unroll
        for (int c = 0; c < 2; ++c) { float kc[64];
#pragma unroll
            for (int j = 0; j < 64; ++j) kc[j] = kk[64 * c + j];
#pragma unroll
            for (int j = 0; j < 64; ++j) { S[64 * c + j] *= a; ks += kc[j] * S[64 * c + j]; }
            CFENCE(); }
        const float dl = be * (vv - ks); float o = 0.f;
#pragma unroll
        for (int c = 0; c < 4; ++c) { float kc[32], qc[32];
#pragma unroll
            for (int j = 0; j < 32; ++j) { kc[j] = kk[32 * c + j]; qc[j] = q[32 * c + j]; }
#pragma unroll
            for (int j = 0; j < 32; ++j) { S[32 * c + j] += kc[j] * dl; o += qc[j] * S[32 * c + j]; }
            CFENCE(); }
        p.OG[((size_t)dir * MROWS + r) * MIX_W + h * 128 + vc] = o;
    }
    if (pf == 123456.789f) p.OG[0] = pf;
}
HD void ssd_chain_item(const Ptrs& p, int b, int hd, int dir, int pc) {
    float hs[SSM_N];
#pragma unroll
    for (int s = 0; s < SSM_N; ++s) hs[s] = 0.f;
    const int g = hd / SSM_HPG;
    float pf = 0.f;
    for (int s = 0; s < CHAIN_LEN; ++s) {
        const int r = chain_row(b, dir, s);
        const float* xb = p.SXBC + (size_t)r * SSM_XBC; const float* Bm = xb + MIX_W + g * SSM_N; const float* Cm = xb + MIX_W + SSM_BC + g * SSM_N;
        const float dt = p.SDT[(size_t)r * 2 * SSM_H + dir * SSM_H + hd], ea = expf(p.SA[(size_t)r * 2 * SSM_H + dir * SSM_H + hd]);
        const float xd = xb[hd * SSM_P + pc] * dt; float y = 0.f;
        if (s + 1 < CHAIN_LEN) { const float* xn = p.SXBC + (size_t)chain_row(b, dir, s + 1) * SSM_XBC + MIX_W + g * SSM_N;
#pragma unroll
            for (int j = 0; j < 4; ++j) pf += xn[32 * j] + xn[SSM_BC + 32 * j]; }
#pragma unroll
        for (int c = 0; c < 4; ++c) { float bc[32], cc[32];
#pragma unroll
            for (int j = 0; j < 32; ++j) { bc[j] = Bm[32 * c + j]; cc[j] = Cm[32 * c + j]; }
#pragma unroll
            for (int j = 0; j < 32; ++j) { hs[32 * c + j] = ea * hs[32 * c + j] + xd * bc[j]; y += cc[j] * hs[32 * c + j]; }
            CFENCE(); }
        p.OS[((size_t)dir * MROWS + r) * MIX_W + hd * SSM_P + pc] = y;
    }
    if (pf == 123456.789f) p.OS[0] = pf;
}
HD void attn_item(const Ptrs& p, int l, int r, int hq) {
    int b, t, len; bool ic; row_info(r, b, t, len, ic);
    const int hkv = hq / ATT_GRP;
    const float* qp = p.AQ + (size_t)r * MIX_W + hq * 128;
    float* sc = p.SC + ((size_t)r * ATT_HQ + hq) * SC_LD;
    const float sink = p.attn_sink[(size_t)l * ATT_HQ + hq];
    const int lo = ic ? 0 : (t - WINDOW < 0 ? 0 : t - WINDOW), hi = ic ? -1 : (t + WINDOW > SEQ - 1 ? SEQ - 1 : t + WINDOW);
    const int nloc = ic ? 0 : hi - lo + 1, nk = nloc + CTX_LEN;
    float m = sink;
    {
        float q[128];
#pragma unroll
        for (int d = 0; d < 128; ++d) q[d] = qp[d];
        for (int j = 0; j < nk; ++j) {
            const int kr = j < nloc ? b * SEQ + lo + j : NLAT + b * CTX_LEN + (j - nloc);
            const float* kk = p.AK + (size_t)kr * (ATT_HKV * 128) + hkv * 128;
            float s = 0.f;
#pragma unroll
            for (int c = 0; c < 4; ++c) { float kc[32];
#pragma unroll
                for (int d = 0; d < 32; ++d) kc[d] = kk[32 * c + d];
#pragma unroll
                for (int d = 0; d < 32; ++d) s += q[32 * c + d] * kc[d];
                CFENCE(); }
            s *= 0.08838834764831845f; sc[j] = s; m = s > m ? s : m;
        }
    }
    float o[128];
#pragma unroll
    for (int d = 0; d < 128; ++d) o[d] = 0.f;
    float den = expf(sink - m);
    for (int j = 0; j < nk; ++j) {
        const int kr = j < nloc ? b * SEQ + lo + j : NLAT + b * CTX_LEN + (j - nloc);
        const bf16* vv = p.P + (size_t)kr * NP_MAIN + C_AKV + ATT_HKV * 128 + hkv * 128;
        const float e = expf(sc[j] - m); den += e;
#pragma unroll
        for (int c = 0; c < 4; ++c) { float vc[32];
#pragma unroll
            for (int d = 0; d < 32; ++d) vc[d] = bf2f(vv[32 * c + d]);
#pragma unroll
            for (int d = 0; d < 32; ++d) o[32 * c + d] += e * vc[d];
            CFENCE(); }
    }
    const float inv = 1.0f / den;
#pragma unroll
    for (int d = 0; d < 128; ++d) p.YC[(size_t)r * MIX_W + hq * 128 + d] = f2bf(o[d] * inv);
}
HD void gdn_out_item(const Ptrs& p, int l, int r, int h) {
    float ss = 0.f;
    for (int d = 0; d < 128; ++d) { const size_t i = (size_t)r * MIX_W + h * 128 + d; const float v = p.OG[i] + p.OG[(size_t)MROWS * MIX_W + i]; ss += v * v; }
    const float rs = 1.0f / sqrtf(ss / 128.0f + EPS);
    for (int d = 0; d < 128; ++d) { const size_t i = (size_t)r * MIX_W + h * 128 + d; const float v = p.OG[i] + p.OG[(size_t)MROWS * MIX_W + i];
        p.YA[i] = f2bf(v * rs * p.gdn_norm[(size_t)l * 128 + d] * silu_f(bf2f(p.P[(size_t)r * NP_MAIN + C_GATE + h * 128 + d]))); }
}
HD void ssd_out_item(const Ptrs& p, int l, int r, int g) {
    constexpr int GW = MIX_W / SSM_G;
    float ss = 0.f;
    for (int pass = 0; pass < 2; ++pass) {
        const float rs = pass ? 1.0f / sqrtf(ss / (float)GW + EPS) : 0.f;
        for (int jj = 0; jj < GW; ++jj) { const int j = g * GW + jj; const size_t i = (size_t)r * MIX_W + j;
            float y = p.OS[i] + p.OS[(size_t)MROWS * MIX_W + i] + p.ssm_d[(size_t)l * SSM_H + j / SSM_P] * p.SXBC[(size_t)r * SSM_XBC + j];
            y *= silu_f(bf2f(p.P[(size_t)r * NP_MAIN + C_Z + j]));
            if (!pass) ss += y * y; else p.YB[i] = f2bf(y * rs * p.ssm_norm[(size_t)l * MIX_W + j]); }
    }
}
HD void act_item(const Ptrs& p, int l, int r, int j) {
    int b, t, len; bool ic; row_info(r, b, t, len, ic);
    const float* w = p.ffn_conv_w + (size_t)l * 3 * D_FF;
    const bf16* ug = p.UG + (size_t)r * (2 * D_FF);
    float g = w[D_FF + j] * bf2f(ug[D_FF + j]);
    if (t > 0) g += w[j] * bf2f(ug[D_FF + j - 2 * D_FF]);
    if (t < len - 1) g += w[2 * D_FF + j] * bf2f(ug[D_FF + j + 2 * D_FF]);
    g += p.ffn_conv_b[(size_t)l * D_FF + j];
    p.ACT[(size_t)r * D_FF + j] = f2bf(silu_f(g) * bf2f(ug[j]));
}

namespace pg8 {
#define PG8_LAS __attribute__((address_space(3)))
typedef unsigned short bf16_t;
typedef short bf16x8 __attribute__((ext_vector_type(8)));
typedef float f32x4 __attribute__((ext_vector_type(4)));
typedef unsigned u32x4 __attribute__((ext_vector_type(4)));
constexpr int BM = 256, BK = 64, HALF = 128, HTB = HALF * BK * 2  , STAGE_BYTES = 8 * HTB, NXCD = 8, WGM = 8;

__host__ __device__ __forceinline__ int lds_byte(int r, int c) { const int st = (r >> 4) * 2 + (c >> 5), rr = r & 15, cc = c & 31, ob = rr * 64 + cc * 2; return st * 1024 + (ob ^ (((ob >> 9) & 1) << 5)); }
__host__ __device__ __forceinline__ void stage_rc(int b, int& R, int& C) { const int st = b / 1024, sb = b % 1024, swz = sb ^ (((sb >> 9) & 1) << 5); R = (st >> 1) * 16 + swz / 64; C = (st & 1) * 32 + (swz % 64) / 2; }
__host__ __device__ __forceinline__ int perm32(int rho) { const int n = rho >> 4, i = rho & 15; return 8 * (i >> 2) + 4 * n + (i & 3); }

struct Unit { int pm, pn, pk; };
struct Gemm { const bf16_t* A; const bf16_t* Bt; int M, N, K, ld; };

struct StaticOrder {
    int nM, nN, nwg, G, c;
    __host__ __device__ void init(int M, int N, int G_, int c_) { nM = M / BM; nN = N / BM; nwg = nM * nN; G = G_; c = c_; }
    __host__ __device__ bool next(int i, Unit& u) const {
        const long L = (long)i * G + c; if (L >= nwg) return false;
        int wgid = (int)L; { const int q = nwg / NXCD, r = nwg % NXCD, xcd = wgid % NXCD, off = wgid / NXCD; wgid = (xcd < r ? xcd * (q + 1) : r * (q + 1) + (xcd - r) * q) + off; }
        const int nig = WGM * nN, gid = wgid / nig, fm = gid * WGM, gsz = (nM - fm) < WGM ? (nM - fm) : WGM;
        u.pm = fm + ((wgid % nig) % gsz); u.pn = (wgid % nig) / gsz; u.pk = 0; return true;
    }
    __device__ __forceinline__ void a_ready(const Unit&) const {}
    __device__ __forceinline__ void done(const Unit&) const {}
};

__device__ __forceinline__ unsigned cvt_pk_bf16(float lo, float hi) { unsigned r; asm volatile("v_cvt_pk_bf16_f32 %0, %1, %2" : "=v"(r) : "v"(lo), "v"(hi)); return r; }

template <class Epi, class Sched, bool ALIGN_EPI = false, bool SP2 = false>
__device__ __forceinline__ void gemm_phase(PG8_LAS unsigned char* lds, const Gemm g, const Sched& S, const Epi& E, int tid_in) {
    int tid_l = tid_in; asm volatile("" : "+v"(tid_l));
    const int tid = tid_l, wid = __builtin_amdgcn_readfirstlane(tid >> 6), lane = tid & 63, wr = wid >> 2, wc = wid & 3, fr = lane & 15, fq = lane >> 4;
    const int K = g.K, nt = K / BK, LD = g.ld;
    unsigned voffA[2], voffB[2];
#pragma unroll
    for (int i = 0; i < 2; ++i) { int R, C; stage_rc(tid * 16 + i * 8192, R, C); const int Rb = Epi::PERM ? ((R & ~31) + perm32(R & 31)) : R;
        voffA[i] = (unsigned)(R * LD + C) * 2u; voffB[i] = (unsigned)(Rb * LD + C) * 2u; }
    const size_t kstep = (size_t)(BK * 2);
    const size_t hstep = (size_t)HALF * LD * 2;
    const size_t tstep = 2 * hstep;
    const unsigned ldsw = (unsigned)wid * 1024u;
    const int aoff = lds_byte(wr * 64 + fr, fq * 8), boff = lds_byte(wc * 32 + fr, fq * 8);
#define PG8_SA(b, h) (((b) * 2 + (h)) * HTB)
#define PG8_SB(b, h) ((4 + (b) * 2 + (h)) * HTB)
#define PG8_STAGE(bufoff, gbase, voff) do { _Pragma("unroll") for (int _i = 0; _i < 2; ++_i) \
        __builtin_amdgcn_global_load_lds((const unsigned*)((const char*)(gbase) + (voff)[_i]), (PG8_LAS unsigned*)(lds + (bufoff) + ldsw + _i * 8192), 16, 0, 0); } while (0)
#define PG8_LDA(dst, b, h) do { _Pragma("unroll") for (int m = 0; m < 4; ++m) _Pragma("unroll") for (int k = 0; k < 2; ++k) dst[m][k] = *(const PG8_LAS bf16x8*)(lds + PG8_SA(b, h) + aoff + m * 2048 + k * 1024); } while (0)
#define PG8_LDB(dst, b, h) do { _Pragma("unroll") for (int n = 0; n < 2; ++n) _Pragma("unroll") for (int k = 0; k < 2; ++k) dst[n][k] = *(const PG8_LAS bf16x8*)(lds + PG8_SB(b, h) + boff + n * 2048 + k * 1024); } while (0)
#define PG8_MMA(ai, bj, At, Bt) do { __builtin_amdgcn_s_setprio(1); _Pragma("unroll") for (int m = 0; m < 4; ++m) _Pragma("unroll") for (int n = 0; n < 2; ++n) _Pragma("unroll") for (int k = 0; k < 2; ++k) \
        acc[ai][bj][m][n] = __builtin_amdgcn_mfma_f32_16x16x32_bf16(Bt[n][k], At[m][k], acc[ai][bj][m][n], 0, 0, 0); __builtin_amdgcn_s_setprio(0); } while (0)
#define PG8_WAIT_V(n) asm volatile("s_waitcnt vmcnt(" #n ")" ::: "memory")
#define PG8_WAIT_L(n) asm volatile("s_waitcnt lgkmcnt(" #n ")" ::: "memory")
#define PG8_BAR __builtin_amdgcn_s_barrier()
#define PG8_SCHED __builtin_amdgcn_sched_barrier(0)
    Unit cur, nxt; int ui = 0;
    if (!S.next(0, cur)) return;
    f32x4 acc[2][2][4][2];
#pragma unroll
    for (int a = 0; a < 2; ++a)
#pragma unroll
        for (int b = 0; b < 2; ++b)
#pragma unroll
            for (int m = 0; m < 4; ++m)
#pragma unroll
                for (int n = 0; n < 2; ++n) acc[a][b][m][n] = (f32x4){0.f, 0.f, 0.f, 0.f};
    bf16x8 At[4][2], B0[2][2], B1[2][2];
    const char* cA = (const char*)g.A + (size_t)cur.pm * tstep + (size_t)cur.pk * 2; const char* cB = (const char*)g.Bt + (size_t)cur.pn * tstep + (size_t)cur.pk * 2;
    S.a_ready(cur);
    if constexpr (SP2) {
        PG8_STAGE(PG8_SB(0, 0), cB, voffB); PG8_STAGE(PG8_SB(0, 1), cB + hstep, voffB); PG8_STAGE(PG8_SA(0, 0), cA, voffA); PG8_STAGE(PG8_SA(0, 1), cA + hstep, voffA);
        if (wr == 1) PG8_BAR;
        PG8_WAIT_V(2); PG8_BAR;
        PG8_STAGE(PG8_SB(1, 0), cB + kstep, voffB); PG8_STAGE(PG8_SA(1, 0), cA + kstep, voffA); PG8_STAGE(PG8_SB(1, 1), cB + hstep + kstep, voffB);
        PG8_WAIT_V(6); PG8_BAR;
    } else {
        PG8_STAGE(PG8_SB(0, 0), cB, voffB); PG8_STAGE(PG8_SA(0, 0), cA, voffA); PG8_STAGE(PG8_SB(0, 1), cB + hstep, voffB); PG8_STAGE(PG8_SA(0, 1), cA + hstep, voffA);
        if (wr == 1) PG8_BAR;
        PG8_WAIT_V(4); PG8_BAR;
        PG8_STAGE(PG8_SB(1, 0), cB + kstep, voffB); PG8_STAGE(PG8_SA(1, 0), cA + kstep, voffA); PG8_STAGE(PG8_SB(1, 1), cB + hstep + kstep, voffB);
        PG8_WAIT_V(6); PG8_BAR;
    }
    for (;;) {
        const bool has_next = S.next(ui + 1, nxt);
        const char* nA = has_next ? (const char*)g.A + (size_t)nxt.pm * tstep + (size_t)nxt.pk * 2 : cA; const char* nB = has_next ? (const char*)g.Bt + (size_t)nxt.pn * tstep + (size_t)nxt.pk * 2 : cB;
        for (int t = 0; t < nt; t += 2) {
            const bool last = (t == nt - 2);
            const char* a1 = cA + (size_t)(t + 1) * kstep;
            const char* a2 = last ? nA : cA + (size_t)(t + 2) * kstep; const char* b2 = last ? nB : cB + (size_t)(t + 2) * kstep;
            const char* a3 = a2 + kstep; const char* b3 = b2 + kstep;
            if (last && has_next) S.a_ready(nxt);
            if constexpr (Epi::KHOOK) E.khook(acc, cur, t, wr, wc, fr, fq);
            if constexpr (SP2) {
            PG8_LDB(B0, 0, 0); PG8_LDB(B1, 0, 1); PG8_SCHED; PG8_LDA(At, 0, 0); PG8_STAGE(PG8_SA(1, 1), a1 + hstep, voffA);
            PG8_WAIT_V(8); PG8_WAIT_L(0); PG8_BAR; PG8_MMA(0, 0, At, B0); PG8_MMA(0, 1, At, B1); PG8_BAR; PG8_SCHED;
            PG8_LDA(At, 0, 1); PG8_STAGE(PG8_SB(0, 0), b2, voffB); PG8_STAGE(PG8_SB(0, 1), b2 + hstep, voffB); PG8_STAGE(PG8_SA(0, 0), a2, voffA);
            PG8_WAIT_V(8); PG8_WAIT_L(0); PG8_BAR; PG8_MMA(1, 0, At, B0); PG8_MMA(1, 1, At, B1); PG8_BAR; PG8_SCHED;
            PG8_LDB(B0, 1, 0); PG8_LDB(B1, 1, 1); PG8_SCHED; PG8_LDA(At, 1, 0); PG8_STAGE(PG8_SA(0, 1), a2 + hstep, voffA);
            PG8_WAIT_V(8); PG8_WAIT_L(0); PG8_BAR; PG8_MMA(0, 0, At, B0); PG8_MMA(0, 1, At, B1); PG8_BAR; PG8_SCHED;
            PG8_LDA(At, 1, 1); PG8_STAGE(PG8_SB(1, 0), b3, voffB); PG8_STAGE(PG8_SB(1, 1), b3 + hstep, voffB); PG8_STAGE(PG8_SA(1, 0), a3, voffA);
            PG8_WAIT_V(8); PG8_WAIT_L(0); PG8_BAR; PG8_MMA(1, 0, At, B0); PG8_MMA(1, 1, At, B1); PG8_BAR; PG8_SCHED;
            } else {
            PG8_LDB(B0, 0, 0); PG8_SCHED; PG8_LDA(At, 0, 0); PG8_STAGE(PG8_SA(1, 1), a1 + hstep, voffA);
            PG8_WAIT_L(8); PG8_BAR; PG8_WAIT_L(0); PG8_MMA(0, 0, At, B0); PG8_BAR; PG8_SCHED;
            PG8_LDB(B1, 0, 1); PG8_STAGE(PG8_SB(0, 0), b2, voffB);
            PG8_BAR; PG8_WAIT_L(0); PG8_MMA(0, 1, At, B1); PG8_BAR;
            PG8_LDA(At, 0, 1); PG8_STAGE(PG8_SA(0, 0), a2, voffA);
            PG8_BAR; PG8_WAIT_L(0); PG8_MMA(1, 0, At, B0); PG8_BAR; PG8_SCHED;
            PG8_STAGE(PG8_SB(0, 1), b2 + hstep, voffB);
            PG8_WAIT_V(6); PG8_BAR; PG8_MMA(1, 1, At, B1); PG8_BAR;
            PG8_LDB(B0, 1, 0); PG8_SCHED; PG8_LDA(At, 1, 0); PG8_STAGE(PG8_SA(0, 1), a2 + hstep, voffA);
            PG8_WAIT_L(8); PG8_BAR; PG8_WAIT_L(0); PG8_MMA(0, 0, At, B0); PG8_BAR; PG8_SCHED;
            PG8_LDB(B1, 1, 1); PG8_STAGE(PG8_SB(1, 0), b3, voffB);
            PG8_BAR; PG8_WAIT_L(0); PG8_MMA(0, 1, At, B1); PG8_BAR;
            PG8_LDA(At, 1, 1); PG8_STAGE(PG8_SA(1, 0), a3, voffA);
            PG8_BAR; PG8_WAIT_L(0); PG8_MMA(1, 0, At, B0); PG8_BAR; PG8_SCHED;
            PG8_STAGE(PG8_SB(1, 1), b3 + hstep, voffB);
            PG8_WAIT_V(6); PG8_BAR; PG8_MMA(1, 1, At, B1); PG8_BAR;
            }
        }
        if constexpr (ALIGN_EPI) { if (wr == 0) PG8_BAR; }
        if constexpr (!Epi::AFTER_DRAIN) { E(acc, cur, wr, wc, fr, fq); S.done(cur); }
        if (!has_next) break;
#pragma unroll
        for (int a = 0; a < 2; ++a)
#pragma unroll
            for (int b = 0; b < 2; ++b)
#pragma unroll
                for (int m = 0; m < 4; ++m)
#pragma unroll
                    for (int n = 0; n < 2; ++n) acc[a][b][m][n] = (f32x4){0.f, 0.f, 0.f, 0.f};
        cur = nxt; cA = nA; cB = nB; ++ui;
        if constexpr (ALIGN_EPI) { if (wr == 1) PG8_BAR; }
    }
    PG8_WAIT_V(0);
    if constexpr (!ALIGN_EPI) { if (wr == 0) PG8_BAR; }
    PG8_BAR;
    if constexpr (Epi::AFTER_DRAIN) { E.fused(acc, cur, wr, wc, fr, fq, lds, wid, lane); S.done(cur); }
#undef PG8_SA
#undef PG8_SB
#undef PG8_STAGE
#undef PG8_LDA
#undef PG8_LDB
#undef PG8_MMA
#undef PG8_WAIT_V
#undef PG8_WAIT_L
#undef PG8_BAR
#undef PG8_SCHED
}
}
#define GAS __attribute__((address_space(1)))
#define LAS __attribute__((address_space(3)))
typedef GAS unsigned gu32;
typedef GAS unsigned long long gu64;
#define RLX_AGENT __ATOMIC_RELAXED, __HIP_MEMORY_SCOPE_AGENT
#define XB_TMO      128
#define XB_XCNT(j)  (256  + 64 * (j))
#define XB_XSUB(j)  (1280 + 64 * (j))
#define XB_XGEN(j)  (2304 + 64 * (j))
#define XB_TOP      3328
#define XB_TOPGEN   3392
#define XCD_BAR_WORDS 3456
#define XB_SPIN_CAP (1u << 18)

__device__ __forceinline__ unsigned xb_ld(unsigned* p)              { return __hip_atomic_load(p, __ATOMIC_RELAXED, __HIP_MEMORY_SCOPE_AGENT); }
__device__ __forceinline__ unsigned xb_add(unsigned* p, unsigned v) { return __hip_atomic_fetch_add(p, v, __ATOMIC_RELAXED, __HIP_MEMORY_SCOPE_AGENT); }
__device__ __forceinline__ unsigned xb_xcc_id() { return (unsigned)__builtin_amdgcn_s_getreg((3 << 11) | 20) & 0xFu; }
#define XB_SPIN(cond, bar) do { unsigned _sp = 0; while (cond) { __builtin_amdgcn_s_sleep(1); \
    if ((++_sp & 255u) == 0u) { if (xb_ld(&(bar)[XB_TMO])) break; if (_sp > XB_SPIN_CAP) { atomicAdd(&(bar)[XB_TMO], 1u); break; } } } } while (0)

struct XcdBarrier {
    unsigned* bar; unsigned x;
    volatile LAS unsigned* st;
};

__device__ __forceinline__ XcdBarrier xcd_barrier_post(unsigned* bar, volatile LAS unsigned* st) {
    XcdBarrier b; b.bar = bar; b.x = xb_xcc_id(); b.st = st;
    if (threadIdx.x == 0) (void)xb_add(&bar[XB_XCNT(b.x)], 1u);
    return b;
}
__device__ __forceinline__ void xcd_barrier_complete(unsigned* bar, unsigned x, unsigned& nloc, unsigned& nx) {
    const unsigned G = gridDim.x * gridDim.y * gridDim.z;
    unsigned sum, cnt, mine, sp = 0u;
    for (;;) {
        sum = 0u; cnt = 0u; mine = 0u;
#pragma unroll
        for (unsigned j = 0; j < 16; ++j) { const unsigned c = xb_ld(&bar[XB_XCNT(j)]); sum += c; cnt += (c > 0u) ? 1u : 0u; mine = (j == x) ? c : mine; }
        if (sum == G) break;
        __builtin_amdgcn_s_sleep(1);
        if ((++sp & 255u) == 0u) { if (xb_ld(&bar[XB_TMO])) break; if (sp > XB_SPIN_CAP) { atomicAdd(&bar[XB_TMO], 1u); break; } }
    }
    nloc = mine > 0u ? mine : 1u; nx = cnt > 0u ? cnt : 1u;
}

__device__ __forceinline__ void xcd_barrier(const XcdBarrier& b) {
    asm volatile("s_waitcnt vmcnt(0)" ::: "memory");
    __syncthreads();
    if (threadIdx.x == 0) {
        unsigned* bar = b.bar;
        __builtin_amdgcn_s_waitcnt(0);
        unsigned nloc = b.st[0], nx = b.st[1];
        if (nloc == 0u) { xcd_barrier_complete(bar, b.x, nloc, nx); b.st[0] = nloc; b.st[1] = nx; }
        const unsigned old = xb_add(&bar[XB_XSUB(b.x)], 1u);
        const unsigned gen = old / nloc;
        if (old + 1u == (gen + 1u) * nloc) {
            __builtin_amdgcn_fence(__ATOMIC_RELEASE, "agent");
            asm volatile("s_waitcnt vmcnt(0)" ::: "memory");
            const unsigned og = xb_add(&bar[XB_TOP], 1u);
            const unsigned tg = og / nx;
            if (og + 1u == (tg + 1u) * nx) xb_add(&bar[XB_TOPGEN], 1u);
            else XB_SPIN(xb_ld(&bar[XB_TOPGEN]) == tg, bar);
            __builtin_amdgcn_fence(__ATOMIC_ACQUIRE, "agent");
            xb_add(&bar[XB_XGEN(b.x)], 1u);
            asm volatile("s_waitcnt vmcnt(0)" ::: "memory");
        } else {
            XB_SPIN(xb_ld(&bar[XB_XGEN(b.x)]) == gen, bar);
            __builtin_amdgcn_fence(__ATOMIC_ACQUIRE, "agent");
            asm volatile("s_waitcnt vmcnt(0)" ::: "memory");
        }
    }
    __syncthreads();
}

#define LDS_BARRIER() do { asm volatile("s_waitcnt lgkmcnt(0)" ::: "memory"); __builtin_amdgcn_s_barrier(); asm volatile("" ::: "memory"); } while (0)
typedef float vf4 __attribute__((ext_vector_type(4)));
typedef unsigned vu2 __attribute__((ext_vector_type(2)));
typedef unsigned vu4 __attribute__((ext_vector_type(4)));
__device__ __forceinline__ float wave_sum(float v) {
#pragma unroll
    for (int o = 1; o < 64; o <<= 1) v += __shfl_xor(v, o);
    return v;
}
template <int CTRL> __device__ __forceinline__ float dpp_f(float x) { return __builtin_bit_cast(float, __builtin_amdgcn_mov_dpp(__builtin_bit_cast(int, x), CTRL, 0xf, 0xf, true)); }
__device__ __forceinline__ float sum16(float x) { x += dpp_f<0xB1>(x); x += dpp_f<0x4E>(x); x += dpp_f<0x124>(x); x += dpp_f<0x128>(x); return x; }
__device__ __forceinline__ float sum8(float x) { x += dpp_f<0xB1>(x); x += dpp_f<0x4E>(x); x += dpp_f<0x141>(x); return x; }
__device__ __forceinline__ unsigned pk2(float lo, float hi) { return (unsigned)f2bf(lo) | ((unsigned)f2bf(hi) << 16); }

constexpr int NV4 = D_MODEL / 256;
__device__ __forceinline__ void row_load(const float* row, int lane, vf4 (&x)[NV4]) {
#pragma unroll
    for (int j = 0; j < NV4; ++j) x[j] = __builtin_nontemporal_load((const vf4*)(row + (size_t)(j * 64 + lane) * 4));
}
__device__ __forceinline__ void row_store(float* row, int lane, const vf4 (&x)[NV4]) {
#pragma unroll
    for (int j = 0; j < NV4; ++j) *(vf4*)(row + (size_t)(j * 64 + lane) * 4) = x[j];
}
__device__ __forceinline__ float row_rs(const vf4 (&x)[NV4]) {
    float ss = 0.f;
#pragma unroll
    for (int j = 0; j < NV4; ++j) ss += (x[j].x * x[j].x + x[j].y * x[j].y) + (x[j].z * x[j].z + x[j].w * x[j].w);
    return 1.0f / sqrtf(wave_sum(ss) * (1.0f / D_MODEL) + EPS);
}
__device__ __forceinline__ void norm_h_wave(const Ptrs& p, int l, int r, int which, int lane, const vf4 (&x)[NV4]) {
    const float rs = row_rs(x);
    const float* g = (which ? p.g_pre2 : p.g_pre1) + (size_t)l * D_MODEL;
    const float* mod = p.MOD + ((size_t)l * (BATCH + 1) + mod_row(r)) * D6 + (which ? 3 * D_MODEL : 0);
#pragma unroll
    for (int j = 0; j < NV4; ++j) { const int c = (j * 64 + lane) * 4;
        const vf4 gv = *(const vf4*)(g + c), sh = *(const vf4*)(mod + c), sc = *(const vf4*)(mod + D_MODEL + c);
        const vf4 o = x[j] * rs * gv * (1.0f + sc) + sh;
        vu2 w; w.x = pk2(o.x, o.y); w.y = pk2(o.z, o.w);
        *(vu2*)(p.H + (size_t)r * D_MODEL + c) = w; }
}
__device__ __forceinline__ void resid_wave(const Ptrs& p, int l, int r, int which, int lane, vf4 (&x)[NV4], int ns) {
    vf4 y[NV4];
    if (r >= NLAT) {
#pragma unroll
        for (int j = 0; j < NV4; ++j) y[j] = (vf4){0.f, 0.f, 0.f, 0.f};
        for (int s = 0; s < ns; ++s) {
#pragma unroll
            for (int j = 0; j < NV4; ++j) y[j] += *(const vf4*)(p.SLAB + ((size_t)s * NCTX + (r - NLAT)) * D_MODEL + (size_t)(j * 64 + lane) * 4); }
    } else
#pragma unroll
    for (int j = 0; j < NV4; ++j) { const vu2 w = __builtin_nontemporal_load((const vu2*)(p.MIXb + (size_t)r * D_MODEL + (size_t)(j * 64 + lane) * 4)); y[j] = (vf4){__uint_as_float(w.x << 16), __uint_as_float(w.x & 0xffff0000u), __uint_as_float(w.y << 16), __uint_as_float(w.y & 0xffff0000u)}; }
    const float rs = row_rs(y);
    const float* g = (which ? p.g_post2 : p.g_post1) + (size_t)l * D_MODEL;
    const float* gate = p.MOD + ((size_t)l * (BATCH + 1) + mod_row(r)) * D6 + (which ? 5 * D_MODEL : 2 * D_MODEL);
#pragma unroll
    for (int j = 0; j < NV4; ++j) { const int c = (j * 64 + lane) * 4; x[j] += *(const vf4*)(gate + c) * (y[j] * rs * *(const vf4*)(g + c)); }
}

struct WtDesc { const float* W; bf16* WT; int K, N, k0, n0, drow0; };
__device__ __forceinline__ void transpose_load(const WtDesc& d, int lane, float (&wv)[32]) {
#pragma unroll
    for (int i = 0; i < 32; ++i) wv[i] = __builtin_nontemporal_load(d.W + (size_t)(d.k0 + 2 * i + (lane >> 5)) * d.N + d.n0 + (lane & 31));
}
__device__ __forceinline__ void transpose_finish(const WtDesc& d, const float (&wv)[32], LAS float* scr, int lane) {
#pragma unroll
    for (int i = 0; i < 32; ++i) scr[(2 * i + (lane >> 5)) * 33 + (lane & 31)] = wv[i];
    asm volatile("s_waitcnt lgkmcnt(0)" ::: "memory");
    const int c = lane & 7;
#pragma unroll
    for (int j = 0; j < 4; ++j) { const int n = (lane >> 3) + 8 * j; const LAS float* s = scr + (8 * c) * 33 + n;
        vu4 o; o.x = pk2(s[0 * 33], s[1 * 33]); o.y = pk2(s[2 * 33], s[3 * 33]); o.z = pk2(s[4 * 33], s[5 * 33]); o.w = pk2(s[6 * 33], s[7 * 33]);
        *(vu4*)(d.WT + (size_t)(d.drow0 + n) * d.K + d.k0 + 8 * c) = o; }
    asm volatile("s_waitcnt lgkmcnt(0)" ::: "memory");
}
__device__ __forceinline__ void transpose_item(const float* W, int K, int N, bf16* WT, int k0, int n0, int drow0, LAS float* scr, int lane) {
    const WtDesc d{W, WT, K, N, k0, n0, drow0}; float wv[32];
    transpose_load(d, lane, wv); transpose_finish(d, wv, scr, lane);
}
__device__ __forceinline__ int inproj_dst_row0(int n0) {
    if (n0 < R_A) return n0;
    if (n0 == R_A) return NP_MAIN;
    if (n0 < R_DT) return n0 - 4 * GDN_H;
    if (n0 == R_DT) return NP_MAIN + PF_DT;
    return n0 - 4 * GDN_H - 2 * SSM_H;
}
__device__ __forceinline__ int up_dst_row0(int n0) {
    const int isg = n0 >= D_FF, j = isg ? n0 - D_FF : n0; return 256 * (j >> 7) + 128 * isg + (j & 127);
}
static_assert(D_FF % 128 == 0, "up-projection tile order");
static_assert(4 * GDN_H == 32 && 2 * SSM_H == 32 && R_A % 32 == 0 && R_DT % 32 == 0, "the 32-column transpose items assume the real shapes");

constexpr int TB = 32;
constexpr int GDN_BUF = TB * 256 + TB * 32 + TB * 2;
__device__ __forceinline__ void gdn_token_wg(const Ptrs& p, LAS float* L, int chain, int slice, int tid) {
    const int b = chain / (GDN_H * 2), h = (chain >> 1) % GDN_H, dir = chain & 1;
    const int lane = tid & 63, wave = tid >> 6, ks = lane & 15, cl = wave * 4 + (lane >> 4);
    LAS float* obuf = L + 2 * GDN_BUF;
    float S[8];
#pragma unroll
    for (int e = 0; e < 8; ++e) S[e] = 0.f;
    vf4 rq[4], rv; float ra = 0.f, rb = 0.f;
    constexpr int NB = CHAIN_LEN / TB;
    auto gload = [&](int n) {
#pragma unroll
        for (int j = 0; j < 4; ++j) { const int idx = j * 512 + tid, i = idx >> 6, c4 = idx & 63; const int r = chain_row(b, dir, n * TB + i);
            rq[j] = *(const vf4*)(p.GQKV + (size_t)r * (3 * MIX_W) + h * 128 + (c4 < 32 ? c4 * 4 : MIX_W + (c4 - 32) * 4)); }
        if (tid < 256) { const int i = tid >> 3, c4 = tid & 7; const int r = chain_row(b, dir, n * TB + i);
            rv = *(const vf4*)(p.GQKV + (size_t)r * (3 * MIX_W) + 2 * MIX_W + h * 128 + slice * 32 + c4 * 4); }
        if (tid < TB) { const int r = chain_row(b, dir, n * TB + tid); ra = __expf(p.GG[(size_t)r * 2 * GDN_H + dir * GDN_H + h]); rb = p.GB[(size_t)r * 2 * GDN_H + dir * GDN_H + h]; }
    };
    auto lstore = [&](LAS float* B) {
#pragma unroll
        for (int j = 0; j < 4; ++j) { const int idx = j * 512 + tid; *(LAS vf4*)(B + (idx >> 6) * 256 + (idx & 63) * 4) = rq[j]; }
        if (tid < 256) *(LAS vf4*)(B + TB * 256 + tid * 4) = rv;
        if (tid < TB) { B[TB * 256 + TB * 32 + tid * 2] = ra; B[TB * 256 + TB * 32 + tid * 2 + 1] = rb; }
    };
    gload(0); lstore(L); LDS_BARRIER();
    for (int n = 0; n < NB; ++n) {
        LAS float* B = L + (n & 1) * GDN_BUF; LAS float* ob = obuf + (n & 1) * (TB * 32);
        if (n + 1 < NB) gload(n + 1);
#pragma unroll 4
        for (int i = 0; i < TB; ++i) {
            const LAS float* kq = B + i * 256;
            const vf4 q0 = *(const LAS vf4*)(kq + ks * 8), q1 = *(const LAS vf4*)(kq + ks * 8 + 4), k0 = *(const LAS vf4*)(kq + 128 + ks * 8), k1 = *(const LAS vf4*)(kq + 128 + ks * 8 + 4);
            const float v = B[TB * 256 + i * 32 + cl], a = B[TB * 256 + TB * 32 + i * 2], be = B[TB * 256 + TB * 32 + i * 2 + 1];
            const float kk[8] = {k0.x, k0.y, k0.z, k0.w, k1.x, k1.y, k1.z, k1.w}, qq[8] = {q0.x, q0.y, q0.z, q0.w, q1.x, q1.y, q1.z, q1.w};
            float rr = 0.f;
#pragma unroll
            for (int e = 0; e < 8; ++e) { S[e] *= a; rr += kk[e] * S[e]; }
            rr = sum16(rr);
            const float dl = be * (v - rr); float o = 0.f;
#pragma unroll
            for (int e = 0; e < 8; ++e) { S[e] += kk[e] * dl; o += qq[e] * S[e]; }
            o = sum16(o);
            if (ks == 0) ob[i * 32 + cl] = o;
        }
        if (n + 1 < NB) lstore(L + ((n + 1) & 1) * GDN_BUF);
        LDS_BARRIER();
        if (tid < 256) { const int i = tid >> 3, c4 = tid & 7; const int r = chain_row(b, dir, n * TB + i);
            *(vf4*)(p.OG + ((size_t)dir * MROWS + r) * MIX_W + h * 128 + slice * 32 + c4 * 4) = *(const LAS vf4*)(ob + i * 32 + c4 * 4); }
    }
}
constexpr int SSD_BUF = TB * 256 + TB * 64 + TB * 2;
__device__ __forceinline__ void ssd_token_wg(const Ptrs& p, LAS float* L, int chain, int tid) {
    const int b = chain / (SSM_H * 2), hd = (chain >> 1) % SSM_H, dir = chain & 1, g = hd / SSM_HPG;
    const int lane = tid & 63, wave = tid >> 6, ss = lane & 7, pc = wave * 8 + (lane >> 3);
    LAS float* obuf = L + 2 * SSD_BUF;
    float hs[16];
#pragma unroll
    for (int e = 0; e < 16; ++e) hs[e] = 0.f;
    vf4 rbc[4], rx; float rdt = 0.f, rea = 0.f;
    constexpr int NB = CHAIN_LEN / TB;
    auto gload = [&](int n) {
#pragma unroll
        for (int j = 0; j < 4; ++j) { const int idx = j * 512 + tid, i = idx >> 6, c4 = idx & 63; const int r = chain_row(b, dir, n * TB + i);
            rbc[j] = *(const vf4*)(p.SXBC + (size_t)r * SSM_XBC + MIX_W + (c4 < 32 ? g * SSM_N + c4 * 4 : SSM_BC + g * SSM_N + (c4 - 32) * 4)); }
        { const int i = tid >> 4, c4 = tid & 15; const int r = chain_row(b, dir, n * TB + i); rx = *(const vf4*)(p.SXBC + (size_t)r * SSM_XBC + hd * SSM_P + c4 * 4); }
        if (tid < TB) { const int r = chain_row(b, dir, n * TB + tid); rdt = p.SDT[(size_t)r * 2 * SSM_H + dir * SSM_H + hd]; rea = __expf(p.SA[(size_t)r * 2 * SSM_H + dir * SSM_H + hd]); }
    };
    auto lstore = [&](LAS float* B) {
#pragma unroll
        for (int j = 0; j < 4; ++j) { const int idx = j * 512 + tid; *(LAS vf4*)(B + (idx >> 6) * 256 + (idx & 63) * 4) = rbc[j]; }
        *(LAS vf4*)(B + TB * 256 + tid * 4) = rx;
        if (tid < TB) { B[TB * 256 + TB * 64 + tid * 2] = rdt; B[TB * 256 + TB * 64 + tid * 2 + 1] = rea; }
    };
    gload(0); lstore(L); LDS_BARRIER();
    for (int n = 0; n < NB; ++n) {
        LAS float* B = L + (n & 1) * SSD_BUF; LAS float* ob = obuf + (n & 1) * (TB * 64);
        if (n + 1 < NB) gload(n + 1);
#pragma unroll 2
        for (int i = 0; i < TB; ++i) {
            const LAS float* bc = B + i * 256;
            const float xd = B[TB * 256 + i * 64 + pc] * B[TB * 256 + TB * 64 + i * 2], ea = B[TB * 256 + TB * 64 + i * 2 + 1];
            float y = 0.f;
#pragma unroll
            for (int q = 0; q < 4; ++q) { const vf4 bv = *(const LAS vf4*)(bc + ss * 16 + q * 4), cv = *(const LAS vf4*)(bc + 128 + ss * 16 + q * 4);
                hs[4 * q + 0] = ea * hs[4 * q + 0] + xd * bv.x; y += cv.x * hs[4 * q + 0];
                hs[4 * q + 1] = ea * hs[4 * q + 1] + xd * bv.y; y += cv.y * hs[4 * q + 1];
                hs[4 * q + 2] = ea * hs[4 * q + 2] + xd * bv.z; y += cv.z * hs[4 * q + 2];
                hs[4 * q + 3] = ea * hs[4 * q + 3] + xd * bv.w; y += cv.w * hs[4 * q + 3]; }
            y = sum8(y);
            if (ss == 0) ob[i * 64 + pc] = y;
        }
        if (n + 1 < NB) lstore(L + ((n + 1) & 1) * SSD_BUF);
        LDS_BARRIER();
        { const int i = tid >> 4, c4 = tid & 15; const int r = chain_row(b, dir, n * TB + i);
            *(vf4*)(p.OS + ((size_t)dir * MROWS + r) * MIX_W + hd * SSM_P + c4 * 4) = *(const LAS vf4*)(ob + i * 64 + c4 * 4); }
    }
}

constexpr int YLD = 3 * MIX_W;
typedef float f32x2_t __attribute__((ext_vector_type(2)));
typedef __bf16 bf16x2_t __attribute__((ext_vector_type(2)));
typedef short bf16x8_t __attribute__((ext_vector_type(8)));
typedef float f32x16_t __attribute__((ext_vector_type(16)));
__device__ __forceinline__ unsigned cvtpk(float lo, float hi) { f32x2_t v = {lo, hi}; bf16x2_t b = __builtin_convertvector(v, bf16x2_t); return __builtin_bit_cast(unsigned, b); }
__device__ __forceinline__ float bflo(unsigned w) { return __uint_as_float(w << 16); }
__device__ __forceinline__ float bfhi(unsigned w) { return __uint_as_float(w & 0xffff0000u); }
__device__ __forceinline__ void unpack8(const vu4 w, float (&f)[8]) { f[0] = bflo(w.x); f[1] = bfhi(w.x); f[2] = bflo(w.y); f[3] = bfhi(w.y); f[4] = bflo(w.z); f[5] = bfhi(w.z); f[6] = bflo(w.w); f[7] = bfhi(w.w); }
__device__ __forceinline__ float silu_fast(float x) { return x * __builtin_amdgcn_rcpf(1.0f + __expf(-x)); }

__device__ __forceinline__ void conv8(const bf16* Prow, bool hp, bool hn, int col, const float* w, int wld, int jc, float (&y)[8]) {
    float xc[8], xp[8], xn[8];
    unpack8(*(const vu4*)(Prow + col), xc);
    if (hp) unpack8(*(const vu4*)(Prow - NP_MAIN + col), xp);
    if (hn) unpack8(*(const vu4*)(Prow + NP_MAIN + col), xn);
    const vf4 w0a = *(const vf4*)(w + jc), w0b = *(const vf4*)(w + jc + 4), w1a = *(const vf4*)(w + wld + jc), w1b = *(const vf4*)(w + wld + jc + 4), w2a = *(const vf4*)(w + 2 * wld + jc), w2b = *(const vf4*)(w + 2 * wld + jc + 4);
    const float w0[8] = {w0a.x, w0a.y, w0a.z, w0a.w, w0b.x, w0b.y, w0b.z, w0b.w}, w1[8] = {w1a.x, w1a.y, w1a.z, w1a.w, w1b.x, w1b.y, w1b.z, w1b.w}, w2[8] = {w2a.x, w2a.y, w2a.z, w2a.w, w2b.x, w2b.y, w2b.z, w2b.w};
#pragma unroll
    for (int e = 0; e < 8; ++e) { float v = w1[e] * xc[e]; if (hp) v += w0[e] * xp[e]; if (hn) v += w2[e] * xn[e]; y[e] = v; }
}
constexpr float ATT_QSCALE = 0.08838834764831845f * 1.4426950408889634f;
__device__ __forceinline__ void prep_row_wave(const Ptrs& p, int l, int r, int lane) {
    int b, t, len; bool ic; row_info(r, b, t, len, ic);
    const bool hp = t > 0, hn = t < len - 1;
    const bf16* Pr = p.P + (size_t)r * NP_MAIN;
    { const float* w = p.gdn_conv_w + (size_t)l * 3 * (3 * MIX_W);
#pragma unroll 3
        for (int ps = 0; ps < (3 * MIX_W) / 512; ++ps) { const int col = ps * 512 + lane * 8, grp = col >> 7; float y[8]; conv8(Pr, hp, hn, C_QKV + col, w, 3 * MIX_W, col, y);
            float ss = 0.f;
#pragma unroll
            for (int e = 0; e < 8; ++e) { y[e] = silu_fast(y[e]); ss += y[e] * y[e]; }
            ss = sum16(ss);
            float sc = 1.0f; if (grp < 2 * GDN_H) { sc = 1.0f / sqrtf(ss + EPS); if (grp < GDN_H) sc *= 0.08838834764831845f; }
            *(vu4*)(p.GQKVb + (size_t)r * (3 * MIX_W) + col) = (vu4){cvtpk(y[0] * sc, y[1] * sc), cvtpk(y[2] * sc, y[3] * sc), cvtpk(y[4] * sc, y[5] * sc), cvtpk(y[6] * sc, y[7] * sc)}; } }
    { const float* w = p.ssm_conv_w + (size_t)l * 3 * SSM_XBC; const float* cb = p.ssm_conv_b + (size_t)l * SSM_XBC;
#pragma unroll 3
        for (int ps = 0; ps < SSM_XBC / 512; ++ps) { const int col = ps * 512 + lane * 8; float y[8]; conv8(Pr, hp, hn, C_XBC + col, w, SSM_XBC, col, y);
            const vf4 ba = *(const vf4*)(cb + col), bb = *(const vf4*)(cb + col + 4); const float bs[8] = {ba.x, ba.y, ba.z, ba.w, bb.x, bb.y, bb.z, bb.w};
#pragma unroll
            for (int e = 0; e < 8; ++e) y[e] = silu_fast(y[e] + bs[e]);
            const vu4 w8 = {cvtpk(y[0], y[1]), cvtpk(y[2], y[3]), cvtpk(y[4], y[5]), cvtpk(y[6], y[7])};
            if (col >= MIX_W) *(vu4*)(p.SBCb + (size_t)r * (2 * SSM_BC) + col - MIX_W) = w8; else *(vu4*)(p.SXb + (size_t)r * MIX_W + col) = w8; } }
    if (lane < 2 * GDN_H) prep_gdn_gb_item(p, l, r, lane);
    if (lane < 2 * SSM_H) prep_ssd_dt_item(p, l, r, lane);
    { const int l16 = lane & 15, ax = l16 >> 3, i0 = (l16 & 7) * 4; const int pos = ic ? 0 : (ax ? t % GRID_W : t / GRID_W);
        const vf4 t0 = *(const vf4*)(p.ROPE + (size_t)(pos * 32 + i0) * 2), t1 = *(const vf4*)(p.ROPE + (size_t)(pos * 32 + i0) * 2 + 4);
        const float cs[4] = {t0.x, t0.z, t1.x, t1.z}, sn[4] = {t0.y, t0.w, t1.y, t1.w};
#pragma unroll 3
        for (int ps = 0; ps < 3; ++ps) { const int hh = ps * 4 + (lane >> 4);
            if (hh < ATT_HQ + ATT_HKV) { const bool isq = hh < ATT_HQ; const int h = isq ? hh : hh - ATT_HQ;
                const bf16* src = Pr + (isq ? C_AQ : C_AKV) + h * 128 + ax * 64 + i0;
                const vu2 a = *(const vu2*)src, c = *(const vu2*)(src + 32);
                const float x1[4] = {bflo(a.x), bfhi(a.x), bflo(a.y), bfhi(a.y)}, x2[4] = {bflo(c.x), bfhi(c.x), bflo(c.y), bfhi(c.y)};
                float o1[4], o2[4]; const float sc = isq ? ATT_QSCALE : 1.0f;
#pragma unroll
                for (int e = 0; e < 4; ++e) { o1[e] = (x1[e] * cs[e] - x2[e] * sn[e]) * sc; o2[e] = (x2[e] * cs[e] + x1[e] * sn[e]) * sc; }
                bf16* dst = (isq ? p.AQb + (size_t)r * MIX_W : p.AKb + (size_t)r * (ATT_HKV * 128)) + h * 128 + ax * 64 + i0;
                vu2 w1; w1.x = cvtpk(o1[0], o1[1]); w1.y = cvtpk(o1[2], o1[3]); vu2 w2; w2.x = cvtpk(o2[0], o2[1]); w2.y = cvtpk(o2[2], o2[3]);
                *(vu2*)dst = w1; *(vu2*)(dst + 32) = w2; } } }
}
constexpr int PREP_RB = 17, PREP_QP = (3 * MIX_W) / 512, PREP_NPASS = PREP_QP + SSM_XBC / 512;
static_assert(MROWS % PREP_RB == 0 && (3 * MIX_W) % 512 == 0 && SSM_XBC % 512 == 0 && MIX_W % 512 == 0 && PREP_NPASS <= PREP_RB && 2 * PREP_NPASS >= PREP_RB, "prep tiling");
__device__ __forceinline__ void prep_row_scalars_wave(const Ptrs& p, int l, int r, int lane);
__device__ __forceinline__ void prep_conv_block_wave(const Ptrs& p, int l, int blk, int ps, int lane) {
    const int r0 = blk * PREP_RB; const bool isx = ps >= PREP_QP;
    const int col = (isx ? ps - PREP_QP : ps) * 512 + lane * 8, wld = isx ? SSM_XBC : 3 * MIX_W, grp = col >> 7;
    const float* w = (isx ? p.ssm_conv_w + (size_t)l * 3 * SSM_XBC : p.gdn_conv_w + (size_t)l * 3 * (3 * MIX_W)) + col;
    const vf4 w0a = *(const vf4*)w, w0b = *(const vf4*)(w + 4), w1a = *(const vf4*)(w + wld), w1b = *(const vf4*)(w + wld + 4), w2a = *(const vf4*)(w + 2 * wld), w2b = *(const vf4*)(w + 2 * wld + 4);
    const float w0[8] = {w0a.x, w0a.y, w0a.z, w0a.w, w0b.x, w0b.y, w0b.z, w0b.w}, w1[8] = {w1a.x, w1a.y, w1a.z, w1a.w, w1b.x, w1b.y, w1b.z, w1b.w}, w2[8] = {w2a.x, w2a.y, w2a.z, w2a.w, w2b.x, w2b.y, w2b.z, w2b.w};
    float bs[8] = {0.f, 0.f, 0.f, 0.f, 0.f, 0.f, 0.f, 0.f};
    if (isx) { const float* cb = p.ssm_conv_b + (size_t)l * SSM_XBC + col; const vf4 ba = *(const vf4*)cb, bb = *(const vf4*)(cb + 4); bs[0] = ba.x; bs[1] = ba.y; bs[2] = ba.z; bs[3] = ba.w; bs[4] = bb.x; bs[5] = bb.y; bs[6] = bb.z; bs[7] = bb.w; }
    const bf16* src = p.P + (size_t)r0 * NP_MAIN + (isx ? C_XBC : C_QKV) + col;
    vu4 rows[PREP_RB + 2];
#pragma unroll
    for (int j = 0; j < PREP_RB + 2; ++j) { const int r = r0 - 1 + j; rows[j] = (r >= 0 && r < MROWS) ? *(const vu4*)(src + ((ptrdiff_t)j - 1) * NP_MAIN) : (vu4){0u, 0u, 0u, 0u}; }
    prep_row_scalars_wave(p, l, r0 + ps, lane);
    if (ps + PREP_NPASS < PREP_RB) prep_row_scalars_wave(p, l, r0 + ps + PREP_NPASS, lane);
    float xp[8], xc[8], xn[8];
    unpack8(rows[0], xp); unpack8(rows[1], xc);
#pragma unroll
    for (int i = 0; i < PREP_RB; ++i) { const int r = r0 + i; int b, t, len; bool ic; row_info(r, b, t, len, ic); const bool hp = t > 0, hn = t < len - 1;
        unpack8(rows[i + 2], xn);
        float y[8];
#pragma unroll
        for (int e = 0; e < 8; ++e) { float v = w1[e] * xc[e] + bs[e]; if (hp) v += w0[e] * xp[e]; if (hn) v += w2[e] * xn[e]; y[e] = silu_fast(v); }
        if (isx) { const vu4 w8 = {cvtpk(y[0], y[1]), cvtpk(y[2], y[3]), cvtpk(y[4], y[5]), cvtpk(y[6], y[7])};
            if (col >= MIX_W) *(vu4*)(p.SBCb + (size_t)r * (2 * SSM_BC) + col - MIX_W) = w8; else *(vu4*)(p.SXb + (size_t)r * MIX_W + col) = w8; }
        else { float ss = 0.f;
#pragma unroll
            for (int e = 0; e < 8; ++e) ss += y[e] * y[e];
            ss = sum16(ss);
            float sc = 1.0f; if (grp < 2 * GDN_H) { sc = 1.0f / sqrtf(ss + EPS); if (grp < GDN_H) sc *= 0.08838834764831845f; }
            *(vu4*)(p.GQKVb + (size_t)r * (3 * MIX_W) + col) = (vu4){cvtpk(y[0] * sc, y[1] * sc), cvtpk(y[2] * sc, y[3] * sc), cvtpk(y[4] * sc, y[5] * sc), cvtpk(y[6] * sc, y[7] * sc)}; }
#pragma unroll
        for (int e = 0; e < 8; ++e) { xp[e] = xc[e]; xc[e] = xn[e]; } }
}
__device__ __forceinline__ void prep_row_scalars_wave(const Ptrs& p, int l, int r, int lane) {
    int b, t, len; bool ic; row_info(r, b, t, len, ic);
    const bf16* Pr = p.P + (size_t)r * NP_MAIN;
    if (lane < 2 * GDN_H) prep_gdn_gb_item(p, l, r, lane);
    if (lane < 2 * SSM_H) prep_ssd_dt_item(p, l, r, lane);
    { const int l16 = lane & 15, ax = l16 >> 3, i0 = (l16 & 7) * 4; const int pos = ic ? 0 : (ax ? t % GRID_W : t / GRID_W);
        const vf4 t0 = *(const vf4*)(p.ROPE + (size_t)(pos * 32 + i0) * 2), t1 = *(const vf4*)(p.ROPE + (size_t)(pos * 32 + i0) * 2 + 4);
        const float cs[4] = {t0.x, t0.z, t1.x, t1.z}, sn[4] = {t0.y, t0.w, t1.y, t1.w};
#pragma unroll 3
        for (int ps = 0; ps < 3; ++ps) { const int hh = ps * 4 + (lane >> 4);
            if (hh < ATT_HQ + ATT_HKV) { const bool isq = hh < ATT_HQ; const int h = isq ? hh : hh - ATT_HQ;
                const bf16* src = Pr + (isq ? C_AQ : C_AKV) + h * 128 + ax * 64 + i0;
                const vu2 a = *(const vu2*)src, c = *(const vu2*)(src + 32);
                const float x1[4] = {bflo(a.x), bfhi(a.x), bflo(a.y), bfhi(a.y)}, x2[4] = {bflo(c.x), bfhi(c.x), bflo(c.y), bfhi(c.y)};
                float o1[4], o2[4]; const float sc = isq ? ATT_QSCALE : 1.0f;
#pragma unroll
                for (int e = 0; e < 4; ++e) { o1[e] = (x1[e] * cs[e] - x2[e] * sn[e]) * sc; o2[e] = (x2[e] * cs[e] + x1[e] * sn[e]) * sc; }
                bf16* dst = (isq ? p.AQb + (size_t)r * MIX_W : p.AKb + (size_t)r * (ATT_HKV * 128)) + h * 128 + ax * 64 + i0;
                vu2 w1; w1.x = cvtpk(o1[0], o1[1]); w1.y = cvtpk(o1[2], o1[3]); vu2 w2; w2.x = cvtpk(o2[0], o2[1]); w2.y = cvtpk(o2[2], o2[3]);
                *(vu2*)dst = w1; *(vu2*)(dst + 32) = w2; } } }
}
__device__ __forceinline__ void mixout_row_wave(const Ptrs& p, int l, int r, int lane) {
    const int c0 = lane * 16;
    {
        float o[16]; float ss = 0.f;
#pragma unroll
        for (int q = 0; q < 2; ++q) { float a8[8], b8[8]; unpack8(__builtin_nontemporal_load((const vu4*)(p.OGb + (size_t)r * MIX_W + c0 + 8 * q)), a8); unpack8(__builtin_nontemporal_load((const vu4*)(p.OGb + ((size_t)MROWS + r) * MIX_W + c0 + 8 * q)), b8);
#pragma unroll
            for (int e = 0; e < 8; ++e) o[8 * q + e] = a8[e] + b8[e]; }
#pragma unroll
        for (int e = 0; e < 16; ++e) ss += o[e] * o[e];
        ss = sum8(ss);
        const float rs = 1.0f / sqrtf(ss * (1.0f / 128.0f) + EPS);
        float gt[16]; { float t8[8]; unpack8(*(const vu4*)(p.P + (size_t)r * NP_MAIN + C_GATE + c0), t8);
#pragma unroll
            for (int e = 0; e < 8; ++e) gt[e] = t8[e];
            unpack8(*(const vu4*)(p.P + (size_t)r * NP_MAIN + C_GATE + c0 + 8), t8);
#pragma unroll
            for (int e = 0; e < 8; ++e) gt[8 + e] = t8[e]; }
        const float* nw = p.gdn_norm + (size_t)l * 128 + (c0 & 127);
        unsigned w[8];
#pragma unroll
        for (int e = 0; e < 8; ++e) w[e] = cvtpk(o[2 * e] * rs * nw[2 * e] * silu_fast(gt[2 * e]), o[2 * e + 1] * rs * nw[2 * e + 1] * silu_fast(gt[2 * e + 1]));
        *(vu4*)(p.YA + (size_t)r * YLD + c0) = (vu4){w[0], w[1], w[2], w[3]}; *(vu4*)(p.YA + (size_t)r * YLD + c0 + 8) = (vu4){w[4], w[5], w[6], w[7]};
    }
    {
        float y[16]; float ss = 0.f; const float dsk = p.ssm_d[(size_t)l * SSM_H + c0 / SSM_P];
        float zt[16]; { float t8[8]; unpack8(*(const vu4*)(p.P + (size_t)r * NP_MAIN + C_Z + c0), t8);
#pragma unroll
            for (int e = 0; e < 8; ++e) zt[e] = t8[e];
            unpack8(*(const vu4*)(p.P + (size_t)r * NP_MAIN + C_Z + c0 + 8), t8);
#pragma unroll
            for (int e = 0; e < 8; ++e) zt[8 + e] = t8[e]; }
#pragma unroll
        for (int q = 0; q < 2; ++q) { float a8[8], c8[8], d8[8], x8[8]; unpack8(__builtin_nontemporal_load((const vu4*)(p.OSb + (size_t)r * MIX_W + c0 + 8 * q)), a8);
            unpack8(__builtin_nontemporal_load((const vu4*)(p.OSb2 + (size_t)r * MIX_W + c0 + 8 * q)), c8); unpack8(__builtin_nontemporal_load((const vu4*)(p.OSb2 + ((size_t)MROWS + r) * MIX_W + c0 + 8 * q)), d8); unpack8(*(const vu4*)(p.SXb + (size_t)r * MIX_W + c0 + 8 * q), x8);
#pragma unroll
            for (int e = 0; e < 8; ++e) y[8 * q + e] = a8[e] + (c8[e] + d8[e]) + dsk * x8[e]; }
#pragma unroll
        for (int e = 0; e < 16; ++e) { y[e] *= silu_fast(zt[e]); ss += y[e] * y[e]; }
        ss = sum16(ss); ss += __shfl_xor(ss, 16);
        const float rs = 1.0f / sqrtf(ss * (1.0f / (float)(MIX_W / SSM_G)) + EPS);
        const float* nw = p.ssm_norm + (size_t)l * MIX_W + c0;
        unsigned w[8];
#pragma unroll
        for (int e = 0; e < 8; ++e) w[e] = cvtpk(y[2 * e] * rs * nw[2 * e], y[2 * e + 1] * rs * nw[2 * e + 1]);
        *(vu4*)(p.YB + (size_t)r * YLD + c0) = (vu4){w[0], w[1], w[2], w[3]}; *(vu4*)(p.YB + (size_t)r * YLD + c0 + 8) = (vu4){w[4], w[5], w[6], w[7]};
    }
}
static_assert(MIX_W == 1024 && SSM_P == 64 && MIX_W / SSM_G == 512, "mixout_row_wave lane mapping assumes the real shapes");
__device__ __forceinline__ void act_vec_item(const Ptrs& p, int l, int r, int j) {
    int b, t, len; bool ic; row_info(r, b, t, len, ic);
    const bf16* ug = p.UG + (size_t)r * (2 * D_FF);
    float u[8], g[8], gp[8], gn[8];
    unpack8(*(const vu4*)(ug + j), u); unpack8(*(const vu4*)(ug + D_FF + j), g);
    const bool hp = t > 0, hn = t < len - 1;
    if (hp) unpack8(*(const vu4*)(ug - 2 * D_FF + D_FF + j), gp);
    if (hn) unpack8(*(const vu4*)(ug + 2 * D_FF + D_FF + j), gn);
    const float* w = p.ffn_conv_w + (size_t)l * 3 * D_FF + j; const float* cb = p.ffn_conv_b + (size_t)l * D_FF + j;
    unsigned o[4];
    float a[8];
#pragma unroll
    for (int e = 0; e < 8; ++e) { float v = w[D_FF + e] * g[e] + cb[e]; if (hp) v += w[e] * gp[e]; if (hn) v += w[2 * D_FF + e] * gn[e]; a[e] = silu_fast(v) * u[e]; }
#pragma unroll
    for (int e = 0; e < 4; ++e) o[e] = cvtpk(a[2 * e], a[2 * e + 1]);
    *(vu4*)(p.ACT + (size_t)r * D_FF + j) = (vu4){o[0], o[1], o[2], o[3]};
}

__device__ __forceinline__ void act_task(const Ptrs& p, int l, int task) {
    constexpr int NJ = D_FF / 8;
    const int rc = task / NJ, j = (task % NJ) * 8, r0 = rc * 16;
    int b, t, len; bool ic; row_info(r0, b, t, len, ic);
    const float* w = p.ffn_conv_w + (size_t)l * 3 * D_FF + j; const float* cb = p.ffn_conv_b + (size_t)l * D_FF + j;
    float w0[8], w1[8], w2[8], bs[8];
    { const vf4 a0 = *(const vf4*)w, a1 = *(const vf4*)(w + 4), b0 = *(const vf4*)(w + D_FF), b1 = *(const vf4*)(w + D_FF + 4), c0 = *(const vf4*)(w + 2 * D_FF), c1 = *(const vf4*)(w + 2 * D_FF + 4), d0 = *(const vf4*)cb, d1 = *(const vf4*)(cb + 4);
        const float t0[8] = {a0.x, a0.y, a0.z, a0.w, a1.x, a1.y, a1.z, a1.w}, t1[8] = {b0.x, b0.y, b0.z, b0.w, b1.x, b1.y, b1.z, b1.w}, t2[8] = {c0.x, c0.y, c0.z, c0.w, c1.x, c1.y, c1.z, c1.w}, t3[8] = {d0.x, d0.y, d0.z, d0.w, d1.x, d1.y, d1.z, d1.w};
#pragma unroll
        for (int e = 0; e < 8; ++e) { w0[e] = t0[e]; w1[e] = t1[e]; w2[e] = t2[e]; bs[e] = t3[e]; } }
    const bf16* base = p.UG + (size_t)r0 * (2 * D_FF) + j;
    vu4 gq[18], uq[16];
    const vu4 z4 = {0u, 0u, 0u, 0u};
    gq[0] = (t > 0) ? *(const vu4*)(base - 2 * D_FF + D_FF) : z4;
#pragma unroll
    for (int i = 0; i < 16; ++i) { gq[i + 1] = *(const vu4*)(base + (size_t)i * (2 * D_FF) + D_FF); uq[i] = *(const vu4*)(base + (size_t)i * (2 * D_FF)); }
    gq[17] = (t + 16 < len) ? *(const vu4*)(base + (size_t)16 * (2 * D_FF) + D_FF) : z4;
#pragma unroll
    for (int i = 0; i < 16; ++i) { float gp[8], gc[8], gn[8], u[8]; unpack8(gq[i], gp); unpack8(gq[i + 1], gc); unpack8(gq[i + 2], gn); unpack8(uq[i], u);
        float a[8];
#pragma unroll
        for (int e = 0; e < 8; ++e) a[e] = silu_fast(w0[e] * gp[e] + w1[e] * gc[e] + w2[e] * gn[e] + bs[e]) * u[e];
        *(vu4*)(p.ACT + (size_t)(r0 + i) * D_FF + j) = (vu4){cvtpk(a[0], a[1]), cvtpk(a[2], a[3]), cvtpk(a[4], a[5]), cvtpk(a[6], a[7])}; }
}
static_assert(SEQ % 16 == 0 && CTX_LEN % 16 == 0, "act_task row chunks must not straddle sequences");

__device__ __forceinline__ void act_fix_item(const Ptrs& p, int l, int bidx, int j) {
    const int row = (bidx >> 1) * 64 + ((bidx & 1) ? 63 : 0);
    int b, t, len; bool ic; row_info(row, b, t, len, ic);
    const size_t bi = (size_t)bidx * D_FF + j;
    vf4 pre = *(const vf4*)(p.BP + bi);
    const vu2 uw = *(const vu2*)(p.BU + bi);
    const bool hasn = (bidx & 1) ? (t < len - 1) : (t > 0);
    if (hasn) { const vu2 gw = *(const vu2*)(p.BG + (size_t)((bidx & 1) ? bidx + 1 : bidx - 1) * D_FF + j);
        const vf4 w = *(const vf4*)(p.ffn_conv_w + (size_t)l * 3 * D_FF + ((bidx & 1) ? 2 * D_FF : 0) + j);
        pre += w * (vf4){bflo(gw.x), bfhi(gw.x), bflo(gw.y), bfhi(gw.y)}; }
    const float u4[4] = {bflo(uw.x), bfhi(uw.x), bflo(uw.y), bfhi(uw.y)};
    *(vu2*)(p.ACT + (size_t)row * D_FF + j) = (vu2){cvtpk(silu_fast(pre.x) * u4[0], silu_fast(pre.y) * u4[1]), cvtpk(silu_fast(pre.z) * u4[2], silu_fast(pre.w) * u4[3])};
}

constexpr int AT_KSTR = 136, AT_VSTR = 68;
constexpr int AT_BUF = 64 * AT_KSTR + 128 * AT_VSTR;
constexpr int ATT_UNITS_LAT = BATCH * ATT_HKV * (SEQ / 64), ATT_UNITS_CTX = BATCH * ATT_HKV * (CTX_LEN / 64);
__device__ __forceinline__ void attn_unit(const Ptrs& p, int l, LAS bf16* L, int unit, int tid) {
    const int lane = tid & 63, wave = tid >> 6, r32 = lane & 31, h = lane >> 5;
    const bool cu = unit >= ATT_UNITS_LAT; const int uu = cu ? unit - ATT_UNITS_LAT : unit;
    const int nqb = cu ? CTX_LEN / 64 : SEQ / 64;
    const int b = uu / (ATT_HKV * nqb), kvh = (uu / nqb) % ATT_HKV, qb = uu % nqb, q0 = qb * 64;
    const int rowbase = (cu ? NLAT + b * CTX_LEN : b * SEQ) + q0;
    const int g = wave >> 1, qh = wave & 1, hq = kvh * ATT_GRP + g;
    const int qpos = q0 + 32 * qh + r32, qrow = rowbase + 32 * qh + r32;
    bf16x8_t qf[8];
#pragma unroll
    for (int s = 0; s < 8; ++s) qf[s] = *(const bf16x8_t*)(p.AQb + (size_t)qrow * MIX_W + hq * 128 + 16 * s + 8 * h);
    float m = p.attn_sink[(size_t)l * ATT_HQ + hq] * 1.4426950408889634f, lsum = h ? 0.f : 1.0f;
    f32x16_t o[4];
#pragma unroll
    for (int d = 0; d < 4; ++d)
#pragma unroll
        for (int e = 0; e < 16; ++e) o[d][e] = 0.f;
    const int jl0 = cu ? 5 : (q0 - 128 < 0 ? (128 - q0) / 64 : 0), jl1 = cu ? 5 : ((q0 + 192 > SEQ) ? 5 - (q0 + 192 - SEQ) / 64 : 5);
    const int nt = (jl1 - jl0) + CTX_LEN / 64;
    vu4 rk[2], rv[2];
    auto tile_row0 = [&](int ti, int& kpos0) -> int { const int j = jl0 + ti; if (j < jl1) { kpos0 = q0 - 128 + 64 * j; return b * SEQ + kpos0; } kpos0 = -1000000; return NLAT + b * CTX_LEN + 64 * (j - jl1); };
    auto gload = [&](int ti) { int kp; const int kr0 = tile_row0(ti, kp);
#pragma unroll
        for (int it = 0; it < 2; ++it) { const int c = tid + 512 * it;
            rk[it] = *(const vu4*)(p.AKb + (size_t)(kr0 + (c >> 4)) * (ATT_HKV * 128) + kvh * 128 + (c & 15) * 8);
            const int vk = (c & 15) | (((c >> 6) & 3) << 4), vd = ((c >> 4) & 3) | ((c >> 8) << 2);
            rv[it] = *(const vu4*)(p.P + (size_t)(kr0 + vk) * NP_MAIN + C_AKV + ATT_HKV * 128 + kvh * 128 + vd * 8); } };
    auto lstore = [&](LAS bf16* B) {
#pragma unroll
        for (int it = 0; it < 2; ++it) { const int c = tid + 512 * it;
            *(LAS vu4*)(B + (c >> 4) * AT_KSTR + (c & 15) * 8) = rk[it];
            const int vk = (c & 15) | (((c >> 6) & 3) << 4), vd = ((c >> 4) & 3) | ((c >> 8) << 2);
            LAS bf16* vt = B + 64 * AT_KSTR + (vd * 8) * AT_VSTR + vk;
            const unsigned w4[4] = {rv[it].x, rv[it].y, rv[it].z, rv[it].w};
#pragma unroll
            for (int e = 0; e < 4; ++e) { vt[(2 * e) * AT_VSTR] = (bf16)(w4[e] & 0xffffu); vt[(2 * e + 1) * AT_VSTR] = (bf16)(w4[e] >> 16); } } };
    gload(0); lstore(L); LDS_BARRIER();
    for (int ti = 0; ti < nt; ++ti) {
        LAS bf16* B = L + (ti & 1) * AT_BUF;
        int kpos0; (void)tile_row0(ti, kpos0);
        if (ti + 1 < nt) gload(ti + 1);
        f32x16_t st[2];
#pragma unroll
        for (int sub = 0; sub < 2; ++sub) {
#pragma unroll
            for (int e = 0; e < 16; ++e) st[sub][e] = 0.f;
            bf16x8_t kf[8];
#pragma unroll
            for (int s = 0; s < 8; ++s) kf[s] = *(const LAS bf16x8_t*)(B + (32 * sub + r32) * AT_KSTR + 16 * s + 8 * h);
            __builtin_amdgcn_s_setprio(1);
#pragma unroll
            for (int s = 0; s < 8; ++s) st[sub] = __builtin_amdgcn_mfma_f32_32x32x16_bf16(kf[s], qf[s], st[sub], 0, 0, 0);
            __builtin_amdgcn_s_setprio(0); }
        float mx = -1e30f;
#pragma unroll
        for (int sub = 0; sub < 2; ++sub)
#pragma unroll
            for (int e = 0; e < 16; ++e) { const int key = 32 * sub + (e & 3) + 8 * (e >> 2) + 4 * h; const int dlt = kpos0 + key - qpos;
                if (kpos0 > -500000 && (dlt > WINDOW || dlt < -WINDOW)) st[sub][e] = -1e30f;
                mx = fmaxf(mx, st[sub][e]); }
        mx = fmaxf(mx, __shfl_xor(mx, 32));
        const float mn = fmaxf(m, mx), alpha = __builtin_amdgcn_exp2f(m - mn); m = mn;
        float ps = 0.f;
#pragma unroll
        for (int sub = 0; sub < 2; ++sub)
#pragma unroll
            for (int e = 0; e < 16; ++e) { const float pe = __builtin_amdgcn_exp2f(st[sub][e] - mn); st[sub][e] = pe; ps += pe; }
        lsum = lsum * alpha + ps;
        if (!__all(alpha == 1.0f)) {
#pragma unroll
            for (int d = 0; d < 4; ++d)
#pragma unroll
                for (int e = 0; e < 16; ++e) o[d][e] *= alpha; }
#pragma unroll
        for (int kk = 0; kk < 4; ++kk) { const int sub = kk >> 1, s8 = (kk & 1) * 8;
            vu4 pw; pw.x = cvtpk(st[sub][s8], st[sub][s8 + 1]); pw.y = cvtpk(st[sub][s8 + 2], st[sub][s8 + 3]); pw.z = cvtpk(st[sub][s8 + 4], st[sub][s8 + 5]); pw.w = cvtpk(st[sub][s8 + 6], st[sub][s8 + 7]);
            const bf16x8_t pf = __builtin_bit_cast(bf16x8_t, pw);
            bf16x8_t vf[4];
#pragma unroll
            for (int d = 0; d < 4; ++d) { const LAS bf16* vp = B + 64 * AT_KSTR + (32 * d + r32) * AT_VSTR + 16 * kk + 4 * h;
                const vu2 lo = *(const LAS vu2*)vp, hi = *(const LAS vu2*)(vp + 8);
                vf[d] = __builtin_bit_cast(bf16x8_t, (vu4){lo.x, lo.y, hi.x, hi.y}); }
            __builtin_amdgcn_s_setprio(1);
#pragma unroll
            for (int d = 0; d < 4; ++d) o[d] = __builtin_amdgcn_mfma_f32_32x32x16_bf16(vf[d], pf, o[d], 0, 0, 0);
            __builtin_amdgcn_s_setprio(0); }
        if (ti + 1 < nt) lstore(L + ((ti + 1) & 1) * AT_BUF);
        LDS_BARRIER();
    }
    lsum += __shfl_xor(lsum, 32);
    const float inv = 1.0f / lsum;
    LAS bf16* os = L + wave * (32 * AT_KSTR);
#pragma unroll
    for (int d = 0; d < 4; ++d)
#pragma unroll
        for (int a4 = 0; a4 < 4; ++a4) { vu2 w; w.x = cvtpk(o[d][4 * a4] * inv, o[d][4 * a4 + 1] * inv); w.y = cvtpk(o[d][4 * a4 + 2] * inv, o[d][4 * a4 + 3] * inv);
            *(LAS vu2*)(os + r32 * AT_KSTR + 32 * d + 8 * a4 + 4 * h) = w; }
    LDS_BARRIER();
#pragma unroll
    for (int i = 0; i < 8; ++i) { const int c = lane + 64 * i, row = c >> 4, ch = c & 15;
        *(vu4*)(p.YC + (size_t)(rowbase + 32 * qh + row) * YLD + hq * 128 + ch * 8) = *(const LAS vu4*)(os + row * AT_KSTR + ch * 8); }
    LDS_BARRIER();
}
static_assert(2 * AT_BUF * 2 <= 131072 && 8 * 32 * AT_KSTR <= 2 * AT_BUF, "attention LDS map");

constexpr int NCH = CHAIN_LEN / 64, NCH_CTX = CTX_LEN / 64;
constexpr int GDN_NU = BATCH * NCH * GDN_H * 2;
constexpr int GC_KS = 136, GC_FS = 65, GC_LS = 68, GC_TS = 72;
__device__ __forceinline__ int gdn_unit_index(int b, int c, int h, int dir) { return ((b * NCH + c) * GDN_H + h) * 2 + dir; }
__device__ __forceinline__ int chunk_row0(int b, int c) { return c < NCH_CTX ? NLAT + b * CTX_LEN + 64 * c : b * SEQ + 64 * (c - NCH_CTX); }
template <int NK> __device__ __forceinline__ f32x16_t mma_lds(f32x16_t acc, const LAS bf16* A, int lda, const LAS bf16* Bt, int ldb, int r32, int hh) {
    bf16x8_t a[NK], bb[NK];
#pragma unroll
    for (int s = 0; s < NK; ++s) { a[s] = *(const LAS bf16x8_t*)(A + r32 * lda + 16 * s + 8 * hh); bb[s] = *(const LAS bf16x8_t*)(Bt + r32 * ldb + 16 * s + 8 * hh); }
    f32x16_t acc2;
#pragma unroll
    for (int e = 0; e < 16; ++e) acc2[e] = 0.f;
#pragma unroll
    for (int s = 0; s < NK; s += 2) { acc = __builtin_amdgcn_mfma_f32_32x32x16_bf16(a[s], bb[s], acc, 0, 0, 0); acc2 = __builtin_amdgcn_mfma_f32_32x32x16_bf16(a[s + 1], bb[s + 1], acc2, 0, 0, 0); }
#pragma unroll
    for (int e = 0; e < 16; ++e) acc[e] += acc2[e];
    return acc;
}
__device__ __forceinline__ f32x16_t zero16() { f32x16_t z;
#pragma unroll
    for (int e = 0; e < 16; ++e) z[e] = 0.f;
    return z; }
__device__ __forceinline__ void tri_solve_wave(const LAS float* Lm, LAS bf16* Tm, LAS bf16* scr, int lane) {
    const int blk = lane >> 5, c = lane & 31, r32 = c, hh = blk;
    LAS bf16* B00 = scr; LAS bf16* XT = scr + 32 * 40;
    float t[32];
    vf4 lb[3][8];
#define TRI_LDROW(i_) do { _Pragma("unroll") for (int j4 = 0; j4 < ((i_) + 3) / 4; ++j4) lb[(i_) % 3][j4] = *(const LAS vf4*)(Lm + (32 * blk + (i_)) * GC_LS + 32 * blk + 4 * j4); } while (0)
    TRI_LDROW(1);
#pragma unroll
    for (int i = 0; i < 32; ++i) {
        if (i + 2 < 32) TRI_LDROW(i + 2);
        float s = (i == c) ? 1.0f : 0.0f;
#pragma unroll
        for (int j4 = 0; j4 < (i + 3) / 4; ++j4) { const vf4 lv = lb[i % 3][j4];
            if (4 * j4 + 0 < i) s -= lv.x * t[4 * j4 + 0];
            if (4 * j4 + 1 < i) s -= lv.y * t[4 * j4 + 1];
            if (4 * j4 + 2 < i) s -= lv.z * t[4 * j4 + 2];
            if (4 * j4 + 3 < i) s -= lv.w * t[4 * j4 + 3]; }
        t[i] = s;
        asm volatile("" : "+v"(t[i]));
    }
#undef TRI_LDROW
#pragma unroll
    for (int i = 0; i < 32; ++i) { Tm[(32 * blk + i) * GC_TS + 32 * blk + c] = f2bf(t[i]); if (blk == 0) Tm[i * GC_TS + 32 + c] = (bf16)0; }
    if (blk == 0) {
#pragma unroll
        for (int q = 0; q < 4; ++q) *(LAS vu4*)(B00 + c * 40 + 8 * q) = (vu4){cvtpk(t[8 * q], t[8 * q + 1]), cvtpk(t[8 * q + 2], t[8 * q + 3]), cvtpk(t[8 * q + 4], t[8 * q + 5]), cvtpk(t[8 * q + 6], t[8 * q + 7])}; }
    f32x16_t x = zero16();
#pragma unroll
    for (int s = 0; s < 2; ++s) { const LAS float* lp = Lm + (32 + r32) * GC_LS + 16 * s + 8 * hh; const vf4 l0 = *(const LAS vf4*)lp, l1 = *(const LAS vf4*)(lp + 4);
        const bf16x8_t a = __builtin_bit_cast(bf16x8_t, (vu4){cvtpk(l0.x, l0.y), cvtpk(l0.z, l0.w), cvtpk(l1.x, l1.y), cvtpk(l1.z, l1.w)});
        const bf16x8_t bb = *(const LAS bf16x8_t*)(B00 + r32 * 40 + 16 * s + 8 * hh);
        x = __builtin_amdgcn_mfma_f32_32x32x16_bf16(a, bb, x, 0, 0, 0); }
#pragma unroll
    for (int a4 = 0; a4 < 4; ++a4) *(LAS vu2*)(XT + r32 * 40 + 8 * a4 + 4 * hh) = (vu2){cvtpk(x[4 * a4], x[4 * a4 + 1]), cvtpk(x[4 * a4 + 2], x[4 * a4 + 3])};
    f32x16_t y = zero16();
#pragma unroll
    for (int s = 0; s < 2; ++s) { const bf16x8_t a = *(const LAS bf16x8_t*)(Tm + (32 + r32) * GC_TS + 32 + 16 * s + 8 * hh), bb = *(const LAS bf16x8_t*)(XT + r32 * 40 + 16 * s + 8 * hh);
        y = __builtin_amdgcn_mfma_f32_32x32x16_bf16(a, bb, y, 0, 0, 0); }
#pragma unroll
    for (int e = 0; e < 16; ++e) Tm[(32 + (e & 3) + 8 * (e >> 2) + 4 * hh) * GC_TS + r32] = f2bf(-y[e]);
}
constexpr int G1_KK = 0, G1_QK = G1_KK + 64 * GC_FS * 4, G1_L = G1_QK + 64 * GC_FS * 4, G1_T = G1_L + 2 * 64 * GC_LS * 4,
              G1_KB = G1_T + 2 * 64 * GC_TS * 2, G1_VB = G1_KB + 128 * GC_TS * 2, G1_SM = G1_VB + 128 * GC_TS * 2, G1_END = G1_SM + 10 * 64 * 4;
__device__ __forceinline__ void st_vu2(LAS bf16* q, vu2 v) { *(LAS vu2*)q = v; }
__device__ __forceinline__ void st_vu2(bf16* q, vu2 v) { *(vu2*)q = v; }
__device__ __forceinline__ void gdn_g1_unit(const Ptrs& p, LAS unsigned char* lds, int unit, int tid) {
    const int lane = tid & 63, wave = tid >> 6, r32 = lane & 31, hh = lane >> 5;
    const int b = unit / (NCH * GDN_H), c = (unit / GDN_H) % NCH, h = unit % GDN_H;
    const int r0 = chunk_row0(b, c);
    LAS float* KKs = (LAS float*)(lds + G1_KK); LAS float* QKs = (LAS float*)(lds + G1_QK);
    LAS float* Lm = (LAS float*)(lds + G1_L); LAS bf16* Tm = (LAS bf16*)(lds + G1_T); LAS bf16* KbT = (LAS bf16*)(lds + G1_KB); LAS bf16* VbT = (LAS bf16*)(lds + G1_VB);
    LAS float* gc = (LAS float*)(lds + G1_SM); LAS float* be = gc + 128; LAS float* eg = gc + 256; LAS float* beg = gc + 384; LAS float* egl = gc + 512;
    const bf16* Qg = p.GQKVb + (size_t)r0 * (3 * MIX_W) + h * 128;
    const int prod = wave >> 2, mt = (wave >> 1) & 1, nt = wave & 1;
    bf16x8_t fa[8], fb[8], ft[4];
    { const bf16* Ap = Qg + (size_t)(32 * mt + r32) * (3 * MIX_W) + (prod ? 0 : MIX_W) + 8 * hh;
      const bf16* Bp = Qg + (size_t)(32 * nt + r32) * (3 * MIX_W) + MIX_W + 8 * hh;
      const bf16* Tp = Qg + (size_t)(32 * mt + r32) * (3 * MIX_W) + (prod ? 2 * MIX_W : MIX_W) + 64 * nt + 8 * hh;
#pragma unroll
      for (int s = 0; s < 8; ++s) { fa[s] = *(const bf16x8_t*)(Ap + 16 * s); fb[s] = *(const bf16x8_t*)(Bp + 16 * s); }
#pragma unroll
      for (int s = 0; s < 4; ++s) ft[s] = *(const bf16x8_t*)(Tp + 16 * s); }
    if (wave < 2) { const int dir = wave, n = dir ? 63 - lane : lane; const size_t gi = (size_t)(r0 + n) * 2 * GDN_H + dir * GDN_H + h;
        float x = p.GG[gi]; const float bt = p.GB[gi];
#pragma unroll
        for (int o = 1; o < 64; o <<= 1) { const float y = __shfl_up(x, o); if (lane >= o) x += y; }
        const float x63 = __shfl(x, 63), ex = __expf(x);
        gc[dir * 64 + lane] = x; be[dir * 64 + lane] = bt; eg[dir * 64 + lane] = ex; beg[dir * 64 + lane] = bt * ex; egl[dir * 64 + lane] = __expf(x63 - x); }
    f32x16_t tt[2];
    { f32x16_t acc = zero16(), acc2 = zero16();
#pragma unroll
      for (int s = 0; s < 8; s += 2) { acc = __builtin_amdgcn_mfma_f32_32x32x16_bf16(fa[s], fb[s], acc, 0, 0, 0); acc2 = __builtin_amdgcn_mfma_f32_32x32x16_bf16(fa[s + 1], fb[s + 1], acc2, 0, 0, 0); }
      LAS float* dst = prod ? QKs : KKs;
#pragma unroll
      for (int e = 0; e < 16; ++e) dst[(32 * mt + (e & 3) + 8 * (e >> 2) + 4 * hh) * GC_FS + 32 * nt + r32] = acc[e] + acc2[e];
      bf16x8_t id[2];
#pragma unroll
      for (int s = 0; s < 2; ++s) { unsigned w[4];
#pragma unroll
          for (int e2 = 0; e2 < 4; ++e2) { const int k0 = 16 * s + 8 * hh + 2 * e2; w[e2] = (k0 == r32 ? 0x3F80u : 0u) | (k0 + 1 == r32 ? 0x3F800000u : 0u); }
          id[s] = __builtin_bit_cast(bf16x8_t, (vu4){w[0], w[1], w[2], w[3]}); }
#pragma unroll
      for (int j = 0; j < 2; ++j) { tt[j] = zero16();
          tt[j] = __builtin_amdgcn_mfma_f32_32x32x16_bf16(ft[2 * j], id[0], tt[j], 0, 0, 0); tt[j] = __builtin_amdgcn_mfma_f32_32x32x16_bf16(ft[2 * j + 1], id[1], tt[j], 0, 0, 0); } }
    LDS_BARRIER();
    auto put_T = [&](int dir, const LAS float* tab, auto dstf) {
#pragma unroll
        for (int j = 0; j < 2; ++j) {
#pragma unroll
            for (int a4 = 0; a4 < 4; ++a4) { const int n0 = 32 * mt + 8 * a4 + 4 * hh;
                if (dir == 0) { const vf4 sc = *(const LAS vf4*)(tab + n0);
                    st_vu2(dstf(j, n0), (vu2){cvtpk(tt[j][4 * a4] * sc.x, tt[j][4 * a4 + 1] * sc.y), cvtpk(tt[j][4 * a4 + 2] * sc.z, tt[j][4 * a4 + 3] * sc.w)}); }
                else { const int i0 = 60 - n0; const vf4 sc = *(const LAS vf4*)(tab + 64 + i0);
                    st_vu2(dstf(j, i0), (vu2){cvtpk(tt[j][4 * a4 + 3] * sc.x, tt[j][4 * a4 + 2] * sc.y), cvtpk(tt[j][4 * a4 + 1] * sc.z, tt[j][4 * a4] * sc.w)}); } } } };
    auto lds_T = [&](LAS bf16* img) { return [=](int j, int i0) { return img + (64 * nt + 32 * j + r32) * GC_TS + i0; }; };
    auto kdt_T = [&](int dir) { bf16* base = p.GKdT + (size_t)gdn_unit_index(b, c, h, dir) * 128 * 64; return [=](int j, int i0) { return base + (((2 * nt + j) * 4 + (i0 >> 4)) * 64 + ((i0 >> 3) & 1) * 32 + r32) * 8 + (i0 & 7); }; };
    if (prod == 0) { put_T(0, egl, kdt_T(0)); put_T(1, egl, kdt_T(1)); put_T(0, beg, lds_T(KbT)); }
    else {
        const int dir = nt, n = 32 * mt + r32, i = dir ? 63 - n : n; const float sc = eg[dir * 64 + i];
        bf16* base = p.GQd + (size_t)gdn_unit_index(b, c, h, dir) * 64 * 128 + ((size_t)((i >> 5) * 8) * 64 + hh * 32 + (i & 31)) * 8;
#pragma unroll
        for (int q = 0; q < 8; ++q) { float q8[8]; unpack8(__builtin_bit_cast(vu4, fa[q]), q8);
            *(vu4*)(base + q * 512) = (vu4){cvtpk(q8[0] * sc, q8[1] * sc), cvtpk(q8[2] * sc, q8[3] * sc), cvtpk(q8[4] * sc, q8[5] * sc), cvtpk(q8[6] * sc, q8[7] * sc)}; }
        put_T(0, be, lds_T(VbT)); }
#pragma unroll
    for (int it = 0; it < 2; ++it) { const int item = it * 512 + tid, dir = item >> 9, j0 = ((item >> 6) & 7) * 8, i = item & 63, ni = dir ? 63 - i : i;
        float o[8] = {0.f, 0.f, 0.f, 0.f, 0.f, 0.f, 0.f, 0.f};
        if (j0 < i) { const float gi = gc[dir * 64 + i], bi = be[dir * 64 + i]; const vf4 ga = *(const LAS vf4*)(gc + dir * 64 + j0), gb = *(const LAS vf4*)(gc + dir * 64 + j0 + 4);
            const float gj[8] = {ga.x, ga.y, ga.z, ga.w, gb.x, gb.y, gb.z, gb.w};
#pragma unroll
            for (int q = 0; q < 8; ++q) { const int j = j0 + q, nj = dir ? 63 - j : j; o[q] = (i > j) ? bi * KKs[ni * GC_FS + nj] * __expf(gi - gj[q]) : 0.0f; } }
        LAS float* dst = Lm + dir * 64 * GC_LS + i * GC_LS + j0;
        *(LAS vf4*)dst = (vf4){o[0], o[1], o[2], o[3]}; *(LAS vf4*)(dst + 4) = (vf4){o[4], o[5], o[6], o[7]}; }
    LDS_BARRIER();
    if (wave < 2) { __builtin_amdgcn_s_setprio(3); tri_solve_wave(Lm + wave * 64 * GC_LS, Tm + wave * 64 * GC_TS, (LAS bf16*)KKs + wave * 2 * 32 * 40, lane); __builtin_amdgcn_s_setprio(0); }
    else if ((wave & 3) >= 2) { const int t6 = ((wave & 1) | ((wave >> 2) << 1)) * 64 + lane;
        for (int it = t6; it < 2 * 64 * 8; it += 256) { const int dir = it >> 9, j8 = (it >> 6) & 7, i = it & 63, ni = dir ? 63 - i : i; unsigned w[4];
#pragma unroll
            for (int e2 = 0; e2 < 4; ++e2) { float a[2];
#pragma unroll
                for (int q = 0; q < 2; ++q) { const int j = j8 * 8 + 2 * e2 + q; a[q] = (i >= j) ? QKs[ni * GC_FS + (dir ? 63 - j : j)] * __expf(gc[dir * 64 + i] - gc[dir * 64 + j]) : 0.0f; }
                w[e2] = cvtpk(a[0], a[1]); }
            *(vu4*)(p.GA + (size_t)gdn_unit_index(b, c, h, dir) * 64 * 64 + (((i >> 5) * 4 + (j8 >> 1)) * 64 + (j8 & 1) * 32 + (i & 31)) * 8) = (vu4){w[0], w[1], w[2], w[3]}; }
        if (t6 < 2) p.GGL[gdn_unit_index(b, c, h, t6)] = eg[t6 * 64 + 63]; }
    LDS_BARRIER();
    LAS bf16* KbT1 = (LAS bf16*)(lds + G1_KK); LAS bf16* VbT1 = KbT1 + 128 * GC_TS;
    if (prod == 0) put_T(1, beg, lds_T(KbT1)); else put_T(1, be, lds_T(VbT1));
    LDS_BARRIER();
#pragma unroll
    for (int dir = 0; dir < 2; ++dir) {
        const int u = gdn_unit_index(b, c, h, dir); const LAS bf16* Td = Tm + dir * 64 * GC_TS; const LAS bf16* Kd = dir ? KbT1 : KbT; const LAS bf16* Vd = dir ? VbT1 : VbT;
        { const int dt = wave >> 1, it2 = wave & 1; f32x16_t acc = zero16(); acc = mma_lds<4>(acc, Kd + 32 * dt * GC_TS, GC_TS, Td + 32 * it2 * GC_TS, GC_TS, r32, hh);
            bf16* dst = p.GW + (size_t)u * 64 * 128 + ((it2 * 8 + 2 * dt) * 64 + r32) * 8 + 4 * hh;
#pragma unroll
            for (int a4 = 0; a4 < 4; ++a4) *(vu2*)(dst + (a4 >> 1) * 512 + (a4 & 1) * 256) = (vu2){cvtpk(acc[4 * a4], acc[4 * a4 + 1]), cvtpk(acc[4 * a4 + 2], acc[4 * a4 + 3])}; }
        { const int it2 = wave >> 2, dt = wave & 3; f32x16_t acc = zero16(); acc = mma_lds<4>(acc, Td + 32 * it2 * GC_TS, GC_TS, Vd + 32 * dt * GC_TS, GC_TS, r32, hh);
            bf16* dst = p.GUT + (size_t)u * 128 * 64 + ((size_t)((dt * 2 + it2) * 4) * 64 + lane) * 4;
#pragma unroll
            for (int a4 = 0; a4 < 4; ++a4) *(vu2*)(dst + a4 * 256) = (vu2){cvtpk(acc[4 * a4], acc[4 * a4 + 1]), cvtpk(acc[4 * a4 + 2], acc[4 * a4 + 3])}; }
    }
    LDS_BARRIER();
}

template <class F> __device__ __forceinline__ void store_tile_rows(const f32x16_t& a, LAS bf16* T, int lane, F rowptr) {
    const int r32 = lane & 31, hh = lane >> 5;
#pragma unroll
    for (int e = 0; e < 16; ++e) T[((e & 3) + 8 * (e >> 2) + 4 * hh) * 40 + r32] = f2bf(a[e]);
    const int il = lane >> 1, half = lane & 1;
    const vu4 w0 = *(const LAS vu4*)(T + il * 40 + half * 16), w1 = *(const LAS vu4*)(T + il * 40 + half * 16 + 8);
    bf16* dst = rowptr(il) + half * 16;
    *(vu4*)dst = w0; *(vu4*)(dst + 8) = w1;
}
__device__ __forceinline__ void gdn_scan_wg(const Ptrs& p, LAS unsigned char* lds, int chain, int slice, int tid) {
    const int b = chain / (GDN_H * 2), h = (chain >> 1) % GDN_H, dir = chain & 1;
    const int lane = tid & 63, wave = tid >> 6, r32 = lane & 31, hh = lane >> 5;
    LAS bf16* SbT = (LAS bf16*)lds;
    LAS bf16* vnT = SbT + 4 * 32 * GC_KS;
    LAS bf16* otile = vnT + 3 * 32 * GC_TS + (wave & 1) * 32 * 40;
    for (int i = tid; i < 32 * GC_KS / 2; i += 512) ((LAS unsigned*)SbT)[i] = 0u;
    LDS_BARRIER();
    auto chunk_of = [&](int s) { return s < NCH_CTX ? (dir ? NCH_CTX - 1 - s : s) : NCH_CTX + (dir ? NCH - NCH_CTX - 1 - (s - NCH_CTX) : s - NCH_CTX); };
    auto unit_of = [&](int s) { return (size_t)gdn_unit_index(b, chunk_of(s), h, dir); };
    using I0 = std::integral_constant<int, 0>; using I1 = std::integral_constant<int, 1>; using I2 = std::integral_constant<int, 2>; using I3 = std::integral_constant<int, 3>;
    if (wave < 2) {
        __builtin_amdgcn_s_setprio(3);
        int tr = tid; asm volatile("" : "+v"(tr)); const int ln = tr & 63, t = (tr >> 6) & 1;
        bf16x8_t fa[4][8]; vu2 ut[4][4];
        auto prefetch = [&](int s, auto KC2) { constexpr int k = decltype(KC2)::value; const size_t u = unit_of(s);
            const bf16* wp = p.GW + u * 64 * 128 + (size_t)(t * 512 + ln) * 8; const bf16* up = p.GUT + u * 128 * 64 + (size_t)((slice * 2 + t) * 256 + ln) * 4;
#pragma unroll
            for (int q = 0; q < 8; ++q) fa[k][q] = *(const bf16x8_t*)(wp + q * 512);
#pragma unroll
            for (int a4 = 0; a4 < 4; ++a4) ut[k][a4] = *(const vu2*)(up + a4 * 256); };
        auto step = [&](int s, auto KC) { constexpr int k = decltype(KC)::value;
            if (s + 3 < NCH) prefetch(s + 3, std::integral_constant<int, (k + 3) % 4>{});
            const LAS bf16* Sc = SbT + (s & 3) * 32 * GC_KS; LAS bf16* vn = vnT + (s % 3) * 32 * GC_TS;
            f32x16_t acc = zero16(), acc2 = zero16();
#pragma unroll
            for (int qh = 0; qh < 2; ++qh) { bf16x8_t bq[4];
#pragma unroll
                for (int q = 0; q < 4; ++q) bq[q] = *(const LAS bf16x8_t*)(Sc + r32 * GC_KS + 16 * (4 * qh + q) + 8 * hh);
#pragma unroll
                for (int q = 0; q < 4; q += 2) { acc = __builtin_amdgcn_mfma_f32_32x32x16_bf16(fa[k][4 * qh + q], bq[q], acc, 0, 0, 0); acc2 = __builtin_amdgcn_mfma_f32_32x32x16_bf16(fa[k][4 * qh + q + 1], bq[q + 1], acc2, 0, 0, 0); } }
#pragma unroll
            for (int a4 = 0; a4 < 4; ++a4) { const vu2 uw = ut[k][a4];
                *(LAS vu2*)(vn + r32 * GC_TS + 32 * t + 8 * a4 + 4 * hh) = (vu2){cvtpk(bflo(uw.x) - (acc[4 * a4] + acc2[4 * a4]), bfhi(uw.x) - (acc[4 * a4 + 1] + acc2[4 * a4 + 1])), cvtpk(bflo(uw.y) - (acc[4 * a4 + 2] + acc2[4 * a4 + 2]), bfhi(uw.y) - (acc[4 * a4 + 3] + acc2[4 * a4 + 3]))}; }
            LDS_BARRIER(); LDS_BARRIER(); };
        prefetch(0, I0{}); prefetch(1, I1{}); prefetch(2, I2{});
        for (int s = 0; s < NCH; s += 4) { step(s, I0{}); step(s + 1, I1{}); step(s + 2, I2{}); step(s + 3, I3{}); }
        __builtin_amdgcn_s_setprio(0);
    } else if (wave >= 4) {
        __builtin_amdgcn_s_setprio(3);
        int tr = tid; asm volatile("" : "+v"(tr)); const int ln = tr & 63, rr = (tr >> 6) & 3;
        int zl = 0; asm volatile("v_mov_b32 %0, 0" : "=v"(zl));
        bf16x8_t fb[8][4]; float gl[8] = {0.f, 0.f, 0.f, 0.f, 0.f, 0.f, 0.f, 0.f}; f32x16_t S = zero16();
        auto prefetch = [&](int s, auto KC2) { constexpr int k = decltype(KC2)::value; const size_t u = unit_of(s);
            const bf16* kp = p.GKdT + u * 128 * 64 + (size_t)(rr * 256 + ln) * 8;
#pragma unroll
            for (int q = 0; q < 4; ++q) fb[k][q] = *(const bf16x8_t*)(kp + q * 512);
            gl[k] = p.GGL[u + zl]; };
        auto step = [&](int s, auto KC) { constexpr int k = decltype(KC)::value;
            if (s + 7 < NCH) prefetch(s + 7, std::integral_constant<int, (k + 7) % 8>{});
            const LAS bf16* vn = vnT + (s % 3) * 32 * GC_TS; LAS bf16* Sn = SbT + ((s + 1) & 3) * 32 * GC_KS;
            const float g1 = gl[k];
#pragma unroll
            for (int e = 0; e < 16; ++e) S[e] *= g1;
            LDS_BARRIER();
            bf16x8_t bq[4];
#pragma unroll
            for (int q = 0; q < 4; ++q) bq[q] = *(const LAS bf16x8_t*)(vn + r32 * GC_TS + 16 * q + 8 * hh);
#pragma unroll
            for (int q = 0; q < 4; ++q) S = __builtin_amdgcn_mfma_f32_32x32x16_bf16(fb[k][q], bq[q], S, 0, 0, 0);
#pragma unroll
            for (int a4 = 0; a4 < 4; ++a4) *(LAS vu2*)(Sn + r32 * GC_KS + 32 * rr + 8 * a4 + 4 * hh) = (vu2){cvtpk(S[4 * a4], S[4 * a4 + 1]), cvtpk(S[4 * a4 + 2], S[4 * a4 + 3])};
            LDS_BARRIER(); };
        using I4 = std::integral_constant<int, 4>; using I5 = std::integral_constant<int, 5>; using I6 = std::integral_constant<int, 6>; using I7 = std::integral_constant<int, 7>;
        prefetch(0, I0{}); prefetch(1, I1{}); prefetch(2, I2{}); prefetch(3, I3{}); prefetch(4, I4{}); prefetch(5, I5{}); prefetch(6, I6{});
        for (int s = 0; s + 7 < NCH; s += 8) { step(s, I0{}); step(s + 1, I1{}); step(s + 2, I2{}); step(s + 3, I3{}); step(s + 4, I4{}); step(s + 5, I5{}); step(s + 6, I6{}); step(s + 7, I7{}); }
        step(NCH - 4, I0{}); step(NCH - 3, I1{}); step(NCH - 2, I2{}); step(NCH - 1, I3{});
        __builtin_amdgcn_s_setprio(0);
    } else {
        int tr = tid; asm volatile("" : "+v"(tr)); const int ln = tr & 63, t = (tr >> 6) & 1;
        bf16x8_t fa[3][8], fb[3][4];
        auto prefetch = [&](int s, auto KC2) { constexpr int k = decltype(KC2)::value; const size_t u = unit_of(s);
            const bf16* qp = p.GQd + u * 64 * 128 + (size_t)(t * 512 + ln) * 8; const bf16* ap = p.GA + u * 64 * 64 + (size_t)(t * 256 + ln) * 8;
#pragma unroll
            for (int q = 0; q < 8; ++q) fa[k][q] = *(const bf16x8_t*)(qp + q * 512);
#pragma unroll
            for (int q = 0; q < 4; ++q) fb[k][q] = *(const bf16x8_t*)(ap + q * 512); };
        auto out_of = [&](int so, auto KC) { constexpr int k = decltype(KC)::value;
            const LAS bf16* Sc = SbT + (so & 3) * 32 * GC_KS; const LAS bf16* vn = vnT + (so % 3) * 32 * GC_TS;
            f32x16_t acc = zero16(), acc2 = zero16();
#pragma unroll
            for (int qh = 0; qh < 2; ++qh) { bf16x8_t bq[4];
#pragma unroll
                for (int q = 0; q < 4; ++q) bq[q] = *(const LAS bf16x8_t*)(Sc + r32 * GC_KS + 16 * (4 * qh + q) + 8 * hh);
#pragma unroll
                for (int q = 0; q < 4; q += 2) { acc = __builtin_amdgcn_mfma_f32_32x32x16_bf16(fa[k][4 * qh + q], bq[q], acc, 0, 0, 0); acc2 = __builtin_amdgcn_mfma_f32_32x32x16_bf16(fa[k][4 * qh + q + 1], bq[q + 1], acc2, 0, 0, 0); } }
            { bf16x8_t bv[4];
#pragma unroll
              for (int q = 0; q < 4; ++q) bv[q] = *(const LAS bf16x8_t*)(vn + r32 * GC_TS + 16 * q + 8 * hh);
#pragma unroll
              for (int q = 0; q < 4; q += 2) { acc = __builtin_amdgcn_mfma_f32_32x32x16_bf16(fb[k][q], bv[q], acc, 0, 0, 0); acc2 = __builtin_amdgcn_mfma_f32_32x32x16_bf16(fb[k][q + 1], bv[q + 1], acc2, 0, 0, 0); } }
            const int r0 = chunk_row0(b, chunk_of(so));
#pragma unroll
            for (int e = 0; e < 16; ++e) acc[e] += acc2[e];
            store_tile_rows(acc, otile, lane, [&](int il) { const int i = 32 * t + il; return p.OGb + ((size_t)dir * MROWS + r0 + (dir ? 63 - i : i)) * MIX_W + h * 128 + slice * 32; }); };
        auto step = [&](int s, auto KC) { constexpr int k = decltype(KC)::value;
            if (s > 1) out_of(s - 2, std::integral_constant<int, (k + 1) % 3>{});
            if (s + 1 < NCH) prefetch(s + 1, std::integral_constant<int, (k + 1) % 3>{});
            LDS_BARRIER(); LDS_BARRIER(); };
        prefetch(0, I0{});
        for (int s = 0; s + 2 < NCH; s += 3) { step(s, I0{}); step(s + 1, I1{}); step(s + 2, I2{}); }
        step(NCH - 2, std::integral_constant<int, (NCH - 2) % 3>{}); step(NCH - 1, std::integral_constant<int, (NCH - 1) % 3>{});
        out_of(NCH - 2, std::integral_constant<int, (NCH - 2) % 3>{}); out_of(NCH - 1, std::integral_constant<int, (NCH - 1) % 3>{});
    }
}
static_assert(G1_END <= 146432 && NCH % 8 == 4 && NCH % 3 == 2, "G1 LDS map / scan unroll");

constexpr int SSD_NU = BATCH * NCH * SSM_H * 2;
__device__ __forceinline__ int ssd_unit_index(int b, int c, int hd, int dir) { return ((b * NCH + c) * SSM_H + hd) * 2 + dir; }
constexpr int SL_BN = 0, SL_CN = SL_BN + 64 * GC_KS * 2, SL_CB = SL_CN + 64 * GC_KS * 2, SL_BT = SL_CB + 64 * GC_FS * 4, SL_XT = SL_BT + 128 * GC_TS * 2, SL_M = SL_XT + 256 * GC_TS * 2,
              SL_XW = SL_M + 64 * GC_TS * 2, SL_SM = SL_XW + 2 * 64 * GC_TS * 2, SL_END = SL_SM + 8 * 3 * 64 * 4;
static_assert(SL_END <= 146432, "ssd local LDS map");
constexpr int SSD_LOCAL_UNITS = BATCH * NCH * SSM_G * 2;
__device__ __forceinline__ void ssd_local_unit(const Ptrs& p, LAS unsigned char* lds, int unit, int tid) {
    const int lane = tid & 63, wave = tid >> 6, r32 = lane & 31, hh = lane >> 5;
    const int b = unit / (NCH * SSM_G * 2), c = (unit / (SSM_G * 2)) % NCH, g = (unit >> 1) % SSM_G, hq = unit & 1;
    const int r0 = chunk_row0(b, c), hd0 = g * SSM_HPG + hq * 4;
    LAS bf16* Bn = (LAS bf16*)(lds + SL_BN); LAS bf16* Cn = (LAS bf16*)(lds + SL_CN); LAS float* CBs = (LAS float*)(lds + SL_CB); LAS bf16* BT = (LAS bf16*)(lds + SL_BT);
    LAS bf16* XT = (LAS bf16*)(lds + SL_XT); LAS bf16* Mm = (LAS bf16*)(lds + SL_M); LAS bf16* XwT = (LAS bf16*)(lds + SL_XW); LAS float* sm = (LAS float*)(lds + SL_SM);
#pragma unroll
    for (int it = 0; it < 4; ++it) { const int idx = it * 512 + tid, row = idx >> 5, which = (idx >> 4) & 1, c8 = idx & 15;
        *(LAS vu4*)((which ? Cn : Bn) + row * GC_KS + c8 * 8) = *(const vu4*)(p.SBCb + (size_t)(r0 + row) * (2 * SSM_BC) + which * SSM_BC + g * SSM_N + c8 * 8); }
    { vu4 xv[4];
#pragma unroll
        for (int it = 0; it < 4; ++it) { const int idx = it * 512 + tid, j = idx >> 5, p8 = idx & 31; xv[it] = *(const vu4*)(p.SXb + (size_t)(r0 + j) * MIX_W + hd0 * SSM_P + p8 * 8); }
#pragma unroll
        for (int it = 0; it < 4; ++it) { const int idx = it * 512 + tid, j = idx >> 5, p8 = idx & 31; const unsigned w4[4] = {xv[it].x, xv[it].y, xv[it].z, xv[it].w};
#pragma unroll
            for (int e = 0; e < 4; ++e) { XT[(8 * p8 + 2 * e) * GC_TS + j] = (bf16)(w4[e] & 0xffffu); XT[(8 * p8 + 2 * e + 1) * GC_TS + j] = (bf16)(w4[e] >> 16); } } }
    { const int hd = hd0 + (wave >> 1), dir = wave & 1, n = dir ? 63 - lane : lane; const size_t gi = (size_t)(r0 + n) * 2 * SSM_H + dir * SSM_H + hd; const int u = ssd_unit_index(b, c, hd, dir);
        float x = p.SA[gi]; const float dt = p.SDT[gi];
#pragma unroll
        for (int o = 1; o < 64; o <<= 1) { const float y = __shfl_up(x, o); if (lane >= o) x += y; }
        const float x63 = __shfl(x, 63);
        sm[(wave * 3 + 0) * 64 + lane] = x; sm[(wave * 3 + 1) * 64 + lane] = dt; sm[(wave * 3 + 2) * 64 + lane] = __expf(x63 - x) * dt;
        p.SEAb[(size_t)u * 64 + lane] = f2bf(__expf(x)); if (lane == 63) p.SDC[u] = __expf(x); }
    LDS_BARRIER();
    *(vu4*)(p.SCF + ((((size_t)(b * NCH + c) * SSM_G + g) * 2 + hq) * 8 + wave) * 512 + lane * 8) = *(const LAS vu4*)(Cn + (32 * hq + r32) * GC_KS + 16 * wave + 8 * hh);
    if (wave < 4) { const int mt = wave >> 1, nt = wave & 1; f32x16_t acc = zero16(); acc = mma_lds<8>(acc, Cn + 32 * mt * GC_KS, GC_KS, Bn + 32 * nt * GC_KS, GC_KS, r32, hh);
#pragma unroll
        for (int e = 0; e < 16; ++e) CBs[(32 * mt + (e & 3) + 8 * (e >> 2) + 4 * hh) * GC_FS + 32 * nt + r32] = acc[e]; }
    else { for (int it = tid - 256; it < 128 * 8; it += 256) { const int s = it >> 3, j8 = it & 7; unsigned w[4];
#pragma unroll
            for (int e2 = 0; e2 < 4; ++e2) w[e2] = (unsigned)Bn[(j8 * 8 + 2 * e2) * GC_KS + s] | ((unsigned)Bn[(j8 * 8 + 2 * e2 + 1) * GC_KS + s] << 16);
            *(LAS vu4*)(BT + s * GC_TS + j8 * 8) = (vu4){w[0], w[1], w[2], w[3]}; } }
    LDS_BARRIER();
#pragma unroll 1
    for (int hl = 0; hl < 4; ++hl) {
        const int hd = hd0 + hl;
        const LAS float* ac0 = sm + (hl * 2 * 3) * 64; const LAS float* ac1 = ac0 + 3 * 64;
        { const int n = tid >> 3, n8 = tid & 7; unsigned w[4];
            const float a0n = ac0[n], a1n = ac1[63 - n];
#pragma unroll
            for (int e2 = 0; e2 < 4; ++e2) { float a[2];
#pragma unroll
                for (int q = 0; q < 2; ++q) { const int nj = n8 * 8 + 2 * e2 + q; const bool lo = nj <= n;
                    const float ex = __expf(lo ? a0n - ac0[nj] : a1n - ac1[63 - nj]);
                    const float dd = (nj < n) ? ac0[64 + nj] : (nj > n) ? ac1[64 + 63 - nj] : ac0[64 + nj] + ac1[64 + 63 - nj];
                    a[q] = CBs[n * GC_FS + nj] * ex * dd; }
                w[e2] = cvtpk(a[0], a[1]); }
            *(LAS vu4*)(Mm + n * GC_TS + n8 * 8) = (vu4){w[0], w[1], w[2], w[3]};
            const int pp = tid >> 3; float xs[8]; unpack8(*(const LAS vu4*)(XT + (hl * 64 + pp) * GC_TS + n8 * 8), xs);
#pragma unroll
            for (int e2 = 0; e2 < 4; ++e2) { const int nj = n8 * 8 + 2 * e2; w[e2] = cvtpk(xs[2 * e2] * ac0[128 + nj], xs[2 * e2 + 1] * ac0[128 + nj + 1]); }
            *(LAS vu4*)(XwT + pp * GC_TS + n8 * 8) = (vu4){w[0], w[1], w[2], w[3]};
#pragma unroll
            for (int e2 = 0; e2 < 4; ++e2) { const int nj = n8 * 8 + 2 * e2; w[e2] = cvtpk(xs[2 * e2] * ac1[128 + 63 - nj], xs[2 * e2 + 1] * ac1[128 + 62 - nj]); }
            *(LAS vu4*)(XwT + (64 + pp) * GC_TS + n8 * 8) = (vu4){w[0], w[1], w[2], w[3]}; }
        LDS_BARRIER();
#pragma unroll
        for (int dir = 0; dir < 2; ++dir) { const int sb = wave >> 1, pb = wave & 1, u = ssd_unit_index(b, c, hd, dir); f32x16_t acc = zero16();
            acc = mma_lds<4>(acc, BT + 32 * sb * GC_TS, GC_TS, XwT + (64 * dir + 32 * pb) * GC_TS, GC_TS, r32, hh);
            bf16* dst = p.SSC + (((size_t)u * 8 + wave) * 64 + lane) * 16;
            *(vu4*)dst = (vu4){cvtpk(acc[0], acc[1]), cvtpk(acc[2], acc[3]), cvtpk(acc[4], acc[5]), cvtpk(acc[6], acc[7])};
            *(vu4*)(dst + 8) = (vu4){cvtpk(acc[8], acc[9]), cvtpk(acc[10], acc[11]), cvtpk(acc[12], acc[13]), cvtpk(acc[14], acc[15])}; }
        if (wave < 4) { const int mt = wave >> 1, pb = wave & 1; f32x16_t acc = zero16(); acc = mma_lds<4>(acc, Mm + 32 * mt * GC_TS, GC_TS, XT + (hl * 64 + 32 * pb) * GC_TS, GC_TS, r32, hh);
#pragma unroll
            for (int e = 0; e < 16; ++e) { const int n = 32 * mt + (e & 3) + 8 * (e >> 2) + 4 * hh;
                p.OSb[((size_t)r0 + n) * MIX_W + hd * SSM_P + 32 * pb + r32] = f2bf(acc[e]); } }
        LDS_BARRIER();
    }
}
__device__ __forceinline__ void ssd_scan_wg(const Ptrs& p, LAS unsigned char* lds, int chain, int tid) {
    const int b = chain / (SSM_H * 2), hd = (chain >> 1) % SSM_H, dir = chain & 1, g = hd / SSM_HPG;
    const int lane = tid & 63, wave = tid >> 6, r32 = lane & 31, hh = lane >> 5;
    int zl = 0; asm volatile("v_mov_b32 %0, 0" : "=v"(zl));
    LAS bf16* hT = (LAS bf16*)lds;
    for (int i = tid; i < 64 * GC_KS / 2; i += 512) ((LAS unsigned*)hT)[i] = 0u;
    LDS_BARRIER();
    auto chunk_of = [&](int s) { return s < NCH_CTX ? (dir ? NCH_CTX - 1 - s : s) : NCH_CTX + (dir ? NCH - NCH_CTX - 1 - (s - NCH_CTX) : s - NCH_CTX); };
    using I0 = std::integral_constant<int, 0>; using I1 = std::integral_constant<int, 1>; using I2 = std::integral_constant<int, 2>; using I3 = std::integral_constant<int, 3>;
    if (wave >= 4) {
        __builtin_amdgcn_s_setprio(3);
        const int hw = wave - 4;
        f32x16_t h0 = zero16(), h1 = zero16();
        vu4 sc[4][4]; float dec[4] = {0.f, 0.f, 0.f, 0.f};
        auto pre_h = [&](int s, auto KC2) { constexpr int k = decltype(KC2)::value; const size_t u = (size_t)ssd_unit_index(b, chunk_of(s), hd, dir);
            const bf16* sp = p.SSC + ((u * 8 + 2 * hw) * 64 + lane) * 16; sc[k][0] = *(const vu4*)sp; sc[k][1] = *(const vu4*)(sp + 8); sc[k][2] = *(const vu4*)(sp + 1024); sc[k][3] = *(const vu4*)(sp + 1024 + 8); dec[k] = p.SDC[u + zl]; };
        auto step = [&](int s, auto KC) { constexpr int k = decltype(KC)::value;
            const unsigned w0[8] = {sc[k][0].x, sc[k][0].y, sc[k][0].z, sc[k][0].w, sc[k][1].x, sc[k][1].y, sc[k][1].z, sc[k][1].w}, w1[8] = {sc[k][2].x, sc[k][2].y, sc[k][2].z, sc[k][2].w, sc[k][3].x, sc[k][3].y, sc[k][3].z, sc[k][3].w};
            const float d1 = dec[k];
#pragma unroll
            for (int e2 = 0; e2 < 8; ++e2) { h0[2 * e2] = h0[2 * e2] * d1 + bflo(w0[e2]); h0[2 * e2 + 1] = h0[2 * e2 + 1] * d1 + bfhi(w0[e2]); h1[2 * e2] = h1[2 * e2] * d1 + bflo(w1[e2]); h1[2 * e2 + 1] = h1[2 * e2 + 1] * d1 + bfhi(w1[e2]); }
            if (s + 3 < NCH) pre_h(s + 3, std::integral_constant<int, (k + 3) % 4>{});
            LAS bf16* Hn = hT + ((s + 1) & 3) * 64 * GC_KS;
#pragma unroll
            for (int a4 = 0; a4 < 4; ++a4) { *(LAS vu2*)(Hn + r32 * GC_KS + 32 * hw + 8 * a4 + 4 * hh) = (vu2){cvtpk(h0[4 * a4], h0[4 * a4 + 1]), cvtpk(h0[4 * a4 + 2], h0[4 * a4 + 3])};
                *(LAS vu2*)(Hn + (32 + r32) * GC_KS + 32 * hw + 8 * a4 + 4 * hh) = (vu2){cvtpk(h1[4 * a4], h1[4 * a4 + 1]), cvtpk(h1[4 * a4 + 2], h1[4 * a4 + 3])}; }
            LDS_BARRIER(); };
        pre_h(0, I0{}); pre_h(1, I1{}); pre_h(2, I2{});
        for (int s = 0; s < NCH; s += 4) { step(s, I0{}); step(s + 1, I1{}); step(s + 2, I2{}); step(s + 3, I3{}); }
        __builtin_amdgcn_s_setprio(0);
    } else {
        const int mt = wave >> 1, pb = wave & 1;
        LAS bf16* otile = hT + 4 * 64 * GC_KS + wave * 32 * 40;
        bf16x8_t cf[3][8]; vu2 ea[3][4];
        auto pre_y = [&](int s, auto KC2) { constexpr int k = decltype(KC2)::value; const int c = chunk_of(s); const size_t u = (size_t)ssd_unit_index(b, c, hd, dir); const int r0 = chunk_row0(b, c);
            const bf16* cp = p.SCF + ((((size_t)(b * NCH + c) * SSM_G + g) * 2 + (dir ? 1 - mt : mt)) * 8) * 512 + (hh * 32 + (dir ? 31 - r32 : r32)) * 8;
#pragma unroll
            for (int q = 0; q < 8; ++q) cf[k][q] = *(const bf16x8_t*)(cp + q * 512);
#pragma unroll
            for (int a4 = 0; a4 < 4; ++a4) ea[k][a4] = *(const vu2*)(p.SEAb + u * 64 + 32 * mt + 8 * a4 + 4 * hh); };
        auto out_y = [&](int so, auto KC) { constexpr int k = decltype(KC)::value;
            const LAS bf16* Hc = hT + (so & 3) * 64 * GC_KS;
            f32x16_t acc = zero16(), acc2 = zero16();
#pragma unroll
            for (int qh = 0; qh < 2; ++qh) { bf16x8_t bq[4];
#pragma unroll
                for (int q = 0; q < 4; ++q) bq[q] = *(const LAS bf16x8_t*)(Hc + (32 * pb + r32) * GC_KS + 16 * (4 * qh + q) + 8 * hh);
#pragma unroll
                for (int q = 0; q < 4; q += 2) { acc = __builtin_amdgcn_mfma_f32_32x32x16_bf16(cf[k][4 * qh + q], bq[q], acc, 0, 0, 0); acc2 = __builtin_amdgcn_mfma_f32_32x32x16_bf16(cf[k][4 * qh + q + 1], bq[q + 1], acc2, 0, 0, 0); } }
            const int r0 = chunk_row0(b, chunk_of(so));
#pragma unroll
            for (int e = 0; e < 16; ++e) { const unsigned ew = (e & 2) ? ea[k][e >> 2].y : ea[k][e >> 2].x; const float ev = (e & 1) ? bfhi(ew) : bflo(ew); acc[e] = ev * (acc[e] + acc2[e]); }
            store_tile_rows(acc, otile, lane, [&](int il) { const int i = 32 * mt + il; return p.OSb2 + ((size_t)dir * MROWS + r0 + (dir ? 63 - i : i)) * MIX_W + hd * SSM_P + 32 * pb; }); };
        auto step = [&](int s, auto KC) { constexpr int k = decltype(KC)::value;
            if (s > 1) out_y(s - 2, std::integral_constant<int, (k + 1) % 3>{});
            if (s + 1 < NCH) pre_y(s + 1, std::integral_constant<int, (k + 1) % 3>{});
            LDS_BARRIER(); };
        pre_y(0, I0{});
        for (int s = 0; s + 2 < NCH; s += 3) { step(s, I0{}); step(s + 1, I1{}); step(s + 2, I2{}); }
        step(NCH - 2, std::integral_constant<int, (NCH - 2) % 3>{}); step(NCH - 1, std::integral_constant<int, (NCH - 1) % 3>{});
        out_y(NCH - 2, std::integral_constant<int, (NCH - 2) % 3>{}); out_y(NCH - 1, std::integral_constant<int, (NCH - 1) % 3>{});
    }
}


namespace pg8 {
struct EpiInProj {
    static constexpr bool PERM = true, AFTER_DRAIN = false, KHOOK = false;
    bf16_t* P; float* PF;
    __device__ __forceinline__ void operator()(const f32x4 (&acc)[2][2][4][2], const Unit& u, int wr, int wc, int fr, int fq) const {
        const int row0 = u.pm * BM + wr * 64 + fr;
        if (u.pn * BM < NP_MAIN) {
            const int col0 = u.pn * BM + wc * 32 + 8 * fq;
#pragma unroll
            for (int ai = 0; ai < 2; ++ai)
#pragma unroll
                for (int m = 0; m < 4; ++m) { bf16_t* rowp = P + (size_t)(row0 + ai * HALF + m * 16) * NP_MAIN + col0;
#pragma unroll
                    for (int bj = 0; bj < 2; ++bj) { const f32x4 v0 = acc[ai][bj][m][0], v1 = acc[ai][bj][m][1];
                        u32x4 w; w.x = cvt_pk_bf16(v0[0], v0[1]); w.y = cvt_pk_bf16(v0[2], v0[3]); w.z = cvt_pk_bf16(v1[0], v1[1]); w.w = cvt_pk_bf16(v1[2], v1[3]);
                        *(u32x4*)(rowp + bj * HALF) = w; } }
        } else {
#pragma unroll
            for (int ai = 0; ai < 2; ++ai)
#pragma unroll
                for (int m = 0; m < 4; ++m) { float* rowp = PF + (size_t)(row0 + ai * HALF + m * 16) * PF_N;
#pragma unroll
                    for (int bj = 0; bj < 2; ++bj) { const int c = bj * HALF + wc * 32 + 8 * fq;
                        if (c < PF_N) { *(f32x4*)(rowp + c) = acc[ai][bj][m][0]; *(f32x4*)(rowp + c + 4) = acc[ai][bj][m][1]; } } }
        }
    }
};
struct EpiMerge {
    static constexpr bool PERM = true, AFTER_DRAIN = false, KHOOK = false;
    const bf16_t* G0; bf16_t* TB;
    __device__ __forceinline__ void operator()(const f32x4 (&acc)[2][2][4][2], const Unit& u, int wr, int wc, int fr, int fq) const {
        const int row0 = u.pm * BM + wr * 64 + fr, col0 = u.pn * BM + wc * 32 + 8 * fq, br = u.pk / MIX_W; const bf16_t* G = G0 + br * D_MODEL;
#pragma unroll
        for (int ai = 0; ai < 2; ++ai)
#pragma unroll
            for (int m = 0; m < 4; ++m) { const size_t row = (size_t)(row0 + ai * HALF + m * 16);
#pragma unroll
                for (int bj = 0; bj < 2; ++bj) { const int col = col0 + bj * HALF;
                    const u32x4 gw = *(const u32x4*)(G + row * NP_MAIN + col);
                    float gt[8];
#pragma unroll
                    for (int j = 0; j < 4; ++j) { gt[2 * j] = __uint_as_float(gw[j] << 16); gt[2 * j + 1] = __uint_as_float(gw[j] & 0xffff0000u); }
                    f32x4 t0, t1;
#pragma unroll
                    for (int j = 0; j < 4; ++j) { t0[j] = acc[ai][bj][m][0][j] * __builtin_amdgcn_rcpf(1.0f + __expf(-gt[j])); t1[j] = acc[ai][bj][m][1][j] * __builtin_amdgcn_rcpf(1.0f + __expf(-gt[4 + j])); }
                    u32x4 w; w.x = cvt_pk_bf16(t0[0], t0[1]); w.y = cvt_pk_bf16(t0[2], t0[3]); w.z = cvt_pk_bf16(t1[0], t1[1]); w.w = cvt_pk_bf16(t1[2], t1[3]);
                    *(u32x4*)(TB + ((size_t)br * NCTX + (row - NLAT)) * D_MODEL + col) = w; } }
    }
};
struct EpiF32Plain {
    static constexpr bool PERM = false, AFTER_DRAIN = false, KHOOK = false;
    float* C; int ldc;
    __device__ __forceinline__ void operator()(const f32x4 (&acc)[2][2][4][2], const Unit& u, int wr, int wc, int fr, int fq) const {
        const int row0 = u.pm * BM + wr * 64 + fr, col0 = u.pn * BM + wc * 32 + 4 * fq;
#pragma unroll
        for (int ai = 0; ai < 2; ++ai)
#pragma unroll
            for (int m = 0; m < 4; ++m) { float* rowp = C + (size_t)(row0 + ai * HALF + m * 16) * ldc + col0;
#pragma unroll
                for (int bj = 0; bj < 2; ++bj)
#pragma unroll
                    for (int n = 0; n < 2; ++n) *(f32x4*)(rowp + bj * HALF + n * 16) = acc[ai][bj][m][n]; }
    }
};
struct EpiBf16Plain {
    static constexpr bool PERM = true, AFTER_DRAIN = false, KHOOK = false;
    bf16_t* O; int ldc;
    __device__ __forceinline__ void operator()(const f32x4 (&acc)[2][2][4][2], const Unit& u, int wr, int wc, int fr, int fq) const {
        const int row0 = u.pm * BM + wr * 64 + fr, col0 = u.pn * BM + wc * 32 + 8 * fq;
#pragma unroll
        for (int ai = 0; ai < 2; ++ai)
#pragma unroll
            for (int m = 0; m < 4; ++m) { bf16_t* rowp = O + (size_t)(row0 + ai * HALF + m * 16) * ldc + col0;
#pragma unroll
                for (int bj = 0; bj < 2; ++bj) { const f32x4 v0 = acc[ai][bj][m][0], v1 = acc[ai][bj][m][1];
                    u32x4 w; w.x = cvt_pk_bf16(v0[0], v0[1]); w.y = cvt_pk_bf16(v0[2], v0[3]); w.z = cvt_pk_bf16(v1[0], v1[1]); w.w = cvt_pk_bf16(v1[2], v1[3]);
                    *(u32x4*)(rowp + bj * HALF) = w; } }
    }
};

struct EpiAct {
    static constexpr bool PERM = true, AFTER_DRAIN = false, KHOOK = false;
    bf16_t* ACT; float* BP; bf16_t* BU; bf16_t* BG; const float* cw; const float* cb;
    __device__ __forceinline__ void operator()(const f32x4 (&acc)[2][2][4][2], const Unit& u, int wr, int wc, int fr, int fq) const {
        const int lp = (fq * 16 + ((fr + 15) & 15)) * 4, ln = (fq * 16 + ((fr + 1) & 15)) * 4;
#pragma unroll
        for (int n = 0; n < 2; ++n) {
            const int j0 = u.pn * 128 + wc * 32 + 8 * fq + 4 * n;
            const f32x4 w0 = *(const f32x4*)(cw + j0), w1 = *(const f32x4*)(cw + D_FF + j0), w2 = *(const f32x4*)(cw + 2 * D_FF + j0), bs = *(const f32x4*)(cb + j0);
#pragma unroll
            for (int ai = 0; ai < 2; ++ai) {
#pragma unroll
                for (int m = 0; m < 4; ++m) {
                    const int row = u.pm * BM + ai * HALF + wr * 64 + m * 16 + fr;
                    const bool hp = !(m == 0 && fr == 0), hn = !(m == 3 && fr == 15);
                    f32x4 gp, gn;
#pragma unroll
                    for (int e = 0; e < 4; ++e) { const float gc = acc[ai][1][m][n][e], gm = acc[ai][1][m > 0 ? m - 1 : 0][n][e], gq = acc[ai][1][m < 3 ? m + 1 : 3][n][e];
                        gp[e] = __int_as_float(__builtin_amdgcn_ds_bpermute(lp, __float_as_int(fr == 15 ? gm : gc)));
                        gn[e] = __int_as_float(__builtin_amdgcn_ds_bpermute(ln, __float_as_int(fr == 0 ? gq : gc))); }
                    const f32x4 g = acc[ai][1][m][n], uu = acc[ai][0][m][n];
                    f32x4 pre = w1 * g + bs;
                    if (hp) pre += w0 * gp;
                    if (hn) pre += w2 * gn;
                    if (hp && hn) {
                        f32x4 a;
#pragma unroll
                        for (int e = 0; e < 4; ++e) a[e] = pre[e] * __builtin_amdgcn_rcpf(1.0f + __expf(-pre[e])) * uu[e];
                        typedef unsigned u32x2 __attribute__((ext_vector_type(2)));
                        u32x2 w; w.x = cvt_pk_bf16(a[0], a[1]); w.y = cvt_pk_bf16(a[2], a[3]);
                        *(u32x2*)(ACT + (size_t)row * D_FF + j0) = w;
                    } else {
                        const size_t bi = (size_t)((row >> 6) * 2 + ((row & 63) == 63 ? 1 : 0)) * D_FF + j0;
                        typedef unsigned u32x2 __attribute__((ext_vector_type(2)));
                        *(f32x4*)(BP + bi) = pre;
                        u32x2 wu; wu.x = cvt_pk_bf16(uu[0], uu[1]); wu.y = cvt_pk_bf16(uu[2], uu[3]); *(u32x2*)(BU + bi) = wu;
                        u32x2 wg; wg.x = cvt_pk_bf16(g[0], g[1]); wg.y = cvt_pk_bf16(g[2], g[3]); *(u32x2*)(BG + bi) = wg;
                    }
                }
            }
        }
    }
};

constexpr int SPLIT_KS = 512, OUT_NS = D_MODEL / SPLIT_KS, DOWN_NS = D_FF / SPLIT_KS;
static_assert(D_MODEL % SPLIT_KS == 0 && D_FF % SPLIT_KS == 0 && NCTX % 256 == 0, "split-K context units");
struct SplitOrder {
    int ns, G, c;
    __device__ __forceinline__ bool next(int i, Unit& u) const { const int L = i * G + c; if (L >= (NCTX / 256) * (D_MODEL / 256) * ns) return false;
        const int ks = L % ns, tile = L / ns; u.pm = NLAT / 256 + tile / (D_MODEL / 256); u.pn = tile % (D_MODEL / 256); u.pk = ks * SPLIT_KS; return true; }
    __device__ __forceinline__ void a_ready(const Unit&) const {}
    __device__ __forceinline__ void done(const Unit&) const {}
};
struct SplitOrder3 {
    int G, c;
    __device__ __forceinline__ bool next(int i, Unit& u) const { const int L = i * G + c; constexpr int NT = (NCTX / 256) * (D_MODEL / 256); if (L >= NT * 3 * OUT_NS) return false;
        const int ks = L % OUT_NS, br = (L / OUT_NS) % 3, tile = L / (3 * OUT_NS); u.pm = br * (NCTX / 256) + tile / (D_MODEL / 256); u.pn = tile % (D_MODEL / 256); u.pk = ks * SPLIT_KS; return true; }
    __device__ __forceinline__ void a_ready(const Unit&) const {}
    __device__ __forceinline__ void done(const Unit&) const {}
};
struct EpiSlab3 {
    static constexpr bool PERM = false, AFTER_DRAIN = false, KHOOK = false;
    float* S;
    __device__ __forceinline__ void operator()(const f32x4 (&acc)[2][2][4][2], const Unit& u, int wr, int wc, int fr, int fq) const {
        const int br = u.pm / (NCTX / 256), ct = u.pm % (NCTX / 256);
        const int row0 = ct * BM + wr * 64 + fr, col0 = u.pn * BM + wc * 32 + 4 * fq; float* base = S + (size_t)(br * OUT_NS + u.pk / SPLIT_KS) * NCTX * D_MODEL;
#pragma unroll
        for (int ai = 0; ai < 2; ++ai)
#pragma unroll
            for (int m = 0; m < 4; ++m) { float* rowp = base + (size_t)(row0 + ai * HALF + m * 16) * D_MODEL + col0;
#pragma unroll
                for (int bj = 0; bj < 2; ++bj)
#pragma unroll
                    for (int n = 0; n < 2; ++n) *(f32x4*)(rowp + bj * HALF + n * 16) = acc[ai][bj][m][n]; }
    }
};

struct EpiMerge3 {
    static constexpr bool PERM = true, AFTER_DRAIN = false, KHOOK = true;
    const bf16_t* G0; bf16_t* MB;
    __device__ __forceinline__ void khook(f32x4 (&acc)[2][2][4][2], const Unit& u, int t, int wr, int wc, int fr, int fq) const {
        if (t != MIX_W / BK && t != 2 * MIX_W / BK) return;
        const int bp = t / (MIX_W / BK) - 1;
        const int row0 = u.pm * BM + wr * 64 + fr, col0 = u.pn * BM + wc * 32 + 8 * fq; const bf16_t* Gp = G0 + bp * D_MODEL;
#pragma unroll
        for (int ai = 0; ai < 2; ++ai) {
            asm volatile("" ::: "memory");
#pragma unroll
            for (int m = 0; m < 4; ++m) { const unsigned rowo = (unsigned)(row0 + ai * HALF + m * 16) * (unsigned)NP_MAIN;
#pragma unroll
                for (int bj = 0; bj < 2; ++bj) { const unsigned off = rowo + (unsigned)(col0 + bj * HALF);
                    const u32x4 gp = *(const u32x4*)(Gp + off), gn = *(const u32x4*)(Gp + D_MODEL + off);
#pragma unroll
                    for (int j = 0; j < 4; ++j) { const float p0 = __uint_as_float(gp[j] << 16), p1 = __uint_as_float(gp[j] & 0xffff0000u), n0 = __uint_as_float(gn[j] << 16), n1 = __uint_as_float(gn[j] & 0xffff0000u);
                        const float r0 = (1.0f + __expf(-n0)) * __builtin_amdgcn_rcpf(1.0f + __expf(-p0)), r1 = (1.0f + __expf(-n1)) * __builtin_amdgcn_rcpf(1.0f + __expf(-p1));
                        if (j < 2) { acc[ai][bj][m][0][2 * j] *= r0; acc[ai][bj][m][0][2 * j + 1] *= r1; } else { acc[ai][bj][m][1][2 * (j - 2)] *= r0; acc[ai][bj][m][1][2 * (j - 2) + 1] *= r1; } } } } }
    }
    __device__ __forceinline__ void operator()(const f32x4 (&acc)[2][2][4][2], const Unit& u, int wr, int wc, int fr, int fq) const {
        const int row0 = u.pm * BM + wr * 64 + fr, col0 = u.pn * BM + wc * 32 + 8 * fq; const bf16_t* G = G0 + 2 * D_MODEL;
#pragma unroll
        for (int ai = 0; ai < 2; ++ai)
#pragma unroll
            for (int m = 0; m < 4; ++m) { const size_t row = (size_t)(row0 + ai * HALF + m * 16);
#pragma unroll
                for (int bj = 0; bj < 2; ++bj) { const int col = col0 + bj * HALF;
                    const u32x4 gw = *(const u32x4*)(G + row * NP_MAIN + col);
                    float gt[8];
#pragma unroll
                    for (int j = 0; j < 4; ++j) { gt[2 * j] = __uint_as_float(gw[j] << 16); gt[2 * j + 1] = __uint_as_float(gw[j] & 0xffff0000u); }
                    f32x4 t0, t1;
#pragma unroll
                    for (int j = 0; j < 4; ++j) { t0[j] = acc[ai][bj][m][0][j] * __builtin_amdgcn_rcpf(1.0f + __expf(-gt[j])); t1[j] = acc[ai][bj][m][1][j] * __builtin_amdgcn_rcpf(1.0f + __expf(-gt[4 + j])); }
                    u32x4 w; w.x = cvt_pk_bf16(t0[0], t0[1]); w.y = cvt_pk_bf16(t0[2], t0[3]); w.z = cvt_pk_bf16(t1[0], t1[1]); w.w = cvt_pk_bf16(t1[2], t1[3]);
                    *(u32x4*)(MB + row * D_MODEL + col) = w; } }
    }
};
struct CtxMergeOrder {
    int c;
    __device__ __forceinline__ bool next(int i, Unit& u) const { if (i > 0 || c >= 3 * (NCTX / 256) * (D_MODEL / 256)) return false;
        const int tile = c / 3; u.pm = NLAT / 256 + tile / (D_MODEL / 256); u.pn = tile % (D_MODEL / 256); u.pk = (c % 3) * MIX_W; return true; }
    __device__ __forceinline__ void a_ready(const Unit&) const {}
    __device__ __forceinline__ void done(const Unit&) const {}
};
struct EpiSlab {
    static constexpr bool PERM = false, AFTER_DRAIN = false, KHOOK = false;
    float* S;
    __device__ __forceinline__ void operator()(const f32x4 (&acc)[2][2][4][2], const Unit& u, int wr, int wc, int fr, int fq) const {
        const int row0 = (u.pm * BM - NLAT) + wr * 64 + fr, col0 = u.pn * BM + wc * 32 + 4 * fq; float* base = S + (size_t)(u.pk / SPLIT_KS) * NCTX * D_MODEL;
#pragma unroll
        for (int ai = 0; ai < 2; ++ai)
#pragma unroll
            for (int m = 0; m < 4; ++m) { float* rowp = base + (size_t)(row0 + ai * HALF + m * 16) * D_MODEL + col0;
#pragma unroll
                for (int bj = 0; bj < 2; ++bj)
#pragma unroll
                    for (int n = 0; n < 2; ++n) *(f32x4*)(rowp + bj * HALF + n * 16) = acc[ai][bj][m][n]; }
    }
};
}

constexpr size_t al256(size_t x) { return (x + 255) & ~(size_t)255; }
constexpr size_t WS_CTL = 0, CTL_BYTES = 1u << 20;
constexpr size_t WS_WIN = WS_CTL + CTL_BYTES;
constexpr size_t WS_WBR = WS_WIN + al256((size_t)DEPTH * NP_PAD * D_MODEL * 2);
constexpr size_t WS_WOUT = WS_WBR + al256((size_t)DEPTH * 3 * D_MODEL * MIX_W * 2);
constexpr size_t WS_WUP = WS_WOUT + al256((size_t)DEPTH * D_MODEL * D_MODEL * 2);
constexpr size_t WS_WDOWN = WS_WUP + al256((size_t)DEPTH * 2 * D_FF * D_MODEL * 2);
constexpr size_t WS_MOD = WS_WDOWN + al256((size_t)DEPTH * D_MODEL * D_FF * 2);
constexpr size_t WS_X = WS_MOD + al256((size_t)DEPTH * (BATCH + 1) * D6 * 4 + GRID_W * 32 * 2 * 4);
constexpr size_t WS_H = WS_X + al256((size_t)MROWS * D_MODEL * 4);
constexpr size_t WS_MIX = WS_H + al256((size_t)MROWS * D_MODEL * 2);
constexpr size_t WS_SLAB = WS_MIX + al256((size_t)MROWS * D_MODEL * 4);
constexpr size_t WS_TB = WS_SLAB + al256((size_t)(D_FF / 512 > 12 ? D_FF / 512 : 12) * NCTX * D_MODEL * 4);
constexpr size_t WS_R = WS_TB + al256((size_t)3 * NCTX * D_MODEL * 2);
constexpr size_t WS_P = WS_R;
constexpr size_t WS_PF = WS_P + al256((size_t)MROWS * NP_MAIN * 2);
constexpr size_t WS_GQKV = WS_PF + al256((size_t)MROWS * PF_N * 4);
#if defined(TOKEN_GDN) || defined(NAIVE_PREP)
constexpr size_t WS_GG = WS_GQKV + al256((size_t)MROWS * 3 * MIX_W * 4);
#else
constexpr size_t WS_GG = WS_GQKV + 256;
#endif
constexpr size_t WS_GB = WS_GG + al256((size_t)MROWS * 2 * GDN_H * 4);
constexpr size_t WS_SXBC = WS_GB + al256((size_t)MROWS * 2 * GDN_H * 4);
#if defined(TOKEN_SSD) || defined(NAIVE_PREP)
constexpr size_t WS_SDT = WS_SXBC + al256((size_t)MROWS * SSM_XBC * 4);
#else
constexpr size_t WS_SDT = WS_SXBC + 256;
#endif
constexpr size_t WS_SA = WS_SDT + al256((size_t)MROWS * 2 * SSM_H * 4);
constexpr size_t WS_AQ = WS_SA + al256((size_t)MROWS * 2 * SSM_H * 4);
#ifdef NAIVE_ATTN
constexpr size_t WS_AK = WS_AQ + al256((size_t)MROWS * MIX_W * 4);
constexpr size_t WS_OG = WS_AK + al256((size_t)MROWS * ATT_HKV * 128 * 4);
#else
constexpr size_t WS_AK = WS_AQ + 256;
constexpr size_t WS_OG = WS_AK + 256;
#endif
#if defined(TOKEN_GDN) || defined(TOKEN_SSD) || defined(NAIVE_MIXOUT)
constexpr size_t WS_OS = WS_OG + al256((size_t)2 * MROWS * MIX_W * 4);
constexpr size_t WS_SC = WS_OS + al256((size_t)2 * MROWS * MIX_W * 4);
#else
constexpr size_t WS_OS = WS_OG + 256;
constexpr size_t WS_SC = WS_OS + 256;
#endif
#ifdef NAIVE_ATTN
constexpr size_t WS_YA = WS_SC + al256((size_t)MROWS * ATT_HQ * SC_LD * 4);
#else
constexpr size_t WS_YA = WS_SC + 256;
#endif
constexpr size_t WS_YB = WS_YA + al256((size_t)MROWS * MIX_W * 2);
constexpr size_t WS_YC = WS_YB + al256((size_t)MROWS * MIX_W * 2);
constexpr size_t WS_M32 = WS_YC + al256((size_t)MROWS * MIX_W * 2);
constexpr size_t WS_MB = WS_M32 + al256((size_t)MROWS * D_MODEL * 4);
constexpr size_t WS_AQB = WS_MB + al256((size_t)MROWS * D_MODEL * 2);
constexpr size_t WS_AKB = WS_AQB + al256((size_t)MROWS * MIX_W * 2);
constexpr size_t GDN_NU_H = (size_t)BATCH * (CHAIN_LEN / 64) * GDN_H * 2;
constexpr size_t WS_GW = WS_AKB + al256((size_t)MROWS * ATT_HKV * 128 * 2);
constexpr size_t WS_GQD = WS_GW + al256(GDN_NU_H * 64 * 128 * 2);
constexpr size_t WS_GKDT = WS_GQD + al256(GDN_NU_H * 64 * 128 * 2);
constexpr size_t WS_GA = WS_GKDT + al256(GDN_NU_H * 128 * 64 * 2);
constexpr size_t WS_GUT = WS_GA + al256(GDN_NU_H * 64 * 64 * 2);
constexpr size_t WS_GGL = WS_GUT + al256(GDN_NU_H * 128 * 64 * 2);
constexpr size_t SSD_NU_H = (size_t)BATCH * (CHAIN_LEN / 64) * SSM_H * 2;
constexpr size_t WS_SBCB = WS_GGL + al256(GDN_NU_H * 4);
constexpr size_t WS_SSC = WS_SBCB + al256((size_t)MROWS * 2 * SSM_BC * 2);
constexpr size_t WS_SEA = WS_SSC + al256(SSD_NU_H * 8 * 64 * 16 * 2);
constexpr size_t WS_SDC = WS_SEA + al256(SSD_NU_H * 64 * 4);
constexpr size_t WS_OGB = WS_SDC + al256(SSD_NU_H * 4);
constexpr size_t WS_OSB = WS_OGB + al256((size_t)2 * MROWS * MIX_W * 2);
constexpr size_t WS_OSB2 = WS_OSB + al256((size_t)2 * MROWS * MIX_W * 2);
constexpr size_t WS_GQKVB = WS_OSB2 + al256((size_t)2 * MROWS * MIX_W * 2);
constexpr size_t WS_SXB = WS_GQKVB + al256((size_t)MROWS * 3 * MIX_W * 2);
constexpr size_t WS_SCF = WS_SXB + al256((size_t)MROWS * MIX_W * 2);
constexpr size_t WS_END_MIX = WS_SCF + al256((size_t)BATCH * (CHAIN_LEN / 64) * SSM_G * 2 * 8 * 512 * 2);
constexpr size_t NBND = (size_t)MROWS / 64 * 2;
constexpr size_t WS_BP = WS_R;
constexpr size_t WS_BU = WS_BP + al256(NBND * D_FF * 4);
constexpr size_t WS_BG = WS_BU + al256(NBND * D_FF * 2);
constexpr size_t WS_ACT = WS_BG + al256(NBND * D_FF * 2);
constexpr size_t WS_END_FFN = WS_ACT + al256((size_t)MROWS * D_FF * 2);
constexpr size_t WS_NEED = WS_END_MIX > WS_END_FFN ? WS_END_MIX : WS_END_FFN;

constexpr int NWAVES = 8, NTHREADS = NWAVES * 64;
#ifndef ATT_EARLY_N
#define ATT_EARLY_N 0
#endif
constexpr int ATT_EARLY = ATT_EARLY_N;
static_assert(ATT_EARLY <= ATT_UNITS_LAT, "early attention units are latent units");
constexpr int RING_BYTES = 131072, LDS_BYTES = 147456, MISC_OFF = LDS_BYTES - 1024;

enum { ST_INPROJ = 0, ST_PREP, ST_G1, ST_MIX, ST_MIXOUT, ST_MERGE, ST_OUT, ST_NORM2, ST_UP, ST_ACT, ST_DOWN, ST_NORM3, NSTEP };
constexpr int STEP0 = 2;
constexpr int TOTAL_STEPS = STEP0 + DEPTH * NSTEP;
#ifndef MK_LAUNCH_MODE
#define MK_LAUNCH_MODE 1
#endif

struct Args { Ptrs p; unsigned* ctl; int step_lo, step_hi; };
typedef const __attribute__((address_space(4))) Args* KArgs;
__device__ __forceinline__ KArgs fresh_args() { KArgs k = (KArgs)__builtin_amdgcn_kernarg_segment_ptr(); asm volatile("" : "+s"(k)); return k; }
#if defined(__HIP_DEVICE_COMPILE__)
#define PTRS() const Ptrs p = fresh_args()->p; int lane; asm volatile("v_mbcnt_lo_u32_b32 %0, -1, 0\n\tv_mbcnt_hi_u32_b32 %0, -1, %0" : "=v"(lane)); const int wave = wave_s; const int tid = wave * 64 + lane; \
    const size_t gtid = (size_t)blockIdx.x * NTHREADS + tid, NT = (size_t)G * NTHREADS; const int gwave = (int)blockIdx.x * NWAVES + wave, NGW = G * NWAVES; (void)lane; (void)wave; (void)gtid; (void)NT; (void)gwave; (void)NGW
#else
#define PTRS() const Ptrs p = a.p; const int tid = 0, lane = 0, wave = 0, gwave = 0, NGW = 1; const size_t gtid = 0, NT = 1; (void)tid; (void)lane; (void)wave; (void)gtid; (void)NT; (void)gwave; (void)NGW
#endif

constexpr int WT_I_IN = (D_MODEL / 64) * (P_IN / 32), WT_I_BR = (MIX_W / 64) * (D_MODEL / 32), WT_I_OUT = (D_MODEL / 64) * (D_MODEL / 32), WT_I_UP = (D_MODEL / 64) * (2 * D_FF / 32), WT_I_DN = (D_FF / 64) * (D_MODEL / 32);
constexpr int WT_I_ALL = WT_I_IN + 3 * WT_I_BR + WT_I_OUT + WT_I_UP + WT_I_DN;
template <class PT> __device__ __forceinline__ void weight_item(const PT& p, int l, int it, LAS float* scr, int lane) {
    int r = it;
    if (r < WT_I_IN) { const int nblk = P_IN / 32, k0 = 64 * (r / nblk), n0 = 32 * (r % nblk);
        transpose_item(p.w_in + (size_t)l * D_MODEL * P_IN, D_MODEL, P_IN, p.Wt_in + (size_t)l * NP_PAD * D_MODEL, k0, n0, inproj_dst_row0(n0), scr, lane); return; } r -= WT_I_IN;
    if (r < 3 * WT_I_BR) { const int br = r / WT_I_BR; r -= br * WT_I_BR; const int nblk = D_MODEL / 32, k0 = 64 * (r / nblk), n0 = 32 * (r % nblk);
        const float* w = (br == 0 ? p.w_br_a : br == 1 ? p.w_br_b : p.w_br_c) + (size_t)l * MIX_W * D_MODEL;
        transpose_item(w, 3 * MIX_W, D_MODEL, p.Wt_br + (size_t)l * 3 * D_MODEL * MIX_W + br * MIX_W, k0, n0, n0, scr, lane); return; } r -= 3 * WT_I_BR;
    if (r < WT_I_OUT) { const int nblk = D_MODEL / 32, k0 = 64 * (r / nblk), n0 = 32 * (r % nblk);
        transpose_item(p.w_out + (size_t)l * D_MODEL * D_MODEL, D_MODEL, D_MODEL, p.Wt_out + (size_t)l * D_MODEL * D_MODEL, k0, n0, n0, scr, lane); return; } r -= WT_I_OUT;
    if (r < WT_I_UP) { const int nblk = 2 * D_FF / 32, k0 = 64 * (r / nblk), n0 = 32 * (r % nblk);
        transpose_item(p.w_up + (size_t)l * D_MODEL * 2 * D_FF, D_MODEL, 2 * D_FF, p.Wt_up + (size_t)l * 2 * D_FF * D_MODEL, k0, n0, up_dst_row0(n0), scr, lane); return; } r -= WT_I_UP;
    { const int nblk = D_MODEL / 32, k0 = 64 * (r / nblk), n0 = 32 * (r % nblk);
        transpose_item(p.w_down + (size_t)l * D_FF * D_MODEL, D_FF, D_MODEL, p.Wt_down + (size_t)l * D_MODEL * D_FF, k0, n0, n0, scr, lane); }
}
template <class PT> __device__ __forceinline__ WtDesc weight_desc(const PT& p, int l, int it) {
    int r = it;
    if (r < WT_I_IN) { const int nblk = P_IN / 32, k0 = 64 * (r / nblk), n0 = 32 * (r % nblk); return WtDesc{p.w_in + (size_t)l * D_MODEL * P_IN, p.Wt_in + (size_t)l * NP_PAD * D_MODEL, D_MODEL, P_IN, k0, n0, inproj_dst_row0(n0)}; } r -= WT_I_IN;
    if (r < 3 * WT_I_BR) { const int br = r / WT_I_BR; r -= br * WT_I_BR; const int nblk = D_MODEL / 32, k0 = 64 * (r / nblk), n0 = 32 * (r % nblk);
        const float* w = (br == 0 ? p.w_br_a : br == 1 ? p.w_br_b : p.w_br_c) + (size_t)l * MIX_W * D_MODEL;
        return WtDesc{w, p.Wt_br + (size_t)l * 3 * D_MODEL * MIX_W + br * MIX_W, 3 * MIX_W, D_MODEL, k0, n0, n0}; } r -= 3 * WT_I_BR;
    if (r < WT_I_OUT) { const int nblk = D_MODEL / 32, k0 = 64 * (r / nblk), n0 = 32 * (r % nblk); return WtDesc{p.w_out + (size_t)l * D_MODEL * D_MODEL, p.Wt_out + (size_t)l * D_MODEL * D_MODEL, D_MODEL, D_MODEL, k0, n0, n0}; } r -= WT_I_OUT;
    if (r < WT_I_UP) { const int nblk = 2 * D_FF / 32, k0 = 64 * (r / nblk), n0 = 32 * (r % nblk); return WtDesc{p.w_up + (size_t)l * D_MODEL * 2 * D_FF, p.Wt_up + (size_t)l * 2 * D_FF * D_MODEL, D_MODEL, 2 * D_FF, k0, n0, up_dst_row0(n0)}; } r -= WT_I_UP;
    { const int nblk = D_MODEL / 32, k0 = 64 * (r / nblk), n0 = 32 * (r % nblk); return WtDesc{p.w_down + (size_t)l * D_FF * D_MODEL, p.Wt_down + (size_t)l * D_MODEL * D_FF, D_FF, D_MODEL, k0, n0, n0}; }
}
constexpr int FILL_A0 = ((MROWS / 256) * (NP_PAD / 256)) % 256, FILL_B0 = 3 * (NCTX / 256) * (D_MODEL / 256), FILL_C0 = ((MROWS / 256) * (2 * D_FF / 256)) % 256;
#ifndef FILL_NA
#define FILL_NA 14
#endif
#ifndef FILL_NB
#define FILL_NB 11
#endif
#ifndef FILL_NC
#define FILL_NC 19
#endif
constexpr int fill_min(int a, int b) { return a < b ? a : b; }
constexpr int WT_OWN = WT_I_ALL - WT_I_IN;
#ifndef FILL_NM
#define FILL_NM 512
#endif
constexpr int FILL_MCH = 16;
constexpr int FILL_EA = fill_min((256 - FILL_A0) * 8 * FILL_NA, WT_I_ALL), FILL_EM = fill_min(FILL_EA + FILL_NM * FILL_MCH, WT_I_ALL), FILL_EB = fill_min(FILL_EM + (256 - FILL_B0) * 8 * FILL_NB, WT_I_ALL), FILL_EC = fill_min(FILL_EB + (256 - FILL_C0) * 8 * FILL_NC, WT_I_ALL);
static_assert(FILL_A0 > 0 && FILL_C0 > 0, "fill slots");
static_assert(FILL_EM >= 3 * WT_I_BR && FILL_EB >= 3 * WT_I_BR + WT_I_OUT + WT_I_UP && FILL_EC >= WT_OWN, "a matrix must be complete before the phase that multiplies by it (branch: merge; up: up-projection; down: within the layer)");
static_assert(64 * 33 <= 2176 && 8 * 4352 * 4 <= 146432 - 1024, "fill scratch: two transpose tiles per wave inside the dynamic LDS below the control words");
__device__ __forceinline__ void weight_fill_ws(int l, int seg_b, int seg_e_in, int ws, int nws, LAS unsigned char* lds, int wv) {
#if defined(__HIP_DEVICE_COMPILE__)
    asm volatile("s_waitcnt vmcnt(0)" ::: "memory"); LDS_BARRIER();
    int l_; asm volatile("v_mbcnt_lo_u32_b32 %0, -1, 0\n\tv_mbcnt_hi_u32_b32 %0, -1, %0" : "=v"(l_));
    const int seg_e = (l == DEPTH - 1 && seg_e_in > WT_OWN) ? WT_OWN : seg_e_in;
#define WT_AT(f_) weight_desc(fresh_args()->p, (f_) < WT_OWN ? l : l + 1, (f_) < WT_OWN ? WT_I_IN + (f_) : (f_) - WT_OWN)
    LAS float* scr = (LAS float*)lds + wv * 4352;
    int it = seg_b + ws;
    if (it < seg_e) { float wa[32], wb[32]; WtDesc da = WT_AT(it), db = da; transpose_load(da, l_, wa);
        for (;;) { const int it2 = it + nws; const bool h2 = it2 < seg_e;
            if (h2) { db = WT_AT(it2); transpose_load(db, l_, wb); }
            transpose_finish(da, wa, scr, l_);
            if (!h2) break;
            const int it3 = it2 + nws; const bool h3 = it3 < seg_e;
            if (h3) { da = WT_AT(it3); transpose_load(da, l_, wa); }
            transpose_finish(db, wb, scr + 2176, l_);
            if (!h3) break;
            it = it3; } }
#undef WT_AT
    LDS_BARRIER();
#endif
}
__device__ __forceinline__ void weight_fill(int l, int seg_b, int seg_e, int wg0, LAS unsigned char* lds, int wv) { weight_fill_ws(l, seg_b, seg_e, ((int)blockIdx.x - wg0) * 8 + wv, (256 - wg0) * 8, lds, wv); }
__global__ void __launch_bounds__(NTHREADS, 2) fwd(Args a) {
    extern __shared__ __attribute__((aligned(16))) unsigned char lds_raw[];
    LAS unsigned char* lds = (LAS unsigned char*)lds_raw;
    volatile LAS unsigned* MISC = (volatile LAS unsigned*)(lds + MISC_OFF);
    const int G = gridDim.x;
    const int wave_s = __builtin_amdgcn_readfirstlane((int)threadIdx.x >> 6);
    for (int u = threadIdx.x; u < (LDS_BYTES - MISC_OFF) / 4; u += NTHREADS) ((LAS unsigned*)(lds + MISC_OFF))[u] = 0u;
    __syncthreads();
    const bool multi = (a.step_hi - a.step_lo) > 1;
    if (multi) (void)xcd_barrier_post(a.ctl + 4096, MISC + 8);
#define IN(k) (fresh_args()->step_lo <= (k) && (k) < fresh_args()->step_hi)
#ifdef ONLY_STEP
#define EN(k) ((k) == ONLY_STEP)
#elif defined(SKIP_MASK)
#define EN(k) (!((SKIP_MASK >> (k)) & 1))
#else
#define EN(k) true
#endif
#define SEAM(k) do { if (IN((k) + 1)) { XcdBarrier bl; bl.bar = fresh_args()->ctl + 4096; bl.x = xb_xcc_id(); bl.st = (volatile LAS unsigned*)(lds + MISC_OFF) + 8; xcd_barrier(bl); } } while (0)
#define FOR_ITEMS(i, n) for (size_t i = gtid; i < (size_t)(n); i += NT)
#define FRESH_TID(name) int name; { int l_; asm volatile("v_mbcnt_lo_u32_b32 %0, -1, 0\n\tv_mbcnt_hi_u32_b32 %0, -1, %0" : "=v"(l_)); name = wave_s * 64 + l_; }

    if (EN(0) && IN(0)) {
        PTRS();
        LAS float* scr = (LAS float*)lds + wave * 4096;
        FOR_ITEMS(i, (size_t)GRID_W * 32) { const float ang = (float)(i >> 5) * rope_inv_freq((int)(i & 31)); p.ROPE[2 * i] = cosf(ang); p.ROPE[2 * i + 1] = sinf(ang); }
#ifdef FILL_OFF
        for (int l = 0; l < DEPTH; ++l) for (int it = gwave; it < WT_I_ALL; it += NGW) weight_item(fresh_args()->p, l, it, scr, lane);
#else
        for (int it = gwave; it < WT_I_IN; it += NGW) weight_item(fresh_args()->p, 0, it, scr, lane);
        for (int l = 1; l < DEPTH; ++l) for (int it = FILL_EC - WT_OWN + gwave; it < WT_I_IN; it += NGW) weight_item(fresh_args()->p, l, it, scr, lane);
#endif
        for (int l = 0; l < DEPTH; ++l) {
            { bf16* z = p.Wt_in + ((size_t)l * NP_PAD + NP_MAIN + PF_N) * D_MODEL; const size_t n16 = (size_t)(NP_PAD - NP_MAIN - PF_N) * D_MODEL / 8;
                FOR_ITEMS(i, n16) *(vu4*)(z + i * 8) = (vu4){0u, 0u, 0u, 0u}; }
        }
        __syncthreads();
        LAS float* sl = (LAS float*)lds;
        LAS float* red = sl + 3 * D_MODEL;
        for (int i = tid; i < (BATCH + 1) * D_MODEL; i += NTHREADS) sl[i] = silu_f(i < BATCH * D_MODEL ? p.c[i] : p.c_ctx[i - BATCH * D_MODEL]);
        __syncthreads();
        for (int it = (int)blockIdx.x; it < DEPTH * (D6 / 64); it += G) {
            const int l = it / (D6 / 64), n0 = (it % (D6 / 64)) * 64;
            float acc0 = 0.f, acc1 = 0.f, acc2 = 0.f;
            const float* w = p.w_ada + ((size_t)l * D_MODEL + wave * (D_MODEL / 8)) * D6 + n0 + lane;
            for (int k0 = 0; k0 < D_MODEL / 8; k0 += 32) { float wv[32];
#pragma unroll
                for (int j = 0; j < 32; ++j) wv[j] = __builtin_nontemporal_load(w + (size_t)(k0 + j) * D6);
#pragma unroll
                for (int j = 0; j < 32; ++j) { const int kk = wave * (D_MODEL / 8) + k0 + j; acc0 += sl[kk] * wv[j]; acc1 += sl[D_MODEL + kk] * wv[j]; acc2 += sl[2 * D_MODEL + kk] * wv[j]; } }
            red[(wave * 3 + 0) * 64 + lane] = acc0; red[(wave * 3 + 1) * 64 + lane] = acc1; red[(wave * 3 + 2) * 64 + lane] = acc2;
            __syncthreads();
            if (tid < 192) { const int m = tid >> 6, ln = tid & 63; float s = 0.f;
#pragma unroll
                for (int w8 = 0; w8 < 8; ++w8) s += red[(w8 * 3 + m) * 64 + ln];
                p.MOD[((size_t)l * (BATCH + 1) + m) * D6 + n0 + ln] = s + p.b_ada[(size_t)l * D6 + n0 + ln]; }
            __syncthreads();
        }
        SEAM(0);
    }
    if (EN(1) && IN(1)) {
        PTRS();
        for (int r = gwave; r < MROWS; r += NGW) { vf4 x[NV4]; row_load(r < NLAT ? p.x + (size_t)r * D_MODEL : p.ctx + (size_t)(r - NLAT) * D_MODEL, lane, x);
            norm_h_wave(p, 0, r, 0, lane, x); }
        SEAM(1);
    }

    for (int l = 0; l < DEPTH; ++l) {
        const int sb = STEP0 + l * NSTEP;
        if (sb + NSTEP <= fresh_args()->step_lo || sb >= fresh_args()->step_hi) continue;
        const bool last = (l == DEPTH - 1);
        const int MR = last ? NLAT : MROWS;

        if (EN(2 + ST_INPROJ) && IN(sb + ST_INPROJ)) {
            PTRS();
            pg8::Gemm g{p.H, p.Wt_in + (size_t)l * NP_PAD * D_MODEL, MROWS, NP_PAD, D_MODEL, D_MODEL}; pg8::StaticOrder S; S.init(MROWS, NP_PAD, G, (int)blockIdx.x);
            pg8::EpiInProj E{p.P, p.PF};
            pg8::gemm_phase<pg8::EpiInProj, pg8::StaticOrder, true, true>(lds, g, S, E, tid);
#ifndef FILL_OFF
            if ((int)blockIdx.x >= FILL_A0) weight_fill(l, 0, FILL_EA, FILL_A0, lds, wave_s);
#endif
            SEAM(sb + ST_INPROJ);
        }

        if (EN(2 + ST_PREP) && IN(sb + ST_PREP)) {
            PTRS();
#ifdef NAIVE_PREP
            FOR_ITEMS(i, (size_t)MROWS * 3 * GDN_H) prep_gdn_item(p, l, (int)(i / (3 * GDN_H)), (int)(i % (3 * GDN_H)));
            FOR_ITEMS(i, (size_t)MROWS * 2 * GDN_H) prep_gdn_gb_item(p, l, (int)(i / (2 * GDN_H)), (int)(i % (2 * GDN_H)));
            FOR_ITEMS(i, (size_t)MROWS * SSM_XBC) prep_ssd_item(p, l, (int)(i / SSM_XBC), (int)(i % SSM_XBC));
            FOR_ITEMS(i, (size_t)MROWS * 2 * SSM_H) prep_ssd_dt_item(p, l, (int)(i / (2 * SSM_H)), (int)(i % (2 * SSM_H)));
#else
            for (int it = gwave; it < (MROWS / PREP_RB) * PREP_NPASS; it += NGW) prep_conv_block_wave(p, l, it / PREP_NPASS, it % PREP_NPASS, lane);
#endif
#ifdef NAIVE_ATTN
            FOR_ITEMS(i, (size_t)MROWS * (ATT_HQ + ATT_HKV)) prep_attn_item(p, (int)(i / (ATT_HQ + ATT_HKV)), (int)(i % (ATT_HQ + ATT_HKV)));
#endif
            SEAM(sb + ST_PREP);
        }

        if (EN(2 + ST_G1) && IN(sb + ST_G1)) {
            PTRS();
            {
                constexpr int NG = BATCH * NCH * GDN_H, NS = SSD_LOCAL_UNITS; unsigned* ctr = fresh_args()->ctl + 8192 + 64 * (DEPTH + l);
                for (;;) { if (tid == 0) MISC[16] = __hip_atomic_fetch_add(ctr, 1u, __ATOMIC_RELAXED, __HIP_MEMORY_SCOPE_AGENT);
                    LDS_BARRIER(); const int u = (int)MISC[16]; LDS_BARRIER();
                    if (u >= NG + NS + ATT_EARLY) break;
                    int tl = tid; asm volatile("" : "+v"(tl));
                    if (u < ATT_EARLY) attn_unit(p, l, (LAS bf16*)lds, u, tl);
                    else if (u < ATT_EARLY + NS) ssd_local_unit(p, lds, u - ATT_EARLY, tl); else gdn_g1_unit(p, lds, u - ATT_EARLY - NS, tl); } }
            SEAM(sb + ST_G1);
        }

        if (EN(2 + ST_MIX) && IN(sb + ST_MIX)) {
            PTRS();
            constexpr int N_GDN_WG = BATCH * GDN_H * 2 * 4, N_SSD_WG = BATCH * SSM_H * 2;
            const int wg = (int)blockIdx.x;
#ifdef TOKEN_GDN
            if (wg < N_GDN_WG) gdn_token_wg(p, (LAS float*)lds, wg >> 2, wg & 3, tid);
#else
            if (wg < N_GDN_WG) gdn_scan_wg(p, lds, (wg & 7) + 8 * (wg >> 5), (wg >> 3) & 3, tid);
#endif
#ifdef TOKEN_SSD
            else if (wg < N_GDN_WG + N_SSD_WG) ssd_token_wg(p, (LAS float*)lds, wg - N_GDN_WG, tid);
#else
            else if (wg < N_GDN_WG + N_SSD_WG) ssd_scan_wg(p, lds, wg - N_GDN_WG, tid);
#endif
            {
                const int nu = ATT_UNITS_LAT + (last ? 0 : ATT_UNITS_CTX); unsigned* ctr = fresh_args()->ctl + 8192 + 64 * l;
                for (;;) { if (tid == 0) MISC[16] = ATT_EARLY + __hip_atomic_fetch_add(ctr, 1u, __ATOMIC_RELAXED, __HIP_MEMORY_SCOPE_AGENT);
                    LDS_BARRIER(); const int u = (int)MISC[16]; LDS_BARRIER();
                    if (u >= nu) break;
                    attn_unit(p, l, (LAS bf16*)lds, u, tid); } }
#ifndef FILL_OFF
            {
                constexpr int NCH_M = (FILL_EM - FILL_EA + FILL_MCH - 1) / FILL_MCH; unsigned* ctr = fresh_args()->ctl + 8192 + 64 * (2 * DEPTH + l);
                const int em = (last && FILL_EM > WT_OWN) ? WT_OWN : FILL_EM;
                for (;;) { if (tid == 0) MISC[16] = __hip_atomic_fetch_add(ctr, 1u, __ATOMIC_RELAXED, __HIP_MEMORY_SCOPE_AGENT);
                    LDS_BARRIER(); const int ch = (int)MISC[16]; LDS_BARRIER();
                    const int fb = FILL_EA + ch * FILL_MCH; if (ch >= NCH_M || fb >= em) break;
                    weight_fill_ws(l, fb, fb + FILL_MCH < em ? fb + FILL_MCH : em, wave_s, 8, lds, wave_s); } }
#endif
            SEAM(sb + ST_MIX);
        }

        if (EN(2 + ST_MIXOUT) && IN(sb + ST_MIXOUT)) {
            PTRS();
#ifdef NAIVE_MIXOUT
            FOR_ITEMS(i, (size_t)MROWS * GDN_H) gdn_out_item(p, l, (int)(i / GDN_H), (int)(i % GDN_H));
            FOR_ITEMS(i, (size_t)MROWS * SSM_G) ssd_out_item(p, l, (int)(i / SSM_G), (int)(i % SSM_G));
#else
            for (int r = gwave; r < (last ? NLAT : MROWS); r += NGW) mixout_row_wave(p, l, r, lane);
#endif
            SEAM(sb + ST_MIXOUT);
        }

        if (EN(2 + ST_MERGE) && IN(sb + ST_MERGE)) {
            PTRS();
            { pg8::Gemm g{p.YA, p.Wt_br + (size_t)l * 3 * D_MODEL * MIX_W, NLAT, D_MODEL, 3 * MIX_W, 3 * MIX_W}; pg8::StaticOrder S; S.init(NLAT, D_MODEL, G, (int)blockIdx.x);
              pg8::EpiMerge3 E{p.P + C_MG, p.MB};
              pg8::gemm_phase<pg8::EpiMerge3, pg8::StaticOrder, true, true>(lds, g, S, E, tid); }
            if (!last) { pg8::Gemm g{p.YA, p.Wt_br + (size_t)l * 3 * D_MODEL * MIX_W, MROWS, D_MODEL, MIX_W, 3 * MIX_W}; pg8::CtxMergeOrder S{(int)blockIdx.x};
              pg8::EpiMerge E{p.P + C_MG, p.TB};
              FRESH_TID(tid2); pg8::gemm_phase<pg8::EpiMerge, pg8::CtxMergeOrder, true, true>(lds, g, S, E, tid2); }
#ifndef FILL_OFF
            if ((int)blockIdx.x >= FILL_B0) weight_fill(l, FILL_EM, FILL_EB, FILL_B0, lds, wave_s);
#endif
            SEAM(sb + ST_MERGE);
        }

        if (EN(2 + ST_OUT) && IN(sb + ST_OUT)) {
            PTRS();
            { pg8::Gemm g{p.MB, p.Wt_out + (size_t)l * D_MODEL * D_MODEL, NLAT, D_MODEL, D_MODEL, D_MODEL}; pg8::StaticOrder S; S.init(NLAT, D_MODEL, G, (int)blockIdx.x);
              pg8::EpiBf16Plain E{p.MIXb, D_MODEL};
              pg8::gemm_phase<pg8::EpiBf16Plain, pg8::StaticOrder, true, true>(lds, g, S, E, tid); }
            if (!last) {
                pg8::Gemm g{p.TB, p.Wt_out + (size_t)l * D_MODEL * D_MODEL, 3 * NCTX, D_MODEL, pg8::SPLIT_KS, D_MODEL}; pg8::SplitOrder3 S{G, (int)blockIdx.x};
                pg8::EpiSlab3 E{p.SLAB};
                FRESH_TID(tid2); pg8::gemm_phase<pg8::EpiSlab3, pg8::SplitOrder3, true, true>(lds, g, S, E, tid2); }
            SEAM(sb + ST_OUT);
        }

        if (EN(2 + ST_NORM2) && IN(sb + ST_NORM2)) {
            PTRS();
            for (int r = gwave; r < MR; r += NGW) { int ll = lane; asm volatile("" : "+v"(ll)); vf4 x[NV4]; row_load(l > 0 ? p.X + (size_t)r * D_MODEL : (r < NLAT ? p.x + (size_t)r * D_MODEL : p.ctx + (size_t)(r - NLAT) * D_MODEL), ll, x); resid_wave(p, l, r, 0, ll, x, 3 * pg8::OUT_NS);
                row_store(p.X + (size_t)r * D_MODEL, ll, x); norm_h_wave(p, l, r, 1, ll, x); }
            SEAM(sb + ST_NORM2);
        }

        if (EN(2 + ST_UP) && IN(sb + ST_UP)) {
            PTRS();
            pg8::Gemm g{p.H, p.Wt_up + (size_t)l * 2 * D_FF * D_MODEL, MR, 2 * D_FF, D_MODEL, D_MODEL}; pg8::StaticOrder S; S.init(MR, 2 * D_FF, G, (int)blockIdx.x);
            pg8::EpiAct E{p.ACT, p.BP, p.BU, p.BG, p.ffn_conv_w + (size_t)l * 3 * D_FF, p.ffn_conv_b + (size_t)l * D_FF};
            pg8::gemm_phase<pg8::EpiAct, pg8::StaticOrder, true, true>(lds, g, S, E, tid);
#ifndef FILL_OFF
            if ((int)blockIdx.x >= FILL_C0) weight_fill(l, FILL_EB, FILL_EC, FILL_C0, lds, wave_s);
#endif
            SEAM(sb + ST_UP);
        }

        if (EN(2 + ST_ACT) && IN(sb + ST_ACT)) { PTRS();
            for (int it = (int)gtid; it < (MR / 64 * 2) * (D_FF / 4); it += (int)NT) act_fix_item(p, l, it / (D_FF / 4), (it % (D_FF / 4)) * 4);
            SEAM(sb + ST_ACT); }

        if (EN(2 + ST_DOWN) && IN(sb + ST_DOWN)) {
            PTRS();
            { pg8::Gemm g{p.ACT, p.Wt_down + (size_t)l * D_MODEL * D_FF, NLAT, D_MODEL, D_FF, D_FF}; pg8::StaticOrder S; S.init(NLAT, D_MODEL, G, (int)blockIdx.x);
              pg8::EpiBf16Plain E{p.MIXb, D_MODEL};
              pg8::gemm_phase<pg8::EpiBf16Plain, pg8::StaticOrder, true, true>(lds, g, S, E, tid); }
            if (!last) {
                pg8::Gemm g{p.ACT, p.Wt_down + (size_t)l * D_MODEL * D_FF, MROWS, D_MODEL, pg8::SPLIT_KS, D_FF}; pg8::SplitOrder S{pg8::DOWN_NS, G, (int)blockIdx.x};
                pg8::EpiSlab E{p.SLAB};
                FRESH_TID(tid2); pg8::gemm_phase<pg8::EpiSlab, pg8::SplitOrder, true, true>(lds, g, S, E, tid2); }
            SEAM(sb + ST_DOWN);
        }

        if (EN(2 + ST_NORM3) && IN(sb + ST_NORM3)) {
            PTRS();
            for (int r = gwave; r < (last ? NLAT : MROWS); r += NGW) { int ll = lane; asm volatile("" : "+v"(ll)); vf4 x[NV4]; row_load(p.X + (size_t)r * D_MODEL, ll, x); resid_wave(p, l, r, 1, ll, x, pg8::DOWN_NS);
                if (last) row_store(p.out + (size_t)r * D_MODEL, ll, x);
                else { row_store(p.X + (size_t)r * D_MODEL, ll, x); norm_h_wave(p, l + 1, r, 0, ll, x); } }
            SEAM(sb + ST_NORM3);
        }
    }
#undef IN
#undef SEAM
#undef FOR_ITEMS
}

extern "C" void kernel_launch(void* const* d_in, const int* in_sizes, int n_in, void* d_out, int out_size, void* d_ws, size_t ws_size, hipStream_t stream) {
    static int grid = 0;
    if (grid == 0) {
        if (n_in != 30 || in_sizes[0] != NLAT * D_MODEL || out_size != NLAT * D_MODEL || ws_size < WS_NEED) {
            fprintf(stderr, "kernel_launch: unexpected problem: n_in %d in0 %d out %d ws %zu (need %zu); nothing launched\n", n_in, n_in > 0 ? in_sizes[0] : -1, out_size, ws_size, (size_t)WS_NEED); grid = -1; return; }
        int dev = 0, cus = 0;
        if (hipGetDevice(&dev) != hipSuccess || hipDeviceGetAttribute(&cus, hipDeviceAttributeMultiprocessorCount, dev) != hipSuccess) { grid = -1; return; }
        if (hipFuncSetAttribute((const void*)fwd, hipFuncAttributeMaxDynamicSharedMemorySize, LDS_BYTES) != hipSuccess) { fprintf(stderr, "kernel_launch: hipFuncSetAttribute failed\n"); grid = -1; return; }
        int per_cu = 0;
        if (hipOccupancyMaxActiveBlocksPerMultiprocessor(&per_cu, (const void*)fwd, NTHREADS, LDS_BYTES) != hipSuccess || per_cu < 1) fprintf(stderr, "kernel_launch: occupancy query reports %d\n", per_cu);
        (void)hipGetLastError();
        grid = cus;
        if (grid != 256) { fprintf(stderr, "kernel_launch: built for a 256-CU device (workgroup roles in the mixer phase); got %d; nothing launched\n", cus); grid = -1; return; }
    }
    if (grid < 0) return;
    unsigned char* ws = (unsigned char*)d_ws;
    if (hipMemsetAsync(ws + WS_CTL, 0, CTL_BYTES, stream) != hipSuccess) return;
    Args a{};
    const float** pi = (const float**)&a.p;
    for (int i = 0; i < 30; ++i) pi[i] = (const float*)d_in[i];
    Ptrs& p = a.p;
    p.out = (float*)d_out;
    p.Wt_in = (bf16*)(ws + WS_WIN); p.Wt_br = (bf16*)(ws + WS_WBR); p.Wt_out = (bf16*)(ws + WS_WOUT); p.Wt_up = (bf16*)(ws + WS_WUP); p.Wt_down = (bf16*)(ws + WS_WDOWN);
    p.MOD = (float*)(ws + WS_MOD); p.ROPE = p.MOD + (size_t)DEPTH * (BATCH + 1) * D6; p.X = (float*)(ws + WS_X); p.H = (bf16*)(ws + WS_H); p.MIX = (float*)(ws + WS_MIX); p.MIXb = (bf16*)(ws + WS_MIX);
    p.SLAB = (float*)(ws + WS_SLAB); p.TB = (bf16*)(ws + WS_TB);
    p.OGb = (bf16*)(ws + WS_OGB); p.OSb = (bf16*)(ws + WS_OSB); p.OSb2 = (bf16*)(ws + WS_OSB2); p.GQKVb = (bf16*)(ws + WS_GQKVB); p.SXb = (bf16*)(ws + WS_SXB);
    p.P = (bf16*)(ws + WS_P); p.PF = (float*)(ws + WS_PF); p.GQKV = (float*)(ws + WS_GQKV); p.GG = (float*)(ws + WS_GG); p.GB = (float*)(ws + WS_GB);
    p.SXBC = (float*)(ws + WS_SXBC); p.SDT = (float*)(ws + WS_SDT); p.SA = (float*)(ws + WS_SA); p.AQ = (float*)(ws + WS_AQ); p.AK = (float*)(ws + WS_AK);
    p.OG = (float*)(ws + WS_OG); p.OS = (float*)(ws + WS_OS); p.SC = (float*)(ws + WS_SC); p.YA = (bf16*)(ws + WS_YA); p.YB = p.YA + MIX_W; p.YC = p.YA + 2 * MIX_W;
    p.SBCb = (bf16*)(ws + WS_SBCB); p.SSC = (bf16*)(ws + WS_SSC); p.SEA = (float*)(ws + WS_SEA); p.SEAb = (bf16*)(ws + WS_SEA); p.SDC = (float*)(ws + WS_SDC); p.SCF = (bf16*)(ws + WS_SCF);
    p.GW = (bf16*)(ws + WS_GW); p.GQd = (bf16*)(ws + WS_GQD); p.GKdT = (bf16*)(ws + WS_GKDT); p.GA = (bf16*)(ws + WS_GA); p.GUT = (bf16*)(ws + WS_GUT); p.GGL = (float*)(ws + WS_GGL);
    p.AQb = (bf16*)(ws + WS_AQB); p.AKb = (bf16*)(ws + WS_AKB);
    p.M32 = (float*)(ws + WS_M32); p.MB = (bf16*)(ws + WS_MB); p.UG = nullptr; p.ACT = (bf16*)(ws + WS_ACT); p.BP = (float*)(ws + WS_BP); p.BU = (bf16*)(ws + WS_BU); p.BG = (bf16*)(ws + WS_BG);
    a.ctl = (unsigned*)(ws + WS_CTL);
#if MK_LAUNCH_MODE == 1
    a.step_lo = 0; a.step_hi = TOTAL_STEPS;
    hipLaunchKernelGGL(fwd, dim3(grid), dim3(NTHREADS), LDS_BYTES, stream, a);
#else
    for (int s = 0; s < TOTAL_STEPS; ++s) { a.step_lo = s; a.step_hi = s + 1; hipLaunchKernelGGL(fwd, dim3(grid), dim3(NTHREADS), LDS_BYTES, stream, a); }
#endif
    const hipError_t le = hipPeekAtLastError();
    if (le != hipSuccess) fprintf(stderr, "kernel_launch: launch failed: %s\n", hipGetErrorName(le));
}
```

```cpp
#include <hip/hip_runtime.h>
#include <cstdio>
#include <cstdint>
#include <type_traits>
#define MK_LAUNCH_MODE 1
#define FILL_NA 10
#define FILL_NB 14
#define FILL_NC 4
#define FILL_NM 256
#include <cstdint>
#include <cstddef>
#include <cmath>
#ifdef HOST_TEST
#define HD inline
#define CFENCE() do {} while (0)
#else
#define HD __host__ __device__ __forceinline__
#if defined(__HIP_DEVICE_COMPILE__)
#define CFENCE() asm volatile("" ::: "memory")
#else
#define CFENCE() do {} while (0)
#endif
#endif

#ifndef CFG_SMALL
constexpr int D_MODEL = 2048, BATCH = 2, SEQ = 4096, DEPTH = 4, CTX_LEN = 256, D_FF = 5632;
#else
constexpr int D_MODEL = 1024, BATCH = 2, SEQ = 512, DEPTH = 2, CTX_LEN = 128, D_FF = 512;
#endif
constexpr int GRID_W = 64, WINDOW = 128;
constexpr float EPS = 1e-6f;
constexpr int MIX_W = D_MODEL / 2, GDN_H = MIX_W / 128, SSM_H = MIX_W / 64, SSM_G = 2, SSM_N = 128, SSM_P = 64, SSM_HPG = SSM_H / SSM_G;
constexpr int ATT_HQ = MIX_W / 128, ATT_HKV = 2, ATT_GRP = ATT_HQ / ATT_HKV;
constexpr int SSM_BC = SSM_G * SSM_N, SSM_XBC = MIX_W + 2 * SSM_BC;
constexpr int NLAT = BATCH * SEQ, NCTX = BATCH * CTX_LEN, MROWS = NLAT + NCTX;
constexpr int CHAIN_LEN = CTX_LEN + SEQ;
constexpr int R_QKV = 0, R_GATE = 3 * MIX_W, R_A = 4 * MIX_W, R_B = R_A + 2 * GDN_H, R_Z = R_B + 2 * GDN_H, R_XBC = R_Z + MIX_W, R_DT = R_XBC + SSM_XBC,
              R_AQ = R_DT + 2 * SSM_H, R_AKV = R_AQ + MIX_W, R_MG = R_AKV + 2 * ATT_HKV * 128, P_IN = R_MG + 3 * D_MODEL;
constexpr int C_QKV = 0, C_GATE = 3 * MIX_W, C_Z = 4 * MIX_W, C_XBC = 5 * MIX_W, C_AQ = C_XBC + SSM_XBC, C_AKV = C_AQ + MIX_W, C_MG = C_AKV + 512, NP_MAIN = C_MG + 3 * D_MODEL;
constexpr int PF_A = 0, PF_B = 2 * GDN_H, PF_DT = 4 * GDN_H, PF_N = 4 * GDN_H + 2 * SSM_H;
constexpr int NP_PAD = NP_MAIN + 256;
static_assert(NP_MAIN % 256 == 0 && PF_N <= 256 && MROWS % 256 == 0 && (2 * D_FF) % 256 == 0 && D_FF % 256 == 0, "tile shapes");
static_assert(P_IN == NP_MAIN + PF_N, "column bookkeeping");
constexpr int D6 = 6 * D_MODEL;

typedef unsigned short bf16;
HD float bf2f(bf16 b) { union { unsigned u; float f; } c; c.u = ((unsigned)b) << 16; return c.f; }
HD bf16 f2bf(float f) { union { unsigned u; float f; } c; c.f = f; unsigned u = c.u; u += 0x7FFFu + ((u >> 16) & 1u); return (bf16)(u >> 16); }
HD float silu_f(float x) { return x / (1.0f + expf(-x)); }
HD float sigmoid_f(float x) { return 1.0f / (1.0f + expf(-x)); }
#if defined(__HIP_DEVICE_COMPILE__)
HD float softplus_f(float x) { return x > 20.0f ? x : __logf(1.0f + __expf(x)); }
#else
HD float softplus_f(float x) { return x > 20.0f ? x : log1pf(expf(x)); }
#endif

struct Ptrs {
    const float *x, *c, *ctx, *c_ctx, *w_ada, *b_ada, *g_pre1, *w_in, *gdn_conv_w, *gdn_a_log, *gdn_dt_bias, *gdn_norm, *ssm_conv_w, *ssm_conv_b, *ssm_a_log,
        *ssm_dt_bias, *ssm_d, *ssm_norm, *attn_sink, *w_br_a, *w_br_b, *w_br_c, *w_out, *g_post1, *g_pre2, *w_up, *ffn_conv_w, *ffn_conv_b, *w_down, *g_post2;
    float* out;
    bf16 *Wt_in, *Wt_br, *Wt_out, *Wt_up, *Wt_down;
    float* ROPE;
    float* MOD;
    float* X;
    bf16* H;
    bf16* P;
    float* PF;
    float *GQKV, *GG, *GB;
    float *SXBC, *SDT, *SA;
    float *AQ, *AK;
    bf16 *GW, *GQd, *GKdT, *GA, *GUT; float* GGL;
    bf16 *SBCb, *SSC, *SEAb, *SCF; float *SEA, *SDC;
    bf16 *MIXb, *OGb, *OSb, *OSb2, *GQKVb, *SXb;
    bf16 *AQb, *AKb;
    float *OG, *OS;
    float* SC;
    bf16 *YA, *YB, *YC;
    float* M32;
    bf16* MB;
    float* MIX;
    bf16* UG;
    bf16* ACT;
    bf16* TB;
    float* SLAB;
    float* BP; bf16 *BU, *BG;
};
constexpr int SC_LD = 2 * WINDOW + 1 + CTX_LEN + 3;

HD void row_info(int r, int& b, int& t, int& len, bool& is_ctx) {
    if (r < NLAT) { b = r / SEQ; t = r % SEQ; len = SEQ; is_ctx = false; } else { const int q = r - NLAT; b = q / CTX_LEN; t = q % CTX_LEN; len = CTX_LEN; is_ctx = true; }
}
HD int mod_row(int r) { return r < NLAT ? r / SEQ : BATCH; }

HD int inproj_src_col(int np) {
    if (np < C_Z) return np;
    if (np < NP_MAIN) return np + 4 * GDN_H + (np >= C_AQ ? 2 * SSM_H : 0);
    const int j = np - NP_MAIN;
    if (j < PF_DT) return R_A + j;
    if (j < PF_N) return R_DT + (j - PF_DT);
    return -1;
}
HD void wcvt_item(const float* W, int K, int N, bf16* Wt, int np, int k8, bool inproj) {
    const int n = inproj ? inproj_src_col(np) : np;
    for (int j = 0; j < 8; ++j) { const int k = k8 * 8 + j; Wt[(size_t)np * K + k] = (n < 0) ? (bf16)0 : f2bf(W[(size_t)k * N + n]); }
}

HD void mod_item(const Ptrs& p, int l, int n) {
    float acc[BATCH + 1];
    for (int m = 0; m <= BATCH; ++m) acc[m] = 0.f;
    for (int k = 0; k < D_MODEL; ++k) {
        const float w = p.w_ada[((size_t)l * D_MODEL + k) * D6 + n];
        for (int m = 0; m < BATCH; ++m) acc[m] += silu_f(p.c[m * D_MODEL + k]) * w;
        acc[BATCH] += silu_f(p.c_ctx[k]) * w;
    }
    for (int m = 0; m <= BATCH; ++m) p.MOD[((size_t)l * (BATCH + 1) + m) * D6 + n] = acc[m] + p.b_ada[(size_t)l * D6 + n];
}
HD void xinit_item(const Ptrs& p, size_t i) { p.X[i] = i < (size_t)NLAT * D_MODEL ? p.x[i] : p.ctx[i - (size_t)NLAT * D_MODEL]; }

HD float row_rstd(const float* v, int n) { float s = 0.f; for (int j = 0; j < n; ++j) s += v[j] * v[j]; return 1.0f / sqrtf(s / (float)n + EPS); }
HD void norm_to_h_row(const Ptrs& p, int l, int r, int which) {
    const float* xr = p.X + (size_t)r * D_MODEL; const float* g = (which ? p.g_pre2 : p.g_pre1) + (size_t)l * D_MODEL;
    const float* mod = p.MOD + ((size_t)l * (BATCH + 1) + mod_row(r)) * D6 + (which ? 3 * D_MODEL : 0);
    const float rs = row_rstd(xr, D_MODEL);
    for (int j = 0; j < D_MODEL; ++j) p.H[(size_t)r * D_MODEL + j] = f2bf(xr[j] * rs * g[j] * (1.0f + mod[D_MODEL + j]) + mod[j]);
}
HD void resid_row(const Ptrs& p, int l, int r, int which, bool to_out) {
    const float* yr = p.MIX + (size_t)r * D_MODEL; const float* g = (which ? p.g_post2 : p.g_post1) + (size_t)l * D_MODEL;
    const float* gate = p.MOD + ((size_t)l * (BATCH + 1) + mod_row(r)) * D6 + (which ? 5 * D_MODEL : 2 * D_MODEL);
    const float rs = row_rstd(yr, D_MODEL);
    float* xr = p.X + (size_t)r * D_MODEL;
    for (int j = 0; j < D_MODEL; ++j) { const float v = xr[j] + gate[j] * (yr[j] * rs * g[j]); xr[j] = v; if (to_out && r < NLAT) p.out[(size_t)r * D_MODEL + j] = v; }
}

HD float conv3_p(const Ptrs& p, int r, int col, const float* w, int wld, int j) {
    int b, t, len; bool ic; row_info(r, b, t, len, ic);
    float y = w[wld + j] * bf2f(p.P[(size_t)r * NP_MAIN + col]);
    if (t > 0) y += w[j] * bf2f(p.P[(size_t)(r - 1) * NP_MAIN + col]);
    if (t < len - 1) y += w[2 * wld + j] * bf2f(p.P[(size_t)(r + 1) * NP_MAIN + col]);
    return y;
}
HD void prep_gdn_item(const Ptrs& p, int l, int r, int grp) {
    const float* w = p.gdn_conv_w + (size_t)l * 3 * (3 * MIX_W);
    float sc = 1.0f;
    if (grp < 2 * GDN_H) {
        float ss = 0.f;
        for (int d = 0; d < 128; ++d) { const int j = grp * 128 + d; const float v = silu_f(conv3_p(p, r, C_QKV + j, w, 3 * MIX_W, j)); ss += v * v; }
        sc = 1.0f / sqrtf(ss + EPS); if (grp < GDN_H) sc *= 0.08838834764831845f;
    }
    for (int d = 0; d < 128; ++d) { const int j = grp * 128 + d; p.GQKV[(size_t)r * (3 * MIX_W) + j] = silu_f(conv3_p(p, r, C_QKV + j, w, 3 * MIX_W, j)) * sc; }
}
HD void prep_gdn_gb_item(const Ptrs& p, int l, int r, int j) {
    const float a = p.PF[(size_t)r * PF_N + PF_A + j], bb = p.PF[(size_t)r * PF_N + PF_B + j];
    p.GG[(size_t)r * 2 * GDN_H + j] = -expf(p.gdn_a_log[(size_t)l * 2 * GDN_H + j]) * softplus_f(a + p.gdn_dt_bias[(size_t)l * 2 * GDN_H + j]);
    p.GB[(size_t)r * 2 * GDN_H + j] = sigmoid_f(bb);
}
HD void prep_ssd_item(const Ptrs& p, int l, int r, int j) {
    const float* w = p.ssm_conv_w + (size_t)l * 3 * SSM_XBC;
    p.SXBC[(size_t)r * SSM_XBC + j] = silu_f(conv3_p(p, r, C_XBC + j, w, SSM_XBC, j) + p.ssm_conv_b[(size_t)l * SSM_XBC + j]);
}
HD void prep_ssd_dt_item(const Ptrs& p, int l, int r, int j) {
    const float dt = softplus_f(p.PF[(size_t)r * PF_N + PF_DT + j] + p.ssm_dt_bias[(size_t)l * 2 * SSM_H + j]);
    p.SDT[(size_t)r * 2 * SSM_H + j] = dt; p.SA[(size_t)r * 2 * SSM_H + j] = -expf(p.ssm_a_log[(size_t)l * 2 * SSM_H + j]) * dt;
}
HD float rope_inv_freq(int i) { return exp2f(-(float)i * 0.4152410118609203f); }
HD void prep_attn_item(const Ptrs& p, int r, int hh) {
    int b, t, len; bool ic; row_info(r, b, t, len, ic);
    const bool isq = hh < ATT_HQ; const int h = isq ? hh : hh - ATT_HQ;
    const bf16* src = p.P + (size_t)r * NP_MAIN + (isq ? C_AQ + h * 128 : C_AKV + h * 128);
    float* dst = isq ? p.AQ + (size_t)r * MIX_W + h * 128 : p.AK + (size_t)r * (ATT_HKV * 128) + h * 128;
    if (ic) { for (int d = 0; d < 128; ++d) dst[d] = bf2f(src[d]); return; }
    const float pos[2] = {(float)(t / GRID_W), (float)(t % GRID_W)};
    for (int ax = 0; ax < 2; ++ax)
        for (int i = 0; i < 32; ++i) {
            const float ang = pos[ax] * rope_inv_freq(i), cs = cosf(ang), sn = sinf(ang);
            const float x1 = bf2f(src[ax * 64 + i]), x2 = bf2f(src[ax * 64 + 32 + i]);
            dst[ax * 64 + i] = x1 * cs - x2 * sn; dst[ax * 64 + 32 + i] = x2 * cs + x1 * sn;
        }
}

HD int chain_row(int b, int dir, int s) {
    if (s < CTX_LEN) return NLAT + b * CTX_LEN + (dir ? CTX_LEN - 1 - s : s);
    const int u = s - CTX_LEN; return b * SEQ + (dir ? SEQ - 1 - u : u);
}
HD void gdn_chain_item(const Ptrs& p, int b, int h, int dir, int vc) {
    float S[128];
#pragma unroll
    for (int k = 0; k < 128; ++k) S[k] = 0.f;
    float pf = 0.f;
    for (int s = 0; s < CHAIN_LEN; ++s) {
        const int r = chain_row(b, dir, s);
        const float* q = p.GQKV + (size_t)r * (3 * MIX_W) + h * 128; const float* kk = q + MIX_W; const float vv = q[2 * MIX_W + vc];
        const float a = expf(p.GG[(size_t)r * 2 * GDN_H + dir * GDN_H + h]), be = p.GB[(size_t)r * 2 * GDN_H + dir * GDN_H + h];
        if (s + 1 < CHAIN_LEN) { const float* qn = p.GQKV + (size_t)chain_row(b, dir, s + 1) * (3 * MIX_W) + h * 128;
#pragma unroll
            for (int j = 0; j < 4; ++j) pf += qn[32 * j] + qn[MIX_W + 32 * j]; }
        float ks = 0.f;
#pragma unroll
        for (int c = 0; c < 2; ++c) { float kc[64];
#pragma unroll
            for (int j = 0; j < 64; ++j) kc[j] = kk[64 * c + j];
#pragma unroll
            for (int j = 0; j < 64; ++j) { S[64 * c + j] *= a; ks += kc[j] * S[64 * c + j]; }
            CFENCE(); }
        const float dl = be * (vv - ks); float o = 0.f;
#pragma unroll
        for (int c = 0; c < 4; ++c) { float kc[32], qc[32];
#pragma unroll
            for (int j = 0; j < 32; ++j) { kc[j] = kk[32 * c + j]; qc[j] = q[32 * c + j]; }
#pragma unroll
            for (int j = 0; j < 32; ++j) { S[32 * c + j] += kc[j] * dl; o += qc[j] * S[32 * c + j]; }
            CFENCE(); }
        p.OG[((size_t)dir * MROWS + r) * MIX_W + h * 128 + vc] = o;
    }
    if (pf == 123456.789f) p.OG[0] = pf;
}
HD void ssd_chain_item(const Ptrs& p, int b, int hd, int dir, int pc) {
    float hs[SSM_N];
#pragma unroll
    for (int s = 0; s < SSM_N; ++s) hs[s] = 0.f;
    const int g = hd / SSM_HPG;
    float pf = 0.f;
    for (int s = 0; s < CHAIN_LEN; ++s) {
        const int r = chain_row(b, dir, s);
        const float* xb = p.SXBC + (size_t)r * SSM_XBC; const float* Bm = xb + MIX_W + g * SSM_N; const float* Cm = xb + MIX_W + SSM_BC + g * SSM_N;
        const float dt = p.SDT[(size_t)r * 2 * SSM_H + dir * SSM_H + hd], ea = expf(p.SA[(size_t)r * 2 * SSM_H + dir * SSM_H + hd]);
        const float xd = xb[hd * SSM_P + pc] * dt; float y = 0.f;
        if (s + 1 < CHAIN_LEN) { const float* xn = p.SXBC + (size_t)chain_row(b, dir, s + 1) * SSM_XBC + MIX_W + g * SSM_N;
#pragma unroll
            for (int j = 0; j < 4; ++j) pf += xn[32 * j] + xn[SSM_BC + 32 * j]; }
#pragma unroll
        for (int c = 0; c < 4; ++c) { float bc[32], cc[32];
#pragma unroll
            for (int j = 0; j < 32; ++j) { bc[j] = Bm[32 * c + j]; cc[j] = Cm[32 * c + j]; }
#pragma unroll
            for (int j = 0; j < 32; ++j) { hs[32 * c + j] = ea * hs[32 * c + j] + xd * bc[j]; y += cc[j] * hs[32 * c + j]; }
            CFENCE(); }
        p.OS[((size_t)dir * MROWS + r) * MIX_W + hd * SSM_P + pc] = y;
    }
    if (pf == 123456.789f) p.OS[0] = pf;
}
HD void attn_item(const Ptrs& p, int l, int r, int hq) {
    int b, t, len; bool ic; row_info(r, b, t, len, ic);
    const int hkv = hq / ATT_GRP;
    const float* qp = p.AQ + (size_t)r * MIX_W + hq * 128;
    float* sc = p.SC + ((size_t)r * ATT_HQ + hq) * SC_LD;
    const float sink = p.attn_sink[(size_t)l * ATT_HQ + hq];
    const int lo = ic ? 0 : (t - WINDOW < 0 ? 0 : t - WINDOW), hi = ic ? -1 : (t + WINDOW > SEQ - 1 ? SEQ - 1 : t + WINDOW);
    const int nloc = ic ? 0 : hi - lo + 1, nk = nloc + CTX_LEN;
    float m = sink;
    {
        float q[128];
#pragma unroll
        for (int d = 0; d < 128; ++d) q[d] = qp[d];
        for (int j = 0; j < nk; ++j) {
            const int kr = j < nloc ? b * SEQ + lo + j : NLAT + b * CTX_LEN + (j - nloc);
            const float* kk = p.AK + (size_t)kr * (ATT_HKV * 128) + hkv * 128;
            float s = 0.f;
#pragma unroll
            for (int c = 0; c < 4; ++c) { float kc[32];
#pragma unroll
                for (int d = 0; d < 32; ++d) kc[d] = kk[32 * c + d];
#pragma unroll
                for (int d = 0; d < 32; ++d) s += q[32 * c + d] * kc[d];
                CFENCE(); }
            s *= 0.08838834764831845f; sc[j] = s; m = s > m ? s : m;
        }
    }
    float o[128];
#pragma unroll
    for (int d = 0; d < 128; ++d) o[d] = 0.f;
    float den = expf(sink - m);
    for (int j = 0; j < nk; ++j) {
        const int kr = j < nloc ? b * SEQ + lo + j : NLAT + b * CTX_LEN + (j - nloc);
        const bf16* vv = p.P + (size_t)kr * NP_MAIN + C_AKV + ATT_HKV * 128 + hkv * 128;
        const float e = expf(sc[j] - m); den += e;
#pragma unroll
        for (int c = 0; c < 4; ++c) { float vc[32];
#pragma unroll
            for (int d = 0; d < 32; ++d) vc[d] = bf2f(vv[32 * c + d]);
#pragma unroll
            for (int d = 0; d < 32; ++d) o[32 * c + d] += e * vc[d];
            CFENCE(); }
    }
    const float inv = 1.0f / den;
#pragma unroll
    for (int d = 0; d < 128; ++d) p.YC[(size_t)r * MIX_W + hq * 128 + d] = f2bf(o[d] * inv);
}
HD void gdn_out_item(const Ptrs& p, int l, int r, int h) {
    float ss = 0.f;
    for (int d = 0; d < 128; ++d) { const size_t i = (size_t)r * MIX_W + h * 128 + d; const float v = p.OG[i] + p.OG[(size_t)MROWS * MIX_W + i]; ss += v * v; }
    const float rs = 1.0f / sqrtf(ss / 128.0f + EPS);
    for (int d = 0; d < 128; ++d) { const size_t i = (size_t)r * MIX_W + h * 128 + d; const float v = p.OG[i] + p.OG[(size_t)MROWS * MIX_W + i];
        p.YA[i] = f2bf(v * rs * p.gdn_norm[(size_t)l * 128 + d] * silu_f(bf2f(p.P[(size_t)r * NP_MAIN + C_GATE + h * 128 + d]))); }
}
HD void ssd_out_item(const Ptrs& p, int l, int r, int g) {
    constexpr int GW = MIX_W / SSM_G;
    float ss = 0.f;
    for (int pass = 0; pass < 2; ++pass) {
        const float rs = pass ? 1.0f / sqrtf(ss / (float)GW + EPS) : 0.f;
        for (int jj = 0; jj < GW; ++jj) { const int j = g * GW + jj; const size_t i = (size_t)r * MIX_W + j;
            float y = p.OS[i] + p.OS[(size_t)MROWS * MIX_W + i] + p.ssm_d[(size_t)l * SSM_H + j / SSM_P] * p.SXBC[(size_t)r * SSM_XBC + j];
            y *= silu_f(bf2f(p.P[(size_t)r * NP_MAIN + C_Z + j]));
            if (!pass) ss += y * y; else p.YB[i] = f2bf(y * rs * p.ssm_norm[(size_t)l * MIX_W + j]); }
    }
}
HD void act_item(const Ptrs& p, int l, int r, int j) {
    int b, t, len; bool ic; row_info(r, b, t, len, ic);
    const float* w = p.ffn_conv_w + (size_t)l * 3 * D_FF;
    const bf16* ug = p.UG + (size_t)r * (2 * D_FF);
    float g = w[D_FF + j] * bf2f(ug[D_FF + j]);
    if (t > 0) g += w[j] * bf2f(ug[D_FF + j - 2 * D_FF]);
    if (t < len - 1) g += w[2 * D_FF + j] * bf2f(ug[D_FF + j + 2 * D_FF]);
    g += p.ffn_conv_b[(size_t)l * D_FF + j];
    p.ACT[(size_t)r * D_FF + j] = f2bf(silu_f(g) * bf2f(ug[j]));
}

namespace pg8 {
#define PG8_LAS __attribute__((address_space(3)))
typedef unsigned short bf16_t;
typedef short bf16x8 __attribute__((ext_vector_type(8)));
typedef float f32x4 __attribute__((ext_vector_type(4)));
typedef unsigned u32x4 __attribute__((ext_vector_type(4)));
constexpr int BM = 256, BK = 64, HALF = 128, HTB = HALF * BK * 2  , STAGE_BYTES = 8 * HTB, NXCD = 8, WGM = 8;

__host__ __device__ __forceinline__ int lds_byte(int r, int c) { const int st = (r >> 4) * 2 + (c >> 5), rr = r & 15, cc = c & 31, ob = rr * 64 + cc * 2; return st * 1024 + (ob ^ (((ob >> 9) & 1) << 5)); }
__host__ __device__ __forceinline__ void stage_rc(int b, int& R, int& C) { const int st = b / 1024, sb = b % 1024, swz = sb ^ (((sb >> 9) & 1) << 5); R = (st >> 1) * 16 + swz / 64; C = (st & 1) * 32 + (swz % 64) / 2; }
__host__ __device__ __forceinline__ int perm32(int rho) { const int n = rho >> 4, i = rho & 15; return 8 * (i >> 2) + 4 * n + (i & 3); }

struct Unit { int pm, pn, pk; };
struct Gemm { const bf16_t* A; const bf16_t* Bt; int M, N, K, ld; };

struct StaticOrder {
    int nM, nN, nwg, G, c;
    __host__ __device__ void init(int M, int N, int G_, int c_) { nM = M / BM; nN = N / BM; nwg = nM * nN; G = G_; c = c_; }
    __host__ __device__ bool next(int i, Unit& u) const {
        const long L = (long)i * G + c; if (L >= nwg) return false;
        int wgid = (int)L; { const int q = nwg / NXCD, r = nwg % NXCD, xcd = wgid % NXCD, off = wgid / NXCD; wgid = (xcd < r ? xcd * (q + 1) : r * (q + 1) + (xcd - r) * q) + off; }
        const int nig = WGM * nN, gid = wgid / nig, fm = gid * WGM, gsz = (nM - fm) < WGM ? (nM - fm) : WGM;
        u.pm = fm + ((wgid % nig) % gsz); u.pn = (wgid % nig) / gsz; u.pk = 0; return true;
    }
    __device__ __forceinline__ void a_ready(const Unit&) const {}
    __device__ __forceinline__ void done(const Unit&) const {}
};

__device__ __forceinline__ unsigned cvt_pk_bf16(float lo, float hi) { unsigned r; asm volatile("v_cvt_pk_bf16_f32 %0, %1, %2" : "=v"(r) : "v"(lo), "v"(hi)); return r; }

template <class Epi, class Sched, bool ALIGN_EPI = false, bool SP2 = false>
__device__ __forceinline__ void gemm_phase(PG8_LAS unsigned char* lds, const Gemm g, const Sched& S, const Epi& E, int tid_in) {
    int tid_l = tid_in; asm volatile("" : "+v"(tid_l));
    const int tid = tid_l, wid = __builtin_amdgcn_readfirstlane(tid >> 6), lane = tid & 63, wr = wid >> 2, wc = wid & 3, fr = lane & 15, fq = lane >> 4;
    const int K = g.K, nt = K / BK, LD = g.ld;
    unsigned voffA[2], voffB[2];
#pragma unroll
    for (int i = 0; i < 2; ++i) { int R, C; stage_rc(tid * 16 + i * 8192, R, C); const int Rb = Epi::PERM ? ((R & ~31) + perm32(R & 31)) : R;
        voffA[i] = (unsigned)(R * LD + C) * 2u; voffB[i] = (unsigned)(Rb * LD + C) * 2u; }
    const size_t kstep = (size_t)(BK * 2);
    const size_t hstep = (size_t)HALF * LD * 2;
    const size_t tstep = 2 * hstep;
    const unsigned ldsw = (unsigned)wid * 1024u;
    const int aoff = lds_byte(wr * 64 + fr, fq * 8), boff = lds_byte(wc * 32 + fr, fq * 8);
#define PG8_SA(b, h) (((b) * 2 + (h)) * HTB)
#define PG8_SB(b, h) ((4 + (b) * 2 + (h)) * HTB)
#define PG8_STAGE(bufoff, gbase, voff) do { _Pragma("unroll") for (int _i = 0; _i < 2; ++_i) \
        __builtin_amdgcn_global_load_lds((const unsigned*)((const char*)(gbase) + (voff)[_i]), (PG8_LAS unsigned*)(lds + (bufoff) + ldsw + _i * 8192), 16, 0, 0); } while (0)
#define PG8_LDA(dst, b, h) do { _Pragma("unroll") for (int m = 0; m < 4; ++m) _Pragma("unroll") for (int k = 0; k < 2; ++k) dst[m][k] = *(const PG8_LAS bf16x8*)(lds + PG8_SA(b, h) + aoff + m * 2048 + k * 1024); } while (0)
#define PG8_LDB(dst, b, h) do { _Pragma("unroll") for (int n = 0; n < 2; ++n) _Pragma("unroll") for (int k = 0; k < 2; ++k) dst[n][k] = *(const PG8_LAS bf16x8*)(lds + PG8_SB(b, h) + boff + n * 2048 + k * 1024); } while (0)
#define PG8_MMA(ai, bj, At, Bt) do { __builtin_amdgcn_s_setprio(1); _Pragma("unroll") for (int m = 0; m < 4; ++m) _Pragma("unroll") for (int n = 0; n < 2; ++n) _Pragma("unroll") for (int k = 0; k < 2; ++k) \
        acc[ai][bj][m][n] = __builtin_amdgcn_mfma_f32_16x16x32_bf16(Bt[n][k], At[m][k], acc[ai][bj][m][n], 0, 0, 0); __builtin_amdgcn_s_setprio(0); } while (0)
#define PG8_WAIT_V(n) asm volatile("s_waitcnt vmcnt(" #n ")" ::: "memory")
#define PG8_WAIT_L(n) asm volatile("s_waitcnt lgkmcnt(" #n ")" ::: "memory")
#define PG8_BAR __builtin_amdgcn_s_barrier()
#define PG8_SCHED __builtin_amdgcn_sched_barrier(0)
    Unit cur, nxt; int ui = 0;
    if (!S.next(0, cur)) return;
    f32x4 acc[2][2][4][2];
#pragma unroll
    for (int a = 0; a < 2; ++a)
#pragma unroll
        for (int b = 0; b < 2; ++b)
#pragma unroll
            for (int m = 0; m < 4; ++m)
#pragma unroll
                for (int n = 0; n < 2; ++n) acc[a][b][m][n] = (f32x4){0.f, 0.f, 0.f, 0.f};
    bf16x8 At[4][2], B0[2][2], B1[2][2];
    const char* cA = (const char*)g.A + (size_t)cur.pm * tstep + (size_t)cur.pk * 2; const char* cB = (const char*)g.Bt + (size_t)cur.pn * tstep + (size_t)cur.pk * 2;
    S.a_ready(cur);
    if constexpr (SP2) {
        PG8_STAGE(PG8_SB(0, 0), cB, voffB); PG8_STAGE(PG8_SB(0, 1), cB + hstep, voffB); PG8_STAGE(PG8_SA(0, 0), cA, voffA); PG8_STAGE(PG8_SA(0, 1), cA + hstep, voffA);
        if (wr == 1) PG8_BAR;
        PG8_WAIT_V(2); PG8_BAR;
        PG8_STAGE(PG8_SB(1, 0), cB + kstep, voffB); PG8_STAGE(PG8_SA(1, 0), cA + kstep, voffA); PG8_STAGE(PG8_SB(1, 1), cB + hstep + kstep, voffB);
        PG8_WAIT_V(6); PG8_BAR;
    } else {
        PG8_STAGE(PG8_SB(0, 0), cB, voffB); PG8_STAGE(PG8_SA(0, 0), cA, voffA); PG8_STAGE(PG8_SB(0, 1), cB + hstep, voffB); PG8_STAGE(PG8_SA(0, 1), cA + hstep, voffA);
        if (wr == 1) PG8_BAR;
        PG8_WAIT_V(4); PG8_BAR;
        PG8_STAGE(PG8_SB(1, 0), cB + kstep, voffB); PG8_STAGE(PG8_SA(1, 0), cA + kstep, voffA); PG8_STAGE(PG8_SB(1, 1), cB + hstep + kstep, voffB);
        PG8_WAIT_V(6); PG8_BAR;
    }
    for (;;) {
        const bool has_next = S.next(ui + 1, nxt);
        const char* nA = has_next ? (const char*)g.A + (size_t)nxt.pm * tstep + (size_t)nxt.pk * 2 : cA; const char* nB = has_next ? (const char*)g.Bt + (size_t)nxt.pn * tstep + (size_t)nxt.pk * 2 : cB;
        for (int t = 0; t < nt; t += 2) {
            const bool last = (t == nt - 2);
            const char* a1 = cA + (size_t)(t + 1) * kstep;
            const char* a2 = last ? nA : cA + (size_t)(t + 2) * kstep; const char* b2 = last ? nB : cB + (size_t)(t + 2) * kstep;
            const char* a3 = a2 + kstep; const char* b3 = b2 + kstep;
            if (last && has_next) S.a_ready(nxt);
            if constexpr (Epi::KHOOK) E.khook(acc, cur, t, wr, wc, fr, fq);
            if constexpr (SP2) {
            PG8_LDB(B0, 0, 0); PG8_LDB(B1, 0, 1); PG8_SCHED; PG8_LDA(At, 0, 0); PG8_STAGE(PG8_SA(1, 1), a1 + hstep, voffA);
            PG8_WAIT_V(8); PG8_WAIT_L(0); PG8_BAR; PG8_MMA(0, 0, At, B0); PG8_MMA(0, 1, At, B1); PG8_BAR; PG8_SCHED;
            PG8_LDA(At, 0, 1); PG8_STAGE(PG8_SB(0, 0), b2, voffB); PG8_STAGE(PG8_SB(0, 1), b2 + hstep, voffB); PG8_STAGE(PG8_SA(0, 0), a2, voffA);
            PG8_WAIT_V(8); PG8_WAIT_L(0); PG8_BAR; PG8_MMA(1, 0, At, B0); PG8_MMA(1, 1, At, B1); PG8_BAR; PG8_SCHED;
            PG8_LDB(B0, 1, 0); PG8_LDB(B1, 1, 1); PG8_SCHED; PG8_LDA(At, 1, 0); PG8_STAGE(PG8_SA(0, 1), a2 + hstep, voffA);
            PG8_WAIT_V(8); PG8_WAIT_L(0); PG8_BAR; PG8_MMA(0, 0, At, B0); PG8_MMA(0, 1, At, B1); PG8_BAR; PG8_SCHED;
            PG8_LDA(At, 1, 1); PG8_STAGE(PG8_SB(1, 0), b3, voffB); PG8_STAGE(PG8_SB(1, 1), b3 + hstep, voffB); PG8_STAGE(PG8_SA(1, 0), a3, voffA);
            PG8_WAIT_V(8); PG8_WAIT_L(0); PG8_BAR; PG8_MMA(1, 0, At, B0); PG8_MMA(1, 1, At, B1); PG8_BAR; PG8_SCHED;
            } else {
            PG8_LDB(B0, 0, 0); PG8_SCHED; PG8_LDA(At, 0, 0); PG8_STAGE(PG8_SA(1, 1), a1 + hstep, voffA);
            PG8_WAIT_L(8); PG8_BAR; PG8_WAIT_L(0); PG8_MMA(0, 0, At, B0); PG8_BAR; PG8_SCHED;
            PG8_LDB(B1, 0, 1); PG8_STAGE(PG8_SB(0, 0), b2, voffB);
            PG8_BAR; PG8_WAIT_L(0); PG8_MMA(0, 1, At, B1); PG8_BAR;
            PG8_LDA(At, 0, 1); PG8_STAGE(PG8_SA(0, 0), a2, voffA);
            PG8_BAR; PG8_WAIT_L(0); PG8_MMA(1, 0, At, B0); PG8_BAR; PG8_SCHED;
            PG8_STAGE(PG8_SB(0, 1), b2 + hstep, voffB);
            PG8_WAIT_V(6); PG8_BAR; PG8_MMA(1, 1, At, B1); PG8_BAR;
            PG8_LDB(B0, 1, 0); PG8_SCHED; PG8_LDA(At, 1, 0); PG8_STAGE(PG8_SA(0, 1), a2 + hstep, voffA);
            PG8_WAIT_L(8); PG8_BAR; PG8_WAIT_L(0); PG8_MMA(0, 0, At, B0); PG8_BAR; PG8_SCHED;
            PG8_LDB(B1, 1, 1); PG8_STAGE(PG8_SB(1, 0), b3, voffB);
            PG8_BAR; PG8_WAIT_L(0); PG8_MMA(0, 1, At, B1); PG8_BAR;
            PG8_LDA(At, 1, 1); PG8_STAGE(PG8_SA(1, 0), a3, voffA);
            PG8_BAR; PG8_WAIT_L(0); PG8_MMA(1, 0, At, B0); PG8_BAR; PG8_SCHED;
            PG8_STAGE(PG8_SB(1, 1), b3 + hstep, voffB);
            PG8_WAIT_V(6); PG8_BAR; PG8_MMA(1, 1, At, B1); PG8_BAR;
            }
        }
        if constexpr (ALIGN_EPI) { if (wr == 0) PG8_BAR; }
        if constexpr (!Epi::AFTER_DRAIN) { E(acc, cur, wr, wc, fr, fq); S.done(cur); }
        if (!has_next) break;
#pragma unroll
        for (int a = 0; a < 2; ++a)
#pragma unroll
            for (int b = 0; b < 2; ++b)
#pragma unroll
                for (int m = 0; m < 4; ++m)
#pragma unroll
                    for (int n = 0; n < 2; ++n) acc[a][b][m][n] = (f32x4){0.f, 0.f, 0.f, 0.f};
        cur = nxt; cA = nA; cB = nB; ++ui;
        if constexpr (ALIGN_EPI) { if (wr == 1) PG8_BAR; }
    }
    PG8_WAIT_V(0);
    if constexpr (!ALIGN_EPI) { if (wr == 0) PG8_BAR; }
    PG8_BAR;
    if constexpr (Epi::AFTER_DRAIN) { E.fused(acc, cur, wr, wc, fr, fq, lds, wid, lane); S.done(cur); }
#undef PG8_SA
#undef PG8_SB
#undef PG8_STAGE
#undef PG8_LDA
#undef PG8_LDB
#undef PG8_MMA
#undef PG8_WAIT_V
#undef PG8_WAIT_L
#undef PG8_BAR
#undef PG8_SCHED
}
}
#define GAS __attribute__((address_space(1)))
#define LAS __attribute__((address_space(3)))
typedef GAS unsigned gu32;
typedef GAS unsigned long long gu64;
#define RLX_AGENT __ATOMIC_RELAXED, __HIP_MEMORY_SCOPE_AGENT
#define XB_TMO      128
#define XB_XCNT(j)  (256  + 64 * (j))
#define XB_XSUB(j)  (1280 + 64 * (j))
#define XB_XGEN(j)  (2304 + 64 * (j))
#define XB_TOP      3328
#define XB_TOPGEN   3392
#define XCD_BAR_WORDS 3456
#define XB_SPIN_CAP (1u << 18)

__device__ __forceinline__ unsigned xb_ld(unsigned* p)              { return __hip_atomic_load(p, __ATOMIC_RELAXED, __HIP_MEMORY_SCOPE_AGENT); }
__device__ __forceinline__ unsigned xb_add(unsigned* p, unsigned v) { return __hip_atomic_fetch_add(p, v, __ATOMIC_RELAXED, __HIP_MEMORY_SCOPE_AGENT); }
__device__ __forceinline__ unsigned xb_xcc_id() { return (unsigned)__builtin_amdgcn_s_getreg((3 << 11) | 20) & 0xFu; }
#define XB_SPIN(cond, bar) do { unsigned _sp = 0; while (cond) { __builtin_amdgcn_s_sleep(1); \
    if ((++_sp & 255u) == 0u) { if (xb_ld(&(bar)[XB_TMO])) break; if (_sp > XB_SPIN_CAP) { atomicAdd(&(bar)[XB_TMO], 1u); break; } } } } while (0)

struct XcdBarrier {
    unsigned* bar; unsigned x;
    volatile LAS unsigned* st;
};

__device__ __forceinline__ XcdBarrier xcd_barrier_post(unsigned* bar, volatile LAS unsigned* st) {
    XcdBarrier b; b.bar = bar; b.x = xb_xcc_id(); b.st = st;
    if (threadIdx.x == 0) (void)xb_add(&bar[XB_XCNT(b.x)], 1u);
    return b;
}
__device__ __forceinline__ void xcd_barrier_complete(unsigned* bar, unsigned x, unsigned& nloc, unsigned& nx) {
    const unsigned G = gridDim.x * gridDim.y * gridDim.z;
    unsigned sum, cnt, mine, sp = 0u;
    for (;;) {
        sum = 0u; cnt = 0u; mine = 0u;
#pragma unroll
        for (unsigned j = 0; j < 16; ++j) { const unsigned c = xb_ld(&bar[XB_XCNT(j)]); sum += c; cnt += (c > 0u) ? 1u : 0u; mine = (j == x) ? c : mine; }
        if (sum == G) break;
        __builtin_amdgcn_s_sleep(1);
        if ((++sp & 255u) == 0u) { if (xb_ld(&bar[XB_TMO])) break; if (sp > XB_SPIN_CAP) { atomicAdd(&bar[XB_TMO], 1u); break; } }
    }
    nloc = mine > 0u ? mine : 1u; nx = cnt > 0u ? cnt : 1u;
}

__device__ __forceinline__ void xcd_barrier(const XcdBarrier& b) {
    asm volatile("s_waitcnt vmcnt(0)" ::: "memory");
    __syncthreads();
    if (threadIdx.x == 0) {
        unsigned* bar = b.bar;
        __builtin_amdgcn_s_waitcnt(0);
        unsigned nloc = b.st[0], nx = b.st[1];
        if (nloc == 0u) { xcd_barrier_complete(bar, b.x, nloc, nx); b.st[0] = nloc; b.st[1] = nx; }
        const unsigned old = xb_add(&bar[XB_XSUB(b.x)], 1u);
        const unsigned gen = old / nloc;
        if (old + 1u == (gen + 1u) * nloc) {
            __builtin_amdgcn_fence(__ATOMIC_RELEASE, "agent");
            asm volatile("s_waitcnt vmcnt(0)" ::: "memory");
            const unsigned og = xb_add(&bar[XB_TOP], 1u);
            const unsigned tg = og / nx;
            if (og + 1u == (tg + 1u) * nx) xb_add(&bar[XB_TOPGEN], 1u);
            else XB_SPIN(xb_ld(&bar[XB_TOPGEN]) == tg, bar);
            __builtin_amdgcn_fence(__ATOMIC_ACQUIRE, "agent");
            xb_add(&bar[XB_XGEN(b.x)], 1u);
            asm volatile("s_waitcnt vmcnt(0)" ::: "memory");
        } else {
            XB_SPIN(xb_ld(&bar[XB_XGEN(b.x)]) == gen, bar);
            __builtin_amdgcn_fence(__ATOMIC_ACQUIRE, "agent");
            asm volatile("s_waitcnt vmcnt(0)" ::: "memory");
        }
    }
    __syncthreads();
}

#define LDS_BARRIER() do { asm volatile("s_waitcnt lgkmcnt(0)" ::: "memory"); __builtin_amdgcn_s_barrier(); asm volatile("" ::: "memory"); } while (0)
typedef float vf4 __attribute__((ext_vector_type(4)));
typedef unsigned vu2 __attribute__((ext_vector_type(2)));
typedef unsigned vu4 __attribute__((ext_vector_type(4)));
__device__ __forceinline__ float wave_sum(float v) {
#pragma unroll
    for (int o = 1; o < 64; o <<= 1) v += __shfl_xor(v, o);
    return v;
}
template <int CTRL> __device__ __forceinline__ float dpp_f(float x) { return __builtin_bit_cast(float, __builtin_amdgcn_mov_dpp(__builtin_bit_cast(int, x), CTRL, 0xf, 0xf, true)); }
__device__ __forceinline__ float sum16(float x) { x += dpp_f<0xB1>(x); x += dpp_f<0x4E>(x); x += dpp_f<0x124>(x); x += dpp_f<0x128>(x); return x; }
__device__ __forceinline__ float sum8(float x) { x += dpp_f<0xB1>(x); x += dpp_f<0x4E>(x); x += dpp_f<0x141>(x); return x; }
__device__ __forceinline__ unsigned pk2(float lo, float hi) { return (unsigned)f2bf(lo) | ((unsigned)f2bf(hi) << 16); }

constexpr int NV4 = D_MODEL / 256;
__device__ __forceinline__ void row_load(const float* row, int lane, vf4 (&x)[NV4]) {
#pragma unroll
    for (int j = 0; j < NV4; ++j) x[j] = __builtin_nontemporal_load((const vf4*)(row + (size_t)(j * 64 + lane) * 4));
}
__device__ __forceinline__ void row_store(float* row, int lane, const vf4 (&x)[NV4]) {
#pragma unroll
    for (int j = 0; j < NV4; ++j) __builtin_nontemporal_store(x[j], (vf4*)(row + (size_t)(j * 64 + lane) * 4));
}
__device__ __forceinline__ float row_rs(const vf4 (&x)[NV4]) {
    float ss = 0.f;
#pragma unroll
    for (int j = 0; j < NV4; ++j) ss += (x[j].x * x[j].x + x[j].y * x[j].y) + (x[j].z * x[j].z + x[j].w * x[j].w);
    return 1.0f / sqrtf(wave_sum(ss) * (1.0f / D_MODEL) + EPS);
}
__device__ __forceinline__ void norm_h_wave(const Ptrs& p, int l, int r, int which, int lane, const vf4 (&x)[NV4]) {
    const float rs = row_rs(x);
    const float* g = (which ? p.g_pre2 : p.g_pre1) + (size_t)l * D_MODEL;
    const float* mod = p.MOD + ((size_t)l * (BATCH + 1) + mod_row(r)) * D6 + (which ? 3 * D_MODEL : 0);
#pragma unroll
    for (int j = 0; j < NV4; ++j) { const int c = (j * 64 + lane) * 4;
        const vf4 gv = *(const vf4*)(g + c), sh = *(const vf4*)(mod + c), sc = *(const vf4*)(mod + D_MODEL + c);
        const vf4 o = x[j] * rs * gv * (1.0f + sc) + sh;
        vu2 w; w.x = pk2(o.x, o.y); w.y = pk2(o.z, o.w);
        *(vu2*)(p.H + (size_t)r * D_MODEL + c) = w; }
}
__device__ __forceinline__ void resid_wave(const Ptrs& p, int l, int r, int which, int lane, vf4 (&x)[NV4], int ns) {
    vf4 y[NV4];
    if (r >= NLAT) {
#pragma unroll
        for (int j = 0; j < NV4; ++j) y[j] = (vf4){0.f, 0.f, 0.f, 0.f};
        for (int s = 0; s < ns; ++s) {
#pragma unroll
            for (int j = 0; j < NV4; ++j) y[j] += *(const vf4*)(p.SLAB + ((size_t)s * NCTX + (r - NLAT)) * D_MODEL + (size_t)(j * 64 + lane) * 4); }
    } else
#pragma unroll
    for (int j = 0; j < NV4; ++j) { const vu2 w = __builtin_nontemporal_load((const vu2*)(p.MIXb + (size_t)r * D_MODEL + (size_t)(j * 64 + lane) * 4)); y[j] = (vf4){__uint_as_float(w.x << 16), __uint_as_float(w.x & 0xffff0000u), __uint_as_float(w.y << 16), __uint_as_float(w.y & 0xffff0000u)}; }
    const float rs = row_rs(y);
    const float* g = (which ? p.g_post2 : p.g_post1) + (size_t)l * D_MODEL;
    const float* gate = p.MOD + ((size_t)l * (BATCH + 1) + mod_row(r)) * D6 + (which ? 5 * D_MODEL : 2 * D_MODEL);
#pragma unroll
    for (int j = 0; j < NV4; ++j) { const int c = (j * 64 + lane) * 4; x[j] += *(const vf4*)(gate + c) * (y[j] * rs * *(const vf4*)(g + c)); }
}

struct WtDesc { const float* W; bf16* WT; int K, N, k0, n0, drow0; };
__device__ __forceinline__ void transpose_load(const WtDesc& d, int lane, float (&wv)[32]) {
#pragma unroll
    for (int i = 0; i < 32; ++i) wv[i] = __builtin_nontemporal_load(d.W + (size_t)(d.k0 + 2 * i + (lane >> 5)) * d.N + d.n0 + (lane & 31));
}
__device__ __forceinline__ void transpose_finish(const WtDesc& d, const float (&wv)[32], LAS float* scr, int lane) {
#pragma unroll
    for (int i = 0; i < 32; ++i) scr[(2 * i + (lane >> 5)) * 33 + (lane & 31)] = wv[i];
    asm volatile("s_waitcnt lgkmcnt(0)" ::: "memory");
    const int c = lane & 7;
#pragma unroll
    for (int j = 0; j < 4; ++j) { const int n = (lane >> 3) + 8 * j; const LAS float* s = scr + (8 * c) * 33 + n;
        vu4 o; o.x = pk2(s[0 * 33], s[1 * 33]); o.y = pk2(s[2 * 33], s[3 * 33]); o.z = pk2(s[4 * 33], s[5 * 33]); o.w = pk2(s[6 * 33], s[7 * 33]);
        __builtin_nontemporal_store(o, (vu4*)(d.WT + (size_t)(d.drow0 + n) * d.K + d.k0 + 8 * c)); }
    asm volatile("s_waitcnt lgkmcnt(0)" ::: "memory");
}
__device__ __forceinline__ void transpose_item(const float* W, int K, int N, bf16* WT, int k0, int n0, int drow0, LAS float* scr, int lane) {
    const WtDesc d{W, WT, K, N, k0, n0, drow0}; float wv[32];
    transpose_load(d, lane, wv); transpose_finish(d, wv, scr, lane);
}
__device__ __forceinline__ int inproj_dst_row0(int n0) {
    if (n0 < R_A) return n0;
    if (n0 == R_A) return NP_MAIN;
    if (n0 < R_DT) return n0 - 4 * GDN_H;
    if (n0 == R_DT) return NP_MAIN + PF_DT;
    return n0 - 4 * GDN_H - 2 * SSM_H;
}
__device__ __forceinline__ int up_dst_row0(int n0) {
    const int isg = n0 >= D_FF, j = isg ? n0 - D_FF : n0; return 256 * (j >> 7) + 128 * isg + (j & 127);
}
static_assert(D_FF % 128 == 0, "up-projection tile order");
static_assert(4 * GDN_H == 32 && 2 * SSM_H == 32 && R_A % 32 == 0 && R_DT % 32 == 0, "the 32-column transpose items assume the real shapes");

constexpr int TB = 32;
constexpr int GDN_BUF = TB * 256 + TB * 32 + TB * 2;
__device__ __forceinline__ void gdn_token_wg(const Ptrs& p, LAS float* L, int chain, int slice, int tid) {
    const int b = chain / (GDN_H * 2), h = (chain >> 1) % GDN_H, dir = chain & 1;
    const int lane = tid & 63, wave = tid >> 6, ks = lane & 15, cl = wave * 4 + (lane >> 4);
    LAS float* obuf = L + 2 * GDN_BUF;
    float S[8];
#pragma unroll
    for (int e = 0; e < 8; ++e) S[e] = 0.f;
    vf4 rq[4], rv; float ra = 0.f, rb = 0.f;
    constexpr int NB = CHAIN_LEN / TB;
    auto gload = [&](int n) {
#pragma unroll
        for (int j = 0; j < 4; ++j) { const int idx = j * 512 + tid, i = idx >> 6, c4 = idx & 63; const int r = chain_row(b, dir, n * TB + i);
            rq[j] = *(const vf4*)(p.GQKV + (size_t)r * (3 * MIX_W) + h * 128 + (c4 < 32 ? c4 * 4 : MIX_W + (c4 - 32) * 4)); }
        if (tid < 256) { const int i = tid >> 3, c4 = tid & 7; const int r = chain_row(b, dir, n * TB + i);
            rv = *(const vf4*)(p.GQKV + (size_t)r * (3 * MIX_W) + 2 * MIX_W + h * 128 + slice * 32 + c4 * 4); }
        if (tid < TB) { const int r = chain_row(b, dir, n * TB + tid); ra = __expf(p.GG[(size_t)r * 2 * GDN_H + dir * GDN_H + h]); rb = p.GB[(size_t)r * 2 * GDN_H + dir * GDN_H + h]; }
    };
    auto lstore = [&](LAS float* B) {
#pragma unroll
        for (int j = 0; j < 4; ++j) { const int idx = j * 512 + tid; *(LAS vf4*)(B + (idx >> 6) * 256 + (idx & 63) * 4) = rq[j]; }
        if (tid < 256) *(LAS vf4*)(B + TB * 256 + tid * 4) = rv;
        if (tid < TB) { B[TB * 256 + TB * 32 + tid * 2] = ra; B[TB * 256 + TB * 32 + tid * 2 + 1] = rb; }
    };
    gload(0); lstore(L); LDS_BARRIER();
    for (int n = 0; n < NB; ++n) {
        LAS float* B = L + (n & 1) * GDN_BUF; LAS float* ob = obuf + (n & 1) * (TB * 32);
        if (n + 1 < NB) gload(n + 1);
#pragma unroll 4
        for (int i = 0; i < TB; ++i) {
            const LAS float* kq = B + i * 256;
            const vf4 q0 = *(const LAS vf4*)(kq + ks * 8), q1 = *(const LAS vf4*)(kq + ks * 8 + 4), k0 = *(const LAS vf4*)(kq + 128 + ks * 8), k1 = *(const LAS vf4*)(kq + 128 + ks * 8 + 4);
            const float v = B[TB * 256 + i * 32 + cl], a = B[TB * 256 + TB * 32 + i * 2], be = B[TB * 256 + TB * 32 + i * 2 + 1];
            const float kk[8] = {k0.x, k0.y, k0.z, k0.w, k1.x, k1.y, k1.z, k1.w}, qq[8] = {q0.x, q0.y, q0.z, q0.w, q1.x, q1.y, q1.z, q1.w};
            float rr = 0.f;
#pragma unroll
            for (int e = 0; e < 8; ++e) { S[e] *= a; rr += kk[e] * S[e]; }
            rr = sum16(rr);
            const float dl = be * (v - rr); float o = 0.f;
#pragma unroll
            for (int e = 0; e < 8; ++e) { S[e] += kk[e] * dl; o += qq[e] * S[e]; }
            o = sum16(o);
            if (ks == 0) ob[i * 32 + cl] = o;
        }
        if (n + 1 < NB) lstore(L + ((n + 1) & 1) * GDN_BUF);
        LDS_BARRIER();
        if (tid < 256) { const int i = tid >> 3, c4 = tid & 7; const int r = chain_row(b, dir, n * TB + i);
            *(vf4*)(p.OG + ((size_t)dir * MROWS + r) * MIX_W + h * 128 + slice * 32 + c4 * 4) = *(const LAS vf4*)(ob + i * 32 + c4 * 4); }
    }
}
constexpr int SSD_BUF = TB * 256 + TB * 64 + TB * 2;
__device__ __forceinline__ void ssd_token_wg(const Ptrs& p, LAS float* L, int chain, int tid) {
    const int b = chain / (SSM_H * 2), hd = (chain >> 1) % SSM_H, dir = chain & 1, g = hd / SSM_HPG;
    const int lane = tid & 63, wave = tid >> 6, ss = lane & 7, pc = wave * 8 + (lane >> 3);
    LAS float* obuf = L + 2 * SSD_BUF;
    float hs[16];
#pragma unroll
    for (int e = 0; e < 16; ++e) hs[e] = 0.f;
    vf4 rbc[4], rx; float rdt = 0.f, rea = 0.f;
    constexpr int NB = CHAIN_LEN / TB;
    auto gload = [&](int n) {
#pragma unroll
        for (int j = 0; j < 4; ++j) { const int idx = j * 512 + tid, i = idx >> 6, c4 = idx & 63; const int r = chain_row(b, dir, n * TB + i);
            rbc[j] = *(const vf4*)(p.SXBC + (size_t)r * SSM_XBC + MIX_W + (c4 < 32 ? g * SSM_N + c4 * 4 : SSM_BC + g * SSM_N + (c4 - 32) * 4)); }
        { const int i = tid >> 4, c4 = tid & 15; const int r = chain_row(b, dir, n * TB + i); rx = *(const vf4*)(p.SXBC + (size_t)r * SSM_XBC + hd * SSM_P + c4 * 4); }
        if (tid < TB) { const int r = chain_row(b, dir, n * TB + tid); rdt = p.SDT[(size_t)r * 2 * SSM_H + dir * SSM_H + hd]; rea = __expf(p.SA[(size_t)r * 2 * SSM_H + dir * SSM_H + hd]); }
    };
    auto lstore = [&](LAS float* B) {
#pragma unroll
        for (int j = 0; j < 4; ++j) { const int idx = j * 512 + tid; *(LAS vf4*)(B + (idx >> 6) * 256 + (idx & 63) * 4) = rbc[j]; }
        *(LAS vf4*)(B + TB * 256 + tid * 4) = rx;
        if (tid < TB) { B[TB * 256 + TB * 64 + tid * 2] = rdt; B[TB * 256 + TB * 64 + tid * 2 + 1] = rea; }
    };
    gload(0); lstore(L); LDS_BARRIER();
    for (int n = 0; n < NB; ++n) {
        LAS float* B = L + (n & 1) * SSD_BUF; LAS float* ob = obuf + (n & 1) * (TB * 64);
        if (n + 1 < NB) gload(n + 1);
#pragma unroll 2
        for (int i = 0; i < TB; ++i) {
            const LAS float* bc = B + i * 256;
            const float xd = B[TB * 256 + i * 64 + pc] * B[TB * 256 + TB * 64 + i * 2], ea = B[TB * 256 + TB * 64 + i * 2 + 1];
            float y = 0.f;
#pragma unroll
            for (int q = 0; q < 4; ++q) { const vf4 bv = *(const LAS vf4*)(bc + ss * 16 + q * 4), cv = *(const LAS vf4*)(bc + 128 + ss * 16 + q * 4);
                hs[4 * q + 0] = ea * hs[4 * q + 0] + xd * bv.x; y += cv.x * hs[4 * q + 0];
                hs[4 * q + 1] = ea * hs[4 * q + 1] + xd * bv.y; y += cv.y * hs[4 * q + 1];
                hs[4 * q + 2] = ea * hs[4 * q + 2] + xd * bv.z; y += cv.z * hs[4 * q + 2];
                hs[4 * q + 3] = ea * hs[4 * q + 3] + xd * bv.w; y += cv.w * hs[4 * q + 3]; }
            y = sum8(y);
            if (ss == 0) ob[i * 64 + pc] = y;
        }
        if (n + 1 < NB) lstore(L + ((n + 1) & 1) * SSD_BUF);
        LDS_BARRIER();
        { const int i = tid >> 4, c4 = tid & 15; const int r = chain_row(b, dir, n * TB + i);
            *(vf4*)(p.OS + ((size_t)dir * MROWS + r) * MIX_W + hd * SSM_P + c4 * 4) = *(const LAS vf4*)(ob + i * 64 + c4 * 4); }
    }
}

constexpr int YLD = 3 * MIX_W;
typedef float f32x2_t __attribute__((ext_vector_type(2)));
typedef __bf16 bf16x2_t __attribute__((ext_vector_type(2)));
typedef short bf16x8_t __attribute__((ext_vector_type(8)));
typedef float f32x16_t __attribute__((ext_vector_type(16)));
__device__ __forceinline__ unsigned cvtpk(float lo, float hi) { f32x2_t v = {lo, hi}; bf16x2_t b = __builtin_convertvector(v, bf16x2_t); return __builtin_bit_cast(unsigned, b); }
__device__ __forceinline__ float bflo(unsigned w) { return __uint_as_float(w << 16); }
__device__ __forceinline__ float bfhi(unsigned w) { return __uint_as_float(w & 0xffff0000u); }
__device__ __forceinline__ void unpack8(const vu4 w, float (&f)[8]) { f[0] = bflo(w.x); f[1] = bfhi(w.x); f[2] = bflo(w.y); f[3] = bfhi(w.y); f[4] = bflo(w.z); f[5] = bfhi(w.z); f[6] = bflo(w.w); f[7] = bfhi(w.w); }
__device__ __forceinline__ float silu_fast(float x) { return x * __builtin_amdgcn_rcpf(1.0f + __expf(-x)); }

__device__ __forceinline__ void conv8(const bf16* Prow, bool hp, bool hn, int col, const float* w, int wld, int jc, float (&y)[8]) {
    float xc[8], xp[8], xn[8];
    unpack8(*(const vu4*)(Prow + col), xc);
    if (hp) unpack8(*(const vu4*)(Prow - NP_MAIN + col), xp);
    if (hn) unpack8(*(const vu4*)(Prow + NP_MAIN + col), xn);
    const vf4 w0a = *(const vf4*)(w + jc), w0b = *(const vf4*)(w + jc + 4), w1a = *(const vf4*)(w + wld + jc), w1b = *(const vf4*)(w + wld + jc + 4), w2a = *(const vf4*)(w + 2 * wld + jc), w2b = *(const vf4*)(w + 2 * wld + jc + 4);
    const float w0[8] = {w0a.x, w0a.y, w0a.z, w0a.w, w0b.x, w0b.y, w0b.z, w0b.w}, w1[8] = {w1a.x, w1a.y, w1a.z, w1a.w, w1b.x, w1b.y, w1b.z, w1b.w}, w2[8] = {w2a.x, w2a.y, w2a.z, w2a.w, w2b.x, w2b.y, w2b.z, w2b.w};
#pragma unroll
    for (int e = 0; e < 8; ++e) { float v = w1[e] * xc[e]; if (hp) v += w0[e] * xp[e]; if (hn) v += w2[e] * xn[e]; y[e] = v; }
}
constexpr float ATT_QSCALE = 0.08838834764831845f * 1.4426950408889634f;
__device__ __forceinline__ void prep_row_wave(const Ptrs& p, int l, int r, int lane) {
    int b, t, len; bool ic; row_info(r, b, t, len, ic);
    const bool hp = t > 0, hn = t < len - 1;
    const bf16* Pr = p.P + (size_t)r * NP_MAIN;
    { const float* w = p.gdn_conv_w + (size_t)l * 3 * (3 * MIX_W);
#pragma unroll 3
        for (int ps = 0; ps < (3 * MIX_W) / 512; ++ps) { const int col = ps * 512 + lane * 8, grp = col >> 7; float y[8]; conv8(Pr, hp, hn, C_QKV + col, w, 3 * MIX_W, col, y);
            float ss = 0.f;
#pragma unroll
            for (int e = 0; e < 8; ++e) { y[e] = silu_fast(y[e]); ss += y[e] * y[e]; }
            ss = sum16(ss);
            float sc = 1.0f; if (grp < 2 * GDN_H) { sc = 1.0f / sqrtf(ss + EPS); if (grp < GDN_H) sc *= 0.08838834764831845f; }
            *(vu4*)(p.GQKVb + (size_t)r * (3 * MIX_W) + col) = (vu4){cvtpk(y[0] * sc, y[1] * sc), cvtpk(y[2] * sc, y[3] * sc), cvtpk(y[4] * sc, y[5] * sc), cvtpk(y[6] * sc, y[7] * sc)}; } }
    { const float* w = p.ssm_conv_w + (size_t)l * 3 * SSM_XBC; const float* cb = p.ssm_conv_b + (size_t)l * SSM_XBC;
#pragma unroll 3
        for (int ps = 0; ps < SSM_XBC / 512; ++ps) { const int col = ps * 512 + lane * 8; float y[8]; conv8(Pr, hp, hn, C_XBC + col, w, SSM_XBC, col, y);
            const vf4 ba = *(const vf4*)(cb + col), bb = *(const vf4*)(cb + col + 4); const float bs[8] = {ba.x, ba.y, ba.z, ba.w, bb.x, bb.y, bb.z, bb.w};
#pragma unroll
            for (int e = 0; e < 8; ++e) y[e] = silu_fast(y[e] + bs[e]);
            const vu4 w8 = {cvtpk(y[0], y[1]), cvtpk(y[2], y[3]), cvtpk(y[4], y[5]), cvtpk(y[6], y[7])};
            if (col >= MIX_W) *(vu4*)(p.SBCb + (size_t)r * (2 * SSM_BC) + col - MIX_W) = w8; else *(vu4*)(p.SXb + (size_t)r * MIX_W + col) = w8; } }
    if (lane < 2 * GDN_H) prep_gdn_gb_item(p, l, r, lane);
    if (lane < 2 * SSM_H) prep_ssd_dt_item(p, l, r, lane);
    { const int l16 = lane & 15, ax = l16 >> 3, i0 = (l16 & 7) * 4; const int pos = ic ? 0 : (ax ? t % GRID_W : t / GRID_W);
        const vf4 t0 = *(const vf4*)(p.ROPE + (size_t)(pos * 32 + i0) * 2), t1 = *(const vf4*)(p.ROPE + (size_t)(pos * 32 + i0) * 2 + 4);
        const float cs[4] = {t0.x, t0.z, t1.x, t1.z}, sn[4] = {t0.y, t0.w, t1.y, t1.w};
#pragma unroll 3
        for (int ps = 0; ps < 3; ++ps) { const int hh = ps * 4 + (lane >> 4);
            if (hh < ATT_HQ + ATT_HKV) { const bool isq = hh < ATT_HQ; const int h = isq ? hh : hh - ATT_HQ;
                const bf16* src = Pr + (isq ? C_AQ : C_AKV) + h * 128 + ax * 64 + i0;
                const vu2 a = *(const vu2*)src, c = *(const vu2*)(src + 32);
                const float x1[4] = {bflo(a.x), bfhi(a.x), bflo(a.y), bfhi(a.y)}, x2[4] = {bflo(c.x), bfhi(c.x), bflo(c.y), bfhi(c.y)};
                float o1[4], o2[4]; const float sc = isq ? ATT_QSCALE : 1.0f;
#pragma unroll
                for (int e = 0; e < 4; ++e) { o1[e] = (x1[e] * cs[e] - x2[e] * sn[e]) * sc; o2[e] = (x2[e] * cs[e] + x1[e] * sn[e]) * sc; }
                bf16* dst = (isq ? p.AQb + (size_t)r * MIX_W : p.AKb + (size_t)r * (ATT_HKV * 128)) + h * 128 + ax * 64 + i0;
                vu2 w1; w1.x = cvtpk(o1[0], o1[1]); w1.y = cvtpk(o1[2], o1[3]); vu2 w2; w2.x = cvtpk(o2[0], o2[1]); w2.y = cvtpk(o2[2], o2[3]);
                *(vu2*)dst = w1; *(vu2*)(dst + 32) = w2; } } }
}
constexpr int PREP_RB = 17, PREP_QP = (3 * MIX_W) / 512, PREP_NPASS = PREP_QP + SSM_XBC / 512;
static_assert(MROWS % PREP_RB == 0 && (3 * MIX_W) % 512 == 0 && SSM_XBC % 512 == 0 && MIX_W % 512 == 0 && PREP_NPASS <= PREP_RB && 2 * PREP_NPASS >= PREP_RB, "prep tiling");
__device__ __forceinline__ void prep_row_scalars_wave(const Ptrs& p, int l, int r, int lane);
__device__ __forceinline__ void prep_conv_block_wave(const Ptrs& p, int l, int blk, int ps, int lane) {
    const int r0 = blk * PREP_RB; const bool isx = ps >= PREP_QP;
    const int col = (isx ? ps - PREP_QP : ps) * 512 + lane * 8, wld = isx ? SSM_XBC : 3 * MIX_W, grp = col >> 7;
    const float* w = (isx ? p.ssm_conv_w + (size_t)l * 3 * SSM_XBC : p.gdn_conv_w + (size_t)l * 3 * (3 * MIX_W)) + col;
    const vf4 w0a = *(const vf4*)w, w0b = *(const vf4*)(w + 4), w1a = *(const vf4*)(w + wld), w1b = *(const vf4*)(w + wld + 4), w2a = *(const vf4*)(w + 2 * wld), w2b = *(const vf4*)(w + 2 * wld + 4);
    const float w0[8] = {w0a.x, w0a.y, w0a.z, w0a.w, w0b.x, w0b.y, w0b.z, w0b.w}, w1[8] = {w1a.x, w1a.y, w1a.z, w1a.w, w1b.x, w1b.y, w1b.z, w1b.w}, w2[8] = {w2a.x, w2a.y, w2a.z, w2a.w, w2b.x, w2b.y, w2b.z, w2b.w};
    float bs[8] = {0.f, 0.f, 0.f, 0.f, 0.f, 0.f, 0.f, 0.f};
    if (isx) { const float* cb = p.ssm_conv_b + (size_t)l * SSM_XBC + col; const vf4 ba = *(const vf4*)cb, bb = *(const vf4*)(cb + 4); bs[0] = ba.x; bs[1] = ba.y; bs[2] = ba.z; bs[3] = ba.w; bs[4] = bb.x; bs[5] = bb.y; bs[6] = bb.z; bs[7] = bb.w; }
    const bf16* src = p.P + (size_t)r0 * NP_MAIN + (isx ? C_XBC : C_QKV) + col;
    vu4 rows[PREP_RB + 2];
#pragma unroll
    for (int j = 0; j < PREP_RB + 2; ++j) { const int r = r0 - 1 + j; rows[j] = (r >= 0 && r < MROWS) ? *(const vu4*)(src + ((ptrdiff_t)j - 1) * NP_MAIN) : (vu4){0u, 0u, 0u, 0u}; }
    prep_row_scalars_wave(p, l, r0 + ps, lane);
    if (ps + PREP_NPASS < PREP_RB) prep_row_scalars_wave(p, l, r0 + ps + PREP_NPASS, lane);
    float xp[8], xc[8], xn[8];
    unpack8(rows[0], xp); unpack8(rows[1], xc);
#pragma unroll
    for (int i = 0; i < PREP_RB; ++i) { const int r = r0 + i; int b, t, len; bool ic; row_info(r, b, t, len, ic); const bool hp = t > 0, hn = t < len - 1;
        unpack8(rows[i + 2], xn);
        float y[8];
#pragma unroll
        for (int e = 0; e < 8; ++e) { float v = w1[e] * xc[e] + bs[e]; if (hp) v += w0[e] * xp[e]; if (hn) v += w2[e] * xn[e]; y[e] = silu_fast(v); }
        if (isx) { const vu4 w8 = {cvtpk(y[0], y[1]), cvtpk(y[2], y[3]), cvtpk(y[4], y[5]), cvtpk(y[6], y[7])};
            if (col >= MIX_W) *(vu4*)(p.SBCb + (size_t)r * (2 * SSM_BC) + col - MIX_W) = w8; else *(vu4*)(p.SXb + (size_t)r * MIX_W + col) = w8; }
        else { float ss = 0.f;
#pragma unroll
            for (int e = 0; e < 8; ++e) ss += y[e] * y[e];
            ss = sum16(ss);
            float sc = 1.0f; if (grp < 2 * GDN_H) { sc = 1.0f / sqrtf(ss + EPS); if (grp < GDN_H) sc *= 0.08838834764831845f; }
            *(vu4*)(p.GQKVb + (size_t)r * (3 * MIX_W) + col) = (vu4){cvtpk(y[0] * sc, y[1] * sc), cvtpk(y[2] * sc, y[3] * sc), cvtpk(y[4] * sc, y[5] * sc), cvtpk(y[6] * sc, y[7] * sc)}; }
#pragma unroll
        for (int e = 0; e < 8; ++e) { xp[e] = xc[e]; xc[e] = xn[e]; } }
}
__device__ __forceinline__ void prep_row_scalars_wave(const Ptrs& p, int l, int r, int lane) {
    int b, t, len; bool ic; row_info(r, b, t, len, ic);
    const bf16* Pr = p.P + (size_t)r * NP_MAIN;
    if (lane < 2 * GDN_H) prep_gdn_gb_item(p, l, r, lane);
    if (lane < 2 * SSM_H) prep_ssd_dt_item(p, l, r, lane);
    { const int l16 = lane & 15, ax = l16 >> 3, i0 = (l16 & 7) * 4; const int pos = ic ? 0 : (ax ? t % GRID_W : t / GRID_W);
        const vf4 t0 = *(const vf4*)(p.ROPE + (size_t)(pos * 32 + i0) * 2), t1 = *(const vf4*)(p.ROPE + (size_t)(pos * 32 + i0) * 2 + 4);
        const float cs[4] = {t0.x, t0.z, t1.x, t1.z}, sn[4] = {t0.y, t0.w, t1.y, t1.w};
#pragma unroll 3
        for (int ps = 0; ps < 3; ++ps) { const int hh = ps * 4 + (lane >> 4);
            if (hh < ATT_HQ + ATT_HKV) { const bool isq = hh < ATT_HQ; const int h = isq ? hh : hh - ATT_HQ;
                const bf16* src = Pr + (isq ? C_AQ : C_AKV) + h * 128 + ax * 64 + i0;
                const vu2 a = *(const vu2*)src, c = *(const vu2*)(src + 32);
                const float x1[4] = {bflo(a.x), bfhi(a.x), bflo(a.y), bfhi(a.y)}, x2[4] = {bflo(c.x), bfhi(c.x), bflo(c.y), bfhi(c.y)};
                float o1[4], o2[4]; const float sc = isq ? ATT_QSCALE : 1.0f;
#pragma unroll
                for (int e = 0; e < 4; ++e) { o1[e] = (x1[e] * cs[e] - x2[e] * sn[e]) * sc; o2[e] = (x2[e] * cs[e] + x1[e] * sn[e]) * sc; }
                bf16* dst = (isq ? p.AQb + (size_t)r * MIX_W : p.AKb + (size_t)r * (ATT_HKV * 128)) + h * 128 + ax * 64 + i0;
                vu2 w1; w1.x = cvtpk(o1[0], o1[1]); w1.y = cvtpk(o1[2], o1[3]); vu2 w2; w2.x = cvtpk(o2[0], o2[1]); w2.y = cvtpk(o2[2], o2[3]);
                *(vu2*)dst = w1; *(vu2*)(dst + 32) = w2; } } }
}
__device__ __forceinline__ void mixout_row_wave(const Ptrs& p, int l, int r, int lane) {
    const int c0 = lane * 16;
    {
        float o[16]; float ss = 0.f;
#pragma unroll
        for (int q = 0; q < 2; ++q) { float a8[8], b8[8]; unpack8(__builtin_nontemporal_load((const vu4*)(p.OGb + (size_t)r * MIX_W + c0 + 8 * q)), a8); unpack8(__builtin_nontemporal_load((const vu4*)(p.OGb + ((size_t)MROWS + r) * MIX_W + c0 + 8 * q)), b8);
#pragma unroll
            for (int e = 0; e < 8; ++e) o[8 * q + e] = a8[e] + b8[e]; }
#pragma unroll
        for (int e = 0; e < 16; ++e) ss += o[e] * o[e];
        ss = sum8(ss);
        const float rs = 1.0f / sqrtf(ss * (1.0f / 128.0f) + EPS);
        float gt[16]; { float t8[8]; unpack8(*(const vu4*)(p.P + (size_t)r * NP_MAIN + C_GATE + c0), t8);
#pragma unroll
            for (int e = 0; e < 8; ++e) gt[e] = t8[e];
            unpack8(*(const vu4*)(p.P + (size_t)r * NP_MAIN + C_GATE + c0 + 8), t8);
#pragma unroll
            for (int e = 0; e < 8; ++e) gt[8 + e] = t8[e]; }
        const float* nw = p.gdn_norm + (size_t)l * 128 + (c0 & 127);
        unsigned w[8];
#pragma unroll
        for (int e = 0; e < 8; ++e) w[e] = cvtpk(o[2 * e] * rs * nw[2 * e] * silu_fast(gt[2 * e]), o[2 * e + 1] * rs * nw[2 * e + 1] * silu_fast(gt[2 * e + 1]));
        *(vu4*)(p.YA + (size_t)r * YLD + c0) = (vu4){w[0], w[1], w[2], w[3]}; *(vu4*)(p.YA + (size_t)r * YLD + c0 + 8) = (vu4){w[4], w[5], w[6], w[7]};
    }
    {
        float y[16]; float ss = 0.f; const float dsk = p.ssm_d[(size_t)l * SSM_H + c0 / SSM_P];
        float zt[16]; { float t8[8]; unpack8(*(const vu4*)(p.P + (size_t)r * NP_MAIN + C_Z + c0), t8);
#pragma unroll
            for (int e = 0; e < 8; ++e) zt[e] = t8[e];
            unpack8(*(const vu4*)(p.P + (size_t)r * NP_MAIN + C_Z + c0 + 8), t8);
#pragma unroll
            for (int e = 0; e < 8; ++e) zt[8 + e] = t8[e]; }
#pragma unroll
        for (int q = 0; q < 2; ++q) { float a8[8], c8[8], d8[8], x8[8]; unpack8(__builtin_nontemporal_load((const vu4*)(p.OSb + (size_t)r * MIX_W + c0 + 8 * q)), a8);
            unpack8(__builtin_nontemporal_load((const vu4*)(p.OSb2 + (size_t)r * MIX_W + c0 + 8 * q)), c8); unpack8(__builtin_nontemporal_load((const vu4*)(p.OSb2 + ((size_t)MROWS + r) * MIX_W + c0 + 8 * q)), d8); unpack8(*(const vu4*)(p.SXb + (size_t)r * MIX_W + c0 + 8 * q), x8);
#pragma unroll
            for (int e = 0; e < 8; ++e) y[8 * q + e] = a8[e] + (c8[e] + d8[e]) + dsk * x8[e]; }
#pragma unroll
        for (int e = 0; e < 16; ++e) { y[e] *= silu_fast(zt[e]); ss += y[e] * y[e]; }
        ss = sum16(ss); ss += __shfl_xor(ss, 16);
        const float rs = 1.0f / sqrtf(ss * (1.0f / (float)(MIX_W / SSM_G)) + EPS);
        const float* nw = p.ssm_norm + (size_t)l * MIX_W + c0;
        unsigned w[8];
#pragma unroll
        for (int e = 0; e < 8; ++e) w[e] = cvtpk(y[2 * e] * rs * nw[2 * e], y[2 * e + 1] * rs * nw[2 * e + 1]);
        *(vu4*)(p.YB + (size_t)r * YLD + c0) = (vu4){w[0], w[1], w[2], w[3]}; *(vu4*)(p.YB + (size_t)r * YLD + c0 + 8) = (vu4){w[4], w[5], w[6], w[7]};
    }
}
static_assert(MIX_W == 1024 && SSM_P == 64 && MIX_W / SSM_G == 512, "mixout_row_wave lane mapping assumes the real shapes");
__device__ __forceinline__ void act_vec_item(const Ptrs& p, int l, int r, int j) {
    int b, t, len; bool ic; row_info(r, b, t, len, ic);
    const bf16* ug = p.UG + (size_t)r * (2 * D_FF);
    float u[8], g[8], gp[8], gn[8];
    unpack8(*(const vu4*)(ug + j), u); unpack8(*(const vu4*)(ug + D_FF + j), g);
    const bool hp = t > 0, hn = t < len - 1;
    if (hp) unpack8(*(const vu4*)(ug - 2 * D_FF + D_FF + j), gp);
    if (hn) unpack8(*(const vu4*)(ug + 2 * D_FF + D_FF + j), gn);
    const float* w = p.ffn_conv_w + (size_t)l * 3 * D_FF + j; const float* cb = p.ffn_conv_b + (size_t)l * D_FF + j;
    unsigned o[4];
    float a[8];
#pragma unroll
    for (int e = 0; e < 8; ++e) { float v = w[D_FF + e] * g[e] + cb[e]; if (hp) v += w[e] * gp[e]; if (hn) v += w[2 * D_FF + e] * gn[e]; a[e] = silu_fast(v) * u[e]; }
#pragma unroll
    for (int e = 0; e < 4; ++e) o[e] = cvtpk(a[2 * e], a[2 * e + 1]);
    *(vu4*)(p.ACT + (size_t)r * D_FF + j) = (vu4){o[0], o[1], o[2], o[3]};
}

__device__ __forceinline__ void act_task(const Ptrs& p, int l, int task) {
    constexpr int NJ = D_FF / 8;
    const int rc = task / NJ, j = (task % NJ) * 8, r0 = rc * 16;
    int b, t, len; bool ic; row_info(r0, b, t, len, ic);
    const float* w = p.ffn_conv_w + (size_t)l * 3 * D_FF + j; const float* cb = p.ffn_conv_b + (size_t)l * D_FF + j;
    float w0[8], w1[8], w2[8], bs[8];
    { const vf4 a0 = *(const vf4*)w, a1 = *(const vf4*)(w + 4), b0 = *(const vf4*)(w + D_FF), b1 = *(const vf4*)(w + D_FF + 4), c0 = *(const vf4*)(w + 2 * D_FF), c1 = *(const vf4*)(w + 2 * D_FF + 4), d0 = *(const vf4*)cb, d1 = *(const vf4*)(cb + 4);
        const float t0[8] = {a0.x, a0.y, a0.z, a0.w, a1.x, a1.y, a1.z, a1.w}, t1[8] = {b0.x, b0.y, b0.z, b0.w, b1.x, b1.y, b1.z, b1.w}, t2[8] = {c0.x, c0.y, c0.z, c0.w, c1.x, c1.y, c1.z, c1.w}, t3[8] = {d0.x, d0.y, d0.z, d0.w, d1.x, d1.y, d1.z, d1.w};
#pragma unroll
        for (int e = 0; e < 8; ++e) { w0[e] = t0[e]; w1[e] = t1[e]; w2[e] = t2[e]; bs[e] = t3[e]; } }
    const bf16* base = p.UG + (size_t)r0 * (2 * D_FF) + j;
    vu4 gq[18], uq[16];
    const vu4 z4 = {0u, 0u, 0u, 0u};
    gq[0] = (t > 0) ? *(const vu4*)(base - 2 * D_FF + D_FF) : z4;
#pragma unroll
    for (int i = 0; i < 16; ++i) { gq[i + 1] = *(const vu4*)(base + (size_t)i * (2 * D_FF) + D_FF); uq[i] = *(const vu4*)(base + (size_t)i * (2 * D_FF)); }
    gq[17] = (t + 16 < len) ? *(const vu4*)(base + (size_t)16 * (2 * D_FF) + D_FF) : z4;
#pragma unroll
    for (int i = 0; i < 16; ++i) { float gp[8], gc[8], gn[8], u[8]; unpack8(gq[i], gp); unpack8(gq[i + 1], gc); unpack8(gq[i + 2], gn); unpack8(uq[i], u);
        float a[8];
#pragma unroll
        for (int e = 0; e < 8; ++e) a[e] = silu_fast(w0[e] * gp[e] + w1[e] * gc[e] + w2[e] * gn[e] + bs[e]) * u[e];
        *(vu4*)(p.ACT + (size_t)(r0 + i) * D_FF + j) = (vu4){cvtpk(a[0], a[1]), cvtpk(a[2], a[3]), cvtpk(a[4], a[5]), cvtpk(a[6], a[7])}; }
}
static_assert(SEQ % 16 == 0 && CTX_LEN % 16 == 0, "act_task row chunks must not straddle sequences");

__device__ __forceinline__ void act_fix_item(const Ptrs& p, int l, int bidx, int j) {
    const int row = (bidx >> 1) * 64 + ((bidx & 1) ? 63 : 0);
    int b, t, len; bool ic; row_info(row, b, t, len, ic);
    const size_t bi = (size_t)bidx * D_FF + j;
    vf4 pre = *(const vf4*)(p.BP + bi);
    const vu2 uw = *(const vu2*)(p.BU + bi);
    const bool hasn = (bidx & 1) ? (t < len - 1) : (t > 0);
    if (hasn) { const vu2 gw = *(const vu2*)(p.BG + (size_t)((bidx & 1) ? bidx + 1 : bidx - 1) * D_FF + j);
        const vf4 w = *(const vf4*)(p.ffn_conv_w + (size_t)l * 3 * D_FF + ((bidx & 1) ? 2 * D_FF : 0) + j);
        pre += w * (vf4){bflo(gw.x), bfhi(gw.x), bflo(gw.y), bfhi(gw.y)}; }
    const float u4[4] = {bflo(uw.x), bfhi(uw.x), bflo(uw.y), bfhi(uw.y)};
    *(vu2*)(p.ACT + (size_t)row * D_FF + j) = (vu2){cvtpk(silu_fast(pre.x) * u4[0], silu_fast(pre.y) * u4[1]), cvtpk(silu_fast(pre.z) * u4[2], silu_fast(pre.w) * u4[3])};
}

constexpr int AT_KSTR = 136, AT_VSTR = 68;
constexpr int AT_BUF = 64 * AT_KSTR + 128 * AT_VSTR;
constexpr int ATT_UNITS_LAT = BATCH * ATT_HKV * (SEQ / 64), ATT_UNITS_CTX = BATCH * ATT_HKV * (CTX_LEN / 64);
__device__ __forceinline__ void attn_unit(const Ptrs& p, int l, LAS bf16* L, int unit, int tid) {
    const int lane = tid & 63, wave = tid >> 6, r32 = lane & 31, h = lane >> 5;
    const bool cu = unit >= ATT_UNITS_LAT; const int uu = cu ? unit - ATT_UNITS_LAT : unit;
    const int nqb = cu ? CTX_LEN / 64 : SEQ / 64;
    const int b = uu / (ATT_HKV * nqb), kvh = (uu / nqb) % ATT_HKV, qb = uu % nqb, q0 = qb * 64;
    const int rowbase = (cu ? NLAT + b * CTX_LEN : b * SEQ) + q0;
    const int g = wave >> 1, qh = wave & 1, hq = kvh * ATT_GRP + g;
    const int qpos = q0 + 32 * qh + r32, qrow = rowbase + 32 * qh + r32;
    bf16x8_t qf[8];
#pragma unroll
    for (int s = 0; s < 8; ++s) qf[s] = *(const bf16x8_t*)(p.AQb + (size_t)qrow * MIX_W + hq * 128 + 16 * s + 8 * h);
    float m = p.attn_sink[(size_t)l * ATT_HQ + hq] * 1.4426950408889634f, lsum = h ? 0.f : 1.0f;
    f32x16_t o[4];
#pragma unroll
    for (int d = 0; d < 4; ++d)
#pragma unroll
        for (int e = 0; e < 16; ++e) o[d][e] = 0.f;
    const int jl0 = cu ? 5 : (q0 - 128 < 0 ? (128 - q0) / 64 : 0), jl1 = cu ? 5 : ((q0 + 192 > SEQ) ? 5 - (q0 + 192 - SEQ) / 64 : 5);
    const int nt = (jl1 - jl0) + CTX_LEN / 64;
    vu4 rk[2], rv[2];
    auto tile_row0 = [&](int ti, int& kpos0) -> int { const int j = jl0 + ti; if (j < jl1) { kpos0 = q0 - 128 + 64 * j; return b * SEQ + kpos0; } kpos0 = -1000000; return NLAT + b * CTX_LEN + 64 * (j - jl1); };
    auto gload = [&](int ti) { int kp; const int kr0 = tile_row0(ti, kp);
#pragma unroll
        for (int it = 0; it < 2; ++it) { const int c = tid + 512 * it;
            rk[it] = *(const vu4*)(p.AKb + (size_t)(kr0 + (c >> 4)) * (ATT_HKV * 128) + kvh * 128 + (c & 15) * 8);
            const int vk = (c & 15) | (((c >> 6) & 3) << 4), vd = ((c >> 4) & 3) | ((c >> 8) << 2);
            rv[it] = *(const vu4*)(p.P + (size_t)(kr0 + vk) * NP_MAIN + C_AKV + ATT_HKV * 128 + kvh * 128 + vd * 8); } };
    auto lstore = [&](LAS bf16* B) {
#pragma unroll
        for (int it = 0; it < 2; ++it) { const int c = tid + 512 * it;
            *(LAS vu4*)(B + (c >> 4) * AT_KSTR + (c & 15) * 8) = rk[it];
            const int vk = (c & 15) | (((c >> 6) & 3) << 4), vd = ((c >> 4) & 3) | ((c >> 8) << 2);
            LAS bf16* vt = B + 64 * AT_KSTR + (vd * 8) * AT_VSTR + vk;
            const unsigned w4[4] = {rv[it].x, rv[it].y, rv[it].z, rv[it].w};
#pragma unroll
            for (int e = 0; e < 4; ++e) { vt[(2 * e) * AT_VSTR] = (bf16)(w4[e] & 0xffffu); vt[(2 * e + 1) * AT_VSTR] = (bf16)(w4[e] >> 16); } } };
    gload(0); lstore(L); LDS_BARRIER();
    for (int ti = 0; ti < nt; ++ti) {
        LAS bf16* B = L + (ti & 1) * AT_BUF;
        int kpos0; (void)tile_row0(ti, kpos0);
        if (ti + 1 < nt) gload(ti + 1);
        f32x16_t st[2];
#pragma unroll
        for (int sub = 0; sub < 2; ++sub) {
#pragma unroll
            for (int e = 0; e < 16; ++e) st[sub][e] = 0.f;
            bf16x8_t kf[8];
#pragma unroll
            for (int s = 0; s < 8; ++s) kf[s] = *(const LAS bf16x8_t*)(B + (32 * sub + r32) * AT_KSTR + 16 * s + 8 * h);
            __builtin_amdgcn_s_setprio(1);
#pragma unroll
            for (int s = 0; s < 8; ++s) st[sub] = __builtin_amdgcn_mfma_f32_32x32x16_bf16(kf[s], qf[s], st[sub], 0, 0, 0);
            __builtin_amdgcn_s_setprio(0); }
        float mx = -1e30f;
#pragma unroll
        for (int sub = 0; sub < 2; ++sub)
#pragma unroll
            for (int e = 0; e < 16; ++e) { const int key = 32 * sub + (e & 3) + 8 * (e >> 2) + 4 * h; const int dlt = kpos0 + key - qpos;
                if (kpos0 > -500000 && (dlt > WINDOW || dlt < -WINDOW)) st[sub][e] = -1e30f;
                mx = fmaxf(mx, st[sub][e]); }
        mx = fmaxf(mx, __shfl_xor(mx, 32));
        const float mn = fmaxf(m, mx), alpha = __builtin_amdgcn_exp2f(m - mn); m = mn;
        float ps = 0.f;
#pragma unroll
        for (int sub = 0; sub < 2; ++sub)
#pragma unroll
            for (int e = 0; e < 16; ++e) { const float pe = __builtin_amdgcn_exp2f(st[sub][e] - mn); st[sub][e] = pe; ps += pe; }
        lsum = lsum * alpha + ps;
        if (!__all(alpha == 1.0f)) {
#pragma unroll
            for (int d = 0; d < 4; ++d)
#pragma unroll
                for (int e = 0; e < 16; ++e) o[d][e] *= alpha; }
#pragma unroll
        for (int kk = 0; kk < 4; ++kk) { const int sub = kk >> 1, s8 = (kk & 1) * 8;
            vu4 pw; pw.x = cvtpk(st[sub][s8], st[sub][s8 + 1]); pw.y = cvtpk(st[sub][s8 + 2], st[sub][s8 + 3]); pw.z = cvtpk(st[sub][s8 + 4], st[sub][s8 + 5]); pw.w = cvtpk(st[sub][s8 + 6], st[sub][s8 + 7]);
            const bf16x8_t pf = __builtin_bit_cast(bf16x8_t, pw);
            bf16x8_t vf[4];
#pragma unroll
            for (int d = 0; d < 4; ++d) { const LAS bf16* vp = B + 64 * AT_KSTR + (32 * d + r32) * AT_VSTR + 16 * kk + 4 * h;
                const vu2 lo = *(const LAS vu2*)vp, hi = *(const LAS vu2*)(vp + 8);
                vf[d] = __builtin_bit_cast(bf16x8_t, (vu4){lo.x, lo.y, hi.x, hi.y}); }
            __builtin_amdgcn_s_setprio(1);
#pragma unroll
            for (int d = 0; d < 4; ++d) o[d] = __builtin_amdgcn_mfma_f32_32x32x16_bf16(vf[d], pf, o[d], 0, 0, 0);
            __builtin_amdgcn_s_setprio(0); }
        if (ti + 1 < nt) lstore(L + ((ti + 1) & 1) * AT_BUF);
        LDS_BARRIER();
    }
    lsum += __shfl_xor(lsum, 32);
    const float inv = 1.0f / lsum;
    LAS bf16* os = L + wave * (32 * AT_KSTR);
#pragma unroll
    for (int d = 0; d < 4; ++d)
#pragma unroll
        for (int a4 = 0; a4 < 4; ++a4) { vu2 w; w.x = cvtpk(o[d][4 * a4] * inv, o[d][4 * a4 + 1] * inv); w.y = cvtpk(o[d][4 * a4 + 2] * inv, o[d][4 * a4 + 3] * inv);
            *(LAS vu2*)(os + r32 * AT_KSTR + 32 * d + 8 * a4 + 4 * h) = w; }
    LDS_BARRIER();
#pragma unroll
    for (int i = 0; i < 8; ++i) { const int c = lane + 64 * i, row = c >> 4, ch = c & 15;
        *(vu4*)(p.YC + (size_t)(rowbase + 32 * qh + row) * YLD + hq * 128 + ch * 8) = *(const LAS vu4*)(os + row * AT_KSTR + ch * 8); }
    LDS_BARRIER();
}
static_assert(2 * AT_BUF * 2 <= 131072 && 8 * 32 * AT_KSTR <= 2 * AT_BUF, "attention LDS map");

constexpr int NCH = CHAIN_LEN / 64, NCH_CTX = CTX_LEN / 64;
constexpr int GDN_NU = BATCH * NCH * GDN_H * 2;
constexpr int GC_KS = 136, GC_FS = 65, GC_LS = 68, GC_TS = 72;
__device__ __forceinline__ int gdn_unit_index(int b, int c, int h, int dir) { return ((b * NCH + c) * GDN_H + h) * 2 + dir; }
__device__ __forceinline__ int chunk_row0(int b, int c) { return c < NCH_CTX ? NLAT + b * CTX_LEN + 64 * c : b * SEQ + 64 * (c - NCH_CTX); }
template <int NK> __device__ __forceinline__ f32x16_t mma_lds(f32x16_t acc, const LAS bf16* A, int lda, const LAS bf16* Bt, int ldb, int r32, int hh) {
    bf16x8_t a[NK], bb[NK];
#pragma unroll
    for (int s = 0; s < NK; ++s) { a[s] = *(const LAS bf16x8_t*)(A + r32 * lda + 16 * s + 8 * hh); bb[s] = *(const LAS bf16x8_t*)(Bt + r32 * ldb + 16 * s + 8 * hh); }
    f32x16_t acc2;
#pragma unroll
    for (int e = 0; e < 16; ++e) acc2[e] = 0.f;
#pragma unroll
    for (int s = 0; s < NK; s += 2) { acc = __builtin_amdgcn_mfma_f32_32x32x16_bf16(a[s], bb[s], acc, 0, 0, 0); acc2 = __builtin_amdgcn_mfma_f32_32x32x16_bf16(a[s + 1], bb[s + 1], acc2, 0, 0, 0); }
#pragma unroll
    for (int e = 0; e < 16; ++e) acc[e] += acc2[e];
    return acc;
}
__device__ __forceinline__ f32x16_t zero16() { f32x16_t z;
#pragma unroll
    for (int e = 0; e < 16; ++e) z[e] = 0.f;
    return z; }
__device__ __forceinline__ void tri_solve_wave(const LAS float* Lm, LAS bf16* Tm, LAS bf16* scr, int lane) {
    const int blk = lane >> 5, c = lane & 31, r32 = c, hh = blk;
    LAS bf16* B00 = scr; LAS bf16* XT = scr + 32 * 40;
    float t[32];
    vf4 lb[3][8];
#define TRI_LDROW(i_) do { _Pragma("unroll") for (int j4 = 0; j4 < ((i_) + 3) / 4; ++j4) lb[(i_) % 3][j4] = *(const LAS vf4*)(Lm + (32 * blk + (i_)) * GC_LS + 32 * blk + 4 * j4); } while (0)
    TRI_LDROW(1);
#pragma unroll
    for (int i = 0; i < 32; ++i) {
        if (i + 2 < 32) TRI_LDROW(i + 2);
        float s = (i == c) ? 1.0f : 0.0f;
#pragma unroll
        for (int j4 = 0; j4 < (i + 3) / 4; ++j4) { const vf4 lv = lb[i % 3][j4];
            if (4 * j4 + 0 < i) s -= lv.x * t[4 * j4 + 0];
            if (4 * j4 + 1 < i) s -= lv.y * t[4 * j4 + 1];
            if (4 * j4 + 2 < i) s -= lv.z * t[4 * j4 + 2];
            if (4 * j4 + 3 < i) s -= lv.w * t[4 * j4 + 3]; }
        t[i] = s;
        asm volatile("" : "+v"(t[i]));
    }
#undef TRI_LDROW
#pragma unroll
    for (int i = 0; i < 32; ++i) { Tm[(32 * blk + i) * GC_TS + 32 * blk + c] = f2bf(t[i]); if (blk == 0) Tm[i * GC_TS + 32 + c] = (bf16)0; }
    if (blk == 0) {
#pragma unroll
        for (int q = 0; q < 4; ++q) *(LAS vu4*)(B00 + c * 40 + 8 * q) = (vu4){cvtpk(t[8 * q], t[8 * q + 1]), cvtpk(t[8 * q + 2], t[8 * q + 3]), cvtpk(t[8 * q + 4], t[8 * q + 5]), cvtpk(t[8 * q + 6], t[8 * q + 7])}; }
    f32x16_t x = zero16();
#pragma unroll
    for (int s = 0; s < 2; ++s) { const LAS float* lp = Lm + (32 + r32) * GC_LS + 16 * s + 8 * hh; const vf4 l0 = *(const LAS vf4*)lp, l1 = *(const LAS vf4*)(lp + 4);
        const bf16x8_t a = __builtin_bit_cast(bf16x8_t, (vu4){cvtpk(l0.x, l0.y), cvtpk(l0.z, l0.w), cvtpk(l1.x, l1.y), cvtpk(l1.z, l1.w)});
        const bf16x8_t bb = *(const LAS bf16x8_t*)(B00 + r32 * 40 + 16 * s + 8 * hh);
        x = __builtin_amdgcn_mfma_f32_32x32x16_bf16(a, bb, x, 0, 0, 0); }
#pragma unroll
    for (int a4 = 0; a4 < 4; ++a4) *(LAS vu2*)(XT + r32 * 40 + 8 * a4 + 4 * hh) = (vu2){cvtpk(x[4 * a4], x[4 * a4 + 1]), cvtpk(x[4 * a4 + 2], x[4 * a4 + 3])};
    f32x16_t y = zero16();
#pragma unroll
    for (int s = 0; s < 2; ++s) { const bf16x8_t a = *(const LAS bf16x8_t*)(Tm + (32 + r32) * GC_TS + 32 + 16 * s + 8 * hh), bb = *(const LAS bf16x8_t*)(XT + r32 * 40 + 16 * s + 8 * hh);
        y = __builtin_amdgcn_mfma_f32_32x32x16_bf16(a, bb, y, 0, 0, 0); }
#pragma unroll
    for (int e = 0; e < 16; ++e) Tm[(32 + (e & 3) + 8 * (e >> 2) + 4 * hh) * GC_TS + r32] = f2bf(-y[e]);
}
constexpr int G1_KK = 0, G1_QK = G1_KK + 64 * GC_FS * 4, G1_L = G1_QK + 64 * GC_FS * 4, G1_T = G1_L + 2 * 64 * GC_LS * 4,
              G1_KB = G1_T + 2 * 64 * GC_TS * 2, G1_VB = G1_KB + 128 * GC_TS * 2, G1_SM = G1_VB + 128 * GC_TS * 2, G1_END = G1_SM + 10 * 64 * 4;
__device__ __forceinline__ void st_vu2(LAS bf16* q, vu2 v) { *(LAS vu2*)q = v; }
__device__ __forceinline__ void st_vu2(bf16* q, vu2 v) { *(vu2*)q = v; }
__device__ __forceinline__ void gdn_g1_unit(const Ptrs& p, LAS unsigned char* lds, int unit, int tid) {
    const int lane = tid & 63, wave = tid >> 6, r32 = lane & 31, hh = lane >> 5;
    const int b = unit / (NCH * GDN_H), c = (unit / GDN_H) % NCH, h = unit % GDN_H;
    const int r0 = chunk_row0(b, c);
    LAS float* KKs = (LAS float*)(lds + G1_KK); LAS float* QKs = (LAS float*)(lds + G1_QK);
    LAS float* Lm = (LAS float*)(lds + G1_L); LAS bf16* Tm = (LAS bf16*)(lds + G1_T); LAS bf16* KbT = (LAS bf16*)(lds + G1_KB); LAS bf16* VbT = (LAS bf16*)(lds + G1_VB);
    LAS float* gc = (LAS float*)(lds + G1_SM); LAS float* be = gc + 128; LAS float* eg = gc + 256; LAS float* beg = gc + 384; LAS float* egl = gc + 512;
    const bf16* Qg = p.GQKVb + (size_t)r0 * (3 * MIX_W) + h * 128;
    const int prod = wave >> 2, mt = (wave >> 1) & 1, nt = wave & 1;
    bf16x8_t fa[8], fb[8], ft[4];
    { const bf16* Ap = Qg + (size_t)(32 * mt + r32) * (3 * MIX_W) + (prod ? 0 : MIX_W) + 8 * hh;
      const bf16* Bp = Qg + (size_t)(32 * nt + r32) * (3 * MIX_W) + MIX_W + 8 * hh;
      const bf16* Tp = Qg + (size_t)(32 * mt + r32) * (3 * MIX_W) + (prod ? 2 * MIX_W : MIX_W) + 64 * nt + 8 * hh;
#pragma unroll
      for (int s = 0; s < 8; ++s) { fa[s] = *(const bf16x8_t*)(Ap + 16 * s); fb[s] = *(const bf16x8_t*)(Bp + 16 * s); }
#pragma unroll
      for (int s = 0; s < 4; ++s) ft[s] = *(const bf16x8_t*)(Tp + 16 * s); }
    if (wave < 2) { const int dir = wave, n = dir ? 63 - lane : lane; const size_t gi = (size_t)(r0 + n) * 2 * GDN_H + dir * GDN_H + h;
        float x = p.GG[gi]; const float bt = p.GB[gi];
#pragma unroll
        for (int o = 1; o < 64; o <<= 1) { const float y = __shfl_up(x, o); if (lane >= o) x += y; }
        const float x63 = __shfl(x, 63), ex = __expf(x);
        gc[dir * 64 + lane] = x; be[dir * 64 + lane] = bt; eg[dir * 64 + lane] = ex; beg[dir * 64 + lane] = bt * ex; egl[dir * 64 + lane] = __expf(x63 - x); }
    f32x16_t tt[2];
    { f32x16_t acc = zero16(), acc2 = zero16();
#pragma unroll
      for (int s = 0; s < 8; s += 2) { acc = __builtin_amdgcn_mfma_f32_32x32x16_bf16(fa[s], fb[s], acc, 0, 0, 0); acc2 = __builtin_amdgcn_mfma_f32_32x32x16_bf16(fa[s + 1], fb[s + 1], acc2, 0, 0, 0); }
      LAS float* dst = prod ? QKs : KKs;
#pragma unroll
      for (int e = 0; e < 16; ++e) dst[(32 * mt + (e & 3) + 8 * (e >> 2) + 4 * hh) * GC_FS + 32 * nt + r32] = acc[e] + acc2[e];
      bf16x8_t id[2];
#pragma unroll
      for (int s = 0; s < 2; ++s) { unsigned w[4];
#pragma unroll
          for (int e2 = 0; e2 < 4; ++e2) { const int k0 = 16 * s + 8 * hh + 2 * e2; w[e2] = (k0 == r32 ? 0x3F80u : 0u) | (k0 + 1 == r32 ? 0x3F800000u : 0u); }
          id[s] = __builtin_bit_cast(bf16x8_t, (vu4){w[0], w[1], w[2], w[3]}); }
#pragma unroll
      for (int j = 0; j < 2; ++j) { tt[j] = zero16();
          tt[j] = __builtin_amdgcn_mfma_f32_32x32x16_bf16(ft[2 * j], id[0], tt[j], 0, 0, 0); tt[j] = __builtin_amdgcn_mfma_f32_32x32x16_bf16(ft[2 * j + 1], id[1], tt[j], 0, 0, 0); } }
    LDS_BARRIER();
    auto put_T = [&](int dir, const LAS float* tab, auto dstf) {
#pragma unroll
        for (int j = 0; j < 2; ++j) {
#pragma unroll
            for (int a4 = 0; a4 < 4; ++a4) { const int n0 = 32 * mt + 8 * a4 + 4 * hh;
                if (dir == 0) { const vf4 sc = *(const LAS vf4*)(tab + n0);
                    st_vu2(dstf(j, n0), (vu2){cvtpk(tt[j][4 * a4] * sc.x, tt[j][4 * a4 + 1] * sc.y), cvtpk(tt[j][4 * a4 + 2] * sc.z, tt[j][4 * a4 + 3] * sc.w)}); }
                else { const int i0 = 60 - n0; const vf4 sc = *(const LAS vf4*)(tab + 64 + i0);
                    st_vu2(dstf(j, i0), (vu2){cvtpk(tt[j][4 * a4 + 3] * sc.x, tt[j][4 * a4 + 2] * sc.y), cvtpk(tt[j][4 * a4 + 1] * sc.z, tt[j][4 * a4] * sc.w)}); } } } };
    auto lds_T = [&](LAS bf16* img) { return [=](int j, int i0) { return img + (64 * nt + 32 * j + r32) * GC_TS + i0; }; };
    auto kdt_T = [&](int dir) { bf16* base = p.GKdT + (size_t)gdn_unit_index(b, c, h, dir) * 128 * 64; return [=](int j, int i0) { return base + (((2 * nt + j) * 4 + (i0 >> 4)) * 64 + ((i0 >> 3) & 1) * 32 + r32) * 8 + (i0 & 7); }; };
    if (prod == 0) { put_T(0, egl, kdt_T(0)); put_T(1, egl, kdt_T(1)); put_T(0, beg, lds_T(KbT)); }
    else {
        const int dir = nt, n = 32 * mt + r32, i = dir ? 63 - n : n; const float sc = eg[dir * 64 + i];
        bf16* base = p.GQd + (size_t)gdn_unit_index(b, c, h, dir) * 64 * 128 + ((size_t)((i >> 5) * 8) * 64 + hh * 32 + (i & 31)) * 8;
#pragma unroll
        for (int q = 0; q < 8; ++q) { float q8[8]; unpack8(__builtin_bit_cast(vu4, fa[q]), q8);
            *(vu4*)(base + q * 512) = (vu4){cvtpk(q8[0] * sc, q8[1] * sc), cvtpk(q8[2] * sc, q8[3] * sc), cvtpk(q8[4] * sc, q8[5] * sc), cvtpk(q8[6] * sc, q8[7] * sc)}; }
        put_T(0, be, lds_T(VbT)); }
#pragma unroll
    for (int it = 0; it < 2; ++it) { const int item = it * 512 + tid, dir = item >> 9, j0 = ((item >> 6) & 7) * 8, i = item & 63, ni = dir ? 63 - i : i;
        float o[8] = {0.f, 0.f, 0.f, 0.f, 0.f, 0.f, 0.f, 0.f};
        if (j0 < i) { const float gi = gc[dir * 64 + i], bi = be[dir * 64 + i]; const vf4 ga = *(const LAS vf4*)(gc + dir * 64 + j0), gb = *(const LAS vf4*)(gc + dir * 64 + j0 + 4);
            const float gj[8] = {ga.x, ga.y, ga.z, ga.w, gb.x, gb.y, gb.z, gb.w};
#pragma unroll
            for (int q = 0; q < 8; ++q) { const int j = j0 + q, nj = dir ? 63 - j : j; o[q] = (i > j) ? bi * KKs[ni * GC_FS + nj] * __expf(gi - gj[q]) : 0.0f; } }
        LAS float* dst = Lm + dir * 64 * GC_LS + i * GC_LS + j0;
        *(LAS vf4*)dst = (vf4){o[0], o[1], o[2], o[3]}; *(LAS vf4*)(dst + 4) = (vf4){o[4], o[5], o[6], o[7]}; }
    LDS_BARRIER();
    if (wave < 2) { __builtin_amdgcn_s_setprio(3); tri_solve_wave(Lm + wave * 64 * GC_LS, Tm + wave * 64 * GC_TS, (LAS bf16*)KKs + wave * 2 * 32 * 40, lane); __builtin_amdgcn_s_setprio(0); }
    else if ((wave & 3) >= 2) { const int t6 = ((wave & 1) | ((wave >> 2) << 1)) * 64 + lane;
        for (int it = t6; it < 2 * 64 * 8; it += 256) { const int dir = it >> 9, j8 = (it >> 6) & 7, i = it & 63, ni = dir ? 63 - i : i; unsigned w[4];
#pragma unroll
            for (int e2 = 0; e2 < 4; ++e2) { float a[2];
#pragma unroll
                for (int q = 0; q < 2; ++q) { const int j = j8 * 8 + 2 * e2 + q; a[q] = (i >= j) ? QKs[ni * GC_FS + (dir ? 63 - j : j)] * __expf(gc[dir * 64 + i] - gc[dir * 64 + j]) : 0.0f; }
                w[e2] = cvtpk(a[0], a[1]); }
            *(vu4*)(p.GA + (size_t)gdn_unit_index(b, c, h, dir) * 64 * 64 + (((i >> 5) * 4 + (j8 >> 1)) * 64 + (j8 & 1) * 32 + (i & 31)) * 8) = (vu4){w[0], w[1], w[2], w[3]}; }
        if (t6 < 2) p.GGL[gdn_unit_index(b, c, h, t6)] = eg[t6 * 64 + 63]; }
    LDS_BARRIER();
    LAS bf16* KbT1 = (LAS bf16*)(lds + G1_KK); LAS bf16* VbT1 = KbT1 + 128 * GC_TS;
    if (prod == 0) put_T(1, beg, lds_T(KbT1)); else put_T(1, be, lds_T(VbT1));
    LDS_BARRIER();
#pragma unroll
    for (int dir = 0; dir < 2; ++dir) {
        const int u = gdn_unit_index(b, c, h, dir); const LAS bf16* Td = Tm + dir * 64 * GC_TS; const LAS bf16* Kd = dir ? KbT1 : KbT; const LAS bf16* Vd = dir ? VbT1 : VbT;
        { const int dt = wave >> 1, it2 = wave & 1; f32x16_t acc = zero16(); acc = mma_lds<4>(acc, Kd + 32 * dt * GC_TS, GC_TS, Td + 32 * it2 * GC_TS, GC_TS, r32, hh);
            bf16* dst = p.GW + (size_t)u * 64 * 128 + ((it2 * 8 + 2 * dt) * 64 + r32) * 8 + 4 * hh;
#pragma unroll
            for (int a4 = 0; a4 < 4; ++a4) *(vu2*)(dst + (a4 >> 1) * 512 + (a4 & 1) * 256) = (vu2){cvtpk(acc[4 * a4], acc[4 * a4 + 1]), cvtpk(acc[4 * a4 + 2], acc[4 * a4 + 3])}; }
        { const int it2 = wave >> 2, dt = wave & 3; f32x16_t acc = zero16(); acc = mma_lds<4>(acc, Td + 32 * it2 * GC_TS, GC_TS, Vd + 32 * dt * GC_TS, GC_TS, r32, hh);
            bf16* dst = p.GUT + (size_t)u * 128 * 64 + ((size_t)((dt * 2 + it2) * 4) * 64 + lane) * 4;
#pragma unroll
            for (int a4 = 0; a4 < 4; ++a4) *(vu2*)(dst + a4 * 256) = (vu2){cvtpk(acc[4 * a4], acc[4 * a4 + 1]), cvtpk(acc[4 * a4 + 2], acc[4 * a4 + 3])}; }
    }
    LDS_BARRIER();
}

template <class F> __device__ __forceinline__ void store_tile_rows(const f32x16_t& a, LAS bf16* T, int lane, F rowptr) {
    const int r32 = lane & 31, hh = lane >> 5;
#pragma unroll
    for (int e = 0; e < 16; ++e) T[((e & 3) + 8 * (e >> 2) + 4 * hh) * 40 + r32] = f2bf(a[e]);
    const int il = lane >> 1, half = lane & 1;
    const vu4 w0 = *(const LAS vu4*)(T + il * 40 + half * 16), w1 = *(const LAS vu4*)(T + il * 40 + half * 16 + 8);
    bf16* dst = rowptr(il) + half * 16;
    *(vu4*)dst = w0; *(vu4*)(dst + 8) = w1;
}
__device__ __forceinline__ void gdn_scan_wg(const Ptrs& p, LAS unsigned char* lds, int chain, int slice, int tid) {
    const int b = chain / (GDN_H * 2), h = (chain >> 1) % GDN_H, dir = chain & 1;
    const int lane = tid & 63, wave = tid >> 6, r32 = lane & 31, hh = lane >> 5;
    LAS bf16* SbT = (LAS bf16*)lds;
    LAS bf16* vnT = SbT + 4 * 32 * GC_KS;
    LAS bf16* otile = vnT + 3 * 32 * GC_TS + (wave & 1) * 32 * 40;
    for (int i = tid; i < 32 * GC_KS / 2; i += 512) ((LAS unsigned*)SbT)[i] = 0u;
    LDS_BARRIER();
    auto chunk_of = [&](int s) { return s < NCH_CTX ? (dir ? NCH_CTX - 1 - s : s) : NCH_CTX + (dir ? NCH - NCH_CTX - 1 - (s - NCH_CTX) : s - NCH_CTX); };
    auto unit_of = [&](int s) { return (size_t)gdn_unit_index(b, chunk_of(s), h, dir); };
    using I0 = std::integral_constant<int, 0>; using I1 = std::integral_constant<int, 1>; using I2 = std::integral_constant<int, 2>; using I3 = std::integral_constant<int, 3>;
    if (wave < 2) {
        __builtin_amdgcn_s_setprio(3);
        int tr = tid; asm volatile("" : "+v"(tr)); const int ln = tr & 63, t = (tr >> 6) & 1;
        bf16x8_t fa[4][8]; vu2 ut[4][4];
        auto prefetch = [&](int s, auto KC2) { constexpr int k = decltype(KC2)::value; const size_t u = unit_of(s);
            const bf16* wp = p.GW + u * 64 * 128 + (size_t)(t * 512 + ln) * 8; const bf16* up = p.GUT + u * 128 * 64 + (size_t)((slice * 2 + t) * 256 + ln) * 4;
#pragma unroll
            for (int q = 0; q < 8; ++q) fa[k][q] = *(const bf16x8_t*)(wp + q * 512);
#pragma unroll
            for (int a4 = 0; a4 < 4; ++a4) ut[k][a4] = *(const vu2*)(up + a4 * 256); };
        auto step = [&](int s, auto KC) { constexpr int k = decltype(KC)::value;
            if (s + 3 < NCH) prefetch(s + 3, std::integral_constant<int, (k + 3) % 4>{});
            const LAS bf16* Sc = SbT + (s & 3) * 32 * GC_KS; LAS bf16* vn = vnT + (s % 3) * 32 * GC_TS;
            f32x16_t acc = zero16(), acc2 = zero16();
#pragma unroll
            for (int qh = 0; qh < 2; ++qh) { bf16x8_t bq[4];
#pragma unroll
                for (int q = 0; q < 4; ++q) bq[q] = *(const LAS bf16x8_t*)(Sc + r32 * GC_KS + 16 * (4 * qh + q) + 8 * hh);
#pragma unroll
                for (int q = 0; q < 4; q += 2) { acc = __builtin_amdgcn_mfma_f32_32x32x16_bf16(fa[k][4 * qh + q], bq[q], acc, 0, 0, 0); acc2 = __builtin_amdgcn_mfma_f32_32x32x16_bf16(fa[k][4 * qh + q + 1], bq[q + 1], acc2, 0, 0, 0); } }
#pragma unroll
            for (int a4 = 0; a4 < 4; ++a4) { const vu2 uw = ut[k][a4];
                *(LAS vu2*)(vn + r32 * GC_TS + 32 * t + 8 * a4 + 4 * hh) = (vu2){cvtpk(bflo(uw.x) - (acc[4 * a4] + acc2[4 * a4]), bfhi(uw.x) - (acc[4 * a4 + 1] + acc2[4 * a4 + 1])), cvtpk(bflo(uw.y) - (acc[4 * a4 + 2] + acc2[4 * a4 + 2]), bfhi(uw.y) - (acc[4 * a4 + 3] + acc2[4 * a4 + 3]))}; }
            LDS_BARRIER(); LDS_BARRIER(); };
        prefetch(0, I0{}); prefetch(1, I1{}); prefetch(2, I2{});
        for (int s = 0; s < NCH; s += 4) { step(s, I0{}); step(s + 1, I1{}); step(s + 2, I2{}); step(s + 3, I3{}); }
        __builtin_amdgcn_s_setprio(0);
    } else if (wave >= 4) {
        __builtin_amdgcn_s_setprio(3);
        int tr = tid; asm volatile("" : "+v"(tr)); const int ln = tr & 63, rr = (tr >> 6) & 3;
        int zl = 0; asm volatile("v_mov_b32 %0, 0" : "=v"(zl));
        bf16x8_t fb[8][4]; float gl[8] = {0.f, 0.f, 0.f, 0.f, 0.f, 0.f, 0.f, 0.f}; f32x16_t S = zero16();
        auto prefetch = [&](int s, auto KC2) { constexpr int k = decltype(KC2)::value; const size_t u = unit_of(s);
            const bf16* kp = p.GKdT + u * 128 * 64 + (size_t)(rr * 256 + ln) * 8;
#pragma unroll
            for (int q = 0; q < 4; ++q) fb[k][q] = *(const bf16x8_t*)(kp + q * 512);
            gl[k] = p.GGL[u + zl]; };
        auto step = [&](int s, auto KC) { constexpr int k = decltype(KC)::value;
            if (s + 7 < NCH) prefetch(s + 7, std::integral_constant<int, (k + 7) % 8>{});
            const LAS bf16* vn = vnT + (s % 3) * 32 * GC_TS; LAS bf16* Sn = SbT + ((s + 1) & 3) * 32 * GC_KS;
            const float g1 = gl[k];
#pragma unroll
            for (int e = 0; e < 16; ++e) S[e] *= g1;
            LDS_BARRIER();
            bf16x8_t bq[4];
#pragma unroll
            for (int q = 0; q < 4; ++q) bq[q] = *(const LAS bf16x8_t*)(vn + r32 * GC_TS + 16 * q + 8 * hh);
#pragma unroll
            for (int q = 0; q < 4; ++q) S = __builtin_amdgcn_mfma_f32_32x32x16_bf16(fb[k][q], bq[q], S, 0, 0, 0);
#pragma unroll
            for (int a4 = 0; a4 < 4; ++a4) *(LAS vu2*)(Sn + r32 * GC_KS + 32 * rr + 8 * a4 + 4 * hh) = (vu2){cvtpk(S[4 * a4], S[4 * a4 + 1]), cvtpk(S[4 * a4 + 2], S[4 * a4 + 3])};
            LDS_BARRIER(); };
        using I4 = std::integral_constant<int, 4>; using I5 = std::integral_constant<int, 5>; using I6 = std::integral_constant<int, 6>; using I7 = std::integral_constant<int, 7>;
        prefetch(0, I0{}); prefetch(1, I1{}); prefetch(2, I2{}); prefetch(3, I3{}); prefetch(4, I4{}); prefetch(5, I5{}); prefetch(6, I6{});
        for (int s = 0; s + 7 < NCH; s += 8) { step(s, I0{}); step(s + 1, I1{}); step(s + 2, I2{}); step(s + 3, I3{}); step(s + 4, I4{}); step(s + 5, I5{}); step(s + 6, I6{}); step(s + 7, I7{}); }
        step(NCH - 4, I0{}); step(NCH - 3, I1{}); step(NCH - 2, I2{}); step(NCH - 1, I3{});
        __builtin_amdgcn_s_setprio(0);
    } else {
        int tr = tid; asm volatile("" : "+v"(tr)); const int ln = tr & 63, t = (tr >> 6) & 1;
        bf16x8_t fa[3][8], fb[3][4];
        auto prefetch = [&](int s, auto KC2) { constexpr int k = decltype(KC2)::value; const size_t u = unit_of(s);
            const bf16* qp = p.GQd + u * 64 * 128 + (size_t)(t * 512 + ln) * 8; const bf16* ap = p.GA + u * 64 * 64 + (size_t)(t * 256 + ln) * 8;
#pragma unroll
            for (int q = 0; q < 8; ++q) fa[k][q] = *(const bf16x8_t*)(qp + q * 512);
#pragma unroll
            for (int q = 0; q < 4; ++q) fb[k][q] = *(const bf16x8_t*)(ap + q * 512); };
        auto out_of = [&](int so, auto KC) { constexpr int k = decltype(KC)::value;
            const LAS bf16* Sc = SbT + (so & 3) * 32 * GC_KS; const LAS bf16* vn = vnT + (so % 3) * 32 * GC_TS;
            f32x16_t acc = zero16(), acc2 = zero16();
#pragma unroll
            for (int qh = 0; qh < 2; ++qh) { bf16x8_t bq[4];
#pragma unroll
                for (int q = 0; q < 4; ++q) bq[q] = *(const LAS bf16x8_t*)(Sc + r32 * GC_KS + 16 * (4 * qh + q) + 8 * hh);
#pragma unroll
                for (int q = 0; q < 4; q += 2) { acc = __builtin_amdgcn_mfma_f32_32x32x16_bf16(fa[k][4 * qh + q], bq[q], acc, 0, 0, 0); acc2 = __builtin_amdgcn_mfma_f32_32x32x16_bf16(fa[k][4 * qh + q + 1], bq[q + 1], acc2, 0, 0, 0); } }
            { bf16x8_t bv[4];
#pragma unroll
              for (int q = 0; q < 4; ++q) bv[q] = *(const LAS bf16x8_t*)(vn + r32 * GC_TS + 16 * q + 8 * hh);
#pragma unroll
              for (int q = 0; q < 4; q += 2) { acc = __builtin_amdgcn_mfma_f32_32x32x16_bf16(fb[k][q], bv[q], acc, 0, 0, 0); acc2 = __builtin_amdgcn_mfma_f32_32x32x16_bf16(fb[k][q + 1], bv[q + 1], acc2, 0, 0, 0); } }
            const int r0 = chunk_row0(b, chunk_of(so));
#pragma unroll
            for (int e = 0; e < 16; ++e) acc[e] += acc2[e];
            store_tile_rows(acc, otile, lane, [&](int il) { const int i = 32 * t + il; return p.OGb + ((size_t)dir * MROWS + r0 + (dir ? 63 - i : i)) * MIX_W + h * 128 + slice * 32; }); };
        auto step = [&](int s, auto KC) { constexpr int k = decltype(KC)::value;
            if (s > 1) out_of(s - 2, std::integral_constant<int, (k + 1) % 3>{});
            if (s + 1 < NCH) prefetch(s + 1, std::integral_constant<int, (k + 1) % 3>{});
            LDS_BARRIER(); LDS_BARRIER(); };
        prefetch(0, I0{});
        for (int s = 0; s + 2 < NCH; s += 3) { step(s, I0{}); step(s + 1, I1{}); step(s + 2, I2{}); }
        step(NCH - 2, std::integral_constant<int, (NCH - 2) % 3>{}); step(NCH - 1, std::integral_constant<int, (NCH - 1) % 3>{});
        out_of(NCH - 2, std::integral_constant<int, (NCH - 2) % 3>{}); out_of(NCH - 1, std::integral_constant<int, (NCH - 1) % 3>{});
    }
}
static_assert(G1_END <= 146432 && NCH % 8 == 4 && NCH % 3 == 2, "G1 LDS map / scan unroll");

constexpr int SSD_NU = BATCH * NCH * SSM_H * 2;
__device__ __forceinline__ int ssd_unit_index(int b, int c, int hd, int dir) { return ((b * NCH + c) * SSM_H + hd) * 2 + dir; }
constexpr int SL_BN = 0, SL_CN = SL_BN + 64 * GC_KS * 2, SL_CB = SL_CN + 64 * GC_KS * 2, SL_BT = SL_CB + 64 * GC_FS * 4, SL_XT = SL_BT + 128 * GC_TS * 2, SL_M = SL_XT + 256 * GC_TS * 2,
              SL_XW = SL_M + 64 * GC_TS * 2, SL_SM = SL_XW + 2 * 64 * GC_TS * 2, SL_END = SL_SM + 8 * 3 * 64 * 4;
static_assert(SL_END <= 146432, "ssd local LDS map");
constexpr int SSD_LOCAL_UNITS = BATCH * NCH * SSM_G * 2;
__device__ __forceinline__ void ssd_local_unit(const Ptrs& p, LAS unsigned char* lds, int unit, int tid) {
    const int lane = tid & 63, wave = tid >> 6, r32 = lane & 31, hh = lane >> 5;
    const int b = unit / (NCH * SSM_G * 2), c = (unit / (SSM_G * 2)) % NCH, g = (unit >> 1) % SSM_G, hq = unit & 1;
    const int r0 = chunk_row0(b, c), hd0 = g * SSM_HPG + hq * 4;
    LAS bf16* Bn = (LAS bf16*)(lds + SL_BN); LAS bf16* Cn = (LAS bf16*)(lds + SL_CN); LAS float* CBs = (LAS float*)(lds + SL_CB); LAS bf16* BT = (LAS bf16*)(lds + SL_BT);
    LAS bf16* XT = (LAS bf16*)(lds + SL_XT); LAS bf16* Mm = (LAS bf16*)(lds + SL_M); LAS bf16* XwT = (LAS bf16*)(lds + SL_XW); LAS float* sm = (LAS float*)(lds + SL_SM);
#pragma unroll
    for (int it = 0; it < 4; ++it) { const int idx = it * 512 + tid, row = idx >> 5, which = (idx >> 4) & 1, c8 = idx & 15;
        *(LAS vu4*)((which ? Cn : Bn) + row * GC_KS + c8 * 8) = *(const vu4*)(p.SBCb + (size_t)(r0 + row) * (2 * SSM_BC) + which * SSM_BC + g * SSM_N + c8 * 8); }
    { vu4 xv[4];
#pragma unroll
        for (int it = 0; it < 4; ++it) { const int idx = it * 512 + tid, j = idx >> 5, p8 = idx & 31; xv[it] = *(const vu4*)(p.SXb + (size_t)(r0 + j) * MIX_W + hd0 * SSM_P + p8 * 8); }
#pragma unroll
        for (int it = 0; it < 4; ++it) { const int idx = it * 512 + tid, j = idx >> 5, p8 = idx & 31; const unsigned w4[4] = {xv[it].x, xv[it].y, xv[it].z, xv[it].w};
#pragma unroll
            for (int e = 0; e < 4; ++e) { XT[(8 * p8 + 2 * e) * GC_TS + j] = (bf16)(w4[e] & 0xffffu); XT[(8 * p8 + 2 * e + 1) * GC_TS + j] = (bf16)(w4[e] >> 16); } } }
    { const int hd = hd0 + (wave >> 1), dir = wave & 1, n = dir ? 63 - lane : lane; const size_t gi = (size_t)(r0 + n) * 2 * SSM_H + dir * SSM_H + hd; const int u = ssd_unit_index(b, c, hd, dir);
        float x = p.SA[gi]; const float dt = p.SDT[gi];
#pragma unroll
        for (int o = 1; o < 64; o <<= 1) { const float y = __shfl_up(x, o); if (lane >= o) x += y; }
        const float x63 = __shfl(x, 63);
        sm[(wave * 3 + 0) * 64 + lane] = x; sm[(wave * 3 + 1) * 64 + lane] = dt; sm[(wave * 3 + 2) * 64 + lane] = __expf(x63 - x) * dt;
        p.SEAb[(size_t)u * 64 + lane] = f2bf(__expf(x)); if (lane == 63) p.SDC[u] = __expf(x); }
    LDS_BARRIER();
    *(vu4*)(p.SCF + ((((size_t)(b * NCH + c) * SSM_G + g) * 2 + hq) * 8 + wave) * 512 + lane * 8) = *(const LAS vu4*)(Cn + (32 * hq + r32) * GC_KS + 16 * wave + 8 * hh);
    if (wave < 4) { const int mt = wave >> 1, nt = wave & 1; f32x16_t acc = zero16(); acc = mma_lds<8>(acc, Cn + 32 * mt * GC_KS, GC_KS, Bn + 32 * nt * GC_KS, GC_KS, r32, hh);
#pragma unroll
        for (int e = 0; e < 16; ++e) CBs[(32 * mt + (e & 3) + 8 * (e >> 2) + 4 * hh) * GC_FS + 32 * nt + r32] = acc[e]; }
    else { for (int it = tid - 256; it < 128 * 8; it += 256) { const int s = it >> 3, j8 = it & 7; unsigned w[4];
#pragma unroll
            for (int e2 = 0; e2 < 4; ++e2) w[e2] = (unsigned)Bn[(j8 * 8 + 2 * e2) * GC_KS + s] | ((unsigned)Bn[(j8 * 8 + 2 * e2 + 1) * GC_KS + s] << 16);
            *(LAS vu4*)(BT + s * GC_TS + j8 * 8) = (vu4){w[0], w[1], w[2], w[3]}; } }
    LDS_BARRIER();
#pragma unroll 1
    for (int hl = 0; hl < 4; ++hl) {
        const int hd = hd0 + hl;
        const LAS float* ac0 = sm + (hl * 2 * 3) * 64; const LAS float* ac1 = ac0 + 3 * 64;
        { const int n = tid >> 3, n8 = tid & 7; unsigned w[4];
            const float a0n = ac0[n], a1n = ac1[63 - n];
#pragma unroll
            for (int e2 = 0; e2 < 4; ++e2) { float a[2];
#pragma unroll
                for (int q = 0; q < 2; ++q) { const int nj = n8 * 8 + 2 * e2 + q; const bool lo = nj <= n;
                    const float ex = __expf(lo ? a0n - ac0[nj] : a1n - ac1[63 - nj]);
                    const float dd = (nj < n) ? ac0[64 + nj] : (nj > n) ? ac1[64 + 63 - nj] : ac0[64 + nj] + ac1[64 + 63 - nj];
                    a[q] = CBs[n * GC_FS + nj] * ex * dd; }
                w[e2] = cvtpk(a[0], a[1]); }
            *(LAS vu4*)(Mm + n * GC_TS + n8 * 8) = (vu4){w[0], w[1], w[2], w[3]};
            const int pp = tid >> 3; float xs[8]; unpack8(*(const LAS vu4*)(XT + (hl * 64 + pp) * GC_TS + n8 * 8), xs);
#pragma unroll
            for (int e2 = 0; e2 < 4; ++e2) { const int nj = n8 * 8 + 2 * e2; w[e2] = cvtpk(xs[2 * e2] * ac0[128 + nj], xs[2 * e2 + 1] * ac0[128 + nj + 1]); }
            *(LAS vu4*)(XwT + pp * GC_TS + n8 * 8) = (vu4){w[0], w[1], w[2], w[3]};
#pragma unroll
            for (int e2 = 0; e2 < 4; ++e2) { const int nj = n8 * 8 + 2 * e2; w[e2] = cvtpk(xs[2 * e2] * ac1[128 + 63 - nj], xs[2 * e2 + 1] * ac1[128 + 62 - nj]); }
            *(LAS vu4*)(XwT + (64 + pp) * GC_TS + n8 * 8) = (vu4){w[0], w[1], w[2], w[3]}; }
        LDS_BARRIER();
#pragma unroll
        for (int dir = 0; dir < 2; ++dir) { const int sb = wave >> 1, pb = wave & 1, u = ssd_unit_index(b, c, hd, dir); f32x16_t acc = zero16();
            acc = mma_lds<4>(acc, BT + 32 * sb * GC_TS, GC_TS, XwT + (64 * dir + 32 * pb) * GC_TS, GC_TS, r32, hh);
            bf16* dst = p.SSC + (((size_t)u * 8 + wave) * 64 + lane) * 16;
            *(vu4*)dst = (vu4){cvtpk(acc[0], acc[1]), cvtpk(acc[2], acc[3]), cvtpk(acc[4], acc[5]), cvtpk(acc[6], acc[7])};
            *(vu4*)(dst + 8) = (vu4){cvtpk(acc[8], acc[9]), cvtpk(acc[10], acc[11]), cvtpk(acc[12], acc[13]), cvtpk(acc[14], acc[15])}; }
        if (wave < 4) { const int mt = wave >> 1, pb = wave & 1; f32x16_t acc = zero16(); acc = mma_lds<4>(acc, Mm + 32 * mt * GC_TS, GC_TS, XT + (hl * 64 + 32 * pb) * GC_TS, GC_TS, r32, hh);
#pragma unroll
            for (int e = 0; e < 16; ++e) { const int n = 32 * mt + (e & 3) + 8 * (e >> 2) + 4 * hh;
                p.OSb[((size_t)r0 + n) * MIX_W + hd * SSM_P + 32 * pb + r32] = f2bf(acc[e]); } }
        LDS_BARRIER();
    }
}
__device__ __forceinline__ void ssd_scan_wg(const Ptrs& p, LAS unsigned char* lds, int chain, int tid) {
    const int b = chain / (SSM_H * 2), hd = (chain >> 1) % SSM_H, dir = chain & 1, g = hd / SSM_HPG;
    const int lane = tid & 63, wave = tid >> 6, r32 = lane & 31, hh = lane >> 5;
    int zl = 0; asm volatile("v_mov_b32 %0, 0" : "=v"(zl));
    LAS bf16* hT = (LAS bf16*)lds;
    for (int i = tid; i < 64 * GC_KS / 2; i += 512) ((LAS unsigned*)hT)[i] = 0u;
    LDS_BARRIER();
    auto chunk_of = [&](int s) { return s < NCH_CTX ? (dir ? NCH_CTX - 1 - s : s) : NCH_CTX + (dir ? NCH - NCH_CTX - 1 - (s - NCH_CTX) : s - NCH_CTX); };
    using I0 = std::integral_constant<int, 0>; using I1 = std::integral_constant<int, 1>; using I2 = std::integral_constant<int, 2>; using I3 = std::integral_constant<int, 3>;
    if (wave >= 4) {
        __builtin_amdgcn_s_setprio(3);
        const int hw = wave - 4;
        f32x16_t h0 = zero16(), h1 = zero16();
        vu4 sc[4][4]; float dec[4] = {0.f, 0.f, 0.f, 0.f};
        auto pre_h = [&](int s, auto KC2) { constexpr int k = decltype(KC2)::value; const size_t u = (size_t)ssd_unit_index(b, chunk_of(s), hd, dir);
            const bf16* sp = p.SSC + ((u * 8 + 2 * hw) * 64 + lane) * 16; sc[k][0] = *(const vu4*)sp; sc[k][1] = *(const vu4*)(sp + 8); sc[k][2] = *(const vu4*)(sp + 1024); sc[k][3] = *(const vu4*)(sp + 1024 + 8); dec[k] = p.SDC[u + zl]; };
        auto step = [&](int s, auto KC) { constexpr int k = decltype(KC)::value;
            const unsigned w0[8] = {sc[k][0].x, sc[k][0].y, sc[k][0].z, sc[k][0].w, sc[k][1].x, sc[k][1].y, sc[k][1].z, sc[k][1].w}, w1[8] = {sc[k][2].x, sc[k][2].y, sc[k][2].z, sc[k][2].w, sc[k][3].x, sc[k][3].y, sc[k][3].z, sc[k][3].w};
            const float d1 = dec[k];
#pragma unroll
            for (int e2 = 0; e2 < 8; ++e2) { h0[2 * e2] = h0[2 * e2] * d1 + bflo(w0[e2]); h0[2 * e2 + 1] = h0[2 * e2 + 1] * d1 + bfhi(w0[e2]); h1[2 * e2] = h1[2 * e2] * d1 + bflo(w1[e2]); h1[2 * e2 + 1] = h1[2 * e2 + 1] * d1 + bfhi(w1[e2]); }
            if (s + 3 < NCH) pre_h(s + 3, std::integral_constant<int, (k + 3) % 4>{});
            LAS bf16* Hn = hT + ((s + 1) & 3) * 64 * GC_KS;
#pragma unroll
            for (int a4 = 0; a4 < 4; ++a4) { *(LAS vu2*)(Hn + r32 * GC_KS + 32 * hw + 8 * a4 + 4 * hh) = (vu2){cvtpk(h0[4 * a4], h0[4 * a4 + 1]), cvtpk(h0[4 * a4 + 2], h0[4 * a4 + 3])};
                *(LAS vu2*)(Hn + (32 + r32) * GC_KS + 32 * hw + 8 * a4 + 4 * hh) = (vu2){cvtpk(h1[4 * a4], h1[4 * a4 + 1]), cvtpk(h1[4 * a4 + 2], h1[4 * a4 + 3])}; }
            LDS_BARRIER(); };
        pre_h(0, I0{}); pre_h(1, I1{}); pre_h(2, I2{});
        for (int s = 0; s < NCH; s += 4) { step(s, I0{}); step(s + 1, I1{}); step(s + 2, I2{}); step(s + 3, I3{}); }
        __builtin_amdgcn_s_setprio(0);
    } else {
        const int mt = wave >> 1, pb = wave & 1;
        LAS bf16* otile = hT + 4 * 64 * GC_KS + wave * 32 * 40;
        bf16x8_t cf[3][8]; vu2 ea[3][4];
        auto pre_y = [&](int s, auto KC2) { constexpr int k = decltype(KC2)::value; const int c = chunk_of(s); const size_t u = (size_t)ssd_unit_index(b, c, hd, dir); const int r0 = chunk_row0(b, c);
            const bf16* cp = p.SCF + ((((size_t)(b * NCH + c) * SSM_G + g) * 2 + (dir ? 1 - mt : mt)) * 8) * 512 + (hh * 32 + (dir ? 31 - r32 : r32)) * 8;
#pragma unroll
            for (int q = 0; q < 8; ++q) cf[k][q] = *(const bf16x8_t*)(cp + q * 512);
#pragma unroll
            for (int a4 = 0; a4 < 4; ++a4) ea[k][a4] = *(const vu2*)(p.SEAb + u * 64 + 32 * mt + 8 * a4 + 4 * hh); };
        auto out_y = [&](int so, auto KC) { constexpr int k = decltype(KC)::value;
            const LAS bf16* Hc = hT + (so & 3) * 64 * GC_KS;
            f32x16_t acc = zero16(), acc2 = zero16();
#pragma unroll
            for (int qh = 0; qh < 2; ++qh) { bf16x8_t bq[4];
#pragma unroll
                for (int q = 0; q < 4; ++q) bq[q] = *(const LAS bf16x8_t*)(Hc + (32 * pb + r32) * GC_KS + 16 * (4 * qh + q) + 8 * hh);
#pragma unroll
                for (int q = 0; q < 4; q += 2) { acc = __builtin_amdgcn_mfma_f32_32x32x16_bf16(cf[k][4 * qh + q], bq[q], acc, 0, 0, 0); acc2 = __builtin_amdgcn_mfma_f32_32x32x16_bf16(cf[k][4 * qh + q + 1], bq[q + 1], acc2, 0, 0, 0); } }
            const int r0 = chunk_row0(b, chunk_of(so));
#pragma unroll
            for (int e = 0; e < 16; ++e) { const unsigned ew = (e & 2) ? ea[k][e >> 2].y : ea[k][e >> 2].x; const float ev = (e & 1) ? bfhi(ew) : bflo(ew); acc[e] = ev * (acc[e] + acc2[e]); }
            store_tile_rows(acc, otile, lane, [&](int il) { const int i = 32 * mt + il; return p.OSb2 + ((size_t)dir * MROWS + r0 + (dir ? 63 - i : i)) * MIX_W + hd * SSM_P + 32 * pb; }); };
        auto step = [&](int s, auto KC) { constexpr int k = decltype(KC)::value;
            if (s > 1) out_y(s - 2, std::integral_constant<int, (k + 1) % 3>{});
            if (s + 1 < NCH) pre_y(s + 1, std::integral_constant<int, (k + 1) % 3>{});
            LDS_BARRIER(); };
        pre_y(0, I0{});
        for (int s = 0; s + 2 < NCH; s += 3) { step(s, I0{}); step(s + 1, I1{}); step(s + 2, I2{}); }
        step(NCH - 2, std::integral_constant<int, (NCH - 2) % 3>{}); step(NCH - 1, std::integral_constant<int, (NCH - 1) % 3>{});
        out_y(NCH - 2, std::integral_constant<int, (NCH - 2) % 3>{}); out_y(NCH - 1, std::integral_constant<int, (NCH - 1) % 3>{});
    }
}


namespace pg8 {
struct EpiInProj {
    static constexpr bool PERM = true, AFTER_DRAIN = false, KHOOK = false;
    bf16_t* P; float* PF;
    __device__ __forceinline__ void operator()(const f32x4 (&acc)[2][2][4][2], const Unit& u, int wr, int wc, int fr, int fq) const {
        const int row0 = u.pm * BM + wr * 64 + fr;
        if (u.pn * BM < NP_MAIN) {
            const int col0 = u.pn * BM + wc * 32 + 8 * fq;
#pragma unroll
            for (int ai = 0; ai < 2; ++ai)
#pragma unroll
                for (int m = 0; m < 4; ++m) { bf16_t* rowp = P + (size_t)(row0 + ai * HALF + m * 16) * NP_MAIN + col0;
#pragma unroll
                    for (int bj = 0; bj < 2; ++bj) { const f32x4 v0 = acc[ai][bj][m][0], v1 = acc[ai][bj][m][1];
                        u32x4 w; w.x = cvt_pk_bf16(v0[0], v0[1]); w.y = cvt_pk_bf16(v0[2], v0[3]); w.z = cvt_pk_bf16(v1[0], v1[1]); w.w = cvt_pk_bf16(v1[2], v1[3]);
                        *(u32x4*)(rowp + bj * HALF) = w; } }
        } else {
#pragma unroll
            for (int ai = 0; ai < 2; ++ai)
#pragma unroll
                for (int m = 0; m < 4; ++m) { float* rowp = PF + (size_t)(row0 + ai * HALF + m * 16) * PF_N;
#pragma unroll
                    for (int bj = 0; bj < 2; ++bj) { const int c = bj * HALF + wc * 32 + 8 * fq;
                        if (c < PF_N) { *(f32x4*)(rowp + c) = acc[ai][bj][m][0]; *(f32x4*)(rowp + c + 4) = acc[ai][bj][m][1]; } } }
        }
    }
};
struct EpiMerge {
    static constexpr bool PERM = true, AFTER_DRAIN = false, KHOOK = false;
    const bf16_t* G0; bf16_t* TB;
    __device__ __forceinline__ void operator()(const f32x4 (&acc)[2][2][4][2], const Unit& u, int wr, int wc, int fr, int fq) const {
        const int row0 = u.pm * BM + wr * 64 + fr, col0 = u.pn * BM + wc * 32 + 8 * fq, br = u.pk / MIX_W; const bf16_t* G = G0 + br * D_MODEL;
#pragma unroll
        for (int ai = 0; ai < 2; ++ai)
#pragma unroll
            for (int m = 0; m < 4; ++m) { const size_t row = (size_t)(row0 + ai * HALF + m * 16);
#pragma unroll
                for (int bj = 0; bj < 2; ++bj) { const int col = col0 + bj * HALF;
                    const u32x4 gw = *(const u32x4*)(G + row * NP_MAIN + col);
                    float gt[8];
#pragma unroll
                    for (int j = 0; j < 4; ++j) { gt[2 * j] = __uint_as_float(gw[j] << 16); gt[2 * j + 1] = __uint_as_float(gw[j] & 0xffff0000u); }
                    f32x4 t0, t1;
#pragma unroll
                    for (int j = 0; j < 4; ++j) { t0[j] = acc[ai][bj][m][0][j] * __builtin_amdgcn_rcpf(1.0f + __expf(-gt[j])); t1[j] = acc[ai][bj][m][1][j] * __builtin_amdgcn_rcpf(1.0f + __expf(-gt[4 + j])); }
                    u32x4 w; w.x = cvt_pk_bf16(t0[0], t0[1]); w.y = cvt_pk_bf16(t0[2], t0[3]); w.z = cvt_pk_bf16(t1[0], t1[1]); w.w = cvt_pk_bf16(t1[2], t1[3]);
                    *(u32x4*)(TB + ((size_t)br * NCTX + (row - NLAT)) * D_MODEL + col) = w; } }
    }
};
struct EpiF32Plain {
    static constexpr bool PERM = false, AFTER_DRAIN = false, KHOOK = false;
    float* C; int ldc;
    __device__ __forceinline__ void operator()(const f32x4 (&acc)[2][2][4][2], const Unit& u, int wr, int wc, int fr, int fq) const {
        const int row0 = u.pm * BM + wr * 64 + fr, col0 = u.pn * BM + wc * 32 + 4 * fq;
#pragma unroll
        for (int ai = 0; ai < 2; ++ai)
#pragma unroll
            for (int m = 0; m < 4; ++m) { float* rowp = C + (size_t)(row0 + ai * HALF + m * 16) * ldc + col0;
#pragma unroll
                for (int bj = 0; bj < 2; ++bj)
#pragma unroll
                    for (int n = 0; n < 2; ++n) *(f32x4*)(rowp + bj * HALF + n * 16) = acc[ai][bj][m][n]; }
    }
};
struct EpiBf16Plain {
    static constexpr bool PERM = true, AFTER_DRAIN = false, KHOOK = false;
    bf16_t* O; int ldc;
    __device__ __forceinline__ void operator()(const f32x4 (&acc)[2][2][4][2], const Unit& u, int wr, int wc, int fr, int fq) const {
        const int row0 = u.pm * BM + wr * 64 + fr, col0 = u.pn * BM + wc * 32 + 8 * fq;
#pragma unroll
        for (int ai = 0; ai < 2; ++ai)
#pragma unroll
            for (int m = 0; m < 4; ++m) { bf16_t* rowp = O + (size_t)(row0 + ai * HALF + m * 16) * ldc + col0;
#pragma unroll
                for (int bj = 0; bj < 2; ++bj) { const f32x4 v0 = acc[ai][bj][m][0], v1 = acc[ai][bj][m][1];
                    u32x4 w; w.x = cvt_pk_bf16(v0[0], v0[1]); w.y = cvt_pk_bf16(v0[2], v0[3]); w.z = cvt_pk_bf16(v1[0], v1[1]); w.w = cvt_pk_bf16(v1[2], v1[3]);
                    *(u32x4*)(rowp + bj * HALF) = w; } }
    }
};

struct EpiAct {
    static constexpr bool PERM = true, AFTER_DRAIN = false, KHOOK = false;
    bf16_t* ACT; float* BP; bf16_t* BU; bf16_t* BG; const float* cw; const float* cb;
    __device__ __forceinline__ void operator()(const f32x4 (&acc)[2][2][4][2], const Unit& u, int wr, int wc, int fr, int fq) const {
        const int lp = (fq * 16 + ((fr + 15) & 15)) * 4, ln = (fq * 16 + ((fr + 1) & 15)) * 4;
#pragma unroll
        for (int n = 0; n < 2; ++n) {
            const int j0 = u.pn * 128 + wc * 32 + 8 * fq + 4 * n;
            const f32x4 w0 = *(const f32x4*)(cw + j0), w1 = *(const f32x4*)(cw + D_FF + j0), w2 = *(const f32x4*)(cw + 2 * D_FF + j0), bs = *(const f32x4*)(cb + j0);
#pragma unroll
            for (int ai = 0; ai < 2; ++ai) {
#pragma unroll
                for (int m = 0; m < 4; ++m) {
                    const int row = u.pm * BM + ai * HALF + wr * 64 + m * 16 + fr;
                    const bool hp = !(m == 0 && fr == 0), hn = !(m == 3 && fr == 15);
                    f32x4 gp, gn;
#pragma unroll
                    for (int e = 0; e < 4; ++e) { const float gc = acc[ai][1][m][n][e], gm = acc[ai][1][m > 0 ? m - 1 : 0][n][e], gq = acc[ai][1][m < 3 ? m + 1 : 3][n][e];
                        gp[e] = __int_as_float(__builtin_amdgcn_ds_bpermute(lp, __float_as_int(fr == 15 ? gm : gc)));
                        gn[e] = __int_as_float(__builtin_amdgcn_ds_bpermute(ln, __float_as_int(fr == 0 ? gq : gc))); }
                    const f32x4 g = acc[ai][1][m][n], uu = acc[ai][0][m][n];
                    f32x4 pre = w1 * g + bs;
                    if (hp) pre += w0 * gp;
                    if (hn) pre += w2 * gn;
                    if (hp && hn) {
                        f32x4 a;
#pragma unroll
                        for (int e = 0; e < 4; ++e) a[e] = pre[e] * __builtin_amdgcn_rcpf(1.0f + __expf(-pre[e])) * uu[e];
                        typedef unsigned u32x2 __attribute__((ext_vector_type(2)));
                        u32x2 w; w.x = cvt_pk_bf16(a[0], a[1]); w.y = cvt_pk_bf16(a[2], a[3]);
                        *(u32x2*)(ACT + (size_t)row * D_FF + j0) = w;
                    } else {
                        const size_t bi = (size_t)((row >> 6) * 2 + ((row & 63) == 63 ? 1 : 0)) * D_FF + j0;
                        typedef unsigned u32x2 __attribute__((ext_vector_type(2)));
                        *(f32x4*)(BP + bi) = pre;
                        u32x2 wu; wu.x = cvt_pk_bf16(uu[0], uu[1]); wu.y = cvt_pk_bf16(uu[2], uu[3]); *(u32x2*)(BU + bi) = wu;
                        u32x2 wg; wg.x = cvt_pk_bf16(g[0], g[1]); wg.y = cvt_pk_bf16(g[2], g[3]); *(u32x2*)(BG + bi) = wg;
                    }
                }
            }
        }
    }
};

constexpr int SPLIT_KS = 512, OUT_NS = D_MODEL / SPLIT_KS, DOWN_NS = D_FF / SPLIT_KS;
static_assert(D_MODEL % SPLIT_KS == 0 && D_FF % SPLIT_KS == 0 && NCTX % 256 == 0, "split-K context units");
struct SplitOrder {
    int ns, G, c;
    __device__ __forceinline__ bool next(int i, Unit& u) const { const int L = i * G + c; if (L >= (NCTX / 256) * (D_MODEL / 256) * ns) return false;
        const int ks = L % ns, tile = L / ns; u.pm = NLAT / 256 + tile / (D_MODEL / 256); u.pn = tile % (D_MODEL / 256); u.pk = ks * SPLIT_KS; return true; }
    __device__ __forceinline__ void a_ready(const Unit&) const {}
    __device__ __forceinline__ void done(const Unit&) const {}
};
struct SplitOrder3 {
    int G, c;
    __device__ __forceinline__ bool next(int i, Unit& u) const { const int L = i * G + c; constexpr int NT = (NCTX / 256) * (D_MODEL / 256); if (L >= NT * 3 * OUT_NS) return false;
        const int ks = L % OUT_NS, br = (L / OUT_NS) % 3, tile = L / (3 * OUT_NS); u.pm = br * (NCTX / 256) + tile / (D_MODEL / 256); u.pn = tile % (D_MODEL / 256); u.pk = ks * SPLIT_KS; return true; }
    __device__ __forceinline__ void a_ready(const Unit&) const {}
    __device__ __forceinline__ void done(const Unit&) const {}
};
struct EpiSlab3 {
    static constexpr bool PERM = false, AFTER_DRAIN = false, KHOOK = false;
    float* S;
    __device__ __forceinline__ void operator()(const f32x4 (&acc)[2][2][4][2], const Unit& u, int wr, int wc, int fr, int fq) const {
        const int br = u.pm / (NCTX / 256), ct = u.pm % (NCTX / 256);
        const int row0 = ct * BM + wr * 64 + fr, col0 = u.pn * BM + wc * 32 + 4 * fq; float* base = S + (size_t)(br * OUT_NS + u.pk / SPLIT_KS) * NCTX * D_MODEL;
#pragma unroll
        for (int ai = 0; ai < 2; ++ai)
#pragma unroll
            for (int m = 0; m < 4; ++m) { float* rowp = base + (size_t)(row0 + ai * HALF + m * 16) * D_MODEL + col0;
#pragma unroll
                for (int bj = 0; bj < 2; ++bj)
#pragma unroll
                    for (int n = 0; n < 2; ++n) *(f32x4*)(rowp + bj * HALF + n * 16) = acc[ai][bj][m][n]; }
    }
};

struct EpiMerge3 {
    static constexpr bool PERM = true, AFTER_DRAIN = false, KHOOK = true;
    const bf16_t* G0; bf16_t* MB;
    __device__ __forceinline__ void khook(f32x4 (&acc)[2][2][4][2], const Unit& u, int t, int wr, int wc, int fr, int fq) const {
        if (t != MIX_W / BK && t != 2 * MIX_W / BK) return;
        const int bp = t / (MIX_W / BK) - 1;
        const int row0 = u.pm * BM + wr * 64 + fr, col0 = u.pn * BM + wc * 32 + 8 * fq; const bf16_t* Gp = G0 + bp * D_MODEL;
#pragma unroll
        for (int ai = 0; ai < 2; ++ai) {
            asm volatile("" ::: "memory");
#pragma unroll
            for (int m = 0; m < 4; ++m) { const unsigned rowo = (unsigned)(row0 + ai * HALF + m * 16) * (unsigned)NP_MAIN;
#pragma unroll
                for (int bj = 0; bj < 2; ++bj) { const unsigned off = rowo + (unsigned)(col0 + bj * HALF);
                    const u32x4 gp = *(const u32x4*)(Gp + off), gn = *(const u32x4*)(Gp + D_MODEL + off);
#pragma unroll
                    for (int j = 0; j < 4; ++j) { const float p0 = __uint_as_float(gp[j] << 16), p1 = __uint_as_float(gp[j] & 0xffff0000u), n0 = __uint_as_float(gn[j] << 16), n1 = __uint_as_float(gn[j] & 0xffff0000u);
                        const float r0 = (1.0f + __expf(-n0)) * __builtin_amdgcn_rcpf(1.0f + __expf(-p0)), r1 = (1.0f + __expf(-n1)) * __builtin_amdgcn_rcpf(1.0f + __expf(-p1));
                        if (j < 2) { acc[ai][bj][m][0][2 * j] *= r0; acc[ai][bj][m][0][2 * j + 1] *= r1; } else { acc[ai][bj][m][1][2 * (j - 2)] *= r0; acc[ai][bj][m][1][2 * (j - 2) + 1] *= r1; } } } } }
    }
    __device__ __forceinline__ void operator()(const f32x4 (&acc)[2][2][4][2], const Unit& u, int wr, int wc, int fr, int fq) const {
        const int row0 = u.pm * BM + wr * 64 + fr, col0 = u.pn * BM + wc * 32 + 8 * fq; const bf16_t* G = G0 + 2 * D_MODEL;
#pragma unroll
        for (int ai = 0; ai < 2; ++ai)
#pragma unroll
            for (int m = 0; m < 4; ++m) { const size_t row = (size_t)(row0 + ai * HALF + m * 16);
#pragma unroll
                for (int bj = 0; bj < 2; ++bj) { const int col = col0 + bj * HALF;
                    const u32x4 gw = *(const u32x4*)(G + row * NP_MAIN + col);
                    float gt[8];
#pragma unroll
                    for (int j = 0; j < 4; ++j) { gt[2 * j] = __uint_as_float(gw[j] << 16); gt[2 * j + 1] = __uint_as_float(gw[j] & 0xffff0000u); }
                    f32x4 t0, t1;
#pragma unroll
                    for (int j = 0; j < 4; ++j) { t0[j] = acc[ai][bj][m][0][j] * __builtin_amdgcn_rcpf(1.0f + __expf(-gt[j])); t1[j] = acc[ai][bj][m][1][j] * __builtin_amdgcn_rcpf(1.0f + __expf(-gt[4 + j])); }
                    u32x4 w; w.x = cvt_pk_bf16(t0[0], t0[1]); w.y = cvt_pk_bf16(t0[2], t0[3]); w.z = cvt_pk_bf16(t1[0], t1[1]); w.w = cvt_pk_bf16(t1[2], t1[3]);
                    *(u32x4*)(MB + row * D_MODEL + col) = w; } }
    }
};
struct CtxMergeOrder {
    int c;
    __device__ __forceinline__ bool next(int i, Unit& u) const { if (i > 0 || c >= 3 * (NCTX / 256) * (D_MODEL / 256)) return false;
        const int tile = c / 3; u.pm = NLAT / 256 + tile / (D_MODEL / 256); u.pn = tile % (D_MODEL / 256); u.pk = (c % 3) * MIX_W; return true; }
    __device__ __forceinline__ void a_ready(const Unit&) const {}
    __device__ __forceinline__ void done(const Unit&) const {}
};
struct EpiSlab {
    static constexpr bool PERM = false, AFTER_DRAIN = false, KHOOK = false;
    float* S;
    __device__ __forceinline__ void operator()(const f32x4 (&acc)[2][2][4][2], const Unit& u, int wr, int wc, int fr, int fq) const {
        const int row0 = (u.pm * BM - NLAT) + wr * 64 + fr, col0 = u.pn * BM + wc * 32 + 4 * fq; float* base = S + (size_t)(u.pk / SPLIT_KS) * NCTX * D_MODEL;
#pragma unroll
        for (int ai = 0; ai < 2; ++ai)
#pragma unroll
            for (int m = 0; m < 4; ++m) { float* rowp = base + (size_t)(row0 + ai * HALF + m * 16) * D_MODEL + col0;
#pragma unroll
                for (int bj = 0; bj < 2; ++bj)
#pragma unroll
                    for (int n = 0; n < 2; ++n) *(f32x4*)(rowp + bj * HALF + n * 16) = acc[ai][bj][m][n]; }
    }
};
}

constexpr size_t al256(size_t x) { return (x + 255) & ~(size_t)255; }
constexpr size_t WS_CTL = 0, CTL_BYTES = 1u << 20;
constexpr size_t WS_WIN = WS_CTL + CTL_BYTES;
constexpr size_t WS_WBR = WS_WIN + al256((size_t)DEPTH * NP_PAD * D_MODEL * 2);
constexpr size_t WS_WOUT = WS_WBR + al256((size_t)DEPTH * 3 * D_MODEL * MIX_W * 2);
constexpr size_t WS_WUP = WS_WOUT + al256((size_t)DEPTH * D_MODEL * D_MODEL * 2);
constexpr size_t WS_WDOWN = WS_WUP + al256((size_t)DEPTH * 2 * D_FF * D_MODEL * 2);
constexpr size_t WS_MOD = WS_WDOWN + al256((size_t)DEPTH * D_MODEL * D_FF * 2);
constexpr size_t WS_X = WS_MOD + al256((size_t)DEPTH * (BATCH + 1) * D6 * 4 + GRID_W * 32 * 2 * 4);
constexpr size_t WS_H = WS_X + al256((size_t)MROWS * D_MODEL * 4);
constexpr size_t WS_MIX = WS_H + al256((size_t)MROWS * D_MODEL * 2);
constexpr size_t WS_SLAB = WS_MIX + al256((size_t)MROWS * D_MODEL * 4);
constexpr size_t WS_TB = WS_SLAB + al256((size_t)(D_FF / 512 > 12 ? D_FF / 512 : 12) * NCTX * D_MODEL * 4);
constexpr size_t WS_R = WS_TB + al256((size_t)3 * NCTX * D_MODEL * 2);
constexpr size_t WS_P = WS_R;
constexpr size_t WS_PF = WS_P + al256((size_t)MROWS * NP_MAIN * 2);
constexpr size_t WS_GQKV = WS_PF + al256((size_t)MROWS * PF_N * 4);
#if defined(TOKEN_GDN) || defined(NAIVE_PREP)
constexpr size_t WS_GG = WS_GQKV + al256((size_t)MROWS * 3 * MIX_W * 4);
#else
constexpr size_t WS_GG = WS_GQKV + 256;
#endif
constexpr size_t WS_GB = WS_GG + al256((size_t)MROWS * 2 * GDN_H * 4);
constexpr size_t WS_SXBC = WS_GB + al256((size_t)MROWS * 2 * GDN_H * 4);
#if defined(TOKEN_SSD) || defined(NAIVE_PREP)
constexpr size_t WS_SDT = WS_SXBC + al256((size_t)MROWS * SSM_XBC * 4);
#else
constexpr size_t WS_SDT = WS_SXBC + 256;
#endif
constexpr size_t WS_SA = WS_SDT + al256((size_t)MROWS * 2 * SSM_H * 4);
constexpr size_t WS_AQ = WS_SA + al256((size_t)MROWS * 2 * SSM_H * 4);
#ifdef NAIVE_ATTN
constexpr size_t WS_AK = WS_AQ + al256((size_t)MROWS * MIX_W * 4);
constexpr size_t WS_OG = WS_AK + al256((size_t)MROWS * ATT_HKV * 128 * 4);
#else
constexpr size_t WS_AK = WS_AQ + 256;
constexpr size_t WS_OG = WS_AK + 256;
#endif
#if defined(TOKEN_GDN) || defined(TOKEN_SSD) || defined(NAIVE_MIXOUT)
constexpr size_t WS_OS = WS_OG + al256((size_t)2 * MROWS * MIX_W * 4);
constexpr size_t WS_SC = WS_OS + al256((size_t)2 * MROWS * MIX_W * 4);
#else
constexpr size_t WS_OS = WS_OG + 256;
constexpr size_t WS_SC = WS_OS + 256;
#endif
#ifdef NAIVE_ATTN
constexpr size_t WS_YA = WS_SC + al256((size_t)MROWS * ATT_HQ * SC_LD * 4);
#else
constexpr size_t WS_YA = WS_SC + 256;
#endif
constexpr size_t WS_YB = WS_YA + al256((size_t)MROWS * MIX_W * 2);
constexpr size_t WS_YC = WS_YB + al256((size_t)MROWS * MIX_W * 2);
constexpr size_t WS_M32 = WS_YC + al256((size_t)MROWS * MIX_W * 2);
constexpr size_t WS_MB = WS_M32 + al256((size_t)MROWS * D_MODEL * 4);
constexpr size_t WS_AQB = WS_MB + al256((size_t)MROWS * D_MODEL * 2);
constexpr size_t WS_AKB = WS_AQB + al256((size_t)MROWS * MIX_W * 2);
constexpr size_t GDN_NU_H = (size_t)BATCH * (CHAIN_LEN / 64) * GDN_H * 2;
constexpr size_t WS_GW = WS_AKB + al256((size_t)MROWS * ATT_HKV * 128 * 2);
constexpr size_t WS_GQD = WS_GW + al256(GDN_NU_H * 64 * 128 * 2);
constexpr size_t WS_GKDT = WS_GQD + al256(GDN_NU_H * 64 * 128 * 2);
constexpr size_t WS_GA = WS_GKDT + al256(GDN_NU_H * 128 * 64 * 2);
constexpr size_t WS_GUT = WS_GA + al256(GDN_NU_H * 64 * 64 * 2);
constexpr size_t WS_GGL = WS_GUT + al256(GDN_NU_H * 128 * 64 * 2);
constexpr size_t SSD_NU_H = (size_t)BATCH * (CHAIN_LEN / 64) * SSM_H * 2;
constexpr size_t WS_SBCB = WS_GGL + al256(GDN_NU_H * 4);
constexpr size_t WS_SSC = WS_SBCB + al256((size_t)MROWS * 2 * SSM_BC * 2);
constexpr size_t WS_SEA = WS_SSC + al256(SSD_NU_H * 8 * 64 * 16 * 2);
constexpr size_t WS_SDC = WS_SEA + al256(SSD_NU_H * 64 * 4);
constexpr size_t WS_OGB = WS_SDC + al256(SSD_NU_H * 4);
constexpr size_t WS_OSB = WS_OGB + al256((size_t)2 * MROWS * MIX_W * 2);
constexpr size_t WS_OSB2 = WS_OSB + al256((size_t)2 * MROWS * MIX_W * 2);
constexpr size_t WS_GQKVB = WS_OSB2 + al256((size_t)2 * MROWS * MIX_W * 2);
constexpr size_t WS_SXB = WS_GQKVB + al256((size_t)MROWS * 3 * MIX_W * 2);
constexpr size_t WS_SCF = WS_SXB + al256((size_t)MROWS * MIX_W * 2);
constexpr size_t WS_END_MIX = WS_SCF + al256((size_t)BATCH * (CHAIN_LEN / 64) * SSM_G * 2 * 8 * 512 * 2);
constexpr size_t NBND = (size_t)MROWS / 64 * 2;
constexpr size_t WS_BP = WS_R;
constexpr size_t WS_BU = WS_BP + al256(NBND * D_FF * 4);
constexpr size_t WS_BG = WS_BU + al256(NBND * D_FF * 2);
constexpr size_t WS_ACT = WS_BG + al256(NBND * D_FF * 2);
constexpr size_t WS_END_FFN = WS_ACT + al256((size_t)MROWS * D_FF * 2);
constexpr size_t WS_NEED = WS_END_MIX > WS_END_FFN ? WS_END_MIX : WS_END_FFN;

constexpr int NWAVES = 8, NTHREADS = NWAVES * 64;
#ifndef ATT_EARLY_N
#define ATT_EARLY_N 0
#endif
constexpr int ATT_EARLY = ATT_EARLY_N;
static_assert(ATT_EARLY <= ATT_UNITS_LAT, "early attention units are latent units");
constexpr int RING_BYTES = 131072, LDS_BYTES = 147456, MISC_OFF = LDS_BYTES - 1024;

enum { ST_INPROJ = 0, ST_PREP, ST_G1, ST_MIX, ST_MIXOUT, ST_MERGE, ST_OUT, ST_NORM2, ST_UP, ST_ACT, ST_DOWN, ST_NORM3, NSTEP };
constexpr int STEP0 = 2;
constexpr int TOTAL_STEPS = STEP0 + DEPTH * NSTEP;
#ifndef MK_LAUNCH_MODE
#define MK_LAUNCH_MODE 1
#endif

struct Args { Ptrs p; unsigned* ctl; int step_lo, step_hi; };
typedef const __attribute__((address_space(4))) Args* KArgs;
__device__ __forceinline__ KArgs fresh_args() { KArgs k = (KArgs)__builtin_amdgcn_kernarg_segment_ptr(); asm volatile("" : "+s"(k)); return k; }
#if defined(__HIP_DEVICE_COMPILE__)
#define PTRS() const Ptrs p = fresh_args()->p; int lane; asm volatile("v_mbcnt_lo_u32_b32 %0, -1, 0\n\tv_mbcnt_hi_u32_b32 %0, -1, %0" : "=v"(lane)); const int wave = wave_s; const int tid = wave * 64 + lane; \
    const size_t gtid = (size_t)blockIdx.x * NTHREADS + tid, NT = (size_t)G * NTHREADS; const int gwave = (int)blockIdx.x * NWAVES + wave, NGW = G * NWAVES; (void)lane; (void)wave; (void)gtid; (void)NT; (void)gwave; (void)NGW
#else
#define PTRS() const Ptrs p = a.p; const int tid = 0, lane = 0, wave = 0, gwave = 0, NGW = 1; const size_t gtid = 0, NT = 1; (void)tid; (void)lane; (void)wave; (void)gtid; (void)NT; (void)gwave; (void)NGW
#endif

constexpr int WT_I_IN = (D_MODEL / 64) * (P_IN / 32), WT_I_BR = (MIX_W / 64) * (D_MODEL / 32), WT_I_OUT = (D_MODEL / 64) * (D_MODEL / 32), WT_I_UP = (D_MODEL / 64) * (2 * D_FF / 32), WT_I_DN = (D_FF / 64) * (D_MODEL / 32);
constexpr int WT_I_ALL = WT_I_IN + 3 * WT_I_BR + WT_I_OUT + WT_I_UP + WT_I_DN;
template <class PT> __device__ __forceinline__ void weight_item(const PT& p, int l, int it, LAS float* scr, int lane) {
    int r = it;
    if (r < WT_I_IN) { const int nblk = P_IN / 32, k0 = 64 * (r / nblk), n0 = 32 * (r % nblk);
        transpose_item(p.w_in + (size_t)l * D_MODEL * P_IN, D_MODEL, P_IN, p.Wt_in + (size_t)l * NP_PAD * D_MODEL, k0, n0, inproj_dst_row0(n0), scr, lane); return; } r -= WT_I_IN;
    if (r < 3 * WT_I_BR) { const int br = r / WT_I_BR; r -= br * WT_I_BR; const int nblk = D_MODEL / 32, k0 = 64 * (r / nblk), n0 = 32 * (r % nblk);
        const float* w = (br == 0 ? p.w_br_a : br == 1 ? p.w_br_b : p.w_br_c) + (size_t)l * MIX_W * D_MODEL;
        transpose_item(w, 3 * MIX_W, D_MODEL, p.Wt_br + (size_t)l * 3 * D_MODEL * MIX_W + br * MIX_W, k0, n0, n0, scr, lane); return; } r -= 3 * WT_I_BR;
    if (r < WT_I_OUT) { const int nblk = D_MODEL / 32, k0 = 64 * (r / nblk), n0 = 32 * (r % nblk);
        transpose_item(p.w_out + (size_t)l * D_MODEL * D_MODEL, D_MODEL, D_MODEL, p.Wt_out + (size_t)l * D_MODEL * D_MODEL, k0, n0, n0, scr, lane); return; } r -= WT_I_OUT;
    if (r < WT_I_UP) { const int nblk = 2 * D_FF / 32, k0 = 64 * (r / nblk), n0 = 32 * (r % nblk);
        transpose_item(p.w_up + (size_t)l * D_MODEL * 2 * D_FF, D_MODEL, 2 * D_FF, p.Wt_up + (size_t)l * 2 * D_FF * D_MODEL, k0, n0, up_dst_row0(n0), scr, lane); return; } r -= WT_I_UP;
    { const int nblk = D_MODEL / 32, k0 = 64 * (r / nblk), n0 = 32 * (r % nblk);
        transpose_item(p.w_down + (size_t)l * D_FF * D_MODEL, D_FF, D_MODEL, p.Wt_down + (size_t)l * D_MODEL * D_FF, k0, n0, n0, scr, lane); }
}
template <class PT> __device__ __forceinline__ WtDesc weight_desc(const PT& p, int l, int it) {
    int r = it;
    if (r < WT_I_IN) { const int nblk = P_IN / 32, k0 = 64 * (r / nblk), n0 = 32 * (r % nblk); return WtDesc{p.w_in + (size_t)l * D_MODEL * P_IN, p.Wt_in + (size_t)l * NP_PAD * D_MODEL, D_MODEL, P_IN, k0, n0, inproj_dst_row0(n0)}; } r -= WT_I_IN;
    if (r < 3 * WT_I_BR) { const int br = r / WT_I_BR; r -= br * WT_I_BR; const int nblk = D_MODEL / 32, k0 = 64 * (r / nblk), n0 = 32 * (r % nblk);
        const float* w = (br == 0 ? p.w_br_a : br == 1 ? p.w_br_b : p.w_br_c) + (size_t)l * MIX_W * D_MODEL;
        return WtDesc{w, p.Wt_br + (size_t)l * 3 * D_MODEL * MIX_W + br * MIX_W, 3 * MIX_W, D_MODEL, k0, n0, n0}; } r -= 3 * WT_I_BR;
    if (r < WT_I_OUT) { const int nblk = D_MODEL / 32, k0 = 64 * (r / nblk), n0 = 32 * (r % nblk); return WtDesc{p.w_out + (size_t)l * D_MODEL * D_MODEL, p.Wt_out + (size_t)l * D_MODEL * D_MODEL, D_MODEL, D_MODEL, k0, n0, n0}; } r -= WT_I_OUT;
    if (r < WT_I_UP) { const int nblk = 2 * D_FF / 32, k0 = 64 * (r / nblk), n0 = 32 * (r % nblk); return WtDesc{p.w_up + (size_t)l * D_MODEL * 2 * D_FF, p.Wt_up + (size_t)l * 2 * D_FF * D_MODEL, D_MODEL, 2 * D_FF, k0, n0, up_dst_row0(n0)}; } r -= WT_I_UP;
    { const int nblk = D_MODEL / 32, k0 = 64 * (r / nblk), n0 = 32 * (r % nblk); return WtDesc{p.w_down + (size_t)l * D_FF * D_MODEL, p.Wt_down + (size_t)l * D_MODEL * D_FF, D_FF, D_MODEL, k0, n0, n0}; }
}
constexpr int FILL_A0 = ((MROWS / 256) * (NP_PAD / 256)) % 256, FILL_B0 = 3 * (NCTX / 256) * (D_MODEL / 256), FILL_C0 = ((MROWS / 256) * (2 * D_FF / 256)) % 256;
#ifndef FILL_NA
#define FILL_NA 14
#endif
#ifndef FILL_NB
#define FILL_NB 11
#endif
#ifndef FILL_NC
#define FILL_NC 19
#endif
constexpr int fill_min(int a, int b) { return a < b ? a : b; }
constexpr int WT_OWN = WT_I_ALL - WT_I_IN;
#ifndef FILL_NM
#define FILL_NM 512
#endif
constexpr int FILL_MCH = 16;
constexpr int FILL_EA = fill_min((256 - FILL_A0) * 8 * FILL_NA, WT_I_ALL), FILL_EM = fill_min(FILL_EA + FILL_NM * FILL_MCH, WT_I_ALL), FILL_EB = fill_min(FILL_EM + (256 - FILL_B0) * 8 * FILL_NB, WT_I_ALL), FILL_EC = fill_min(FILL_EB + (256 - FILL_C0) * 8 * FILL_NC, WT_I_ALL);
static_assert(FILL_A0 > 0 && FILL_C0 > 0, "fill slots");
static_assert(FILL_EM >= 3 * WT_I_BR && FILL_EB >= 3 * WT_I_BR + WT_I_OUT + WT_I_UP && FILL_EC >= WT_OWN, "a matrix must be complete before the phase that multiplies by it (branch: merge; up: up-projection; down: within the layer)");
static_assert(64 * 33 <= 2176 && 8 * 4352 * 4 <= 146432 - 1024, "fill scratch: two transpose tiles per wave inside the dynamic LDS below the control words");
__device__ __forceinline__ void weight_fill_ws(int l, int seg_b, int seg_e_in, int ws, int nws, LAS unsigned char* lds, int wv) {
#if defined(__HIP_DEVICE_COMPILE__)
    asm volatile("s_waitcnt vmcnt(0)" ::: "memory"); LDS_BARRIER();
    int l_; asm volatile("v_mbcnt_lo_u32_b32 %0, -1, 0\n\tv_mbcnt_hi_u32_b32 %0, -1, %0" : "=v"(l_));
    const int seg_e = (l == DEPTH - 1 && seg_e_in > WT_OWN) ? WT_OWN : seg_e_in;
#define WT_AT(f_) weight_desc(fresh_args()->p, (f_) < WT_OWN ? l : l + 1, (f_) < WT_OWN ? WT_I_IN + (f_) : (f_) - WT_OWN)
    LAS float* scr = (LAS float*)lds + wv * 4352;
    int it = seg_b + ws;
    if (it < seg_e) { float wa[32], wb[32]; WtDesc da = WT_AT(it), db = da; transpose_load(da, l_, wa);
        for (;;) { const int it2 = it + nws; const bool h2 = it2 < seg_e;
            if (h2) { db = WT_AT(it2); transpose_load(db, l_, wb); }
            transpose_finish(da, wa, scr, l_);
            if (!h2) break;
            const int it3 = it2 + nws; const bool h3 = it3 < seg_e;
            if (h3) { da = WT_AT(it3); transpose_load(da, l_, wa); }
            transpose_finish(db, wb, scr + 2176, l_);
            if (!h3) break;
            it = it3; } }
#undef WT_AT
    LDS_BARRIER();
#endif
}
__device__ __forceinline__ void weight_fill(int l, int seg_b, int seg_e, int wg0, LAS unsigned char* lds, int wv) { weight_fill_ws(l, seg_b, seg_e, ((int)blockIdx.x - wg0) * 8 + wv, (256 - wg0) * 8, lds, wv); }
__global__ void __launch_bounds__(NTHREADS, 2) fwd(Args a) {
    extern __shared__ __attribute__((aligned(16))) unsigned char lds_raw[];
    LAS unsigned char* lds = (LAS unsigned char*)lds_raw;
    volatile LAS unsigned* MISC = (volatile LAS unsigned*)(lds + MISC_OFF);
    const int G = gridDim.x;
    const int wave_s = __builtin_amdgcn_readfirstlane((int)threadIdx.x >> 6);
    for (int u = threadIdx.x; u < (LDS_BYTES - MISC_OFF) / 4; u += NTHREADS) ((LAS unsigned*)(lds + MISC_OFF))[u] = 0u;
    __syncthreads();
    const bool multi = (a.step_hi - a.step_lo) > 1;
    if (multi) (void)xcd_barrier_post(a.ctl + 4096, MISC + 8);
#define IN(k) (fresh_args()->step_lo <= (k) && (k) < fresh_args()->step_hi)
#ifdef ONLY_STEP
#define EN(k) ((k) == ONLY_STEP)
#elif defined(SKIP_MASK)
#define EN(k) (!((SKIP_MASK >> (k)) & 1))
#else
#define EN(k) true
#endif
#define SEAM(k) do { if (IN((k) + 1)) { XcdBarrier bl; bl.bar = fresh_args()->ctl + 4096; bl.x = xb_xcc_id(); bl.st = (volatile LAS unsigned*)(lds + MISC_OFF) + 8; xcd_barrier(bl); } } while (0)
#define FOR_ITEMS(i, n) for (size_t i = gtid; i < (size_t)(n); i += NT)
#define FRESH_TID(name) int name; { int l_; asm volatile("v_mbcnt_lo_u32_b32 %0, -1, 0\n\tv_mbcnt_hi_u32_b32 %0, -1, %0" : "=v"(l_)); name = wave_s * 64 + l_; }

    if (EN(0) && IN(0)) {
        PTRS();
        LAS float* scr = (LAS float*)lds + wave * 4096;
        FOR_ITEMS(i, (size_t)GRID_W * 32) { const float ang = (float)(i >> 5) * rope_inv_freq((int)(i & 31)); p.ROPE[2 * i] = cosf(ang); p.ROPE[2 * i + 1] = sinf(ang); }
#ifdef FILL_OFF
        for (int l = 0; l < DEPTH; ++l) for (int it = gwave; it < WT_I_ALL; it += NGW) weight_item(fresh_args()->p, l, it, scr, lane);
#else
        for (int it = gwave; it < WT_I_IN; it += NGW) weight_item(fresh_args()->p, 0, it, scr, lane);
        for (int l = 1; l < DEPTH; ++l) for (int it = FILL_EC - WT_OWN + gwave; it < WT_I_IN; it += NGW) weight_item(fresh_args()->p, l, it, scr, lane);
#endif
        for (int l = 0; l < DEPTH; ++l) {
            { bf16* z = p.Wt_in + ((size_t)l * NP_PAD + NP_MAIN + PF_N) * D_MODEL; const size_t n16 = (size_t)(NP_PAD - NP_MAIN - PF_N) * D_MODEL / 8;
                FOR_ITEMS(i, n16) *(vu4*)(z + i * 8) = (vu4){0u, 0u, 0u, 0u}; }
        }
        __syncthreads();
        LAS float* sl = (LAS float*)lds;
        LAS float* red = sl + 3 * D_MODEL;
        for (int i = tid; i < (BATCH + 1) * D_MODEL; i += NTHREADS) sl[i] = silu_f(i < BATCH * D_MODEL ? p.c[i] : p.c_ctx[i - BATCH * D_MODEL]);
        __syncthreads();
        for (int it = (int)blockIdx.x; it < DEPTH * (D6 / 64); it += G) {
            const int l = it / (D6 / 64), n0 = (it % (D6 / 64)) * 64;
            float acc0 = 0.f, acc1 = 0.f, acc2 = 0.f;
            const float* w = p.w_ada + ((size_t)l * D_MODEL + wave * (D_MODEL / 8)) * D6 + n0 + lane;
            for (int k0 = 0; k0 < D_MODEL / 8; k0 += 32) { float wv[32];
#pragma unroll
                for (int j = 0; j < 32; ++j) wv[j] = __builtin_nontemporal_load(w + (size_t)(k0 + j) * D6);
#pragma unroll
                for (int j = 0; j < 32; ++j) { const int kk = wave * (D_MODEL / 8) + k0 + j; acc0 += sl[kk] * wv[j]; acc1 += sl[D_MODEL + kk] * wv[j]; acc2 += sl[2 * D_MODEL + kk] * wv[j]; } }
            red[(wave * 3 + 0) * 64 + lane] = acc0; red[(wave * 3 + 1) * 64 + lane] = acc1; red[(wave * 3 + 2) * 64 + lane] = acc2;
            __syncthreads();
            if (tid < 192) { const int m = tid >> 6, ln = tid & 63; float s = 0.f;
#pragma unroll
                for (int w8 = 0; w8 < 8; ++w8) s += red[(w8 * 3 + m) * 64 + ln];
                p.MOD[((size_t)l * (BATCH + 1) + m) * D6 + n0 + ln] = s + p.b_ada[(size_t)l * D6 + n0 + ln]; }
            __syncthreads();
        }
        SEAM(0);
    }
    if (EN(1) && IN(1)) {
        PTRS();
        for (int r = gwave; r < MROWS; r += NGW) { vf4 x[NV4]; row_load(r < NLAT ? p.x + (size_t)r * D_MODEL : p.ctx + (size_t)(r - NLAT) * D_MODEL, lane, x);
            norm_h_wave(p, 0, r, 0, lane, x); }
        SEAM(1);
    }

    for (int l = 0; l < DEPTH; ++l) {
        const int sb = STEP0 + l * NSTEP;
        if (sb + NSTEP <= fresh_args()->step_lo || sb >= fresh_args()->step_hi) continue;
        const bool last = (l == DEPTH - 1);
        const int MR = last ? NLAT : MROWS;

        if (EN(2 + ST_INPROJ) && IN(sb + ST_INPROJ)) {
            PTRS();
            pg8::Gemm g{p.H, p.Wt_in + (size_t)l * NP_PAD * D_MODEL, MROWS, NP_PAD, D_MODEL, D_MODEL}; pg8::StaticOrder S; S.init(MROWS, NP_PAD, G, (int)blockIdx.x);
            pg8::EpiInProj E{p.P, p.PF};
            pg8::gemm_phase<pg8::EpiInProj, pg8::StaticOrder, true, true>(lds, g, S, E, tid);
#ifndef FILL_OFF
            if ((int)blockIdx.x >= FILL_A0) weight_fill(l, 0, FILL_EA, FILL_A0, lds, wave_s);
#endif
            SEAM(sb + ST_INPROJ);
        }

        if (EN(2 + ST_PREP) && IN(sb + ST_PREP)) {
            PTRS();
#ifdef NAIVE_PREP
            FOR_ITEMS(i, (size_t)MROWS * 3 * GDN_H) prep_gdn_item(p, l, (int)(i / (3 * GDN_H)), (int)(i % (3 * GDN_H)));
            FOR_ITEMS(i, (size_t)MROWS * 2 * GDN_H) prep_gdn_gb_item(p, l, (int)(i / (2 * GDN_H)), (int)(i % (2 * GDN_H)));
            FOR_ITEMS(i, (size_t)MROWS * SSM_XBC) prep_ssd_item(p, l, (int)(i / SSM_XBC), (int)(i % SSM_XBC));
            FOR_ITEMS(i, (size_t)MROWS * 2 * SSM_H) prep_ssd_dt_item(p, l, (int)(i / (2 * SSM_H)), (int)(i % (2 * SSM_H)));
#else
            for (int it = gwave; it < (MROWS / PREP_RB) * PREP_NPASS; it += NGW) prep_conv_block_wave(p, l, it / PREP_NPASS, it % PREP_NPASS, lane);
#endif
#ifdef NAIVE_ATTN
            FOR_ITEMS(i, (size_t)MROWS * (ATT_HQ + ATT_HKV)) prep_attn_item(p, (int)(i / (ATT_HQ + ATT_HKV)), (int)(i % (ATT_HQ + ATT_HKV)));
#endif
            SEAM(sb + ST_PREP);
        }

        if (EN(2 + ST_G1) && IN(sb + ST_G1)) {
            PTRS();
            {
                constexpr int NG = BATCH * NCH * GDN_H, NS = SSD_LOCAL_UNITS; unsigned* ctr = fresh_args()->ctl + 8192 + 64 * (DEPTH + l);
                for (;;) { if (tid == 0) MISC[16] = __hip_atomic_fetch_add(ctr, 1u, __ATOMIC_RELAXED, __HIP_MEMORY_SCOPE_AGENT);
                    LDS_BARRIER(); const int u = (int)MISC[16]; LDS_BARRIER();
                    if (u >= NG + NS + ATT_EARLY) break;
                    int tl = tid; asm volatile("" : "+v"(tl));
                    if (u < ATT_EARLY) attn_unit(p, l, (LAS bf16*)lds, u, tl);
                    else if (u < ATT_EARLY + NS) ssd_local_unit(p, lds, u - ATT_EARLY, tl); else gdn_g1_unit(p, lds, u - ATT_EARLY - NS, tl); } }
            SEAM(sb + ST_G1);
        }

        if (EN(2 + ST_MIX) && IN(sb + ST_MIX)) {
            PTRS();
            constexpr int N_GDN_WG = BATCH * GDN_H * 2 * 4, N_SSD_WG = BATCH * SSM_H * 2;
            const int wg = (int)blockIdx.x;
#ifdef TOKEN_GDN
            if (wg < N_GDN_WG) gdn_token_wg(p, (LAS float*)lds, wg >> 2, wg & 3, tid);
#else
            if (wg < N_GDN_WG) gdn_scan_wg(p, lds, (wg & 7) + 8 * (wg >> 5), (wg >> 3) & 3, tid);
#endif
#ifdef TOKEN_SSD
            else if (wg < N_GDN_WG + N_SSD_WG) ssd_token_wg(p, (LAS float*)lds, wg - N_GDN_WG, tid);
#else
            else if (wg < N_GDN_WG + N_SSD_WG) ssd_scan_wg(p, lds, wg - N_GDN_WG, tid);
#endif
            {
                const int nu = ATT_UNITS_LAT + (last ? 0 : ATT_UNITS_CTX); unsigned* ctr = fresh_args()->ctl + 8192 + 64 * l;
                for (;;) { if (tid == 0) MISC[16] = ATT_EARLY + __hip_atomic_fetch_add(ctr, 1u, __ATOMIC_RELAXED, __HIP_MEMORY_SCOPE_AGENT);
                    LDS_BARRIER(); const int u = (int)MISC[16]; LDS_BARRIER();
                    if (u >= nu) break;
                    attn_unit(p, l, (LAS bf16*)lds, u, tid); } }
#ifndef FILL_OFF
            {
                constexpr int NCH_M = (FILL_EM - FILL_EA + FILL_MCH - 1) / FILL_MCH; unsigned* ctr = fresh_args()->ctl + 8192 + 64 * (2 * DEPTH + l);
                const int em = (last && FILL_EM > WT_OWN) ? WT_OWN : FILL_EM;
                for (;;) { if (tid == 0) MISC[16] = __hip_atomic_fetch_add(ctr, 1u, __ATOMIC_RELAXED, __HIP_MEMORY_SCOPE_AGENT);
                    LDS_BARRIER(); const int ch = (int)MISC[16]; LDS_BARRIER();
                    const int fb = FILL_EA + ch * FILL_MCH; if (ch >= NCH_M || fb >= em) break;
                    weight_fill_ws(l, fb, fb + FILL_MCH < em ? fb + FILL_MCH : em, wave_s, 8, lds, wave_s); } }
#endif
            SEAM(sb + ST_MIX);
        }

        if (EN(2 + ST_MIXOUT) && IN(sb + ST_MIXOUT)) {
            PTRS();
#ifdef NAIVE_MIXOUT
            FOR_ITEMS(i, (size_t)MROWS * GDN_H) gdn_out_item(p, l, (int)(i / GDN_H), (int)(i % GDN_H));
            FOR_ITEMS(i, (size_t)MROWS * SSM_G) ssd_out_item(p, l, (int)(i / SSM_G), (int)(i % SSM_G));
#else
            for (int r = gwave; r < (last ? NLAT : MROWS); r += NGW) mixout_row_wave(p, l, r, lane);
#endif
            SEAM(sb + ST_MIXOUT);
        }

        if (EN(2 + ST_MERGE) && IN(sb + ST_MERGE)) {
            PTRS();
            { pg8::Gemm g{p.YA, p.Wt_br + (size_t)l * 3 * D_MODEL * MIX_W, NLAT, D_MODEL, 3 * MIX_W, 3 * MIX_W}; pg8::StaticOrder S; S.init(NLAT, D_MODEL, G, (int)blockIdx.x);
              pg8::EpiMerge3 E{p.P + C_MG, p.MB};
              pg8::gemm_phase<pg8::EpiMerge3, pg8::StaticOrder, true, true>(lds, g, S, E, tid); }
            if (!last) { pg8::Gemm g{p.YA, p.Wt_br + (size_t)l * 3 * D_MODEL * MIX_W, MROWS, D_MODEL, MIX_W, 3 * MIX_W}; pg8::CtxMergeOrder S{(int)blockIdx.x};
              pg8::EpiMerge E{p.P + C_MG, p.TB};
              FRESH_TID(tid2); pg8::gemm_phase<pg8::EpiMerge, pg8::CtxMergeOrder, true, true>(lds, g, S, E, tid2); }
#ifndef FILL_OFF
            if ((int)blockIdx.x >= FILL_B0) weight_fill(l, FILL_EM, FILL_EB, FILL_B0, lds, wave_s);
#endif
            SEAM(sb + ST_MERGE);
        }

        if (EN(2 + ST_OUT) && IN(sb + ST_OUT)) {
            PTRS();
            { pg8::Gemm g{p.MB, p.Wt_out + (size_t)l * D_MODEL * D_MODEL, NLAT, D_MODEL, D_MODEL, D_MODEL}; pg8::StaticOrder S; S.init(NLAT, D_MODEL, G, (int)blockIdx.x);
              pg8::EpiBf16Plain E{p.MIXb, D_MODEL};
              pg8::gemm_phase<pg8::EpiBf16Plain, pg8::StaticOrder, true, true>(lds, g, S, E, tid); }
            if (!last) {
                pg8::Gemm g{p.TB, p.Wt_out + (size_t)l * D_MODEL * D_MODEL, 3 * NCTX, D_MODEL, pg8::SPLIT_KS, D_MODEL}; pg8::SplitOrder3 S{G, (int)blockIdx.x};
                pg8::EpiSlab3 E{p.SLAB};
                FRESH_TID(tid2); pg8::gemm_phase<pg8::EpiSlab3, pg8::SplitOrder3, true, true>(lds, g, S, E, tid2); }
            SEAM(sb + ST_OUT);
        }

        if (EN(2 + ST_NORM2) && IN(sb + ST_NORM2)) {
            PTRS();
            for (int r = gwave; r < MR; r += NGW) { int ll = lane; asm volatile("" : "+v"(ll)); vf4 x[NV4]; row_load(l > 0 ? p.X + (size_t)r * D_MODEL : (r < NLAT ? p.x + (size_t)r * D_MODEL : p.ctx + (size_t)(r - NLAT) * D_MODEL), ll, x); resid_wave(p, l, r, 0, ll, x, 3 * pg8::OUT_NS);
                row_store(p.X + (size_t)r * D_MODEL, ll, x); norm_h_wave(p, l, r, 1, ll, x); }
            SEAM(sb + ST_NORM2);
        }

        if (EN(2 + ST_UP) && IN(sb + ST_UP)) {
            PTRS();
            pg8::Gemm g{p.H, p.Wt_up + (size_t)l * 2 * D_FF * D_MODEL, MR, 2 * D_FF, D_MODEL, D_MODEL}; pg8::StaticOrder S; S.init(MR, 2 * D_FF, G, (int)blockIdx.x);
            pg8::EpiAct E{p.ACT, p.BP, p.BU, p.BG, p.ffn_conv_w + (size_t)l * 3 * D_FF, p.ffn_conv_b + (size_t)l * D_FF};
            pg8::gemm_phase<pg8::EpiAct, pg8::StaticOrder, true, true>(lds, g, S, E, tid);
#ifndef FILL_OFF
            if ((int)blockIdx.x >= FILL_C0) weight_fill(l, FILL_EB, FILL_EC, FILL_C0, lds, wave_s);
#endif
            SEAM(sb + ST_UP);
        }

        if (EN(2 + ST_ACT) && IN(sb + ST_ACT)) { PTRS();
            for (int it = (int)gtid; it < (MR / 64 * 2) * (D_FF / 4); it += (int)NT) act_fix_item(p, l, it / (D_FF / 4), (it % (D_FF / 4)) * 4);
            SEAM(sb + ST_ACT); }

        if (EN(2 + ST_DOWN) && IN(sb + ST_DOWN)) {
            PTRS();
            { pg8::Gemm g{p.ACT, p.Wt_down + (size_t)l * D_MODEL * D_FF, NLAT, D_MODEL, D_FF, D_FF}; pg8::StaticOrder S; S.init(NLAT, D_MODEL, G, (int)blockIdx.x);
              pg8::EpiBf16Plain E{p.MIXb, D_MODEL};
              pg8::gemm_phase<pg8::EpiBf16Plain, pg8::StaticOrder, true, true>(lds, g, S, E, tid); }
            if (!last) {
                pg8::Gemm g{p.ACT, p.Wt_down + (size_t)l * D_MODEL * D_FF, MROWS, D_MODEL, pg8::SPLIT_KS, D_FF}; pg8::SplitOrder S{pg8::DOWN_NS, G, (int)blockIdx.x};
                pg8::EpiSlab E{p.SLAB};
                FRESH_TID(tid2); pg8::gemm_phase<pg8::EpiSlab, pg8::SplitOrder, true, true>(lds, g, S, E, tid2); }
            SEAM(sb + ST_DOWN);
        }

        if (EN(2 + ST_NORM3) && IN(sb + ST_NORM3)) {
            PTRS();
            for (int r = gwave; r < (last ? NLAT : MROWS); r += NGW) { int ll = lane; asm volatile("" : "+v"(ll)); vf4 x[NV4]; row_load(p.X + (size_t)r * D_MODEL, ll, x); resid_wave(p, l, r, 1, ll, x, pg8::DOWN_NS);
                if (last) row_store(p.out + (size_t)r * D_MODEL, ll, x);
                else { row_store(p.X + (size_t)r * D_MODEL, ll, x); norm_h_wave(p, l + 1, r, 0, ll, x); } }
            SEAM(sb + ST_NORM3);
        }
    }
#undef IN
#undef SEAM
#undef FOR_ITEMS
}

extern "C" void kernel_launch(void* const* d_in, const int* in_sizes, int n_in, void* d_out, int out_size, void* d_ws, size_t ws_size, hipStream_t stream) {
    static int grid = 0;
    if (grid == 0) {
        if (n_in != 30 || in_sizes[0] != NLAT * D_MODEL || out_size != NLAT * D_MODEL || ws_size < WS_NEED) {
            fprintf(stderr, "kernel_launch: unexpected problem: n_in %d in0 %d out %d ws %zu (need %zu); nothing launched\n", n_in, n_in > 0 ? in_sizes[0] : -1, out_size, ws_size, (size_t)WS_NEED); grid = -1; return; }
        int dev = 0, cus = 0;
        if (hipGetDevice(&dev) != hipSuccess || hipDeviceGetAttribute(&cus, hipDeviceAttributeMultiprocessorCount, dev) != hipSuccess) { grid = -1; return; }
        if (hipFuncSetAttribute((const void*)fwd, hipFuncAttributeMaxDynamicSharedMemorySize, LDS_BYTES) != hipSuccess) { fprintf(stderr, "kernel_launch: hipFuncSetAttribute failed\n"); grid = -1; return; }
        int per_cu = 0;
        if (hipOccupancyMaxActiveBlocksPerMultiprocessor(&per_cu, (const void*)fwd, NTHREADS, LDS_BYTES) != hipSuccess || per_cu < 1) fprintf(stderr, "kernel_launch: occupancy query reports %d\n", per_cu);
        (void)hipGetLastError();
        grid = cus;
        if (grid != 256) { fprintf(stderr, "kernel_launch: built for a 256-CU device (workgroup roles in the mixer phase); got %d; nothing launched\n", cus); grid = -1; return; }
    }
    if (grid < 0) return;
    unsigned char* ws = (unsigned char*)d_ws;
    if (hipMemsetAsync(ws + WS_CTL, 0, CTL_BYTES, stream) != hipSuccess) return;
    Args a{};
    const float** pi = (const float**)&a.p;
    for (int i = 0; i < 30; ++i) pi[i] = (const float*)d_in[i];
    Ptrs& p = a.p;
    p.out = (float*)d_out;
    p.Wt_in = (bf16*)(ws + WS_WIN); p.Wt_br = (bf16*)(ws + WS_WBR); p.Wt_out = (bf16*)(ws + WS_WOUT); p.Wt_up = (bf16*)(ws + WS_WUP); p.Wt_down = (bf16*)(ws + WS_WDOWN);
    p.MOD = (float*)(ws + WS_MOD); p.ROPE = p.MOD + (size_t)DEPTH * (BATCH + 1) * D6; p.X = (float*)(ws + WS_X); p.H = (bf16*)(ws + WS_H); p.MIX = (float*)(ws + WS_MIX); p.MIXb = (bf16*)(ws + WS_MIX);
    p.SLAB = (float*)(ws + WS_SLAB); p.TB = (bf16*)(ws + WS_TB);
    p.OGb = (bf16*)(ws + WS_OGB); p.OSb = (bf16*)(ws + WS_OSB); p.OSb2 = (bf16*)(ws + WS_OSB2); p.GQKVb = (bf16*)(ws + WS_GQKVB); p.SXb = (bf16*)(ws + WS_SXB);
    p.P = (bf16*)(ws + WS_P); p.PF = (float*)(ws + WS_PF); p.GQKV = (float*)(ws + WS_GQKV); p.GG = (float*)(ws + WS_GG); p.GB = (float*)(ws + WS_GB);
    p.SXBC = (float*)(ws + WS_SXBC); p.SDT = (float*)(ws + WS_SDT); p.SA = (float*)(ws + WS_SA); p.AQ = (float*)(ws + WS_AQ); p.AK = (float*)(ws + WS_AK);
    p.OG = (float*)(ws + WS_OG); p.OS = (float*)(ws + WS_OS); p.SC = (float*)(ws + WS_SC); p.YA = (bf16*)(ws + WS_YA); p.YB = p.YA + MIX_W; p.YC = p.YA + 2 * MIX_W;
    p.SBCb = (bf16*)(ws + WS_SBCB); p.SSC = (bf16*)(ws + WS_SSC); p.SEA = (float*)(ws + WS_SEA); p.SEAb = (bf16*)(ws + WS_SEA); p.SDC = (float*)(ws + WS_SDC); p.SCF = (bf16*)(ws + WS_SCF);
    p.GW = (bf16*)(ws + WS_GW); p.GQd = (bf16*)(ws + WS_GQD); p.GKdT = (bf16*)(ws + WS_GKDT); p.GA = (bf16*)(ws + WS_GA); p.GUT = (bf16*)(ws + WS_GUT); p.GGL = (float*)(ws + WS_GGL);
    p.AQb = (bf16*)(ws + WS_AQB); p.AKb = (bf16*)(ws + WS_AKB);
    p.M32 = (float*)(ws + WS_M32); p.MB = (bf16*)(ws + WS_MB); p.UG = nullptr; p.ACT = (bf16*)(ws + WS_ACT); p.BP = (float*)(ws + WS_BP); p.BU = (bf16*)(ws + WS_BU); p.BG = (bf16*)(ws + WS_BG);
    a.ctl = (unsigned*)(ws + WS_CTL);
#if MK_LAUNCH_MODE == 1
    a.step_lo = 0; a.step_hi = TOTAL_STEPS;
    hipLaunchKernelGGL(fwd, dim3(grid), dim3(NTHREADS), LDS_BYTES, stream, a);
#else
    for (int s = 0; s < TOTAL_STEPS; ++s) { a.step_lo = s; a.step_hi = s + 1; hipLaunchKernelGGL(fwd, dim3(grid), dim3(NTHREADS), LDS_BYTES, stream, a); }
#endif
    const hipError_t le = hipPeekAtLastError();
    if (le != hipSuccess) fprintf(stderr, "kernel_launch: launch failed: %s\n", hipGetErrorName(le));
}
```

```cpp
#include <hip/hip_runtime.h>
#include <cstdio>
#include <cstdint>
#include <type_traits>
#define MK_LAUNCH_MODE 1
#define FILL_NA 10
#define FILL_NB 14
#define FILL_NC 4
#define FILL_NM 256
#include <cstdint>
#include <cstddef>
#include <cmath>
#ifdef HOST_TEST
#define HD inline
#define CFENCE() do {} while (0)
#else
#define HD __host__ __device__ __forceinline__
#if defined(__HIP_DEVICE_COMPILE__)
#define CFENCE() asm volatile("" ::: "memory")
#else
#define CFENCE() do {} while (0)
#endif
#endif

#ifndef CFG_SMALL
constexpr int D_MODEL = 2048, BATCH = 2, SEQ = 4096, DEPTH = 4, CTX_LEN = 256, D_FF = 5632;
#else
constexpr int D_MODEL = 1024, BATCH = 2, SEQ = 512, DEPTH = 2, CTX_LEN = 128, D_FF = 512;
#endif
constexpr int GRID_W = 64, WINDOW = 128;
constexpr float EPS = 1e-6f;
constexpr int MIX_W = D_MODEL / 2, GDN_H = MIX_W / 128, SSM_H = MIX_W / 64, SSM_G = 2, SSM_N = 128, SSM_P = 64, SSM_HPG = SSM_H / SSM_G;
constexpr int ATT_HQ = MIX_W / 128, ATT_HKV = 2, ATT_GRP = ATT_HQ / ATT_HKV;
constexpr int SSM_BC = SSM_G * SSM_N, SSM_XBC = MIX_W + 2 * SSM_BC;
constexpr int NLAT = BATCH * SEQ, NCTX = BATCH * CTX_LEN, MROWS = NLAT + NCTX;
constexpr int CHAIN_LEN = CTX_LEN + SEQ;
constexpr int R_QKV = 0, R_GATE = 3 * MIX_W, R_A = 4 * MIX_W, R_B = R_A + 2 * GDN_H, R_Z = R_B + 2 * GDN_H, R_XBC = R_Z + MIX_W, R_DT = R_XBC + SSM_XBC,
              R_AQ = R_DT + 2 * SSM_H, R_AKV = R_AQ + MIX_W, R_MG = R_AKV + 2 * ATT_HKV * 128, P_IN = R_MG + 3 * D_MODEL;
constexpr int C_QKV = 0, C_GATE = 3 * MIX_W, C_Z = 4 * MIX_W, C_XBC = 5 * MIX_W, C_AQ = C_XBC + SSM_XBC, C_AKV = C_AQ + MIX_W, C_MG = C_AKV + 512, NP_MAIN = C_MG + 3 * D_MODEL;
constexpr int PF_A = 0, PF_B = 2 * GDN_H, PF_DT = 4 * GDN_H, PF_N = 4 * GDN_H + 2 * SSM_H;
constexpr int NP_PAD = NP_MAIN + 256;
static_assert(NP_MAIN % 256 == 0 && PF_N <= 256 && MROWS % 256 == 0 && (2 * D_FF) % 256 == 0 && D_FF % 256 == 0, "tile shapes");
static_assert(P_IN == NP_MAIN + PF_N, "column bookkeeping");
constexpr int D6 = 6 * D_MODEL;

typedef unsigned short bf16;
HD float bf2f(bf16 b) { union { unsigned u; float f; } c; c.u = ((unsigned)b) << 16; return c.f; }
HD bf16 f2bf(float f) { union { unsigned u; float f; } c; c.f = f; unsigned u = c.u; u += 0x7FFFu + ((u >> 16) & 1u); return (bf16)(u >> 16); }
HD float silu_f(float x) { return x / (1.0f + expf(-x)); }
HD float sigmoid_f(float x) { return 1.0f / (1.0f + expf(-x)); }
#if defined(__HIP_DEVICE_COMPILE__)
HD float softplus_f(float x) { return x > 20.0f ? x : __logf(1.0f + __expf(x)); }
#else
HD float softplus_f(float x) { return x > 20.0f ? x : log1pf(expf(x)); }
#endif

struct Ptrs {
    const float *x, *c, *ctx, *c_ctx, *w_ada, *b_ada, *g_pre1, *w_in, *gdn_conv_w, *gdn_a_log, *gdn_dt_bias, *gdn_norm, *ssm_conv_w, *ssm_conv_b, *ssm_a_log,
        *ssm_dt_bias, *ssm_d, *ssm_norm, *attn_sink, *w_br_a, *w_br_b, *w_br_c, *w_out, *g_post1, *g_pre2, *w_up, *ffn_conv_w, *ffn_conv_b, *w_down, *g_post2;
    float* out;
    bf16 *Wt_in, *Wt_br, *Wt_out, *Wt_up, *Wt_down;
    float* ROPE;
    float* MOD;
    float* X;
    bf16* H;
    bf16* P;
    float* PF;
    float *GQKV, *GG, *GB;
    float *SXBC, *SDT, *SA;
    float *AQ, *AK;
    bf16 *GW, *GQd, *GKdT, *GA, *GUT; float* GGL;
    bf16 *SBCb, *SSC, *SEAb, *SCF; float *SEA, *SDC;
    bf16 *MIXb, *OGb, *OSb, *OSb2, *GQKVb, *SXb;
    bf16 *AQb, *AKb;
    float *OG, *OS;
    float* SC;
    bf16 *YA, *YB, *YC;
    float* M32;
    bf16* MB;
    float* MIX;
    bf16* UG;
    bf16* ACT;
    bf16* TB;
    float* SLAB;
    float* BP; bf16 *BU, *BG;
};
constexpr int SC_LD = 2 * WINDOW + 1 + CTX_LEN + 3;

HD void row_info(int r, int& b, int& t, int& len, bool& is_ctx) {
    if (r < NLAT) { b = r / SEQ; t = r % SEQ; len = SEQ; is_ctx = false; } else { const int q = r - NLAT; b = q / CTX_LEN; t = q % CTX_LEN; len = CTX_LEN; is_ctx = true; }
}
HD int mod_row(int r) { return r < NLAT ? r / SEQ : BATCH; }

HD int inproj_src_col(int np) {
    if (np < C_Z) return np;
    if (np < NP_MAIN) return np + 4 * GDN_H + (np >= C_AQ ? 2 * SSM_H : 0);
    const int j = np - NP_MAIN;
    if (j < PF_DT) return R_A + j;
    if (j < PF_N) return R_DT + (j - PF_DT);
    return -1;
}
HD void wcvt_item(const float* W, int K, int N, bf16* Wt, int np, int k8, bool inproj) {
    const int n = inproj ? inproj_src_col(np) : np;
    for (int j = 0; j < 8; ++j) { const int k = k8 * 8 + j; Wt[(size_t)np * K + k] = (n < 0) ? (bf16)0 : f2bf(W[(size_t)k * N + n]); }
}

HD void mod_item(const Ptrs& p, int l, int n) {
    float acc[BATCH + 1];
    for (int m = 0; m <= BATCH; ++m) acc[m] = 0.f;
    for (int k = 0; k < D_MODEL; ++k) {
        const float w = p.w_ada[((size_t)l * D_MODEL + k) * D6 + n];
        for (int m = 0; m < BATCH; ++m) acc[m] += silu_f(p.c[m * D_MODEL + k]) * w;
        acc[BATCH] += silu_f(p.c_ctx[k]) * w;
    }
    for (int m = 0; m <= BATCH; ++m) p.MOD[((size_t)l * (BATCH + 1) + m) * D6 + n] = acc[m] + p.b_ada[(size_t)l * D6 + n];
}
HD void xinit_item(const Ptrs& p, size_t i) { p.X[i] = i < (size_t)NLAT * D_MODEL ? p.x[i] : p.ctx[i - (size_t)NLAT * D_MODEL]; }

HD float row_rstd(const float* v, int n) { float s = 0.f; for (int j = 0; j < n; ++j) s += v[j] * v[j]; return 1.0f / sqrtf(s / (float)n + EPS); }
HD void norm_to_h_row(const Ptrs& p, int l, int r, int which) {
    const float* xr = p.X + (size_t)r * D_MODEL; const float* g = (which ? p.g_pre2 : p.g_pre1) + (size_t)l * D_MODEL;
    const float* mod = p.MOD + ((size_t)l * (BATCH + 1) + mod_row(r)) * D6 + (which ? 3 * D_MODEL : 0);
    const float rs = row_rstd(xr, D_MODEL);
    for (int j = 0; j < D_MODEL; ++j) p.H[(size_t)r * D_MODEL + j] = f2bf(xr[j] * rs * g[j] * (1.0f + mod[D_MODEL + j]) + mod[j]);
}
HD void resid_row(const Ptrs& p, int l, int r, int which, bool to_out) {
    const float* yr = p.MIX + (size_t)r * D_MODEL; const float* g = (which ? p.g_post2 : p.g_post1) + (size_t)l * D_MODEL;
    const float* gate = p.MOD + ((size_t)l * (BATCH + 1) + mod_row(r)) * D6 + (which ? 5 * D_MODEL : 2 * D_MODEL);
    const float rs = row_rstd(yr, D_MODEL);
    float* xr = p.X + (size_t)r * D_MODEL;
    for (int j = 0; j < D_MODEL; ++j) { const float v = xr[j] + gate[j] * (yr[j] * rs * g[j]); xr[j] = v; if (to_out && r < NLAT) p.out[(size_t)r * D_MODEL + j] = v; }
}

HD float conv3_p(const Ptrs& p, int r, int col, const float* w, int wld, int j) {
    int b, t, len; bool ic; row_info(r, b, t, len, ic);
    float y = w[wld + j] * bf2f(p.P[(size_t)r * NP_MAIN + col]);
    if (t > 0) y += w[j] * bf2f(p.P[(size_t)(r - 1) * NP_MAIN + col]);
    if (t < len - 1) y += w[2 * wld + j] * bf2f(p.P[(size_t)(r + 1) * NP_MAIN + col]);
    return y;
}
HD void prep_gdn_item(const Ptrs& p, int l, int r, int grp) {
    const float* w = p.gdn_conv_w + (size_t)l * 3 * (3 * MIX_W);
    float sc = 1.0f;
    if (grp < 2 * GDN_H) {
        float ss = 0.f;
        for (int d = 0; d < 128; ++d) { const int j = grp * 128 + d; const float v = silu_f(conv3_p(p, r, C_QKV + j, w, 3 * MIX_W, j)); ss += v * v; }
        sc = 1.0f / sqrtf(ss + EPS); if (grp < GDN_H) sc *= 0.08838834764831845f;
    }
    for (int d = 0; d < 128; ++d) { const int j = grp * 128 + d; p.GQKV[(size_t)r * (3 * MIX_W) + j] = silu_f(conv3_p(p, r, C_QKV + j, w, 3 * MIX_W, j)) * sc; }
}
HD void prep_gdn_gb_item(const Ptrs& p, int l, int r, int j) {
    const float a = p.PF[(size_t)r * PF_N + PF_A + j], bb = p.PF[(size_t)r * PF_N + PF_B + j];
    p.GG[(size_t)r * 2 * GDN_H + j] = -expf(p.gdn_a_log[(size_t)l * 2 * GDN_H + j]) * softplus_f(a + p.gdn_dt_bias[(size_t)l * 2 * GDN_H + j]);
    p.GB[(size_t)r * 2 * GDN_H + j] = sigmoid_f(bb);
}
HD void prep_ssd_item(const Ptrs& p, int l, int r, int j) {
    const float* w = p.ssm_conv_w + (size_t)l * 3 * SSM_XBC;
    p.SXBC[(size_t)r * SSM_XBC + j] = silu_f(conv3_p(p, r, C_XBC + j, w, SSM_XBC, j) + p.ssm_conv_b[(size_t)l * SSM_XBC + j]);
}
HD void prep_ssd_dt_item(const Ptrs& p, int l, int r, int j) {
    const float dt = softplus_f(p.PF[(size_t)r * PF_N + PF_DT + j] + p.ssm_dt_bias[(size_t)l * 2 * SSM_H + j]);
    p.SDT[(size_t)r * 2 * SSM_H + j] = dt; p.SA[(size_t)r * 2 * SSM_H + j] = -expf(p.ssm_a_log[(size_t)l * 2 * SSM_H + j]) * dt;
}
HD float rope_inv_freq(int i) { return exp2f(-(float)i * 0.4152410118609203f); }
HD void prep_attn_item(const Ptrs& p, int r, int hh) {
    int b, t, len; bool ic; row_info(r, b, t, len, ic);
    const bool isq = hh < ATT_HQ; const int h = isq ? hh : hh - ATT_HQ;
    const bf16* src = p.P + (size_t)r * NP_MAIN + (isq ? C_AQ + h * 128 : C_AKV + h * 128);
    float* dst = isq ? p.AQ + (size_t)r * MIX_W + h * 128 : p.AK + (size_t)r * (ATT_HKV * 128) + h * 128;
    if (ic) { for (int d = 0; d < 128; ++d) dst[d] = bf2f(src[d]); return; }
    const float pos[2] = {(float)(t / GRID_W), (float)(t % GRID_W)};
    for (int ax = 0; ax < 2; ++ax)
        for (int i = 0; i < 32; ++i) {
            const float ang = pos[ax] * rope_inv_freq(i), cs = cosf(ang), sn = sinf(ang);
            const float x1 = bf2f(src[ax * 64 + i]), x2 = bf2f(src[ax * 64 + 32 + i]);
            dst[ax * 64 + i] = x1 * cs - x2 * sn; dst[ax * 64 + 32 + i] = x2 * cs + x1 * sn;
        }
}

HD int chain_row(int b, int dir, int s) {
    if (s < CTX_LEN) return NLAT + b * CTX_LEN + (dir ? CTX_LEN - 1 - s : s);
    const int u = s - CTX_LEN; return b * SEQ + (dir ? SEQ - 1 - u : u);
}
HD void gdn_chain_item(const Ptrs& p, int b, int h, int dir, int vc) {
    float S[128];
#pragma unroll
    for (int k = 0; k < 128; ++k) S[k] = 0.f;
    float pf = 0.f;
    for (int s = 0; s < CHAIN_LEN; ++s) {
        const int r = chain_row(b, dir, s);
        const float* q = p.GQKV + (size_t)r * (3 * MIX_W) + h * 128; const float* kk = q + MIX_W; const float vv = q[2 * MIX_W + vc];
        const float a = expf(p.GG[(size_t)r * 2 * GDN_H + dir * GDN_H + h]), be = p.GB[(size_t)r * 2 * GDN_H + dir * GDN_H + h];
        if (s + 1 < CHAIN_LEN) { const float* qn = p.GQKV + (size_t)chain_row(b, dir, s + 1) * (3 * MIX_W) + h * 128;
#pragma unroll
            for (int j = 0; j < 4; ++j) pf += qn[32 * j] + qn[MIX_W + 32 * j]; }
        float ks = 0.f;
#pragma unroll
        for (int c = 0; c < 2; ++c) { float kc[64];
#pragma unroll
            for (int j = 0; j < 64; ++j) kc[j] = kk[64 * c + j];
#pragma unroll
            for (int j = 0; j < 64; ++j) { S[64 * c + j] *= a; ks += kc[j] * S[64 * c + j]; }
            CFENCE(); }
        const float dl = be * (vv - ks); float o = 0.f;
#pragma unroll
        for (int c = 0; c < 4; ++c) { float kc[32], qc[32];
#pragma unroll
            for (int j = 0; j < 32; ++j) { kc[j] = kk[32 * c + j]; qc[j] = q[32 * c + j]; }
#pragma unroll
            for (int j = 0; j < 32; ++j) { S[32 * c + j] += kc[j] * dl; o += qc[j] * S[32 * c + j]; }
            CFENCE(); }
        p.OG[((size_t)dir * MROWS + r) * MIX_W + h * 128 + vc] = o;
    }
    if (pf == 123456.789f) p.OG[0] = pf;
}
HD void ssd_chain_item(const Ptrs& p, int b, int hd, int dir, int pc) {
    float hs[SSM_N];
#pragma unroll
    for (int s = 0; s < SSM_N; ++s) hs[s] = 0.f;
    const int g = hd / SSM_HPG;
    float pf = 0.f;
    for (int s = 0; s < CHAIN_LEN; ++s) {
        const int r = chain_row(b, dir, s);
        const float* xb = p.SXBC + (size_t)r * SSM_XBC; const float* Bm = xb + MIX_W + g * SSM_N; const float* Cm = xb + MIX_W + SSM_BC + g * SSM_N;
        const float dt = p.SDT[(size_t)r * 2 * SSM_H + dir * SSM_H + hd], ea = expf(p.SA[(size_t)r * 2 * SSM_H + dir * SSM_H + hd]);
        const float xd = xb[hd * SSM_P + pc] * dt; float y = 0.f;
        if (s + 1 < CHAIN_LEN) { const float* xn = p.SXBC + (size_t)chain_row(b, dir, s + 1) * SSM_XBC + MIX_W + g * SSM_N;
#pragma unroll
            for (int j = 0; j < 4; ++j) pf += xn[32 * j] + xn[SSM_BC + 32 * j]; }
#pragma unroll
        for (int c = 0; c < 4; ++c) { float bc[32], cc[32];
#pragma unroll
            for (int j = 0; j < 32; ++j) { bc[j] = Bm[32 * c + j]; cc[j] = Cm[32 * c + j]; }
#pragma unroll
            for (int j = 0; j < 32; ++j) { hs[32 * c + j] = ea * hs[32 * c + j] + xd * bc[j]; y += cc[j] * hs[32 * c + j]; }
            CFENCE(); }
        p.OS[((size_t)dir * MROWS + r) * MIX_W + hd * SSM_P + pc] = y;
    }
    if (pf == 123456.789f) p.OS[0] = pf;
}
HD void attn_item(const Ptrs& p, int l, int r, int hq) {
    int b, t, len; bool ic; row_info(r, b, t, len, ic);
    const int hkv = hq / ATT_GRP;
    const float* qp = p.AQ + (size_t)r * MIX_W + hq * 128;
    float* sc = p.SC + ((size_t)r * ATT_HQ + hq) * SC_LD;
    const float sink = p.attn_sink[(size_t)l * ATT_HQ + hq];
    const int lo = ic ? 0 : (t - WINDOW < 0 ? 0 : t - WINDOW), hi = ic ? -1 : (t + WINDOW > SEQ - 1 ? SEQ - 1 : t + WINDOW);
    const int nloc = ic ? 0 : hi - lo + 1, nk = nloc + CTX_LEN;
    float m = sink;
    {
        float q[128];
#pragma unroll
        for (int d = 0; d < 128; ++d) q[d] = qp[d];
        for (int j = 0; j < nk; ++j) {
            const int kr = j < nloc ? b * SEQ + lo + j : NLAT + b * CTX_LEN + (j - nloc);
            const float* kk = p.AK + (size_t)kr * (ATT_HKV * 128) + hkv * 128;
            float s = 0.f;
#pragma unroll
            for (int c = 0; c < 4; ++c) { float kc[32];
#pragma unroll
                for (int d = 0; d < 32; ++d) kc[d] = kk[32 * c + d];
#pragma unroll
                for (int d = 0; d < 32; ++d) s += q[32 * c + d] * kc[d];
                CFENCE(); }
            s *= 0.08838834764831845f; sc[j] = s; m = s > m ? s : m;
        }
    }
    float o[128];
#pragma unroll
    for (int d = 0; d < 128; ++d) o[d] = 0.f;
    float den = expf(sink - m);
    for (int j = 0; j < nk; ++j) {
        const int kr = j < nloc ? b * SEQ + lo + j : NLAT + b * CTX_LEN + (j - nloc);
        const bf16* vv = p.P + (size_t)kr * NP_MAIN + C_AKV + ATT_HKV * 128 + hkv * 128;
        const float e = expf(sc[j] - m); den += e;
#pragma unroll
        for (int c = 0; c < 4; ++c) { float vc[32];
#pragma unroll
            for (int d = 0; d < 32; ++d) vc[d] = bf2f(vv[32 * c + d]);
#pragma unroll
            for (int d = 0; d < 32; ++d) o[32 * c + d] += e * vc[d];
            CFENCE(); }
    }
    const float inv = 1.0f / den;
#pragma unroll
    for (int d = 0; d < 128; ++d) p.YC[(size_t)r * MIX_W + hq * 128 + d] = f2bf(o[d] * inv);
}
HD void gdn_out_item(const Ptrs& p, int l, int r, int h) {
    float ss = 0.f;
    for (int d = 0; d < 128; ++d) { const size_t i = (size_t)r * MIX_W + h * 128 + d; const float v = p.OG[i] + p.OG[(size_t)MROWS * MIX_W + i]; ss += v * v; }
    const float rs = 1.0f / sqrtf(ss / 128.0f + EPS);
    for (int d = 0; d < 128; ++d) { const size_t i = (size_t)r * MIX_W + h * 128 + d; const float v = p.OG[i] + p.OG[(size_t)MROWS * MIX_W + i];
        p.YA[i] = f2bf(v * rs * p.gdn_norm[(size_t)l * 128 + d] * silu_f(bf2f(p.P[(size_t)r * NP_MAIN + C_GATE + h * 128 + d]))); }
}
HD void ssd_out_item(const Ptrs& p, int l, int r, int g) {
    constexpr int GW = MIX_W / SSM_G;
    float ss = 0.f;
    for (int pass = 0; pass < 2; ++pass) {
        const float rs = pass ? 1.0f / sqrtf(ss / (float)GW + EPS) : 0.f;
        for (int jj = 0; jj < GW; ++jj) { const int j = g * GW + jj; const size_t i = (size_t)r * MIX_W + j;
            float y = p.OS[i] + p.OS[(size_t)MROWS * MIX_W + i] + p.ssm_d[(size_t)l * SSM_H + j / SSM_P] * p.SXBC[(size_t)r * SSM_XBC + j];
            y *= silu_f(bf2f(p.P[(size_t)r * NP_MAIN + C_Z + j]));
            if (!pass) ss += y * y; else p.YB[i] = f2bf(y * rs * p.ssm_norm[(size_t)l * MIX_W + j]); }
    }
}
HD void act_item(const Ptrs& p, int l, int r, int j) {
    int b, t, len; bool ic; row_info(r, b, t, len, ic);
    const float* w = p.ffn_conv_w + (size_t)l * 3 * D_FF;
    const bf16* ug = p.UG + (size_t)r * (2 * D_FF);
    float g = w[D_FF + j] * bf2f(ug[D_FF + j]);
    if (t > 0) g += w[j] * bf2f(ug[D_FF + j - 2 * D_FF]);
    if (t < len - 1) g += w[2 * D_FF + j] * bf2f(ug[D_FF + j + 2 * D_FF]);
    g += p.ffn_conv_b[(size_t)l * D_FF + j];
    p.ACT[(size_t)r * D_FF + j] = f2bf(silu_f(g) * bf2f(ug[j]));
}

namespace pg8 {
#define PG8_LAS __attribute__((address_space(3)))
typedef unsigned short bf16_t;
typedef short bf16x8 __attribute__((ext_vector_type(8)));
typedef float f32x4 __attribute__((ext_vector_type(4)));
typedef unsigned u32x4 __attribute__((ext_vector_type(4)));
constexpr int BM = 256, BK = 64, HALF = 128, HTB = HALF * BK * 2  , STAGE_BYTES = 8 * HTB, NXCD = 8, WGM = 8;

__host__ __device__ __forceinline__ int lds_byte(int r, int c) { const int st = (r >> 4) * 2 + (c >> 5), rr = r & 15, cc = c & 31, ob = rr * 64 + cc * 2; return st * 1024 + (ob ^ (((ob >> 9) & 1) << 5)); }
__host__ __device__ __forceinline__ void stage_rc(int b, int& R, int& C) { const int st = b / 1024, sb = b % 1024, swz = sb ^ (((sb >> 9) & 1) << 5); R = (st >> 1) * 16 + swz / 64; C = (st & 1) * 32 + (swz % 64) / 2; }
__host__ __device__ __forceinline__ int perm32(int rho) { const int n = rho >> 4, i = rho & 15; return 8 * (i >> 2) + 4 * n + (i & 3); }

struct Unit { int pm, pn, pk; };
struct Gemm { const bf16_t* A; const bf16_t* Bt; int M, N, K, ld; };

struct StaticOrder {
    int nM, nN, nwg, G, c;
    __host__ __device__ void init(int M, int N, int G_, int c_) { nM = M / BM; nN = N / BM; nwg = nM * nN; G = G_; c = c_; }
    __host__ __device__ bool next(int i, Unit& u) const {
        const long L = (long)i * G + c; if (L >= nwg) return false;
        int wgid = (int)L; { const int q = nwg / NXCD, r = nwg % NXCD, xcd = wgid % NXCD, off = wgid / NXCD; wgid = (xcd < r ? xcd * (q + 1) : r * (q + 1) + (xcd - r) * q) + off; }
        const int nig = WGM * nN, gid = wgid / nig, fm = gid * WGM, gsz = (nM - fm) < WGM ? (nM - fm) : WGM;
        u.pm = fm + ((wgid % nig) % gsz); u.pn = (wgid % nig) / gsz; u.pk = 0; return true;
    }
    __device__ __forceinline__ void a_ready(const Unit&) const {}
    __device__ __forceinline__ void done(const Unit&) const {}
};

__device__ __forceinline__ unsigned cvt_pk_bf16(float lo, float hi) { unsigned r; asm volatile("v_cvt_pk_bf16_f32 %0, %1, %2" : "=v"(r) : "v"(lo), "v"(hi)); return r; }

template <class Epi, class Sched, bool ALIGN_EPI = false, bool SP2 = false>
__device__ __forceinline__ void gemm_phase(PG8_LAS unsigned char* lds, const Gemm g, const Sched& S, const Epi& E, int tid_in) {
    int tid_l = tid_in; asm volatile("" : "+v"(tid_l));
    const int tid = tid_l, wid = __builtin_amdgcn_readfirstlane(tid >> 6), lane = tid & 63, wr = wid >> 2, wc = wid & 3, fr = lane & 15, fq = lane >> 4;
    const int K = g.K, nt = K / BK, LD = g.ld;
    unsigned voffA[2], voffB[2];
#pragma unroll
    for (int i = 0; i < 2; ++i) { int R, C; stage_rc(tid * 16 + i * 8192, R, C); const int Rb = Epi::PERM ? ((R & ~31) + perm32(R & 31)) : R;
        voffA[i] = (unsigned)(R * LD + C) * 2u; voffB[i] = (unsigned)(Rb * LD + C) * 2u; }
    const size_t kstep = (size_t)(BK * 2);
    const size_t hstep = (size_t)HALF * LD * 2;
    const size_t tstep = 2 * hstep;
    const unsigned ldsw = (unsigned)wid * 1024u;
    const int aoff = lds_byte(wr * 64 + fr, fq * 8), boff = lds_byte(wc * 32 + fr, fq * 8);
#define PG8_SA(b, h) (((b) * 2 + (h)) * HTB)
#define PG8_SB(b, h) ((4 + (b) * 2 + (h)) * HTB)
#define PG8_STAGE(bufoff, gbase, voff) do { _Pragma("unroll") for (int _i = 0; _i < 2; ++_i) \
        __builtin_amdgcn_global_load_lds((const unsigned*)((const char*)(gbase) + (voff)[_i]), (PG8_LAS unsigned*)(lds + (bufoff) + ldsw + _i * 8192), 16, 0, 0); } while (0)
#define PG8_LDA(dst, b, h) do { _Pragma("unroll") for (int m = 0; m < 4; ++m) _Pragma("unroll") for (int k = 0; k < 2; ++k) dst[m][k] = *(const PG8_LAS bf16x8*)(lds + PG8_SA(b, h) + aoff + m * 2048 + k * 1024); } while (0)
#define PG8_LDB(dst, b, h) do { _Pragma("unroll") for (int n = 0; n < 2; ++n) _Pragma("unroll") for (int k = 0; k < 2; ++k) dst[n][k] = *(const PG8_LAS bf16x8*)(lds + PG8_SB(b, h) + boff + n * 2048 + k * 1024); } while (0)
#define PG8_MMA(ai, bj, At, Bt) do { __builtin_amdgcn_s_setprio(1); _Pragma("unroll") for (int m = 0; m < 4; ++m) _Pragma("unroll") for (int n = 0; n < 2; ++n) _Pragma("unroll") for (int k = 0; k < 2; ++k) \
        acc[ai][bj][m][n] = __builtin_amdgcn_mfma_f32_16x16x32_bf16(Bt[n][k], At[m][k], acc[ai][bj][m][n], 0, 0, 0); __builtin_amdgcn_s_setprio(0); } while (0)
#define PG8_WAIT_V(n) asm volatile("s_waitcnt vmcnt(" #n ")" ::: "memory")
#define PG8_WAIT_L(n) asm volatile("s_waitcnt lgkmcnt(" #n ")" ::: "memory")
#define PG8_BAR __builtin_amdgcn_s_barrier()
#define PG8_SCHED __builtin_amdgcn_sched_barrier(0)
    Unit cur, nxt; int ui = 0;
    if (!S.next(0, cur)) return;
    f32x4 acc[2][2][4][2];
#pragma unroll
    for (int a = 0; a < 2; ++a)
#pragma unroll
        for (int b = 0; b < 2; ++b)
#pragma unroll
            for (int m = 0; m < 4; ++m)
#pragma unroll
                for (int n = 0; n < 2; ++n) acc[a][b][m][n] = (f32x4){0.f, 0.f, 0.f, 0.f};
    bf16x8 At[4][2], B0[2][2], B1[2][2];
    const char* cA = (const char*)g.A + (size_t)cur.pm * tstep + (size_t)cur.pk * 2; const char* cB = (const char*)g.Bt + (size_t)cur.pn * tstep + (size_t)cur.pk * 2;
    S.a_ready(cur);
    if constexpr (SP2) {
        PG8_STAGE(PG8_SB(0, 0), cB, voffB); PG8_STAGE(PG8_SB(0, 1), cB + hstep, voffB); PG8_STAGE(PG8_SA(0, 0), cA, voffA); PG8_STAGE(PG8_SA(0, 1), cA + hstep, voffA);
        if (wr == 1) PG8_BAR;
        PG8_WAIT_V(2); PG8_BAR;
        PG8_STAGE(PG8_SB(1, 0), cB + kstep, voffB); PG8_STAGE(PG8_SA(1, 0), cA + kstep, voffA); PG8_STAGE(PG8_SB(1, 1), cB + hstep + kstep, voffB);
        PG8_WAIT_V(6); PG8_BAR;
    } else {
        PG8_STAGE(PG8_SB(0, 0), cB, voffB); PG8_STAGE(PG8_SA(0, 0), cA, voffA); PG8_STAGE(PG8_SB(0, 1), cB + hstep, voffB); PG8_STAGE(PG8_SA(0, 1), cA + hstep, voffA);
        if (wr == 1) PG8_BAR;
        PG8_WAIT_V(4); PG8_BAR;
        PG8_STAGE(PG8_SB(1, 0), cB + kstep, voffB); PG8_STAGE(PG8_SA(1, 0), cA + kstep, voffA); PG8_STAGE(PG8_SB(1, 1), cB + hstep + kstep, voffB);
        PG8_WAIT_V(6); PG8_BAR;
    }
    for (;;) {
        const bool has_next = S.next(ui + 1, nxt);
        const char* nA = has_next ? (const char*)g.A + (size_t)nxt.pm * tstep + (size_t)nxt.pk * 2 : cA; const char* nB = has_next ? (const char*)g.Bt + (size_t)nxt.pn * tstep + (size_t)nxt.pk * 2 : cB;
        for (int t = 0; t < nt; t += 2) {
            const bool last = (t == nt - 2);
            const char* a1 = cA + (size_t)(t + 1) * kstep;
            const char* a2 = last ? nA : cA + (size_t)(t + 2) * kstep; const char* b2 = last ? nB : cB + (size_t)(t + 2) * kstep;
            const char* a3 = a2 + kstep; const char* b3 = b2 + kstep;
            if (last && has_next) S.a_ready(nxt);
            if constexpr (Epi::KHOOK) E.khook(acc, cur, t, wr, wc, fr, fq);
            if constexpr (SP2) {
            PG8_LDB(B0, 0, 0); PG8_LDB(B1, 0, 1); PG8_SCHED; PG8_LDA(At, 0, 0); PG8_STAGE(PG8_SA(1, 1), a1 + hstep, voffA);
            PG8_WAIT_V(8); PG8_WAIT_L(0); PG8_BAR; PG8_MMA(0, 0, At, B0); PG8_MMA(0, 1, At, B1); PG8_BAR; PG8_SCHED;
            PG8_LDA(At, 0, 1); PG8_STAGE(PG8_SB(0, 0), b2, voffB); PG8_STAGE(PG8_SB(0, 1), b2 + hstep, voffB); PG8_STAGE(PG8_SA(0, 0), a2, voffA);
            PG8_WAIT_V(8); PG8_WAIT_L(0); PG8_BAR; PG8_MMA(1, 0, At, B0); PG8_MMA(1, 1, At, B1); PG8_BAR; PG8_SCHED;
            PG8_LDB(B0, 1, 0); PG8_LDB(B1, 1, 1); PG8_SCHED; PG8_LDA(At, 1, 0); PG8_STAGE(PG8_SA(0, 1), a2 + hstep, voffA);
            PG8_WAIT_V(8); PG8_WAIT_L(0); PG8_BAR; PG8_MMA(0, 0, At, B0); PG8_MMA(0, 1, At, B1); PG8_BAR; PG8_SCHED;
            PG8_LDA(At, 1, 1); PG8_STAGE(PG8_SB(1, 0), b3, voffB); PG8_STAGE(PG8_SB(1, 1), b3 + hstep, voffB); PG8_STAGE(PG8_SA(1, 0), a3, voffA);
            PG8_WAIT_V(8); PG8_WAIT_L(0); PG8_BAR; PG8_MMA(1, 0, At, B0); PG8_MMA(1, 1, At, B1); PG8_BAR; PG8_SCHED;
            } else {
            PG8_LDB(B0, 0, 0); PG8_SCHED; PG8_LDA(At, 0, 0); PG8_STAGE(PG8_SA(1, 1), a1 + hstep, voffA);
            PG8_WAIT_L(8); PG8_BAR; PG8_WAIT_L(0); PG8_MMA(0, 0, At, B0); PG8_BAR; PG8_SCHED;
            PG8_LDB(B1, 0, 1); PG8_STAGE(PG8_SB(0, 0), b2, voffB);
            PG8_BAR; PG8_WAIT_L(0); PG8_MMA(0, 1, At, B1); PG8_BAR;
            PG8_LDA(At, 0, 1); PG8_STAGE(PG8_SA(0, 0), a2, voffA);
            PG8_BAR; PG8_WAIT_L(0); PG8_MMA(1, 0, At, B0); PG8_BAR; PG8_SCHED;
            PG8_STAGE(PG8_SB(0, 1), b2 + hstep, voffB);
            PG8_WAIT_V(6); PG8_BAR; PG8_MMA(1, 1, At, B1); PG8_BAR;
            PG8_LDB(B0, 1, 0); PG8_SCHED; PG8_LDA(At, 1, 0); PG8_STAGE(PG8_SA(0, 1), a2 + hstep, voffA);
            PG8_WAIT_L(8); PG8_BAR; PG8_WAIT_L(0); PG8_MMA(0, 0, At, B0); PG8_BAR; PG8_SCHED;
            PG8_LDB(B1, 1, 1); PG8_STAGE(PG8_SB(1, 0), b3, voffB);
            PG8_BAR; PG8_WAIT_L(0); PG8_MMA(0, 1, At, B1); PG8_BAR;
            PG8_LDA(At, 1, 1); PG8_STAGE(PG8_SA(1, 0), a3, voffA);
            PG8_BAR; PG8_WAIT_L(0); PG8_MMA(1, 0, At, B0); PG8_BAR; PG8_SCHED;
            PG8_STAGE(PG8_SB(1, 1), b3 + hstep, voffB);
            PG8_WAIT_V(6); PG8_BAR; PG8_MMA(1, 1, At, B1); PG8_BAR;
            }
        }
        if constexpr (ALIGN_EPI) { if (wr == 0) PG8_BAR; }
        if constexpr (!Epi::AFTER_DRAIN) { E(acc, cur, wr, wc, fr, fq); S.done(cur); }
        if (!has_next) break;
#pragma unroll
        for (int a = 0; a < 2; ++a)
#pragma unroll
            for (int b = 0; b < 2; ++b)
#pragma unroll
                for (int m = 0; m < 4; ++m)
#pragma unroll
                    for (int n = 0; n < 2; ++n) acc[a][b][m][n] = (f32x4){0.f, 0.f, 0.f, 0.f};
        cur = nxt; cA = nA; cB = nB; ++ui;
        if constexpr (ALIGN_EPI) { if (wr == 1) PG8_BAR; }
    }
    PG8_WAIT_V(0);
    if constexpr (!ALIGN_EPI) { if (wr == 0) PG8_BAR; }
    PG8_BAR;
    if constexpr (Epi::AFTER_DRAIN) { E.fused(acc, cur, wr, wc, fr, fq, lds, wid, lane); S.done(cur); }
#undef PG8_SA
#undef PG8_SB
#undef PG8_STAGE
#undef PG8_LDA
#undef PG8_LDB
#undef PG8_MMA
#undef PG8_WAIT_V
#undef PG8_WAIT_L
#undef PG8_BAR
#undef PG8_SCHED
}
}
#define GAS __attribute__((address_space(1)))
#define LAS __attribute__((address_space(3)))
typedef GAS unsigned gu32;
typedef GAS unsigned long long gu64;
#define RLX_AGENT __ATOMIC_RELAXED, __HIP_MEMORY_SCOPE_AGENT
#define XB_TMO      128
#define XB_XCNT(j)  (256  + 64 * (j))
#define XB_XSUB(j)  (1280 + 64 * (j))
#define XB_XGEN(j)  (2304 + 64 * (j))
#define XB_TOP      3328
#define XB_TOPGEN   3392
#define XCD_BAR_WORDS 3456
#define XB_SPIN_CAP (1u << 18)

__device__ __forceinline__ unsigned xb_ld(unsigned* p)              { return __hip_atomic_load(p, __ATOMIC_RELAXED, __HIP_MEMORY_SCOPE_AGENT); }
__device__ __forceinline__ unsigned xb_add(unsigned* p, unsigned v) { return __hip_atomic_fetch_add(p, v, __ATOMIC_RELAXED, __HIP_MEMORY_SCOPE_AGENT); }
__device__ __forceinline__ unsigned xb_xcc_id() { return (unsigned)__builtin_amdgcn_s_getreg((3 << 11) | 20) & 0xFu; }
#define XB_SPIN(cond, bar) do { unsigned _sp = 0; while (cond) { __builtin_amdgcn_s_sleep(1); \
    if ((++_sp & 255u) == 0u) { if (xb_ld(&(bar)[XB_TMO])) break; if (_sp > XB_SPIN_CAP) { atomicAdd(&(bar)[XB_TMO], 1u); break; } } } } while (0)

struct XcdBarrier {
    unsigned* bar; unsigned x;
    volatile LAS unsigned* st;
};

__device__ __forceinline__ XcdBarrier xcd_barrier_post(unsigned* bar, volatile LAS unsigned* st) {
    XcdBarrier b; b.bar = bar; b.x = xb_xcc_id(); b.st = st;
    if (threadIdx.x == 0) (void)xb_add(&bar[XB_XCNT(b.x)], 1u);
    return b;
}
__device__ __forceinline__ void xcd_barrier_complete(unsigned* bar, unsigned x, unsigned& nloc, unsigned& nx) {
    const unsigned G = gridDim.x * gridDim.y * gridDim.z;
    unsigned sum, cnt, mine, sp = 0u;
    for (;;) {
        sum = 0u; cnt = 0u; mine = 0u;
#pragma unroll
        for (unsigned j = 0; j < 16; ++j) { const unsigned c = xb_ld(&bar[XB_XCNT(j)]); sum += c; cnt += (c > 0u) ? 1u : 0u; mine = (j == x) ? c : mine; }
        if (sum == G) break;
        __builtin_amdgcn_s_sleep(1);
        if ((++sp & 255u) == 0u) { if (xb_ld(&bar[XB_TMO])) break; if (sp > XB_SPIN_CAP) { atomicAdd(&bar[XB_TMO], 1u); break; } }
    }
    nloc = mine > 0u ? mine : 1u; nx = cnt > 0u ? cnt : 1u;
}

__device__ __forceinline__ void xcd_barrier(const XcdBarrier& b) {
    asm volatile("s_waitcnt vmcnt(0)" ::: "memory");
    __syncthreads();
    if (threadIdx.x == 0) {
        unsigned* bar = b.bar;
        __builtin_amdgcn_s_waitcnt(0);
        unsigned nloc = b.st[0], nx = b.st[1];
        if (nloc == 0u) { xcd_barrier_complete(bar, b.x, nloc, nx); b.st[0] = nloc; b.st[1] = nx; }
        const unsigned old = xb_add(&bar[XB_XSUB(b.x)], 1u);
        const unsigned gen = old / nloc;
        if (old + 1u == (gen + 1u) * nloc) {
            __builtin_amdgcn_fence(__ATOMIC_RELEASE, "agent");
            asm volatile("s_waitcnt vmcnt(0)" ::: "memory");
            const unsigned og = xb_add(&bar[XB_TOP], 1u);
            const unsigned tg = og / nx;
            if (og + 1u == (tg + 1u) * nx) xb_add(&bar[XB_TOPGEN], 1u);
            else XB_SPIN(xb_ld(&bar[XB_TOPGEN]) == tg, bar);
            __builtin_amdgcn_fence(__ATOMIC_ACQUIRE, "agent");
            xb_add(&bar[XB_XGEN(b.x)], 1u);
            asm volatile("s_waitcnt vmcnt(0)" ::: "memory");
        } else {
            XB_SPIN(xb_ld(&bar[XB_XGEN(b.x)]) == gen, bar);
            __builtin_amdgcn_fence(__ATOMIC_ACQUIRE, "agent");
            asm volatile("s_waitcnt vmcnt(0)" ::: "memory");
        }
    }
    __syncthreads();
}

#define LDS_BARRIER() do { asm volatile("s_waitcnt lgkmcnt(0)" ::: "memory"); __builtin_amdgcn_s_barrier(); asm volatile("" ::: "memory"); } while (0)
typedef float vf4 __attribute__((ext_vector_type(4)));
typedef unsigned vu2 __attribute__((ext_vector_type(2)));
typedef unsigned vu4 __attribute__((ext_vector_type(4)));
__device__ __forceinline__ float wave_sum(float v) {
#pragma unroll
    for (int o = 1; o < 64; o <<= 1) v += __shfl_xor(v, o);
    return v;
}
template <int CTRL> __device__ __forceinline__ float dpp_f(float x) { return __builtin_bit_cast(float, __builtin_amdgcn_mov_dpp(__builtin_bit_cast(int, x), CTRL, 0xf, 0xf, true)); }
__device__ __forceinline__ float sum16(float x) { x += dpp_f<0xB1>(x); x += dpp_f<0x4E>(x); x += dpp_f<0x124>(x); x += dpp_f<0x128>(x); return x; }
__device__ __forceinline__ float sum8(float x) { x += dpp_f<0xB1>(x); x += dpp_f<0x4E>(x); x += dpp_f<0x141>(x); return x; }
__device__ __forceinline__ unsigned pk2(float lo, float hi) { return (unsigned)f2bf(lo) | ((unsigned)f2bf(hi) << 16); }

constexpr int NV4 = D_MODEL / 256;
__device__ __forceinline__ void row_load(const float* row, int lane, vf4 (&x)[NV4]) {
#pragma unroll
    for (int j = 0; j < NV4; ++j) x[j] = __builtin_nontemporal_load((const vf4*)(row + (size_t)(j * 64 + lane) * 4));
}
__device__ __forceinline__ void row_store(float* row, int lane, const vf4 (&x)[NV4]) {
#pragma unroll
    for (int j = 0; j < NV4; ++j) __builtin_nontemporal_store(x[j], (vf4*)(row + (size_t)(j * 64 + lane) * 4));
}
__device__ __forceinline__ float row_rs(const vf4 (&x)[NV4]) {
    float ss = 0.f;
#pragma unroll
    for (int j = 0; j < NV4; ++j) ss += (x[j].x * x[j].x + x[j].y * x[j].y) + (x[j].z * x[j].z + x[j].w * x[j].w);
    return 1.0f / sqrtf(wave_sum(ss) * (1.0f / D_MODEL) + EPS);
}
__device__ __forceinline__ void norm_h_wave(const Ptrs& p, int l, int r, int which, int lane, const vf4 (&x)[NV4]) {
    const float rs = row_rs(x);
    const float* g = (which ? p.g_pre2 : p.g_pre1) + (size_t)l * D_MODEL;
    const float* mod = p.MOD + ((size_t)l * (BATCH + 1) + mod_row(r)) * D6 + (which ? 3 * D_MODEL : 0);
#pragma unroll
    for (int j = 0; j < NV4; ++j) { const int c = (j * 64 + lane) * 4;
        const vf4 gv = *(const vf4*)(g + c), sh = *(const vf4*)(mod + c), sc = *(const vf4*)(mod + D_MODEL + c);
        const vf4 o = x[j] * rs * gv * (1.0f + sc) + sh;
        vu2 w; w.x = pk2(o.x, o.y); w.y = pk2(o.z, o.w);
        *(vu2*)(p.H + (size_t)r * D_MODEL + c) = w; }
}
__device__ __forceinline__ void resid_wave(const Ptrs& p, int l, int r, int which, int lane, vf4 (&x)[NV4], int ns) {
    vf4 y[NV4];
    if (r >= NLAT) {
#pragma unroll
        for (int j = 0; j < NV4; ++j) y[j] = (vf4){0.f, 0.f, 0.f, 0.f};
        for (int s = 0; s < ns; ++s) {
#pragma unroll
            for (int j = 0; j < NV4; ++j) y[j] += *(const vf4*)(p.SLAB + ((size_t)s * NCTX + (r - NLAT)) * D_MODEL + (size_t)(j * 64 + lane) * 4); }
    } else
#pragma unroll
    for (int j = 0; j < NV4; ++j) { const vu2 w = __builtin_nontemporal_load((const vu2*)(p.MIXb + (size_t)r * D_MODEL + (size_t)(j * 64 + lane) * 4)); y[j] = (vf4){__uint_as_float(w.x << 16), __uint_as_float(w.x & 0xffff0000u), __uint_as_float(w.y << 16), __uint_as_float(w.y & 0xffff0000u)}; }
    const float rs = row_rs(y);
    const float* g = (which ? p.g_post2 : p.g_post1) + (size_t)l * D_MODEL;
    const float* gate = p.MOD + ((size_t)l * (BATCH + 1) + mod_row(r)) * D6 + (which ? 5 * D_MODEL : 2 * D_MODEL);
#pragma unroll
    for (int j = 0; j < NV4; ++j) { const int c = (j * 64 + lane) * 4; x[j] += *(const vf4*)(gate + c) * (y[j] * rs * *(const vf4*)(g + c)); }
}

struct WtDesc { const float* W; bf16* WT; int K, N, k0, n0, drow0; };
__device__ __forceinline__ void transpose_load(const WtDesc& d, int lane, float (&wv)[32]) {
#pragma unroll
    for (int i = 0; i < 32; ++i) wv[i] = __builtin_nontemporal_load(d.W + (size_t)(d.k0 + 2 * i + (lane >> 5)) * d.N + d.n0 + (lane & 31));
}
__device__ __forceinline__ void transpose_finish(const WtDesc& d, const float (&wv)[32], LAS float* scr, int lane) {
#pragma unroll
    for (int i = 0; i < 32; ++i) scr[(2 * i + (lane >> 5)) * 33 + (lane & 31)] = wv[i];
    asm volatile("s_waitcnt lgkmcnt(0)" ::: "memory");
    const int c = lane & 7;
#pragma unroll
    for (int j = 0; j < 4; ++j) { const int n = (lane >> 3) + 8 * j; const LAS float* s = scr + (8 * c) * 33 + n;
        vu4 o; o.x = pk2(s[0 * 33], s[1 * 33]); o.y = pk2(s[2 * 33], s[3 * 33]); o.z = pk2(s[4 * 33], s[5 * 33]); o.w = pk2(s[6 * 33], s[7 * 33]);
        __builtin_nontemporal_store(o, (vu4*)(d.WT + (size_t)(d.drow0 + n) * d.K + d.k0 + 8 * c)); }
    asm volatile("s_waitcnt lgkmcnt(0)" ::: "memory");
}
__device__ __forceinline__ void transpose_item(const float* W, int K, int N, bf16* WT, int k0, int n0, int drow0, LAS float* scr, int lane) {
    const WtDesc d{W, WT, K, N, k0, n0, drow0}; float wv[32];
    transpose_load(d, lane, wv); transpose_finish(d, wv, scr, lane);
}
__device__ __forceinline__ int inproj_dst_row0(int n0) {
    if (n0 < R_A) return n0;
    if (n0 == R_A) return NP_MAIN;
    if (n0 < R_DT) return n0 - 4 * GDN_H;
    if (n0 == R_DT) return NP_MAIN + PF_DT;
    return n0 - 4 * GDN_H - 2 * SSM_H;
}
__device__ __forceinline__ int up_dst_row0(int n0) {
    const int isg = n0 >= D_FF, j = isg ? n0 - D_FF : n0; return 256 * (j >> 7) + 128 * isg + (j & 127);
}
static_assert(D_FF % 128 == 0, "up-projection tile order");
static_assert(4 * GDN_H == 32 && 2 * SSM_H == 32 && R_A % 32 == 0 && R_DT % 32 == 0, "the 32-column transpose items assume the real shapes");

constexpr int TB = 32;
constexpr int GDN_BUF = TB * 256 + TB * 32 + TB * 2;
__device__ __forceinline__ void gdn_token_wg(const Ptrs& p, LAS float* L, int chain, int slice, int tid) {
    const int b = chain / (GDN_H * 2), h = (chain >> 1) % GDN_H, dir = chain & 1;
    const int lane = tid & 63, wave = tid >> 6, ks = lane & 15, cl = wave * 4 + (lane >> 4);
    LAS float* obuf = L + 2 * GDN_BUF;
    float S[8];
#pragma unroll
    for (int e = 0; e < 8; ++e) S[e] = 0.f;
    vf4 rq[4], rv; float ra = 0.f, rb = 0.f;
    constexpr int NB = CHAIN_LEN / TB;
    auto gload = [&](int n) {
#pragma unroll
        for (int j = 0; j < 4; ++j) { const int idx = j * 512 + tid, i = idx >> 6, c4 = idx & 63; const int r = chain_row(b, dir, n * TB + i);
            rq[j] = *(const vf4*)(p.GQKV + (size_t)r * (3 * MIX_W) + h * 128 + (c4 < 32 ? c4 * 4 : MIX_W + (c4 - 32) * 4)); }
        if (tid < 256) { const int i = tid >> 3, c4 = tid & 7; const int r = chain_row(b, dir, n * TB + i);
            rv = *(const vf4*)(p.GQKV + (size_t)r * (3 * MIX_W) + 2 * MIX_W + h * 128 + slice * 32 + c4 * 4); }
        if (tid < TB) { const int r = chain_row(b, dir, n * TB + tid); ra = __expf(p.GG[(size_t)r * 2 * GDN_H + dir * GDN_H + h]); rb = p.GB[(size_t)r * 2 * GDN_H + dir * GDN_H + h]; }
    };
    auto lstore = [&](LAS float* B) {
#pragma unroll
        for (int j = 0; j < 4; ++j) { const int idx = j * 512 + tid; *(LAS vf4*)(B + (idx >> 6) * 256 + (idx & 63) * 4) = rq[j]; }
        if (tid < 256) *(LAS vf4*)(B + TB * 256 + tid * 4) = rv;
        if (tid < TB) { B[TB * 256 + TB * 32 + tid * 2] = ra; B[TB * 256 + TB * 32 + tid * 2 + 1] = rb; }
    };
    gload(0); lstore(L); LDS_BARRIER();
    for (int n = 0; n < NB; ++n) {
        LAS float* B = L + (n & 1) * GDN_BUF; LAS float* ob = obuf + (n & 1) * (TB * 32);
        if (n + 1 < NB) gload(n + 1);
#pragma unroll 4
        for (int i = 0; i < TB; ++i) {
            const LAS float* kq = B + i * 256;
            const vf4 q0 = *(const LAS vf4*)(kq + ks * 8), q1 = *(const LAS vf4*)(kq + ks * 8 + 4), k0 = *(const LAS vf4*)(kq + 128 + ks * 8), k1 = *(const LAS vf4*)(kq + 128 + ks * 8 + 4);
            const float v = B[TB * 256 + i * 32 + cl], a = B[TB * 256 + TB * 32 + i * 2], be = B[TB * 256 + TB * 32 + i * 2 + 1];
            const float kk[8] = {k0.x, k0.y, k0.z, k0.w, k1.x, k1.y, k1.z, k1.w}, qq[8] = {q0.x, q0.y, q0.z, q0.w, q1.x, q1.y, q1.z, q1.w};
            float rr = 0.f;
#pragma unroll
            for (int e = 0; e < 8; ++e) { S[e] *= a; rr += kk[e] * S[e]; }
            rr = sum16(rr);
            const float dl = be * (v - rr); float o = 0.f;
#pragma unroll
            for (int e = 0; e < 8; ++e) { S[e] += kk[e] * dl; o += qq[e] * S[e]; }
            o = sum16(o);
            if (ks == 0) ob[i * 32 + cl] = o;
        }
        if (n + 1 < NB) lstore(L + ((n + 1) & 1) * GDN_BUF);
        LDS_BARRIER();
        if (tid < 256) { const int i = tid >> 3, c4 = tid & 7; const int r = chain_row(b, dir, n * TB + i);
            *(vf4*)(p.OG + ((size_t)dir * MROWS + r) * MIX_W + h * 128 + slice * 32 + c4 * 4) = *(const LAS vf4*)(ob + i * 32 + c4 * 4); }
    }
}
constexpr int SSD_BUF = TB * 256 + TB * 64 + TB * 2;
__device__ __forceinline__ void ssd_token_wg(const Ptrs& p, LAS float* L, int chain, int tid) {
    const int b = chain / (SSM_H * 2), hd = (chain >> 1) % SSM_H, dir = chain & 1, g = hd / SSM_HPG;
    const int lane = tid & 63, wave = tid >> 6, ss = lane & 7, pc = wave * 8 + (lane >> 3);
    LAS float* obuf = L + 2 * SSD_BUF;
    float hs[16];
#pragma unroll
    for (int e = 0; e < 16; ++e) hs[e] = 0.f;
    vf4 rbc[4], rx; float rdt = 0.f, rea = 0.f;
    constexpr int NB = CHAIN_LEN / TB;
    auto gload = [&](int n) {
#pragma unroll
        for (int j = 0; j < 4; ++j) { const int idx = j * 512 + tid, i = idx >> 6, c4 = idx & 63; const int r = chain_row(b, dir, n * TB + i);
            rbc[j] = *(const vf4*)(p.SXBC + (size_t)r * SSM_XBC + MIX_W + (c4 < 32 ? g * SSM_N + c4 * 4 : SSM_BC + g * SSM_N + (c4 - 32) * 4)); }
        { const int i = tid >> 4, c4 = tid & 15; const int r = chain_row(b, dir, n * TB + i); rx = *(const vf4*)(p.SXBC + (size_t)r * SSM_XBC + hd * SSM_P + c4 * 4); }
        if (tid < TB) { const int r = chain_row(b, dir, n * TB + tid); rdt = p.SDT[(size_t)r * 2 * SSM_H + dir * SSM_H + hd]; rea = __expf(p.SA[(size_t)r * 2 * SSM_H + dir * SSM_H + hd]); }
    };
    auto lstore = [&](LAS float* B) {
#pragma unroll
        for (int j = 0; j < 4; ++j) { const int idx = j * 512 + tid; *(LAS vf4*)(B + (idx >> 6) * 256 + (idx & 63) * 4) = rbc[j]; }
        *(LAS vf4*)(B + TB * 256 + tid * 4) = rx;
        if (tid < TB) { B[TB * 256 + TB * 64 + tid * 2] = rdt; B[TB * 256 + TB * 64 + tid * 2 + 1] = rea; }
    };
    gload(0); lstore(L); LDS_BARRIER();
    for (int n = 0; n < NB; ++n) {
        LAS float* B = L + (n & 1) * SSD_BUF; LAS float* ob = obuf + (n & 1) * (TB * 64);
        if (n + 1 < NB) gload(n + 1);
#pragma unroll 2
        for (int i = 0; i < TB; ++i) {
            const LAS float* bc = B + i * 256;
            const float xd = B[TB * 256 + i * 64 + pc] * B[TB * 256 + TB * 64 + i * 2], ea = B[TB * 256 + TB * 64 + i * 2 + 1];
            float y = 0.f;
#pragma unroll
            for (int q = 0; q < 4; ++q) { const vf4 bv = *(const LAS vf4*)(bc + ss * 16 + q * 4), cv = *(const LAS vf4*)(bc + 128 + ss * 16 + q * 4);
                hs[4 * q + 0] = ea * hs[4 * q + 0] + xd * bv.x; y += cv.x * hs[4 * q + 0];
                hs[4 * q + 1] = ea * hs[4 * q + 1] + xd * bv.y; y += cv.y * hs[4 * q + 1];
                hs[4 * q + 2] = ea * hs[4 * q + 2] + xd * bv.z; y += cv.z * hs[4 * q + 2];
                hs[4 * q + 3] = ea * hs[4 * q + 3] + xd * bv.w; y += cv.w * hs[4 * q + 3]; }
            y = sum8(y);
            if (ss == 0) ob[i * 64 + pc] = y;
        }
        if (n + 1 < NB) lstore(L + ((n + 1) & 1) * SSD_BUF);
        LDS_BARRIER();
        { const int i = tid >> 4, c4 = tid & 15; const int r = chain_row(b, dir, n * TB + i);
            *(vf4*)(p.OS + ((size_t)dir * MROWS + r) * MIX_W + hd * SSM_P + c4 * 4) = *(const LAS vf4*)(ob + i * 64 + c4 * 4); }
    }
}

constexpr int YLD = 3 * MIX_W;
typedef float f32x2_t __attribute__((ext_vector_type(2)));
typedef __bf16 bf16x2_t __attribute__((ext_vector_type(2)));
typedef short bf16x8_t __attribute__((ext_vector_type(8)));
typedef float f32x16_t __attribute__((ext_vector_type(16)));
__device__ __forceinline__ unsigned cvtpk(float lo, float hi) { f32x2_t v = {lo, hi}; bf16x2_t b = __builtin_convertvector(v, bf16x2_t); return __builtin_bit_cast(unsigned, b); }
__device__ __forceinline__ float bflo(unsigned w) { return __uint_as_float(w << 16); }
__device__ __forceinline__ float bfhi(unsigned w) { return __uint_as_float(w & 0xffff0000u); }
__device__ __forceinline__ void unpack8(const vu4 w, float (&f)[8]) { f[0] = bflo(w.x); f[1] = bfhi(w.x); f[2] = bflo(w.y); f[3] = bfhi(w.y); f[4] = bflo(w.z); f[5] = bfhi(w.z); f[6] = bflo(w.w); f[7] = bfhi(w.w); }
__device__ __forceinline__ float silu_fast(float x) { return x * __builtin_amdgcn_rcpf(1.0f + __expf(-x)); }

__device__ __forceinline__ void conv8(const bf16* Prow, bool hp, bool hn, int col, const float* w, int wld, int jc, float (&y)[8]) {
    float xc[8], xp[8], xn[8];
    unpack8(*(const vu4*)(Prow + col), xc);
    if (hp) unpack8(*(const vu4*)(Prow - NP_MAIN + col), xp);
    if (hn) unpack8(*(const vu4*)(Prow + NP_MAIN + col), xn);
    const vf4 w0a = *(const vf4*)(w + jc), w0b = *(const vf4*)(w + jc + 4), w1a = *(const vf4*)(w + wld + jc), w1b = *(const vf4*)(w + wld + jc + 4), w2a = *(const vf4*)(w + 2 * wld + jc), w2b = *(const vf4*)(w + 2 * wld + jc + 4);
    const float w0[8] = {w0a.x, w0a.y, w0a.z, w0a.w, w0b.x, w0b.y, w0b.z, w0b.w}, w1[8] = {w1a.x, w1a.y, w1a.z, w1a.w, w1b.x, w1b.y, w1b.z, w1b.w}, w2[8] = {w2a.x, w2a.y, w2a.z, w2a.w, w2b.x, w2b.y, w2b.z, w2b.w};
#pragma unroll
    for (int e = 0; e < 8; ++e) { float v = w1[e] * xc[e]; if (hp) v += w0[e] * xp[e]; if (hn) v += w2[e] * xn[e]; y[e] = v; }
}
constexpr float ATT_QSCALE = 0.08838834764831845f * 1.4426950408889634f;
__device__ __forceinline__ void prep_row_wave(const Ptrs& p, int l, int r, int lane) {
    int b, t, len; bool ic; row_info(r, b, t, len, ic);
    const bool hp = t > 0, hn = t < len - 1;
    const bf16* Pr = p.P + (size_t)r * NP_MAIN;
    { const float* w = p.gdn_conv_w + (size_t)l * 3 * (3 * MIX_W);
#pragma unroll 3
        for (int ps = 0; ps < (3 * MIX_W) / 512; ++ps) { const int col = ps * 512 + lane * 8, grp = col >> 7; float y[8]; conv8(Pr, hp, hn, C_QKV + col, w, 3 * MIX_W, col, y);
            float ss = 0.f;
#pragma unroll
            for (int e = 0; e < 8; ++e) { y[e] = silu_fast(y[e]); ss += y[e] * y[e]; }
            ss = sum16(ss);
            float sc = 1.0f; if (grp < 2 * GDN_H) { sc = 1.0f / sqrtf(ss + EPS); if (grp < GDN_H) sc *= 0.08838834764831845f; }
            *(vu4*)(p.GQKVb + (size_t)r * (3 * MIX_W) + col) = (vu4){cvtpk(y[0] * sc, y[1] * sc), cvtpk(y[2] * sc, y[3] * sc), cvtpk(y[4] * sc, y[5] * sc), cvtpk(y[6] * sc, y[7] * sc)}; } }
    { const float* w = p.ssm_conv_w + (size_t)l * 3 * SSM_XBC; const float* cb = p.ssm_conv_b + (size_t)l * SSM_XBC;
#pragma unroll 3
        for (int ps = 0; ps < SSM_XBC / 512; ++ps) { const int col = ps * 512 + lane * 8; float y[8]; conv8(Pr, hp, hn, C_XBC + col, w, SSM_XBC, col, y);
            const vf4 ba = *(const vf4*)(cb + col), bb = *(const vf4*)(cb + col + 4); const float bs[8] = {ba.x, ba.y, ba.z, ba.w, bb.x, bb.y, bb.z, bb.w};
#pragma unroll
            for (int e = 0; e < 8; ++e) y[e] = silu_fast(y[e] + bs[e]);
            const vu4 w8 = {cvtpk(y[0], y[1]), cvtpk(y[2], y[3]), cvtpk(y[4], y[5]), cvtpk(y[6], y[7])};
            if (col >= MIX_W) *(vu4*)(p.SBCb + (size_t)r * (2 * SSM_BC) + col - MIX_W) = w8; else *(vu4*)(p.SXb + (size_t)r * MIX_W + col) = w8; } }
    if (lane < 2 * GDN_H) prep_gdn_gb_item(p, l, r, lane);
    if (lane < 2 * SSM_H) prep_ssd_dt_item(p, l, r, lane);
    { const int l16 = lane & 15, ax = l16 >> 3, i0 = (l16 & 7) * 4; const int pos = ic ? 0 : (ax ? t % GRID_W : t / GRID_W);
        const vf4 t0 = *(const vf4*)(p.ROPE + (size_t)(pos * 32 + i0) * 2), t1 = *(const vf4*)(p.ROPE + (size_t)(pos * 32 + i0) * 2 + 4);
        const float cs[4] = {t0.x, t0.z, t1.x, t1.z}, sn[4] = {t0.y, t0.w, t1.y, t1.w};
#pragma unroll 3
        for (int ps = 0; ps < 3; ++ps) { const int hh = ps * 4 + (lane >> 4);
            if (hh < ATT_HQ + ATT_HKV) { const bool isq = hh < ATT_HQ; const int h = isq ? hh : hh - ATT_HQ;
                const bf16* src = Pr + (isq ? C_AQ : C_AKV) + h * 128 + ax * 64 + i0;
                const vu2 a = *(const vu2*)src, c = *(const vu2*)(src + 32);
                const float x1[4] = {bflo(a.x), bfhi(a.x), bflo(a.y), bfhi(a.y)}, x2[4] = {bflo(c.x), bfhi(c.x), bflo(c.y), bfhi(c.y)};
                float o1[4], o2[4]; const float sc = isq ? ATT_QSCALE : 1.0f;
#pragma unroll
                for (int e = 0; e < 4; ++e) { o1[e] = (x1[e] * cs[e] - x2[e] * sn[e]) * sc; o2[e] = (x2[e] * cs[e] + x1[e] * sn[e]) * sc; }
                bf16* dst = (isq ? p.AQb + (size_t)r * MIX_W : p.AKb + (size_t)r * (ATT_HKV * 128)) + h * 128 + ax * 64 + i0;
                vu2 w1; w1.x = cvtpk(o1[0], o1[1]); w1.y = cvtpk(o1[2], o1[3]); vu2 w2; w2.x = cvtpk(o2[0], o2[1]); w2.y = cvtpk(o2[2], o2[3]);
                *(vu2*)dst = w1; *(vu2*)(dst + 32) = w2; } } }
}
constexpr int PREP_RB = 17, PREP_QP = (3 * MIX_W) / 512, PREP_NPASS = PREP_QP + SSM_XBC / 512;
static_assert(MROWS % PREP_RB == 0 && (3 * MIX_W) % 512 == 0 && SSM_XBC % 512 == 0 && MIX_W % 512 == 0 && PREP_NPASS <= PREP_RB && 2 * PREP_NPASS >= PREP_RB, "prep tiling");
__device__ __forceinline__ void prep_row_scalars_wave(const Ptrs& p, int l, int r, int lane);
__device__ __forceinline__ void prep_conv_block_wave(const Ptrs& p, int l, int blk, int ps, int lane) {
    const int r0 = blk * PREP_RB; const bool isx = ps >= PREP_QP;
    const int col = (isx ? ps - PREP_QP : ps) * 512 + lane * 8, wld = isx ? SSM_XBC : 3 * MIX_W, grp = col >> 7;
    const float* w = (isx ? p.ssm_conv_w + (size_t)l * 3 * SSM_XBC : p.gdn_conv_w + (size_t)l * 3 * (3 * MIX_W)) + col;
    const vf4 w0a = *(const vf4*)w, w0b = *(const vf4*)(w + 4), w1a = *(const vf4*)(w + wld), w1b = *(const vf4*)(w + wld + 4), w2a = *(const vf4*)(w + 2 * wld), w2b = *(const vf4*)(w + 2 * wld + 4);
    const float w0[8] = {w0a.x, w0a.y, w0a.z, w0a.w, w0b.x, w0b.y, w0b.z, w0b.w}, w1[8] = {w1a.x, w1a.y, w1a.z, w1a.w, w1b.x, w1b.y, w1b.z, w1b.w}, w2[8] = {w2a.x, w2a.y, w2a.z, w2a.w, w2b.x, w2b.y, w2b.z, w2b.w};
    float bs[8] = {0.f, 0.f, 0.f, 0.f, 0.f, 0.f, 0.f, 0.f};
    if (isx) { const float* cb = p.ssm_conv_b + (size_t)l * SSM_XBC + col; const vf4 ba = *(const vf4*)cb, bb = *(const vf4*)(cb + 4); bs[0] = ba.x; bs[1] = ba.y; bs[2] = ba.z; bs[3] = ba.w; bs[4] = bb.x; bs[5] = bb.y; bs[6] = bb.z; bs[7] = bb.w; }
    const bf16* src = p.P + (size_t)r0 * NP_MAIN + (isx ? C_XBC : C_QKV) + col;
    vu4 rows[PREP_RB + 2];
#pragma unroll
    for (int j = 0; j < PREP_RB + 2; ++j) { const int r = r0 - 1 + j; rows[j] = (r >= 0 && r < MROWS) ? *(const vu4*)(src + ((ptrdiff_t)j - 1) * NP_MAIN) : (vu4){0u, 0u, 0u, 0u}; }
    prep_row_scalars_wave(p, l, r0 + ps, lane);
    if (ps + PREP_NPASS < PREP_RB) prep_row_scalars_wave(p, l, r0 + ps + PREP_NPASS, lane);
    float xp[8], xc[8], xn[8];
    unpack8(rows[0], xp); unpack8(rows[1], xc);
#pragma unroll
    for (int i = 0; i < PREP_RB; ++i) { const int r = r0 + i; int b, t, len; bool ic; row_info(r, b, t, len, ic); const bool hp = t > 0, hn = t < len - 1;
        unpack8(rows[i + 2], xn);
        float y[8];
#pragma unroll
        for (int e = 0; e < 8; ++e) { float v = w1[e] * xc[e] + bs[e]; if (hp) v += w0[e] * xp[e]; if (hn) v += w2[e] * xn[e]; y[e] = silu_fast(v); }
        if (isx) { const vu4 w8 = {cvtpk(y[0], y[1]), cvtpk(y[2], y[3]), cvtpk(y[4], y[5]), cvtpk(y[6], y[7])};
            if (col >= MIX_W) *(vu4*)(p.SBCb + (size_t)r * (2 * SSM_BC) + col - MIX_W) = w8; else *(vu4*)(p.SXb + (size_t)r * MIX_W + col) = w8; }
        else { float ss = 0.f;
#pragma unroll
            for (int e = 0; e < 8; ++e) ss += y[e] * y[e];
            ss = sum16(ss);
            float sc = 1.0f; if (grp < 2 * GDN_H) { sc = 1.0f / sqrtf(ss + EPS); if (grp < GDN_H) sc *= 0.08838834764831845f; }
            *(vu4*)(p.GQKVb + (size_t)r * (3 * MIX_W) + col) = (vu4){cvtpk(y[0] * sc, y[1] * sc), cvtpk(y[2] * sc, y[3] * sc), cvtpk(y[4] * sc, y[5] * sc), cvtpk(y[6] * sc, y[7] * sc)}; }
#pragma unroll
        for (int e = 0; e < 8; ++e) { xp[e] = xc[e]; xc[e] = xn[e]; } }
}
__device__ __forceinline__ void prep_row_scalars_wave(const Ptrs& p, int l, int r, int lane) {
    int b, t, len; bool ic; row_info(r, b, t, len, ic);
    const bf16* Pr = p.P + (size_t)r * NP_MAIN;
    if (lane < 2 * GDN_H) prep_gdn_gb_item(p, l, r, lane);
    if (lane < 2 * SSM_H) prep_ssd_dt_item(p, l, r, lane);
    { const int l16 = lane & 15, ax = l16 >> 3, i0 = (l16 & 7) * 4; const int pos = ic ? 0 : (ax ? t % GRID_W : t / GRID_W);
        const vf4 t0 = *(const vf4*)(p.ROPE + (size_t)(pos * 32 + i0) * 2), t1 = *(const vf4*)(p.ROPE + (size_t)(pos * 32 + i0) * 2 + 4);
        const float cs[4] = {t0.x, t0.z, t1.x, t1.z}, sn[4] = {t0.y, t0.w, t1.y, t1.w};
#pragma unroll 3
        for (int ps = 0; ps < 3; ++ps) { const int hh = ps * 4 + (lane >> 4);
            if (hh < ATT_HQ + ATT_HKV) { const bool isq = hh < ATT_HQ; const int h = isq ? hh : hh - ATT_HQ;
                const bf16* src = Pr + (isq ? C_AQ : C_AKV) + h * 128 + ax * 64 + i0;
                const vu2 a = *(const vu2*)src, c = *(const vu2*)(src + 32);
                const float x1[4] = {bflo(a.x), bfhi(a.x), bflo(a.y), bfhi(a.y)}, x2[4] = {bflo(c.x), bfhi(c.x), bflo(c.y), bfhi(c.y)};
                float o1[4], o2[4]; const float sc = isq ? ATT_QSCALE : 1.0f;
#pragma unroll
                for (int e = 0; e < 4; ++e) { o1[e] = (x1[e] * cs[e] - x2[e] * sn[e]) * sc; o2[e] = (x2[e] * cs[e] + x1[e] * sn[e]) * sc; }
                bf16* dst = (isq ? p.AQb + (size_t)r * MIX_W : p.AKb + (size_t)r * (ATT_HKV * 128)) + h * 128 + ax * 64 + i0;
                vu2 w1; w1.x = cvtpk(o1[0], o1[1]); w1.y = cvtpk(o1[2], o1[3]); vu2 w2; w2.x = cvtpk(o2[0], o2[1]); w2.y = cvtpk(o2[2], o2[3]);
                *(vu2*)dst = w1; *(vu2*)(dst + 32) = w2; } } }
}
__device__ __forceinline__ void mixout_row_wave(const Ptrs& p, int l, int r, int lane) {
    const int c0 = lane * 16;
    {
        float o[16]; float ss = 0.f;
#pragma unroll
        for (int q = 0; q < 2; ++q) { float a8[8], b8[8]; unpack8(__builtin_nontemporal_load((const vu4*)(p.OGb + (size_t)r * MIX_W + c0 + 8 * q)), a8); unpack8(__builtin_nontemporal_load((const vu4*)(p.OGb + ((size_t)MROWS + r) * MIX_W + c0 + 8 * q)), b8);
#pragma unroll
            for (int e = 0; e < 8; ++e) o[8 * q + e] = a8[e] + b8[e]; }
#pragma unroll
        for (int e = 0; e < 16; ++e) ss += o[e] * o[e];
        ss = sum8(ss);
        const float rs = 1.0f / sqrtf(ss * (1.0f / 128.0f) + EPS);
        float gt[16]; { float t8[8]; unpack8(*(const vu4*)(p.P + (size_t)r * NP_MAIN + C_GATE + c0), t8);
#pragma unroll
            for (int e = 0; e < 8; ++e) gt[e] = t8[e];
            unpack8(*(const vu4*)(p.P + (size_t)r * NP_MAIN + C_GATE + c0 + 8), t8);
#pragma unroll
            for (int e = 0; e < 8; ++e) gt[8 + e] = t8[e]; }
        const float* nw = p.gdn_norm + (size_t)l * 128 + (c0 & 127);
        unsigned w[8];
#pragma unroll
        for (int e = 0; e < 8; ++e) w[e] = cvtpk(o[2 * e] * rs * nw[2 * e] * silu_fast(gt[2 * e]), o[2 * e + 1] * rs * nw[2 * e + 1] * silu_fast(gt[2 * e + 1]));
        *(vu4*)(p.YA + (size_t)r * YLD + c0) = (vu4){w[0], w[1], w[2], w[3]}; *(vu4*)(p.YA + (size_t)r * YLD + c0 + 8) = (vu4){w[4], w[5], w[6], w[7]};
    }
    {
        float y[16]; float ss = 0.f; const float dsk = p.ssm_d[(size_t)l * SSM_H + c0 / SSM_P];
        float zt[16]; { float t8[8]; unpack8(*(const vu4*)(p.P + (size_t)r * NP_MAIN + C_Z + c0), t8);
#pragma unroll
            for (int e = 0; e < 8; ++e) zt[e] = t8[e];
            unpack8(*(const vu4*)(p.P + (size_t)r * NP_MAIN + C_Z + c0 + 8), t8);
#pragma unroll
            for (int e = 0; e < 8; ++e) zt[8 + e] = t8[e]; }
#pragma unroll
        for (int q = 0; q < 2; ++q) { float a8[8], c8[8], d8[8], x8[8]; unpack8(__builtin_nontemporal_load((const vu4*)(p.OSb + (size_t)r * MIX_W + c0 + 8 * q)), a8);
            unpack8(__builtin_nontemporal_load((const vu4*)(p.OSb2 + (size_t)r * MIX_W + c0 + 8 * q)), c8); unpack8(__builtin_nontemporal_load((const vu4*)(p.OSb2 + ((size_t)MROWS + r) * MIX_W + c0 + 8 * q)), d8); unpack8(*(const vu4*)(p.SXb + (size_t)r * MIX_W + c0 + 8 * q), x8);
#pragma unroll
            for (int e = 0; e < 8; ++e) y[8 * q + e] = a8[e] + (c8[e] + d8[e]) + dsk * x8[e]; }
#pragma unroll
        for (int e = 0; e < 16; ++e) { y[e] *= silu_fast(zt[e]); ss += y[e] * y[e]; }
        ss = sum16(ss); ss += __shfl_xor(ss, 16);
        const float rs = 1.0f / sqrtf(ss * (1.0f / (float)(MIX_W / SSM_G)) + EPS);
        const float* nw = p.ssm_norm + (size_t)l * MIX_W + c0;
        unsigned w[8];
#pragma unroll
        for (int e = 0; e < 8; ++e) w[e] = cvtpk(y[2 * e] * rs * nw[2 * e], y[2 * e + 1] * rs * nw[2 * e + 1]);
        *(vu4*)(p.YB + (size_t)r * YLD + c0) = (vu4){w[0], w[1], w[2], w[3]}; *(vu4*)(p.YB + (size_t)r * YLD + c0 + 8) = (vu4){w[4], w[5], w[6], w[7]};
    }
}
static_assert(MIX_W == 1024 && SSM_P == 64 && MIX_W / SSM_G == 512, "mixout_row_wave lane mapping assumes the real shapes");
__device__ __forceinline__ void act_vec_item(const Ptrs& p, int l, int r, int j) {
    int b, t, len; bool ic; row_info(r, b, t, len, ic);
    const bf16* ug = p.UG + (size_t)r * (2 * D_FF);
    float u[8], g[8], gp[8], gn[8];
    unpack8(*(const vu4*)(ug + j), u); unpack8(*(const vu4*)(ug + D_FF + j), g);
    const bool hp = t > 0, hn = t < len - 1;
    if (hp) unpack8(*(const vu4*)(ug - 2 * D_FF + D_FF + j), gp);
    if (hn) unpack8(*(const vu4*)(ug + 2 * D_FF + D_FF + j), gn);
    const float* w = p.ffn_conv_w + (size_t)l * 3 * D_FF + j; const float* cb = p.ffn_conv_b + (size_t)l * D_FF + j;
    unsigned o[4];
    float a[8];
#pragma unroll
    for (int e = 0; e < 8; ++e) { float v = w[D_FF + e] * g[e] + cb[e]; if (hp) v += w[e] * gp[e]; if (hn) v += w[2 * D_FF + e] * gn[e]; a[e] = silu_fast(v) * u[e]; }
#pragma unroll
    for (int e = 0; e < 4; ++e) o[e] = cvtpk(a[2 * e], a[2 * e + 1]);
    *(vu4*)(p.ACT + (size_t)r * D_FF + j) = (vu4){o[0], o[1], o[2], o[3]};
}

__device__ __forceinline__ void act_task(const Ptrs& p, int l, int task) {
    constexpr int NJ = D_FF / 8;
    const int rc = task / NJ, j = (task % NJ) * 8, r0 = rc * 16;
    int b, t, len; bool ic; row_info(r0, b, t, len, ic);
    const float* w = p.ffn_conv_w + (size_t)l * 3 * D_FF + j; const float* cb = p.ffn_conv_b + (size_t)l * D_FF + j;
    float w0[8], w1[8], w2[8], bs[8];
    { const vf4 a0 = *(const vf4*)w, a1 = *(const vf4*)(w + 4), b0 = *(const vf4*)(w + D_FF), b1 = *(const vf4*)(w + D_FF + 4), c0 = *(const vf4*)(w + 2 * D_FF), c1 = *(const vf4*)(w + 2 * D_FF + 4), d0 = *(const vf4*)cb, d1 = *(const vf4*)(cb + 4);
        const float t0[8] = {a0.x, a0.y, a0.z, a0.w, a1.x, a1.y, a1.z, a1.w}, t1[8] = {b0.x, b0.y, b0.z, b0.w, b1.x, b1.y, b1.z, b1.w}, t2[8] = {c0.x, c0.y, c0.z, c0.w, c1.x, c1.y, c1.z, c1.w}, t3[8] = {d0.x, d0.y, d0.z, d0.w, d1.x, d1.y, d1.z, d1.w};
#pragma unroll
        for (int e = 0; e < 8; ++e) { w0[e] = t0[e]; w1[e] = t1[e]; w2[e] = t2[e]; bs[e] = t3[e]; } }
    const bf16* base = p.UG + (size_t)r0 * (2 * D_FF) + j;
    vu4 gq[18], uq[16];
    const vu4 z4 = {0u, 0u, 0u, 0u};
    gq[0] = (t > 0) ? *(const vu4*)(base - 2 * D_FF + D_FF) : z4;
#pragma unroll
    for (int i = 0; i < 16; ++i) { gq[i + 1] = *(const vu4*)(base + (size_t)i * (2 * D_FF) + D_FF); uq[i] = *(const vu4*)(base + (size_t)i * (2 * D_FF)); }
    gq[17] = (t + 16 < len) ? *(const vu4*)(base + (size_t)16 * (2 * D_FF) + D_FF) : z4;
#pragma unroll
    for (int i = 0; i < 16; ++i) { float gp[8], gc[8], gn[8], u[8]; unpack8(gq[i], gp); unpack8(gq[i + 1], gc); unpack8(gq[i + 2], gn); unpack8(uq[i], u);
        float a[8];
#pragma unroll
        for (int e = 0; e < 8; ++e) a[e] = silu_fast(w0[e] * gp[e] + w1[e] * gc[e] + w2[e] * gn[e] + bs[e]) * u[e];
        *(vu4*)(p.ACT + (size_t)(r0 + i) * D_FF + j) = (vu4){cvtpk(a[0], a[1]), cvtpk(a[2], a[3]), cvtpk(a[4], a[5]), cvtpk(a[6], a[7])}; }
}
static_assert(SEQ % 16 == 0 && CTX_LEN % 16 == 0, "act_task row chunks must not straddle sequences");

__device__ __forceinline__ void act_fix_item(const Ptrs& p, int l, int bidx, int j) {
    const int row = (bidx >> 1) * 64 + ((bidx & 1) ? 63 : 0);
    int b, t, len; bool ic; row_info(row, b, t, len, ic);
    const size_t bi = (size_t)bidx * D_FF + j;
    vf4 pre = *(const vf4*)(p.BP + bi);
    const vu2 uw = *(const vu2*)(p.BU + bi);
    const bool hasn = (bidx & 1) ? (t < len - 1) : (t > 0);
    if (hasn) { const vu2 gw = *(const vu2*)(p.BG + (size_t)((bidx & 1) ? bidx + 1 : bidx - 1) * D_FF + j);
        const vf4 w = *(const vf4*)(p.ffn_conv_w + (size_t)l * 3 * D_FF + ((bidx & 1) ? 2 * D_FF : 0) + j);
        pre += w * (vf4){bflo(gw.x), bfhi(gw.x), bflo(gw.y), bfhi(gw.y)}; }
    const float u4[4] = {bflo(uw.x), bfhi(uw.x), bflo(uw.y), bfhi(uw.y)};
    *(vu2*)(p.ACT + (size_t)row * D_FF + j) = (vu2){cvtpk(silu_fast(pre.x) * u4[0], silu_fast(pre.y) * u4[1]), cvtpk(silu_fast(pre.z) * u4[2], silu_fast(pre.w) * u4[3])};
}

constexpr int AT_KSTR = 136, AT_VSTR = 68;
constexpr int AT_BUF = 64 * AT_KSTR + 128 * AT_VSTR;
constexpr int ATT_UNITS_LAT = BATCH * ATT_HKV * (SEQ / 64), ATT_UNITS_CTX = BATCH * ATT_HKV * (CTX_LEN / 64);
__device__ __forceinline__ void attn_unit(const Ptrs& p, int l, LAS bf16* L, int unit, int tid) {
    const int lane = tid & 63, wave = tid >> 6, r32 = lane & 31, h = lane >> 5;
    const bool cu = unit >= ATT_UNITS_LAT; const int uu = cu ? unit - ATT_UNITS_LAT : unit;
    const int nqb = cu ? CTX_LEN / 64 : SEQ / 64;
    const int b = uu / (ATT_HKV * nqb), kvh = (uu / nqb) % ATT_HKV, qb = uu % nqb, q0 = qb * 64;
    const int rowbase = (cu ? NLAT + b * CTX_LEN : b * SEQ) + q0;
    const int g = wave >> 1, qh = wave & 1, hq = kvh * ATT_GRP + g;
    const int qpos = q0 + 32 * qh + r32, qrow = rowbase + 32 * qh + r32;
    bf16x8_t qf[8];
#pragma unroll
    for (int s = 0; s < 8; ++s) qf[s] = *(const bf16x8_t*)(p.AQb + (size_t)qrow * MIX_W + hq * 128 + 16 * s + 8 * h);
    float m = p.attn_sink[(size_t)l * ATT_HQ + hq] * 1.4426950408889634f, lsum = h ? 0.f : 1.0f;
    f32x16_t o[4];
#pragma unroll
    for (int d = 0; d < 4; ++d)
#pragma unroll
        for (int e = 0; e < 16; ++e) o[d][e] = 0.f;
    const int jl0 = cu ? 5 : (q0 - 128 < 0 ? (128 - q0) / 64 : 0), jl1 = cu ? 5 : ((q0 + 192 > SEQ) ? 5 - (q0 + 192 - SEQ) / 64 : 5);
    const int nt = (jl1 - jl0) + CTX_LEN / 64;
    vu4 rk[2], rv[2];
    auto tile_row0 = [&](int ti, int& kpos0) -> int { const int j = jl0 + ti; if (j < jl1) { kpos0 = q0 - 128 + 64 * j; return b * SEQ + kpos0; } kpos0 = -1000000; return NLAT + b * CTX_LEN + 64 * (j - jl1); };
    auto gload = [&](int ti) { int kp; const int kr0 = tile_row0(ti, kp);
#pragma unroll
        for (int it = 0; it < 2; ++it) { const int c = tid + 512 * it;
            rk[it] = *(const vu4*)(p.AKb + (size_t)(kr0 + (c >> 4)) * (ATT_HKV * 128) + kvh * 128 + (c & 15) * 8);
            const int vk = (c & 15) | (((c >> 6) & 3) << 4), vd = ((c >> 4) & 3) | ((c >> 8) << 2);
            rv[it] = *(const vu4*)(p.P + (size_t)(kr0 + vk) * NP_MAIN + C_AKV + ATT_HKV * 128 + kvh * 128 + vd * 8); } };
    auto lstore = [&](LAS bf16* B) {
#pragma unroll
        for (int it = 0; it < 2; ++it) { const int c = tid + 512 * it;
            *(LAS vu4*)(B + (c >> 4) * AT_KSTR + (c & 15) * 8) = rk[it];
            const int vk = (c & 15) | (((c >> 6) & 3) << 4), vd = ((c >> 4) & 3) | ((c >> 8) << 2);
            LAS bf16* vt = B + 64 * AT_KSTR + (vd * 8) * AT_VSTR + vk;
            const unsigned w4[4] = {rv[it].x, rv[it].y, rv[it].z, rv[it].w};
#pragma unroll
            for (int e = 0; e < 4; ++e) { vt[(2 * e) * AT_VSTR] = (bf16)(w4[e] & 0xffffu); vt[(2 * e + 1) * AT_VSTR] = (bf16)(w4[e] >> 16); } } };
    gload(0); lstore(L); LDS_BARRIER();
    for (int ti = 0; ti < nt; ++ti) {
        LAS bf16* B = L + (ti & 1) * AT_BUF;
        int kpos0; (void)tile_row0(ti, kpos0);
        if (ti + 1 < nt) gload(ti + 1);
        f32x16_t st[2];
#pragma unroll
        for (int sub = 0; sub < 2; ++sub) {
#pragma unroll
            for (int e = 0; e < 16; ++e) st[sub][e] = 0.f;
            bf16x8_t kf[8];
#pragma unroll
            for (int s = 0; s < 8; ++s) kf[s] = *(const LAS bf16x8_t*)(B + (32 * sub + r32) * AT_KSTR + 16 * s + 8 * h);
            __builtin_amdgcn_s_setprio(1);
#pragma unroll
            for (int s = 0; s < 8; ++s) st[sub] = __builtin_amdgcn_mfma_f32_32x32x16_bf16(kf[s], qf[s], st[sub], 0, 0, 0);
            __builtin_amdgcn_s_setprio(0); }
        float mx = -1e30f;
#pragma unroll
        for (int sub = 0; sub < 2; ++sub)
#pragma unroll
            for (int e = 0; e < 16; ++e) { const int key = 32 * sub + (e & 3) + 8 * (e >> 2) + 4 * h; const int dlt = kpos0 + key - qpos;
                if (kpos0 > -500000 && (dlt > WINDOW || dlt < -WINDOW)) st[sub][e] = -1e30f;
                mx = fmaxf(mx, st[sub][e]); }
        mx = fmaxf(mx, __shfl_xor(mx, 32));
        const float mn = fmaxf(m, mx), alpha = __builtin_amdgcn_exp2f(m - mn); m = mn;
        float ps = 0.f;
#pragma unroll
        for (int sub = 0; sub < 2; ++sub)
#pragma unroll
            for (int e = 0; e < 16; ++e) { const float pe = __builtin_amdgcn_exp2f(st[sub][e] - mn); st[sub][e] = pe; ps += pe; }
        lsum = lsum * alpha + ps;
        if (!__all(alpha == 1.0f)) {
#pragma unroll
            for (int d = 0; d < 4; ++d)
#pragma unroll
                for (int e = 0; e < 16; ++e) o[d][e] *= alpha; }
#pragma unroll
        for (int kk = 0; kk < 4; ++kk) { const int sub = kk >> 1, s8 = (kk & 1) * 8;
            vu4 pw; pw.x = cvtpk(st[sub][s8], st[sub][s8 + 1]); pw.y = cvtpk(st[sub][s8 + 2], st[sub][s8 + 3]); pw.z = cvtpk(st[sub][s8 + 4], st[sub][s8 + 5]); pw.w = cvtpk(st[sub][s8 + 6], st[sub][s8 + 7]);
            const bf16x8_t pf = __builtin_bit_cast(bf16x8_t, pw);
            bf16x8_t vf[4];
#pragma unroll
            for (int d = 0; d < 4; ++d) { const LAS bf16* vp = B + 64 * AT_KSTR + (32 * d + r32) * AT_VSTR + 16 * kk + 4 * h;
                const vu2 lo = *(const LAS vu2*)vp, hi = *(const LAS vu2*)(vp + 8);
                vf[d] = __builtin_bit_cast(bf16x8_t, (vu4){lo.x, lo.y, hi.x, hi.y}); }
            __builtin_amdgcn_s_setprio(1);
#pragma unroll
            for (int d = 0; d < 4; ++d) o[d] = __builtin_amdgcn_mfma_f32_32x32x16_bf16(vf[d], pf, o[d], 0, 0, 0);
            __builtin_amdgcn_s_setprio(0); }
        if (ti + 1 < nt) lstore(L + ((ti + 1) & 1) * AT_BUF);
        LDS_BARRIER();
    }
    lsum += __shfl_xor(lsum, 32);
    const float inv = 1.0f / lsum;
    LAS bf16* os = L + wave * (32 * AT_KSTR);
#pragma unroll
    for (int d = 0; d < 4; ++d)
#pragma unroll
        for (int a4 = 0; a4 < 4; ++a4) { vu2 w; w.x = cvtpk(o[d][4 * a4] * inv, o[d][4 * a4 + 1] * inv); w.y = cvtpk(o[d][4 * a4 + 2] * inv, o[d][4 * a4 + 3] * inv);
            *(LAS vu2*)(os + r32 * AT_KSTR + 32 * d + 8 * a4 + 4 * h) = w; }
    LDS_BARRIER();
#pragma unroll
    for (int i = 0; i < 8; ++i) { const int c = lane + 64 * i, row = c >> 4, ch = c & 15;
        *(vu4*)(p.YC + (size_t)(rowbase + 32 * qh + row) * YLD + hq * 128 + ch * 8) = *(const LAS vu4*)(os + row * AT_KSTR + ch * 8); }
    LDS_BARRIER();
}
static_assert(2 * AT_BUF * 2 <= 131072 && 8 * 32 * AT_KSTR <= 2 * AT_BUF, "attention LDS map");

constexpr int NCH = CHAIN_LEN / 64, NCH_CTX = CTX_LEN / 64;
constexpr int GDN_NU = BATCH * NCH * GDN_H * 2;
constexpr int GC_KS = 136, GC_FS = 65, GC_LS = 68, GC_TS = 72;
__device__ __forceinline__ int gdn_unit_index(int b, int c, int h, int dir) { return ((b * NCH + c) * GDN_H + h) * 2 + dir; }
__device__ __forceinline__ int chunk_row0(int b, int c) { return c < NCH_CTX ? NLAT + b * CTX_LEN + 64 * c : b * SEQ + 64 * (c - NCH_CTX); }
template <int NK> __device__ __forceinline__ f32x16_t mma_lds(f32x16_t acc, const LAS bf16* A, int lda, const LAS bf16* Bt, int ldb, int r32, int hh) {
    bf16x8_t a[NK], bb[NK];
#pragma unroll
    for (int s = 0; s < NK; ++s) { a[s] = *(const LAS bf16x8_t*)(A + r32 * lda + 16 * s + 8 * hh); bb[s] = *(const LAS bf16x8_t*)(Bt + r32 * ldb + 16 * s + 8 * hh); }
    f32x16_t acc2;
#pragma unroll
    for (int e = 0; e < 16; ++e) acc2[e] = 0.f;
#pragma unroll
    for (int s = 0; s < NK; s += 2) { acc = __builtin_amdgcn_mfma_f32_32x32x16_bf16(a[s], bb[s], acc, 0, 0, 0); acc2 = __builtin_amdgcn_mfma_f32_32x32x16_bf16(a[s + 1], bb[s + 1], acc2, 0, 0, 0); }
#pragma unroll
    for (int e = 0; e < 16; ++e) acc[e] += acc2[e];
    return acc;
}
__device__ __forceinline__ f32x16_t zero16() { f32x16_t z;
#pragma unroll
    for (int e = 0; e < 16; ++e) z[e] = 0.f;
    return z; }
__device__ __forceinline__ void tri_solve_wave(const LAS float* Lm, LAS bf16* Tm, LAS bf16* scr, int lane) {
    const int blk = lane >> 5, c = lane & 31, r32 = c, hh = blk;
    LAS bf16* B00 = scr; LAS bf16* XT = scr + 32 * 40;
    float t[32];
    vf4 lb[3][8];
#define TRI_LDROW(i_) do { _Pragma("unroll") for (int j4 = 0; j4 < ((i_) + 3) / 4; ++j4) lb[(i_) % 3][j4] = *(const LAS vf4*)(Lm + (32 * blk + (i_)) * GC_LS + 32 * blk + 4 * j4); } while (0)
    TRI_LDROW(1);
#pragma unroll
    for (int i = 0; i < 32; ++i) {
        if (i + 2 < 32) TRI_LDROW(i + 2);
        float s = (i == c) ? 1.0f : 0.0f;
#pragma unroll
        for (int j4 = 0; j4 < (i + 3) / 4; ++j4) { const vf4 lv = lb[i % 3][j4];
            if (4 * j4 + 0 < i) s -= lv.x * t[4 * j4 + 0];
            if (4 * j4 + 1 < i) s -= lv.y * t[4 * j4 + 1];
            if (4 * j4 + 2 < i) s -= lv.z * t[4 * j4 + 2];
            if (4 * j4 + 3 < i) s -= lv.w * t[4 * j4 + 3]; }
        t[i] = s;
        asm volatile("" : "+v"(t[i]));
    }
#undef TRI_LDROW
#pragma unroll
    for (int i = 0; i < 32; ++i) { Tm[(32 * blk + i) * GC_TS + 32 * blk + c] = f2bf(t[i]); if (blk == 0) Tm[i * GC_TS + 32 + c] = (bf16)0; }
    if (blk == 0) {
#pragma unroll
        for (int q = 0; q < 4; ++q) *(LAS vu4*)(B00 + c * 40 + 8 * q) = (vu4){cvtpk(t[8 * q], t[8 * q + 1]), cvtpk(t[8 * q + 2], t[8 * q + 3]), cvtpk(t[8 * q + 4], t[8 * q + 5]), cvtpk(t[8 * q + 6], t[8 * q + 7])}; }
    f32x16_t x = zero16();
#pragma unroll
    for (int s = 0; s < 2; ++s) { const LAS float* lp = Lm + (32 + r32) * GC_LS + 16 * s + 8 * hh; const vf4 l0 = *(const LAS vf4*)lp, l1 = *(const LAS vf4*)(lp + 4);
        const bf16x8_t a = __builtin_bit_cast(bf16x8_t, (vu4){cvtpk(l0.x, l0.y), cvtpk(l0.z, l0.w), cvtpk(l1.x, l1.y), cvtpk(l1.z, l1.w)});
        const bf16x8_t bb = *(const LAS bf16x8_t*)(B00 + r32 * 40 + 16 * s + 8 * hh);
        x = __builtin_amdgcn_mfma_f32_32x32x16_bf16(a, bb, x, 0, 0, 0); }
#pragma unroll
    for (int a4 = 0; a4 < 4; ++a4) *(LAS vu2*)(XT + r32 * 40 + 8 * a4 + 4 * hh) = (vu2){cvtpk(x[4 * a4], x[4 * a4 + 1]), cvtpk(x[4 * a4 + 2], x[4 * a4 + 3])};
    f32x16_t y = zero16();
#pragma unroll
    for (int s = 0; s < 2; ++s) { const bf16x8_t a = *(const LAS bf16x8_t*)(Tm + (32 + r32) * GC_TS + 32 + 16 * s + 8 * hh), bb = *(const LAS bf16x8_t*)(XT + r32 * 40 + 16 * s + 8 * hh);
        y = __builtin_amdgcn_mfma_f32_32x32x16_bf16(a, bb, y, 0, 0, 0); }
#pragma unroll
    for (int e = 0; e < 16; ++e) Tm[(32 + (e & 3) + 8 * (e >> 2) + 4 * hh) * GC_TS + r32] = f2bf(-y[e]);
}
constexpr int G1_KK = 0, G1_QK = G1_KK + 64 * GC_FS * 4, G1_L = G1_QK + 64 * GC_FS * 4, G1_T = G1_L + 2 * 64 * GC_LS * 4,
              G1_KB = G1_T + 2 * 64 * GC_TS * 2, G1_VB = G1_KB + 128 * GC_TS * 2, G1_SM = G1_VB + 128 * GC_TS * 2, G1_END = G1_SM + 10 * 64 * 4;
__device__ __forceinline__ void st_vu2(LAS bf16* q, vu2 v) { *(LAS vu2*)q = v; }
__device__ __forceinline__ void st_vu2(bf16* q, vu2 v) { __builtin_nontemporal_store(v, (vu2*)q); }
__device__ __forceinline__ void gdn_g1_unit(const Ptrs& p, LAS unsigned char* lds, int unit, int tid) {
    const int lane = tid & 63, wave = tid >> 6, r32 = lane & 31, hh = lane >> 5;
    const int b = unit / (NCH * GDN_H), c = (unit / GDN_H) % NCH, h = unit % GDN_H;
    const int r0 = chunk_row0(b, c);
    LAS float* KKs = (LAS float*)(lds + G1_KK); LAS float* QKs = (LAS float*)(lds + G1_QK);
    LAS float* Lm = (LAS float*)(lds + G1_L); LAS bf16* Tm = (LAS bf16*)(lds + G1_T); LAS bf16* KbT = (LAS bf16*)(lds + G1_KB); LAS bf16* VbT = (LAS bf16*)(lds + G1_VB);
    LAS float* gc = (LAS float*)(lds + G1_SM); LAS float* be = gc + 128; LAS float* eg = gc + 256; LAS float* beg = gc + 384; LAS float* egl = gc + 512;
    const bf16* Qg = p.GQKVb + (size_t)r0 * (3 * MIX_W) + h * 128;
    const int prod = wave >> 2, mt = (wave >> 1) & 1, nt = wave & 1;
    bf16x8_t fa[8], fb[8], ft[4];
    { const bf16* Ap = Qg + (size_t)(32 * mt + r32) * (3 * MIX_W) + (prod ? 0 : MIX_W) + 8 * hh;
      const bf16* Bp = Qg + (size_t)(32 * nt + r32) * (3 * MIX_W) + MIX_W + 8 * hh;
      const bf16* Tp = Qg + (size_t)(32 * mt + r32) * (3 * MIX_W) + (prod ? 2 * MIX_W : MIX_W) + 64 * nt + 8 * hh;
#pragma unroll
      for (int s = 0; s < 8; ++s) { fa[s] = *(const bf16x8_t*)(Ap + 16 * s); fb[s] = *(const bf16x8_t*)(Bp + 16 * s); }
#pragma unroll
      for (int s = 0; s < 4; ++s) ft[s] = *(const bf16x8_t*)(Tp + 16 * s); }
    if (wave < 2) { const int dir = wave, n = dir ? 63 - lane : lane; const size_t gi = (size_t)(r0 + n) * 2 * GDN_H + dir * GDN_H + h;
        float x = p.GG[gi]; const float bt = p.GB[gi];
#pragma unroll
        for (int o = 1; o < 64; o <<= 1) { const float y = __shfl_up(x, o); if (lane >= o) x += y; }
        const float x63 = __shfl(x, 63), ex = __expf(x);
        gc[dir * 64 + lane] = x; be[dir * 64 + lane] = bt; eg[dir * 64 + lane] = ex; beg[dir * 64 + lane] = bt * ex; egl[dir * 64 + lane] = __expf(x63 - x); }
    f32x16_t tt[2];
    { f32x16_t acc = zero16(), acc2 = zero16();
#pragma unroll
      for (int s = 0; s < 8; s += 2) { acc = __builtin_amdgcn_mfma_f32_32x32x16_bf16(fa[s], fb[s], acc, 0, 0, 0); acc2 = __builtin_amdgcn_mfma_f32_32x32x16_bf16(fa[s + 1], fb[s + 1], acc2, 0, 0, 0); }
      LAS float* dst = prod ? QKs : KKs;
#pragma unroll
      for (int e = 0; e < 16; ++e) dst[(32 * mt + (e & 3) + 8 * (e >> 2) + 4 * hh) * GC_FS + 32 * nt + r32] = acc[e] + acc2[e];
      bf16x8_t id[2];
#pragma unroll
      for (int s = 0; s < 2; ++s) { unsigned w[4];
#pragma unroll
          for (int e2 = 0; e2 < 4; ++e2) { const int k0 = 16 * s + 8 * hh + 2 * e2; w[e2] = (k0 == r32 ? 0x3F80u : 0u) | (k0 + 1 == r32 ? 0x3F800000u : 0u); }
          id[s] = __builtin_bit_cast(bf16x8_t, (vu4){w[0], w[1], w[2], w[3]}); }
#pragma unroll
      for (int j = 0; j < 2; ++j) { tt[j] = zero16();
          tt[j] = __builtin_amdgcn_mfma_f32_32x32x16_bf16(ft[2 * j], id[0], tt[j], 0, 0, 0); tt[j] = __builtin_amdgcn_mfma_f32_32x32x16_bf16(ft[2 * j + 1], id[1], tt[j], 0, 0, 0); } }
    LDS_BARRIER();
    auto put_T = [&](int dir, const LAS float* tab, auto dstf) {
#pragma unroll
        for (int j = 0; j < 2; ++j) {
#pragma unroll
            for (int a4 = 0; a4 < 4; ++a4) { const int n0 = 32 * mt + 8 * a4 + 4 * hh;
                if (dir == 0) { const vf4 sc = *(const LAS vf4*)(tab + n0);
                    st_vu2(dstf(j, n0), (vu2){cvtpk(tt[j][4 * a4] * sc.x, tt[j][4 * a4 + 1] * sc.y), cvtpk(tt[j][4 * a4 + 2] * sc.z, tt[j][4 * a4 + 3] * sc.w)}); }
                else { const int i0 = 60 - n0; const vf4 sc = *(const LAS vf4*)(tab + 64 + i0);
                    st_vu2(dstf(j, i0), (vu2){cvtpk(tt[j][4 * a4 + 3] * sc.x, tt[j][4 * a4 + 2] * sc.y), cvtpk(tt[j][4 * a4 + 1] * sc.z, tt[j][4 * a4] * sc.w)}); } } } };
    auto lds_T = [&](LAS bf16* img) { return [=](int j, int i0) { return img + (64 * nt + 32 * j + r32) * GC_TS + i0; }; };
    auto kdt_T = [&](int dir) { bf16* base = p.GKdT + (size_t)gdn_unit_index(b, c, h, dir) * 128 * 64; return [=](int j, int i0) { return base + (((2 * nt + j) * 4 + (i0 >> 4)) * 64 + ((i0 >> 3) & 1) * 32 + r32) * 8 + (i0 & 7); }; };
    if (prod == 0) { put_T(0, egl, kdt_T(0)); put_T(1, egl, kdt_T(1)); put_T(0, beg, lds_T(KbT)); }
    else {
        const int dir = nt, n = 32 * mt + r32, i = dir ? 63 - n : n; const float sc = eg[dir * 64 + i];
        bf16* base = p.GQd + (size_t)gdn_unit_index(b, c, h, dir) * 64 * 128 + ((size_t)((i >> 5) * 8) * 64 + hh * 32 + (i & 31)) * 8;
#pragma unroll
        for (int q = 0; q < 8; ++q) { float q8[8]; unpack8(__builtin_bit_cast(vu4, fa[q]), q8);
            __builtin_nontemporal_store((vu4){cvtpk(q8[0] * sc, q8[1] * sc), cvtpk(q8[2] * sc, q8[3] * sc), cvtpk(q8[4] * sc, q8[5] * sc), cvtpk(q8[6] * sc, q8[7] * sc)}, (vu4*)(base + q * 512)); }
        put_T(0, be, lds_T(VbT)); }
#pragma unroll
    for (int it = 0; it < 2; ++it) { const int item = it * 512 + tid, dir = item >> 9, j0 = ((item >> 6) & 7) * 8, i = item & 63, ni = dir ? 63 - i : i;
        float o[8] = {0.f, 0.f, 0.f, 0.f, 0.f, 0.f, 0.f, 0.f};
        if (j0 < i) { const float gi = gc[dir * 64 + i], bi = be[dir * 64 + i]; const vf4 ga = *(const LAS vf4*)(gc + dir * 64 + j0), gb = *(const LAS vf4*)(gc + dir * 64 + j0 + 4);
            const float gj[8] = {ga.x, ga.y, ga.z, ga.w, gb.x, gb.y, gb.z, gb.w};
#pragma unroll
            for (int q = 0; q < 8; ++q) { const int j = j0 + q, nj = dir ? 63 - j : j; o[q] = (i > j) ? bi * KKs[ni * GC_FS + nj] * __expf(gi - gj[q]) : 0.0f; } }
        LAS float* dst = Lm + dir * 64 * GC_LS + i * GC_LS + j0;
        *(LAS vf4*)dst = (vf4){o[0], o[1], o[2], o[3]}; *(LAS vf4*)(dst + 4) = (vf4){o[4], o[5], o[6], o[7]}; }
    LDS_BARRIER();
    if (wave < 2) { __builtin_amdgcn_s_setprio(3); tri_solve_wave(Lm + wave * 64 * GC_LS, Tm + wave * 64 * GC_TS, (LAS bf16*)KKs + wave * 2 * 32 * 40, lane); __builtin_amdgcn_s_setprio(0); }
    else if ((wave & 3) >= 2) { const int t6 = ((wave & 1) | ((wave >> 2) << 1)) * 64 + lane;
        for (int it = t6; it < 2 * 64 * 8; it += 256) { const int dir = it >> 9, j8 = (it >> 6) & 7, i = it & 63, ni = dir ? 63 - i : i; unsigned w[4];
#pragma unroll
            for (int e2 = 0; e2 < 4; ++e2) { float a[2];
#pragma unroll
                for (int q = 0; q < 2; ++q) { const int j = j8 * 8 + 2 * e2 + q; a[q] = (i >= j) ? QKs[ni * GC_FS + (dir ? 63 - j : j)] * __expf(gc[dir * 64 + i] - gc[dir * 64 + j]) : 0.0f; }
                w[e2] = cvtpk(a[0], a[1]); }
            __builtin_nontemporal_store((vu4){w[0], w[1], w[2], w[3]}, (vu4*)(p.GA + (size_t)gdn_unit_index(b, c, h, dir) * 64 * 64 + (((i >> 5) * 4 + (j8 >> 1)) * 64 + (j8 & 1) * 32 + (i & 31)) * 8)); }
        if (t6 < 2) p.GGL[gdn_unit_index(b, c, h, t6)] = eg[t6 * 64 + 63]; }
    LDS_BARRIER();
    LAS bf16* KbT1 = (LAS bf16*)(lds + G1_KK); LAS bf16* VbT1 = KbT1 + 128 * GC_TS;
    if (prod == 0) put_T(1, beg, lds_T(KbT1)); else put_T(1, be, lds_T(VbT1));
    LDS_BARRIER();
#pragma unroll
    for (int dir = 0; dir < 2; ++dir) {
        const int u = gdn_unit_index(b, c, h, dir); const LAS bf16* Td = Tm + dir * 64 * GC_TS; const LAS bf16* Kd = dir ? KbT1 : KbT; const LAS bf16* Vd = dir ? VbT1 : VbT;
        { const int dt = wave >> 1, it2 = wave & 1; f32x16_t acc = zero16(); acc = mma_lds<4>(acc, Kd + 32 * dt * GC_TS, GC_TS, Td + 32 * it2 * GC_TS, GC_TS, r32, hh);
            bf16* dst = p.GW + (size_t)u * 64 * 128 + ((it2 * 8 + 2 * dt) * 64 + r32) * 8 + 4 * hh;
#pragma unroll
            for (int a4 = 0; a4 < 4; ++a4) __builtin_nontemporal_store((vu2){cvtpk(acc[4 * a4], acc[4 * a4 + 1]), cvtpk(acc[4 * a4 + 2], acc[4 * a4 + 3])}, (vu2*)(dst + (a4 >> 1) * 512 + (a4 & 1) * 256)); }
        { const int it2 = wave >> 2, dt = wave & 3; f32x16_t acc = zero16(); acc = mma_lds<4>(acc, Td + 32 * it2 * GC_TS, GC_TS, Vd + 32 * dt * GC_TS, GC_TS, r32, hh);
            bf16* dst = p.GUT + (size_t)u * 128 * 64 + ((size_t)((dt * 2 + it2) * 4) * 64 + lane) * 4;
#pragma unroll
            for (int a4 = 0; a4 < 4; ++a4) __builtin_nontemporal_store((vu2){cvtpk(acc[4 * a4], acc[4 * a4 + 1]), cvtpk(acc[4 * a4 + 2], acc[4 * a4 + 3])}, (vu2*)(dst + a4 * 256)); }
    }
    LDS_BARRIER();
}

template <class F> __device__ __forceinline__ void store_tile_rows(const f32x16_t& a, LAS bf16* T, int lane, F rowptr) {
    const int r32 = lane & 31, hh = lane >> 5;
#pragma unroll
    for (int e = 0; e < 16; ++e) T[((e & 3) + 8 * (e >> 2) + 4 * hh) * 40 + r32] = f2bf(a[e]);
    const int il = lane >> 1, half = lane & 1;
    const vu4 w0 = *(const LAS vu4*)(T + il * 40 + half * 16), w1 = *(const LAS vu4*)(T + il * 40 + half * 16 + 8);
    bf16* dst = rowptr(il) + half * 16;
    *(vu4*)dst = w0; *(vu4*)(dst + 8) = w1;
}
__device__ __forceinline__ void gdn_scan_wg(const Ptrs& p, LAS unsigned char* lds, int chain, int slice, int tid) {
    const int b = chain / (GDN_H * 2), h = (chain >> 1) % GDN_H, dir = chain & 1;
    const int lane = tid & 63, wave = tid >> 6, r32 = lane & 31, hh = lane >> 5;
    LAS bf16* SbT = (LAS bf16*)lds;
    LAS bf16* vnT = SbT + 4 * 32 * GC_KS;
    LAS bf16* otile = vnT + 3 * 32 * GC_TS + (wave & 1) * 32 * 40;
    for (int i = tid; i < 32 * GC_KS / 2; i += 512) ((LAS unsigned*)SbT)[i] = 0u;
    LDS_BARRIER();
    auto chunk_of = [&](int s) { return s < NCH_CTX ? (dir ? NCH_CTX - 1 - s : s) : NCH_CTX + (dir ? NCH - NCH_CTX - 1 - (s - NCH_CTX) : s - NCH_CTX); };
    auto unit_of = [&](int s) { return (size_t)gdn_unit_index(b, chunk_of(s), h, dir); };
    using I0 = std::integral_constant<int, 0>; using I1 = std::integral_constant<int, 1>; using I2 = std::integral_constant<int, 2>; using I3 = std::integral_constant<int, 3>;
    if (wave < 2) {
        __builtin_amdgcn_s_setprio(3);
        int tr = tid; asm volatile("" : "+v"(tr)); const int ln = tr & 63, t = (tr >> 6) & 1;
        bf16x8_t fa[4][8]; vu2 ut[4][4];
        auto prefetch = [&](int s, auto KC2) { constexpr int k = decltype(KC2)::value; const size_t u = unit_of(s);
            const bf16* wp = p.GW + u * 64 * 128 + (size_t)(t * 512 + ln) * 8; const bf16* up = p.GUT + u * 128 * 64 + (size_t)((slice * 2 + t) * 256 + ln) * 4;
#pragma unroll
            for (int q = 0; q < 8; ++q) fa[k][q] = *(const bf16x8_t*)(wp + q * 512);
#pragma unroll
            for (int a4 = 0; a4 < 4; ++a4) ut[k][a4] = *(const vu2*)(up + a4 * 256); };
        auto step = [&](int s, auto KC) { constexpr int k = decltype(KC)::value;
            if (s + 3 < NCH) prefetch(s + 3, std::integral_constant<int, (k + 3) % 4>{});
            const LAS bf16* Sc = SbT + (s & 3) * 32 * GC_KS; LAS bf16* vn = vnT + (s % 3) * 32 * GC_TS;
            f32x16_t acc = zero16(), acc2 = zero16();
#pragma unroll
            for (int qh = 0; qh < 2; ++qh) { bf16x8_t bq[4];
#pragma unroll
                for (int q = 0; q < 4; ++q) bq[q] = *(const LAS bf16x8_t*)(Sc + r32 * GC_KS + 16 * (4 * qh + q) + 8 * hh);
#pragma unroll
                for (int q = 0; q < 4; q += 2) { acc = __builtin_amdgcn_mfma_f32_32x32x16_bf16(fa[k][4 * qh + q], bq[q], acc, 0, 0, 0); acc2 = __builtin_amdgcn_mfma_f32_32x32x16_bf16(fa[k][4 * qh + q + 1], bq[q + 1], acc2, 0, 0, 0); } }
#pragma unroll
            for (int a4 = 0; a4 < 4; ++a4) { const vu2 uw = ut[k][a4];
                *(LAS vu2*)(vn + r32 * GC_TS + 32 * t + 8 * a4 + 4 * hh) = (vu2){cvtpk(bflo(uw.x) - (acc[4 * a4] + acc2[4 * a4]), bfhi(uw.x) - (acc[4 * a4 + 1] + acc2[4 * a4 + 1])), cvtpk(bflo(uw.y) - (acc[4 * a4 + 2] + acc2[4 * a4 + 2]), bfhi(uw.y) - (acc[4 * a4 + 3] + acc2[4 * a4 + 3]))}; }
            LDS_BARRIER(); LDS_BARRIER(); };
        prefetch(0, I0{}); prefetch(1, I1{}); prefetch(2, I2{});
        for (int s = 0; s < NCH; s += 4) { step(s, I0{}); step(s + 1, I1{}); step(s + 2, I2{}); step(s + 3, I3{}); }
        __builtin_amdgcn_s_setprio(0);
    } else if (wave >= 4) {
        __builtin_amdgcn_s_setprio(3);
        int tr = tid; asm volatile("" : "+v"(tr)); const int ln = tr & 63, rr = (tr >> 6) & 3;
        int zl = 0; asm volatile("v_mov_b32 %0, 0" : "=v"(zl));
        bf16x8_t fb[8][4]; float gl[8] = {0.f, 0.f, 0.f, 0.f, 0.f, 0.f, 0.f, 0.f}; f32x16_t S = zero16();
        auto prefetch = [&](int s, auto KC2) { constexpr int k = decltype(KC2)::value; const size_t u = unit_of(s);
            const bf16* kp = p.GKdT + u * 128 * 64 + (size_t)(rr * 256 + ln) * 8;
#pragma unroll
            for (int q = 0; q < 4; ++q) fb[k][q] = *(const bf16x8_t*)(kp + q * 512);
            gl[k] = p.GGL[u + zl]; };
        auto step = [&](int s, auto KC) { constexpr int k = decltype(KC)::value;
            if (s + 7 < NCH) prefetch(s + 7, std::integral_constant<int, (k + 7) % 8>{});
            const LAS bf16* vn = vnT + (s % 3) * 32 * GC_TS; LAS bf16* Sn = SbT + ((s + 1) & 3) * 32 * GC_KS;
            const float g1 = gl[k];
#pragma unroll
            for (int e = 0; e < 16; ++e) S[e] *= g1;
            LDS_BARRIER();
            bf16x8_t bq[4];
#pragma unroll
            for (int q = 0; q < 4; ++q) bq[q] = *(const LAS bf16x8_t*)(vn + r32 * GC_TS + 16 * q + 8 * hh);
#pragma unroll
            for (int q = 0; q < 4; ++q) S = __builtin_amdgcn_mfma_f32_32x32x16_bf16(fb[k][q], bq[q], S, 0, 0, 0);
#pragma unroll
            for (int a4 = 0; a4 < 4; ++a4) *(LAS vu2*)(Sn + r32 * GC_KS + 32 * rr + 8 * a4 + 4 * hh) = (vu2){cvtpk(S[4 * a4], S[4 * a4 + 1]), cvtpk(S[4 * a4 + 2], S[4 * a4 + 3])};
            LDS_BARRIER(); };
        using I4 = std::integral_constant<int, 4>; using I5 = std::integral_constant<int, 5>; using I6 = std::integral_constant<int, 6>; using I7 = std::integral_constant<int, 7>;
        prefetch(0, I0{}); prefetch(1, I1{}); prefetch(2, I2{}); prefetch(3, I3{}); prefetch(4, I4{}); prefetch(5, I5{}); prefetch(6, I6{});
        for (int s = 0; s + 7 < NCH; s += 8) { step(s, I0{}); step(s + 1, I1{}); step(s + 2, I2{}); step(s + 3, I3{}); step(s + 4, I4{}); step(s + 5, I5{}); step(s + 6, I6{}); step(s + 7, I7{}); }
        step(NCH - 4, I0{}); step(NCH - 3, I1{}); step(NCH - 2, I2{}); step(NCH - 1, I3{});
        __builtin_amdgcn_s_setprio(0);
    } else {
        int tr = tid; asm volatile("" : "+v"(tr)); const int ln = tr & 63, t = (tr >> 6) & 1;
        bf16x8_t fa[3][8], fb[3][4];
        auto prefetch = [&](int s, auto KC2) { constexpr int k = decltype(KC2)::value; const size_t u = unit_of(s);
            const bf16* qp = p.GQd + u * 64 * 128 + (size_t)(t * 512 + ln) * 8; const bf16* ap = p.GA + u * 64 * 64 + (size_t)(t * 256 + ln) * 8;
#pragma unroll
            for (int q = 0; q < 8; ++q) fa[k][q] = *(const bf16x8_t*)(qp + q * 512);
#pragma unroll
            for (int q = 0; q < 4; ++q) fb[k][q] = *(const bf16x8_t*)(ap + q * 512); };
        auto out_of = [&](int so, auto KC) { constexpr int k = decltype(KC)::value;
            const LAS bf16* Sc = SbT + (so & 3) * 32 * GC_KS; const LAS bf16* vn = vnT + (so % 3) * 32 * GC_TS;
            f32x16_t acc = zero16(), acc2 = zero16();
#pragma unroll
            for (int qh = 0; qh < 2; ++qh) { bf16x8_t bq[4];
#pragma unroll
                for (int q = 0; q < 4; ++q) bq[q] = *(const LAS bf16x8_t*)(Sc + r32 * GC_KS + 16 * (4 * qh + q) + 8 * hh);
#pragma unroll
                for (int q = 0; q < 4; q += 2) { acc = __builtin_amdgcn_mfma_f32_32x32x16_bf16(fa[k][4 * qh + q], bq[q], acc, 0, 0, 0); acc2 = __builtin_amdgcn_mfma_f32_32x32x16_bf16(fa[k][4 * qh + q + 1], bq[q + 1], acc2, 0, 0, 0); } }
            { bf16x8_t bv[4];
#pragma unroll
              for (int q = 0; q < 4; ++q) bv[q] = *(const LAS bf16x8_t*)(vn + r32 * GC_TS + 16 * q + 8 * hh);
#pragma unroll
              for (int q = 0; q < 4; q += 2) { acc = __builtin_amdgcn_mfma_f32_32x32x16_bf16(fb[k][q], bv[q], acc, 0, 0, 0); acc2 = __builtin_amdgcn_mfma_f32_32x32x16_bf16(fb[k][q + 1], bv[q + 1], acc2, 0, 0, 0); } }
            const int r0 = chunk_row0(b, chunk_of(so));
#pragma unroll
            for (int e = 0; e < 16; ++e) acc[e] += acc2[e];
            store_tile_rows(acc, otile, lane, [&](int il) { const int i = 32 * t + il; return p.OGb + ((size_t)dir * MROWS + r0 + (dir ? 63 - i : i)) * MIX_W + h * 128 + slice * 32; }); };
        auto step = [&](int s, auto KC) { constexpr int k = decltype(KC)::value;
            if (s > 1) out_of(s - 2, std::integral_constant<int, (k + 1) % 3>{});
            if (s + 1 < NCH) prefetch(s + 1, std::integral_constant<int, (k + 1) % 3>{});
            LDS_BARRIER(); LDS_BARRIER(); };
        prefetch(0, I0{});
        for (int s = 0; s + 2 < NCH; s += 3) { step(s, I0{}); step(s + 1, I1{}); step(s + 2, I2{}); }
        step(NCH - 2, std::integral_constant<int, (NCH - 2) % 3>{}); step(NCH - 1, std::integral_constant<int, (NCH - 1) % 3>{});
        out_of(NCH - 2, std::integral_constant<int, (NCH - 2) % 3>{}); out_of(NCH - 1, std::integral_constant<int, (NCH - 1) % 3>{});
    }
}
static_assert(G1_END <= 146432 && NCH % 8 == 4 && NCH % 3 == 2, "G1 LDS map / scan unroll");

constexpr int SSD_NU = BATCH * NCH * SSM_H * 2;
__device__ __forceinline__ int ssd_unit_index(int b, int c, int hd, int dir) { return ((b * NCH + c) * SSM_H + hd) * 2 + dir; }
constexpr int SL_BN = 0, SL_CN = SL_BN + 64 * GC_KS * 2, SL_CB = SL_CN + 64 * GC_KS * 2, SL_BT = SL_CB + 64 * GC_FS * 4, SL_XT = SL_BT + 128 * GC_TS * 2, SL_M = SL_XT + 256 * GC_TS * 2,
              SL_XW = SL_M + 64 * GC_TS * 2, SL_SM = SL_XW + 2 * 64 * GC_TS * 2, SL_END = SL_SM + 8 * 3 * 64 * 4;
static_assert(SL_END <= 146432, "ssd local LDS map");
constexpr int SSD_LOCAL_UNITS = BATCH * NCH * SSM_G * 2;
__device__ __forceinline__ void ssd_local_unit(const Ptrs& p, LAS unsigned char* lds, int unit, int tid) {
    const int lane = tid & 63, wave = tid >> 6, r32 = lane & 31, hh = lane >> 5;
    const int b = unit / (NCH * SSM_G * 2), c = (unit / (SSM_G * 2)) % NCH, g = (unit >> 1) % SSM_G, hq = unit & 1;
    const int r0 = chunk_row0(b, c), hd0 = g * SSM_HPG + hq * 4;
    LAS bf16* Bn = (LAS bf16*)(lds + SL_BN); LAS bf16* Cn = (LAS bf16*)(lds + SL_CN); LAS float* CBs = (LAS float*)(lds + SL_CB); LAS bf16* BT = (LAS bf16*)(lds + SL_BT);
    LAS bf16* XT = (LAS bf16*)(lds + SL_XT); LAS bf16* Mm = (LAS bf16*)(lds + SL_M); LAS bf16* XwT = (LAS bf16*)(lds + SL_XW); LAS float* sm = (LAS float*)(lds + SL_SM);
#pragma unroll
    for (int it = 0; it < 4; ++it) { const int idx = it * 512 + tid, row = idx >> 5, which = (idx >> 4) & 1, c8 = idx & 15;
        *(LAS vu4*)((which ? Cn : Bn) + row * GC_KS + c8 * 8) = *(const vu4*)(p.SBCb + (size_t)(r0 + row) * (2 * SSM_BC) + which * SSM_BC + g * SSM_N + c8 * 8); }
    { vu4 xv[4];
#pragma unroll
        for (int it = 0; it < 4; ++it) { const int idx = it * 512 + tid, j = idx >> 5, p8 = idx & 31; xv[it] = *(const vu4*)(p.SXb + (size_t)(r0 + j) * MIX_W + hd0 * SSM_P + p8 * 8); }
#pragma unroll
        for (int it = 0; it < 4; ++it) { const int idx = it * 512 + tid, j = idx >> 5, p8 = idx & 31; const unsigned w4[4] = {xv[it].x, xv[it].y, xv[it].z, xv[it].w};
#pragma unroll
            for (int e = 0; e < 4; ++e) { XT[(8 * p8 + 2 * e) * GC_TS + j] = (bf16)(w4[e] & 0xffffu); XT[(8 * p8 + 2 * e + 1) * GC_TS + j] = (bf16)(w4[e] >> 16); } } }
    { const int hd = hd0 + (wave >> 1), dir = wave & 1, n = dir ? 63 - lane : lane; const size_t gi = (size_t)(r0 + n) * 2 * SSM_H + dir * SSM_H + hd; const int u = ssd_unit_index(b, c, hd, dir);
        float x = p.SA[gi]; const float dt = p.SDT[gi];
#pragma unroll
        for (int o = 1; o < 64; o <<= 1) { const float y = __shfl_up(x, o); if (lane >= o) x += y; }
        const float x63 = __shfl(x, 63);
        sm[(wave * 3 + 0) * 64 + lane] = x; sm[(wave * 3 + 1) * 64 + lane] = dt; sm[(wave * 3 + 2) * 64 + lane] = __expf(x63 - x) * dt;
        p.SEAb[(size_t)u * 64 + lane] = f2bf(__expf(x)); if (lane == 63) p.SDC[u] = __expf(x); }
    LDS_BARRIER();
    *(vu4*)(p.SCF + ((((size_t)(b * NCH + c) * SSM_G + g) * 2 + hq) * 8 + wave) * 512 + lane * 8) = *(const LAS vu4*)(Cn + (32 * hq + r32) * GC_KS + 16 * wave + 8 * hh);
    if (wave < 4) { const int mt = wave >> 1, nt = wave & 1; f32x16_t acc = zero16(); acc = mma_lds<8>(acc, Cn + 32 * mt * GC_KS, GC_KS, Bn + 32 * nt * GC_KS, GC_KS, r32, hh);
#pragma unroll
        for (int e = 0; e < 16; ++e) CBs[(32 * mt + (e & 3) + 8 * (e >> 2) + 4 * hh) * GC_FS + 32 * nt + r32] = acc[e]; }
    else { for (int it = tid - 256; it < 128 * 8; it += 256) { const int s = it >> 3, j8 = it & 7; unsigned w[4];
#pragma unroll
            for (int e2 = 0; e2 < 4; ++e2) w[e2] = (unsigned)Bn[(j8 * 8 + 2 * e2) * GC_KS + s] | ((unsigned)Bn[(j8 * 8 + 2 * e2 + 1) * GC_KS + s] << 16);
            *(LAS vu4*)(BT + s * GC_TS + j8 * 8) = (vu4){w[0], w[1], w[2], w[3]}; } }
    LDS_BARRIER();
#pragma unroll 1
    for (int hl = 0; hl < 4; ++hl) {
        const int hd = hd0 + hl;
        const LAS float* ac0 = sm + (hl * 2 * 3) * 64; const LAS float* ac1 = ac0 + 3 * 64;
        { const int n = tid >> 3, n8 = tid & 7; unsigned w[4];
            const float a0n = ac0[n], a1n = ac1[63 - n];
#pragma unroll
            for (int e2 = 0; e2 < 4; ++e2) { float a[2];
#pragma unroll
                for (int q = 0; q < 2; ++q) { const int nj = n8 * 8 + 2 * e2 + q; const bool lo = nj <= n;
                    const float ex = __expf(lo ? a0n - ac0[nj] : a1n - ac1[63 - nj]);
                    const float dd = (nj < n) ? ac0[64 + nj] : (nj > n) ? ac1[64 + 63 - nj] : ac0[64 + nj] + ac1[64 + 63 - nj];
                    a[q] = CBs[n * GC_FS + nj] * ex * dd; }
                w[e2] = cvtpk(a[0], a[1]); }
            *(LAS vu4*)(Mm + n * GC_TS + n8 * 8) = (vu4){w[0], w[1], w[2], w[3]};
            const int pp = tid >> 3; float xs[8]; unpack8(*(const LAS vu4*)(XT + (hl * 64 + pp) * GC_TS + n8 * 8), xs);
#pragma unroll
            for (int e2 = 0; e2 < 4; ++e2) { const int nj = n8 * 8 + 2 * e2; w[e2] = cvtpk(xs[2 * e2] * ac0[128 + nj], xs[2 * e2 + 1] * ac0[128 + nj + 1]); }
            *(LAS vu4*)(XwT + pp * GC_TS + n8 * 8) = (vu4){w[0], w[1], w[2], w[3]};
#pragma unroll
            for (int e2 = 0; e2 < 4; ++e2) { const int nj = n8 * 8 + 2 * e2; w[e2] = cvtpk(xs[2 * e2] * ac1[128 + 63 - nj], xs[2 * e2 + 1] * ac1[128 + 62 - nj]); }
            *(LAS vu4*)(XwT + (64 + pp) * GC_TS + n8 * 8) = (vu4){w[0], w[1], w[2], w[3]}; }
        LDS_BARRIER();
#pragma unroll
        for (int dir = 0; dir < 2; ++dir) { const int sb = wave >> 1, pb = wave & 1, u = ssd_unit_index(b, c, hd, dir); f32x16_t acc = zero16();
            acc = mma_lds<4>(acc, BT + 32 * sb * GC_TS, GC_TS, XwT + (64 * dir + 32 * pb) * GC_TS, GC_TS, r32, hh);
            bf16* dst = p.SSC + (((size_t)u * 8 + wave) * 64 + lane) * 16;
            __builtin_nontemporal_store((vu4){cvtpk(acc[0], acc[1]), cvtpk(acc[2], acc[3]), cvtpk(acc[4], acc[5]), cvtpk(acc[6], acc[7])}, (vu4*)dst);
            __builtin_nontemporal_store((vu4){cvtpk(acc[8], acc[9]), cvtpk(acc[10], acc[11]), cvtpk(acc[12], acc[13]), cvtpk(acc[14], acc[15])}, (vu4*)(dst + 8)); }
        if (wave < 4) { const int mt = wave >> 1, pb = wave & 1; f32x16_t acc = zero16(); acc = mma_lds<4>(acc, Mm + 32 * mt * GC_TS, GC_TS, XT + (hl * 64 + 32 * pb) * GC_TS, GC_TS, r32, hh);
#pragma unroll
            for (int e = 0; e < 16; ++e) { const int n = 32 * mt + (e & 3) + 8 * (e >> 2) + 4 * hh;
                p.OSb[((size_t)r0 + n) * MIX_W + hd * SSM_P + 32 * pb + r32] = f2bf(acc[e]); } }
        LDS_BARRIER();
    }
}
__device__ __forceinline__ void ssd_scan_wg(const Ptrs& p, LAS unsigned char* lds, int chain, int tid) {
    const int b = chain / (SSM_H * 2), hd = (chain >> 1) % SSM_H, dir = chain & 1, g = hd / SSM_HPG;
    const int lane = tid & 63, wave = tid >> 6, r32 = lane & 31, hh = lane >> 5;
    int zl = 0; asm volatile("v_mov_b32 %0, 0" : "=v"(zl));
    LAS bf16* hT = (LAS bf16*)lds;
    for (int i = tid; i < 64 * GC_KS / 2; i += 512) ((LAS unsigned*)hT)[i] = 0u;
    LDS_BARRIER();
    auto chunk_of = [&](int s) { return s < NCH_CTX ? (dir ? NCH_CTX - 1 - s : s) : NCH_CTX + (dir ? NCH - NCH_CTX - 1 - (s - NCH_CTX) : s - NCH_CTX); };
    using I0 = std::integral_constant<int, 0>; using I1 = std::integral_constant<int, 1>; using I2 = std::integral_constant<int, 2>; using I3 = std::integral_constant<int, 3>;
    if (wave >= 4) {
        __builtin_amdgcn_s_setprio(3);
        const int hw = wave - 4;
        f32x16_t h0 = zero16(), h1 = zero16();
        vu4 sc[4][4]; float dec[4] = {0.f, 0.f, 0.f, 0.f};
        auto pre_h = [&](int s, auto KC2) { constexpr int k = decltype(KC2)::value; const size_t u = (size_t)ssd_unit_index(b, chunk_of(s), hd, dir);
            const bf16* sp = p.SSC + ((u * 8 + 2 * hw) * 64 + lane) * 16; sc[k][0] = *(const vu4*)sp; sc[k][1] = *(const vu4*)(sp + 8); sc[k][2] = *(const vu4*)(sp + 1024); sc[k][3] = *(const vu4*)(sp + 1024 + 8); dec[k] = p.SDC[u + zl]; };
        auto step = [&](int s, auto KC) { constexpr int k = decltype(KC)::value;
            const unsigned w0[8] = {sc[k][0].x, sc[k][0].y, sc[k][0].z, sc[k][0].w, sc[k][1].x, sc[k][1].y, sc[k][1].z, sc[k][1].w}, w1[8] = {sc[k][2].x, sc[k][2].y, sc[k][2].z, sc[k][2].w, sc[k][3].x, sc[k][3].y, sc[k][3].z, sc[k][3].w};
            const float d1 = dec[k];
#pragma unroll
            for (int e2 = 0; e2 < 8; ++e2) { h0[2 * e2] = h0[2 * e2] * d1 + bflo(w0[e2]); h0[2 * e2 + 1] = h0[2 * e2 + 1] * d1 + bfhi(w0[e2]); h1[2 * e2] = h1[2 * e2] * d1 + bflo(w1[e2]); h1[2 * e2 + 1] = h1[2 * e2 + 1] * d1 + bfhi(w1[e2]); }
            if (s + 3 < NCH) pre_h(s + 3, std::integral_constant<int, (k + 3) % 4>{});
            LAS bf16* Hn = hT + ((s + 1) & 3) * 64 * GC_KS;
#pragma unroll
            for (int a4 = 0; a4 < 4; ++a4) { *(LAS vu2*)(Hn + r32 * GC_KS + 32 * hw + 8 * a4 + 4 * hh) = (vu2){cvtpk(h0[4 * a4], h0[4 * a4 + 1]), cvtpk(h0[4 * a4 + 2], h0[4 * a4 + 3])};
                *(LAS vu2*)(Hn + (32 + r32) * GC_KS + 32 * hw + 8 * a4 + 4 * hh) = (vu2){cvtpk(h1[4 * a4], h1[4 * a4 + 1]), cvtpk(h1[4 * a4 + 2], h1[4 * a4 + 3])}; }
            LDS_BARRIER(); };
        pre_h(0, I0{}); pre_h(1, I1{}); pre_h(2, I2{});
        for (int s = 0; s < NCH; s += 4) { step(s, I0{}); step(s + 1, I1{}); step(s + 2, I2{}); step(s + 3, I3{}); }
        __builtin_amdgcn_s_setprio(0);
    } else {
        const int mt = wave >> 1, pb = wave & 1;
        LAS bf16* otile = hT + 4 * 64 * GC_KS + wave * 32 * 40;
        bf16x8_t cf[3][8]; vu2 ea[3][4];
        auto pre_y = [&](int s, auto KC2) { constexpr int k = decltype(KC2)::value; const int c = chunk_of(s); const size_t u = (size_t)ssd_unit_index(b, c, hd, dir); const int r0 = chunk_row0(b, c);
            const bf16* cp = p.SCF + ((((size_t)(b * NCH + c) * SSM_G + g) * 2 + (dir ? 1 - mt : mt)) * 8) * 512 + (hh * 32 + (dir ? 31 - r32 : r32)) * 8;
#pragma unroll
            for (int q = 0; q < 8; ++q) cf[k][q] = *(const bf16x8_t*)(cp + q * 512);
#pragma unroll
            for (int a4 = 0; a4 < 4; ++a4) ea[k][a4] = *(const vu2*)(p.SEAb + u * 64 + 32 * mt + 8 * a4 + 4 * hh); };
        auto out_y = [&](int so, auto KC) { constexpr int k = decltype(KC)::value;
            const LAS bf16* Hc = hT + (so & 3) * 64 * GC_KS;
            f32x16_t acc = zero16(), acc2 = zero16();
#pragma unroll
            for (int qh = 0; qh < 2; ++qh) { bf16x8_t bq[4];
#pragma unroll
                for (int q = 0; q < 4; ++q) bq[q] = *(const LAS bf16x8_t*)(Hc + (32 * pb + r32) * GC_KS + 16 * (4 * qh + q) + 8 * hh);
#pragma unroll
                for (int q = 0; q < 4; q += 2) { acc = __builtin_amdgcn_mfma_f32_32x32x16_bf16(cf[k][4 * qh + q], bq[q], acc, 0, 0, 0); acc2 = __builtin_amdgcn_mfma_f32_32x32x16_bf16(cf[k][4 * qh + q + 1], bq[q + 1], acc2, 0, 0, 0); } }
            const int r0 = chunk_row0(b, chunk_of(so));
#pragma unroll
            for (int e = 0; e < 16; ++e) { const unsigned ew = (e & 2) ? ea[k][e >> 2].y : ea[k][e >> 2].x; const float ev = (e & 1) ? bfhi(ew) : bflo(ew); acc[e] = ev * (acc[e] + acc2[e]); }
            store_tile_rows(acc, otile, lane, [&](int il) { const int i = 32 * mt + il; return p.OSb2 + ((size_t)dir * MROWS + r0 + (dir ? 63 - i : i)) * MIX_W + hd * SSM_P + 32 * pb; }); };
        auto step = [&](int s, auto KC) { constexpr int k = decltype(KC)::value;
            if (s > 1) out_y(s - 2, std::integral_constant<int, (k + 1) % 3>{});
            if (s + 1 < NCH) pre_y(s + 1, std::integral_constant<int, (k + 1) % 3>{});
            LDS_BARRIER(); };
        pre_y(0, I0{});
        for (int s = 0; s + 2 < NCH; s += 3) { step(s, I0{}); step(s + 1, I1{}); step(s + 2, I2{}); }
        step(NCH - 2, std::integral_constant<int, (NCH - 2) % 3>{}); step(NCH - 1, std::integral_constant<int, (NCH - 1) % 3>{});
        out_y(NCH - 2, std::integral_constant<int, (NCH - 2) % 3>{}); out_y(NCH - 1, std::integral_constant<int, (NCH - 1) % 3>{});
    }
}


namespace pg8 {
struct EpiInProj {
    static constexpr bool PERM = true, AFTER_DRAIN = false, KHOOK = false;
    bf16_t* P; float* PF;
    __device__ __forceinline__ void operator()(const f32x4 (&acc)[2][2][4][2], const Unit& u, int wr, int wc, int fr, int fq) const {
        const int row0 = u.pm * BM + wr * 64 + fr;
        if (u.pn * BM < NP_MAIN) {
            const int col0 = u.pn * BM + wc * 32 + 8 * fq;
#pragma unroll
            for (int ai = 0; ai < 2; ++ai)
#pragma unroll
                for (int m = 0; m < 4; ++m) { bf16_t* rowp = P + (size_t)(row0 + ai * HALF + m * 16) * NP_MAIN + col0;
#pragma unroll
                    for (int bj = 0; bj < 2; ++bj) { const f32x4 v0 = acc[ai][bj][m][0], v1 = acc[ai][bj][m][1];
                        u32x4 w; w.x = cvt_pk_bf16(v0[0], v0[1]); w.y = cvt_pk_bf16(v0[2], v0[3]); w.z = cvt_pk_bf16(v1[0], v1[1]); w.w = cvt_pk_bf16(v1[2], v1[3]);
                        *(u32x4*)(rowp + bj * HALF) = w; } }
        } else {
#pragma unroll
            for (int ai = 0; ai < 2; ++ai)
#pragma unroll
                for (int m = 0; m < 4; ++m) { float* rowp = PF + (size_t)(row0 + ai * HALF + m * 16) * PF_N;
#pragma unroll
                    for (int bj = 0; bj < 2; ++bj) { const int c = bj * HALF + wc * 32 + 8 * fq;
                        if (c < PF_N) { *(f32x4*)(rowp + c) = acc[ai][bj][m][0]; *(f32x4*)(rowp + c + 4) = acc[ai][bj][m][1]; } } }
        }
    }
};
struct EpiMerge {
    static constexpr bool PERM = true, AFTER_DRAIN = false, KHOOK = false;
    const bf16_t* G0; bf16_t* TB;
    __device__ __forceinline__ void operator()(const f32x4 (&acc)[2][2][4][2], const Unit& u, int wr, int wc, int fr, int fq) const {
        const int row0 = u.pm * BM + wr * 64 + fr, col0 = u.pn * BM + wc * 32 + 8 * fq, br = u.pk / MIX_W; const bf16_t* G = G0 + br * D_MODEL;
#pragma unroll
        for (int ai = 0; ai < 2; ++ai)
#pragma unroll
            for (int m = 0; m < 4; ++m) { const size_t row = (size_t)(row0 + ai * HALF + m * 16);
#pragma unroll
                for (int bj = 0; bj < 2; ++bj) { const int col = col0 + bj * HALF;
                    const u32x4 gw = *(const u32x4*)(G + row * NP_MAIN + col);
                    float gt[8];
#pragma unroll
                    for (int j = 0; j < 4; ++j) { gt[2 * j] = __uint_as_float(gw[j] << 16); gt[2 * j + 1] = __uint_as_float(gw[j] & 0xffff0000u); }
                    f32x4 t0, t1;
#pragma unroll
                    for (int j = 0; j < 4; ++j) { t0[j] = acc[ai][bj][m][0][j] * __builtin_amdgcn_rcpf(1.0f + __expf(-gt[j])); t1[j] = acc[ai][bj][m][1][j] * __builtin_amdgcn_rcpf(1.0f + __expf(-gt[4 + j])); }
                    u32x4 w; w.x = cvt_pk_bf16(t0[0], t0[1]); w.y = cvt_pk_bf16(t0[2], t0[3]); w.z = cvt_pk_bf16(t1[0], t1[1]); w.w = cvt_pk_bf16(t1[2], t1[3]);
                    *(u32x4*)(TB + ((size_t)br * NCTX + (row - NLAT)) * D_MODEL + col) = w; } }
    }
};
struct EpiF32Plain {
    static constexpr bool PERM = false, AFTER_DRAIN = false, KHOOK = false;
    float* C; int ldc;
    __device__ __forceinline__ void operator()(const f32x4 (&acc)[2][2][4][2], const Unit& u, int wr, int wc, int fr, int fq) const {
        const int row0 = u.pm * BM + wr * 64 + fr, col0 = u.pn * BM + wc * 32 + 4 * fq;
#pragma unroll
        for (int ai = 0; ai < 2; ++ai)
#pragma unroll
            for (int m = 0; m < 4; ++m) { float* rowp = C + (size_t)(row0 + ai * HALF + m * 16) * ldc + col0;
#pragma unroll
                for (int bj = 0; bj < 2; ++bj)
#pragma unroll
                    for (int n = 0; n < 2; ++n) *(f32x4*)(rowp + bj * HALF + n * 16) = acc[ai][bj][m][n]; }
    }
};
struct EpiBf16Plain {
    static constexpr bool PERM = true, AFTER_DRAIN = false, KHOOK = false;
    bf16_t* O; int ldc;
    __device__ __forceinline__ void operator()(const f32x4 (&acc)[2][2][4][2], const Unit& u, int wr, int wc, int fr, int fq) const {
        const int row0 = u.pm * BM + wr * 64 + fr, col0 = u.pn * BM + wc * 32 + 8 * fq;
#pragma unroll
        for (int ai = 0; ai < 2; ++ai)
#pragma unroll
            for (int m = 0; m < 4; ++m) { bf16_t* rowp = O + (size_t)(row0 + ai * HALF + m * 16) * ldc + col0;
#pragma unroll
                for (int bj = 0; bj < 2; ++bj) { const f32x4 v0 = acc[ai][bj][m][0], v1 = acc[ai][bj][m][1];
                    u32x4 w; w.x = cvt_pk_bf16(v0[0], v0[1]); w.y = cvt_pk_bf16(v0[2], v0[3]); w.z = cvt_pk_bf16(v1[0], v1[1]); w.w = cvt_pk_bf16(v1[2], v1[3]);
                    *(u32x4*)(rowp + bj * HALF) = w; } }
    }
};

struct EpiAct {
    static constexpr bool PERM = true, AFTER_DRAIN = false, KHOOK = false;
    bf16_t* ACT; float* BP; bf16_t* BU; bf16_t* BG; const float* cw; const float* cb;
    __device__ __forceinline__ void operator()(const f32x4 (&acc)[2][2][4][2], const Unit& u, int wr, int wc, int fr, int fq) const {
        const int lp = (fq * 16 + ((fr + 15) & 15)) * 4, ln = (fq * 16 + ((fr + 1) & 15)) * 4;
#pragma unroll
        for (int n = 0; n < 2; ++n) {
            const int j0 = u.pn * 128 + wc * 32 + 8 * fq + 4 * n;
            const f32x4 w0 = *(const f32x4*)(cw + j0), w1 = *(const f32x4*)(cw + D_FF + j0), w2 = *(const f32x4*)(cw + 2 * D_FF + j0), bs = *(const f32x4*)(cb + j0);
#pragma unroll
            for (int ai = 0; ai < 2; ++ai) {
#pragma unroll
                for (int m = 0; m < 4; ++m) {
                    const int row = u.pm * BM + ai * HALF + wr * 64 + m * 16 + fr;
                    const bool hp = !(m == 0 && fr == 0), hn = !(m == 3 && fr == 15);
                    f32x4 gp, gn;
#pragma unroll
                    for (int e = 0; e < 4; ++e) { const float gc = acc[ai][1][m][n][e], gm = acc[ai][1][m > 0 ? m - 1 : 0][n][e], gq = acc[ai][1][m < 3 ? m + 1 : 3][n][e];
                        gp[e] = __int_as_float(__builtin_amdgcn_ds_bpermute(lp, __float_as_int(fr == 15 ? gm : gc)));
                        gn[e] = __int_as_float(__builtin_amdgcn_ds_bpermute(ln, __float_as_int(fr == 0 ? gq : gc))); }
                    const f32x4 g = acc[ai][1][m][n], uu = acc[ai][0][m][n];
                    f32x4 pre = w1 * g + bs;
                    if (hp) pre += w0 * gp;
                    if (hn) pre += w2 * gn;
                    if (hp && hn) {
                        f32x4 a;
#pragma unroll
                        for (int e = 0; e < 4; ++e) a[e] = pre[e] * __builtin_amdgcn_rcpf(1.0f + __expf(-pre[e])) * uu[e];
                        typedef unsigned u32x2 __attribute__((ext_vector_type(2)));
                        u32x2 w; w.x = cvt_pk_bf16(a[0], a[1]); w.y = cvt_pk_bf16(a[2], a[3]);
                        *(u32x2*)(ACT + (size_t)row * D_FF + j0) = w;
                    } else {
                        const size_t bi = (size_t)((row >> 6) * 2 + ((row & 63) == 63 ? 1 : 0)) * D_FF + j0;
                        typedef unsigned u32x2 __attribute__((ext_vector_type(2)));
                        *(f32x4*)(BP + bi) = pre;
                        u32x2 wu; wu.x = cvt_pk_bf16(uu[0], uu[1]); wu.y = cvt_pk_bf16(uu[2], uu[3]); *(u32x2*)(BU + bi) = wu;
                        u32x2 wg; wg.x = cvt_pk_bf16(g[0], g[1]); wg.y = cvt_pk_bf16(g[2], g[3]); *(u32x2*)(BG + bi) = wg;
                    }
                }
            }
        }
    }
};

constexpr int SPLIT_KS = 512, OUT_NS = D_MODEL / SPLIT_KS, DOWN_NS = D_FF / SPLIT_KS;
static_assert(D_MODEL % SPLIT_KS == 0 && D_FF % SPLIT_KS == 0 && NCTX % 256 == 0, "split-K context units");
struct SplitOrder {
    int ns, G, c;
    __device__ __forceinline__ bool next(int i, Unit& u) const { const int L = i * G + c; if (L >= (NCTX / 256) * (D_MODEL / 256) * ns) return false;
        const int ks = L % ns, tile = L / ns; u.pm = NLAT / 256 + tile / (D_MODEL / 256); u.pn = tile % (D_MODEL / 256); u.pk = ks * SPLIT_KS; return true; }
    __device__ __forceinline__ void a_ready(const Unit&) const {}
    __device__ __forceinline__ void done(const Unit&) const {}
};
struct SplitOrder3 {
    int G, c;
    __device__ __forceinline__ bool next(int i, Unit& u) const { const int L = i * G + c; constexpr int NT = (NCTX / 256) * (D_MODEL / 256); if (L >= NT * 3 * OUT_NS) return false;
        const int ks = L % OUT_NS, br = (L / OUT_NS) % 3, tile = L / (3 * OUT_NS); u.pm = br * (NCTX / 256) + tile / (D_MODEL / 256); u.pn = tile % (D_MODEL / 256); u.pk = ks * SPLIT_KS; return true; }
    __device__ __forceinline__ void a_ready(const Unit&) const {}
    __device__ __forceinline__ void done(const Unit&) const {}
};
struct EpiSlab3 {
    static constexpr bool PERM = false, AFTER_DRAIN = false, KHOOK = false;
    float* S;
    __device__ __forceinline__ void operator()(const f32x4 (&acc)[2][2][4][2], const Unit& u, int wr, int wc, int fr, int fq) const {
        const int br = u.pm / (NCTX / 256), ct = u.pm % (NCTX / 256);
        const int row0 = ct * BM + wr * 64 + fr, col0 = u.pn * BM + wc * 32 + 4 * fq; float* base = S + (size_t)(br * OUT_NS + u.pk / SPLIT_KS) * NCTX * D_MODEL;
#pragma unroll
        for (int ai = 0; ai < 2; ++ai)
#pragma unroll
            for (int m = 0; m < 4; ++m) { float* rowp = base + (size_t)(row0 + ai * HALF + m * 16) * D_MODEL + col0;
#pragma unroll
                for (int bj = 0; bj < 2; ++bj)
#pragma unroll
                    for (int n = 0; n < 2; ++n) *(f32x4*)(rowp + bj * HALF + n * 16) = acc[ai][bj][m][n]; }
    }
};

struct EpiMerge3 {
    static constexpr bool PERM = true, AFTER_DRAIN = false, KHOOK = true;
    const bf16_t* G0; bf16_t* MB;
    __device__ __forceinline__ void khook(f32x4 (&acc)[2][2][4][2], const Unit& u, int t, int wr, int wc, int fr, int fq) const {
        if (t != MIX_W / BK && t != 2 * MIX_W / BK) return;
        const int bp = t / (MIX_W / BK) - 1;
        const int row0 = u.pm * BM + wr * 64 + fr, col0 = u.pn * BM + wc * 32 + 8 * fq; const bf16_t* Gp = G0 + bp * D_MODEL;
#pragma unroll
        for (int ai = 0; ai < 2; ++ai) {
            asm volatile("" ::: "memory");
#pragma unroll
            for (int m = 0; m < 4; ++m) { const unsigned rowo = (unsigned)(row0 + ai * HALF + m * 16) * (unsigned)NP_MAIN;
#pragma unroll
                for (int bj = 0; bj < 2; ++bj) { const unsigned off = rowo + (unsigned)(col0 + bj * HALF);
                    const u32x4 gp = *(const u32x4*)(Gp + off), gn = *(const u32x4*)(Gp + D_MODEL + off);
#pragma unroll
                    for (int j = 0; j < 4; ++j) { const float p0 = __uint_as_float(gp[j] << 16), p1 = __uint_as_float(gp[j] & 0xffff0000u), n0 = __uint_as_float(gn[j] << 16), n1 = __uint_as_float(gn[j] & 0xffff0000u);
                        const float r0 = (1.0f + __expf(-n0)) * __builtin_amdgcn_rcpf(1.0f + __expf(-p0)), r1 = (1.0f + __expf(-n1)) * __builtin_amdgcn_rcpf(1.0f + __expf(-p1));
                        if (j < 2) { acc[ai][bj][m][0][2 * j] *= r0; acc[ai][bj][m][0][2 * j + 1] *= r1; } else { acc[ai][bj][m][1][2 * (j - 2)] *= r0; acc[ai][bj][m][1][2 * (j - 2) + 1] *= r1; } } } } }
    }
    __device__ __forceinline__ void operator()(const f32x4 (&acc)[2][2][4][2], const Unit& u, int wr, int wc, int fr, int fq) const {
        const int row0 = u.pm * BM + wr * 64 + fr, col0 = u.pn * BM + wc * 32 + 8 * fq; const bf16_t* G = G0 + 2 * D_MODEL;
#pragma unroll
        for (int ai = 0; ai < 2; ++ai)
#pragma unroll
            for (int m = 0; m < 4; ++m) { const size_t row = (size_t)(row0 + ai * HALF + m * 16);
#pragma unroll
                for (int bj = 0; bj < 2; ++bj) { const int col = col0 + bj * HALF;
                    const u32x4 gw = *(const u32x4*)(G + row * NP_MAIN + col);
                    float gt[8];
#pragma unroll
                    for (int j = 0; j < 4; ++j) { gt[2 * j] = __uint_as_float(gw[j] << 16); gt[2 * j + 1] = __uint_as_float(gw[j] & 0xffff0000u); }
                    f32x4 t0, t1;
#pragma unroll
                    for (int j = 0; j < 4; ++j) { t0[j] = acc[ai][bj][m][0][j] * __builtin_amdgcn_rcpf(1.0f + __expf(-gt[j])); t1[j] = acc[ai][bj][m][1][j] * __builtin_amdgcn_rcpf(1.0f + __expf(-gt[4 + j])); }
                    u32x4 w; w.x = cvt_pk_bf16(t0[0], t0[1]); w.y = cvt_pk_bf16(t0[2], t0[3]); w.z = cvt_pk_bf16(t1[0], t1[1]); w.w = cvt_pk_bf16(t1[2], t1[3]);
                    *(u32x4*)(MB + row * D_MODEL + col) = w; } }
    }
};
struct CtxMergeOrder {
    int c;
    __device__ __forceinline__ bool next(int i, Unit& u) const { if (i > 0 || c >= 3 * (NCTX / 256) * (D_MODEL / 256)) return false;
        const int tile = c / 3; u.pm = NLAT / 256 + tile / (D_MODEL / 256); u.pn = tile % (D_MODEL / 256); u.pk = (c % 3) * MIX_W; return true; }
    __device__ __forceinline__ void a_ready(const Unit&) const {}
    __device__ __forceinline__ void done(const Unit&) const {}
};
struct EpiSlab {
    static constexpr bool PERM = false, AFTER_DRAIN = false, KHOOK = false;
    float* S;
    __device__ __forceinline__ void operator()(const f32x4 (&acc)[2][2][4][2], const Unit& u, int wr, int wc, int fr, int fq) const {
        const int row0 = (u.pm * BM - NLAT) + wr * 64 + fr, col0 = u.pn * BM + wc * 32 + 4 * fq; float* base = S + (size_t)(u.pk / SPLIT_KS) * NCTX * D_MODEL;
#pragma unroll
        for (int ai = 0; ai < 2; ++ai)
#pragma unroll
            for (int m = 0; m < 4; ++m) { float* rowp = base + (size_t)(row0 + ai * HALF + m * 16) * D_MODEL + col0;
#pragma unroll
                for (int bj = 0; bj < 2; ++bj)
#pragma unroll
                    for (int n = 0; n < 2; ++n) *(f32x4*)(rowp + bj * HALF + n * 16) = acc[ai][bj][m][n]; }
    }
};
}

constexpr size_t al256(size_t x) { return (x + 255) & ~(size_t)255; }
constexpr size_t WS_CTL = 0, CTL_BYTES = 1u << 20;
constexpr size_t WS_WIN = WS_CTL + CTL_BYTES;
constexpr size_t WS_WBR = WS_WIN + al256((size_t)DEPTH * NP_PAD * D_MODEL * 2);
constexpr size_t WS_WOUT = WS_WBR + al256((size_t)DEPTH * 3 * D_MODEL * MIX_W * 2);
constexpr size_t WS_WUP = WS_WOUT + al256((size_t)DEPTH * D_MODEL * D_MODEL * 2);
constexpr size_t WS_WDOWN = WS_WUP + al256((size_t)DEPTH * 2 * D_FF * D_MODEL * 2);
constexpr size_t WS_MOD = WS_WDOWN + al256((size_t)DEPTH * D_MODEL * D_FF * 2);
constexpr size_t WS_X = WS_MOD + al256((size_t)DEPTH * (BATCH + 1) * D6 * 4 + GRID_W * 32 * 2 * 4);
constexpr size_t WS_H = WS_X + al256((size_t)MROWS * D_MODEL * 4);
constexpr size_t WS_MIX = WS_H + al256((size_t)MROWS * D_MODEL * 2);
constexpr size_t WS_SLAB = WS_MIX + al256((size_t)MROWS * D_MODEL * 4);
constexpr size_t WS_TB = WS_SLAB + al256((size_t)(D_FF / 512 > 12 ? D_FF / 512 : 12) * NCTX * D_MODEL * 4);
constexpr size_t WS_R = WS_TB + al256((size_t)3 * NCTX * D_MODEL * 2);
constexpr size_t WS_P = WS_R;
constexpr size_t WS_PF = WS_P + al256((size_t)MROWS * NP_MAIN * 2);
constexpr size_t WS_GQKV = WS_PF + al256((size_t)MROWS * PF_N * 4);
#if defined(TOKEN_GDN) || defined(NAIVE_PREP)
constexpr size_t WS_GG = WS_GQKV + al256((size_t)MROWS * 3 * MIX_W * 4);
#else
constexpr size_t WS_GG = WS_GQKV + 256;
#endif
constexpr size_t WS_GB = WS_GG + al256((size_t)MROWS * 2 * GDN_H * 4);
constexpr size_t WS_SXBC = WS_GB + al256((size_t)MROWS * 2 * GDN_H * 4);
#if defined(TOKEN_SSD) || defined(NAIVE_PREP)
constexpr size_t WS_SDT = WS_SXBC + al256((size_t)MROWS * SSM_XBC * 4);
#else
constexpr size_t WS_SDT = WS_SXBC + 256;
#endif
constexpr size_t WS_SA = WS_SDT + al256((size_t)MROWS * 2 * SSM_H * 4);
constexpr size_t WS_AQ = WS_SA + al256((size_t)MROWS * 2 * SSM_H * 4);
#ifdef NAIVE_ATTN
constexpr size_t WS_AK = WS_AQ + al256((size_t)MROWS * MIX_W * 4);
constexpr size_t WS_OG = WS_AK + al256((size_t)MROWS * ATT_HKV * 128 * 4);
#else
constexpr size_t WS_AK = WS_AQ + 256;
constexpr size_t WS_OG = WS_AK + 256;
#endif
#if defined(TOKEN_GDN) || defined(TOKEN_SSD) || defined(NAIVE_MIXOUT)
constexpr size_t WS_OS = WS_OG + al256((size_t)2 * MROWS * MIX_W * 4);
constexpr size_t WS_SC = WS_OS + al256((size_t)2 * MROWS * MIX_W * 4);
#else
constexpr size_t WS_OS = WS_OG + 256;
constexpr size_t WS_SC = WS_OS + 256;
#endif
#ifdef NAIVE_ATTN
constexpr size_t WS_YA = WS_SC + al256((size_t)MROWS * ATT_HQ * SC_LD * 4);
#else
constexpr size_t WS_YA = WS_SC + 256;
#endif
constexpr size_t WS_YB = WS_YA + al256((size_t)MROWS * MIX_W * 2);
constexpr size_t WS_YC = WS_YB + al256((size_t)MROWS * MIX_W * 2);
constexpr size_t WS_M32 = WS_YC + al256((size_t)MROWS * MIX_W * 2);
constexpr size_t WS_MB = WS_M32 + al256((size_t)MROWS * D_MODEL * 4);
constexpr size_t WS_AQB = WS_MB + al256((size_t)MROWS * D_MODEL * 2);
constexpr size_t WS_AKB = WS_AQB + al256((size_t)MROWS * MIX_W * 2);
constexpr size_t GDN_NU_H = (size_t)BATCH * (CHAIN_LEN / 64) * GDN_H * 2;
constexpr size_t WS_GW = WS_AKB + al256((size_t)MROWS * ATT_HKV * 128 * 2);
constexpr size_t WS_GQD = WS_GW + al256(GDN_NU_H * 64 * 128 * 2);
constexpr size_t WS_GKDT = WS_GQD + al256(GDN_NU_H * 64 * 128 * 2);
constexpr size_t WS_GA = WS_GKDT + al256(GDN_NU_H * 128 * 64 * 2);
constexpr size_t WS_GUT = WS_GA + al256(GDN_NU_H * 64 * 64 * 2);
constexpr size_t WS_GGL = WS_GUT + al256(GDN_NU_H * 128 * 64 * 2);
constexpr size_t SSD_NU_H = (size_t)BATCH * (CHAIN_LEN / 64) * SSM_H * 2;
constexpr size_t WS_SBCB = WS_GGL + al256(GDN_NU_H * 4);
constexpr size_t WS_SSC = WS_SBCB + al256((size_t)MROWS * 2 * SSM_BC * 2);
constexpr size_t WS_SEA = WS_SSC + al256(SSD_NU_H * 8 * 64 * 16 * 2);
constexpr size_t WS_SDC = WS_SEA + al256(SSD_NU_H * 64 * 4);
constexpr size_t WS_OGB = WS_SDC + al256(SSD_NU_H * 4);
constexpr size_t WS_OSB = WS_OGB + al256((size_t)2 * MROWS * MIX_W * 2);
constexpr size_t WS_OSB2 = WS_OSB + al256((size_t)2 * MROWS * MIX_W * 2);
constexpr size_t WS_GQKVB = WS_OSB2 + al256((size_t)2 * MROWS * MIX_W * 2);
constexpr size_t WS_SXB = WS_GQKVB + al256((size_t)MROWS * 3 * MIX_W * 2);
constexpr size_t WS_SCF = WS_SXB + al256((size_t)MROWS * MIX_W * 2);
constexpr size_t WS_END_MIX = WS_SCF + al256((size_t)BATCH * (CHAIN_LEN / 64) * SSM_G * 2 * 8 * 512 * 2);
constexpr size_t NBND = (size_t)MROWS / 64 * 2;
constexpr size_t WS_BP = WS_R;
constexpr size_t WS_BU = WS_BP + al256(NBND * D_FF * 4);
constexpr size_t WS_BG = WS_BU + al256(NBND * D_FF * 2);
constexpr size_t WS_ACT = WS_BG + al256(NBND * D_FF * 2);
constexpr size_t WS_END_FFN = WS_ACT + al256((size_t)MROWS * D_FF * 2);
constexpr size_t WS_NEED = WS_END_MIX > WS_END_FFN ? WS_END_MIX : WS_END_FFN;

constexpr int NWAVES = 8, NTHREADS = NWAVES * 64;
#ifndef ATT_EARLY_N
#define ATT_EARLY_N 0
#endif
constexpr int ATT_EARLY = ATT_EARLY_N;
static_assert(ATT_EARLY <= ATT_UNITS_LAT, "early attention units are latent units");
constexpr int RING_BYTES = 131072, LDS_BYTES = 147456, MISC_OFF = LDS_BYTES - 1024;

enum { ST_INPROJ = 0, ST_PREP, ST_G1, ST_MIX, ST_MIXOUT, ST_MERGE, ST_OUT, ST_NORM2, ST_UP, ST_ACT, ST_DOWN, ST_NORM3, NSTEP };
constexpr int STEP0 = 2;
constexpr int TOTAL_STEPS = STEP0 + DEPTH * NSTEP;
#ifndef MK_LAUNCH_MODE
#define MK_LAUNCH_MODE 1
#endif

struct Args { Ptrs p; unsigned* ctl; int step_lo, step_hi; };
typedef const __attribute__((address_space(4))) Args* KArgs;
__device__ __forceinline__ KArgs fresh_args() { KArgs k = (KArgs)__builtin_amdgcn_kernarg_segment_ptr(); asm volatile("" : "+s"(k)); return k; }
#if defined(__HIP_DEVICE_COMPILE__)
#define PTRS() const Ptrs p = fresh_args()->p; int lane; asm volatile("v_mbcnt_lo_u32_b32 %0, -1, 0\n\tv_mbcnt_hi_u32_b32 %0, -1, %0" : "=v"(lane)); const int wave = wave_s; const int tid = wave * 64 + lane; \
    const size_t gtid = (size_t)blockIdx.x * NTHREADS + tid, NT = (size_t)G * NTHREADS; const int gwave = (int)blockIdx.x * NWAVES + wave, NGW = G * NWAVES; (void)lane; (void)wave; (void)gtid; (void)NT; (void)gwave; (void)NGW
#else
#define PTRS() const Ptrs p = a.p; const int tid = 0, lane = 0, wave = 0, gwave = 0, NGW = 1; const size_t gtid = 0, NT = 1; (void)tid; (void)lane; (void)wave; (void)gtid; (void)NT; (void)gwave; (void)NGW
#endif

constexpr int WT_I_IN = (D_MODEL / 64) * (P_IN / 32), WT_I_BR = (MIX_W / 64) * (D_MODEL / 32), WT_I_OUT = (D_MODEL / 64) * (D_MODEL / 32), WT_I_UP = (D_MODEL / 64) * (2 * D_FF / 32), WT_I_DN = (D_FF / 64) * (D_MODEL / 32);
constexpr int WT_I_ALL = WT_I_IN + 3 * WT_I_BR + WT_I_OUT + WT_I_UP + WT_I_DN;
template <class PT> __device__ __forceinline__ void weight_item(const PT& p, int l, int it, LAS float* scr, int lane) {
    int r = it;
    if (r < WT_I_IN) { const int nblk = P_IN / 32, k0 = 64 * (r / nblk), n0 = 32 * (r % nblk);
        transpose_item(p.w_in + (size_t)l * D_MODEL * P_IN, D_MODEL, P_IN, p.Wt_in + (size_t)l * NP_PAD * D_MODEL, k0, n0, inproj_dst_row0(n0), scr, lane); return; } r -= WT_I_IN;
    if (r < 3 * WT_I_BR) { const int br = r / WT_I_BR; r -= br * WT_I_BR; const int nblk = D_MODEL / 32, k0 = 64 * (r / nblk), n0 = 32 * (r % nblk);
        const float* w = (br == 0 ? p.w_br_a : br == 1 ? p.w_br_b : p.w_br_c) + (size_t)l * MIX_W * D_MODEL;
        transpose_item(w, 3 * MIX_W, D_MODEL, p.Wt_br + (size_t)l * 3 * D_MODEL * MIX_W + br * MIX_W, k0, n0, n0, scr, lane); return; } r -= 3 * WT_I_BR;
    if (r < WT_I_OUT) { const int nblk = D_MODEL / 32, k0 = 64 * (r / nblk), n0 = 32 * (r % nblk);
        transpose_item(p.w_out + (size_t)l * D_MODEL * D_MODEL, D_MODEL, D_MODEL, p.Wt_out + (size_t)l * D_MODEL * D_MODEL, k0, n0, n0, scr, lane); return; } r -= WT_I_OUT;
    if (r < WT_I_UP) { const int nblk = 2 * D_FF / 32, k0 = 64 * (r / nblk), n0 = 32 * (r % nblk);
        transpose_item(p.w_up + (size_t)l * D_MODEL * 2 * D_FF, D_MODEL, 2 * D_FF, p.Wt_up + (size_t)l * 2 * D_FF * D_MODEL, k0, n0, up_dst_row0(n0), scr, lane); return; } r -= WT_I_UP;
    { const int nblk = D_MODEL / 32, k0 = 64 * (r / nblk), n0 = 32 * (r % nblk);
        transpose_item(p.w_down + (size_t)l * D_FF * D_MODEL, D_FF, D_MODEL, p.Wt_down + (size_t)l * D_MODEL * D_FF, k0, n0, n0, scr, lane); }
}
template <class PT> __device__ __forceinline__ WtDesc weight_desc(const PT& p, int l, int it) {
    int r = it;
    if (r < WT_I_IN) { const int nblk = P_IN / 32, k0 = 64 * (r / nblk), n0 = 32 * (r % nblk); return WtDesc{p.w_in + (size_t)l * D_MODEL * P_IN, p.Wt_in + (size_t)l * NP_PAD * D_MODEL, D_MODEL, P_IN, k0, n0, inproj_dst_row0(n0)}; } r -= WT_I_IN;
    if (r < 3 * WT_I_BR) { const int br = r / WT_I_BR; r -= br * WT_I_BR; const int nblk = D_MODEL / 32, k0 = 64 * (r / nblk), n0 = 32 * (r % nblk);
        const float* w = (br == 0 ? p.w_br_a : br == 1 ? p.w_br_b : p.w_br_c) + (size_t)l * MIX_W * D_MODEL;
        return WtDesc{w, p.Wt_br + (size_t)l * 3 * D_MODEL * MIX_W + br * MIX_W, 3 * MIX_W, D_MODEL, k0, n0, n0}; } r -= 3 * WT_I_BR;
    if (r < WT_I_OUT) { const int nblk = D_MODEL / 32, k0 = 64 * (r / nblk), n0 = 32 * (r % nblk); return WtDesc{p.w_out + (size_t)l * D_MODEL * D_MODEL, p.Wt_out + (size_t)l * D_MODEL * D_MODEL, D_MODEL, D_MODEL, k0, n0, n0}; } r -= WT_I_OUT;
    if (r < WT_I_UP) { const int nblk = 2 * D_FF / 32, k0 = 64 * (r / nblk), n0 = 32 * (r % nblk); return WtDesc{p.w_up + (size_t)l * D_MODEL * 2 * D_FF, p.Wt_up + (size_t)l * 2 * D_FF * D_MODEL, D_MODEL, 2 * D_FF, k0, n0, up_dst_row0(n0)}; } r -= WT_I_UP;
    { const int nblk = D_MODEL / 32, k0 = 64 * (r / nblk), n0 = 32 * (r % nblk); return WtDesc{p.w_down + (size_t)l * D_FF * D_MODEL, p.Wt_down + (size_t)l * D_MODEL * D_FF, D_FF, D_MODEL, k0, n0, n0}; }
}
constexpr int FILL_A0 = ((MROWS / 256) * (NP_PAD / 256)) % 256, FILL_B0 = 3 * (NCTX / 256) * (D_MODEL / 256), FILL_C0 = ((MROWS / 256) * (2 * D_FF / 256)) % 256;
#ifndef FILL_NA
#define FILL_NA 14
#endif
#ifndef FILL_NB
#define FILL_NB 11
#endif
#ifndef FILL_NC
#define FILL_NC 19
#endif
constexpr int fill_min(int a, int b) { return a < b ? a : b; }
constexpr int WT_OWN = WT_I_ALL - WT_I_IN;
#ifndef FILL_NM
#define FILL_NM 512
#endif
constexpr int FILL_MCH = 16;
constexpr int FILL_EA = fill_min((256 - FILL_A0) * 8 * FILL_NA, WT_I_ALL), FILL_EM = fill_min(FILL_EA + FILL_NM * FILL_MCH, WT_I_ALL), FILL_EB = fill_min(FILL_EM + (256 - FILL_B0) * 8 * FILL_NB, WT_I_ALL), FILL_EC = fill_min(FILL_EB + (256 - FILL_C0) * 8 * FILL_NC, WT_I_ALL);
static_assert(FILL_A0 > 0 && FILL_C0 > 0, "fill slots");
static_assert(FILL_EM >= 3 * WT_I_BR && FILL_EB >= 3 * WT_I_BR + WT_I_OUT + WT_I_UP && FILL_EC >= WT_OWN, "a matrix must be complete before the phase that multiplies by it (branch: merge; up: up-projection; down: within the layer)");
static_assert(64 * 33 <= 2176 && 8 * 4352 * 4 <= 146432 - 1024, "fill scratch: two transpose tiles per wave inside the dynamic LDS below the control words");
__device__ __forceinline__ void weight_fill_ws(int l, int seg_b, int seg_e_in, int ws, int nws, LAS unsigned char* lds, int wv) {
#if defined(__HIP_DEVICE_COMPILE__)
    asm volatile("s_waitcnt vmcnt(0)" ::: "memory"); LDS_BARRIER();
    int l_; asm volatile("v_mbcnt_lo_u32_b32 %0, -1, 0\n\tv_mbcnt_hi_u32_b32 %0, -1, %0" : "=v"(l_));
    const int seg_e = (l == DEPTH - 1 && seg_e_in > WT_OWN) ? WT_OWN : seg_e_in;
#define WT_AT(f_) weight_desc(fresh_args()->p, (f_) < WT_OWN ? l : l + 1, (f_) < WT_OWN ? WT_I_IN + (f_) : (f_) - WT_OWN)
    LAS float* scr = (LAS float*)lds + wv * 4352;
    int it = seg_b + ws;
    if (it < seg_e) { float wa[32], wb[32]; WtDesc da = WT_AT(it), db = da; transpose_load(da, l_, wa);
        for (;;) { const int it2 = it + nws; const bool h2 = it2 < seg_e;
            if (h2) { db = WT_AT(it2); transpose_load(db, l_, wb); }
            transpose_finish(da, wa, scr, l_);
            if (!h2) break;
            const int it3 = it2 + nws; const bool h3 = it3 < seg_e;
            if (h3) { da = WT_AT(it3); transpose_load(da, l_, wa); }
            transpose_finish(db, wb, scr + 2176, l_);
            if (!h3) break;
            it = it3; } }
#undef WT_AT
    LDS_BARRIER();
#endif
}
__device__ __forceinline__ void weight_fill(int l, int seg_b, int seg_e, int wg0, LAS unsigned char* lds, int wv) { weight_fill_ws(l, seg_b, seg_e, ((int)blockIdx.x - wg0) * 8 + wv, (256 - wg0) * 8, lds, wv); }
__global__ void __launch_bounds__(NTHREADS, 2) fwd(Args a) {
    extern __shared__ __attribute__((aligned(16))) unsigned char lds_raw[];
    LAS unsigned char* lds = (LAS unsigned char*)lds_raw;
    volatile LAS unsigned* MISC = (volatile LAS unsigned*)(lds + MISC_OFF);
    const int G = gridDim.x;
    const int wave_s = __builtin_amdgcn_readfirstlane((int)threadIdx.x >> 6);
    for (int u = threadIdx.x; u < (LDS_BYTES - MISC_OFF) / 4; u += NTHREADS) ((LAS unsigned*)(lds + MISC_OFF))[u] = 0u;
    __syncthreads();
    const bool multi = (a.step_hi - a.step_lo) > 1;
    if (multi) (void)xcd_barrier_post(a.ctl + 4096, MISC + 8);
#define IN(k) (fresh_args()->step_lo <= (k) && (k) < fresh_args()->step_hi)
#ifdef ONLY_STEP
#define EN(k) ((k) == ONLY_STEP)
#elif defined(SKIP_MASK)
#define EN(k) (!((SKIP_MASK >> (k)) & 1))
#else
#define EN(k) true
#endif
#define SEAM(k) do { if (IN((k) + 1)) { XcdBarrier bl; bl.bar = fresh_args()->ctl + 4096; bl.x = xb_xcc_id(); bl.st = (volatile LAS unsigned*)(lds + MISC_OFF) + 8; xcd_barrier(bl); } } while (0)
#define FOR_ITEMS(i, n) for (size_t i = gtid; i < (size_t)(n); i += NT)
#define FRESH_TID(name) int name; { int l_; asm volatile("v_mbcnt_lo_u32_b32 %0, -1, 0\n\tv_mbcnt_hi_u32_b32 %0, -1, %0" : "=v"(l_)); name = wave_s * 64 + l_; }

    if (EN(0) && IN(0)) {
        PTRS();
        LAS float* scr = (LAS float*)lds + wave * 4096;
        FOR_ITEMS(i, (size_t)GRID_W * 32) { const float ang = (float)(i >> 5) * rope_inv_freq((int)(i & 31)); p.ROPE[2 * i] = cosf(ang); p.ROPE[2 * i + 1] = sinf(ang); }
#ifdef FILL_OFF
        for (int l = 0; l < DEPTH; ++l) for (int it = gwave; it < WT_I_ALL; it += NGW) weight_item(fresh_args()->p, l, it, scr, lane);
#else
        for (int it = gwave; it < WT_I_IN; it += NGW) weight_item(fresh_args()->p, 0, it, scr, lane);
        for (int l = 1; l < DEPTH; ++l) for (int it = FILL_EC - WT_OWN + gwave; it < WT_I_IN; it += NGW) weight_item(fresh_args()->p, l, it, scr, lane);
#endif
        for (int l = 0; l < DEPTH; ++l) {
            { bf16* z = p.Wt_in + ((size_t)l * NP_PAD + NP_MAIN + PF_N) * D_MODEL; const size_t n16 = (size_t)(NP_PAD - NP_MAIN - PF_N) * D_MODEL / 8;
                FOR_ITEMS(i, n16) *(vu4*)(z + i * 8) = (vu4){0u, 0u, 0u, 0u}; }
        }
        __syncthreads();
        LAS float* sl = (LAS float*)lds;
        LAS float* red = sl + 3 * D_MODEL;
        for (int i = tid; i < (BATCH + 1) * D_MODEL; i += NTHREADS) sl[i] = silu_f(i < BATCH * D_MODEL ? p.c[i] : p.c_ctx[i - BATCH * D_MODEL]);
        __syncthreads();
        for (int it = (int)blockIdx.x; it < DEPTH * (D6 / 64); it += G) {
            const int l = it / (D6 / 64), n0 = (it % (D6 / 64)) * 64;
            float acc0 = 0.f, acc1 = 0.f, acc2 = 0.f;
            const float* w = p.w_ada + ((size_t)l * D_MODEL + wave * (D_MODEL / 8)) * D6 + n0 + lane;
            for (int k0 = 0; k0 < D_MODEL / 8; k0 += 32) { float wv[32];
#pragma unroll
                for (int j = 0; j < 32; ++j) wv[j] = __builtin_nontemporal_load(w + (size_t)(k0 + j) * D6);
#pragma unroll
                for (int j = 0; j < 32; ++j) { const int kk = wave * (D_MODEL / 8) + k0 + j; acc0 += sl[kk] * wv[j]; acc1 += sl[D_MODEL + kk] * wv[j]; acc2 += sl[2 * D_MODEL + kk] * wv[j]; } }
            red[(wave * 3 + 0) * 64 + lane] = acc0; red[(wave * 3 + 1) * 64 + lane] = acc1; red[(wave * 3 + 2) * 64 + lane] = acc2;
            __syncthreads();
            if (tid < 192) { const int m = tid >> 6, ln = tid & 63; float s = 0.f;
#pragma unroll
                for (int w8 = 0; w8 < 8; ++w8) s += red[(w8 * 3 + m) * 64 + ln];
                p.MOD[((size_t)l * (BATCH + 1) + m) * D6 + n0 + ln] = s + p.b_ada[(size_t)l * D6 + n0 + ln]; }
            __syncthreads();
        }
        SEAM(0);
    }
    if (EN(1) && IN(1)) {
        PTRS();
        for (int r = gwave; r < MROWS; r += NGW) { vf4 x[NV4]; row_load(r < NLAT ? p.x + (size_t)r * D_MODEL : p.ctx + (size_t)(r - NLAT) * D_MODEL, lane, x);
            norm_h_wave(p, 0, r, 0, lane, x); }
        SEAM(1);
    }

    for (int l = 0; l < DEPTH; ++l) {
        const int sb = STEP0 + l * NSTEP;
        if (sb + NSTEP <= fresh_args()->step_lo || sb >= fresh_args()->step_hi) continue;
        const bool last = (l == DEPTH - 1);
        const int MR = last ? NLAT : MROWS;

        if (EN(2 + ST_INPROJ) && IN(sb + ST_INPROJ)) {
            PTRS();
            pg8::Gemm g{p.H, p.Wt_in + (size_t)l * NP_PAD * D_MODEL, MROWS, NP_PAD, D_MODEL, D_MODEL}; pg8::StaticOrder S; S.init(MROWS, NP_PAD, G, (int)blockIdx.x);
            pg8::EpiInProj E{p.P, p.PF};
            pg8::gemm_phase<pg8::EpiInProj, pg8::StaticOrder, true, true>(lds, g, S, E, tid);
#ifndef FILL_OFF
            if ((int)blockIdx.x >= FILL_A0) weight_fill(l, 0, FILL_EA, FILL_A0, lds, wave_s);
#endif
            SEAM(sb + ST_INPROJ);
        }

        if (EN(2 + ST_PREP) && IN(sb + ST_PREP)) {
            PTRS();
#ifdef NAIVE_PREP
            FOR_ITEMS(i, (size_t)MROWS * 3 * GDN_H) prep_gdn_item(p, l, (int)(i / (3 * GDN_H)), (int)(i % (3 * GDN_H)));
            FOR_ITEMS(i, (size_t)MROWS * 2 * GDN_H) prep_gdn_gb_item(p, l, (int)(i / (2 * GDN_H)), (int)(i % (2 * GDN_H)));
            FOR_ITEMS(i, (size_t)MROWS * SSM_XBC) prep_ssd_item(p, l, (int)(i / SSM_XBC), (int)(i % SSM_XBC));
            FOR_ITEMS(i, (size_t)MROWS * 2 * SSM_H) prep_ssd_dt_item(p, l, (int)(i / (2 * SSM_H)), (int)(i % (2 * SSM_H)));
#else
            for (int it = gwave; it < (MROWS / PREP_RB) * PREP_NPASS; it += NGW) prep_conv_block_wave(p, l, it / PREP_NPASS, it % PREP_NPASS, lane);
#endif
#ifdef NAIVE_ATTN
            FOR_ITEMS(i, (size_t)MROWS * (ATT_HQ + ATT_HKV)) prep_attn_item(p, (int)(i / (ATT_HQ + ATT_HKV)), (int)(i % (ATT_HQ + ATT_HKV)));
#endif
            SEAM(sb + ST_PREP);
        }

        if (EN(2 + ST_G1) && IN(sb + ST_G1)) {
            PTRS();
            {
                constexpr int NG = BATCH * NCH * GDN_H, NS = SSD_LOCAL_UNITS; unsigned* ctr = fresh_args()->ctl + 8192 + 64 * (DEPTH + l);
                for (;;) { if (tid == 0) MISC[16] = __hip_atomic_fetch_add(ctr, 1u, __ATOMIC_RELAXED, __HIP_MEMORY_SCOPE_AGENT);
                    LDS_BARRIER(); const int u = (int)MISC[16]; LDS_BARRIER();
                    if (u >= NG + NS + ATT_EARLY) break;
                    int tl = tid; asm volatile("" : "+v"(tl));
                    if (u < ATT_EARLY) attn_unit(p, l, (LAS bf16*)lds, u, tl);
                    else if (u < ATT_EARLY + NS) ssd_local_unit(p, lds, u - ATT_EARLY, tl); else gdn_g1_unit(p, lds, u - ATT_EARLY - NS, tl); } }
            SEAM(sb + ST_G1);
        }

        if (EN(2 + ST_MIX) && IN(sb + ST_MIX)) {
            PTRS();
            constexpr int N_GDN_WG = BATCH * GDN_H * 2 * 4, N_SSD_WG = BATCH * SSM_H * 2;
            const int wg = (int)blockIdx.x;
#ifdef TOKEN_GDN
            if (wg < N_GDN_WG) gdn_token_wg(p, (LAS float*)lds, wg >> 2, wg & 3, tid);
#else
            if (wg < N_GDN_WG) gdn_scan_wg(p, lds, (wg & 7) + 8 * (wg >> 5), (wg >> 3) & 3, tid);
#endif
#ifdef TOKEN_SSD
            else if (wg < N_GDN_WG + N_SSD_WG) ssd_token_wg(p, (LAS float*)lds, wg - N_GDN_WG, tid);
#else
            else if (wg < N_GDN_WG + N_SSD_WG) ssd_scan_wg(p, lds, wg - N_GDN_WG, tid);
#endif
            {
                const int nu = ATT_UNITS_LAT + (last ? 0 : ATT_UNITS_CTX); unsigned* ctr = fresh_args()->ctl + 8192 + 64 * l;
                for (;;) { if (tid == 0) MISC[16] = ATT_EARLY + __hip_atomic_fetch_add(ctr, 1u, __ATOMIC_RELAXED, __HIP_MEMORY_SCOPE_AGENT);
                    LDS_BARRIER(); const int u = (int)MISC[16]; LDS_BARRIER();
                    if (u >= nu) break;
                    attn_unit(p, l, (LAS bf16*)lds, u, tid); } }
#ifndef FILL_OFF
            {
                constexpr int NCH_M = (FILL_EM - FILL_EA + FILL_MCH - 1) / FILL_MCH; unsigned* ctr = fresh_args()->ctl + 8192 + 64 * (2 * DEPTH + l);
                const int em = (last && FILL_EM > WT_OWN) ? WT_OWN : FILL_EM;
                for (;;) { if (tid == 0) MISC[16] = __hip_atomic_fetch_add(ctr, 1u, __ATOMIC_RELAXED, __HIP_MEMORY_SCOPE_AGENT);
                    LDS_BARRIER(); const int ch = (int)MISC[16]; LDS_BARRIER();
                    const int fb = FILL_EA + ch * FILL_MCH; if (ch >= NCH_M || fb >= em) break;
                    weight_fill_ws(l, fb, fb + FILL_MCH < em ? fb + FILL_MCH : em, wave_s, 8, lds, wave_s); } }
#endif
            SEAM(sb + ST_MIX);
        }

        if (EN(2 + ST_MIXOUT) && IN(sb + ST_MIXOUT)) {
            PTRS();
#ifdef NAIVE_MIXOUT
            FOR_ITEMS(i, (size_t)MROWS * GDN_H) gdn_out_item(p, l, (int)(i / GDN_H), (int)(i % GDN_H));
            FOR_ITEMS(i, (size_t)MROWS * SSM_G) ssd_out_item(p, l, (int)(i / SSM_G), (int)(i % SSM_G));
#else
            for (int r = gwave; r < (last ? NLAT : MROWS); r += NGW) mixout_row_wave(p, l, r, lane);
#endif
            SEAM(sb + ST_MIXOUT);
        }

        if (EN(2 + ST_MERGE) && IN(sb + ST_MERGE)) {
            PTRS();
            { pg8::Gemm g{p.YA, p.Wt_br + (size_t)l * 3 * D_MODEL * MIX_W, NLAT, D_MODEL, 3 * MIX_W, 3 * MIX_W}; pg8::StaticOrder S; S.init(NLAT, D_MODEL, G, (int)blockIdx.x);
              pg8::EpiMerge3 E{p.P + C_MG, p.MB};
              pg8::gemm_phase<pg8::EpiMerge3, pg8::StaticOrder, true, true>(lds, g, S, E, tid); }
            if (!last) { pg8::Gemm g{p.YA, p.Wt_br + (size_t)l * 3 * D_MODEL * MIX_W, MROWS, D_MODEL, MIX_W, 3 * MIX_W}; pg8::CtxMergeOrder S{(int)blockIdx.x};
              pg8::EpiMerge E{p.P + C_MG, p.TB};
              FRESH_TID(tid2); pg8::gemm_phase<pg8::EpiMerge, pg8::CtxMergeOrder, true, true>(lds, g, S, E, tid2); }
#ifndef FILL_OFF
            if ((int)blockIdx.x >= FILL_B0) weight_fill(l, FILL_EM, FILL_EB, FILL_B0, lds, wave_s);
#endif
            SEAM(sb + ST_MERGE);
        }

        if (EN(2 + ST_OUT) && IN(sb + ST_OUT)) {
            PTRS();
            { pg8::Gemm g{p.MB, p.Wt_out + (size_t)l * D_MODEL * D_MODEL, NLAT, D_MODEL, D_MODEL, D_MODEL}; pg8::StaticOrder S; S.init(NLAT, D_MODEL, G, (int)blockIdx.x);
              pg8::EpiBf16Plain E{p.MIXb, D_MODEL};
              pg8::gemm_phase<pg8::EpiBf16Plain, pg8::StaticOrder, true, true>(lds, g, S, E, tid); }
            if (!last) {
                pg8::Gemm g{p.TB, p.Wt_out + (size_t)l * D_MODEL * D_MODEL, 3 * NCTX, D_MODEL, pg8::SPLIT_KS, D_MODEL}; pg8::SplitOrder3 S{G, (int)blockIdx.x};
                pg8::EpiSlab3 E{p.SLAB};
                FRESH_TID(tid2); pg8::gemm_phase<pg8::EpiSlab3, pg8::SplitOrder3, true, true>(lds, g, S, E, tid2); }
            SEAM(sb + ST_OUT);
        }

        if (EN(2 + ST_NORM2) && IN(sb + ST_NORM2)) {
            PTRS();
            for (int r = gwave; r < MR; r += NGW) { int ll = lane; asm volatile("" : "+v"(ll)); vf4 x[NV4]; row_load(l > 0 ? p.X + (size_t)r * D_MODEL : (r < NLAT ? p.x + (size_t)r * D_MODEL : p.ctx + (size_t)(r - NLAT) * D_MODEL), ll, x); resid_wave(p, l, r, 0, ll, x, 3 * pg8::OUT_NS);
                row_store(p.X + (size_t)r * D_MODEL, ll, x); norm_h_wave(p, l, r, 1, ll, x); }
            SEAM(sb + ST_NORM2);
        }

        if (EN(2 + ST_UP) && IN(sb + ST_UP)) {
            PTRS();
            pg8::Gemm g{p.H, p.Wt_up + (size_t)l * 2 * D_FF * D_MODEL, MR, 2 * D_FF, D_MODEL, D_MODEL}; pg8::StaticOrder S; S.init(MR, 2 * D_FF, G, (int)blockIdx.x);
            pg8::EpiAct E{p.ACT, p.BP, p.BU, p.BG, p.ffn_conv_w + (size_t)l * 3 * D_FF, p.ffn_conv_b + (size_t)l * D_FF};
            pg8::gemm_phase<pg8::EpiAct, pg8::StaticOrder, true, true>(lds, g, S, E, tid);
#ifndef FILL_OFF
            if ((int)blockIdx.x >= FILL_C0) weight_fill(l, FILL_EB, FILL_EC, FILL_C0, lds, wave_s);
#endif
            SEAM(sb + ST_UP);
        }

        if (EN(2 + ST_ACT) && IN(sb + ST_ACT)) { PTRS();
            for (int it = (int)gtid; it < (MR / 64 * 2) * (D_FF / 4); it += (int)NT) act_fix_item(p, l, it / (D_FF / 4), (it % (D_FF / 4)) * 4);
            SEAM(sb + ST_ACT); }

        if (EN(2 + ST_DOWN) && IN(sb + ST_DOWN)) {
            PTRS();
            { pg8::Gemm g{p.ACT, p.Wt_down + (size_t)l * D_MODEL * D_FF, NLAT, D_MODEL, D_FF, D_FF}; pg8::StaticOrder S; S.init(NLAT, D_MODEL, G, (int)blockIdx.x);
              pg8::EpiBf16Plain E{p.MIXb, D_MODEL};
              pg8::gemm_phase<pg8::EpiBf16Plain, pg8::StaticOrder, true, true>(lds, g, S, E, tid); }
            if (!last) {
                pg8::Gemm g{p.ACT, p.Wt_down + (size_t)l * D_MODEL * D_FF, MROWS, D_MODEL, pg8::SPLIT_KS, D_FF}; pg8::SplitOrder S{pg8::DOWN_NS, G, (int)blockIdx.x};
                pg8::EpiSlab E{p.SLAB};
                FRESH_TID(tid2); pg8::gemm_phase<pg8::EpiSlab, pg8::SplitOrder, true, true>(lds, g, S, E, tid2); }
            SEAM(sb + ST_DOWN);
        }

        if (EN(2 + ST_NORM3) && IN(sb + ST_NORM3)) {
            PTRS();
            for (int r = gwave; r < (last ? NLAT : MROWS); r += NGW) { int ll = lane; asm volatile("" : "+v"(ll)); vf4 x[NV4]; row_load(p.X + (size_t)r * D_MODEL, ll, x); resid_wave(p, l, r, 1, ll, x, pg8::DOWN_NS);
                if (last) row_store(p.out + (size_t)r * D_MODEL, ll, x);
                else { row_store(p.X + (size_t)r * D_MODEL, ll, x); norm_h_wave(p, l + 1, r, 0, ll, x); } }
            SEAM(sb + ST_NORM3);
        }
    }
#undef IN
#undef SEAM
#undef FOR_ITEMS
}

extern "C" void kernel_launch(void* const* d_in, const int* in_sizes, int n_in, void* d_out, int out_size, void* d_ws, size_t ws_size, hipStream_t stream) {
    static int grid = 0;
    if (grid == 0) {
        if (n_in != 30 || in_sizes[0] != NLAT * D_MODEL || out_size != NLAT * D_MODEL || ws_size < WS_NEED) {
            fprintf(stderr, "kernel_launch: unexpected problem: n_in %d in0 %d out %d ws %zu (need %zu); nothing launched\n", n_in, n_in > 0 ? in_sizes[0] : -1, out_size, ws_size, (size_t)WS_NEED); grid = -1; return; }
        int dev = 0, cus = 0;
        if (hipGetDevice(&dev) != hipSuccess || hipDeviceGetAttribute(&cus, hipDeviceAttributeMultiprocessorCount, dev) != hipSuccess) { grid = -1; return; }
        if (hipFuncSetAttribute((const void*)fwd, hipFuncAttributeMaxDynamicSharedMemorySize, LDS_BYTES) != hipSuccess) { fprintf(stderr, "kernel_launch: hipFuncSetAttribute failed\n"); grid = -1; return; }
        int per_cu = 0;
        if (hipOccupancyMaxActiveBlocksPerMultiprocessor(&per_cu, (const void*)fwd, NTHREADS, LDS_BYTES) != hipSuccess || per_cu < 1) fprintf(stderr, "kernel_launch: occupancy query reports %d\n", per_cu);
        (void)hipGetLastError();
        grid = cus;
        if (grid != 256) { fprintf(stderr, "kernel_launch: built for a 256-CU device (workgroup roles in the mixer phase); got %d; nothing launched\n", cus); grid = -1; return; }
    }
    if (grid < 0) return;
    unsigned char* ws = (unsigned char*)d_ws;
    if (hipMemsetAsync(ws + WS_CTL, 0, CTL_BYTES, stream) != hipSuccess) return;
    Args a{};
    const float** pi = (const float**)&a.p;
    for (int i = 0; i < 30; ++i) pi[i] = (const float*)d_in[i];
    Ptrs& p = a.p;
    p.out = (float*)d_out;
    p.Wt_in = (bf16*)(ws + WS_WIN); p.Wt_br = (bf16*)(ws + WS_WBR); p.Wt_out = (bf16*)(ws + WS_WOUT); p.Wt_up = (bf16*)(ws + WS_WUP); p.Wt_down = (bf16*)(ws + WS_WDOWN);
    p.MOD = (float*)(ws + WS_MOD); p.ROPE = p.MOD + (size_t)DEPTH * (BATCH + 1) * D6; p.X = (float*)(ws + WS_X); p.H = (bf16*)(ws + WS_H); p.MIX = (float*)(ws + WS_MIX); p.MIXb = (bf16*)(ws + WS_MIX);
    p.SLAB = (float*)(ws + WS_SLAB); p.TB = (bf16*)(ws + WS_TB);
    p.OGb = (bf16*)(ws + WS_OGB); p.OSb = (bf16*)(ws + WS_OSB); p.OSb2 = (bf16*)(ws + WS_OSB2); p.GQKVb = (bf16*)(ws + WS_GQKVB); p.SXb = (bf16*)(ws + WS_SXB);
    p.P = (bf16*)(ws + WS_P); p.PF = (float*)(ws + WS_PF); p.GQKV = (float*)(ws + WS_GQKV); p.GG = (float*)(ws + WS_GG); p.GB = (float*)(ws + WS_GB);
    p.SXBC = (float*)(ws + WS_SXBC); p.SDT = (float*)(ws + WS_SDT); p.SA = (float*)(ws + WS_SA); p.AQ = (float*)(ws + WS_AQ); p.AK = (float*)(ws + WS_AK);
    p.OG = (float*)(ws + WS_OG); p.OS = (float*)(ws + WS_OS); p.SC = (float*)(ws + WS_SC); p.YA = (bf16*)(ws + WS_YA); p.YB = p.YA + MIX_W; p.YC = p.YA + 2 * MIX_W;
    p.SBCb = (bf16*)(ws + WS_SBCB); p.SSC = (bf16*)(ws + WS_SSC); p.SEA = (float*)(ws + WS_SEA); p.SEAb = (bf16*)(ws + WS_SEA); p.SDC = (float*)(ws + WS_SDC); p.SCF = (bf16*)(ws + WS_SCF);
    p.GW = (bf16*)(ws + WS_GW); p.GQd = (bf16*)(ws + WS_GQD); p.GKdT = (bf16*)(ws + WS_GKDT); p.GA = (bf16*)(ws + WS_GA); p.GUT = (bf16*)(ws + WS_GUT); p.GGL = (float*)(ws + WS_GGL);
    p.AQb = (bf16*)(ws + WS_AQB); p.AKb = (bf16*)(ws + WS_AKB);
    p.M32 = (float*)(ws + WS_M32); p.MB = (bf16*)(ws + WS_MB); p.UG = nullptr; p.ACT = (bf16*)(ws + WS_ACT); p.BP = (float*)(ws + WS_BP); p.BU = (bf16*)(ws + WS_BU); p.BG = (bf16*)(ws + WS_BG);
    a.ctl = (unsigned*)(ws + WS_CTL);
#if MK_LAUNCH_MODE == 1
    a.step_lo = 0; a.step_hi = TOTAL_STEPS;
    hipLaunchKernelGGL(fwd, dim3(grid), dim3(NTHREADS), LDS_BYTES, stream, a);
#else
    for (int s = 0; s < TOTAL_STEPS; ++s) { a.step_lo = s; a.step_hi = s + 1; hipLaunchKernelGGL(fwd, dim3(grid), dim3(NTHREADS), LDS_BYTES, stream, a); }
#endif
    const hipError_t le = hipPeekAtLastError();
    if (le != hipSuccess) fprintf(stderr, "kernel_launch: launch failed: %s\n", hipGetErrorName(le));
}
```

```cpp
#include <hip/hip_runtime.h>
#include <cstdio>
#include <cstdint>
#include <type_traits>
#define MK_LAUNCH_MODE 1
#define FILL_NA 10
#define FILL_NB 14
#define FILL_NC 4
#define FILL_NM 256
#include <cstdint>
#include <cstddef>
#include <cmath>
#ifdef HOST_TEST
#define HD inline
#define CFENCE() do {} while (0)
#else
#define HD __host__ __device__ __forceinline__
#if defined(__HIP_DEVICE_COMPILE__)
#define CFENCE() asm volatile("" ::: "memory")
#else
#define CFENCE() do {} while (0)
#endif
#endif

#ifndef CFG_SMALL
constexpr int D_MODEL = 2048, BATCH = 2, SEQ = 4096, DEPTH = 4, CTX_LEN = 256, D_FF = 5632;
#else
constexpr int D_MODEL = 1024, BATCH = 2, SEQ = 512, DEPTH = 2, CTX_LEN = 128, D_FF = 512;
#endif
constexpr int GRID_W = 64, WINDOW = 128;
constexpr float EPS = 1e-6f;
constexpr int MIX_W = D_MODEL / 2, GDN_H = MIX_W / 128, SSM_H = MIX_W / 64, SSM_G = 2, SSM_N = 128, SSM_P = 64, SSM_HPG = SSM_H / SSM_G;
constexpr int ATT_HQ = MIX_W / 128, ATT_HKV = 2, ATT_GRP = ATT_HQ / ATT_HKV;
constexpr int SSM_BC = SSM_G * SSM_N, SSM_XBC = MIX_W + 2 * SSM_BC;
constexpr int NLAT = BATCH * SEQ, NCTX = BATCH * CTX_LEN, MROWS = NLAT + NCTX;
constexpr int CHAIN_LEN = CTX_LEN + SEQ;
constexpr int R_QKV = 0, R_GATE = 3 * MIX_W, R_A = 4 * MIX_W, R_B = R_A + 2 * GDN_H, R_Z = R_B + 2 * GDN_H, R_XBC = R_Z + MIX_W, R_DT = R_XBC + SSM_XBC,
              R_AQ = R_DT + 2 * SSM_H, R_AKV = R_AQ + MIX_W, R_MG = R_AKV + 2 * ATT_HKV * 128, P_IN = R_MG + 3 * D_MODEL;
constexpr int C_QKV = 0, C_GATE = 3 * MIX_W, C_Z = 4 * MIX_W, C_XBC = 5 * MIX_W, C_AQ = C_XBC + SSM_XBC, C_AKV = C_AQ + MIX_W, C_MG = C_AKV + 512, NP_MAIN = C_MG + 3 * D_MODEL;
constexpr int PF_A = 0, PF_B = 2 * GDN_H, PF_DT = 4 * GDN_H, PF_N = 4 * GDN_H + 2 * SSM_H;
constexpr int NP_PAD = NP_MAIN + 256;
static_assert(NP_MAIN % 256 == 0 && PF_N <= 256 && MROWS % 256 == 0 && (2 * D_FF) % 256 == 0 && D_FF % 256 == 0, "tile shapes");
static_assert(P_IN == NP_MAIN + PF_N, "column bookkeeping");
constexpr int D6 = 6 * D_MODEL;

typedef unsigned short bf16;
HD float bf2f(bf16 b) { union { unsigned u; float f; } c; c.u = ((unsigned)b) << 16; return c.f; }
HD bf16 f2bf(float f) { union { unsigned u; float f; } c; c.f = f; unsigned u = c.u; u += 0x7FFFu + ((u >> 16) & 1u); return (bf16)(u >> 16); }
HD float silu_f(float x) { return x / (1.0f + expf(-x)); }
HD float sigmoid_f(float x) { return 1.0f / (1.0f + expf(-x)); }
#if defined(__HIP_DEVICE_COMPILE__)
HD float softplus_f(float x) { return x > 20.0f ? x : __logf(1.0f + __expf(x)); }
#else
HD float softplus_f(float x) { return x > 20.0f ? x : log1pf(expf(x)); }
#endif

struct Ptrs {
    const float *x, *c, *ctx, *c_ctx, *w_ada, *b_ada, *g_pre1, *w_in, *gdn_conv_w, *gdn_a_log, *gdn_dt_bias, *gdn_norm, *ssm_conv_w, *ssm_conv_b, *ssm_a_log,
        *ssm_dt_bias, *ssm_d, *ssm_norm, *attn_sink, *w_br_a, *w_br_b, *w_br_c, *w_out, *g_post1, *g_pre2, *w_up, *ffn_conv_w, *ffn_conv_b, *w_down, *g_post2;
    float* out;
    bf16 *Wt_in, *Wt_br, *Wt_out, *Wt_up, *Wt_down;
    float* ROPE;
    float* MOD;
    float* X;
    bf16* H;
    bf16* P;
    float* PF;
    float *GQKV, *GG, *GB;
    float *SXBC, *SDT, *SA;
    float *AQ, *AK;
    bf16 *GW, *GQd, *GKdT, *GA, *GUT; float* GGL;
    bf16 *SBCb, *SSC, *SEAb, *SCF; float *SEA, *SDC;
    bf16 *MIXb, *OGb, *OSb, *OSb2, *GQKVb, *SXb;
    bf16 *AQb, *AKb;
    float *OG, *OS;
    float* SC;
    bf16 *YA, *YB, *YC;
    float* M32;
    bf16* MB;
    float* MIX;
    bf16* UG;
    bf16* ACT;
    bf16* TB;
    float* SLAB;
    float* BP; bf16 *BU, *BG;
};
constexpr int SC_LD = 2 * WINDOW + 1 + CTX_LEN + 3;

HD void row_info(int r, int& b, int& t, int& len, bool& is_ctx) {
    if (r < NLAT) { b = r / SEQ; t = r % SEQ; len = SEQ; is_ctx = false; } else { const int q = r - NLAT; b = q / CTX_LEN; t = q % CTX_LEN; len = CTX_LEN; is_ctx = true; }
}
HD int mod_row(int r) { return r < NLAT ? r / SEQ : BATCH; }

HD int inproj_src_col(int np) {
    if (np < C_Z) return np;
    if (np < NP_MAIN) return np + 4 * GDN_H + (np >= C_AQ ? 2 * SSM_H : 0);
    const int j = np - NP_MAIN;
    if (j < PF_DT) return R_A + j;
    if (j < PF_N) return R_DT + (j - PF_DT);
    return -1;
}
HD void wcvt_item(const float* W, int K, int N, bf16* Wt, int np, int k8, bool inproj) {
    const int n = inproj ? inproj_src_col(np) : np;
    for (int j = 0; j < 8; ++j) { const int k = k8 * 8 + j; Wt[(size_t)np * K + k] = (n < 0) ? (bf16)0 : f2bf(W[(size_t)k * N + n]); }
}

HD void mod_item(const Ptrs& p, int l, int n) {
    float acc[BATCH + 1];
    for (int m = 0; m <= BATCH; ++m) acc[m] = 0.f;
    for (int k = 0; k < D_MODEL; ++k) {
        const float w = p.w_ada[((size_t)l * D_MODEL + k) * D6 + n];
        for (int m = 0; m < BATCH; ++m) acc[m] += silu_f(p.c[m * D_MODEL + k]) * w;
        acc[BATCH] += silu_f(p.c_ctx[k]) * w;
    }
    for (int m = 0; m <= BATCH; ++m) p.MOD[((size_t)l * (BATCH + 1) + m) * D6 + n] = acc[m] + p.b_ada[(size_t)l * D6 + n];
}
HD void xinit_item(const Ptrs& p, size_t i) { p.X[i] = i < (size_t)NLAT * D_MODEL ? p.x[i] : p.ctx[i - (size_t)NLAT * D_MODEL]; }

HD float row_rstd(const float* v, int n) { float s = 0.f; for (int j = 0; j < n; ++j) s += v[j] * v[j]; return 1.0f / sqrtf(s / (float)n + EPS); }
HD void norm_to_h_row(const Ptrs& p, int l, int r, int which) {
    const float* xr = p.X + (size_t)r * D_MODEL; const float* g = (which ? p.g_pre2 : p.g_pre1) + (size_t)l * D_MODEL;
    const float* mod = p.MOD + ((size_t)l * (BATCH + 1) + mod_row(r)) * D6 + (which ? 3 * D_MODEL : 0);
    const float rs = row_rstd(xr, D_MODEL);
    for (int j = 0; j < D_MODEL; ++j) p.H[(size_t)r * D_MODEL + j] = f2bf(xr[j] * rs * g[j] * (1.0f + mod[D_MODEL + j]) + mod[j]);
}
HD void resid_row(const Ptrs& p, int l, int r, int which, bool to_out) {
    const float* yr = p.MIX + (size_t)r * D_MODEL; const float* g = (which ? p.g_post2 : p.g_post1) + (size_t)l * D_MODEL;
    const float* gate = p.MOD + ((size_t)l * (BATCH + 1) + mod_row(r)) * D6 + (which ? 5 * D_MODEL : 2 * D_MODEL);
    const float rs = row_rstd(yr, D_MODEL);
    float* xr = p.X + (size_t)r * D_MODEL;
    for (int j = 0; j < D_MODEL; ++j) { const float v = xr[j] + gate[j] * (yr[j] * rs * g[j]); xr[j] = v; if (to_out && r < NLAT) p.out[(size_t)r * D_MODEL + j] = v; }
}

HD float conv3_p(const Ptrs& p, int r, int col, const float* w, int wld, int j) {
    int b, t, len; bool ic; row_info(r, b, t, len, ic);
    float y = w[wld + j] * bf2f(p.P[(size_t)r * NP_MAIN + col]);
    if (t > 0) y += w[j] * bf2f(p.P[(size_t)(r - 1) * NP_MAIN + col]);
    if (t < len - 1) y += w[2 * wld + j] * bf2f(p.P[(size_t)(r + 1) * NP_MAIN + col]);
    return y;
}
HD void prep_gdn_item(const Ptrs& p, int l, int r, int grp) {
    const float* w = p.gdn_conv_w + (size_t)l * 3 * (3 * MIX_W);
    float sc = 1.0f;
    if (grp < 2 * GDN_H) {
        float ss = 0.f;
        for (int d = 0; d < 128; ++d) { const int j = grp * 128 + d; const float v = silu_f(conv3_p(p, r, C_QKV + j, w, 3 * MIX_W, j)); ss += v * v; }
        sc = 1.0f / sqrtf(ss + EPS); if (grp < GDN_H) sc *= 0.08838834764831845f;
    }
    for (int d = 0; d < 128; ++d) { const int j = grp * 128 + d; p.GQKV[(size_t)r * (3 * MIX_W) + j] = silu_f(conv3_p(p, r, C_QKV + j, w, 3 * MIX_W, j)) * sc; }
}
HD void prep_gdn_gb_item(const Ptrs& p, int l, int r, int j) {
    const float a = p.PF[(size_t)r * PF_N + PF_A + j], bb = p.PF[(size_t)r * PF_N + PF_B + j];
    p.GG[(size_t)r * 2 * GDN_H + j] = -expf(p.gdn_a_log[(size_t)l * 2 * GDN_H + j]) * softplus_f(a + p.gdn_dt_bias[(size_t)l * 2 * GDN_H + j]);
    p.GB[(size_t)r * 2 * GDN_H + j] = sigmoid_f(bb);
}
HD void prep_ssd_item(const Ptrs& p, int l, int r, int j) {
    const float* w = p.ssm_conv_w + (size_t)l * 3 * SSM_XBC;
    p.SXBC[(size_t)r * SSM_XBC + j] = silu_f(conv3_p(p, r, C_XBC + j, w, SSM_XBC, j) + p.ssm_conv_b[(size_t)l * SSM_XBC + j]);
}
HD void prep_ssd_dt_item(const Ptrs& p, int l, int r, int j) {
    const float dt = softplus_f(p.PF[(size_t)r * PF_N + PF_DT + j] + p.ssm_dt_bias[(size_t)l * 2 * SSM_H + j]);
    p.SDT[(size_t)r * 2 * SSM_H + j] = dt; p.SA[(size_t)r * 2 * SSM_H + j] = -expf(p.ssm_a_log[(size_t)l * 2 * SSM_H + j]) * dt;
}
HD float rope_inv_freq(int i) { return exp2f(-(float)i * 0.4152410118609203f); }
HD void prep_attn_item(const Ptrs& p, int r, int hh) {
    int b, t, len; bool ic; row_info(r, b, t, len, ic);
    const bool isq = hh < ATT_HQ; const int h = isq ? hh : hh - ATT_HQ;
    const bf16* src = p.P + (size_t)r * NP_MAIN + (isq ? C_AQ + h * 128 : C_AKV + h * 128);
    float* dst = isq ? p.AQ + (size_t)r * MIX_W + h * 128 : p.AK + (size_t)r * (ATT_HKV * 128) + h * 128;
    if (ic) { for (int d = 0; d < 128; ++d) dst[d] = bf2f(src[d]); return; }
    const float pos[2] = {(float)(t / GRID_W), (float)(t % GRID_W)};
    for (int ax = 0; ax < 2; ++ax)
        for (int i = 0; i < 32; ++i) {
            const float ang = pos[ax] * rope_inv_freq(i), cs = cosf(ang), sn = sinf(ang);
            const float x1 = bf2f(src[ax * 64 + i]), x2 = bf2f(src[ax * 64 + 32 + i]);
            dst[ax * 64 + i] = x1 * cs - x2 * sn; dst[ax * 64 + 32 + i] = x2 * cs + x1 * sn;
        }
}

HD int chain_row(int b, int dir, int s) {
    if (s < CTX_LEN) return NLAT + b * CTX_LEN + (dir ? CTX_LEN - 1 - s : s);
    const int u = s - CTX_LEN; return b * SEQ + (dir ? SEQ - 1 - u : u);
}
HD void gdn_chain_item(const Ptrs& p, int b, int h, int dir, int vc) {
    float S[128];
#pragma unroll
    for (int k = 0; k < 128; ++k) S[k] = 0.f;
    float pf = 0.f;
    for (int s = 0; s < CHAIN_LEN; ++s) {
        const int r = chain_row(b, dir, s);
        const float* q = p.GQKV + (size_t)r * (3 * MIX_W) + h * 128; const float* kk = q + MIX_W; const float vv = q[2 * MIX_W + vc];
        const float a = expf(p.GG[(size_t)r * 2 * GDN_H + dir * GDN_H + h]), be = p.GB[(size_t)r * 2 * GDN_H + dir * GDN_H + h];
        if (s + 1 < CHAIN_LEN) { const float* qn = p.GQKV + (size_t)chain_row(b, dir, s + 1) * (3 * MIX_W) + h * 128;
#pragma unroll
            for (int j = 0; j < 4; ++j) pf += qn[32 * j] + qn[MIX_W + 32 * j]; }
        float ks = 0.f;
#pragma unroll
        for (int c = 0; c < 2; ++c) { float kc[64];
#pragma unroll
            for (int j = 0; j < 64; ++j) kc[j] = kk[64 * c + j];
#pragma unroll
            for (int j = 0; j < 64; ++j) { S[64 * c + j] *= a; ks += kc[j] * S[64 * c + j]; }
            CFENCE(); }
        const float dl = be * (vv - ks); float o = 0.f;
#pragma unroll
        for (int c = 0; c < 4; ++c) { float kc[32], qc[32];
#pragma unroll
            for (int j = 0; j < 32; ++j) { kc[j] = kk[32 * c + j]; qc[j] = q[32 * c + j]; }
#pragma unroll
            for (int j = 0; j < 32; ++j) { S[32 * c + j] += kc[j] * dl; o += qc[j] * S[32 * c + j]; }
            CFENCE(); }
        p.OG[((size_t)dir * MROWS + r) * MIX_W + h * 128 + vc] = o;
    }
    if (pf == 123456.789f) p.OG[0] = pf;
}
HD void ssd_chain_item(const Ptrs& p, int b, int hd, int dir, int pc) {
    float hs[SSM_N];
#pragma unroll
    for (int s = 0; s < SSM_N; ++s) hs[s] = 0.f;
    const int g = hd / SSM_HPG;
    float pf = 0.f;
    for (int s = 0; s < CHAIN_LEN; ++s) {
        const int r = chain_row(b, dir, s);
        const float* xb = p.SXBC + (size_t)r * SSM_XBC; const float* Bm = xb + MIX_W + g * SSM_N; const float* Cm = xb + MIX_W + SSM_BC + g * SSM_N;
        const float dt = p.SDT[(size_t)r * 2 * SSM_H + dir * SSM_H + hd], ea = expf(p.SA[(size_t)r * 2 * SSM_H + dir * SSM_H + hd]);
        const float xd = xb[hd * SSM_P + pc] * dt; float y = 0.f;
        if (s + 1 < CHAIN_LEN) { const float* xn = p.SXBC + (size_t)chain_row(b, dir, s + 1) * SSM_XBC + MIX_W + g * SSM_N;
#pragma unroll
            for (int j = 0; j < 4; ++j) pf += xn[32 * j] + xn[SSM_BC + 32 * j]; }
#pragma unroll
        for (int c = 0; c < 4; ++c) { float bc[32], cc[32];
#pragma unroll
            for (int j = 0; j < 32; ++j) { bc[j] = Bm[32 * c + j]; cc[j] = Cm[32 * c + j]; }
#pragma unroll
            for (int j = 0; j < 32; ++j) { hs[32 * c + j] = ea * hs[32 * c + j] + xd * bc[j]; y += cc[j] * hs[32 * c + j]; }
            CFENCE(); }
        p.OS[((size_t)dir * MROWS + r) * MIX_W + hd * SSM_P + pc] = y;
    }
    if (pf == 123456.789f) p.OS[0] = pf;
}
HD void attn_item(const Ptrs& p, int l, int r, int hq) {
    int b, t, len; bool ic; row_info(r, b, t, len, ic);
    const int hkv = hq / ATT_GRP;
    const float* qp = p.AQ + (size_t)r * MIX_W + hq * 128;
    float* sc = p.SC + ((size_t)r * ATT_HQ + hq) * SC_LD;
    const float sink = p.attn_sink[(size_t)l * ATT_HQ + hq];
    const int lo = ic ? 0 : (t - WINDOW < 0 ? 0 : t - WINDOW), hi = ic ? -1 : (t + WINDOW > SEQ - 1 ? SEQ - 1 : t + WINDOW);
    const int nloc = ic ? 0 : hi - lo + 1, nk = nloc + CTX_LEN;
    float m = sink;
    {
        float q[128];
#pragma unroll
        for (int d = 0; d < 128; ++d) q[d] = qp[d];
        for (int j = 0; j < nk; ++j) {
            const int kr = j < nloc ? b * SEQ + lo + j : NLAT + b * CTX_LEN + (j - nloc);
            const float* kk = p.AK + (size_t)kr * (ATT_HKV * 128) + hkv * 128;
            float s = 0.f;
#pragma unroll
            for (int c = 0; c < 4; ++c) { float kc[32];
#pragma unroll
                for (int d = 0; d < 32; ++d) kc[d] = kk[32 * c + d];
#pragma unroll
                for (int d = 0; d < 32; ++d) s += q[32 * c + d] * kc[d];
                CFENCE(); }
            s *= 0.08838834764831845f; sc[j] = s; m = s > m ? s : m;
        }
    }
    float o[128];
#pragma unroll
    for (int d = 0; d < 128; ++d) o[d] = 0.f;
    float den = expf(sink - m);
    for (int j = 0; j < nk; ++j) {
        const int kr = j < nloc ? b * SEQ + lo + j : NLAT + b * CTX_LEN + (j - nloc);
        const bf16* vv = p.P + (size_t)kr * NP_MAIN + C_AKV + ATT_HKV * 128 + hkv * 128;
        const float e = expf(sc[j] - m); den += e;
#pragma unroll
        for (int c = 0; c < 4; ++c) { float vc[32];
#pragma unroll
            for (int d = 0; d < 32; ++d) vc[d] = bf2f(vv[32 * c + d]);
#pragma unroll
            for (int d = 0; d < 32; ++d) o[32 * c + d] += e * vc[d];
            CFENCE(); }
    }
    const float inv = 1.0f / den;
#pragma unroll
    for (int d = 0; d < 128; ++d) p.YC[(size_t)r * MIX_W + hq * 128 + d] = f2bf(o[d] * inv);
}
HD void gdn_out_item(const Ptrs& p, int l, int r, int h) {
    float ss = 0.f;
    for (int d = 0; d < 128; ++d) { const size_t i = (size_t)r * MIX_W + h * 128 + d; const float v = p.OG[i] + p.OG[(size_t)MROWS * MIX_W + i]; ss += v * v; }
    const float rs = 1.0f / sqrtf(ss / 128.0f + EPS);
    for (int d = 0; d < 128; ++d) { const size_t i = (size_t)r * MIX_W + h * 128 + d; const float v = p.OG[i] + p.OG[(size_t)MROWS * MIX_W + i];
        p.YA[i] = f2bf(v * rs * p.gdn_norm[(size_t)l * 128 + d] * silu_f(bf2f(p.P[(size_t)r * NP_MAIN + C_GATE + h * 128 + d]))); }
}
HD void ssd_out_item(const Ptrs& p, int l, int r, int g) {
    constexpr int GW = MIX_W / SSM_G;
    float ss = 0.f;
    for (int pass = 0; pass < 2; ++pass) {
        const float rs = pass ? 1.0f / sqrtf(ss / (float)GW + EPS) : 0.f;
        for (int jj = 0; jj < GW; ++jj) { const int j = g * GW + jj; const size_t i = (size_t)r * MIX_W + j;
            float y = p.OS[i] + p.OS[(size_t)MROWS * MIX_W + i] + p.ssm_d[(size_t)l * SSM_H + j / SSM_P] * p.SXBC[(size_t)r * SSM_XBC + j];
            y *= silu_f(bf2f(p.P[(size_t)r * NP_MAIN + C_Z + j]));
            if (!pass) ss += y * y; else p.YB[i] = f2bf(y * rs * p.ssm_norm[(size_t)l * MIX_W + j]); }
    }
}
HD void act_item(const Ptrs& p, int l, int r, int j) {
    int b, t, len; bool ic; row_info(r, b, t, len, ic);
    const float* w = p.ffn_conv_w + (size_t)l * 3 * D_FF;
    const bf16* ug = p.UG + (size_t)r * (2 * D_FF);
    float g = w[D_FF + j] * bf2f(ug[D_FF + j]);
    if (t > 0) g += w[j] * bf2f(ug[D_FF + j - 2 * D_FF]);
    if (t < len - 1) g += w[2 * D_FF + j] * bf2f(ug[D_FF + j + 2 * D_FF]);
    g += p.ffn_conv_b[(size_t)l * D_FF + j];
    p.ACT[(size_t)r * D_FF + j] = f2bf(silu_f(g) * bf2f(ug[j]));
}

namespace pg8 {
#define PG8_LAS __attribute__((address_space(3)))
typedef unsigned short bf16_t;
typedef short bf16x8 __attribute__((ext_vector_type(8)));
typedef float f32x4 __attribute__((ext_vector_type(4)));
typedef unsigned u32x4 __attribute__((ext_vector_type(4)));
constexpr int BM = 256, BK = 64, HALF = 128, HTB = HALF * BK * 2  , STAGE_BYTES = 8 * HTB, NXCD = 8, WGM = 8;

__host__ __device__ __forceinline__ int lds_byte(int r, int c) { const int st = (r >> 4) * 2 + (c >> 5), rr = r & 15, cc = c & 31, ob = rr * 64 + cc * 2; return st * 1024 + (ob ^ (((ob >> 9) & 1) << 5)); }
__host__ __device__ __forceinline__ void stage_rc(int b, int& R, int& C) { const int st = b / 1024, sb = b % 1024, swz = sb ^ (((sb >> 9) & 1) << 5); R = (st >> 1) * 16 + swz / 64; C = (st & 1) * 32 + (swz % 64) / 2; }
__host__ __device__ __forceinline__ int perm32(int rho) { const int n = rho >> 4, i = rho & 15; return 8 * (i >> 2) + 4 * n + (i & 3); }

struct Unit { int pm, pn, pk; };
struct Gemm { const bf16_t* A; const bf16_t* Bt; int M, N, K, ld; };

struct StaticOrder {
    int nM, nN, nwg, G, c;
    __host__ __device__ void init(int M, int N, int G_, int c_) { nM = M / BM; nN = N / BM; nwg = nM * nN; G = G_; c = c_; }
    __host__ __device__ bool next(int i, Unit& u) const {
        const long L = (long)i * G + c; if (L >= nwg) return false;
        int wgid = (int)L; { const int q = nwg / NXCD, r = nwg % NXCD, xcd = wgid % NXCD, off = wgid / NXCD; wgid = (xcd < r ? xcd * (q + 1) : r * (q + 1) + (xcd - r) * q) + off; }
        const int nig = WGM * nN, gid = wgid / nig, fm = gid * WGM, gsz = (nM - fm) < WGM ? (nM - fm) : WGM;
        u.pm = fm + ((wgid % nig) % gsz); u.pn = (wgid % nig) / gsz; u.pk = 0; return true;
    }
    __device__ __forceinline__ void a_ready(const Unit&) const {}
    __device__ __forceinline__ void done(const Unit&) const {}
};

__device__ __forceinline__ unsigned cvt_pk_bf16(float lo, float hi) { unsigned r; asm volatile("v_cvt_pk_bf16_f32 %0, %1, %2" : "=v"(r) : "v"(lo), "v"(hi)); return r; }

template <class Epi, class Sched, bool ALIGN_EPI = false, bool SP2 = false>
__device__ __forceinline__ void gemm_phase(PG8_LAS unsigned char* lds, const Gemm g, const Sched& S, const Epi& E, int tid_in) {
    int tid_l = tid_in; asm volatile("" : "+v"(tid_l));
    const int tid = tid_l, wid = __builtin_amdgcn_readfirstlane(tid >> 6), lane = tid & 63, wr = wid >> 2, wc = wid & 3, fr = lane & 15, fq = lane >> 4;
    const int K = g.K, nt = K / BK, LD = g.ld;
    unsigned voffA[2], voffB[2];
#pragma unroll
    for (int i = 0; i < 2; ++i) { int R, C; stage_rc(tid * 16 + i * 8192, R, C); const int Rb = Epi::PERM ? ((R & ~31) + perm32(R & 31)) : R;
        voffA[i] = (unsigned)(R * LD + C) * 2u; voffB[i] = (unsigned)(Rb * LD + C) * 2u; }
    const size_t kstep = (size_t)(BK * 2);
    const size_t hstep = (size_t)HALF * LD * 2;
    const size_t tstep = 2 * hstep;
    const unsigned ldsw = (unsigned)wid * 1024u;
    const int aoff = lds_byte(wr * 64 + fr, fq * 8), boff = lds_byte(wc * 32 + fr, fq * 8);
#define PG8_SA(b, h) (((b) * 2 + (h)) * HTB)
#define PG8_SB(b, h) ((4 + (b) * 2 + (h)) * HTB)
#define PG8_STAGE(bufoff, gbase, voff) do { _Pragma("unroll") for (int _i = 0; _i < 2; ++_i) \
        __builtin_amdgcn_global_load_lds((const unsigned*)((const char*)(gbase) + (voff)[_i]), (PG8_LAS unsigned*)(lds + (bufoff) + ldsw + _i * 8192), 16, 0, 0); } while (0)
#define PG8_LDA(dst, b, h) do { _Pragma("unroll") for (int m = 0; m < 4; ++m) _Pragma("unroll") for (int k = 0; k < 2; ++k) dst[m][k] = *(const PG8_LAS bf16x8*)(lds + PG8_SA(b, h) + aoff + m * 2048 + k * 1024); } while (0)
#define PG8_LDB(dst, b, h) do { _Pragma("unroll") for (int n = 0; n < 2; ++n) _Pragma("unroll") for (int k = 0; k < 2; ++k) dst[n][k] = *(const PG8_LAS bf16x8*)(lds + PG8_SB(b, h) + boff + n * 2048 + k * 1024); } while (0)
#define PG8_MMA(ai, bj, At, Bt) do { __builtin_amdgcn_s_setprio(1); _Pragma("unroll") for (int m = 0; m < 4; ++m) _Pragma("unroll") for (int n = 0; n < 2; ++n) _Pragma("unroll") for (int k = 0; k < 2; ++k) \
        acc[ai][bj][m][n] = __builtin_amdgcn_mfma_f32_16x16x32_bf16(Bt[n][k], At[m][k], acc[ai][bj][m][n], 0, 0, 0); __builtin_amdgcn_s_setprio(0); } while (0)
#define PG8_WAIT_V(n) asm volatile("s_waitcnt vmcnt(" #n ")" ::: "memory")
#define PG8_WAIT_L(n) asm volatile("s_waitcnt lgkmcnt(" #n ")" ::: "memory")
#define PG8_BAR __builtin_amdgcn_s_barrier()
#define PG8_SCHED __builtin_amdgcn_sched_barrier(0)
    Unit cur, nxt; int ui = 0;
    if (!S.next(0, cur)) return;
    f32x4 acc[2][2][4][2];
#pragma unroll
    for (int a = 0; a < 2; ++a)
#pragma unroll
        for (int b = 0; b < 2; ++b)
#pragma unroll
            for (int m = 0; m < 4; ++m)
#pragma unroll
                for (int n = 0; n < 2; ++n) acc[a][b][m][n] = (f32x4){0.f, 0.f, 0.f, 0.f};
    bf16x8 At[4][2], B0[2][2], B1[2][2];
    const char* cA = (const char*)g.A + (size_t)cur.pm * tstep + (size_t)cur.pk * 2; const char* cB = (const char*)g.Bt + (size_t)cur.pn * tstep + (size_t)cur.pk * 2;
    S.a_ready(cur);
    if constexpr (SP2) {
        PG8_STAGE(PG8_SB(0, 0), cB, voffB); PG8_STAGE(PG8_SB(0, 1), cB + hstep, voffB); PG8_STAGE(PG8_SA(0, 0), cA, voffA); PG8_STAGE(PG8_SA(0, 1), cA + hstep, voffA);
        if (wr == 1) PG8_BAR;
        PG8_WAIT_V(2); PG8_BAR;
        PG8_STAGE(PG8_SB(1, 0), cB + kstep, voffB); PG8_STAGE(PG8_SA(1, 0), cA + kstep, voffA); PG8_STAGE(PG8_SB(1, 1), cB + hstep + kstep, voffB);
        PG8_WAIT_V(6); PG8_BAR;
    } else {
        PG8_STAGE(PG8_SB(0, 0), cB, voffB); PG8_STAGE(PG8_SA(0, 0), cA, voffA); PG8_STAGE(PG8_SB(0, 1), cB + hstep, voffB); PG8_STAGE(PG8_SA(0, 1), cA + hstep, voffA);
        if (wr == 1) PG8_BAR;
        PG8_WAIT_V(4); PG8_BAR;
        PG8_STAGE(PG8_SB(1, 0), cB + kstep, voffB); PG8_STAGE(PG8_SA(1, 0), cA + kstep, voffA); PG8_STAGE(PG8_SB(1, 1), cB + hstep + kstep, voffB);
        PG8_WAIT_V(6); PG8_BAR;
    }
    for (;;) {
        const bool has_next = S.next(ui + 1, nxt);
        const char* nA = has_next ? (const char*)g.A + (size_t)nxt.pm * tstep + (size_t)nxt.pk * 2 : cA; const char* nB = has_next ? (const char*)g.Bt + (size_t)nxt.pn * tstep + (size_t)nxt.pk * 2 : cB;
        for (int t = 0; t < nt; t += 2) {
            const bool last = (t == nt - 2);
            const char* a1 = cA + (size_t)(t + 1) * kstep;
            const char* a2 = last ? nA : cA + (size_t)(t + 2) * kstep; const char* b2 = last ? nB : cB + (size_t)(t + 2) * kstep;
            const char* a3 = a2 + kstep; const char* b3 = b2 + kstep;
            if (last && has_next) S.a_ready(nxt);
            if constexpr (Epi::KHOOK) E.khook(acc, cur, t, wr, wc, fr, fq);
            if constexpr (SP2) {
            PG8_LDB(B0, 0, 0); PG8_LDB(B1, 0, 1); PG8_SCHED; PG8_LDA(At, 0, 0); PG8_STAGE(PG8_SA(1, 1), a1 + hstep, voffA);
            PG8_WAIT_V(8); PG8_WAIT_L(0); PG8_BAR; PG8_MMA(0, 0, At, B0); PG8_MMA(0, 1, At, B1); PG8_BAR; PG8_SCHED;
            PG8_LDA(At, 0, 1); PG8_STAGE(PG8_SB(0, 0), b2, voffB); PG8_STAGE(PG8_SB(0, 1), b2 + hstep, voffB); PG8_STAGE(PG8_SA(0, 0), a2, voffA);
            PG8_WAIT_V(8); PG8_WAIT_L(0); PG8_BAR; PG8_MMA(1, 0, At, B0); PG8_MMA(1, 1, At, B1); PG8_BAR; PG8_SCHED;
            PG8_LDB(B0, 1, 0); PG8_LDB(B1, 1, 1); PG8_SCHED; PG8_LDA(At, 1, 0); PG8_STAGE(PG8_SA(0, 1), a2 + hstep, voffA);
            PG8_WAIT_V(8); PG8_WAIT_L(0); PG8_BAR; PG8_MMA(0, 0, At, B0); PG8_MMA(0, 1, At, B1); PG8_BAR; PG8_SCHED;
            PG8_LDA(At, 1, 1); PG8_STAGE(PG8_SB(1, 0), b3, voffB); PG8_STAGE(PG8_SB(1, 1), b3 + hstep, voffB); PG8_STAGE(PG8_SA(1, 0), a3, voffA);
            PG8_WAIT_V(8); PG8_WAIT_L(0); PG8_BAR; PG8_MMA(1, 0, At, B0); PG8_MMA(1, 1, At, B1); PG8_BAR; PG8_SCHED;
            } else {
            PG8_LDB(B0, 0, 0); PG8_SCHED; PG8_LDA(At, 0, 0); PG8_STAGE(PG8_SA(1, 1), a1 + hstep, voffA);
            PG8_WAIT_L(8); PG8_BAR; PG8_WAIT_L(0); PG8_MMA(0, 0, At, B0); PG8_BAR; PG8_SCHED;
            PG8_LDB(B1, 0, 1); PG8_STAGE(PG8_SB(0, 0), b2, voffB);
            PG8_BAR; PG8_WAIT_L(0); PG8_MMA(0, 1, At, B1); PG8_BAR;
            PG8_LDA(At, 0, 1); PG8_STAGE(PG8_SA(0, 0), a2, voffA);
            PG8_BAR; PG8_WAIT_L(0); PG8_MMA(1, 0, At, B0); PG8_BAR; PG8_SCHED;
            PG8_STAGE(PG8_SB(0, 1), b2 + hstep, voffB);
            PG8_WAIT_V(6); PG8_BAR; PG8_MMA(1, 1, At, B1); PG8_BAR;
            PG8_LDB(B0, 1, 0); PG8_SCHED; PG8_LDA(At, 1, 0); PG8_STAGE(PG8_SA(0, 1), a2 + hstep, voffA);
            PG8_WAIT_L(8); PG8_BAR; PG8_WAIT_L(0); PG8_MMA(0, 0, At, B0); PG8_BAR; PG8_SCHED;
            PG8_LDB(B1, 1, 1); PG8_STAGE(PG8_SB(1, 0), b3, voffB);
            PG8_BAR; PG8_WAIT_L(0); PG8_MMA(0, 1, At, B1); PG8_BAR;
            PG8_LDA(At, 1, 1); PG8_STAGE(PG8_SA(1, 0), a3, voffA);
            PG8_BAR; PG8_WAIT_L(0); PG8_MMA(1, 0, At, B0); PG8_BAR; PG8_SCHED;
            PG8_STAGE(PG8_SB(1, 1), b3 + hstep, voffB);
            PG8_WAIT_V(6); PG8_BAR; PG8_MMA(1, 1, At, B1); PG8_BAR;
            }
        }
        if constexpr (ALIGN_EPI) { if (wr == 0) PG8_BAR; }
        if constexpr (!Epi::AFTER_DRAIN) { E(acc, cur, wr, wc, fr, fq); S.done(cur); }
        if (!has_next) break;
#pragma unroll
        for (int a = 0; a < 2; ++a)
#pragma unroll
            for (int b = 0; b < 2; ++b)
#pragma unroll
                for (int m = 0; m < 4; ++m)
#pragma unroll
                    for (int n = 0; n < 2; ++n) acc[a][b][m][n] = (f32x4){0.f, 0.f, 0.f, 0.f};
        cur = nxt; cA = nA; cB = nB; ++ui;
        if constexpr (ALIGN_EPI) { if (wr == 1) PG8_BAR; }
    }
    PG8_WAIT_V(0);
    if constexpr (!ALIGN_EPI) { if (wr == 0) PG8_BAR; }
    PG8_BAR;
    if constexpr (Epi::AFTER_DRAIN) { E.fused(acc, cur, wr, wc, fr, fq, lds, wid, lane); S.done(cur); }
#undef PG8_SA
#undef PG8_SB
#undef PG8_STAGE
#undef PG8_LDA
#undef PG8_LDB
#undef PG8_MMA
#undef PG8_WAIT_V
#undef PG8_WAIT_L
#undef PG8_BAR
#undef PG8_SCHED
}
}
#define GAS __attribute__((address_space(1)))
#define LAS __attribute__((address_space(3)))
typedef GAS unsigned gu32;
typedef GAS unsigned long long gu64;
#define RLX_AGENT __ATOMIC_RELAXED, __HIP_MEMORY_SCOPE_AGENT
#define XB_TMO      128
#define XB_XCNT(j)  (256  + 64 * (j))
#define XB_XSUB(j)  (1280 + 64 * (j))
#define XB_XGEN(j)  (2304 + 64 * (j))
#define XB_TOP      3328
#define XB_TOPGEN   3392
#define XCD_BAR_WORDS 3456
#define XB_SPIN_CAP (1u << 18)

__device__ __forceinline__ unsigned xb_ld(unsigned* p)              { return __hip_atomic_load(p, __ATOMIC_RELAXED, __HIP_MEMORY_SCOPE_AGENT); }
__device__ __forceinline__ unsigned xb_add(unsigned* p, unsigned v) { return __hip_atomic_fetch_add(p, v, __ATOMIC_RELAXED, __HIP_MEMORY_SCOPE_AGENT); }
__device__ __forceinline__ unsigned xb_xcc_id() { return (unsigned)__builtin_amdgcn_s_getreg((3 << 11) | 20) & 0xFu; }
#define XB_SPIN(cond, bar) do { unsigned _sp = 0; while (cond) { __builtin_amdgcn_s_sleep(1); \
    if ((++_sp & 255u) == 0u) { if (xb_ld(&(bar)[XB_TMO])) break; if (_sp > XB_SPIN_CAP) { atomicAdd(&(bar)[XB_TMO], 1u); break; } } } } while (0)

struct XcdBarrier {
    unsigned* bar; unsigned x;
    volatile LAS unsigned* st;
};

__device__ __forceinline__ XcdBarrier xcd_barrier_post(unsigned* bar, volatile LAS unsigned* st) {
    XcdBarrier b; b.bar = bar; b.x = xb_xcc_id(); b.st = st;
    if (threadIdx.x == 0) (void)xb_add(&bar[XB_XCNT(b.x)], 1u);
    return b;
}
__device__ __forceinline__ void xcd_barrier_complete(unsigned* bar, unsigned x, unsigned& nloc, unsigned& nx) {
    const unsigned G = gridDim.x * gridDim.y * gridDim.z;
    unsigned sum, cnt, mine, sp = 0u;
    for (;;) {
        sum = 0u; cnt = 0u; mine = 0u;
#pragma unroll
        for (unsigned j = 0; j < 16; ++j) { const unsigned c = xb_ld(&bar[XB_XCNT(j)]); sum += c; cnt += (c > 0u) ? 1u : 0u; mine = (j == x) ? c : mine; }
        if (sum == G) break;
        __builtin_amdgcn_s_sleep(1);
        if ((++sp & 255u) == 0u) { if (xb_ld(&bar[XB_TMO])) break; if (sp > XB_SPIN_CAP) { atomicAdd(&bar[XB_TMO], 1u); break; } }
    }
    nloc = mine > 0u ? mine : 1u; nx = cnt > 0u ? cnt : 1u;
}

__device__ __forceinline__ void xcd_barrier(const XcdBarrier& b) {
    asm volatile("s_waitcnt vmcnt(0)" ::: "memory");
    __syncthreads();
    if (threadIdx.x == 0) {
        unsigned* bar = b.bar;
        __builtin_amdgcn_s_waitcnt(0);
        unsigned nloc = b.st[0], nx = b.st[1];
        if (nloc == 0u) { xcd_barrier_complete(bar, b.x, nloc, nx); b.st[0] = nloc; b.st[1] = nx; }
        const unsigned old = xb_add(&bar[XB_XSUB(b.x)], 1u);
        const unsigned gen = old / nloc;
        if (old + 1u == (gen + 1u) * nloc) {
            __builtin_amdgcn_fence(__ATOMIC_RELEASE, "agent");
            asm volatile("s_waitcnt vmcnt(0)" ::: "memory");
            const unsigned og = xb_add(&bar[XB_TOP], 1u);
            const unsigned tg = og / nx;
            if (og + 1u == (tg + 1u) * nx) xb_add(&bar[XB_TOPGEN], 1u);
            else XB_SPIN(xb_ld(&bar[XB_TOPGEN]) == tg, bar);
            __builtin_amdgcn_fence(__ATOMIC_ACQUIRE, "agent");
            xb_add(&bar[XB_XGEN(b.x)], 1u);
            asm volatile("s_waitcnt vmcnt(0)" ::: "memory");
        } else {
            XB_SPIN(xb_ld(&bar[XB_XGEN(b.x)]) == gen, bar);
            __builtin_amdgcn_fence(__ATOMIC_ACQUIRE, "agent");
            asm volatile("s_waitcnt vmcnt(0)" ::: "memory");
        }
    }
    __syncthreads();
}

#define LDS_BARRIER() do { asm volatile("s_waitcnt lgkmcnt(0)" ::: "memory"); __builtin_amdgcn_s_barrier(); asm volatile("" ::: "memory"); } while (0)
typedef float vf4 __attribute__((ext_vector_type(4)));
typedef unsigned vu2 __attribute__((ext_vector_type(2)));
typedef unsigned vu4 __attribute__((ext_vector_type(4)));
__device__ __forceinline__ float wave_sum(float v) {
#pragma unroll
    for (int o = 1; o < 64; o <<= 1) v += __shfl_xor(v, o);
    return v;
}
template <int CTRL> __device__ __forceinline__ float dpp_f(float x) { return __builtin_bit_cast(float, __builtin_amdgcn_mov_dpp(__builtin_bit_cast(int, x), CTRL, 0xf, 0xf, true)); }
__device__ __forceinline__ float sum16(float x) { x += dpp_f<0xB1>(x); x += dpp_f<0x4E>(x); x += dpp_f<0x124>(x); x += dpp_f<0x128>(x); return x; }
__device__ __forceinline__ float sum8(float x) { x += dpp_f<0xB1>(x); x += dpp_f<0x4E>(x); x += dpp_f<0x141>(x); return x; }
__device__ __forceinline__ unsigned pk2(float lo, float hi) { return (unsigned)f2bf(lo) | ((unsigned)f2bf(hi) << 16); }

constexpr int NV4 = D_MODEL / 256;
__device__ __forceinline__ void row_load(const float* row, int lane, vf4 (&x)[NV4]) {
#pragma unroll
    for (int j = 0; j < NV4; ++j) x[j] = __builtin_nontemporal_load((const vf4*)(row + (size_t)(j * 64 + lane) * 4));
}
__device__ __forceinline__ void row_store(float* row, int lane, const vf4 (&x)[NV4]) {
#pragma unroll
    for (int j = 0; j < NV4; ++j) __builtin_nontemporal_store(x[j], (vf4*)(row + (size_t)(j * 64 + lane) * 4));
}
__device__ __forceinline__ float row_rs(const vf4 (&x)[NV4]) {
    float ss = 0.f;
#pragma unroll
    for (int j = 0; j < NV4; ++j) ss += (x[j].x * x[j].x + x[j].y * x[j].y) + (x[j].z * x[j].z + x[j].w * x[j].w);
    return 1.0f / sqrtf(wave_sum(ss) * (1.0f / D_MODEL) + EPS);
}
__device__ __forceinline__ void norm_h_wave(const Ptrs& p, int l, int r, int which, int lane, const vf4 (&x)[NV4]) {
    const float rs = row_rs(x);
    const float* g = (which ? p.g_pre2 : p.g_pre1) + (size_t)l * D_MODEL;
    const float* mod = p.MOD + ((size_t)l * (BATCH + 1) + mod_row(r)) * D6 + (which ? 3 * D_MODEL : 0);
#pragma unroll
    for (int j = 0; j < NV4; ++j) { const int c = (j * 64 + lane) * 4;
        const vf4 gv = *(const vf4*)(g + c), sh = *(const vf4*)(mod + c), sc = *(const vf4*)(mod + D_MODEL + c);
        const vf4 o = x[j] * rs * gv * (1.0f + sc) + sh;
        vu2 w; w.x = pk2(o.x, o.y); w.y = pk2(o.z, o.w);
        *(vu2*)(p.H + (size_t)r * D_MODEL + c) = w; }
}
__device__ __forceinline__ void resid_wave(const Ptrs& p, int l, int r, int which, int lane, vf4 (&x)[NV4], int ns) {
    vf4 y[NV4];
    if (r >= NLAT) {
#pragma unroll
        for (int j = 0; j < NV4; ++j) y[j] = (vf4){0.f, 0.f, 0.f, 0.f};
        for (int s = 0; s < ns; ++s) {
#pragma unroll
            for (int j = 0; j < NV4; ++j) y[j] += *(const vf4*)(p.SLAB + ((size_t)s * NCTX + (r - NLAT)) * D_MODEL + (size_t)(j * 64 + lane) * 4); }
    } else
#pragma unroll
    for (int j = 0; j < NV4; ++j) { const vu2 w = __builtin_nontemporal_load((const vu2*)(p.MIXb + (size_t)r * D_MODEL + (size_t)(j * 64 + lane) * 4)); y[j] = (vf4){__uint_as_float(w.x << 16), __uint_as_float(w.x & 0xffff0000u), __uint_as_float(w.y << 16), __uint_as_float(w.y & 0xffff0000u)}; }
    const float rs = row_rs(y);
    const float* g = (which ? p.g_post2 : p.g_post1) + (size_t)l * D_MODEL;
    const float* gate = p.MOD + ((size_t)l * (BATCH + 1) + mod_row(r)) * D6 + (which ? 5 * D_MODEL : 2 * D_MODEL);
#pragma unroll
    for (int j = 0; j < NV4; ++j) { const int c = (j * 64 + lane) * 4; x[j] += *(const vf4*)(gate + c) * (y[j] * rs * *(const vf4*)(g + c)); }
}

struct WtDesc { const float* W; bf16* WT; int K, N, k0, n0, drow0; };
__device__ __forceinline__ void transpose_load(const WtDesc& d, int lane, float (&wv)[32]) {
#pragma unroll
    for (int i = 0; i < 32; ++i) wv[i] = __builtin_nontemporal_load(d.W + (size_t)(d.k0 + 2 * i + (lane >> 5)) * d.N + d.n0 + (lane & 31));
}
__device__ __forceinline__ void transpose_finish(const WtDesc& d, const float (&wv)[32], LAS float* scr, int lane) {
#pragma unroll
    for (int i = 0; i < 32; ++i) scr[(2 * i + (lane >> 5)) * 33 + (lane & 31)] = wv[i];
    asm volatile("s_waitcnt lgkmcnt(0)" ::: "memory");
    const int c = lane & 7;
#pragma unroll
    for (int j = 0; j < 4; ++j) { const int n = (lane >> 3) + 8 * j; const LAS float* s = scr + (8 * c) * 33 + n;
        vu4 o; o.x = pk2(s[0 * 33], s[1 * 33]); o.y = pk2(s[2 * 33], s[3 * 33]); o.z = pk2(s[4 * 33], s[5 * 33]); o.w = pk2(s[6 * 33], s[7 * 33]);
        __builtin_nontemporal_store(o, (vu4*)(d.WT + (size_t)(d.drow0 + n) * d.K + d.k0 + 8 * c)); }
    asm volatile("s_waitcnt lgkmcnt(0)" ::: "memory");
}
__device__ __forceinline__ void transpose_item(const float* W, int K, int N, bf16* WT, int k0, int n0, int drow0, LAS float* scr, int lane) {
    const WtDesc d{W, WT, K, N, k0, n0, drow0}; float wv[32];
    transpose_load(d, lane, wv); transpose_finish(d, wv, scr, lane);
}
__device__ __forceinline__ int inproj_dst_row0(int n0) {
    if (n0 < R_A) return n0;
    if (n0 == R_A) return NP_MAIN;
    if (n0 < R_DT) return n0 - 4 * GDN_H;
    if (n0 == R_DT) return NP_MAIN + PF_DT;
    return n0 - 4 * GDN_H - 2 * SSM_H;
}
__device__ __forceinline__ int up_dst_row0(int n0) {
    const int isg = n0 >= D_FF, j = isg ? n0 - D_FF : n0; return 256 * (j >> 7) + 128 * isg + (j & 127);
}
static_assert(D_FF % 128 == 0, "up-projection tile order");
static_assert(4 * GDN_H == 32 && 2 * SSM_H == 32 && R_A % 32 == 0 && R_DT % 32 == 0, "the 32-column transpose items assume the real shapes");

constexpr int TB = 32;
constexpr int GDN_BUF = TB * 256 + TB * 32 + TB * 2;
__device__ __forceinline__ void gdn_token_wg(const Ptrs& p, LAS float* L, int chain, int slice, int tid) {
    const int b = chain / (GDN_H * 2), h = (chain >> 1) % GDN_H, dir = chain & 1;
    const int lane = tid & 63, wave = tid >> 6, ks = lane & 15, cl = wave * 4 + (lane >> 4);
    LAS float* obuf = L + 2 * GDN_BUF;
    float S[8];
#pragma unroll
    for (int e = 0; e < 8; ++e) S[e] = 0.f;
    vf4 rq[4], rv; float ra = 0.f, rb = 0.f;
    constexpr int NB = CHAIN_LEN / TB;
    auto gload = [&](int n) {
#pragma unroll
        for (int j = 0; j < 4; ++j) { const int idx = j * 512 + tid, i = idx >> 6, c4 = idx & 63; const int r = chain_row(b, dir, n * TB + i);
            rq[j] = *(const vf4*)(p.GQKV + (size_t)r * (3 * MIX_W) + h * 128 + (c4 < 32 ? c4 * 4 : MIX_W + (c4 - 32) * 4)); }
        if (tid < 256) { const int i = tid >> 3, c4 = tid & 7; const int r = chain_row(b, dir, n * TB + i);
            rv = *(const vf4*)(p.GQKV + (size_t)r * (3 * MIX_W) + 2 * MIX_W + h * 128 + slice * 32 + c4 * 4); }
        if (tid < TB) { const int r = chain_row(b, dir, n * TB + tid); ra = __expf(p.GG[(size_t)r * 2 * GDN_H + dir * GDN_H + h]); rb = p.GB[(size_t)r * 2 * GDN_H + dir * GDN_H + h]; }
    };
    auto lstore = [&](LAS float* B) {
#pragma unroll
        for (int j = 0; j < 4; ++j) { const int idx = j * 512 + tid; *(LAS vf4*)(B + (idx >> 6) * 256 + (idx & 63) * 4) = rq[j]; }
        if (tid < 256) *(LAS vf4*)(B + TB * 256 + tid * 4) = rv;
        if (tid < TB) { B[TB * 256 + TB * 32 + tid * 2] = ra; B[TB * 256 + TB * 32 + tid * 2 + 1] = rb; }
    };
    gload(0); lstore(L); LDS_BARRIER();
    for (int n = 0; n < NB; ++n) {
        LAS float* B = L + (n & 1) * GDN_BUF; LAS float* ob = obuf + (n & 1) * (TB * 32);
        if (n + 1 < NB) gload(n + 1);
#pragma unroll 4
        for (int i = 0; i < TB; ++i) {
            const LAS float* kq = B + i * 256;
            const vf4 q0 = *(const LAS vf4*)(kq + ks * 8), q1 = *(const LAS vf4*)(kq + ks * 8 + 4), k0 = *(const LAS vf4*)(kq + 128 + ks * 8), k1 = *(const LAS vf4*)(kq + 128 + ks * 8 + 4);
            const float v = B[TB * 256 + i * 32 + cl], a = B[TB * 256 + TB * 32 + i * 2], be = B[TB * 256 + TB * 32 + i * 2 + 1];
            const float kk[8] = {k0.x, k0.y, k0.z, k0.w, k1.x, k1.y, k1.z, k1.w}, qq[8] = {q0.x, q0.y, q0.z, q0.w, q1.x, q1.y, q1.z, q1.w};
            float rr = 0.f;
#pragma unroll
            for (int e = 0; e < 8; ++e) { S[e] *= a; rr += kk[e] * S[e]; }
            rr = sum16(rr);
            const float dl = be * (v - rr); float o = 0.f;
#pragma unroll
            for (int e = 0; e < 8; ++e) { S[e] += kk[e] * dl; o += qq[e] * S[e]; }
            o = sum16(o);
            if (ks == 0) ob[i * 32 + cl] = o;
        }
        if (n + 1 < NB) lstore(L + ((n + 1) & 1) * GDN_BUF);
        LDS_BARRIER();
        if (tid < 256) { const int i = tid >> 3, c4 = tid & 7; const int r = chain_row(b, dir, n * TB + i);
            *(vf4*)(p.OG + ((size_t)dir * MROWS + r) * MIX_W + h * 128 + slice * 32 + c4 * 4) = *(const LAS vf4*)(ob + i * 32 + c4 * 4); }
    }
}
constexpr int SSD_BUF = TB * 256 + TB * 64 + TB * 2;
__device__ __forceinline__ void ssd_token_wg(const Ptrs& p, LAS float* L, int chain, int tid) {
    const int b = chain / (SSM_H * 2), hd = (chain >> 1) % SSM_H, dir = chain & 1, g = hd / SSM_HPG;
    const int lane = tid & 63, wave = tid >> 6, ss = lane & 7, pc = wave * 8 + (lane >> 3);
    LAS float* obuf = L + 2 * SSD_BUF;
    float hs[16];
#pragma unroll
    for (int e = 0; e < 16; ++e) hs[e] = 0.f;
    vf4 rbc[4], rx; float rdt = 0.f, rea = 0.f;
    constexpr int NB = CHAIN_LEN / TB;
    auto gload = [&](int n) {
#pragma unroll
        for (int j = 0; j < 4; ++j) { const int idx = j * 512 + tid, i = idx >> 6, c4 = idx & 63; const int r = chain_row(b, dir, n * TB + i);
            rbc[j] = *(const vf4*)(p.SXBC + (size_t)r * SSM_XBC + MIX_W + (c4 < 32 ? g * SSM_N + c4 * 4 : SSM_BC + g * SSM_N + (c4 - 32) * 4)); }
        { const int i = tid >> 4, c4 = tid & 15; const int r = chain_row(b, dir, n * TB + i); rx = *(const vf4*)(p.SXBC + (size_t)r * SSM_XBC + hd * SSM_P + c4 * 4); }
        if (tid < TB) { const int r = chain_row(b, dir, n * TB + tid); rdt = p.SDT[(size_t)r * 2 * SSM_H + dir * SSM_H + hd]; rea = __expf(p.SA[(size_t)r * 2 * SSM_H + dir * SSM_H + hd]); }
    };
    auto lstore = [&](LAS float* B) {
#pragma unroll
        for (int j = 0; j < 4; ++j) { const int idx = j * 512 + tid; *(LAS vf4*)(B + (idx >> 6) * 256 + (idx & 63) * 4) = rbc[j]; }
        *(LAS vf4*)(B + TB * 256 + tid * 4) = rx;
        if (tid < TB) { B[TB * 256 + TB * 64 + tid * 2] = rdt; B[TB * 256 + TB * 64 + tid * 2 + 1] = rea; }
    };
    gload(0); lstore(L); LDS_BARRIER();
    for (int n = 0; n < NB; ++n) {
        LAS float* B = L + (n & 1) * SSD_BUF; LAS float* ob = obuf + (n & 1) * (TB * 64);
        if (n + 1 < NB) gload(n + 1);
#pragma unroll 2
        for (int i = 0; i < TB; ++i) {
            const LAS float* bc = B + i * 256;
            const float xd = B[TB * 256 + i * 64 + pc] * B[TB * 256 + TB * 64 + i * 2], ea = B[TB * 256 + TB * 64 + i * 2 + 1];
            float y = 0.f;
#pragma unroll
            for (int q = 0; q < 4; ++q) { const vf4 bv = *(const LAS vf4*)(bc + ss * 16 + q * 4), cv = *(const LAS vf4*)(bc + 128 + ss * 16 + q * 4);
                hs[4 * q + 0] = ea * hs[4 * q + 0] + xd * bv.x; y += cv.x * hs[4 * q + 0];
                hs[4 * q + 1] = ea * hs[4 * q + 1] + xd * bv.y; y += cv.y * hs[4 * q + 1];
                hs[4 * q + 2] = ea * hs[4 * q + 2] + xd * bv.z; y += cv.z * hs[4 * q + 2];
                hs[4 * q + 3] = ea * hs[4 * q + 3] + xd * bv.w; y += cv.w * hs[4 * q + 3]; }
            y = sum8(y);
            if (ss == 0) ob[i * 64 + pc] = y;
        }
        if (n + 1 < NB) lstore(L + ((n + 1) & 1) * SSD_BUF);
        LDS_BARRIER();
        { const int i = tid >> 4, c4 = tid & 15; const int r = chain_row(b, dir, n * TB + i);
            *(vf4*)(p.OS + ((size_t)dir * MROWS + r) * MIX_W + hd * SSM_P + c4 * 4) = *(const LAS vf4*)(ob + i * 64 + c4 * 4); }
    }
}

constexpr int YLD = 3 * MIX_W;
typedef float f32x2_t __attribute__((ext_vector_type(2)));
typedef __bf16 bf16x2_t __attribute__((ext_vector_type(2)));
typedef short bf16x8_t __attribute__((ext_vector_type(8)));
typedef float f32x16_t __attribute__((ext_vector_type(16)));
__device__ __forceinline__ unsigned cvtpk(float lo, float hi) { f32x2_t v = {lo, hi}; bf16x2_t b = __builtin_convertvector(v, bf16x2_t); return __builtin_bit_cast(unsigned, b); }
__device__ __forceinline__ float bflo(unsigned w) { return __uint_as_float(w << 16); }
__device__ __forceinline__ float bfhi(unsigned w) { return __uint_as_float(w & 0xffff0000u); }
__device__ __forceinline__ void unpack8(const vu4 w, float (&f)[8]) { f[0] = bflo(w.x); f[1] = bfhi(w.x); f[2] = bflo(w.y); f[3] = bfhi(w.y); f[4] = bflo(w.z); f[5] = bfhi(w.z); f[6] = bflo(w.w); f[7] = bfhi(w.w); }
__device__ __forceinline__ float silu_fast(float x) { return x * __builtin_amdgcn_rcpf(1.0f + __expf(-x)); }

__device__ __forceinline__ void conv8(const bf16* Prow, bool hp, bool hn, int col, const float* w, int wld, int jc, float (&y)[8]) {
    float xc[8], xp[8], xn[8];
    unpack8(*(const vu4*)(Prow + col), xc);
    if (hp) unpack8(*(const vu4*)(Prow - NP_MAIN + col), xp);
    if (hn) unpack8(*(const vu4*)(Prow + NP_MAIN + col), xn);
    const vf4 w0a = *(const vf4*)(w + jc), w0b = *(const vf4*)(w + jc + 4), w1a = *(const vf4*)(w + wld + jc), w1b = *(const vf4*)(w + wld + jc + 4), w2a = *(const vf4*)(w + 2 * wld + jc), w2b = *(const vf4*)(w + 2 * wld + jc + 4);
    const float w0[8] = {w0a.x, w0a.y, w0a.z, w0a.w, w0b.x, w0b.y, w0b.z, w0b.w}, w1[8] = {w1a.x, w1a.y, w1a.z, w1a.w, w1b.x, w1b.y, w1b.z, w1b.w}, w2[8] = {w2a.x, w2a.y, w2a.z, w2a.w, w2b.x, w2b.y, w2b.z, w2b.w};
#pragma unroll
    for (int e = 0; e < 8; ++e) { float v = w1[e] * xc[e]; if (hp) v += w0[e] * xp[e]; if (hn) v += w2[e] * xn[e]; y[e] = v; }
}
constexpr float ATT_QSCALE = 0.08838834764831845f * 1.4426950408889634f;
__device__ __forceinline__ void prep_row_wave(const Ptrs& p, int l, int r, int lane) {
    int b, t, len; bool ic; row_info(r, b, t, len, ic);
    const bool hp = t > 0, hn = t < len - 1;
    const bf16* Pr = p.P + (size_t)r * NP_MAIN;
    { const float* w = p.gdn_conv_w + (size_t)l * 3 * (3 * MIX_W);
#pragma unroll 3
        for (int ps = 0; ps < (3 * MIX_W) / 512; ++ps) { const int col = ps * 512 + lane * 8, grp = col >> 7; float y[8]; conv8(Pr, hp, hn, C_QKV + col, w, 3 * MIX_W, col, y);
            float ss = 0.f;
#pragma unroll
            for (int e = 0; e < 8; ++e) { y[e] = silu_fast(y[e]); ss += y[e] * y[e]; }
            ss = sum16(ss);
            float sc = 1.0f; if (grp < 2 * GDN_H) { sc = 1.0f / sqrtf(ss + EPS); if (grp < GDN_H) sc *= 0.08838834764831845f; }
            *(vu4*)(p.GQKVb + (size_t)r * (3 * MIX_W) + col) = (vu4){cvtpk(y[0] * sc, y[1] * sc), cvtpk(y[2] * sc, y[3] * sc), cvtpk(y[4] * sc, y[5] * sc), cvtpk(y[6] * sc, y[7] * sc)}; } }
    { const float* w = p.ssm_conv_w + (size_t)l * 3 * SSM_XBC; const float* cb = p.ssm_conv_b + (size_t)l * SSM_XBC;
#pragma unroll 3
        for (int ps = 0; ps < SSM_XBC / 512; ++ps) { const int col = ps * 512 + lane * 8; float y[8]; conv8(Pr, hp, hn, C_XBC + col, w, SSM_XBC, col, y);
            const vf4 ba = *(const vf4*)(cb + col), bb = *(const vf4*)(cb + col + 4); const float bs[8] = {ba.x, ba.y, ba.z, ba.w, bb.x, bb.y, bb.z, bb.w};
#pragma unroll
            for (int e = 0; e < 8; ++e) y[e] = silu_fast(y[e] + bs[e]);
            const vu4 w8 = {cvtpk(y[0], y[1]), cvtpk(y[2], y[3]), cvtpk(y[4], y[5]), cvtpk(y[6], y[7])};
            if (col >= MIX_W) *(vu4*)(p.SBCb + (size_t)r * (2 * SSM_BC) + col - MIX_W) = w8; else *(vu4*)(p.SXb + (size_t)r * MIX_W + col) = w8; } }
    if (lane < 2 * GDN_H) prep_gdn_gb_item(p, l, r, lane);
    if (lane < 2 * SSM_H) prep_ssd_dt_item(p, l, r, lane);
    { const int l16 = lane & 15, ax = l16 >> 3, i0 = (l16 & 7) * 4; const int pos = ic ? 0 : (ax ? t % GRID_W : t / GRID_W);
        const vf4 t0 = *(const vf4*)(p.ROPE + (size_t)(pos * 32 + i0) * 2), t1 = *(const vf4*)(p.ROPE + (size_t)(pos * 32 + i0) * 2 + 4);
        const float cs[4] = {t0.x, t0.z, t1.x, t1.z}, sn[4] = {t0.y, t0.w, t1.y, t1.w};
#pragma unroll 3
        for (int ps = 0; ps < 3; ++ps) { const int hh = ps * 4 + (lane >> 4);
            if (hh < ATT_HQ + ATT_HKV) { const bool isq = hh < ATT_HQ; const int h = isq ? hh : hh - ATT_HQ;
                const bf16* src = Pr + (isq ? C_AQ : C_AKV) + h * 128 + ax * 64 + i0;
                const vu2 a = *(const vu2*)src, c = *(const vu2*)(src + 32);
                const float x1[4] = {bflo(a.x), bfhi(a.x), bflo(a.y), bfhi(a.y)}, x2[4] = {bflo(c.x), bfhi(c.x), bflo(c.y), bfhi(c.y)};
                float o1[4], o2[4]; const float sc = isq ? ATT_QSCALE : 1.0f;
#pragma unroll
                for (int e = 0; e < 4; ++e) { o1[e] = (x1[e] * cs[e] - x2[e] * sn[e]) * sc; o2[e] = (x2[e] * cs[e] + x1[e] * sn[e]) * sc; }
                bf16* dst = (isq ? p.AQb + (size_t)r * MIX_W : p.AKb + (size_t)r * (ATT_HKV * 128)) + h * 128 + ax * 64 + i0;
                vu2 w1; w1.x = cvtpk(o1[0], o1[1]); w1.y = cvtpk(o1[2], o1[3]); vu2 w2; w2.x = cvtpk(o2[0], o2[1]); w2.y = cvtpk(o2[2], o2[3]);
                *(vu2*)dst = w1; *(vu2*)(dst + 32) = w2; } } }
}
constexpr int PREP_RB = 17, PREP_QP = (3 * MIX_W) / 512, PREP_NPASS = PREP_QP + SSM_XBC / 512;
static_assert(MROWS % PREP_RB == 0 && (3 * MIX_W) % 512 == 0 && SSM_XBC % 512 == 0 && MIX_W % 512 == 0 && PREP_NPASS <= PREP_RB && 2 * PREP_NPASS >= PREP_RB, "prep tiling");
__device__ __forceinline__ void prep_row_scalars_wave(const Ptrs& p, int l, int r, int lane);
__device__ __forceinline__ void prep_conv_block_wave(const Ptrs& p, int l, int blk, int ps, int lane) {
    const int r0 = blk * PREP_RB; const bool isx = ps >= PREP_QP;
    const int col = (isx ? ps - PREP_QP : ps) * 512 + lane * 8, wld = isx ? SSM_XBC : 3 * MIX_W, grp = col >> 7;
    const float* w = (isx ? p.ssm_conv_w + (size_t)l * 3 * SSM_XBC : p.gdn_conv_w + (size_t)l * 3 * (3 * MIX_W)) + col;
    const vf4 w0a = *(const vf4*)w, w0b = *(const vf4*)(w + 4), w1a = *(const vf4*)(w + wld), w1b = *(const vf4*)(w + wld + 4), w2a = *(const vf4*)(w + 2 * wld), w2b = *(const vf4*)(w + 2 * wld + 4);
    const float w0[8] = {w0a.x, w0a.y, w0a.z, w0a.w, w0b.x, w0b.y, w0b.z, w0b.w}, w1[8] = {w1a.x, w1a.y, w1a.z, w1a.w, w1b.x, w1b.y, w1b.z, w1b.w}, w2[8] = {w2a.x, w2a.y, w2a.z, w2a.w, w2b.x, w2b.y, w2b.z, w2b.w};
    float bs[8] = {0.f, 0.f, 0.f, 0.f, 0.f, 0.f, 0.f, 0.f};
    if (isx) { const float* cb = p.ssm_conv_b + (size_t)l * SSM_XBC + col; const vf4 ba = *(const vf4*)cb, bb = *(const vf4*)(cb + 4); bs[0] = ba.x; bs[1] = ba.y; bs[2] = ba.z; bs[3] = ba.w; bs[4] = bb.x; bs[5] = bb.y; bs[6] = bb.z; bs[7] = bb.w; }
    const bf16* src = p.P + (size_t)r0 * NP_MAIN + (isx ? C_XBC : C_QKV) + col;
    vu4 rows[PREP_RB + 2];
#pragma unroll
    for (int j = 0; j < PREP_RB + 2; ++j) { const int r = r0 - 1 + j; rows[j] = (r >= 0 && r < MROWS) ? __builtin_nontemporal_load((const vu4*)(src + ((ptrdiff_t)j - 1) * NP_MAIN)) : (vu4){0u, 0u, 0u, 0u}; }
    prep_row_scalars_wave(p, l, r0 + ps, lane);
    if (ps + PREP_NPASS < PREP_RB) prep_row_scalars_wave(p, l, r0 + ps + PREP_NPASS, lane);
    float xp[8], xc[8], xn[8];
    unpack8(rows[0], xp); unpack8(rows[1], xc);
#pragma unroll
    for (int i = 0; i < PREP_RB; ++i) { const int r = r0 + i; int b, t, len; bool ic; row_info(r, b, t, len, ic); const bool hp = t > 0, hn = t < len - 1;
        unpack8(rows[i + 2], xn);
        float y[8];
#pragma unroll
        for (int e = 0; e < 8; ++e) { float v = w1[e] * xc[e] + bs[e]; if (hp) v += w0[e] * xp[e]; if (hn) v += w2[e] * xn[e]; y[e] = silu_fast(v); }
        if (isx) { const vu4 w8 = {cvtpk(y[0], y[1]), cvtpk(y[2], y[3]), cvtpk(y[4], y[5]), cvtpk(y[6], y[7])};
            if (col >= MIX_W) *(vu4*)(p.SBCb + (size_t)r * (2 * SSM_BC) + col - MIX_W) = w8; else *(vu4*)(p.SXb + (size_t)r * MIX_W + col) = w8; }
        else { float ss = 0.f;
#pragma unroll
            for (int e = 0; e < 8; ++e) ss += y[e] * y[e];
            ss = sum16(ss);
            float sc = 1.0f; if (grp < 2 * GDN_H) { sc = 1.0f / sqrtf(ss + EPS); if (grp < GDN_H) sc *= 0.08838834764831845f; }
            *(vu4*)(p.GQKVb + (size_t)r * (3 * MIX_W) + col) = (vu4){cvtpk(y[0] * sc, y[1] * sc), cvtpk(y[2] * sc, y[3] * sc), cvtpk(y[4] * sc, y[5] * sc), cvtpk(y[6] * sc, y[7] * sc)}; }
#pragma unroll
        for (int e = 0; e < 8; ++e) { xp[e] = xc[e]; xc[e] = xn[e]; } }
}
__device__ __forceinline__ void prep_row_scalars_wave(const Ptrs& p, int l, int r, int lane) {
    int b, t, len; bool ic; row_info(r, b, t, len, ic);
    const bf16* Pr = p.P + (size_t)r * NP_MAIN;
    if (lane < 2 * GDN_H) prep_gdn_gb_item(p, l, r, lane);
    if (lane < 2 * SSM_H) prep_ssd_dt_item(p, l, r, lane);
    { const int l16 = lane & 15, ax = l16 >> 3, i0 = (l16 & 7) * 4; const int pos = ic ? 0 : (ax ? t % GRID_W : t / GRID_W);
        const vf4 t0 = *(const vf4*)(p.ROPE + (size_t)(pos * 32 + i0) * 2), t1 = *(const vf4*)(p.ROPE + (size_t)(pos * 32 + i0) * 2 + 4);
        const float cs[4] = {t0.x, t0.z, t1.x, t1.z}, sn[4] = {t0.y, t0.w, t1.y, t1.w};
#pragma unroll 3
        for (int ps = 0; ps < 3; ++ps) { const int hh = ps * 4 + (lane >> 4);
            if (hh < ATT_HQ + ATT_HKV) { const bool isq = hh < ATT_HQ; const int h = isq ? hh : hh - ATT_HQ;
                const bf16* src = Pr + (isq ? C_AQ : C_AKV) + h * 128 + ax * 64 + i0;
                const vu2 a = *(const vu2*)src, c = *(const vu2*)(src + 32);
                const float x1[4] = {bflo(a.x), bfhi(a.x), bflo(a.y), bfhi(a.y)}, x2[4] = {bflo(c.x), bfhi(c.x), bflo(c.y), bfhi(c.y)};
                float o1[4], o2[4]; const float sc = isq ? ATT_QSCALE : 1.0f;
#pragma unroll
                for (int e = 0; e < 4; ++e) { o1[e] = (x1[e] * cs[e] - x2[e] * sn[e]) * sc; o2[e] = (x2[e] * cs[e] + x1[e] * sn[e]) * sc; }
                bf16* dst = (isq ? p.AQb + (size_t)r * MIX_W : p.AKb + (size_t)r * (ATT_HKV * 128)) + h * 128 + ax * 64 + i0;
                vu2 w1; w1.x = cvtpk(o1[0], o1[1]); w1.y = cvtpk(o1[2], o1[3]); vu2 w2; w2.x = cvtpk(o2[0], o2[1]); w2.y = cvtpk(o2[2], o2[3]);
                *(vu2*)dst = w1; *(vu2*)(dst + 32) = w2; } } }
}
__device__ __forceinline__ void mixout_row_wave(const Ptrs& p, int l, int r, int lane) {
    const int c0 = lane * 16;
    {
        float o[16]; float ss = 0.f;
#pragma unroll
        for (int q = 0; q < 2; ++q) { float a8[8], b8[8]; unpack8(__builtin_nontemporal_load((const vu4*)(p.OGb + (size_t)r * MIX_W + c0 + 8 * q)), a8); unpack8(__builtin_nontemporal_load((const vu4*)(p.OGb + ((size_t)MROWS + r) * MIX_W + c0 + 8 * q)), b8);
#pragma unroll
            for (int e = 0; e < 8; ++e) o[8 * q + e] = a8[e] + b8[e]; }
#pragma unroll
        for (int e = 0; e < 16; ++e) ss += o[e] * o[e];
        ss = sum8(ss);
        const float rs = 1.0f / sqrtf(ss * (1.0f / 128.0f) + EPS);
        float gt[16]; { float t8[8]; unpack8(*(const vu4*)(p.P + (size_t)r * NP_MAIN + C_GATE + c0), t8);
#pragma unroll
            for (int e = 0; e < 8; ++e) gt[e] = t8[e];
            unpack8(*(const vu4*)(p.P + (size_t)r * NP_MAIN + C_GATE + c0 + 8), t8);
#pragma unroll
            for (int e = 0; e < 8; ++e) gt[8 + e] = t8[e]; }
        const float* nw = p.gdn_norm + (size_t)l * 128 + (c0 & 127);
        unsigned w[8];
#pragma unroll
        for (int e = 0; e < 8; ++e) w[e] = cvtpk(o[2 * e] * rs * nw[2 * e] * silu_fast(gt[2 * e]), o[2 * e + 1] * rs * nw[2 * e + 1] * silu_fast(gt[2 * e + 1]));
        *(vu4*)(p.YA + (size_t)r * YLD + c0) = (vu4){w[0], w[1], w[2], w[3]}; *(vu4*)(p.YA + (size_t)r * YLD + c0 + 8) = (vu4){w[4], w[5], w[6], w[7]};
    }
    {
        float y[16]; float ss = 0.f; const float dsk = p.ssm_d[(size_t)l * SSM_H + c0 / SSM_P];
        float zt[16]; { float t8[8]; unpack8(*(const vu4*)(p.P + (size_t)r * NP_MAIN + C_Z + c0), t8);
#pragma unroll
            for (int e = 0; e < 8; ++e) zt[e] = t8[e];
            unpack8(*(const vu4*)(p.P + (size_t)r * NP_MAIN + C_Z + c0 + 8), t8);
#pragma unroll
            for (int e = 0; e < 8; ++e) zt[8 + e] = t8[e]; }
#pragma unroll
        for (int q = 0; q < 2; ++q) { float a8[8], c8[8], d8[8], x8[8]; unpack8(__builtin_nontemporal_load((const vu4*)(p.OSb + (size_t)r * MIX_W + c0 + 8 * q)), a8);
            unpack8(__builtin_nontemporal_load((const vu4*)(p.OSb2 + (size_t)r * MIX_W + c0 + 8 * q)), c8); unpack8(__builtin_nontemporal_load((const vu4*)(p.OSb2 + ((size_t)MROWS + r) * MIX_W + c0 + 8 * q)), d8); unpack8(*(const vu4*)(p.SXb + (size_t)r * MIX_W + c0 + 8 * q), x8);
#pragma unroll
            for (int e = 0; e < 8; ++e) y[8 * q + e] = a8[e] + (c8[e] + d8[e]) + dsk * x8[e]; }
#pragma unroll
        for (int e = 0; e < 16; ++e) { y[e] *= silu_fast(zt[e]); ss += y[e] * y[e]; }
        ss = sum16(ss); ss += __shfl_xor(ss, 16);
        const float rs = 1.0f / sqrtf(ss * (1.0f / (float)(MIX_W / SSM_G)) + EPS);
        const float* nw = p.ssm_norm + (size_t)l * MIX_W + c0;
        unsigned w[8];
#pragma unroll
        for (int e = 0; e < 8; ++e) w[e] = cvtpk(y[2 * e] * rs * nw[2 * e], y[2 * e + 1] * rs * nw[2 * e + 1]);
        *(vu4*)(p.YB + (size_t)r * YLD + c0) = (vu4){w[0], w[1], w[2], w[3]}; *(vu4*)(p.YB + (size_t)r * YLD + c0 + 8) = (vu4){w[4], w[5], w[6], w[7]};
    }
}
static_assert(MIX_W == 1024 && SSM_P == 64 && MIX_W / SSM_G == 512, "mixout_row_wave lane mapping assumes the real shapes");
__device__ __forceinline__ void act_vec_item(const Ptrs& p, int l, int r, int j) {
    int b, t, len; bool ic; row_info(r, b, t, len, ic);
    const bf16* ug = p.UG + (size_t)r * (2 * D_FF);
    float u[8], g[8], gp[8], gn[8];
    unpack8(*(const vu4*)(ug + j), u); unpack8(*(const vu4*)(ug + D_FF + j), g);
    const bool hp = t > 0, hn = t < len - 1;
    if (hp) unpack8(*(const vu4*)(ug - 2 * D_FF + D_FF + j), gp);
    if (hn) unpack8(*(const vu4*)(ug + 2 * D_FF + D_FF + j), gn);
    const float* w = p.ffn_conv_w + (size_t)l * 3 * D_FF + j; const float* cb = p.ffn_conv_b + (size_t)l * D_FF + j;
    unsigned o[4];
    float a[8];
#pragma unroll
    for (int e = 0; e < 8; ++e) { float v = w[D_FF + e] * g[e] + cb[e]; if (hp) v += w[e] * gp[e]; if (hn) v += w[2 * D_FF + e] * gn[e]; a[e] = silu_fast(v) * u[e]; }
#pragma unroll
    for (int e = 0; e < 4; ++e) o[e] = cvtpk(a[2 * e], a[2 * e + 1]);
    *(vu4*)(p.ACT + (size_t)r * D_FF + j) = (vu4){o[0], o[1], o[2], o[3]};
}

__device__ __forceinline__ void act_task(const Ptrs& p, int l, int task) {
    constexpr int NJ = D_FF / 8;
    const int rc = task / NJ, j = (task % NJ) * 8, r0 = rc * 16;
    int b, t, len; bool ic; row_info(r0, b, t, len, ic);
    const float* w = p.ffn_conv_w + (size_t)l * 3 * D_FF + j; const float* cb = p.ffn_conv_b + (size_t)l * D_FF + j;
    float w0[8], w1[8], w2[8], bs[8];
    { const vf4 a0 = *(const vf4*)w, a1 = *(const vf4*)(w + 4), b0 = *(const vf4*)(w + D_FF), b1 = *(const vf4*)(w + D_FF + 4), c0 = *(const vf4*)(w + 2 * D_FF), c1 = *(const vf4*)(w + 2 * D_FF + 4), d0 = *(const vf4*)cb, d1 = *(const vf4*)(cb + 4);
        const float t0[8] = {a0.x, a0.y, a0.z, a0.w, a1.x, a1.y, a1.z, a1.w}, t1[8] = {b0.x, b0.y, b0.z, b0.w, b1.x, b1.y, b1.z, b1.w}, t2[8] = {c0.x, c0.y, c0.z, c0.w, c1.x, c1.y, c1.z, c1.w}, t3[8] = {d0.x, d0.y, d0.z, d0.w, d1.x, d1.y, d1.z, d1.w};
#pragma unroll
        for (int e = 0; e < 8; ++e) { w0[e] = t0[e]; w1[e] = t1[e]; w2[e] = t2[e]; bs[e] = t3[e]; } }
    const bf16* base = p.UG + (size_t)r0 * (2 * D_FF) + j;
    vu4 gq[18], uq[16];
    const vu4 z4 = {0u, 0u, 0u, 0u};
    gq[0] = (t > 0) ? *(const vu4*)(base - 2 * D_FF + D_FF) : z4;
#pragma unroll
    for (int i = 0; i < 16; ++i) { gq[i + 1] = *(const vu4*)(base + (size_t)i * (2 * D_FF) + D_FF); uq[i] = *(const vu4*)(base + (size_t)i * (2 * D_FF)); }
    gq[17] = (t + 16 < len) ? *(const vu4*)(base + (size_t)16 * (2 * D_FF) + D_FF) : z4;
#pragma unroll
    for (int i = 0; i < 16; ++i) { float gp[8], gc[8], gn[8], u[8]; unpack8(gq[i], gp); unpack8(gq[i + 1], gc); unpack8(gq[i + 2], gn); unpack8(uq[i], u);
        float a[8];
#pragma unroll
        for (int e = 0; e < 8; ++e) a[e] = silu_fast(w0[e] * gp[e] + w1[e] * gc[e] + w2[e] * gn[e] + bs[e]) * u[e];
        *(vu4*)(p.ACT + (size_t)(r0 + i) * D_FF + j) = (vu4){cvtpk(a[0], a[1]), cvtpk(a[2], a[3]), cvtpk(a[4], a[5]), cvtpk(a[6], a[7])}; }
}
static_assert(SEQ % 16 == 0 && CTX_LEN % 16 == 0, "act_task row chunks must not straddle sequences");

__device__ __forceinline__ void act_fix_item(const Ptrs& p, int l, int bidx, int j) {
    const int row = (bidx >> 1) * 64 + ((bidx & 1) ? 63 : 0);
    int b, t, len; bool ic; row_info(row, b, t, len, ic);
    const size_t bi = (size_t)bidx * D_FF + j;
    vf4 pre = *(const vf4*)(p.BP + bi);
    const vu2 uw = *(const vu2*)(p.BU + bi);
    const bool hasn = (bidx & 1) ? (t < len - 1) : (t > 0);
    if (hasn) { const vu2 gw = *(const vu2*)(p.BG + (size_t)((bidx & 1) ? bidx + 1 : bidx - 1) * D_FF + j);
        const vf4 w = *(const vf4*)(p.ffn_conv_w + (size_t)l * 3 * D_FF + ((bidx & 1) ? 2 * D_FF : 0) + j);
        pre += w * (vf4){bflo(gw.x), bfhi(gw.x), bflo(gw.y), bfhi(gw.y)}; }
    const float u4[4] = {bflo(uw.x), bfhi(uw.x), bflo(uw.y), bfhi(uw.y)};
    *(vu2*)(p.ACT + (size_t)row * D_FF + j) = (vu2){cvtpk(silu_fast(pre.x) * u4[0], silu_fast(pre.y) * u4[1]), cvtpk(silu_fast(pre.z) * u4[2], silu_fast(pre.w) * u4[3])};
}

constexpr int AT_KSTR = 136, AT_VSTR = 68;
constexpr int AT_BUF = 64 * AT_KSTR + 128 * AT_VSTR;
constexpr int ATT_UNITS_LAT = BATCH * ATT_HKV * (SEQ / 64), ATT_UNITS_CTX = BATCH * ATT_HKV * (CTX_LEN / 64);
__device__ __forceinline__ void attn_unit(const Ptrs& p, int l, LAS bf16* L, int unit, int tid) {
    const int lane = tid & 63, wave = tid >> 6, r32 = lane & 31, h = lane >> 5;
    const bool cu = unit >= ATT_UNITS_LAT; const int uu = cu ? unit - ATT_UNITS_LAT : unit;
    const int nqb = cu ? CTX_LEN / 64 : SEQ / 64;
    const int b = uu / (ATT_HKV * nqb), kvh = (uu / nqb) % ATT_HKV, qb = uu % nqb, q0 = qb * 64;
    const int rowbase = (cu ? NLAT + b * CTX_LEN : b * SEQ) + q0;
    const int g = wave >> 1, qh = wave & 1, hq = kvh * ATT_GRP + g;
    const int qpos = q0 + 32 * qh + r32, qrow = rowbase + 32 * qh + r32;
    bf16x8_t qf[8];
#pragma unroll
    for (int s = 0; s < 8; ++s) qf[s] = *(const bf16x8_t*)(p.AQb + (size_t)qrow * MIX_W + hq * 128 + 16 * s + 8 * h);
    float m = p.attn_sink[(size_t)l * ATT_HQ + hq] * 1.4426950408889634f, lsum = h ? 0.f : 1.0f;
    f32x16_t o[4];
#pragma unroll
    for (int d = 0; d < 4; ++d)
#pragma unroll
        for (int e = 0; e < 16; ++e) o[d][e] = 0.f;
    const int jl0 = cu ? 5 : (q0 - 128 < 0 ? (128 - q0) / 64 : 0), jl1 = cu ? 5 : ((q0 + 192 > SEQ) ? 5 - (q0 + 192 - SEQ) / 64 : 5);
    const int nt = (jl1 - jl0) + CTX_LEN / 64;
    vu4 rk[2], rv[2];
    auto tile_row0 = [&](int ti, int& kpos0) -> int { const int j = jl0 + ti; if (j < jl1) { kpos0 = q0 - 128 + 64 * j; return b * SEQ + kpos0; } kpos0 = -1000000; return NLAT + b * CTX_LEN + 64 * (j - jl1); };
    auto gload = [&](int ti) { int kp; const int kr0 = tile_row0(ti, kp);
#pragma unroll
        for (int it = 0; it < 2; ++it) { const int c = tid + 512 * it;
            rk[it] = *(const vu4*)(p.AKb + (size_t)(kr0 + (c >> 4)) * (ATT_HKV * 128) + kvh * 128 + (c & 15) * 8);
            const int vk = (c & 15) | (((c >> 6) & 3) << 4), vd = ((c >> 4) & 3) | ((c >> 8) << 2);
            rv[it] = *(const vu4*)(p.P + (size_t)(kr0 + vk) * NP_MAIN + C_AKV + ATT_HKV * 128 + kvh * 128 + vd * 8); } };
    auto lstore = [&](LAS bf16* B) {
#pragma unroll
        for (int it = 0; it < 2; ++it) { const int c = tid + 512 * it;
            *(LAS vu4*)(B + (c >> 4) * AT_KSTR + (c & 15) * 8) = rk[it];
            const int vk = (c & 15) | (((c >> 6) & 3) << 4), vd = ((c >> 4) & 3) | ((c >> 8) << 2);
            LAS bf16* vt = B + 64 * AT_KSTR + (vd * 8) * AT_VSTR + vk;
            const unsigned w4[4] = {rv[it].x, rv[it].y, rv[it].z, rv[it].w};
#pragma unroll
            for (int e = 0; e < 4; ++e) { vt[(2 * e) * AT_VSTR] = (bf16)(w4[e] & 0xffffu); vt[(2 * e + 1) * AT_VSTR] = (bf16)(w4[e] >> 16); } } };
    gload(0); lstore(L); LDS_BARRIER();
    for (int ti = 0; ti < nt; ++ti) {
        LAS bf16* B = L + (ti & 1) * AT_BUF;
        int kpos0; (void)tile_row0(ti, kpos0);
        if (ti + 1 < nt) gload(ti + 1);
        f32x16_t st[2];
#pragma unroll
        for (int sub = 0; sub < 2; ++sub) {
#pragma unroll
            for (int e = 0; e < 16; ++e) st[sub][e] = 0.f;
            bf16x8_t kf[8];
#pragma unroll
            for (int s = 0; s < 8; ++s) kf[s] = *(const LAS bf16x8_t*)(B + (32 * sub + r32) * AT_KSTR + 16 * s + 8 * h);
            __builtin_amdgcn_s_setprio(1);
#pragma unroll
            for (int s = 0; s < 8; ++s) st[sub] = __builtin_amdgcn_mfma_f32_32x32x16_bf16(kf[s], qf[s], st[sub], 0, 0, 0);
            __builtin_amdgcn_s_setprio(0); }
        float mx = -1e30f;
#pragma unroll
        for (int sub = 0; sub < 2; ++sub)
#pragma unroll
            for (int e = 0; e < 16; ++e) { const int key = 32 * sub + (e & 3) + 8 * (e >> 2) + 4 * h; const int dlt = kpos0 + key - qpos;
                if (kpos0 > -500000 && (dlt > WINDOW || dlt < -WINDOW)) st[sub][e] = -1e30f;
                mx = fmaxf(mx, st[sub][e]); }
        mx = fmaxf(mx, __shfl_xor(mx, 32));
        const float mn = fmaxf(m, mx), alpha = __builtin_amdgcn_exp2f(m - mn); m = mn;
        float ps = 0.f;
#pragma unroll
        for (int sub = 0; sub < 2; ++sub)
#pragma unroll
            for (int e = 0; e < 16; ++e) { const float pe = __builtin_amdgcn_exp2f(st[sub][e] - mn); st[sub][e] = pe; ps += pe; }
        lsum = lsum * alpha + ps;
        if (!__all(alpha == 1.0f)) {
#pragma unroll
            for (int d = 0; d < 4; ++d)
#pragma unroll
                for (int e = 0; e < 16; ++e) o[d][e] *= alpha; }
#pragma unroll
        for (int kk = 0; kk < 4; ++kk) { const int sub = kk >> 1, s8 = (kk & 1) * 8;
            vu4 pw; pw.x = cvtpk(st[sub][s8], st[sub][s8 + 1]); pw.y = cvtpk(st[sub][s8 + 2], st[sub][s8 + 3]); pw.z = cvtpk(st[sub][s8 + 4], st[sub][s8 + 5]); pw.w = cvtpk(st[sub][s8 + 6], st[sub][s8 + 7]);
            const bf16x8_t pf = __builtin_bit_cast(bf16x8_t, pw);
            bf16x8_t vf[4];
#pragma unroll
            for (int d = 0; d < 4; ++d) { const LAS bf16* vp = B + 64 * AT_KSTR + (32 * d + r32) * AT_VSTR + 16 * kk + 4 * h;
                const vu2 lo = *(const LAS vu2*)vp, hi = *(const LAS vu2*)(vp + 8);
                vf[d] = __builtin_bit_cast(bf16x8_t, (vu4){lo.x, lo.y, hi.x, hi.y}); }
            __builtin_amdgcn_s_setprio(1);
#pragma unroll
            for (int d = 0; d < 4; ++d) o[d] = __builtin_amdgcn_mfma_f32_32x32x16_bf16(vf[d], pf, o[d], 0, 0, 0);
            __builtin_amdgcn_s_setprio(0); }
        if (ti + 1 < nt) lstore(L + ((ti + 1) & 1) * AT_BUF);
        LDS_BARRIER();
    }
    lsum += __shfl_xor(lsum, 32);
    const float inv = 1.0f / lsum;
    LAS bf16* os = L + wave * (32 * AT_KSTR);
#pragma unroll
    for (int d = 0; d < 4; ++d)
#pragma unroll
        for (int a4 = 0; a4 < 4; ++a4) { vu2 w; w.x = cvtpk(o[d][4 * a4] * inv, o[d][4 * a4 + 1] * inv); w.y = cvtpk(o[d][4 * a4 + 2] * inv, o[d][4 * a4 + 3] * inv);
            *(LAS vu2*)(os + r32 * AT_KSTR + 32 * d + 8 * a4 + 4 * h) = w; }
    LDS_BARRIER();
#pragma unroll
    for (int i = 0; i < 8; ++i) { const int c = lane + 64 * i, row = c >> 4, ch = c & 15;
        *(vu4*)(p.YC + (size_t)(rowbase + 32 * qh + row) * YLD + hq * 128 + ch * 8) = *(const LAS vu4*)(os + row * AT_KSTR + ch * 8); }
    LDS_BARRIER();
}
static_assert(2 * AT_BUF * 2 <= 131072 && 8 * 32 * AT_KSTR <= 2 * AT_BUF, "attention LDS map");

constexpr int NCH = CHAIN_LEN / 64, NCH_CTX = CTX_LEN / 64;
constexpr int GDN_NU = BATCH * NCH * GDN_H * 2;
constexpr int GC_KS = 136, GC_FS = 65, GC_LS = 68, GC_TS = 72;
__device__ __forceinline__ int gdn_unit_index(int b, int c, int h, int dir) { return ((b * NCH + c) * GDN_H + h) * 2 + dir; }
__device__ __forceinline__ int chunk_row0(int b, int c) { return c < NCH_CTX ? NLAT + b * CTX_LEN + 64 * c : b * SEQ + 64 * (c - NCH_CTX); }
template <int NK> __device__ __forceinline__ f32x16_t mma_lds(f32x16_t acc, const LAS bf16* A, int lda, const LAS bf16* Bt, int ldb, int r32, int hh) {
    bf16x8_t a[NK], bb[NK];
#pragma unroll
    for (int s = 0; s < NK; ++s) { a[s] = *(const LAS bf16x8_t*)(A + r32 * lda + 16 * s + 8 * hh); bb[s] = *(const LAS bf16x8_t*)(Bt + r32 * ldb + 16 * s + 8 * hh); }
    f32x16_t acc2;
#pragma unroll
    for (int e = 0; e < 16; ++e) acc2[e] = 0.f;
#pragma unroll
    for (int s = 0; s < NK; s += 2) { acc = __builtin_amdgcn_mfma_f32_32x32x16_bf16(a[s], bb[s], acc, 0, 0, 0); acc2 = __builtin_amdgcn_mfma_f32_32x32x16_bf16(a[s + 1], bb[s + 1], acc2, 0, 0, 0); }
#pragma unroll
    for (int e = 0; e < 16; ++e) acc[e] += acc2[e];
    return acc;
}
__device__ __forceinline__ f32x16_t zero16() { f32x16_t z;
#pragma unroll
    for (int e = 0; e < 16; ++e) z[e] = 0.f;
    return z; }
__device__ __forceinline__ void tri_solve_wave(const LAS float* Lm, LAS bf16* Tm, LAS bf16* scr, int lane) {
    const int blk = lane >> 5, c = lane & 31, r32 = c, hh = blk;
    LAS bf16* B00 = scr; LAS bf16* XT = scr + 32 * 40;
    float t[32];
    vf4 lb[3][8];
#define TRI_LDROW(i_) do { _Pragma("unroll") for (int j4 = 0; j4 < ((i_) + 3) / 4; ++j4) lb[(i_) % 3][j4] = *(const LAS vf4*)(Lm + (32 * blk + (i_)) * GC_LS + 32 * blk + 4 * j4); } while (0)
    TRI_LDROW(1);
#pragma unroll
    for (int i = 0; i < 32; ++i) {
        if (i + 2 < 32) TRI_LDROW(i + 2);
        float s = (i == c) ? 1.0f : 0.0f;
#pragma unroll
        for (int j4 = 0; j4 < (i + 3) / 4; ++j4) { const vf4 lv = lb[i % 3][j4];
            if (4 * j4 + 0 < i) s -= lv.x * t[4 * j4 + 0];
            if (4 * j4 + 1 < i) s -= lv.y * t[4 * j4 + 1];
            if (4 * j4 + 2 < i) s -= lv.z * t[4 * j4 + 2];
            if (4 * j4 + 3 < i) s -= lv.w * t[4 * j4 + 3]; }
        t[i] = s;
        asm volatile("" : "+v"(t[i]));
    }
#undef TRI_LDROW
#pragma unroll
    for (int i = 0; i < 32; ++i) { Tm[(32 * blk + i) * GC_TS + 32 * blk + c] = f2bf(t[i]); if (blk == 0) Tm[i * GC_TS + 32 + c] = (bf16)0; }
    if (blk == 0) {
#pragma unroll
        for (int q = 0; q < 4; ++q) *(LAS vu4*)(B00 + c * 40 + 8 * q) = (vu4){cvtpk(t[8 * q], t[8 * q + 1]), cvtpk(t[8 * q + 2], t[8 * q + 3]), cvtpk(t[8 * q + 4], t[8 * q + 5]), cvtpk(t[8 * q + 6], t[8 * q + 7])}; }
    f32x16_t x = zero16();
#pragma unroll
    for (int s = 0; s < 2; ++s) { const LAS float* lp = Lm + (32 + r32) * GC_LS + 16 * s + 8 * hh; const vf4 l0 = *(const LAS vf4*)lp, l1 = *(const LAS vf4*)(lp + 4);
        const bf16x8_t a = __builtin_bit_cast(bf16x8_t, (vu4){cvtpk(l0.x, l0.y), cvtpk(l0.z, l0.w), cvtpk(l1.x, l1.y), cvtpk(l1.z, l1.w)});
        const bf16x8_t bb = *(const LAS bf16x8_t*)(B00 + r32 * 40 + 16 * s + 8 * hh);
        x = __builtin_amdgcn_mfma_f32_32x32x16_bf16(a, bb, x, 0, 0, 0); }
#pragma unroll
    for (int a4 = 0; a4 < 4; ++a4) *(LAS vu2*)(XT + r32 * 40 + 8 * a4 + 4 * hh) = (vu2){cvtpk(x[4 * a4], x[4 * a4 + 1]), cvtpk(x[4 * a4 + 2], x[4 * a4 + 3])};
    f32x16_t y = zero16();
#pragma unroll
    for (int s = 0; s < 2; ++s) { const bf16x8_t a = *(const LAS bf16x8_t*)(Tm + (32 + r32) * GC_TS + 32 + 16 * s + 8 * hh), bb = *(const LAS bf16x8_t*)(XT + r32 * 40 + 16 * s + 8 * hh);
        y = __builtin_amdgcn_mfma_f32_32x32x16_bf16(a, bb, y, 0, 0, 0); }
#pragma unroll
    for (int e = 0; e < 16; ++e) Tm[(32 + (e & 3) + 8 * (e >> 2) + 4 * hh) * GC_TS + r32] = f2bf(-y[e]);
}
constexpr int G1_KK = 0, G1_QK = G1_KK + 64 * GC_FS * 4, G1_L = G1_QK + 64 * GC_FS * 4, G1_T = G1_L + 2 * 64 * GC_LS * 4,
              G1_KB = G1_T + 2 * 64 * GC_TS * 2, G1_VB = G1_KB + 128 * GC_TS * 2, G1_SM = G1_VB + 128 * GC_TS * 2, G1_END = G1_SM + 10 * 64 * 4;
__device__ __forceinline__ void st_vu2(LAS bf16* q, vu2 v) { *(LAS vu2*)q = v; }
__device__ __forceinline__ void st_vu2(bf16* q, vu2 v) { __builtin_nontemporal_store(v, (vu2*)q); }
__device__ __forceinline__ void gdn_g1_unit(const Ptrs& p, LAS unsigned char* lds, int unit, int tid) {
    const int lane = tid & 63, wave = tid >> 6, r32 = lane & 31, hh = lane >> 5;
    const int b = unit / (NCH * GDN_H), c = (unit / GDN_H) % NCH, h = unit % GDN_H;
    const int r0 = chunk_row0(b, c);
    LAS float* KKs = (LAS float*)(lds + G1_KK); LAS float* QKs = (LAS float*)(lds + G1_QK);
    LAS float* Lm = (LAS float*)(lds + G1_L); LAS bf16* Tm = (LAS bf16*)(lds + G1_T); LAS bf16* KbT = (LAS bf16*)(lds + G1_KB); LAS bf16* VbT = (LAS bf16*)(lds + G1_VB);
    LAS float* gc = (LAS float*)(lds + G1_SM); LAS float* be = gc + 128; LAS float* eg = gc + 256; LAS float* beg = gc + 384; LAS float* egl = gc + 512;
    const bf16* Qg = p.GQKVb + (size_t)r0 * (3 * MIX_W) + h * 128;
    const int prod = wave >> 2, mt = (wave >> 1) & 1, nt = wave & 1;
    bf16x8_t fa[8], fb[8], ft[4];
    { const bf16* Ap = Qg + (size_t)(32 * mt + r32) * (3 * MIX_W) + (prod ? 0 : MIX_W) + 8 * hh;
      const bf16* Bp = Qg + (size_t)(32 * nt + r32) * (3 * MIX_W) + MIX_W + 8 * hh;
      const bf16* Tp = Qg + (size_t)(32 * mt + r32) * (3 * MIX_W) + (prod ? 2 * MIX_W : MIX_W) + 64 * nt + 8 * hh;
#pragma unroll
      for (int s = 0; s < 8; ++s) { fa[s] = *(const bf16x8_t*)(Ap + 16 * s); fb[s] = *(const bf16x8_t*)(Bp + 16 * s); }
#pragma unroll
      for (int s = 0; s < 4; ++s) ft[s] = *(const bf16x8_t*)(Tp + 16 * s); }
    if (wave < 2) { const int dir = wave, n = dir ? 63 - lane : lane; const size_t gi = (size_t)(r0 + n) * 2 * GDN_H + dir * GDN_H + h;
        float x = p.GG[gi]; const float bt = p.GB[gi];
#pragma unroll
        for (int o = 1; o < 64; o <<= 1) { const float y = __shfl_up(x, o); if (lane >= o) x += y; }
        const float x63 = __shfl(x, 63), ex = __expf(x);
        gc[dir * 64 + lane] = x; be[dir * 64 + lane] = bt; eg[dir * 64 + lane] = ex; beg[dir * 64 + lane] = bt * ex; egl[dir * 64 + lane] = __expf(x63 - x); }
    f32x16_t tt[2];
    { f32x16_t acc = zero16(), acc2 = zero16();
#pragma unroll
      for (int s = 0; s < 8; s += 2) { acc = __builtin_amdgcn_mfma_f32_32x32x16_bf16(fa[s], fb[s], acc, 0, 0, 0); acc2 = __builtin_amdgcn_mfma_f32_32x32x16_bf16(fa[s + 1], fb[s + 1], acc2, 0, 0, 0); }
      LAS float* dst = prod ? QKs : KKs;
#pragma unroll
      for (int e = 0; e < 16; ++e) dst[(32 * mt + (e & 3) + 8 * (e >> 2) + 4 * hh) * GC_FS + 32 * nt + r32] = acc[e] + acc2[e];
      bf16x8_t id[2];
#pragma unroll
      for (int s = 0; s < 2; ++s) { unsigned w[4];
#pragma unroll
          for (int e2 = 0; e2 < 4; ++e2) { const int k0 = 16 * s + 8 * hh + 2 * e2; w[e2] = (k0 == r32 ? 0x3F80u : 0u) | (k0 + 1 == r32 ? 0x3F800000u : 0u); }
          id[s] = __builtin_bit_cast(bf16x8_t, (vu4){w[0], w[1], w[2], w[3]}); }
#pragma unroll
      for (int j = 0; j < 2; ++j) { tt[j] = zero16();
          tt[j] = __builtin_amdgcn_mfma_f32_32x32x16_bf16(ft[2 * j], id[0], tt[j], 0, 0, 0); tt[j] = __builtin_amdgcn_mfma_f32_32x32x16_bf16(ft[2 * j + 1], id[1], tt[j], 0, 0, 0); } }
    LDS_BARRIER();
    auto put_T = [&](int dir, const LAS float* tab, auto dstf) {
#pragma unroll
        for (int j = 0; j < 2; ++j) {
#pragma unroll
            for (int a4 = 0; a4 < 4; ++a4) { const int n0 = 32 * mt + 8 * a4 + 4 * hh;
                if (dir == 0) { const vf4 sc = *(const LAS vf4*)(tab + n0);
                    st_vu2(dstf(j, n0), (vu2){cvtpk(tt[j][4 * a4] * sc.x, tt[j][4 * a4 + 1] * sc.y), cvtpk(tt[j][4 * a4 + 2] * sc.z, tt[j][4 * a4 + 3] * sc.w)}); }
                else { const int i0 = 60 - n0; const vf4 sc = *(const LAS vf4*)(tab + 64 + i0);
                    st_vu2(dstf(j, i0), (vu2){cvtpk(tt[j][4 * a4 + 3] * sc.x, tt[j][4 * a4 + 2] * sc.y), cvtpk(tt[j][4 * a4 + 1] * sc.z, tt[j][4 * a4] * sc.w)}); } } } };
    auto lds_T = [&](LAS bf16* img) { return [=](int j, int i0) { return img + (64 * nt + 32 * j + r32) * GC_TS + i0; }; };
    auto kdt_T = [&](int dir) { bf16* base = p.GKdT + (size_t)gdn_unit_index(b, c, h, dir) * 128 * 64; return [=](int j, int i0) { return base + (((2 * nt + j) * 4 + (i0 >> 4)) * 64 + ((i0 >> 3) & 1) * 32 + r32) * 8 + (i0 & 7); }; };
    if (prod == 0) { put_T(0, egl, kdt_T(0)); put_T(1, egl, kdt_T(1)); put_T(0, beg, lds_T(KbT)); }
    else {
        const int dir = nt, n = 32 * mt + r32, i = dir ? 63 - n : n; const float sc = eg[dir * 64 + i];
        bf16* base = p.GQd + (size_t)gdn_unit_index(b, c, h, dir) * 64 * 128 + ((size_t)((i >> 5) * 8) * 64 + hh * 32 + (i & 31)) * 8;
#pragma unroll
        for (int q = 0; q < 8; ++q) { float q8[8]; unpack8(__builtin_bit_cast(vu4, fa[q]), q8);
            __builtin_nontemporal_store((vu4){cvtpk(q8[0] * sc, q8[1] * sc), cvtpk(q8[2] * sc, q8[3] * sc), cvtpk(q8[4] * sc, q8[5] * sc), cvtpk(q8[6] * sc, q8[7] * sc)}, (vu4*)(base + q * 512)); }
        put_T(0, be, lds_T(VbT)); }
#pragma unroll
    for (int it = 0; it < 2; ++it) { const int item = it * 512 + tid, dir = item >> 9, j0 = ((item >> 6) & 7) * 8, i = item & 63, ni = dir ? 63 - i : i;
        float o[8] = {0.f, 0.f, 0.f, 0.f, 0.f, 0.f, 0.f, 0.f};
        if (j0 < i) { const float gi = gc[dir * 64 + i], bi = be[dir * 64 + i]; const vf4 ga = *(const LAS vf4*)(gc + dir * 64 + j0), gb = *(const LAS vf4*)(gc + dir * 64 + j0 + 4);
            const float gj[8] = {ga.x, ga.y, ga.z, ga.w, gb.x, gb.y, gb.z, gb.w};
#pragma unroll
            for (int q = 0; q < 8; ++q) { const int j = j0 + q, nj = dir ? 63 - j : j; o[q] = (i > j) ? bi * KKs[ni * GC_FS + nj] * __expf(gi - gj[q]) : 0.0f; } }
        LAS float* dst = Lm + dir * 64 * GC_LS + i * GC_LS + j0;
        *(LAS vf4*)dst = (vf4){o[0], o[1], o[2], o[3]}; *(LAS vf4*)(dst + 4) = (vf4){o[4], o[5], o[6], o[7]}; }
    LDS_BARRIER();
    if (wave < 2) { __builtin_amdgcn_s_setprio(3); tri_solve_wave(Lm + wave * 64 * GC_LS, Tm + wave * 64 * GC_TS, (LAS bf16*)KKs + wave * 2 * 32 * 40, lane); __builtin_amdgcn_s_setprio(0); }
    else if ((wave & 3) >= 2) { const int t6 = ((wave & 1) | ((wave >> 2) << 1)) * 64 + lane;
        for (int it = t6; it < 2 * 64 * 8; it += 256) { const int dir = it >> 9, j8 = (it >> 6) & 7, i = it & 63, ni = dir ? 63 - i : i; unsigned w[4];
#pragma unroll
            for (int e2 = 0; e2 < 4; ++e2) { float a[2];
#pragma unroll
                for (int q = 0; q < 2; ++q) { const int j = j8 * 8 + 2 * e2 + q; a[q] = (i >= j) ? QKs[ni * GC_FS + (dir ? 63 - j : j)] * __expf(gc[dir * 64 + i] - gc[dir * 64 + j]) : 0.0f; }
                w[e2] = cvtpk(a[0], a[1]); }
            __builtin_nontemporal_store((vu4){w[0], w[1], w[2], w[3]}, (vu4*)(p.GA + (size_t)gdn_unit_index(b, c, h, dir) * 64 * 64 + (((i >> 5) * 4 + (j8 >> 1)) * 64 + (j8 & 1) * 32 + (i & 31)) * 8)); }
        if (t6 < 2) p.GGL[gdn_unit_index(b, c, h, t6)] = eg[t6 * 64 + 63]; }
    LDS_BARRIER();
    LAS bf16* KbT1 = (LAS bf16*)(lds + G1_KK); LAS bf16* VbT1 = KbT1 + 128 * GC_TS;
    if (prod == 0) put_T(1, beg, lds_T(KbT1)); else put_T(1, be, lds_T(VbT1));
    LDS_BARRIER();
#pragma unroll
    for (int dir = 0; dir < 2; ++dir) {
        const int u = gdn_unit_index(b, c, h, dir); const LAS bf16* Td = Tm + dir * 64 * GC_TS; const LAS bf16* Kd = dir ? KbT1 : KbT; const LAS bf16* Vd = dir ? VbT1 : VbT;
        { const int dt = wave >> 1, it2 = wave & 1; f32x16_t acc = zero16(); acc = mma_lds<4>(acc, Kd + 32 * dt * GC_TS, GC_TS, Td + 32 * it2 * GC_TS, GC_TS, r32, hh);
            bf16* dst = p.GW + (size_t)u * 64 * 128 + ((it2 * 8 + 2 * dt) * 64 + r32) * 8 + 4 * hh;
#pragma unroll
            for (int a4 = 0; a4 < 4; ++a4) __builtin_nontemporal_store((vu2){cvtpk(acc[4 * a4], acc[4 * a4 + 1]), cvtpk(acc[4 * a4 + 2], acc[4 * a4 + 3])}, (vu2*)(dst + (a4 >> 1) * 512 + (a4 & 1) * 256)); }
        { const int it2 = wave >> 2, dt = wave & 3; f32x16_t acc = zero16(); acc = mma_lds<4>(acc, Td + 32 * it2 * GC_TS, GC_TS, Vd + 32 * dt * GC_TS, GC_TS, r32, hh);
            bf16* dst = p.GUT + (size_t)u * 128 * 64 + ((size_t)((dt * 2 + it2) * 4) * 64 + lane) * 4;
#pragma unroll
            for (int a4 = 0; a4 < 4; ++a4) __builtin_nontemporal_store((vu2){cvtpk(acc[4 * a4], acc[4 * a4 + 1]), cvtpk(acc[4 * a4 + 2], acc[4 * a4 + 3])}, (vu2*)(dst + a4 * 256)); }
    }
    LDS_BARRIER();
}

template <class F> __device__ __forceinline__ void store_tile_rows(const f32x16_t& a, LAS bf16* T, int lane, F rowptr) {
    const int r32 = lane & 31, hh = lane >> 5;
#pragma unroll
    for (int e = 0; e < 16; ++e) T[((e & 3) + 8 * (e >> 2) + 4 * hh) * 40 + r32] = f2bf(a[e]);
    const int il = lane >> 1, half = lane & 1;
    const vu4 w0 = *(const LAS vu4*)(T + il * 40 + half * 16), w1 = *(const LAS vu4*)(T + il * 40 + half * 16 + 8);
    bf16* dst = rowptr(il) + half * 16;
    *(vu4*)dst = w0; *(vu4*)(dst + 8) = w1;
}
__device__ __forceinline__ void gdn_scan_wg(const Ptrs& p, LAS unsigned char* lds, int chain, int slice, int tid) {
    const int b = chain / (GDN_H * 2), h = (chain >> 1) % GDN_H, dir = chain & 1;
    const int lane = tid & 63, wave = tid >> 6, r32 = lane & 31, hh = lane >> 5;
    LAS bf16* SbT = (LAS bf16*)lds;
    LAS bf16* vnT = SbT + 4 * 32 * GC_KS;
    LAS bf16* otile = vnT + 3 * 32 * GC_TS + (wave & 1) * 32 * 40;
    for (int i = tid; i < 32 * GC_KS / 2; i += 512) ((LAS unsigned*)SbT)[i] = 0u;
    LDS_BARRIER();
    auto chunk_of = [&](int s) { return s < NCH_CTX ? (dir ? NCH_CTX - 1 - s : s) : NCH_CTX + (dir ? NCH - NCH_CTX - 1 - (s - NCH_CTX) : s - NCH_CTX); };
    auto unit_of = [&](int s) { return (size_t)gdn_unit_index(b, chunk_of(s), h, dir); };
    using I0 = std::integral_constant<int, 0>; using I1 = std::integral_constant<int, 1>; using I2 = std::integral_constant<int, 2>; using I3 = std::integral_constant<int, 3>;
    if (wave < 2) {
        __builtin_amdgcn_s_setprio(3);
        int tr = tid; asm volatile("" : "+v"(tr)); const int ln = tr & 63, t = (tr >> 6) & 1;
        bf16x8_t fa[4][8]; vu2 ut[4][4];
        auto prefetch = [&](int s, auto KC2) { constexpr int k = decltype(KC2)::value; const size_t u = unit_of(s);
            const bf16* wp = p.GW + u * 64 * 128 + (size_t)(t * 512 + ln) * 8; const bf16* up = p.GUT + u * 128 * 64 + (size_t)((slice * 2 + t) * 256 + ln) * 4;
#pragma unroll
            for (int q = 0; q < 8; ++q) fa[k][q] = *(const bf16x8_t*)(wp + q * 512);
#pragma unroll
            for (int a4 = 0; a4 < 4; ++a4) ut[k][a4] = *(const vu2*)(up + a4 * 256); };
        auto step = [&](int s, auto KC) { constexpr int k = decltype(KC)::value;
            if (s + 3 < NCH) prefetch(s + 3, std::integral_constant<int, (k + 3) % 4>{});
            const LAS bf16* Sc = SbT + (s & 3) * 32 * GC_KS; LAS bf16* vn = vnT + (s % 3) * 32 * GC_TS;
            f32x16_t acc = zero16(), acc2 = zero16();
#pragma unroll
            for (int qh = 0; qh < 2; ++qh) { bf16x8_t bq[4];
#pragma unroll
                for (int q = 0; q < 4; ++q) bq[q] = *(const LAS bf16x8_t*)(Sc + r32 * GC_KS + 16 * (4 * qh + q) + 8 * hh);
#pragma unroll
                for (int q = 0; q < 4; q += 2) { acc = __builtin_amdgcn_mfma_f32_32x32x16_bf16(fa[k][4 * qh + q], bq[q], acc, 0, 0, 0); acc2 = __builtin_amdgcn_mfma_f32_32x32x16_bf16(fa[k][4 * qh + q + 1], bq[q + 1], acc2, 0, 0, 0); } }
#pragma unroll
            for (int a4 = 0; a4 < 4; ++a4) { const vu2 uw = ut[k][a4];
                *(LAS vu2*)(vn + r32 * GC_TS + 32 * t + 8 * a4 + 4 * hh) = (vu2){cvtpk(bflo(uw.x) - (acc[4 * a4] + acc2[4 * a4]), bfhi(uw.x) - (acc[4 * a4 + 1] + acc2[4 * a4 + 1])), cvtpk(bflo(uw.y) - (acc[4 * a4 + 2] + acc2[4 * a4 + 2]), bfhi(uw.y) - (acc[4 * a4 + 3] + acc2[4 * a4 + 3]))}; }
            LDS_BARRIER(); LDS_BARRIER(); };
        prefetch(0, I0{}); prefetch(1, I1{}); prefetch(2, I2{});
        for (int s = 0; s < NCH; s += 4) { step(s, I0{}); step(s + 1, I1{}); step(s + 2, I2{}); step(s + 3, I3{}); }
        __builtin_amdgcn_s_setprio(0);
    } else if (wave >= 4) {
        __builtin_amdgcn_s_setprio(3);
        int tr = tid; asm volatile("" : "+v"(tr)); const int ln = tr & 63, rr = (tr >> 6) & 3;
        int zl = 0; asm volatile("v_mov_b32 %0, 0" : "=v"(zl));
        bf16x8_t fb[8][4]; float gl[8] = {0.f, 0.f, 0.f, 0.f, 0.f, 0.f, 0.f, 0.f}; f32x16_t S = zero16();
        auto prefetch = [&](int s, auto KC2) { constexpr int k = decltype(KC2)::value; const size_t u = unit_of(s);
            const bf16* kp = p.GKdT + u * 128 * 64 + (size_t)(rr * 256 + ln) * 8;
#pragma unroll
            for (int q = 0; q < 4; ++q) fb[k][q] = *(const bf16x8_t*)(kp + q * 512);
            gl[k] = p.GGL[u + zl]; };
        auto step = [&](int s, auto KC) { constexpr int k = decltype(KC)::value;
            if (s + 7 < NCH) prefetch(s + 7, std::integral_constant<int, (k + 7) % 8>{});
            const LAS bf16* vn = vnT + (s % 3) * 32 * GC_TS; LAS bf16* Sn = SbT + ((s + 1) & 3) * 32 * GC_KS;
            const float g1 = gl[k];
#pragma unroll
            for (int e = 0; e < 16; ++e) S[e] *= g1;
            LDS_BARRIER();
            bf16x8_t bq[4];
#pragma unroll
            for (int q = 0; q < 4; ++q) bq[q] = *(const LAS bf16x8_t*)(vn + r32 * GC_TS + 16 * q + 8 * hh);
#pragma unroll
            for (int q = 0; q < 4; ++q) S = __builtin_amdgcn_mfma_f32_32x32x16_bf16(fb[k][q], bq[q], S, 0, 0, 0);
#pragma unroll
            for (int a4 = 0; a4 < 4; ++a4) *(LAS vu2*)(Sn + r32 * GC_KS + 32 * rr + 8 * a4 + 4 * hh) = (vu2){cvtpk(S[4 * a4], S[4 * a4 + 1]), cvtpk(S[4 * a4 + 2], S[4 * a4 + 3])};
            LDS_BARRIER(); };
        using I4 = std::integral_constant<int, 4>; using I5 = std::integral_constant<int, 5>; using I6 = std::integral_constant<int, 6>; using I7 = std::integral_constant<int, 7>;
        prefetch(0, I0{}); prefetch(1, I1{}); prefetch(2, I2{}); prefetch(3, I3{}); prefetch(4, I4{}); prefetch(5, I5{}); prefetch(6, I6{});
        for (int s = 0; s + 7 < NCH; s += 8) { step(s, I0{}); step(s + 1, I1{}); step(s + 2, I2{}); step(s + 3, I3{}); step(s + 4, I4{}); step(s + 5, I5{}); step(s + 6, I6{}); step(s + 7, I7{}); }
        step(NCH - 4, I0{}); step(NCH - 3, I1{}); step(NCH - 2, I2{}); step(NCH - 1, I3{});
        __builtin_amdgcn_s_setprio(0);
    } else {
        int tr = tid; asm volatile("" : "+v"(tr)); const int ln = tr & 63, t = (tr >> 6) & 1;
        bf16x8_t fa[3][8], fb[3][4];
        auto prefetch = [&](int s, auto KC2) { constexpr int k = decltype(KC2)::value; const size_t u = unit_of(s);
            const bf16* qp = p.GQd + u * 64 * 128 + (size_t)(t * 512 + ln) * 8; const bf16* ap = p.GA + u * 64 * 64 + (size_t)(t * 256 + ln) * 8;
#pragma unroll
            for (int q = 0; q < 8; ++q) fa[k][q] = *(const bf16x8_t*)(qp + q * 512);
#pragma unroll
            for (int q = 0; q < 4; ++q) fb[k][q] = *(const bf16x8_t*)(ap + q * 512); };
        auto out_of = [&](int so, auto KC) { constexpr int k = decltype(KC)::value;
            const LAS bf16* Sc = SbT + (so & 3) * 32 * GC_KS; const LAS bf16* vn = vnT + (so % 3) * 32 * GC_TS;
            f32x16_t acc = zero16(), acc2 = zero16();
#pragma unroll
            for (int qh = 0; qh < 2; ++qh) { bf16x8_t bq[4];
#pragma unroll
                for (int q = 0; q < 4; ++q) bq[q] = *(const LAS bf16x8_t*)(Sc + r32 * GC_KS + 16 * (4 * qh + q) + 8 * hh);
#pragma unroll
                for (int q = 0; q < 4; q += 2) { acc = __builtin_amdgcn_mfma_f32_32x32x16_bf16(fa[k][4 * qh + q], bq[q], acc, 0, 0, 0); acc2 = __builtin_amdgcn_mfma_f32_32x32x16_bf16(fa[k][4 * qh + q + 1], bq[q + 1], acc2, 0, 0, 0); } }
            { bf16x8_t bv[4];
#pragma unroll
              for (int q = 0; q < 4; ++q) bv[q] = *(const LAS bf16x8_t*)(vn + r32 * GC_TS + 16 * q + 8 * hh);
#pragma unroll
              for (int q = 0; q < 4; q += 2) { acc = __builtin_amdgcn_mfma_f32_32x32x16_bf16(fb[k][q], bv[q], acc, 0, 0, 0); acc2 = __builtin_amdgcn_mfma_f32_32x32x16_bf16(fb[k][q + 1], bv[q + 1], acc2, 0, 0, 0); } }
            const int r0 = chunk_row0(b, chunk_of(so));
#pragma unroll
            for (int e = 0; e < 16; ++e) acc[e] += acc2[e];
            store_tile_rows(acc, otile, lane, [&](int il) { const int i = 32 * t + il; return p.OGb + ((size_t)dir * MROWS + r0 + (dir ? 63 - i : i)) * MIX_W + h * 128 + slice * 32; }); };
        auto step = [&](int s, auto KC) { constexpr int k = decltype(KC)::value;
            if (s > 1) out_of(s - 2, std::integral_constant<int, (k + 1) % 3>{});
            if (s + 1 < NCH) prefetch(s + 1, std::integral_constant<int, (k + 1) % 3>{});
            LDS_BARRIER(); LDS_BARRIER(); };
        prefetch(0, I0{});
        for (int s = 0; s + 2 < NCH; s += 3) { step(s, I0{}); step(s + 1, I1{}); step(s + 2, I2{}); }
        step(NCH - 2, std::integral_constant<int, (NCH - 2) % 3>{}); step(NCH - 1, std::integral_constant<int, (NCH - 1) % 3>{});
        out_of(NCH - 2, std::integral_constant<int, (NCH - 2) % 3>{}); out_of(NCH - 1, std::integral_constant<int, (NCH - 1) % 3>{});
    }
}
static_assert(G1_END <= 146432 && NCH % 8 == 4 && NCH % 3 == 2, "G1 LDS map / scan unroll");

constexpr int SSD_NU = BATCH * NCH * SSM_H * 2;
__device__ __forceinline__ int ssd_unit_index(int b, int c, int hd, int dir) { return ((b * NCH + c) * SSM_H + hd) * 2 + dir; }
constexpr int SL_BN = 0, SL_CN = SL_BN + 64 * GC_KS * 2, SL_CB = SL_CN + 64 * GC_KS * 2, SL_BT = SL_CB + 64 * GC_FS * 4, SL_XT = SL_BT + 128 * GC_TS * 2, SL_M = SL_XT + 256 * GC_TS * 2,
              SL_XW = SL_M + 64 * GC_TS * 2, SL_SM = SL_XW + 2 * 64 * GC_TS * 2, SL_END = SL_SM + 8 * 3 * 64 * 4;
static_assert(SL_END <= 146432, "ssd local LDS map");
constexpr int SSD_LOCAL_UNITS = BATCH * NCH * SSM_G * 2;
__device__ __forceinline__ void ssd_local_unit(const Ptrs& p, LAS unsigned char* lds, int unit, int tid) {
    const int lane = tid & 63, wave = tid >> 6, r32 = lane & 31, hh = lane >> 5;
    const int b = unit / (NCH * SSM_G * 2), c = (unit / (SSM_G * 2)) % NCH, g = (unit >> 1) % SSM_G, hq = unit & 1;
    const int r0 = chunk_row0(b, c), hd0 = g * SSM_HPG + hq * 4;
    LAS bf16* Bn = (LAS bf16*)(lds + SL_BN); LAS bf16* Cn = (LAS bf16*)(lds + SL_CN); LAS float* CBs = (LAS float*)(lds + SL_CB); LAS bf16* BT = (LAS bf16*)(lds + SL_BT);
    LAS bf16* XT = (LAS bf16*)(lds + SL_XT); LAS bf16* Mm = (LAS bf16*)(lds + SL_M); LAS bf16* XwT = (LAS bf16*)(lds + SL_XW); LAS float* sm = (LAS float*)(lds + SL_SM);
#pragma unroll
    for (int it = 0; it < 4; ++it) { const int idx = it * 512 + tid, row = idx >> 5, which = (idx >> 4) & 1, c8 = idx & 15;
        *(LAS vu4*)((which ? Cn : Bn) + row * GC_KS + c8 * 8) = *(const vu4*)(p.SBCb + (size_t)(r0 + row) * (2 * SSM_BC) + which * SSM_BC + g * SSM_N + c8 * 8); }
    { vu4 xv[4];
#pragma unroll
        for (int it = 0; it < 4; ++it) { const int idx = it * 512 + tid, j = idx >> 5, p8 = idx & 31; xv[it] = *(const vu4*)(p.SXb + (size_t)(r0 + j) * MIX_W + hd0 * SSM_P + p8 * 8); }
#pragma unroll
        for (int it = 0; it < 4; ++it) { const int idx = it * 512 + tid, j = idx >> 5, p8 = idx & 31; const unsigned w4[4] = {xv[it].x, xv[it].y, xv[it].z, xv[it].w};
#pragma unroll
            for (int e = 0; e < 4; ++e) { XT[(8 * p8 + 2 * e) * GC_TS + j] = (bf16)(w4[e] & 0xffffu); XT[(8 * p8 + 2 * e + 1) * GC_TS + j] = (bf16)(w4[e] >> 16); } } }
    { const int hd = hd0 + (wave >> 1), dir = wave & 1, n = dir ? 63 - lane : lane; const size_t gi = (size_t)(r0 + n) * 2 * SSM_H + dir * SSM_H + hd; const int u = ssd_unit_index(b, c, hd, dir);
        float x = p.SA[gi]; const float dt = p.SDT[gi];
#pragma unroll
        for (int o = 1; o < 64; o <<= 1) { const float y = __shfl_up(x, o); if (lane >= o) x += y; }
        const float x63 = __shfl(x, 63);
        sm[(wave * 3 + 0) * 64 + lane] = x; sm[(wave * 3 + 1) * 64 + lane] = dt; sm[(wave * 3 + 2) * 64 + lane] = __expf(x63 - x) * dt;
        p.SEAb[(size_t)u * 64 + lane] = f2bf(__expf(x)); if (lane == 63) p.SDC[u] = __expf(x); }
    LDS_BARRIER();
    *(vu4*)(p.SCF + ((((size_t)(b * NCH + c) * SSM_G + g) * 2 + hq) * 8 + wave) * 512 + lane * 8) = *(const LAS vu4*)(Cn + (32 * hq + r32) * GC_KS + 16 * wave + 8 * hh);
    if (wave < 4) { const int mt = wave >> 1, nt = wave & 1; f32x16_t acc = zero16(); acc = mma_lds<8>(acc, Cn + 32 * mt * GC_KS, GC_KS, Bn + 32 * nt * GC_KS, GC_KS, r32, hh);
#pragma unroll
        for (int e = 0; e < 16; ++e) CBs[(32 * mt + (e & 3) + 8 * (e >> 2) + 4 * hh) * GC_FS + 32 * nt + r32] = acc[e]; }
    else { for (int it = tid - 256; it < 128 * 8; it += 256) { const int s = it >> 3, j8 = it & 7; unsigned w[4];
#pragma unroll
            for (int e2 = 0; e2 < 4; ++e2) w[e2] = (unsigned)Bn[(j8 * 8 + 2 * e2) * GC_KS + s] | ((unsigned)Bn[(j8 * 8 + 2 * e2 + 1) * GC_KS + s] << 16);
            *(LAS vu4*)(BT + s * GC_TS + j8 * 8) = (vu4){w[0], w[1], w[2], w[3]}; } }
    LDS_BARRIER();
#pragma unroll 1
    for (int hl = 0; hl < 4; ++hl) {
        const int hd = hd0 + hl;
        const LAS float* ac0 = sm + (hl * 2 * 3) * 64; const LAS float* ac1 = ac0 + 3 * 64;
        { const int n = tid >> 3, n8 = tid & 7; unsigned w[4];
            const float a0n = ac0[n], a1n = ac1[63 - n];
#pragma unroll
            for (int e2 = 0; e2 < 4; ++e2) { float a[2];
#pragma unroll
                for (int q = 0; q < 2; ++q) { const int nj = n8 * 8 + 2 * e2 + q; const bool lo = nj <= n;
                    const float ex = __expf(lo ? a0n - ac0[nj] : a1n - ac1[63 - nj]);
                    const float dd = (nj < n) ? ac0[64 + nj] : (nj > n) ? ac1[64 + 63 - nj] : ac0[64 + nj] + ac1[64 + 63 - nj];
                    a[q] = CBs[n * GC_FS + nj] * ex * dd; }
                w[e2] = cvtpk(a[0], a[1]); }
            *(LAS vu4*)(Mm + n * GC_TS + n8 * 8) = (vu4){w[0], w[1], w[2], w[3]};
            const int pp = tid >> 3; float xs[8]; unpack8(*(const LAS vu4*)(XT + (hl * 64 + pp) * GC_TS + n8 * 8), xs);
#pragma unroll
            for (int e2 = 0; e2 < 4; ++e2) { const int nj = n8 * 8 + 2 * e2; w[e2] = cvtpk(xs[2 * e2] * ac0[128 + nj], xs[2 * e2 + 1] * ac0[128 + nj + 1]); }
            *(LAS vu4*)(XwT + pp * GC_TS + n8 * 8) = (vu4){w[0], w[1], w[2], w[3]};
#pragma unroll
            for (int e2 = 0; e2 < 4; ++e2) { const int nj = n8 * 8 + 2 * e2; w[e2] = cvtpk(xs[2 * e2] * ac1[128 + 63 - nj], xs[2 * e2 + 1] * ac1[128 + 62 - nj]); }
            *(LAS vu4*)(XwT + (64 + pp) * GC_TS + n8 * 8) = (vu4){w[0], w[1], w[2], w[3]}; }
        LDS_BARRIER();
#pragma unroll
        for (int dir = 0; dir < 2; ++dir) { const int sb = wave >> 1, pb = wave & 1, u = ssd_unit_index(b, c, hd, dir); f32x16_t acc = zero16();
            acc = mma_lds<4>(acc, BT + 32 * sb * GC_TS, GC_TS, XwT + (64 * dir + 32 * pb) * GC_TS, GC_TS, r32, hh);
            bf16* dst = p.SSC + (((size_t)u * 8 + wave) * 64 + lane) * 16;
            __builtin_nontemporal_store((vu4){cvtpk(acc[0], acc[1]), cvtpk(acc[2], acc[3]), cvtpk(acc[4], acc[5]), cvtpk(acc[6], acc[7])}, (vu4*)dst);
            __builtin_nontemporal_store((vu4){cvtpk(acc[8], acc[9]), cvtpk(acc[10], acc[11]), cvtpk(acc[12], acc[13]), cvtpk(acc[14], acc[15])}, (vu4*)(dst + 8)); }
        if (wave < 4) { const int mt = wave >> 1, pb = wave & 1; f32x16_t acc = zero16(); acc = mma_lds<4>(acc, Mm + 32 * mt * GC_TS, GC_TS, XT + (hl * 64 + 32 * pb) * GC_TS, GC_TS, r32, hh);
#pragma unroll
            for (int e = 0; e < 16; ++e) { const int n = 32 * mt + (e & 3) + 8 * (e >> 2) + 4 * hh;
                p.OSb[((size_t)r0 + n) * MIX_W + hd * SSM_P + 32 * pb + r32] = f2bf(acc[e]); } }
        LDS_BARRIER();
    }
}
__device__ __forceinline__ void ssd_scan_wg(const Ptrs& p, LAS unsigned char* lds, int chain, int tid) {
    const int b = chain / (SSM_H * 2), hd = (chain >> 1) % SSM_H, dir = chain & 1, g = hd / SSM_HPG;
    const int lane = tid & 63, wave = tid >> 6, r32 = lane & 31, hh = lane >> 5;
    int zl = 0; asm volatile("v_mov_b32 %0, 0" : "=v"(zl));
    LAS bf16* hT = (LAS bf16*)lds;
    for (int i = tid; i < 64 * GC_KS / 2; i += 512) ((LAS unsigned*)hT)[i] = 0u;
    LDS_BARRIER();
    auto chunk_of = [&](int s) { return s < NCH_CTX ? (dir ? NCH_CTX - 1 - s : s) : NCH_CTX + (dir ? NCH - NCH_CTX - 1 - (s - NCH_CTX) : s - NCH_CTX); };
    using I0 = std::integral_constant<int, 0>; using I1 = std::integral_constant<int, 1>; using I2 = std::integral_constant<int, 2>; using I3 = std::integral_constant<int, 3>;
    if (wave >= 4) {
        __builtin_amdgcn_s_setprio(3);
        const int hw = wave - 4;
        f32x16_t h0 = zero16(), h1 = zero16();
        vu4 sc[4][4]; float dec[4] = {0.f, 0.f, 0.f, 0.f};
        auto pre_h = [&](int s, auto KC2) { constexpr int k = decltype(KC2)::value; const size_t u = (size_t)ssd_unit_index(b, chunk_of(s), hd, dir);
            const bf16* sp = p.SSC + ((u * 8 + 2 * hw) * 64 + lane) * 16; sc[k][0] = *(const vu4*)sp; sc[k][1] = *(const vu4*)(sp + 8); sc[k][2] = *(const vu4*)(sp + 1024); sc[k][3] = *(const vu4*)(sp + 1024 + 8); dec[k] = p.SDC[u + zl]; };
        auto step = [&](int s, auto KC) { constexpr int k = decltype(KC)::value;
            const unsigned w0[8] = {sc[k][0].x, sc[k][0].y, sc[k][0].z, sc[k][0].w, sc[k][1].x, sc[k][1].y, sc[k][1].z, sc[k][1].w}, w1[8] = {sc[k][2].x, sc[k][2].y, sc[k][2].z, sc[k][2].w, sc[k][3].x, sc[k][3].y, sc[k][3].z, sc[k][3].w};
            const float d1 = dec[k];
#pragma unroll
            for (int e2 = 0; e2 < 8; ++e2) { h0[2 * e2] = h0[2 * e2] * d1 + bflo(w0[e2]); h0[2 * e2 + 1] = h0[2 * e2 + 1] * d1 + bfhi(w0[e2]); h1[2 * e2] = h1[2 * e2] * d1 + bflo(w1[e2]); h1[2 * e2 + 1] = h1[2 * e2 + 1] * d1 + bfhi(w1[e2]); }
            if (s + 3 < NCH) pre_h(s + 3, std::integral_constant<int, (k + 3) % 4>{});
            LAS bf16* Hn = hT + ((s + 1) & 3) * 64 * GC_KS;
#pragma unroll
            for (int a4 = 0; a4 < 4; ++a4) { *(LAS vu2*)(Hn + r32 * GC_KS + 32 * hw + 8 * a4 + 4 * hh) = (vu2){cvtpk(h0[4 * a4], h0[4 * a4 + 1]), cvtpk(h0[4 * a4 + 2], h0[4 * a4 + 3])};
                *(LAS vu2*)(Hn + (32 + r32) * GC_KS + 32 * hw + 8 * a4 + 4 * hh) = (vu2){cvtpk(h1[4 * a4], h1[4 * a4 + 1]), cvtpk(h1[4 * a4 + 2], h1[4 * a4 + 3])}; }
            LDS_BARRIER(); };
        pre_h(0, I0{}); pre_h(1, I1{}); pre_h(2, I2{});
        for (int s = 0; s < NCH; s += 4) { step(s, I0{}); step(s + 1, I1{}); step(s + 2, I2{}); step(s + 3, I3{}); }
        __builtin_amdgcn_s_setprio(0);
    } else {
        const int mt = wave >> 1, pb = wave & 1;
        LAS bf16* otile = hT + 4 * 64 * GC_KS + wave * 32 * 40;
        bf16x8_t cf[3][8]; vu2 ea[3][4];
        auto pre_y = [&](int s, auto KC2) { constexpr int k = decltype(KC2)::value; const int c = chunk_of(s); const size_t u = (size_t)ssd_unit_index(b, c, hd, dir); const int r0 = chunk_row0(b, c);
            const bf16* cp = p.SCF + ((((size_t)(b * NCH + c) * SSM_G + g) * 2 + (dir ? 1 - mt : mt)) * 8) * 512 + (hh * 32 + (dir ? 31 - r32 : r32)) * 8;
#pragma unroll
            for (int q = 0; q < 8; ++q) cf[k][q] = *(const bf16x8_t*)(cp + q * 512);
#pragma unroll
            for (int a4 = 0; a4 < 4; ++a4) ea[k][a4] = *(const vu2*)(p.SEAb + u * 64 + 32 * mt + 8 * a4 + 4 * hh); };
        auto out_y = [&](int so, auto KC) { constexpr int k = decltype(KC)::value;
            const LAS bf16* Hc = hT + (so & 3) * 64 * GC_KS;
            f32x16_t acc = zero16(), acc2 = zero16();
#pragma unroll
            for (int qh = 0; qh < 2; ++qh) { bf16x8_t bq[4];
#pragma unroll
                for (int q = 0; q < 4; ++q) bq[q] = *(const LAS bf16x8_t*)(Hc + (32 * pb + r32) * GC_KS + 16 * (4 * qh + q) + 8 * hh);
#pragma unroll
                for (int q = 0; q < 4; q += 2) { acc = __builtin_amdgcn_mfma_f32_32x32x16_bf16(cf[k][4 * qh + q], bq[q], acc, 0, 0, 0); acc2 = __builtin_amdgcn_mfma_f32_32x32x16_bf16(cf[k][4 * qh + q + 1], bq[q + 1], acc2, 0, 0, 0); } }
            const int r0 = chunk_row0(b, chunk_of(so));
#pragma unroll
            for (int e = 0; e < 16; ++e) { const unsigned ew = (e & 2) ? ea[k][e >> 2].y : ea[k][e >> 2].x; const float ev = (e & 1) ? bfhi(ew) : bflo(ew); acc[e] = ev * (acc[e] + acc2[e]); }
            store_tile_rows(acc, otile, lane, [&](int il) { const int i = 32 * mt + il; return p.OSb2 + ((size_t)dir * MROWS + r0 + (dir ? 63 - i : i)) * MIX_W + hd * SSM_P + 32 * pb; }); };
        auto step = [&](int s, auto KC) { constexpr int k = decltype(KC)::value;
            if (s > 1) out_y(s - 2, std::integral_constant<int, (k + 1) % 3>{});
            if (s + 1 < NCH) pre_y(s + 1, std::integral_constant<int, (k + 1) % 3>{});
            LDS_BARRIER(); };
        pre_y(0, I0{});
        for (int s = 0; s + 2 < NCH; s += 3) { step(s, I0{}); step(s + 1, I1{}); step(s + 2, I2{}); }
        step(NCH - 2, std::integral_constant<int, (NCH - 2) % 3>{}); step(NCH - 1, std::integral_constant<int, (NCH - 1) % 3>{});
        out_y(NCH - 2, std::integral_constant<int, (NCH - 2) % 3>{}); out_y(NCH - 1, std::integral_constant<int, (NCH - 1) % 3>{});
    }
}


namespace pg8 {
struct EpiInProj {
    static constexpr bool PERM = true, AFTER_DRAIN = false, KHOOK = false;
    bf16_t* P; float* PF;
    __device__ __forceinline__ void operator()(const f32x4 (&acc)[2][2][4][2], const Unit& u, int wr, int wc, int fr, int fq) const {
        const int row0 = u.pm * BM + wr * 64 + fr;
        if (u.pn * BM < NP_MAIN) {
            const int col0 = u.pn * BM + wc * 32 + 8 * fq;
#pragma unroll
            for (int ai = 0; ai < 2; ++ai)
#pragma unroll
                for (int m = 0; m < 4; ++m) { bf16_t* rowp = P + (size_t)(row0 + ai * HALF + m * 16) * NP_MAIN + col0;
#pragma unroll
                    for (int bj = 0; bj < 2; ++bj) { const f32x4 v0 = acc[ai][bj][m][0], v1 = acc[ai][bj][m][1];
                        u32x4 w; w.x = cvt_pk_bf16(v0[0], v0[1]); w.y = cvt_pk_bf16(v0[2], v0[3]); w.z = cvt_pk_bf16(v1[0], v1[1]); w.w = cvt_pk_bf16(v1[2], v1[3]);
                        *(u32x4*)(rowp + bj * HALF) = w; } }
        } else {
#pragma unroll
            for (int ai = 0; ai < 2; ++ai)
#pragma unroll
                for (int m = 0; m < 4; ++m) { float* rowp = PF + (size_t)(row0 + ai * HALF + m * 16) * PF_N;
#pragma unroll
                    for (int bj = 0; bj < 2; ++bj) { const int c = bj * HALF + wc * 32 + 8 * fq;
                        if (c < PF_N) { *(f32x4*)(rowp + c) = acc[ai][bj][m][0]; *(f32x4*)(rowp + c + 4) = acc[ai][bj][m][1]; } } }
        }
    }
};
struct EpiMerge {
    static constexpr bool PERM = true, AFTER_DRAIN = false, KHOOK = false;
    const bf16_t* G0; bf16_t* TB;
    __device__ __forceinline__ void operator()(const f32x4 (&acc)[2][2][4][2], const Unit& u, int wr, int wc, int fr, int fq) const {
        const int row0 = u.pm * BM + wr * 64 + fr, col0 = u.pn * BM + wc * 32 + 8 * fq, br = u.pk / MIX_W; const bf16_t* G = G0 + br * D_MODEL;
#pragma unroll
        for (int ai = 0; ai < 2; ++ai)
#pragma unroll
            for (int m = 0; m < 4; ++m) { const size_t row = (size_t)(row0 + ai * HALF + m * 16);
#pragma unroll
                for (int bj = 0; bj < 2; ++bj) { const int col = col0 + bj * HALF;
                    const u32x4 gw = *(const u32x4*)(G + row * NP_MAIN + col);
                    float gt[8];
#pragma unroll
                    for (int j = 0; j < 4; ++j) { gt[2 * j] = __uint_as_float(gw[j] << 16); gt[2 * j + 1] = __uint_as_float(gw[j] & 0xffff0000u); }
                    f32x4 t0, t1;
#pragma unroll
                    for (int j = 0; j < 4; ++j) { t0[j] = acc[ai][bj][m][0][j] * __builtin_amdgcn_rcpf(1.0f + __expf(-gt[j])); t1[j] = acc[ai][bj][m][1][j] * __builtin_amdgcn_rcpf(1.0f + __expf(-gt[4 + j])); }
                    u32x4 w; w.x = cvt_pk_bf16(t0[0], t0[1]); w.y = cvt_pk_bf16(t0[2], t0[3]); w.z = cvt_pk_bf16(t1[0], t1[1]); w.w = cvt_pk_bf16(t1[2], t1[3]);
                    *(u32x4*)(TB + ((size_t)br * NCTX + (row - NLAT)) * D_MODEL + col) = w; } }
    }
};
struct EpiF32Plain {
    static constexpr bool PERM = false, AFTER_DRAIN = false, KHOOK = false;
    float* C; int ldc;
    __device__ __forceinline__ void operator()(const f32x4 (&acc)[2][2][4][2], const Unit& u, int wr, int wc, int fr, int fq) const {
        const int row0 = u.pm * BM + wr * 64 + fr, col0 = u.pn * BM + wc * 32 + 4 * fq;
#pragma unroll
        for (int ai = 0; ai < 2; ++ai)
#pragma unroll
            for (int m = 0; m < 4; ++m) { float* rowp = C + (size_t)(row0 + ai * HALF + m * 16) * ldc + col0;
#pragma unroll
                for (int bj = 0; bj < 2; ++bj)
#pragma unroll
                    for (int n = 0; n < 2; ++n) *(f32x4*)(rowp + bj * HALF + n * 16) = acc[ai][bj][m][n]; }
    }
};
struct EpiBf16Plain {
    static constexpr bool PERM = true, AFTER_DRAIN = false, KHOOK = false;
    bf16_t* O; int ldc;
    __device__ __forceinline__ void operator()(const f32x4 (&acc)[2][2][4][2], const Unit& u, int wr, int wc, int fr, int fq) const {
        const int row0 = u.pm * BM + wr * 64 + fr, col0 = u.pn * BM + wc * 32 + 8 * fq;
#pragma unroll
        for (int ai = 0; ai < 2; ++ai)
#pragma unroll
            for (int m = 0; m < 4; ++m) { bf16_t* rowp = O + (size_t)(row0 + ai * HALF + m * 16) * ldc + col0;
#pragma unroll
                for (int bj = 0; bj < 2; ++bj) { const f32x4 v0 = acc[ai][bj][m][0], v1 = acc[ai][bj][m][1];
                    u32x4 w; w.x = cvt_pk_bf16(v0[0], v0[1]); w.y = cvt_pk_bf16(v0[2], v0[3]); w.z = cvt_pk_bf16(v1[0], v1[1]); w.w = cvt_pk_bf16(v1[2], v1[3]);
                    *(u32x4*)(rowp + bj * HALF) = w; } }
    }
};

struct EpiAct {
    static constexpr bool PERM = true, AFTER_DRAIN = false, KHOOK = false;
    bf16_t* ACT; float* BP; bf16_t* BU; bf16_t* BG; const float* cw; const float* cb;
    __device__ __forceinline__ void operator()(const f32x4 (&acc)[2][2][4][2], const Unit& u, int wr, int wc, int fr, int fq) const {
        const int lp = (fq * 16 + ((fr + 15) & 15)) * 4, ln = (fq * 16 + ((fr + 1) & 15)) * 4;
#pragma unroll
        for (int n = 0; n < 2; ++n) {
            const int j0 = u.pn * 128 + wc * 32 + 8 * fq + 4 * n;
            const f32x4 w0 = *(const f32x4*)(cw + j0), w1 = *(const f32x4*)(cw + D_FF + j0), w2 = *(const f32x4*)(cw + 2 * D_FF + j0), bs = *(const f32x4*)(cb + j0);
#pragma unroll
            for (int ai = 0; ai < 2; ++ai) {
#pragma unroll
                for (int m = 0; m < 4; ++m) {
                    const int row = u.pm * BM + ai * HALF + wr * 64 + m * 16 + fr;
                    const bool hp = !(m == 0 && fr == 0), hn = !(m == 3 && fr == 15);
                    f32x4 gp, gn;
#pragma unroll
                    for (int e = 0; e < 4; ++e) { const float gc = acc[ai][1][m][n][e], gm = acc[ai][1][m > 0 ? m - 1 : 0][n][e], gq = acc[ai][1][m < 3 ? m + 1 : 3][n][e];
                        gp[e] = __int_as_float(__builtin_amdgcn_ds_bpermute(lp, __float_as_int(fr == 15 ? gm : gc)));
                        gn[e] = __int_as_float(__builtin_amdgcn_ds_bpermute(ln, __float_as_int(fr == 0 ? gq : gc))); }
                    const f32x4 g = acc[ai][1][m][n], uu = acc[ai][0][m][n];
                    f32x4 pre = w1 * g + bs;
                    if (hp) pre += w0 * gp;
                    if (hn) pre += w2 * gn;
                    if (hp && hn) {
                        f32x4 a;
#pragma unroll
                        for (int e = 0; e < 4; ++e) a[e] = pre[e] * __builtin_amdgcn_rcpf(1.0f + __expf(-pre[e])) * uu[e];
                        typedef unsigned u32x2 __attribute__((ext_vector_type(2)));
                        u32x2 w; w.x = cvt_pk_bf16(a[0], a[1]); w.y = cvt_pk_bf16(a[2], a[3]);
                        *(u32x2*)(ACT + (size_t)row * D_FF + j0) = w;
                    } else {
                        const size_t bi = (size_t)((row >> 6) * 2 + ((row & 63) == 63 ? 1 : 0)) * D_FF + j0;
                        typedef unsigned u32x2 __attribute__((ext_vector_type(2)));
                        *(f32x4*)(BP + bi) = pre;
                        u32x2 wu; wu.x = cvt_pk_bf16(uu[0], uu[1]); wu.y = cvt_pk_bf16(uu[2], uu[3]); *(u32x2*)(BU + bi) = wu;
                        u32x2 wg; wg.x = cvt_pk_bf16(g[0], g[1]); wg.y = cvt_pk_bf16(g[2], g[3]); *(u32x2*)(BG + bi) = wg;
                    }
                }
            }
        }
    }
};

constexpr int SPLIT_KS = 512, OUT_NS = D_MODEL / SPLIT_KS, DOWN_NS = D_FF / SPLIT_KS;
static_assert(D_MODEL % SPLIT_KS == 0 && D_FF % SPLIT_KS == 0 && NCTX % 256 == 0, "split-K context units");
struct SplitOrder {
    int ns, G, c;
    __device__ __forceinline__ bool next(int i, Unit& u) const { const int L = i * G + c; if (L >= (NCTX / 256) * (D_MODEL / 256) * ns) return false;
        const int ks = L % ns, tile = L / ns; u.pm = NLAT / 256 + tile / (D_MODEL / 256); u.pn = tile % (D_MODEL / 256); u.pk = ks * SPLIT_KS; return true; }
    __device__ __forceinline__ void a_ready(const Unit&) const {}
    __device__ __forceinline__ void done(const Unit&) const {}
};
struct SplitOrder3 {
    int G, c;
    __device__ __forceinline__ bool next(int i, Unit& u) const { const int L = i * G + c; constexpr int NT = (NCTX / 256) * (D_MODEL / 256); if (L >= NT * 3 * OUT_NS) return false;
        const int ks = L % OUT_NS, br = (L / OUT_NS) % 3, tile = L / (3 * OUT_NS); u.pm = br * (NCTX / 256) + tile / (D_MODEL / 256); u.pn = tile % (D_MODEL / 256); u.pk = ks * SPLIT_KS; return true; }
    __device__ __forceinline__ void a_ready(const Unit&) const {}
    __device__ __forceinline__ void done(const Unit&) const {}
};
struct EpiSlab3 {
    static constexpr bool PERM = false, AFTER_DRAIN = false, KHOOK = false;
    float* S;
    __device__ __forceinline__ void operator()(const f32x4 (&acc)[2][2][4][2], const Unit& u, int wr, int wc, int fr, int fq) const {
        const int br = u.pm / (NCTX / 256), ct = u.pm % (NCTX / 256);
        const int row0 = ct * BM + wr * 64 + fr, col0 = u.pn * BM + wc * 32 + 4 * fq; float* base = S + (size_t)(br * OUT_NS + u.pk / SPLIT_KS) * NCTX * D_MODEL;
#pragma unroll
        for (int ai = 0; ai < 2; ++ai)
#pragma unroll
            for (int m = 0; m < 4; ++m) { float* rowp = base + (size_t)(row0 + ai * HALF + m * 16) * D_MODEL + col0;
#pragma unroll
                for (int bj = 0; bj < 2; ++bj)
#pragma unroll
                    for (int n = 0; n < 2; ++n) *(f32x4*)(rowp + bj * HALF + n * 16) = acc[ai][bj][m][n]; }
    }
};

struct EpiMerge3 {
    static constexpr bool PERM = true, AFTER_DRAIN = false, KHOOK = true;
    const bf16_t* G0; bf16_t* MB;
    __device__ __forceinline__ void khook(f32x4 (&acc)[2][2][4][2], const Unit& u, int t, int wr, int wc, int fr, int fq) const {
        if (t != MIX_W / BK && t != 2 * MIX_W / BK) return;
        const int bp = t / (MIX_W / BK) - 1;
        const int row0 = u.pm * BM + wr * 64 + fr, col0 = u.pn * BM + wc * 32 + 8 * fq; const bf16_t* Gp = G0 + bp * D_MODEL;
#pragma unroll
        for (int ai = 0; ai < 2; ++ai) {
            asm volatile("" ::: "memory");
#pragma unroll
            for (int m = 0; m < 4; ++m) { const unsigned rowo = (unsigned)(row0 + ai * HALF + m * 16) * (unsigned)NP_MAIN;
#pragma unroll
                for (int bj = 0; bj < 2; ++bj) { const unsigned off = rowo + (unsigned)(col0 + bj * HALF);
                    const u32x4 gp = *(const u32x4*)(Gp + off), gn = *(const u32x4*)(Gp + D_MODEL + off);
#pragma unroll
                    for (int j = 0; j < 4; ++j) { const float p0 = __uint_as_float(gp[j] << 16), p1 = __uint_as_float(gp[j] & 0xffff0000u), n0 = __uint_as_float(gn[j] << 16), n1 = __uint_as_float(gn[j] & 0xffff0000u);
                        const float r0 = (1.0f + __expf(-n0)) * __builtin_amdgcn_rcpf(1.0f + __expf(-p0)), r1 = (1.0f + __expf(-n1)) * __builtin_amdgcn_rcpf(1.0f + __expf(-p1));
                        if (j < 2) { acc[ai][bj][m][0][2 * j] *= r0; acc[ai][bj][m][0][2 * j + 1] *= r1; } else { acc[ai][bj][m][1][2 * (j - 2)] *= r0; acc[ai][bj][m][1][2 * (j - 2) + 1] *= r1; } } } } }
    }
    __device__ __forceinline__ void operator()(const f32x4 (&acc)[2][2][4][2], const Unit& u, int wr, int wc, int fr, int fq) const {
        const int row0 = u.pm * BM + wr * 64 + fr, col0 = u.pn * BM + wc * 32 + 8 * fq; const bf16_t* G = G0 + 2 * D_MODEL;
#pragma unroll
        for (int ai = 0; ai < 2; ++ai)
#pragma unroll
            for (int m = 0; m < 4; ++m) { const size_t row = (size_t)(row0 + ai * HALF + m * 16);
#pragma unroll
                for (int bj = 0; bj < 2; ++bj) { const int col = col0 + bj * HALF;
                    const u32x4 gw = *(const u32x4*)(G + row * NP_MAIN + col);
                    float gt[8];
#pragma unroll
                    for (int j = 0; j < 4; ++j) { gt[2 * j] = __uint_as_float(gw[j] << 16); gt[2 * j + 1] = __uint_as_float(gw[j] & 0xffff0000u); }
                    f32x4 t0, t1;
#pragma unroll
                    for (int j = 0; j < 4; ++j) { t0[j] = acc[ai][bj][m][0][j] * __builtin_amdgcn_rcpf(1.0f + __expf(-gt[j])); t1[j] = acc[ai][bj][m][1][j] * __builtin_amdgcn_rcpf(1.0f + __expf(-gt[4 + j])); }
                    u32x4 w; w.x = cvt_pk_bf16(t0[0], t0[1]); w.y = cvt_pk_bf16(t0[2], t0[3]); w.z = cvt_pk_bf16(t1[0], t1[1]); w.w = cvt_pk_bf16(t1[2], t1[3]);
                    *(u32x4*)(MB + row * D_MODEL + col) = w; } }
    }
};
struct CtxMergeOrder {
    int c;
    __device__ __forceinline__ bool next(int i, Unit& u) const { if (i > 0 || c >= 3 * (NCTX / 256) * (D_MODEL / 256)) return false;
        const int tile = c / 3; u.pm = NLAT / 256 + tile / (D_MODEL / 256); u.pn = tile % (D_MODEL / 256); u.pk = (c % 3) * MIX_W; return true; }
    __device__ __forceinline__ void a_ready(const Unit&) const {}
    __device__ __forceinline__ void done(const Unit&) const {}
};
struct EpiSlab {
    static constexpr bool PERM = false, AFTER_DRAIN = false, KHOOK = false;
    float* S;
    __device__ __forceinline__ void operator()(const f32x4 (&acc)[2][2][4][2], const Unit& u, int wr, int wc, int fr, int fq) const {
        const int row0 = (u.pm * BM - NLAT) + wr * 64 + fr, col0 = u.pn * BM + wc * 32 + 4 * fq; float* base = S + (size_t)(u.pk / SPLIT_KS) * NCTX * D_MODEL;
#pragma unroll
        for (int ai = 0; ai < 2; ++ai)
#pragma unroll
            for (int m = 0; m < 4; ++m) { float* rowp = base + (size_t)(row0 + ai * HALF + m * 16) * D_MODEL + col0;
#pragma unroll
                for (int bj = 0; bj < 2; ++bj)
#pragma unroll
                    for (int n = 0; n < 2; ++n) *(f32x4*)(rowp + bj * HALF + n * 16) = acc[ai][bj][m][n]; }
    }
};
}

constexpr size_t al256(size_t x) { return (x + 255) & ~(size_t)255; }
constexpr size_t WS_CTL = 0, CTL_BYTES = 1u << 20;
constexpr size_t WS_WIN = WS_CTL + CTL_BYTES;
constexpr size_t WS_WBR = WS_WIN + al256((size_t)DEPTH * NP_PAD * D_MODEL * 2);
constexpr size_t WS_WOUT = WS_WBR + al256((size_t)DEPTH * 3 * D_MODEL * MIX_W * 2);
constexpr size_t WS_WUP = WS_WOUT + al256((size_t)DEPTH * D_MODEL * D_MODEL * 2);
constexpr size_t WS_WDOWN = WS_WUP + al256((size_t)DEPTH * 2 * D_FF * D_MODEL * 2);
constexpr size_t WS_MOD = WS_WDOWN + al256((size_t)DEPTH * D_MODEL * D_FF * 2);
constexpr size_t WS_X = WS_MOD + al256((size_t)DEPTH * (BATCH + 1) * D6 * 4 + GRID_W * 32 * 2 * 4);
constexpr size_t WS_H = WS_X + al256((size_t)MROWS * D_MODEL * 4);
constexpr size_t WS_MIX = WS_H + al256((size_t)MROWS * D_MODEL * 2);
constexpr size_t WS_SLAB = WS_MIX + al256((size_t)MROWS * D_MODEL * 4);
constexpr size_t WS_TB = WS_SLAB + al256((size_t)(D_FF / 512 > 12 ? D_FF / 512 : 12) * NCTX * D_MODEL * 4);
constexpr size_t WS_R = WS_TB + al256((size_t)3 * NCTX * D_MODEL * 2);
constexpr size_t WS_P = WS_R;
constexpr size_t WS_PF = WS_P + al256((size_t)MROWS * NP_MAIN * 2);
constexpr size_t WS_GQKV = WS_PF + al256((size_t)MROWS * PF_N * 4);
#if defined(TOKEN_GDN) || defined(NAIVE_PREP)
constexpr size_t WS_GG = WS_GQKV + al256((size_t)MROWS * 3 * MIX_W * 4);
#else
constexpr size_t WS_GG = WS_GQKV + 256;
#endif
constexpr size_t WS_GB = WS_GG + al256((size_t)MROWS * 2 * GDN_H * 4);
constexpr size_t WS_SXBC = WS_GB + al256((size_t)MROWS * 2 * GDN_H * 4);
#if defined(TOKEN_SSD) || defined(NAIVE_PREP)
constexpr size_t WS_SDT = WS_SXBC + al256((size_t)MROWS * SSM_XBC * 4);
#else
constexpr size_t WS_SDT = WS_SXBC + 256;
#endif
constexpr size_t WS_SA = WS_SDT + al256((size_t)MROWS * 2 * SSM_H * 4);
constexpr size_t WS_AQ = WS_SA + al256((size_t)MROWS * 2 * SSM_H * 4);
#ifdef NAIVE_ATTN
constexpr size_t WS_AK = WS_AQ + al256((size_t)MROWS * MIX_W * 4);
constexpr size_t WS_OG = WS_AK + al256((size_t)MROWS * ATT_HKV * 128 * 4);
#else
constexpr size_t WS_AK = WS_AQ + 256;
constexpr size_t WS_OG = WS_AK + 256;
#endif
#if defined(TOKEN_GDN) || defined(TOKEN_SSD) || defined(NAIVE_MIXOUT)
constexpr size_t WS_OS = WS_OG + al256((size_t)2 * MROWS * MIX_W * 4);
constexpr size_t WS_SC = WS_OS + al256((size_t)2 * MROWS * MIX_W * 4);
#else
constexpr size_t WS_OS = WS_OG + 256;
constexpr size_t WS_SC = WS_OS + 256;
#endif
#ifdef NAIVE_ATTN
constexpr size_t WS_YA = WS_SC + al256((size_t)MROWS * ATT_HQ * SC_LD * 4);
#else
constexpr size_t WS_YA = WS_SC + 256;
#endif
constexpr size_t WS_YB = WS_YA + al256((size_t)MROWS * MIX_W * 2);
constexpr size_t WS_YC = WS_YB + al256((size_t)MROWS * MIX_W * 2);
constexpr size_t WS_M32 = WS_YC + al256((size_t)MROWS * MIX_W * 2);
constexpr size_t WS_MB = WS_M32 + al256((size_t)MROWS * D_MODEL * 4);
constexpr size_t WS_AQB = WS_MB + al256((size_t)MROWS * D_MODEL * 2);
constexpr size_t WS_AKB = WS_AQB + al256((size_t)MROWS * MIX_W * 2);
constexpr size_t GDN_NU_H = (size_t)BATCH * (CHAIN_LEN / 64) * GDN_H * 2;
constexpr size_t WS_GW = WS_AKB + al256((size_t)MROWS * ATT_HKV * 128 * 2);
constexpr size_t WS_GQD = WS_GW + al256(GDN_NU_H * 64 * 128 * 2);
constexpr size_t WS_GKDT = WS_GQD + al256(GDN_NU_H * 64 * 128 * 2);
constexpr size_t WS_GA = WS_GKDT + al256(GDN_NU_H * 128 * 64 * 2);
constexpr size_t WS_GUT = WS_GA + al256(GDN_NU_H * 64 * 64 * 2);
constexpr size_t WS_GGL = WS_GUT + al256(GDN_NU_H * 128 * 64 * 2);
constexpr size_t SSD_NU_H = (size_t)BATCH * (CHAIN_LEN / 64) * SSM_H * 2;
constexpr size_t WS_SBCB = WS_GGL + al256(GDN_NU_H * 4);
constexpr size_t WS_SSC = WS_SBCB + al256((size_t)MROWS * 2 * SSM_BC * 2);
constexpr size_t WS_SEA = WS_SSC + al256(SSD_NU_H * 8 * 64 * 16 * 2);
constexpr size_t WS_SDC = WS_SEA + al256(SSD_NU_H * 64 * 4);
constexpr size_t WS_OGB = WS_SDC + al256(SSD_NU_H * 4);
constexpr size_t WS_OSB = WS_OGB + al256((size_t)2 * MROWS * MIX_W * 2);
constexpr size_t WS_OSB2 = WS_OSB + al256((size_t)2 * MROWS * MIX_W * 2);
constexpr size_t WS_GQKVB = WS_OSB2 + al256((size_t)2 * MROWS * MIX_W * 2);
constexpr size_t WS_SXB = WS_GQKVB + al256((size_t)MROWS * 3 * MIX_W * 2);
constexpr size_t WS_SCF = WS_SXB + al256((size_t)MROWS * MIX_W * 2);
constexpr size_t WS_END_MIX = WS_SCF + al256((size_t)BATCH * (CHAIN_LEN / 64) * SSM_G * 2 * 8 * 512 * 2);
constexpr size_t NBND = (size_t)MROWS / 64 * 2;
constexpr size_t WS_BP = WS_R;
constexpr size_t WS_BU = WS_BP + al256(NBND * D_FF * 4);
constexpr size_t WS_BG = WS_BU + al256(NBND * D_FF * 2);
constexpr size_t WS_ACT = WS_BG + al256(NBND * D_FF * 2);
constexpr size_t WS_END_FFN = WS_ACT + al256((size_t)MROWS * D_FF * 2);
constexpr size_t WS_NEED = WS_END_MIX > WS_END_FFN ? WS_END_MIX : WS_END_FFN;

constexpr int NWAVES = 8, NTHREADS = NWAVES * 64;
#ifndef ATT_EARLY_N
#define ATT_EARLY_N 0
#endif
constexpr int ATT_EARLY = ATT_EARLY_N;
static_assert(ATT_EARLY <= ATT_UNITS_LAT, "early attention units are latent units");
constexpr int RING_BYTES = 131072, LDS_BYTES = 147456, MISC_OFF = LDS_BYTES - 1024;

enum { ST_INPROJ = 0, ST_PREP, ST_G1, ST_MIX, ST_MIXOUT, ST_MERGE, ST_OUT, ST_NORM2, ST_UP, ST_ACT, ST_DOWN, ST_NORM3, NSTEP };
constexpr int STEP0 = 2;
constexpr int TOTAL_STEPS = STEP0 + DEPTH * NSTEP;
#ifndef MK_LAUNCH_MODE
#define MK_LAUNCH_MODE 1
#endif

struct Args { Ptrs p; unsigned* ctl; int step_lo, step_hi; };
typedef const __attribute__((address_space(4))) Args* KArgs;
__device__ __forceinline__ KArgs fresh_args() { KArgs k = (KArgs)__builtin_amdgcn_kernarg_segment_ptr(); asm volatile("" : "+s"(k)); return k; }
#if defined(__HIP_DEVICE_COMPILE__)
#define PTRS() const Ptrs p = fresh_args()->p; int lane; asm volatile("v_mbcnt_lo_u32_b32 %0, -1, 0\n\tv_mbcnt_hi_u32_b32 %0, -1, %0" : "=v"(lane)); const int wave = wave_s; const int tid = wave * 64 + lane; \
    const size_t gtid = (size_t)blockIdx.x * NTHREADS + tid, NT = (size_t)G * NTHREADS; const int gwave = (int)blockIdx.x * NWAVES + wave, NGW = G * NWAVES; (void)lane; (void)wave; (void)gtid; (void)NT; (void)gwave; (void)NGW
#else
#define PTRS() const Ptrs p = a.p; const int tid = 0, lane = 0, wave = 0, gwave = 0, NGW = 1; const size_t gtid = 0, NT = 1; (void)tid; (void)lane; (void)wave; (void)gtid; (void)NT; (void)gwave; (void)NGW
#endif

constexpr int WT_I_IN = (D_MODEL / 64) * (P_IN / 32), WT_I_BR = (MIX_W / 64) * (D_MODEL / 32), WT_I_OUT = (D_MODEL / 64) * (D_MODEL / 32), WT_I_UP = (D_MODEL / 64) * (2 * D_FF / 32), WT_I_DN = (D_FF / 64) * (D_MODEL / 32);
constexpr int WT_I_ALL = WT_I_IN + 3 * WT_I_BR + WT_I_OUT + WT_I_UP + WT_I_DN;
template <class PT> __device__ __forceinline__ void weight_item(const PT& p, int l, int it, LAS float* scr, int lane) {
    int r = it;
    if (r < WT_I_IN) { const int nblk = P_IN / 32, k0 = 64 * (r / nblk), n0 = 32 * (r % nblk);
        transpose_item(p.w_in + (size_t)l * D_MODEL * P_IN, D_MODEL, P_IN, p.Wt_in + (size_t)l * NP_PAD * D_MODEL, k0, n0, inproj_dst_row0(n0), scr, lane); return; } r -= WT_I_IN;
    if (r < 3 * WT_I_BR) { const int br = r / WT_I_BR; r -= br * WT_I_BR; const int nblk = D_MODEL / 32, k0 = 64 * (r / nblk), n0 = 32 * (r % nblk);
        const float* w = (br == 0 ? p.w_br_a : br == 1 ? p.w_br_b : p.w_br_c) + (size_t)l * MIX_W * D_MODEL;
        transpose_item(w, 3 * MIX_W, D_MODEL, p.Wt_br + (size_t)l * 3 * D_MODEL * MIX_W + br * MIX_W, k0, n0, n0, scr, lane); return; } r -= 3 * WT_I_BR;
    if (r < WT_I_OUT) { const int nblk = D_MODEL / 32, k0 = 64 * (r / nblk), n0 = 32 * (r % nblk);
        transpose_item(p.w_out + (size_t)l * D_MODEL * D_MODEL, D_MODEL, D_MODEL, p.Wt_out + (size_t)l * D_MODEL * D_MODEL, k0, n0, n0, scr, lane); return; } r -= WT_I_OUT;
    if (r < WT_I_UP) { const int nblk = 2 * D_FF / 32, k0 = 64 * (r / nblk), n0 = 32 * (r % nblk);
        transpose_item(p.w_up + (size_t)l * D_MODEL * 2 * D_FF, D_MODEL, 2 * D_FF, p.Wt_up + (size_t)l * 2 * D_FF * D_MODEL, k0, n0, up_dst_row0(n0), scr, lane); return; } r -= WT_I_UP;
    { const int nblk = D_MODEL / 32, k0 = 64 * (r / nblk), n0 = 32 * (r % nblk);
        transpose_item(p.w_down + (size_t)l * D_FF * D_MODEL, D_FF, D_MODEL, p.Wt_down + (size_t)l * D_MODEL * D_FF, k0, n0, n0, scr, lane); }
}
template <class PT> __device__ __forceinline__ WtDesc weight_desc(const PT& p, int l, int it) {
    int r = it;
    if (r < WT_I_IN) { const int nblk = P_IN / 32, k0 = 64 * (r / nblk), n0 = 32 * (r % nblk); return WtDesc{p.w_in + (size_t)l * D_MODEL * P_IN, p.Wt_in + (size_t)l * NP_PAD * D_MODEL, D_MODEL, P_IN, k0, n0, inproj_dst_row0(n0)}; } r -= WT_I_IN;
    if (r < 3 * WT_I_BR) { const int br = r / WT_I_BR; r -= br * WT_I_BR; const int nblk = D_MODEL / 32, k0 = 64 * (r / nblk), n0 = 32 * (r % nblk);
        const float* w = (br == 0 ? p.w_br_a : br == 1 ? p.w_br_b : p.w_br_c) + (size_t)l * MIX_W * D_MODEL;
        return WtDesc{w, p.Wt_br + (size_t)l * 3 * D_MODEL * MIX_W + br * MIX_W, 3 * MIX_W, D_MODEL, k0, n0, n0}; } r -= 3 * WT_I_BR;
    if (r < WT_I_OUT) { const int nblk = D_MODEL / 32, k0 = 64 * (r / nblk), n0 = 32 * (r % nblk); return WtDesc{p.w_out + (size_t)l * D_MODEL * D_MODEL, p.Wt_out + (size_t)l * D_MODEL * D_MODEL, D_MODEL, D_MODEL, k0, n0, n0}; } r -= WT_I_OUT;
    if (r < WT_I_UP) { const int nblk = 2 * D_FF / 32, k0 = 64 * (r / nblk), n0 = 32 * (r % nblk); return WtDesc{p.w_up + (size_t)l * D_MODEL * 2 * D_FF, p.Wt_up + (size_t)l * 2 * D_FF * D_MODEL, D_MODEL, 2 * D_FF, k0, n0, up_dst_row0(n0)}; } r -= WT_I_UP;
    { const int nblk = D_MODEL / 32, k0 = 64 * (r / nblk), n0 = 32 * (r % nblk); return WtDesc{p.w_down + (size_t)l * D_FF * D_MODEL, p.Wt_down + (size_t)l * D_MODEL * D_FF, D_FF, D_MODEL, k0, n0, n0}; }
}
constexpr int FILL_A0 = ((MROWS / 256) * (NP_PAD / 256)) % 256, FILL_B0 = 3 * (NCTX / 256) * (D_MODEL / 256), FILL_C0 = ((MROWS / 256) * (2 * D_FF / 256)) % 256;
#ifndef FILL_NA
#define FILL_NA 14
#endif
#ifndef FILL_NB
#define FILL_NB 11
#endif
#ifndef FILL_NC
#define FILL_NC 19
#endif
constexpr int fill_min(int a, int b) { return a < b ? a : b; }
constexpr int WT_OWN = WT_I_ALL - WT_I_IN;
#ifndef FILL_NM
#define FILL_NM 512
#endif
constexpr int FILL_MCH = 16;
constexpr int FILL_EA = fill_min((256 - FILL_A0) * 8 * FILL_NA, WT_I_ALL), FILL_EM = fill_min(FILL_EA + FILL_NM * FILL_MCH, WT_I_ALL), FILL_EB = fill_min(FILL_EM + (256 - FILL_B0) * 8 * FILL_NB, WT_I_ALL), FILL_EC = fill_min(FILL_EB + (256 - FILL_C0) * 8 * FILL_NC, WT_I_ALL);
static_assert(FILL_A0 > 0 && FILL_C0 > 0, "fill slots");
static_assert(FILL_EM >= 3 * WT_I_BR && FILL_EB >= 3 * WT_I_BR + WT_I_OUT + WT_I_UP && FILL_EC >= WT_OWN, "a matrix must be complete before the phase that multiplies by it (branch: merge; up: up-projection; down: within the layer)");
static_assert(64 * 33 <= 2176 && 8 * 4352 * 4 <= 146432 - 1024, "fill scratch: two transpose tiles per wave inside the dynamic LDS below the control words");
__device__ __forceinline__ void weight_fill_ws(int l, int seg_b, int seg_e_in, int ws, int nws, LAS unsigned char* lds, int wv) {
#if defined(__HIP_DEVICE_COMPILE__)
    asm volatile("s_waitcnt vmcnt(0)" ::: "memory"); LDS_BARRIER();
    int l_; asm volatile("v_mbcnt_lo_u32_b32 %0, -1, 0\n\tv_mbcnt_hi_u32_b32 %0, -1, %0" : "=v"(l_));
    const int seg_e = (l == DEPTH - 1 && seg_e_in > WT_OWN) ? WT_OWN : seg_e_in;
#define WT_AT(f_) weight_desc(fresh_args()->p, (f_) < WT_OWN ? l : l + 1, (f_) < WT_OWN ? WT_I_IN + (f_) : (f_) - WT_OWN)
    LAS float* scr = (LAS float*)lds + wv * 4352;
    int it = seg_b + ws;
    if (it < seg_e) { float wa[32], wb[32]; WtDesc da = WT_AT(it), db = da; transpose_load(da, l_, wa);
        for (;;) { const int it2 = it + nws; const bool h2 = it2 < seg_e;
            if (h2) { db = WT_AT(it2); transpose_load(db, l_, wb); }
            transpose_finish(da, wa, scr, l_);
            if (!h2) break;
            const int it3 = it2 + nws; const bool h3 = it3 < seg_e;
            if (h3) { da = WT_AT(it3); transpose_load(da, l_, wa); }
            transpose_finish(db, wb, scr + 2176, l_);
            if (!h3) break;
            it = it3; } }
#undef WT_AT
    LDS_BARRIER();
#endif
}
__device__ __forceinline__ void weight_fill(int l, int seg_b, int seg_e, int wg0, LAS unsigned char* lds, int wv) { weight_fill_ws(l, seg_b, seg_e, ((int)blockIdx.x - wg0) * 8 + wv, (256 - wg0) * 8, lds, wv); }
__global__ void __launch_bounds__(NTHREADS, 2) fwd(Args a) {
    extern __shared__ __attribute__((aligned(16))) unsigned char lds_raw[];
    LAS unsigned char* lds = (LAS unsigned char*)lds_raw;
    volatile LAS unsigned* MISC = (volatile LAS unsigned*)(lds + MISC_OFF);
    const int G = gridDim.x;
    const int wave_s = __builtin_amdgcn_readfirstlane((int)threadIdx.x >> 6);
    for (int u = threadIdx.x; u < (LDS_BYTES - MISC_OFF) / 4; u += NTHREADS) ((LAS unsigned*)(lds + MISC_OFF))[u] = 0u;
    __syncthreads();
    const bool multi = (a.step_hi - a.step_lo) > 1;
    if (multi) (void)xcd_barrier_post(a.ctl + 4096, MISC + 8);
#define IN(k) (fresh_args()->step_lo <= (k) && (k) < fresh_args()->step_hi)
#ifdef ONLY_STEP
#define EN(k) ((k) == ONLY_STEP)
#elif defined(SKIP_MASK)
#define EN(k) (!((SKIP_MASK >> (k)) & 1))
#else
#define EN(k) true
#endif
#define SEAM(k) do { if (IN((k) + 1)) { XcdBarrier bl; bl.bar = fresh_args()->ctl + 4096; bl.x = xb_xcc_id(); bl.st = (volatile LAS unsigned*)(lds + MISC_OFF) + 8; xcd_barrier(bl); } } while (0)
#define FOR_ITEMS(i, n) for (size_t i = gtid; i < (size_t)(n); i += NT)
#define FRESH_TID(name) int name; { int l_; asm volatile("v_mbcnt_lo_u32_b32 %0, -1, 0\n\tv_mbcnt_hi_u32_b32 %0, -1, %0" : "=v"(l_)); name = wave_s * 64 + l_; }

    if (EN(0) && IN(0)) {
        PTRS();
        LAS float* scr = (LAS float*)lds + wave * 4096;
        FOR_ITEMS(i, (size_t)GRID_W * 32) { const float ang = (float)(i >> 5) * rope_inv_freq((int)(i & 31)); p.ROPE[2 * i] = cosf(ang); p.ROPE[2 * i + 1] = sinf(ang); }
#ifdef FILL_OFF
        for (int l = 0; l < DEPTH; ++l) for (int it = gwave; it < WT_I_ALL; it += NGW) weight_item(fresh_args()->p, l, it, scr, lane);
#else
        for (int it = gwave; it < WT_I_IN; it += NGW) weight_item(fresh_args()->p, 0, it, scr, lane);
        for (int l = 1; l < DEPTH; ++l) for (int it = FILL_EC - WT_OWN + gwave; it < WT_I_IN; it += NGW) weight_item(fresh_args()->p, l, it, scr, lane);
#endif
        for (int l = 0; l < DEPTH; ++l) {
            { bf16* z = p.Wt_in + ((size_t)l * NP_PAD + NP_MAIN + PF_N) * D_MODEL; const size_t n16 = (size_t)(NP_PAD - NP_MAIN - PF_N) * D_MODEL / 8;
                FOR_ITEMS(i, n16) *(vu4*)(z + i * 8) = (vu4){0u, 0u, 0u, 0u}; }
        }
        __syncthreads();
        LAS float* sl = (LAS float*)lds;
        LAS float* red = sl + 3 * D_MODEL;
        for (int i = tid; i < (BATCH + 1) * D_MODEL; i += NTHREADS) sl[i] = silu_f(i < BATCH * D_MODEL ? p.c[i] : p.c_ctx[i - BATCH * D_MODEL]);
        __syncthreads();
        for (int it = (int)blockIdx.x; it < DEPTH * (D6 / 64); it += G) {
            const int l = it / (D6 / 64), n0 = (it % (D6 / 64)) * 64;
            float acc0 = 0.f, acc1 = 0.f, acc2 = 0.f;
            const float* w = p.w_ada + ((size_t)l * D_MODEL + wave * (D_MODEL / 8)) * D6 + n0 + lane;
            for (int k0 = 0; k0 < D_MODEL / 8; k0 += 32) { float wv[32];
#pragma unroll
                for (int j = 0; j < 32; ++j) wv[j] = __builtin_nontemporal_load(w + (size_t)(k0 + j) * D6);
#pragma unroll
                for (int j = 0; j < 32; ++j) { const int kk = wave * (D_MODEL / 8) + k0 + j; acc0 += sl[kk] * wv[j]; acc1 += sl[D_MODEL + kk] * wv[j]; acc2 += sl[2 * D_MODEL + kk] * wv[j]; } }
            red[(wave * 3 + 0) * 64 + lane] = acc0; red[(wave * 3 + 1) * 64 + lane] = acc1; red[(wave * 3 + 2) * 64 + lane] = acc2;
            __syncthreads();
            if (tid < 192) { const int m = tid >> 6, ln = tid & 63; float s = 0.f;
#pragma unroll
                for (int w8 = 0; w8 < 8; ++w8) s += red[(w8 * 3 + m) * 64 + ln];
                p.MOD[((size_t)l * (BATCH + 1) + m) * D6 + n0 + ln] = s + p.b_ada[(size_t)l * D6 + n0 + ln]; }
            __syncthreads();
        }
        SEAM(0);
    }
    if (EN(1) && IN(1)) {
        PTRS();
        for (int r = gwave; r < MROWS; r += NGW) { vf4 x[NV4]; row_load(r < NLAT ? p.x + (size_t)r * D_MODEL : p.ctx + (size_t)(r - NLAT) * D_MODEL, lane, x);
            norm_h_wave(p, 0, r, 0, lane, x); }
        SEAM(1);
    }

    for (int l = 0; l < DEPTH; ++l) {
        const int sb = STEP0 + l * NSTEP;
        if (sb + NSTEP <= fresh_args()->step_lo || sb >= fresh_args()->step_hi) continue;
        const bool last = (l == DEPTH - 1);
        const int MR = last ? NLAT : MROWS;

        if (EN(2 + ST_INPROJ) && IN(sb + ST_INPROJ)) {
            PTRS();
            pg8::Gemm g{p.H, p.Wt_in + (size_t)l * NP_PAD * D_MODEL, MROWS, NP_PAD, D_MODEL, D_MODEL}; pg8::StaticOrder S; S.init(MROWS, NP_PAD, G, (int)blockIdx.x);
            pg8::EpiInProj E{p.P, p.PF};
            pg8::gemm_phase<pg8::EpiInProj, pg8::StaticOrder, true, true>(lds, g, S, E, tid);
#ifndef FILL_OFF
            if ((int)blockIdx.x >= FILL_A0) weight_fill(l, 0, FILL_EA, FILL_A0, lds, wave_s);
#endif
            SEAM(sb + ST_INPROJ);
        }

        if (EN(2 + ST_PREP) && IN(sb + ST_PREP)) {
            PTRS();
#ifdef NAIVE_PREP
            FOR_ITEMS(i, (size_t)MROWS * 3 * GDN_H) prep_gdn_item(p, l, (int)(i / (3 * GDN_H)), (int)(i % (3 * GDN_H)));
            FOR_ITEMS(i, (size_t)MROWS * 2 * GDN_H) prep_gdn_gb_item(p, l, (int)(i / (2 * GDN_H)), (int)(i % (2 * GDN_H)));
            FOR_ITEMS(i, (size_t)MROWS * SSM_XBC) prep_ssd_item(p, l, (int)(i / SSM_XBC), (int)(i % SSM_XBC));
            FOR_ITEMS(i, (size_t)MROWS * 2 * SSM_H) prep_ssd_dt_item(p, l, (int)(i / (2 * SSM_H)), (int)(i % (2 * SSM_H)));
#else
            for (int it = gwave; it < (MROWS / PREP_RB) * PREP_NPASS; it += NGW) prep_conv_block_wave(p, l, it / PREP_NPASS, it % PREP_NPASS, lane);
#endif
#ifdef NAIVE_ATTN
            FOR_ITEMS(i, (size_t)MROWS * (ATT_HQ + ATT_HKV)) prep_attn_item(p, (int)(i / (ATT_HQ + ATT_HKV)), (int)(i % (ATT_HQ + ATT_HKV)));
#endif
            SEAM(sb + ST_PREP);
        }

        if (EN(2 + ST_G1) && IN(sb + ST_G1)) {
            PTRS();
            {
                constexpr int NG = BATCH * NCH * GDN_H, NS = SSD_LOCAL_UNITS; unsigned* ctr = fresh_args()->ctl + 8192 + 64 * (DEPTH + l);
                for (;;) { if (tid == 0) MISC[16] = __hip_atomic_fetch_add(ctr, 1u, __ATOMIC_RELAXED, __HIP_MEMORY_SCOPE_AGENT);
                    LDS_BARRIER(); const int u = (int)MISC[16]; LDS_BARRIER();
                    if (u >= NG + NS + ATT_EARLY) break;
                    int tl = tid; asm volatile("" : "+v"(tl));
                    if (u < ATT_EARLY) attn_unit(p, l, (LAS bf16*)lds, u, tl);
                    else if (u < ATT_EARLY + NS) ssd_local_unit(p, lds, u - ATT_EARLY, tl); else gdn_g1_unit(p, lds, u - ATT_EARLY - NS, tl); } }
            SEAM(sb + ST_G1);
        }

        if (EN(2 + ST_MIX) && IN(sb + ST_MIX)) {
            PTRS();
            constexpr int N_GDN_WG = BATCH * GDN_H * 2 * 4, N_SSD_WG = BATCH * SSM_H * 2;
            const int wg = (int)blockIdx.x;
#ifdef TOKEN_GDN
            if (wg < N_GDN_WG) gdn_token_wg(p, (LAS float*)lds, wg >> 2, wg & 3, tid);
#else
            if (wg < N_GDN_WG) gdn_scan_wg(p, lds, (wg & 7) + 8 * (wg >> 5), (wg >> 3) & 3, tid);
#endif
#ifdef TOKEN_SSD
            else if (wg < N_GDN_WG + N_SSD_WG) ssd_token_wg(p, (LAS float*)lds, wg - N_GDN_WG, tid);
#else
            else if (wg < N_GDN_WG + N_SSD_WG) ssd_scan_wg(p, lds, wg - N_GDN_WG, tid);
#endif
            {
                const int nu = ATT_UNITS_LAT + (last ? 0 : ATT_UNITS_CTX); unsigned* ctr = fresh_args()->ctl + 8192 + 64 * l;
                for (;;) { if (tid == 0) MISC[16] = ATT_EARLY + __hip_atomic_fetch_add(ctr, 1u, __ATOMIC_RELAXED, __HIP_MEMORY_SCOPE_AGENT);
                    LDS_BARRIER(); const int u = (int)MISC[16]; LDS_BARRIER();
                    if (u >= nu) break;
                    attn_unit(p, l, (LAS bf16*)lds, u, tid); } }
#ifndef FILL_OFF
            {
                constexpr int NCH_M = (FILL_EM - FILL_EA + FILL_MCH - 1) / FILL_MCH; unsigned* ctr = fresh_args()->ctl + 8192 + 64 * (2 * DEPTH + l);
                const int em = (last && FILL_EM > WT_OWN) ? WT_OWN : FILL_EM;
                for (;;) { if (tid == 0) MISC[16] = __hip_atomic_fetch_add(ctr, 1u, __ATOMIC_RELAXED, __HIP_MEMORY_SCOPE_AGENT);
                    LDS_BARRIER(); const int ch = (int)MISC[16]; LDS_BARRIER();
                    const int fb = FILL_EA + ch * FILL_MCH; if (ch >= NCH_M || fb >= em) break;
                    weight_fill_ws(l, fb, fb + FILL_MCH < em ? fb + FILL_MCH : em, wave_s, 8, lds, wave_s); } }
#endif
            SEAM(sb + ST_MIX);
        }

        if (EN(2 + ST_MIXOUT) && IN(sb + ST_MIXOUT)) {
            PTRS();
#ifdef NAIVE_MIXOUT
            FOR_ITEMS(i, (size_t)MROWS * GDN_H) gdn_out_item(p, l, (int)(i / GDN_H), (int)(i % GDN_H));
            FOR_ITEMS(i, (size_t)MROWS * SSM_G) ssd_out_item(p, l, (int)(i / SSM_G), (int)(i % SSM_G));
#else
            for (int r = gwave; r < (last ? NLAT : MROWS); r += NGW) mixout_row_wave(p, l, r, lane);
#endif
            SEAM(sb + ST_MIXOUT);
        }

        if (EN(2 + ST_MERGE) && IN(sb + ST_MERGE)) {
            PTRS();
            { pg8::Gemm g{p.YA, p.Wt_br + (size_t)l * 3 * D_MODEL * MIX_W, NLAT, D_MODEL, 3 * MIX_W, 3 * MIX_W}; pg8::StaticOrder S; S.init(NLAT, D_MODEL, G, (int)blockIdx.x);
              pg8::EpiMerge3 E{p.P + C_MG, p.MB};
              pg8::gemm_phase<pg8::EpiMerge3, pg8::StaticOrder, true, true>(lds, g, S, E, tid); }
            if (!last) { pg8::Gemm g{p.YA, p.Wt_br + (size_t)l * 3 * D_MODEL * MIX_W, MROWS, D_MODEL, MIX_W, 3 * MIX_W}; pg8::CtxMergeOrder S{(int)blockIdx.x};
              pg8::EpiMerge E{p.P + C_MG, p.TB};
              FRESH_TID(tid2); pg8::gemm_phase<pg8::EpiMerge, pg8::CtxMergeOrder, true, true>(lds, g, S, E, tid2); }
#ifndef FILL_OFF
            if ((int)blockIdx.x >= FILL_B0) weight_fill(l, FILL_EM, FILL_EB, FILL_B0, lds, wave_s);
#endif
            SEAM(sb + ST_MERGE);
        }

        if (EN(2 + ST_OUT) && IN(sb + ST_OUT)) {
            PTRS();
            { pg8::Gemm g{p.MB, p.Wt_out + (size_t)l * D_MODEL * D_MODEL, NLAT, D_MODEL, D_MODEL, D_MODEL}; pg8::StaticOrder S; S.init(NLAT, D_MODEL, G, (int)blockIdx.x);
              pg8::EpiBf16Plain E{p.MIXb, D_MODEL};
              pg8::gemm_phase<pg8::EpiBf16Plain, pg8::StaticOrder, true, true>(lds, g, S, E, tid); }
            if (!last) {
                pg8::Gemm g{p.TB, p.Wt_out + (size_t)l * D_MODEL * D_MODEL, 3 * NCTX, D_MODEL, pg8::SPLIT_KS, D_MODEL}; pg8::SplitOrder3 S{G, (int)blockIdx.x};
                pg8::EpiSlab3 E{p.SLAB};
                FRESH_TID(tid2); pg8::gemm_phase<pg8::EpiSlab3, pg8::SplitOrder3, true, true>(lds, g, S, E, tid2); }
            SEAM(sb + ST_OUT);
        }

        if (EN(2 + ST_NORM2) && IN(sb + ST_NORM2)) {
            PTRS();
            for (int r = gwave; r < MR; r += NGW) { int ll = lane; asm volatile("" : "+v"(ll)); vf4 x[NV4]; row_load(l > 0 ? p.X + (size_t)r * D_MODEL : (r < NLAT ? p.x + (size_t)r * D_MODEL : p.ctx + (size_t)(r - NLAT) * D_MODEL), ll, x); resid_wave(p, l, r, 0, ll, x, 3 * pg8::OUT_NS);
                row_store(p.X + (size_t)r * D_MODEL, ll, x); norm_h_wave(p, l, r, 1, ll, x); }
            SEAM(sb + ST_NORM2);
        }

        if (EN(2 + ST_UP) && IN(sb + ST_UP)) {
            PTRS();
            pg8::Gemm g{p.H, p.Wt_up + (size_t)l * 2 * D_FF * D_MODEL, MR, 2 * D_FF, D_MODEL, D_MODEL}; pg8::StaticOrder S; S.init(MR, 2 * D_FF, G, (int)blockIdx.x);
            pg8::EpiAct E{p.ACT, p.BP, p.BU, p.BG, p.ffn_conv_w + (size_t)l * 3 * D_FF, p.ffn_conv_b + (size_t)l * D_FF};
            pg8::gemm_phase<pg8::EpiAct, pg8::StaticOrder, true, true>(lds, g, S, E, tid);
#ifndef FILL_OFF
            if ((int)blockIdx.x >= FILL_C0) weight_fill(l, FILL_EB, FILL_EC, FILL_C0, lds, wave_s);
#endif
            SEAM(sb + ST_UP);
        }

        if (EN(2 + ST_ACT) && IN(sb + ST_ACT)) { PTRS();
            for (int it = (int)gtid; it < (MR / 64 * 2) * (D_FF / 4); it += (int)NT) act_fix_item(p, l, it / (D_FF / 4), (it % (D_FF / 4)) * 4);
            SEAM(sb + ST_ACT); }

        if (EN(2 + ST_DOWN) && IN(sb + ST_DOWN)) {
            PTRS();
            { pg8::Gemm g{p.ACT, p.Wt_down + (size_t)l * D_MODEL * D_FF, NLAT, D_MODEL, D_FF, D_FF}; pg8::StaticOrder S; S.init(NLAT, D_MODEL, G, (int)blockIdx.x);
              pg8::EpiBf16Plain E{p.MIXb, D_MODEL};
              pg8::gemm_phase<pg8::EpiBf16Plain, pg8::StaticOrder, true, true>(lds, g, S, E, tid); }
            if (!last) {
                pg8::Gemm g{p.ACT, p.Wt_down + (size_t)l * D_MODEL * D_FF, MROWS, D_MODEL, pg8::SPLIT_KS, D_FF}; pg8::SplitOrder S{pg8::DOWN_NS, G, (int)blockIdx.x};
                pg8::EpiSlab E{p.SLAB};
                FRESH_TID(tid2); pg8::gemm_phase<pg8::EpiSlab, pg8::SplitOrder, true, true>(lds, g, S, E, tid2); }
            SEAM(sb + ST_DOWN);
        }

        if (EN(2 + ST_NORM3) && IN(sb + ST_NORM3)) {
            PTRS();
            for (int r = gwave; r < (last ? NLAT : MROWS); r += NGW) { int ll = lane; asm volatile("" : "+v"(ll)); vf4 x[NV4]; row_load(p.X + (size_t)r * D_MODEL, ll, x); resid_wave(p, l, r, 1, ll, x, pg8::DOWN_NS);
                if (last) row_store(p.out + (size_t)r * D_MODEL, ll, x);
                else { row_store(p.X + (size_t)r * D_MODEL, ll, x); norm_h_wave(p, l + 1, r, 0, ll, x); } }
            SEAM(sb + ST_NORM3);
        }
    }
#undef IN
#undef SEAM
#undef FOR_ITEMS
}

extern "C" void kernel_launch(void* const* d_in, const int* in_sizes, int n_in, void* d_out, int out_size, void* d_ws, size_t ws_size, hipStream_t stream) {
    static int grid = 0;
    if (grid == 0) {
        if (n_in != 30 || in_sizes[0] != NLAT * D_MODEL || out_size != NLAT * D_MODEL || ws_size < WS_NEED) {
            fprintf(stderr, "kernel_launch: unexpected problem: n_in %d in0 %d out %d ws %zu (need %zu); nothing launched\n", n_in, n_in > 0 ? in_sizes[0] : -1, out_size, ws_size, (size_t)WS_NEED); grid = -1; return; }
        int dev = 0, cus = 0;
        if (hipGetDevice(&dev) != hipSuccess || hipDeviceGetAttribute(&cus, hipDeviceAttributeMultiprocessorCount, dev) != hipSuccess) { grid = -1; return; }
        if (hipFuncSetAttribute((const void*)fwd, hipFuncAttributeMaxDynamicSharedMemorySize, LDS_BYTES) != hipSuccess) { fprintf(stderr, "kernel_launch: hipFuncSetAttribute failed\n"); grid = -1; return; }
        int per_cu = 0;
        if (hipOccupancyMaxActiveBlocksPerMultiprocessor(&per_cu, (const void*)fwd, NTHREADS, LDS_BYTES) != hipSuccess || per_cu < 1) fprintf(stderr, "kernel_launch: occupancy query reports %d\n", per_cu);
        (void)hipGetLastError();
        grid = cus;
        if (grid != 256) { fprintf(stderr, "kernel_launch: built for a 256-CU device (workgroup roles in the mixer phase); got %d; nothing launched\n", cus); grid = -1; return; }
    }
    if (grid < 0) return;
    unsigned char* ws = (unsigned char*)d_ws;
    if (hipMemsetAsync(ws + WS_CTL, 0, CTL_BYTES, stream) != hipSuccess) return;
    Args a{};
    const float** pi = (const float**)&a.p;
    for (int i = 0; i < 30; ++i) pi[i] = (const float*)d_in[i];
    Ptrs& p = a.p;
    p.out = (float*)d_out;
    p.Wt_in = (bf16*)(ws + WS_WIN); p.Wt_br = (bf16*)(ws + WS_WBR); p.Wt_out = (bf16*)(ws + WS_WOUT); p.Wt_up = (bf16*)(ws + WS_WUP); p.Wt_down = (bf16*)(ws + WS_WDOWN);
    p.MOD = (float*)(ws + WS_MOD); p.ROPE = p.MOD + (size_t)DEPTH * (BATCH + 1) * D6; p.X = (float*)(ws + WS_X); p.H = (bf16*)(ws + WS_H); p.MIX = (float*)(ws + WS_MIX); p.MIXb = (bf16*)(ws + WS_MIX);
    p.SLAB = (float*)(ws + WS_SLAB); p.TB = (bf16*)(ws + WS_TB);
    p.OGb = (bf16*)(ws + WS_OGB); p.OSb = (bf16*)(ws + WS_OSB); p.OSb2 = (bf16*)(ws + WS_OSB2); p.GQKVb = (bf16*)(ws + WS_GQKVB); p.SXb = (bf16*)(ws + WS_SXB);
    p.P = (bf16*)(ws + WS_P); p.PF = (float*)(ws + WS_PF); p.GQKV = (float*)(ws + WS_GQKV); p.GG = (float*)(ws + WS_GG); p.GB = (float*)(ws + WS_GB);
    p.SXBC = (float*)(ws + WS_SXBC); p.SDT = (float*)(ws + WS_SDT); p.SA = (float*)(ws + WS_SA); p.AQ = (float*)(ws + WS_AQ); p.AK = (float*)(ws + WS_AK);
    p.OG = (float*)(ws + WS_OG); p.OS = (float*)(ws + WS_OS); p.SC = (float*)(ws + WS_SC); p.YA = (bf16*)(ws + WS_YA); p.YB = p.YA + MIX_W; p.YC = p.YA + 2 * MIX_W;
    p.SBCb = (bf16*)(ws + WS_SBCB); p.SSC = (bf16*)(ws + WS_SSC); p.SEA = (float*)(ws + WS_SEA); p.SEAb = (bf16*)(ws + WS_SEA); p.SDC = (float*)(ws + WS_SDC); p.SCF = (bf16*)(ws + WS_SCF);
    p.GW = (bf16*)(ws + WS_GW); p.GQd = (bf16*)(ws + WS_GQD); p.GKdT = (bf16*)(ws + WS_GKDT); p.GA = (bf16*)(ws + WS_GA); p.GUT = (bf16*)(ws + WS_GUT); p.GGL = (float*)(ws + WS_GGL);
    p.AQb = (bf16*)(ws + WS_AQB); p.AKb = (bf16*)(ws + WS_AKB);
    p.M32 = (float*)(ws + WS_M32); p.MB = (bf16*)(ws + WS_MB); p.UG = nullptr; p.ACT = (bf16*)(ws + WS_ACT); p.BP = (float*)(ws + WS_BP); p.BU = (bf16*)(ws + WS_BU); p.BG = (bf16*)(ws + WS_BG);
    a.ctl = (unsigned*)(ws + WS_CTL);
#if MK_LAUNCH_MODE == 1
    a.step_lo = 0; a.step_hi = TOTAL_STEPS;
    hipLaunchKernelGGL(fwd, dim3(grid), dim3(NTHREADS), LDS_BYTES, stream, a);
#else
    for (int s = 0; s < TOTAL_STEPS; ++s) { a.step_lo = s; a.step_hi = s + 1; hipLaunchKernelGGL(fwd, dim3(grid), dim3(NTHREADS), LDS_BYTES, stream, a); }
#endif
    const hipError_t le = hipPeekAtLastError();
    if (le != hipSuccess) fprintf(stderr, "kernel_launch: launch failed: %s\n", hipGetErrorName(le));
}
```
